# Optimizing an MI355X kernel written in HIP

```python
import jax, jax.numpy as jnp
from jax import lax
import numpy as np

D_MODEL = 1024
BATCH = 8
SEQ = 2048
DEPTH = 2

LRU_WIDTH = 512
LRU_BLOCKS = 8
LRU_BLOCK = LRU_WIDTH // LRU_BLOCKS
CONV_W = 4
LRU_C = 8.0
HG_HEADS = 4
HG_DK = 128
HG_DV = 128
HG_CHUNK = 64
HG_FDIM = HG_HEADS * HG_DK
HG_VDIM = HG_HEADS * HG_DV
EVEN_IN = 2 * LRU_WIDTH + 2 * HG_FDIM + 2 * HG_VDIM
EVEN_MIX = LRU_WIDTH + HG_VDIM

HEAD_DIM = 64
NSA_HEADS = 8
NSA_GROUPS = 2
NSA_HPG = NSA_HEADS // NSA_GROUPS
NSA_KV = NSA_GROUPS * HEAD_DIM
CMP_LEN = 32
CMP_STRIDE = 16
CMP_HIDDEN = 128
SLC_LEN = 64
SLC_TOPN = 16
SLC_QBLK = 64
WIN = 512
WIN_QBLK = 128
FORCE_BONUS = 1e4
MOBA_HEADS = 8
MOBA_BLOCK = 256
MOBA_TOPK = 3
MOBA_QBLK = 32
ODD_IN = NSA_HEADS * HEAD_DIM + 6 * NSA_KV + 3 * NSA_HEADS + 3 * MOBA_HEADS * HEAD_DIM
ODD_MIX = NSA_HEADS * HEAD_DIM + MOBA_HEADS * HEAD_DIM

N_EXPERTS = 256
TOP_K = 8
N_GROUPS = 8
TOPK_GROUPS = 4
EXPERT_HIDDEN = 256
SHARED_HIDDEN = 256
ROUTED_SCALE = 2.5
DISPATCH_BLK = 128

DN_ALPHA = (2 * DEPTH) ** 0.25
DN_BETA = (8 * DEPTH) ** -0.25
N_EVEN = (DEPTH + 1) // 2
N_ODD = DEPTH // 2
LN_EPS = 1e-5
NEG = -1e30

kernel_name = "hybrid_lru_hgrn2_nsa_moba_moe"


def layer_norm(x, g, b):
    xf = x.astype(jnp.float32)
    mu = xf.mean(-1, keepdims=True)
    var = jnp.square(xf - mu).mean(-1, keepdims=True)
    return ((xf - mu) * lax.rsqrt(var + LN_EPS) * g + b).astype(x.dtype)


def masked_softmax(s, mask):
    s = jnp.where(mask, s.astype(jnp.float32), NEG)
    m = s.max(-1, keepdims=True)
    p = jnp.where(mask, jnp.exp(s - m), 0.0)
    return p / jnp.maximum(p.sum(-1, keepdims=True), 1e-30)


def alibi_slopes():
    n = NSA_HEADS + MOBA_HEADS
    s = 2.0 ** (-8.0 * np.arange(1, n + 1) / n)
    return jnp.asarray(s[0::2], jnp.float32), jnp.asarray(s[1::2], jnp.float32)


def slc_overlap(nc, ns):
    i = np.arange(nc)[:, None]
    j = np.arange(ns)[None, :]
    return ((CMP_STRIDE * i < SLC_LEN * (j + 1)) & (CMP_STRIDE * i + CMP_LEN > SLC_LEN * j)).astype(np.float32)


def rg_lru_block(xb, gb, conv_w, conv_b, wa, ba, wx, bx, lam):
    B, T, C = xb.shape
    xc = lax.conv_general_dilated(xb, conv_w[:, None, :], window_strides=(1,), padding=[(CONV_W - 1, 0)],
                                  dimension_numbers=('NWC', 'WIO', 'NWC'), feature_group_count=C) + conv_b
    xh = xc.reshape(B, T, LRU_BLOCKS, LRU_BLOCK)
    r = jax.nn.sigmoid(jnp.einsum('bthi,hij->bthj', xh, wa).reshape(B, T, C) + ba)
    i = jax.nn.sigmoid(jnp.einsum('bthi,hij->bthj', xh, wx).reshape(B, T, C) + bx)
    log_a = (-LRU_C * r * jax.nn.softplus(-lam)).astype(jnp.float32)
    a = jnp.exp(log_a)
    mult = jnp.sqrt(-jnp.expm1(2.0 * log_a)).at[:, 0].set(1.0)
    b = mult * (i * xc).astype(jnp.float32)

    def combine(l, rr):
        a1, b1 = l
        a2, b2 = rr
        return a1 * a2, a2 * b1 + b2

    _, h = lax.associative_scan(combine, (a, b), axis=1)
    return h.astype(xb.dtype) * jax.nn.gelu(gb)


def hgrn2_block(q, f_pre, v, g, lb, norm_g):
    B, T, _ = q.shape
    f32 = jnp.float32
    n_chunk = T // HG_CHUNK
    q = jax.nn.silu(q.astype(f32))
    f = lb + (1.0 - lb) * jax.nn.sigmoid(f_pre.astype(f32))
    k = 1.0 - f
    logf = jnp.log(f)

    def heads(z, d):
        return z.reshape(B, n_chunk, HG_CHUNK, HG_HEADS, d).transpose(1, 0, 3, 2, 4)

    qc, kc, gc, vc = heads(q, HG_DK), heads(k, HG_DK), heads(logf, HG_DK), heads(v.astype(f32), HG_DV)
    causal = jnp.tril(jnp.ones((HG_CHUNK, HG_CHUNK), bool))[:, :, None]

    def step(S, inp):
        qb, kb, gb, vb = inp
        cum = jnp.cumsum(gb, axis=2)
        o_inter = jnp.einsum('bhtk,bhkv->bhtv', qb * jnp.exp(cum), S)
        diff = cum[:, :, :, None, :] - cum[:, :, None, :, :]
        decay = jnp.exp(jnp.where(causal, diff, NEG))
        A = jnp.einsum('bhtk,bhsk,bhtsk->bhts', qb, kb, decay)
        o = o_inter + jnp.einsum('bhts,bhsv->bhtv', A, vb)
        last = cum[:, :, -1:, :]
        S = jnp.exp(last[:, :, 0, :])[..., None] * S + jnp.einsum('bhsk,bhsv->bhkv', kb * jnp.exp(last - cum), vb)
        return S, o

    S0 = jnp.zeros((B, HG_HEADS, HG_DK, HG_DV), f32)
    _, o = lax.scan(step, S0, (qc, kc, gc, vc))
    o = o.transpose(1, 0, 3, 2, 4).reshape(B, T, HG_HEADS, HG_DV)
    o = o * lax.rsqrt(jnp.mean(o * o, -1, keepdims=True) + 1e-6) * norm_g.reshape(HG_HEADS, HG_DV)
    return (o.reshape(B, T, HG_VDIM) * jax.nn.sigmoid(g.astype(f32))).astype(g.dtype)


def even_mixer(x, w_in, conv_w, conv_b, wa, ba, wx, bx, lam, lb, norm_g, w_out):
    u = x @ w_in
    sizes = [LRU_WIDTH, LRU_WIDTH, HG_FDIM, HG_FDIM, HG_VDIM, HG_VDIM]
    xb, gb, q, f_pre, v, g = jnp.split(u, np.cumsum(sizes)[:-1], axis=-1)
    ya = rg_lru_block(xb, gb, conv_w, conv_b, wa, ba, wx, bx, lam)
    yb = hgrn2_block(q, f_pre, v, g, lb, norm_g)
    return jnp.concatenate([ya, yb], -1).astype(x.dtype) @ w_out


def nsa_block(q, kc, vc, ks, vs, kw, vw, gates, pe_k, pe_v, wk1, wk2, wv1, wv2, slopes):
    B, T, _ = q.shape
    G, I, Dh = NSA_GROUPS, NSA_HPG, HEAD_DIM
    f32 = jnp.float32
    scale = Dh ** -0.5
    qh = q.reshape(B, T, G, I, Dh).transpose(0, 2, 3, 1, 4)

    def grp(z):
        return z.reshape(B, T, G, Dh).transpose(0, 2, 1, 3)

    kc, vc, ks, vs, kw, vw = grp(kc), grp(vc), grp(ks), grp(vs), grp(kw), grp(vw)
    sl = slopes.reshape(1, G, I, 1, 1)
    pos = jnp.arange(T)

    nc = (T - CMP_LEN) // CMP_STRIDE + 1
    cidx = jnp.arange(nc)[:, None] * CMP_STRIDE + jnp.arange(CMP_LEN)[None, :]

    def compress(z, pe, w1, w2):
        blk = (z[:, :, cidx] + pe).reshape(B, G, nc, CMP_LEN * Dh)
        return jax.nn.gelu(blk @ w1) @ w2

    k_cmp = compress(kc, pe_k, wk1, wk2)
    v_cmp = compress(vc, pe_v, wv1, wv2)
    d_c = pos[:, None] - (jnp.arange(nc) * CMP_STRIDE + CMP_LEN - 1)[None, :]
    s_c = jnp.einsum('bgitd,bgcd->bgitc', qh, k_cmp).astype(f32) * scale - sl * d_c.astype(f32)
    p_c = masked_softmax(s_c, d_c >= 0)
    o_c = jnp.einsum('bgitc,bgcd->bgitd', p_c, v_cmp)

    ns = T // SLC_LEN
    n_sel = min(SLC_TOPN, ns)
    imp = jnp.einsum('bgtc,cj->bgtj', p_c.sum(2), jnp.asarray(slc_overlap(nc, ns)))
    own = pos // SLC_LEN
    j = jnp.arange(ns)
    forced = (j[None] == 0) | (j[None] == own[:, None]) | (j[None] == own[:, None] - 1)
    imp = jnp.where(j[None] <= own[:, None], imp + FORCE_BONUS * forced, NEG)
    _, sel = lax.top_k(imp, n_sel)

    ksb = ks.reshape(B, G, ns, SLC_LEN, Dh)
    vsb = vs.reshape(B, G, ns, SLC_LEN, Dh)
    nq = T // SLC_QBLK
    q_blocks = qh.reshape(B, G, I, nq, SLC_QBLK, Dh).transpose(3, 0, 1, 2, 4, 5)
    sel_blocks = sel.reshape(B, G, nq, SLC_QBLK, n_sel).transpose(2, 0, 1, 3, 4)
    bi = jnp.arange(B)[:, None, None, None]
    gi = jnp.arange(G)[None, :, None, None]

    def slc_step(args):
        qb, sb, q0 = args
        kg = ksb[bi, gi, sb].reshape(B, G, SLC_QBLK, n_sel * SLC_LEN, Dh)
        vg = vsb[bi, gi, sb].reshape(B, G, SLC_QBLK, n_sel * SLC_LEN, Dh)
        tpos = q0 + jnp.arange(SLC_QBLK)
        spos = (sb[..., None] * SLC_LEN + jnp.arange(SLC_LEN)).reshape(B, G, SLC_QBLK, n_sel * SLC_LEN)
        dist = (tpos[:, None] - spos)[:, :, None]
        s = jnp.einsum('bgiqd,bgqkd->bgiqk', qb, kg).astype(f32) * scale - sl * dist.astype(f32)
        p = masked_softmax(s, dist >= 0)
        return jnp.einsum('bgiqk,bgqkd->bgiqd', p, vg)

    o_s = lax.map(slc_step, (q_blocks, sel_blocks, jnp.arange(nq) * SLC_QBLK))
    o_s = o_s.transpose(1, 2, 3, 0, 4, 5).reshape(B, G, I, T, Dh)

    nw = T // WIN_QBLK
    kwid = WIN + WIN_QBLK
    kidx = jnp.arange(nw)[:, None] * WIN_QBLK + jnp.arange(kwid)[None, :]
    padw = ((0, 0), (0, 0), (WIN, 0), (0, 0))
    kwb = jnp.pad(kw, padw)[:, :, kidx]
    vwb = jnp.pad(vw, padw)[:, :, kidx]
    qw = qh.reshape(B, G, I, nw, WIN_QBLK, Dh)
    tpos = jnp.arange(nw)[:, None] * WIN_QBLK + jnp.arange(WIN_QBLK)[None, :]
    spos = kidx - WIN
    dist = tpos[:, :, None] - spos[:, None, :]
    m_w = (dist >= 0) & (dist < WIN) & (spos[:, None, :] >= 0)
    s_w = jnp.einsum('bgiwqd,bgwkd->bgiwqk', qw, kwb).astype(f32) * scale - sl[..., None] * dist.astype(f32)
    p_w = masked_softmax(s_w, m_w)
    o_w = jnp.einsum('bgiwqk,bgwkd->bgiwqd', p_w, vwb).reshape(B, G, I, T, Dh)

    g = jax.nn.sigmoid(gates.astype(f32)).reshape(B, T, G, I, 3).transpose(0, 2, 3, 1, 4)
    o = g[..., 0:1] * o_c + g[..., 1:2] * o_s + g[..., 2:3] * o_w
    return o.transpose(0, 3, 1, 2, 4).reshape(B, T, G * I * Dh)


def moba_block(q, k, v, slopes):
    B, T, _ = q.shape
    H, Dh, BS = MOBA_HEADS, HEAD_DIM, MOBA_BLOCK
    f32 = jnp.float32
    scale = Dh ** -0.5
    tp = -(-T // BS) * BS

    def heads(z):
        return jnp.pad(z.reshape(B, T, H, Dh).transpose(0, 2, 1, 3), ((0, 0), (0, 0), (0, tp - T), (0, 0)))

    qh, kh, vh = heads(q), heads(k), heads(v)
    nb = tp // BS
    kb = kh.reshape(B, H, nb, BS, Dh)
    vb = vh.reshape(B, H, nb, BS, Dh)
    kmean = kb.mean(3)
    n_sel = min(MOBA_TOPK, nb - 1)
    sl = slopes.reshape(1, H, 1, 1)
    bi = jnp.arange(B)[:, None, None, None]
    hi = jnp.arange(H)[None, :, None, None]
    nq = tp // MOBA_QBLK
    q_blocks = qh.reshape(B, H, nq, MOBA_QBLK, Dh).transpose(2, 0, 1, 3, 4)

    def step(args):
        qb, q0 = args
        tpos = q0 + jnp.arange(MOBA_QBLK)
        ob = q0 // BS
        k_own = lax.dynamic_slice_in_dim(kh, ob * BS, BS, axis=2)
        v_own = lax.dynamic_slice_in_dim(vh, ob * BS, BS, axis=2)
        d_own = tpos[:, None] - (ob * BS + jnp.arange(BS))[None, :]
        s_own = jnp.einsum('bhqd,bhkd->bhqk', qb, k_own).astype(f32) * scale - sl * d_own.astype(f32)
        m_own = jnp.broadcast_to(d_own >= 0, s_own.shape)
        if n_sel == 0:
            return jnp.einsum('bhqk,bhkd->bhqd', masked_softmax(s_own, m_own), v_own)
        gate = jnp.einsum('bhqd,bhjd->bhqj', qb, kmean).astype(f32)
        gate = jnp.where(jnp.arange(nb) < ob, gate, NEG)
        _, sel = lax.top_k(gate, n_sel)
        kg = kb[bi, hi, sel].reshape(B, H, MOBA_QBLK, n_sel * BS, Dh)
        vg = vb[bi, hi, sel].reshape(B, H, MOBA_QBLK, n_sel * BS, Dh)
        spos = (sel[..., None] * BS + jnp.arange(BS)).reshape(B, H, MOBA_QBLK, n_sel * BS)
        s_sel = jnp.einsum('bhqd,bhqkd->bhqk', qb, kg).astype(f32) * scale - sl * (tpos[:, None] - spos).astype(f32)
        m_sel = jnp.repeat(sel < ob, BS, axis=-1)
        p = masked_softmax(jnp.concatenate([s_sel, s_own], -1), jnp.concatenate([m_sel, m_own], -1))
        nk = n_sel * BS
        return (jnp.einsum('bhqk,bhqkd->bhqd', p[..., :nk], vg)
                + jnp.einsum('bhqk,bhkd->bhqd', p[..., nk:], v_own))

    o = lax.map(step, (q_blocks, jnp.arange(nq) * MOBA_QBLK))
    return o.transpose(1, 0, 3, 2, 4).reshape(B, tp, H * Dh)[:, :T]


def odd_mixer(x, w_in, pe_k, pe_v, wk1, wk2, wv1, wv2, w_out):
    u = x @ w_in
    sizes = [NSA_HEADS * HEAD_DIM] + [NSA_KV] * 6 + [3 * NSA_HEADS] + [MOBA_HEADS * HEAD_DIM] * 3
    q, kc, vc, ks, vs, kw, vw, gates, mq, mk, mv = jnp.split(u, np.cumsum(sizes)[:-1], axis=-1)
    s_nsa, s_moba = alibi_slopes()
    yc = nsa_block(q, kc, vc, ks, vs, kw, vw, gates, pe_k, pe_v, wk1, wk2, wv1, wv2, s_nsa)
    yd = moba_block(mq, mk, mv, s_moba)
    return jnp.concatenate([yc, yd], -1).astype(x.dtype) @ w_out


def routed_experts(xf, eidx, w, w_gate, w_up, w_down):
    N, D = xf.shape
    A = N * TOP_K
    flat_e = eidx.reshape(-1)
    order = jnp.argsort(flat_e)
    se = flat_e[order]
    stok = (order // TOP_K).astype(jnp.int32)
    sw = w.reshape(-1)[order]
    counts = jnp.bincount(flat_e, length=N_EXPERTS)
    padded = (counts + DISPATCH_BLK - 1) // DISPATCH_BLK * DISPATCH_BLK
    pend = jnp.cumsum(padded)
    pstart = pend - padded
    gstart = jnp.cumsum(counts) - counts
    dest = pstart[se] + jnp.arange(A) - gstart[se]
    n_blk = (A + DISPATCH_BLK - 1) // DISPATCH_BLK + N_EXPERTS
    n_rows = n_blk * DISPATCH_BLK
    row_tok = jnp.zeros((n_rows,), jnp.int32).at[dest].set(stok)
    row_w = jnp.zeros((n_rows,), sw.dtype).at[dest].set(sw)
    blk_e = jnp.minimum(jnp.searchsorted(pend, jnp.arange(n_blk) * DISPATCH_BLK, side='right'), N_EXPERTS - 1)
    xs = xf[row_tok].reshape(n_blk, DISPATCH_BLK, D)

    def run(args):
        xb, e = args
        return (jax.nn.silu(xb @ w_gate[e]) * (xb @ w_up[e])) @ w_down[e]

    y = lax.map(run, (xs, blk_e)).reshape(n_rows, D)
    return jax.ops.segment_sum(y * row_w[:, None].astype(y.dtype), row_tok, num_segments=N)


def moe(x, w_router, b_router, w_gate, w_up, w_down, ws_gate, ws_up, ws_down):
    B, T, D = x.shape
    xf = x.reshape(B * T, D)
    N = B * T
    scores = jax.nn.sigmoid((xf @ w_router).astype(jnp.float32))
    biased = scores + b_router
    gscore = lax.top_k(biased.reshape(N, N_GROUPS, N_EXPERTS // N_GROUPS), 2)[0].sum(-1)
    _, gidx = lax.top_k(gscore, TOPK_GROUPS)
    gmask = jax.nn.one_hot(gidx, N_GROUPS).sum(-2) > 0
    emask = jnp.repeat(gmask, N_EXPERTS // N_GROUPS, axis=-1)
    _, eidx = lax.top_k(jnp.where(emask, biased, NEG), TOP_K)
    w = jnp.take_along_axis(scores, eidx, axis=1)
    w = w / w.sum(-1, keepdims=True) * ROUTED_SCALE
    routed = routed_experts(xf, eidx, w, w_gate, w_up, w_down)
    shared = (jax.nn.silu(xf @ ws_gate) * (xf @ ws_up)) @ ws_down
    return (routed.astype(x.dtype) + shared).reshape(B, T, D)


def setup_inputs(seed: int = 0) -> dict:
    key = jax.random.key(seed)
    keys = iter(jax.random.split(key, 32))

    def nrm(shape, scale):
        return jax.random.normal(next(keys), shape, jnp.float32) * scale

    D = D_MODEL
    x = nrm((BATCH, SEQ, D), 1.0)
    even_w_in = nrm((N_EVEN, D, EVEN_IN), D ** -0.5)
    lru_conv_w = nrm((N_EVEN, CONV_W, LRU_WIDTH), CONV_W ** -0.5)
    lru_conv_b = nrm((N_EVEN, LRU_WIDTH), 0.01)
    lru_wa = nrm((N_EVEN, LRU_BLOCKS, LRU_BLOCK, LRU_BLOCK), LRU_BLOCK ** -0.5)
    lru_ba = nrm((N_EVEN, LRU_WIDTH), 0.01)
    lru_wx = nrm((N_EVEN, LRU_BLOCKS, LRU_BLOCK, LRU_BLOCK), LRU_BLOCK ** -0.5)
    lru_bx = nrm((N_EVEN, LRU_WIDTH), 0.01)
    a_c = jax.random.uniform(next(keys), (N_EVEN, LRU_WIDTH), jnp.float32, 0.9, 0.999)
    a = a_c ** (1.0 / LRU_C)
    lru_lambda = jnp.log(a) - jnp.log1p(-a)
    hg_lower_bound = nrm((DEPTH + 1, HG_FDIM), 0.5)
    hg_norm_g = 1.0 + nrm((N_EVEN, HG_VDIM), 0.02)
    even_w_out = nrm((N_EVEN, EVEN_MIX, D), EVEN_MIX ** -0.5 * DN_BETA)
    odd_w_in = nrm((N_ODD, D, ODD_IN), D ** -0.5)
    nsa_pe_k = nrm((N_ODD, CMP_LEN, HEAD_DIM), 0.1)
    nsa_pe_v = nrm((N_ODD, CMP_LEN, HEAD_DIM), 0.1)
    nsa_wk1 = nrm((N_ODD, CMP_LEN * HEAD_DIM, CMP_HIDDEN), (CMP_LEN * HEAD_DIM) ** -0.5)
    nsa_wk2 = nrm((N_ODD, CMP_HIDDEN, HEAD_DIM), CMP_HIDDEN ** -0.5)
    nsa_wv1 = nrm((N_ODD, CMP_LEN * HEAD_DIM, CMP_HIDDEN), (CMP_LEN * HEAD_DIM) ** -0.5)
    nsa_wv2 = nrm((N_ODD, CMP_HIDDEN, HEAD_DIM), CMP_HIDDEN ** -0.5)
    odd_w_out = nrm((N_ODD, ODD_MIX, D), ODD_MIX ** -0.5 * DN_BETA)
    ln_g = 1.0 + nrm((DEPTH, 2, D), 0.02)
    ln_b = nrm((DEPTH, 2, D), 0.01)
    w_router = nrm((DEPTH, D, N_EXPERTS), D ** -0.5)
    b_router = nrm((DEPTH, N_EXPERTS), 0.01)
    w_gate = nrm((DEPTH, N_EXPERTS, D, EXPERT_HIDDEN), D ** -0.5)
    w_up = nrm((DEPTH, N_EXPERTS, D, EXPERT_HIDDEN), D ** -0.5)
    w_down = nrm((DEPTH, N_EXPERTS, EXPERT_HIDDEN, D), EXPERT_HIDDEN ** -0.5 * DN_BETA)
    ws_gate = nrm((DEPTH, D, SHARED_HIDDEN), D ** -0.5)
    ws_up = nrm((DEPTH, D, SHARED_HIDDEN), D ** -0.5)
    ws_down = nrm((DEPTH, SHARED_HIDDEN, D), SHARED_HIDDEN ** -0.5 * DN_BETA)
    return {"x": x, "even_w_in": even_w_in, "lru_conv_w": lru_conv_w, "lru_conv_b": lru_conv_b,
            "lru_wa": lru_wa, "lru_ba": lru_ba, "lru_wx": lru_wx, "lru_bx": lru_bx,
            "lru_lambda": lru_lambda, "hg_lower_bound": hg_lower_bound, "hg_norm_g": hg_norm_g,
            "even_w_out": even_w_out, "odd_w_in": odd_w_in, "nsa_pe_k": nsa_pe_k, "nsa_pe_v": nsa_pe_v,
            "nsa_wk1": nsa_wk1, "nsa_wk2": nsa_wk2, "nsa_wv1": nsa_wv1, "nsa_wv2": nsa_wv2,
            "odd_w_out": odd_w_out, "ln_g": ln_g, "ln_b": ln_b, "w_router": w_router,
            "b_router": b_router, "w_gate": w_gate, "w_up": w_up, "w_down": w_down,
            "ws_gate": ws_gate, "ws_up": ws_up, "ws_down": ws_down}


def reference(x, even_w_in, lru_conv_w, lru_conv_b, lru_wa, lru_ba, lru_wx, lru_bx, lru_lambda,
              hg_lower_bound, hg_norm_g, even_w_out, odd_w_in, nsa_pe_k, nsa_pe_v, nsa_wk1, nsa_wk2,
              nsa_wv1, nsa_wv2, odd_w_out, ln_g, ln_b, w_router, b_router, w_gate, w_up, w_down,
              ws_gate, ws_up, ws_down):
    lb_all = jnp.cumsum(jax.nn.softmax(hg_lower_bound.astype(jnp.float32), axis=0), axis=0)
    for layer in range(DEPTH):
        li = layer // 2
        if layer % 2 == 0:
            mix = even_mixer(x, even_w_in[li], lru_conv_w[li], lru_conv_b[li], lru_wa[li], lru_ba[li],
                             lru_wx[li], lru_bx[li], lru_lambda[li], lb_all[layer], hg_norm_g[li], even_w_out[li])
        else:
            mix = odd_mixer(x, odd_w_in[li], nsa_pe_k[li], nsa_pe_v[li], nsa_wk1[li], nsa_wk2[li],
                            nsa_wv1[li], nsa_wv2[li], odd_w_out[li])
        x = layer_norm(DN_ALPHA * x + mix, ln_g[layer, 0], ln_b[layer, 0])
        ff = moe(x, w_router[layer], b_router[layer], w_gate[layer], w_up[layer], w_down[layer],
                 ws_gate[layer], ws_up[layer], ws_down[layer])
        x = layer_norm(DN_ALPHA * x + ff, ln_g[layer, 1], ln_b[layer, 1])
    return x
```

```cpp
#include <hip/hip_runtime.h>
#include <hip/hip_bf16.h>
#include <stdint.h>

#define NTOK 16384
#define DM 1024
#define SEQ 2048
#define NBATCH 8
#define EVEN_IN 3072
#define ODD_IN 2840
#define NEXP 256
#define NEGF (-1e30f)
#define DN_ALPHA 1.4142135623730951f
#define LN_EPS 1e-5f
#define MAXRT 1280
#define SH_TILE0 1280
#define NTILES (1280 + 128)
#define NROWS (NTILES * 128)

typedef unsigned short bf16_t;
typedef short bf16x8 __attribute__((ext_vector_type(8)));
typedef float f32x4 __attribute__((ext_vector_type(4)));
typedef unsigned u32x4 __attribute__((ext_vector_type(4)));
typedef unsigned u32x2 __attribute__((ext_vector_type(2)));

__device__ __forceinline__ float wave_sum(float v) {
#pragma unroll
    for (int o = 32; o >= 1; o >>= 1) v += __shfl_xor(v, o);
    return v;
}
__device__ __forceinline__ float wave_max(float v) {
#pragma unroll
    for (int o = 32; o >= 1; o >>= 1) v = fmaxf(v, __shfl_xor(v, o));
    return v;
}
__device__ __forceinline__ unsigned f2bf(float f) {
    unsigned u = __float_as_uint(f);
    u += 0x7FFFu + ((u >> 16) & 1u);
    return u >> 16;
}
__device__ __forceinline__ float bf2f(unsigned b) { return __uint_as_float(b << 16); }
__device__ __forceinline__ unsigned pack2(float lo, float hi) { return f2bf(lo) | (f2bf(hi) << 16); }
__device__ __forceinline__ float sigmoidf_(float x) { return 1.0f / (1.0f + __expf(-x)); }
__device__ __forceinline__ float siluf_(float x) { return x / (1.0f + __expf(-x)); }
__device__ __forceinline__ float gelu_tanh(float x) {
    const float u = 0.7978845608028654f * (x + 0.044715f * x * x * x);
    return 0.5f * x * (1.0f + tanhf(u));
}

struct P {
    const float *x, *even_w_in, *conv_w, *conv_b, *wa, *ba, *wx, *bx, *lam, *hg_lb, *hg_ng, *even_w_out;
    const float *odd_w_in, *pe_k, *pe_v, *wk1, *wk2, *wv1, *wv2, *odd_w_out, *ln_g, *ln_b, *w_router, *b_router;
    const float *w_gate, *w_up, *w_down, *ws_gate, *ws_up, *ws_down;
    float* out;
    float* U;
    bf16_t* MIX;
    float* T0;
    float* XA; bf16_t* XAb; float* XB; bf16_t* XBb;
    float* LOG;
    int* eidx; float* ew; int* erank; int* epos;
    int* cnt;
    int* tile_e;
    int* rowtok;
    bf16_t* H;
    bf16_t* Y;
    float* LA; float* LB;
    float* KC; float* VC;
    float* OC;
    unsigned* SELM;
    float* KM;
};

__device__ __forceinline__ int lds_off(int r, int c) {
    const int st = (r >> 4) * 2 + (c >> 5), ob = (r & 15) * 64 + (c & 31) * 2;
    return st * 1024 + (ob ^ (((ob >> 9) & 1) << 5));
}
#define GEMM_LDS 32768

__device__ __forceinline__ float cvt_part(float v, int lo) { return lo ? (v - bf2f(f2bf(v))) : v; }

struct ALoadF32 {
    const float* rp[4];
    int nk1;
    struct Regs { f32x4 v[8]; };
    __device__ __forceinline__ void load(int kt, Regs& R) const {
        const int k = (kt % nk1) * 64;
#pragma unroll
        for (int i = 0; i < 4; ++i) { R.v[2 * i] = *(const f32x4*)(rp[i] + k); R.v[2 * i + 1] = *(const f32x4*)(rp[i] + k + 4); }
    }
    __device__ __forceinline__ void store(int kt, const Regs& R, char* lds) const {
        const int lo = (kt / nk1) == 2;
#pragma unroll
        for (int i = 0; i < 4; ++i) {
            const int p = threadIdx.x + 256 * i, row = p >> 3, ch = p & 7;
            const f32x4 a = R.v[2 * i], b = R.v[2 * i + 1];
            u32x4 w;
            w.x = pack2(cvt_part(a[0], lo), cvt_part(a[1], lo)); w.y = pack2(cvt_part(a[2], lo), cvt_part(a[3], lo));
            w.z = pack2(cvt_part(b[0], lo), cvt_part(b[1], lo)); w.w = pack2(cvt_part(b[2], lo), cvt_part(b[3], lo));
            *(u32x4*)(lds + lds_off(row, ch * 8)) = w;
        }
    }
};
struct ALoadBF16 {
    const bf16_t* rp[4];
    struct Regs { u32x4 v[4]; };
    __device__ __forceinline__ void load(int kt, Regs& R) const {
#pragma unroll
        for (int i = 0; i < 4; ++i) R.v[i] = *(const u32x4*)(rp[i] + kt * 64);
    }
    __device__ __forceinline__ void store(int kt, const Regs& R, char* lds) const {
#pragma unroll
        for (int i = 0; i < 4; ++i) { const int p = threadIdx.x + 256 * i; *(u32x4*)(lds + lds_off(p >> 3, (p & 7) * 8)) = R.v[i]; }
    }
};
struct BLoadF32 {
    const float* bp; int ldb; bool valid; int nk1;
    struct Regs { f32x4 v[8]; };
    __device__ __forceinline__ void load(int kt, Regs& R) const {
        const float* p = bp + (size_t)((kt % nk1) * 64) * ldb;
#pragma unroll
        for (int j = 0; j < 8; ++j) R.v[j] = valid ? *(const f32x4*)(p + (size_t)j * ldb) : (f32x4){0.f, 0.f, 0.f, 0.f};
    }
    __device__ __forceinline__ void store(int kt, const Regs& R, char* lds) const {
        const int lo = (kt / nk1) == 1;
        const int nq = threadIdx.x & 31, kg = threadIdx.x >> 5;
#pragma unroll
        for (int i = 0; i < 4; ++i) {
            u32x4 w;
            w.x = pack2(cvt_part(R.v[0][i], lo), cvt_part(R.v[1][i], lo)); w.y = pack2(cvt_part(R.v[2][i], lo), cvt_part(R.v[3][i], lo));
            w.z = pack2(cvt_part(R.v[4][i], lo), cvt_part(R.v[5][i], lo)); w.w = pack2(cvt_part(R.v[6][i], lo), cvt_part(R.v[7][i], lo));
            *(u32x4*)(lds + lds_off(nq * 4 + i, kg * 8)) = w;
        }
    }
};

template <class AL, class BL>
__device__ __forceinline__ void gemm_tile(char* lds, const AL& al, const BL& bl, int nk, f32x4 (&acc)[4][4]) {
    const int lane = threadIdx.x & 63, wid = threadIdx.x >> 6, wr = wid >> 1, wc = wid & 1, fr = lane & 15, fq = lane >> 4;
    char* ldsA = lds; char* ldsB = lds + 16384;
#pragma unroll
    for (int m = 0; m < 4; ++m)
#pragma unroll
        for (int n = 0; n < 4; ++n) acc[m][n] = (f32x4){0.f, 0.f, 0.f, 0.f};
    typename AL::Regs ra; typename BL::Regs rb;
    al.load(0, ra); bl.load(0, rb);
    for (int kt = 0; kt < nk; ++kt) {
        __syncthreads();
        al.store(kt, ra, ldsA); bl.store(kt, rb, ldsB);
        __syncthreads();
        if (kt + 1 < nk) { al.load(kt + 1, ra); bl.load(kt + 1, rb); }
#pragma unroll
        for (int kk = 0; kk < 2; ++kk) {
            bf16x8 a[4], b[4];
#pragma unroll
            for (int m = 0; m < 4; ++m) a[m] = *(const bf16x8*)(ldsA + lds_off(wr * 64 + m * 16 + fr, kk * 32 + fq * 8));
#pragma unroll
            for (int n = 0; n < 4; ++n) b[n] = *(const bf16x8*)(ldsB + lds_off(wc * 64 + n * 16 + fr, kk * 32 + fq * 8));
#pragma unroll
            for (int m = 0; m < 4; ++m)
#pragma unroll
                for (int n = 0; n < 4; ++n) acc[m][n] = __builtin_amdgcn_mfma_f32_16x16x32_bf16(b[n], a[m], acc[m][n], 0, 0, 0);
        }
    }
}

template <bool AF32, bool SPLIT>
__device__ __forceinline__ void phase_gemm_dense(char* lds, int bid, int nb, const void* A, int lda, const float* W, int ldw, int M, int N, int K, float* C, int ldc) {
    const int ntn = (N + 127) / 128, ntm = M / 128, nk1 = K / 64;
    const int tid = threadIdx.x, lane = tid & 63, wid = tid >> 6, wr = wid >> 1, wc = wid & 1, fr = lane & 15, fq = lane >> 4;
    for (int u = bid; u < ntm * ntn; u += nb) {
        const int tm = u / ntn, tn = u % ntn;
        BLoadF32 bl; { const int nq = tid & 31, kg = tid >> 5; const int col = tn * 128 + nq * 4; bl.valid = col < N; bl.ldb = ldw; bl.nk1 = SPLIT ? nk1 : (1 << 30);
            bl.bp = W + (size_t)(kg * 8) * ldw + (bl.valid ? col : 0); }
        f32x4 acc[4][4];
        if (AF32) {
            ALoadF32 al; al.nk1 = SPLIT ? nk1 : (1 << 30);
#pragma unroll
            for (int i = 0; i < 4; ++i) { const int p = tid + 256 * i; al.rp[i] = (const float*)A + (size_t)(tm * 128 + (p >> 3)) * lda + (p & 7) * 8; }
            gemm_tile(lds, al, bl, SPLIT ? 3 * nk1 : nk1, acc);
        } else {
            ALoadBF16 al;
#pragma unroll
            for (int i = 0; i < 4; ++i) { const int p = tid + 256 * i; al.rp[i] = (const bf16_t*)A + (size_t)(tm * 128 + (p >> 3)) * lda + (p & 7) * 8; }
            gemm_tile(lds, al, bl, nk1, acc);
        }
#pragma unroll
        for (int m = 0; m < 4; ++m)
#pragma unroll
            for (int n = 0; n < 4; ++n) {
                const int row = tm * 128 + wr * 64 + m * 16 + fr, col = tn * 128 + wc * 64 + n * 16 + fq * 4;
                if (col < N) *(f32x4*)(C + (size_t)row * ldc + col) = acc[m][n];
            }
    }
}

__device__ __forceinline__ void ln_row_store(float (&v)[16], const float* g, const float* b, float* of, bf16_t* ob, int row, int lane) {
    float s = 0.f;
#pragma unroll
    for (int i = 0; i < 16; ++i) s += v[i];
    const float mu = wave_sum(s) * (1.0f / DM);
    float q = 0.f;
#pragma unroll
    for (int i = 0; i < 16; ++i) { const float d = v[i] - mu; q += d * d; }
    const float rstd = rsqrtf(wave_sum(q) * (1.0f / DM) + LN_EPS);
#pragma unroll
    for (int h = 0; h < 2; ++h) {
        const int c0 = h * 512 + lane * 8;
        float o[8];
#pragma unroll
        for (int i = 0; i < 8; ++i) o[i] = (v[h * 8 + i] - mu) * rstd * g[c0 + i] + b[c0 + i];
        *(f32x4*)(of + (size_t)row * DM + c0) = (f32x4){o[0], o[1], o[2], o[3]};
        *(f32x4*)(of + (size_t)row * DM + c0 + 4) = (f32x4){o[4], o[5], o[6], o[7]};
        if (ob) { u32x4 w; w.x = pack2(o[0], o[1]); w.y = pack2(o[2], o[3]); w.z = pack2(o[4], o[5]); w.w = pack2(o[6], o[7]); *(u32x4*)(ob + (size_t)row * DM + c0) = w; }
    }
}
__device__ __forceinline__ void phase_ln_add(int bid, int nb, const float* res, const float* add, const float* g, const float* b, float* of, bf16_t* ob) {
    const int lane = threadIdx.x & 63, wid = threadIdx.x >> 6;
    for (int row = bid * 4 + wid; row < NTOK; row += nb * 4) {
        float v[16];
#pragma unroll
        for (int h = 0; h < 2; ++h) {
            const size_t o = (size_t)row * DM + h * 512 + lane * 8;
            const f32x4 r0 = *(const f32x4*)(res + o), r1 = *(const f32x4*)(res + o + 4), a0 = *(const f32x4*)(add + o), a1 = *(const f32x4*)(add + o + 4);
#pragma unroll
            for (int i = 0; i < 4; ++i) { v[h * 8 + i] = DN_ALPHA * r0[i] + a0[i]; v[h * 8 + 4 + i] = DN_ALPHA * r1[i] + a1[i]; }
        }
        ln_row_store(v, g, b, of, ob, row, lane);
    }
}

__device__ __forceinline__ void phase_lru_gates(char* lds, int bid, int nb, const P& p) {
    float* xs = (float*)lds;
    const int tid = threadIdx.x;
    for (int tok = bid; tok < NTOK; tok += nb) {
        const int t = tok & (SEQ - 1);
        __syncthreads();
#pragma unroll
        for (int cc = 0; cc < 2; ++cc) {
            const int c = tid + 256 * cc;
            float xc = p.conv_b[c];
#pragma unroll
            for (int w = 0; w < 4; ++w) { const int tt = t - 3 + w; if (tt >= 0) xc += p.conv_w[w * 512 + c] * p.U[(size_t)(tok - 3 + w) * EVEN_IN + c]; }
            xs[c] = xc;
        }
        __syncthreads();
#pragma unroll
        for (int cc = 0; cc < 2; ++cc) {
            const int c = tid + 256 * cc, h = c >> 6, j = c & 63;
            float ra = p.ba[c], ri = p.bx[c];
#pragma unroll 8
            for (int i = 0; i < 64; ++i) { const float xv = xs[h * 64 + i]; ra += xv * p.wa[(h * 64 + i) * 64 + j]; ri += xv * p.wx[(h * 64 + i) * 64 + j]; }
            const float r = sigmoidf_(ra), ig = sigmoidf_(ri);
            const float nl = -p.lam[c];
            const float sp = fmaxf(nl, 0.f) + log1pf(expf(-fabsf(nl)));
            const float log_a = -8.0f * r * sp;
            const float a = expf(log_a);
            const float mult = (t == 0) ? 1.0f : sqrtf(-expm1f(2.0f * log_a));
            p.LA[(size_t)tok * 512 + c] = a;
            p.LB[(size_t)tok * 512 + c] = mult * ig * xs[c];
        }
    }
}
__device__ __forceinline__ void phase_lru_scan(int bid, int nb, const P& p) {
    for (int it = bid * 256 + threadIdx.x; it < NBATCH * 512; it += nb * 256) {
        const int b = it >> 9, c = it & 511;
        float h = 0.f;
        for (int t = 0; t < SEQ; ++t) {
            const size_t n = (size_t)b * SEQ + t;
            h = p.LA[n * 512 + c] * h + p.LB[n * 512 + c];
            const float gb = p.U[n * EVEN_IN + 512 + c];
            p.MIX[n * DM + c] = (bf16_t)f2bf(h * gelu_tanh(gb));
        }
    }
}
__device__ __forceinline__ void phase_hgrn_seq(char* lds, int bid, int nb, const P& p) {
    const int tid = threadIdx.x, half = tid >> 7, v = tid & 127;
    float* sq = (float*)lds + half * 512;
    float* sf = sq + 128;
    float* red = sq + 256;
    for (int u0 = bid * 2; u0 < NBATCH * 4; u0 += nb * 2) {
        const int u = u0 + half;
        const int b = u >> 2, h = u & 3;
        const int ch = h * 128 + v;
        float lbv; { const float l0 = p.hg_lb[ch], l1 = p.hg_lb[512 + ch], l2 = p.hg_lb[1024 + ch]; const float mx = fmaxf(l0, fmaxf(l1, l2));
            const float e0 = expf(l0 - mx), e1 = expf(l1 - mx), e2 = expf(l2 - mx); lbv = e0 / (e0 + e1 + e2); }
        const float ng = p.hg_ng[ch];
        float S[128];
#pragma unroll
        for (int k = 0; k < 128; ++k) S[k] = 0.f;
        for (int t = 0; t < SEQ; ++t) {
            const size_t n = (size_t)b * SEQ + t;
            const float* ur = p.U + n * EVEN_IN;
            const float qv = siluf_(ur[1024 + ch]);
            const float f = lbv + (1.0f - lbv) * sigmoidf_(ur[1536 + ch]);
            __syncthreads();
            sq[v] = qv; sf[v] = f;
            __syncthreads();
            const float vv = ur[2048 + ch];
            float o = 0.f;
#pragma unroll
            for (int k = 0; k < 128; ++k) { const float fk = sf[k]; S[k] = fk * S[k] + (1.0f - fk) * vv; o += sq[k] * S[k]; }
            const float ss = wave_sum(o * o);
            if ((tid & 63) == 0) red[(tid >> 6) & 1] = ss;
            __syncthreads();
            const float tot = red[0] + red[1];
            const float y = o * rsqrtf(tot * (1.0f / 128.0f) + 1e-6f) * ng * sigmoidf_(ur[2560 + ch]);
            p.MIX[n * DM + 512 + ch] = (bf16_t)f2bf(y);
        }
        __syncthreads();
    }
}

__device__ __forceinline__ void phase_route(int bid, int nb, const P& p, int layer) {
    const float* br = p.b_router + layer * NEXP;
    const int gt = bid * 256 + threadIdx.x, gs = nb * 256;
    for (int i = gt; i < NROWS; i += gs) p.rowtok[i] = (i >= SH_TILE0 * 128) ? (i - SH_TILE0 * 128) : 0;
    for (int t = gt; t < NTOK; t += gs) {
        const float* lg = p.LOG + (size_t)t * NEXP;
        float gsc[8];
#pragma unroll
        for (int g = 0; g < 8; ++g) {
            float t1 = -3e38f, t2 = -3e38f;
            for (int j = 0; j < 32; ++j) { const float s = sigmoidf_(lg[g * 32 + j]) + br[g * 32 + j]; if (s > t1) { t2 = t1; t1 = s; } else if (s > t2) t2 = s; }
            gsc[g] = t1 + t2;
        }
        unsigned allowed = 0;
#pragma unroll
        for (int g = 0; g < 8; ++g) {
            int rank = 0;
#pragma unroll
            for (int g2 = 0; g2 < 8; ++g2) rank += (gsc[g2] > gsc[g] || (gsc[g2] == gsc[g] && g2 < g)) ? 1 : 0;
            if (rank < 4) allowed |= 1u << g;
        }
        float pv = 3e38f; int pe = -1; float wsum = 0.f; float wk[8]; int ek[8];
#pragma unroll
        for (int k = 0; k < 8; ++k) {
            float bv = -3e38f; int be = 0; float bs = 0.f;
            for (int e = 0; e < NEXP; ++e) {
                if (!((allowed >> (e >> 5)) & 1u)) continue;
                const float sc = sigmoidf_(lg[e]); const float s = sc + br[e];
                const bool after = (s < pv) || (s == pv && e > pe);
                if (after && s > bv) { bv = s; be = e; bs = sc; }
            }
            pv = bv; pe = be; wk[k] = bs; ek[k] = be; wsum += bs;
        }
#pragma unroll
        for (int k = 0; k < 8; ++k) {
            p.eidx[t * 8 + k] = ek[k];
            p.ew[t * 8 + k] = wk[k] / wsum * 2.5f;
            p.erank[t * 8 + k] = atomicAdd(&p.cnt[ek[k]], 1);
        }
    }
}
__device__ __forceinline__ void phase_scatter(char* lds, int bid, int nb, const P& p) {
    int* base = (int*)lds;
    const int tid = threadIdx.x;
    __syncthreads();
    { int s = 0; for (int e = 0; e < tid; ++e) s += (p.cnt[e] + 127) & ~127; base[tid] = s; if (tid == 255) base[256] = s + ((p.cnt[255] + 127) & ~127); }
    __syncthreads();
    for (int a = bid * 256 + tid; a < NTOK * 8; a += nb * 256) {
        const int e = p.eidx[a]; const int row = base[e] + p.erank[a];
        p.rowtok[row] = a >> 3; p.epos[a] = row;
    }
    if (bid == 0) {
        const int nrt = base[256] >> 7;
        for (int i = tid; i < NTILES; i += 256) if (i >= nrt) p.tile_e[i] = (i >= SH_TILE0) ? NEXP : -1;
        const int t0 = base[tid] >> 7, t1 = base[tid + 1] >> 7;
        for (int i = t0; i < t1; ++i) p.tile_e[i] = tid;
    }
    __syncthreads();
}
__device__ __forceinline__ void phase_moe1(char* lds, int bid, int nb, const P& p, int layer, const bf16_t* Xb) {
    const int tid = threadIdx.x, lane = tid & 63, wid = tid >> 6, wr = wid >> 1, wc = wid & 1, fr = lane & 15, fq = lane >> 4;
    for (int u = bid; u < NTILES * 4; u += nb) {
        const int tile = u >> 2, nt = u & 3;
        const int e = p.tile_e[tile];
        if (e < 0) continue;
        const float* Wg = (e < NEXP) ? p.w_gate + ((size_t)layer * NEXP + e) * (DM * 256) : p.ws_gate + (size_t)layer * (DM * 256);
        const float* Wu = (e < NEXP) ? p.w_up + ((size_t)layer * NEXP + e) * (DM * 256) : p.ws_up + (size_t)layer * (DM * 256);
        ALoadBF16 al;
#pragma unroll
        for (int i = 0; i < 4; ++i) { const int pp = tid + 256 * i; const int tok = p.rowtok[tile * 128 + (pp >> 3)]; al.rp[i] = Xb + (size_t)tok * DM + (pp & 7) * 8; }
        BLoadF32 bl; { const int nq = tid & 31, kg = tid >> 5; const int j = nq * 4, jw = j & 63, w2 = j >> 6; const int col = nt * 64 + w2 * 32 + (jw & 31);
            bl.valid = true; bl.ldb = 256; bl.nk1 = 1 << 30; bl.bp = ((jw >= 32) ? Wu : Wg) + (size_t)(kg * 8) * 256 + col; }
        f32x4 acc[4][4];
        gemm_tile(lds, al, bl, DM / 64, acc);
#pragma unroll
        for (int m = 0; m < 4; ++m)
#pragma unroll
            for (int n = 0; n < 2; ++n) {
                const int row = tile * 128 + wr * 64 + m * 16 + fr, col = nt * 64 + wc * 32 + n * 16 + fq * 4;
                const f32x4 g = acc[m][n], uu = acc[m][n + 2];
                u32x2 w; w.x = pack2(siluf_(g[0]) * uu[0], siluf_(g[1]) * uu[1]); w.y = pack2(siluf_(g[2]) * uu[2], siluf_(g[3]) * uu[3]);
                *(u32x2*)(p.H + (size_t)row * 256 + col) = w;
            }
    }
}
__device__ __forceinline__ void phase_moe2(char* lds, int bid, int nb, const P& p, int layer) {
    const int tid = threadIdx.x, lane = tid & 63, wid = tid >> 6, wr = wid >> 1, wc = wid & 1, fr = lane & 15, fq = lane >> 4;
    for (int u = bid; u < NTILES * 8; u += nb) {
        const int tile = u >> 3, nt = u & 7;
        const int e = p.tile_e[tile];
        if (e < 0) continue;
        const float* Wd = (e < NEXP) ? p.w_down + ((size_t)layer * NEXP + e) * (256 * DM) : p.ws_down + (size_t)layer * (256 * DM);
        ALoadBF16 al;
#pragma unroll
        for (int i = 0; i < 4; ++i) { const int pp = tid + 256 * i; al.rp[i] = p.H + (size_t)(tile * 128 + (pp >> 3)) * 256 + (pp & 7) * 8; }
        BLoadF32 bl; { const int nq = tid & 31, kg = tid >> 5; bl.valid = true; bl.ldb = DM; bl.nk1 = 1 << 30; bl.bp = Wd + (size_t)(kg * 8) * DM + nt * 128 + nq * 4; }
        f32x4 acc[4][4];
        gemm_tile(lds, al, bl, 256 / 64, acc);
#pragma unroll
        for (int m = 0; m < 4; ++m)
#pragma unroll
            for (int n = 0; n < 4; ++n) {
                const int row = tile * 128 + wr * 64 + m * 16 + fr, col = nt * 128 + wc * 64 + n * 16 + fq * 4;
                const f32x4 a = acc[m][n];
                u32x2 w; w.x = pack2(a[0], a[1]); w.y = pack2(a[2], a[3]);
                *(u32x2*)(p.Y + (size_t)row * DM + col) = w;
            }
    }
}
__device__ __forceinline__ void phase_combine_ln(int bid, int nb, const P& p, const float* X, const float* g, const float* b, float* of, bf16_t* ob) {
    const int lane = threadIdx.x & 63, wid = threadIdx.x >> 6;
    for (int row = bid * 4 + wid; row < NTOK; row += nb * 4) {
        float v[16];
#pragma unroll
        for (int h = 0; h < 2; ++h) {
            const size_t o = (size_t)row * DM + h * 512 + lane * 8;
            const f32x4 r0 = *(const f32x4*)(X + o), r1 = *(const f32x4*)(X + o + 4);
#pragma unroll
            for (int i = 0; i < 4; ++i) { v[h * 8 + i] = DN_ALPHA * r0[i]; v[h * 8 + 4 + i] = DN_ALPHA * r1[i]; }
        }
#pragma unroll
        for (int k = 0; k < 9; ++k) {
            const int yr = (k < 8) ? p.epos[row * 8 + k] : (SH_TILE0 * 128 + row);
            const float w = (k < 8) ? p.ew[row * 8 + k] : 1.0f;
#pragma unroll
            for (int h = 0; h < 2; ++h) {
                const u32x4 y = *(const u32x4*)(p.Y + (size_t)yr * DM + h * 512 + lane * 8);
                v[h * 8 + 0] += w * bf2f(y.x & 0xffffu); v[h * 8 + 1] += w * bf2f(y.x >> 16);
                v[h * 8 + 2] += w * bf2f(y.y & 0xffffu); v[h * 8 + 3] += w * bf2f(y.y >> 16);
                v[h * 8 + 4] += w * bf2f(y.z & 0xffffu); v[h * 8 + 5] += w * bf2f(y.z >> 16);
                v[h * 8 + 6] += w * bf2f(y.w & 0xffffu); v[h * 8 + 7] += w * bf2f(y.w >> 16);
            }
        }
        ln_row_store(v, g, b, of, ob, row, lane);
    }
}

__device__ __forceinline__ void phase_nsa_compress(char* lds, int bid, int nb, const P& p) {
    float* blk = (float*)lds;
    float* hs = blk + 4096;
    const int tid = threadIdx.x, which = tid >> 7, j = tid & 127;
    const float* pe = which ? p.pe_v : p.pe_k; const float* w1 = which ? p.wv1 : p.wk1; const float* w2 = which ? p.wv2 : p.wk2;
    float* outp = which ? p.VC : p.KC;
    const int colbase = which ? 640 : 512;
    for (int u = bid; u < 16 * 127; u += nb) {
        const int bg = u / 127, c = u % 127, b = bg >> 1, g = bg & 1;
        __syncthreads();
        for (int i = j; i < 2048; i += 128) { const int l = i >> 6, d = i & 63; blk[which * 2048 + i] = p.U[(size_t)(b * SEQ + 16 * c + l) * ODD_IN + colbase + g * 64 + d] + pe[i]; }
        __syncthreads();
        float a = 0.f;
        for (int i = 0; i < 2048; ++i) a += blk[which * 2048 + i] * w1[i * 128 + j];
        hs[which * 128 + j] = gelu_tanh(a);
        __syncthreads();
        if (j < 64) { float o = 0.f; for (int i = 0; i < 128; ++i) o += hs[which * 128 + i] * w2[i * 64 + j]; outp[(size_t)(bg * 127 + c) * 64 + j] = o; }
    }
}
__device__ __forceinline__ void phase_moba_kmean(int bid, int nb, const P& p) {
    for (int it = bid * 256 + threadIdx.x; it < NBATCH * 8 * 8 * 64; it += nb * 256) {
        const int d = it & 63, j = (it >> 6) & 7, h = (it >> 9) & 7, b = it >> 12;
        float s = 0.f;
        for (int r = 0; r < 256; ++r) s += p.U[(size_t)(b * SEQ + j * 256 + r) * ODD_IN + 1816 + h * 64 + d];
        p.KM[it] = s * (1.0f / 256.0f);
    }
}
#define CMP_LDS ((127 * 65 + 127 * 64 + 4 * (64 + 128 + 128)) * 4)
__device__ __forceinline__ void phase_nsa_cmp(char* lds, int bid, int nb, const P& p) {
    float* kc = (float*)lds;
    float* vc = kc + 127 * 65;
    const int tid = threadIdx.x, lane = tid & 63, wid = tid >> 6;
    float* qs = vc + 127 * 64 + wid * 320;
    float* ps = qs + 64;
    float* pp = ps + 128;
    for (int u = bid; u < 16 * 32; u += nb) {
        const int bg = u >> 5, tb = u & 31, b = bg >> 1, g = bg & 1;
        __syncthreads();
        for (int i = tid; i < 127 * 64; i += 256) { const int c = i >> 6, d = i & 63; kc[c * 65 + d] = p.KC[(size_t)bg * 127 * 64 + i]; vc[i] = p.VC[(size_t)bg * 127 * 64 + i]; }
        __syncthreads();
        for (int qi = 0; qi < 16; ++qi) {
            const int t = tb * 64 + wid * 16 + qi;
            const size_t n = (size_t)b * SEQ + t;
            float psum0 = 0.f, psum1 = 0.f;
            for (int i = 0; i < 4; ++i) {
                const int hd = g * 4 + i;
                const float slope = exp2f(-((float)hd + 0.5f));
                qs[lane] = p.U[n * ODD_IN + hd * 64 + lane];
                __builtin_amdgcn_wave_barrier();
                float s0 = NEGF, s1 = NEGF;
                const int c0 = lane, c1 = lane + 64;
                const bool v0 = (16 * c0 + 31 <= t), v1 = (c1 < 127) && (16 * c1 + 31 <= t);
                if (v0) { float d = 0.f; for (int k = 0; k < 64; ++k) d += qs[k] * kc[c0 * 65 + k]; s0 = d * 0.125f - slope * (float)(t - (16 * c0 + 31)); }
                if (v1) { float d = 0.f; for (int k = 0; k < 64; ++k) d += qs[k] * kc[c1 * 65 + k]; s1 = d * 0.125f - slope * (float)(t - (16 * c1 + 31)); }
                const float m = wave_max(fmaxf(s0, s1));
                float p0 = v0 ? __expf(s0 - m) : 0.f, p1 = v1 ? __expf(s1 - m) : 0.f;
                const float den = fmaxf(wave_sum(p0 + p1), 1e-30f);
                p0 /= den; p1 /= den;
                psum0 += p0; psum1 += p1;
                ps[c0] = p0; ps[c1] = p1;
                __builtin_amdgcn_wave_barrier();
                float o = 0.f;
                for (int c = 0; c < 127; ++c) o += ps[c] * vc[c * 64 + lane];
                p.OC[n * 512 + hd * 64 + lane] = o;
                __builtin_amdgcn_wave_barrier();
            }
            pp[lane] = psum0; pp[lane + 64] = psum1;
            __builtin_amdgcn_wave_barrier();
            const int j = lane & 31, own = t >> 6;
            float imp = 0.f;
#pragma unroll
            for (int c = 4 * j - 1; c <= 4 * j + 3; ++c) if (c >= 0 && c < 127) imp += pp[c];
            const bool forced = (j == 0) || (j == own) || (j == own - 1);
            const bool valid = j <= own;
            const float val = valid ? (imp + (forced ? 1e4f : 0.f)) : NEGF;
            int rank = 0;
            for (int j2 = 0; j2 < 32; ++j2) { const float o2 = __shfl(val, j2); rank += (o2 > val || (o2 == val && j2 < j)) ? 1 : 0; }
            const unsigned long long bal = __ballot(valid && rank < 16 && lane < 32);
            if (lane == 0) p.SELM[(size_t)bg * SEQ + t] = (unsigned)bal;
            __builtin_amdgcn_wave_barrier();
        }
    }
}
struct AttnState { float m, l, o; };
__device__ __forceinline__ void attn_block(AttnState& st, const float* qs, float* ps, const float* Kb, const float* Vb, int s0, int t, float slope, bool lanevalid) {
    const int lane = threadIdx.x & 63;
    float sc = NEGF;
    if (lanevalid) {
        const float* kr = Kb + (size_t)lane * ODD_IN;
        float d = 0.f;
#pragma unroll
        for (int k = 0; k < 64; k += 4) { const f32x4 kv = *(const f32x4*)(kr + k); d += kv[0] * qs[k] + kv[1] * qs[k + 1] + kv[2] * qs[k + 2] + kv[3] * qs[k + 3]; }
        sc = d * 0.125f - slope * (float)(t - (s0 + lane));
    }
    const float mn = fmaxf(st.m, wave_max(sc));
    const float pr = lanevalid ? __expf(sc - mn) : 0.f;
    const float corr = __expf(st.m - mn);
    st.l = st.l * corr + wave_sum(pr);
    __builtin_amdgcn_wave_barrier();
    ps[lane] = pr;
    __builtin_amdgcn_wave_barrier();
    float acc = 0.f;
    for (int s = 0; s < 64; ++s) acc += ps[s] * Vb[(size_t)s * ODD_IN + lane];
    st.o = st.o * corr + acc; st.m = mn;
    __builtin_amdgcn_wave_barrier();
}
__device__ __forceinline__ void phase_nsa_attn(char* lds, int bid, int nb, const P& p) {
    const int tid = threadIdx.x, lane = tid & 63, wid = tid >> 6;
    float* qs = (float*)lds + wid * 128; float* ps = qs + 64;
    for (int it = bid * 4 + wid; it < NTOK * 8; it += nb * 4) {
        const int hd = it & 7; const int n = it >> 3; const int b = n >> 11, t = n & (SEQ - 1), g = hd >> 2;
        const float slope = exp2f(-((float)hd + 0.5f));
        __builtin_amdgcn_wave_barrier();
        qs[lane] = p.U[(size_t)n * ODD_IN + hd * 64 + lane];
        __builtin_amdgcn_wave_barrier();
        const unsigned mask = p.SELM[(size_t)(b * 2 + g) * SEQ + t];
        const int own = t >> 6;
        AttnState ss; ss.m = NEGF; ss.l = 0.f; ss.o = 0.f;
        for (int j = 0; j <= own; ++j) if ((mask >> j) & 1u) {
            const float* base = p.U + (size_t)(b * SEQ + j * 64) * ODD_IN + g * 64;
            attn_block(ss, qs, ps, base + 768, base + 896, j * 64, t, slope, (j * 64 + lane) <= t);
        }
        AttnState sw; sw.m = NEGF; sw.l = 0.f; sw.o = 0.f;
        const int jb0 = (t >= 511) ? ((t - 511) >> 6) : 0;
        for (int j = jb0; j <= own; ++j) {
            const float* base = p.U + (size_t)(b * SEQ + j * 64) * ODD_IN + g * 64;
            const int s = j * 64 + lane;
            attn_block(sw, qs, ps, base + 1024, base + 1152, j * 64, t, slope, (s <= t) && (t - s < 512));
        }
        const float os = ss.o / fmaxf(ss.l, 1e-30f), ow = sw.o / fmaxf(sw.l, 1e-30f);
        const float oc = p.OC[(size_t)n * 512 + hd * 64 + lane];
        const float* gp = p.U + (size_t)n * ODD_IN + 1280 + hd * 3;
        const float y = sigmoidf_(gp[0]) * oc + sigmoidf_(gp[1]) * os + sigmoidf_(gp[2]) * ow;
        p.MIX[(size_t)n * DM + hd * 64 + lane] = (bf16_t)f2bf(y);
    }
}
__device__ __forceinline__ void phase_moba_attn(char* lds, int bid, int nb, const P& p) {
    const int tid = threadIdx.x, lane = tid & 63, wid = tid >> 6;
    float* qs = (float*)lds + wid * 128; float* ps = qs + 64;
    for (int it = bid * 4 + wid; it < NTOK * 8; it += nb * 4) {
        const int hd = it & 7; const int n = it >> 3; const int b = n >> 11, t = n & (SEQ - 1);
        const float slope = exp2f(-((float)hd + 1.0f));
        const float qv = p.U[(size_t)n * ODD_IN + 1304 + hd * 64 + lane];
        __builtin_amdgcn_wave_barrier();
        qs[lane] = qv;
        __builtin_amdgcn_wave_barrier();
        const int ob = t >> 8;
        float gate[8];
#pragma unroll
        for (int j = 0; j < 8; ++j) gate[j] = (j < ob) ? wave_sum(qv * p.KM[((size_t)(b * 8 + hd) * 8 + j) * 64 + lane]) : NEGF;
        unsigned selm = 0;
#pragma unroll
        for (int j = 0; j < 8; ++j) {
            int rank = 0;
#pragma unroll
            for (int j2 = 0; j2 < 8; ++j2) rank += (gate[j2] > gate[j] || (gate[j2] == gate[j] && j2 < j)) ? 1 : 0;
            if (j < ob && rank < 3) selm |= 1u << j;
        }
        AttnState st; st.m = NEGF; st.l = 0.f; st.o = 0.f;
        for (int j = 0; j < ob; ++j) if ((selm >> j) & 1u) {
            for (int sb = 0; sb < 4; ++sb) {
                const float* base = p.U + (size_t)(b * SEQ + j * 256 + sb * 64) * ODD_IN + hd * 64;
                attn_block(st, qs, ps, base + 1816, base + 2328, j * 256 + sb * 64, t, slope, true);
            }
        }
        for (int sb = 0; sb <= ((t & 255) >> 6); ++sb) {
            const float* base = p.U + (size_t)(b * SEQ + ob * 256 + sb * 64) * ODD_IN + hd * 64;
            attn_block(st, qs, ps, base + 1816, base + 2328, ob * 256 + sb * 64, t, slope, (ob * 256 + sb * 64 + lane) <= t);
        }
        p.MIX[(size_t)n * DM + 512 + hd * 64 + lane] = (bf16_t)f2bf(st.o / fmaxf(st.l, 1e-30f));
    }
}

extern __shared__ __attribute__((aligned(16))) char dyn_lds[];
#define KDEF(name, ...) __global__ void __launch_bounds__(256, 2) name(P p, int layer) { char* lds = dyn_lds; const int bid = blockIdx.x, nb = gridDim.x; (void)lds; (void)layer; __VA_ARGS__ }

KDEF(k_inproj0, phase_gemm_dense<true, false>(lds, bid, nb, p.x, DM, p.even_w_in, EVEN_IN, NTOK, EVEN_IN, DM, p.U, EVEN_IN);)
KDEF(k_lru_gates, phase_lru_gates(lds, bid, nb, p);)
KDEF(k_lru_scan, phase_lru_scan(bid, nb, p);)
KDEF(k_outproj, phase_gemm_dense<false, false>(lds, bid, nb, p.MIX, DM, layer ? p.odd_w_out : p.even_w_out, DM, NTOK, DM, DM, p.T0, DM);)
KDEF(k_ln_mix, { const float* res = layer ? p.XB : p.x; phase_ln_add(bid, nb, res, p.T0, p.ln_g + (layer * 2) * DM, p.ln_b + (layer * 2) * DM, p.XA, p.XAb); })
KDEF(k_router, { if (bid == 0) p.cnt[threadIdx.x] = 0; phase_gemm_dense<true, true>(lds, bid, nb, p.XA, DM, p.w_router + (size_t)layer * DM * NEXP, NEXP, NTOK, NEXP, DM, p.LOG, NEXP); })
KDEF(k_route, phase_route(bid, nb, p, layer);)
KDEF(k_scatter, phase_scatter(lds, bid, nb, p);)
KDEF(k_moe1, phase_moe1(lds, bid, nb, p, layer, p.XAb);)
KDEF(k_moe2, phase_moe2(lds, bid, nb, p, layer);)
KDEF(k_combine, { float* of = layer ? p.out : p.XB; bf16_t* ob = layer ? nullptr : p.XBb; phase_combine_ln(bid, nb, p, p.XA, p.ln_g + (layer * 2 + 1) * DM, p.ln_b + (layer * 2 + 1) * DM, of, ob); })
KDEF(k_inproj1, phase_gemm_dense<true, false>(lds, bid, nb, p.XB, DM, p.odd_w_in, ODD_IN, NTOK, ODD_IN, DM, p.U, ODD_IN);)
KDEF(k_nsa_compress, phase_nsa_compress(lds, bid, nb, p);)
KDEF(k_moba_kmean, phase_moba_kmean(bid, nb, p);)
KDEF(k_nsa_cmp, phase_nsa_cmp(lds, bid, nb, p);)
KDEF(k_nsa_attn, phase_nsa_attn(lds, bid, nb, p);)
KDEF(k_moba_attn, phase_moba_attn(lds, bid, nb, p);)
__global__ void __launch_bounds__(256, 1) k_hgrn(P p, int layer) { phase_hgrn_seq(dyn_lds, blockIdx.x, gridDim.x, p); }

static inline size_t al256(size_t x) { return (x + 255) & ~(size_t)255; }

extern "C" void kernel_launch(void* const* d_in, const int* in_sizes, int n_in, void* d_out, int out_size, void* d_ws, size_t ws_size, hipStream_t stream) {
    P p{};
    const float** ip = (const float**)&p.x;
    for (int i = 0; i < 30; ++i) ip[i] = (const float*)d_in[i];
    p.out = (float*)d_out;
    char* w = (char*)d_ws; size_t o = 0;
    auto take = [&](size_t bytes) { char* r = w + o; o = al256(o + bytes); return r; };
    p.U = (float*)take((size_t)NTOK * EVEN_IN * 4);
    p.MIX = (bf16_t*)take((size_t)NTOK * DM * 2);
    p.T0 = (float*)take((size_t)NTOK * DM * 4);
    p.XA = (float*)take((size_t)NTOK * DM * 4); p.XAb = (bf16_t*)take((size_t)NTOK * DM * 2);
    p.XB = (float*)take((size_t)NTOK * DM * 4); p.XBb = (bf16_t*)take((size_t)NTOK * DM * 2);
    p.LOG = (float*)take((size_t)NTOK * NEXP * 4);
    p.eidx = (int*)take(NTOK * 8 * 4); p.ew = (float*)take(NTOK * 8 * 4); p.erank = (int*)take(NTOK * 8 * 4); p.epos = (int*)take(NTOK * 8 * 4);
    p.cnt = (int*)take(NEXP * 4); p.tile_e = (int*)take(NTILES * 4); p.rowtok = (int*)take(NROWS * 4);
    p.H = (bf16_t*)take((size_t)NROWS * 256 * 2);
    p.Y = (bf16_t*)take((size_t)NROWS * DM * 2);
    p.LA = (float*)take((size_t)NTOK * 512 * 4); p.LB = (float*)take((size_t)NTOK * 512 * 4);
    p.KC = (float*)take(16 * 127 * 64 * 4); p.VC = (float*)take(16 * 127 * 64 * 4);
    p.OC = (float*)take((size_t)NTOK * 512 * 4);
    p.SELM = (unsigned*)take(16 * SEQ * 4);
    p.KM = (float*)take(8 * 8 * 8 * 64 * 4);
    if (o > ws_size) return;

    static bool attr = false;
    if (!attr) { (void)hipFuncSetAttribute((const void*)k_nsa_cmp, hipFuncAttributeMaxDynamicSharedMemorySize, CMP_LDS); attr = true; }
    const int G = 1024;
#define L(k, lds, layer) k<<<G, 256, lds, stream>>>(p, layer)
    L(k_inproj0, GEMM_LDS, 0);
    L(k_lru_gates, 2048, 0);
    L(k_lru_scan, 0, 0);
    k_hgrn<<<16, 256, 4096, stream>>>(p, 0);
    L(k_outproj, GEMM_LDS, 0);
    L(k_ln_mix, 0, 0);
    L(k_router, GEMM_LDS, 0); L(k_route, 0, 0); L(k_scatter, 2048, 0); L(k_moe1, GEMM_LDS, 0); L(k_moe2, GEMM_LDS, 0); L(k_combine, 0, 0);
    L(k_inproj1, GEMM_LDS, 1);
    L(k_nsa_compress, 17408, 1);
    L(k_moba_kmean, 0, 1);
    L(k_nsa_cmp, CMP_LDS, 1);
    L(k_nsa_attn, 2048, 1);
    L(k_moba_attn, 2048, 1);
    L(k_outproj, GEMM_LDS, 1);
    L(k_ln_mix, 0, 1);
    L(k_router, GEMM_LDS, 1); L(k_route, 0, 1); L(k_scatter, 2048, 1); L(k_moe1, GEMM_LDS, 1); L(k_moe2, GEMM_LDS, 1); L(k_combine, 0, 1);
}
```

```cpp
#include <hip/hip_runtime.h>
#include <hip/hip_bf16.h>
#include <stdint.h>

#define NTOK 16384
#define DM 1024
#define SEQ 2048
#define NBATCH 8
#define EVEN_IN 3072
#define ODD_IN 2840
#define NEXP 256
#define NEGF (-1e30f)
#define DN_ALPHA 1.4142135623730951f
#define LN_EPS 1e-5f
#define MAXRT 1280
#define SH_TILE0 1280
#define NTILES (1280 + 128)
#define NROWS (NTILES * 128)

typedef unsigned short bf16_t;
typedef short bf16x8 __attribute__((ext_vector_type(8)));
typedef float f32x4 __attribute__((ext_vector_type(4)));
typedef unsigned u32x4 __attribute__((ext_vector_type(4)));
typedef unsigned u32x2 __attribute__((ext_vector_type(2)));

__device__ __forceinline__ float wave_sum(float v) {
#pragma unroll
    for (int o = 32; o >= 1; o >>= 1) v += __shfl_xor(v, o);
    return v;
}
__device__ __forceinline__ float wave_max(float v) {
#pragma unroll
    for (int o = 32; o >= 1; o >>= 1) v = fmaxf(v, __shfl_xor(v, o));
    return v;
}
__device__ __forceinline__ unsigned f2bf(float f) {
    unsigned u = __float_as_uint(f);
    u += 0x7FFFu + ((u >> 16) & 1u);
    return u >> 16;
}
__device__ __forceinline__ float bf2f(unsigned b) { return __uint_as_float(b << 16); }
__device__ __forceinline__ unsigned pack2(float lo, float hi) { return f2bf(lo) | (f2bf(hi) << 16); }
__device__ __forceinline__ float sigmoidf_(float x) { return 1.0f / (1.0f + __expf(-x)); }
__device__ __forceinline__ float siluf_(float x) { return x / (1.0f + __expf(-x)); }
__device__ __forceinline__ float gelu_tanh(float x) {
    const float u = 0.7978845608028654f * (x + 0.044715f * x * x * x);
    return 0.5f * x * (1.0f + tanhf(u));
}


#define XB_TMO      128
#define XB_XCNT(j)  (256  + 64 * (j))
#define XB_XSUB(j)  (1280 + 64 * (j))
#define XB_XGEN(j)  (2304 + 64 * (j))
#define XB_TOP      3328
#define XB_TOPGEN   3392
#define XCD_BAR_WORDS 3456
#define XB_SPIN_CAP (1u << 18)
#define LAS __attribute__((address_space(3)))
__device__ __forceinline__ unsigned xb_ld(unsigned* p)              { return __hip_atomic_load(p, __ATOMIC_RELAXED, __HIP_MEMORY_SCOPE_AGENT); }
__device__ __forceinline__ unsigned xb_add(unsigned* p, unsigned v) { return __hip_atomic_fetch_add(p, v, __ATOMIC_RELAXED, __HIP_MEMORY_SCOPE_AGENT); }
__device__ __forceinline__ unsigned xb_xcc_id() { return (unsigned)__builtin_amdgcn_s_getreg((3 << 11) | 20) & 0xFu; }
#define XB_SPIN(cond, bar) do { unsigned _sp = 0; while (cond) { __builtin_amdgcn_s_sleep(1); \
    if ((++_sp & 255u) == 0u) { if (xb_ld(&(bar)[XB_TMO])) break; if (_sp > XB_SPIN_CAP) { atomicAdd(&(bar)[XB_TMO], 1u); break; } } } } while (0)
struct XcdBarrier { unsigned* bar; unsigned x; volatile LAS unsigned* st; };
__device__ __forceinline__ XcdBarrier xcd_barrier_post(unsigned* bar, volatile LAS unsigned* st) {
    XcdBarrier b; b.bar = bar; b.x = xb_xcc_id(); b.st = st;
    if (threadIdx.x == 0) (void)xb_add(&bar[XB_XCNT(b.x)], 1u);
    return b;
}
__device__ __forceinline__ void xcd_barrier_complete(unsigned* bar, unsigned x, unsigned& nloc, unsigned& nx) {
    const unsigned G = gridDim.x * gridDim.y * gridDim.z;
    unsigned sum, cnt, mine, sp = 0u;
    for (;;) {
        sum = 0u; cnt = 0u; mine = 0u;
#pragma unroll
        for (unsigned j = 0; j < 16; ++j) { const unsigned c = xb_ld(&bar[XB_XCNT(j)]); sum += c; cnt += (c > 0u) ? 1u : 0u; mine = (j == x) ? c : mine; }
        if (sum == G) break;
        __builtin_amdgcn_s_sleep(1);
        if ((++sp & 255u) == 0u) { if (xb_ld(&bar[XB_TMO])) break; if (sp > XB_SPIN_CAP) { atomicAdd(&bar[XB_TMO], 1u); break; } }
    }
    nloc = mine > 0u ? mine : 1u; nx = cnt > 0u ? cnt : 1u;
}
__device__ __forceinline__ void xcd_barrier(const XcdBarrier& b) {
    asm volatile("s_waitcnt vmcnt(0)" ::: "memory");
    __syncthreads();
    if (threadIdx.x == 0) {
        unsigned* bar = b.bar;
        __builtin_amdgcn_s_waitcnt(0);
        unsigned nloc = b.st[0], nx = b.st[1];
        if (nloc == 0u) { xcd_barrier_complete(bar, b.x, nloc, nx); b.st[0] = nloc; b.st[1] = nx; }
        const unsigned old = xb_add(&bar[XB_XSUB(b.x)], 1u);
        const unsigned gen = old / nloc;
        if (old + 1u == (gen + 1u) * nloc) {
            __builtin_amdgcn_fence(__ATOMIC_RELEASE, "agent");
            asm volatile("s_waitcnt vmcnt(0)" ::: "memory");
            const unsigned og = xb_add(&bar[XB_TOP], 1u);
            const unsigned tg = og / nx;
            if (og + 1u == (tg + 1u) * nx) xb_add(&bar[XB_TOPGEN], 1u);
            else XB_SPIN(xb_ld(&bar[XB_TOPGEN]) == tg, bar);
            __builtin_amdgcn_fence(__ATOMIC_ACQUIRE, "agent");
            xb_add(&bar[XB_XGEN(b.x)], 1u);
            asm volatile("s_waitcnt vmcnt(0)" ::: "memory");
        } else {
            XB_SPIN(xb_ld(&bar[XB_XGEN(b.x)]) == gen, bar);
            __builtin_amdgcn_fence(__ATOMIC_ACQUIRE, "agent");
            asm volatile("s_waitcnt vmcnt(0)" ::: "memory");
        }
    }
    __syncthreads();
}

struct P {
    const float *x, *even_w_in, *conv_w, *conv_b, *wa, *ba, *wx, *bx, *lam, *hg_lb, *hg_ng, *even_w_out;
    const float *odd_w_in, *pe_k, *pe_v, *wk1, *wk2, *wv1, *wv2, *odd_w_out, *ln_g, *ln_b, *w_router, *b_router;
    const float *w_gate, *w_up, *w_down, *ws_gate, *ws_up, *ws_down;
    float* out;
    float* U;
    bf16_t* MIX;
    float* T0;
    float* XA; bf16_t* XAb; float* XB; bf16_t* XBb;
    float* LOG;
    int* eidx; float* ew; int* erank; int* epos;
    int* cnt;
    int* tile_e;
    int* rowtok;
    bf16_t* H;
    bf16_t* Y;
    float* LA; float* LB;
    float* KC; float* VC;
    float* OC;
    unsigned* SELM;
    float* KM;
    unsigned* bar;
};

__device__ __forceinline__ int lds_off(int r, int c) {
    const int st = (r >> 4) * 2 + (c >> 5), ob = (r & 15) * 64 + (c & 31) * 2;
    return st * 1024 + (ob ^ (((ob >> 9) & 1) << 5));
}
#define GEMM_LDS 32768

__device__ __forceinline__ float cvt_part(float v, int lo) { return lo ? (v - bf2f(f2bf(v))) : v; }

struct ALoadF32 {
    const float* rp[4];
    int nk1;
    struct Regs { f32x4 v[8]; };
    __device__ __forceinline__ void load(int kt, Regs& R) const {
        const int k = (kt % nk1) * 64;
#pragma unroll
        for (int i = 0; i < 4; ++i) { R.v[2 * i] = *(const f32x4*)(rp[i] + k); R.v[2 * i + 1] = *(const f32x4*)(rp[i] + k + 4); }
    }
    __device__ __forceinline__ void store(int kt, const Regs& R, char* lds) const {
        const int lo = (kt / nk1) == 2;
#pragma unroll
        for (int i = 0; i < 4; ++i) {
            const int p = threadIdx.x + 256 * i, row = p >> 3, ch = p & 7;
            const f32x4 a = R.v[2 * i], b = R.v[2 * i + 1];
            u32x4 w;
            w.x = pack2(cvt_part(a[0], lo), cvt_part(a[1], lo)); w.y = pack2(cvt_part(a[2], lo), cvt_part(a[3], lo));
            w.z = pack2(cvt_part(b[0], lo), cvt_part(b[1], lo)); w.w = pack2(cvt_part(b[2], lo), cvt_part(b[3], lo));
            *(u32x4*)(lds + lds_off(row, ch * 8)) = w;
        }
    }
};
struct ALoadBF16 {
    const bf16_t* rp[4];
    struct Regs { u32x4 v[4]; };
    __device__ __forceinline__ void load(int kt, Regs& R) const {
#pragma unroll
        for (int i = 0; i < 4; ++i) R.v[i] = *(const u32x4*)(rp[i] + kt * 64);
    }
    __device__ __forceinline__ void store(int kt, const Regs& R, char* lds) const {
#pragma unroll
        for (int i = 0; i < 4; ++i) { const int p = threadIdx.x + 256 * i; *(u32x4*)(lds + lds_off(p >> 3, (p & 7) * 8)) = R.v[i]; }
    }
};
struct BLoadF32 {
    const float* bp; int ldb; bool valid; int nk1;
    struct Regs { f32x4 v[8]; };
    __device__ __forceinline__ void load(int kt, Regs& R) const {
        const float* p = bp + (size_t)((kt % nk1) * 64) * ldb;
#pragma unroll
        for (int j = 0; j < 8; ++j) R.v[j] = valid ? *(const f32x4*)(p + (size_t)j * ldb) : (f32x4){0.f, 0.f, 0.f, 0.f};
    }
    __device__ __forceinline__ void store(int kt, const Regs& R, char* lds) const {
        const int lo = (kt / nk1) == 1;
        const int nq = threadIdx.x & 31, kg = threadIdx.x >> 5;
#pragma unroll
        for (int i = 0; i < 4; ++i) {
            u32x4 w;
            w.x = pack2(cvt_part(R.v[0][i], lo), cvt_part(R.v[1][i], lo)); w.y = pack2(cvt_part(R.v[2][i], lo), cvt_part(R.v[3][i], lo));
            w.z = pack2(cvt_part(R.v[4][i], lo), cvt_part(R.v[5][i], lo)); w.w = pack2(cvt_part(R.v[6][i], lo), cvt_part(R.v[7][i], lo));
            *(u32x4*)(lds + lds_off(nq * 4 + i, kg * 8)) = w;
        }
    }
};

template <class AL, class BL>
__device__ __forceinline__ void gemm_tile(char* lds, const AL& al, const BL& bl, int nk, f32x4 (&acc)[4][4]) {
    const int lane = threadIdx.x & 63, wid = threadIdx.x >> 6, wr = wid >> 1, wc = wid & 1, fr = lane & 15, fq = lane >> 4;
    char* ldsA = lds; char* ldsB = lds + 16384;
#pragma unroll
    for (int m = 0; m < 4; ++m)
#pragma unroll
        for (int n = 0; n < 4; ++n) acc[m][n] = (f32x4){0.f, 0.f, 0.f, 0.f};
    typename AL::Regs ra; typename BL::Regs rb;
    al.load(0, ra); bl.load(0, rb);
    for (int kt = 0; kt < nk; ++kt) {
        __syncthreads();
        al.store(kt, ra, ldsA); bl.store(kt, rb, ldsB);
        __syncthreads();
        if (kt + 1 < nk) { al.load(kt + 1, ra); bl.load(kt + 1, rb); }
#pragma unroll
        for (int kk = 0; kk < 2; ++kk) {
            bf16x8 a[4], b[4];
#pragma unroll
            for (int m = 0; m < 4; ++m) a[m] = *(const bf16x8*)(ldsA + lds_off(wr * 64 + m * 16 + fr, kk * 32 + fq * 8));
#pragma unroll
            for (int n = 0; n < 4; ++n) b[n] = *(const bf16x8*)(ldsB + lds_off(wc * 64 + n * 16 + fr, kk * 32 + fq * 8));
#pragma unroll
            for (int m = 0; m < 4; ++m)
#pragma unroll
                for (int n = 0; n < 4; ++n) acc[m][n] = __builtin_amdgcn_mfma_f32_16x16x32_bf16(b[n], a[m], acc[m][n], 0, 0, 0);
        }
    }
}

template <bool AF32, bool SPLIT>
__device__ __forceinline__ void phase_gemm_dense(char* lds, int bid, int nb, const void* A, int lda, const float* W, int ldw, int M, int N, int K, float* C, int ldc) {
    const int ntn = (N + 127) / 128, ntm = M / 128, nk1 = K / 64;
    const int tid = threadIdx.x, lane = tid & 63, wid = tid >> 6, wr = wid >> 1, wc = wid & 1, fr = lane & 15, fq = lane >> 4;
    for (int u = bid; u < ntm * ntn; u += nb) {
        const int tm = u / ntn, tn = u % ntn;
        BLoadF32 bl; { const int nq = tid & 31, kg = tid >> 5; const int col = tn * 128 + nq * 4; bl.valid = col < N; bl.ldb = ldw; bl.nk1 = SPLIT ? nk1 : (1 << 30);
            bl.bp = W + (size_t)(kg * 8) * ldw + (bl.valid ? col : 0); }
        f32x4 acc[4][4];
        if (AF32) {
            ALoadF32 al; al.nk1 = SPLIT ? nk1 : (1 << 30);
#pragma unroll
            for (int i = 0; i < 4; ++i) { const int p = tid + 256 * i; al.rp[i] = (const float*)A + (size_t)(tm * 128 + (p >> 3)) * lda + (p & 7) * 8; }
            gemm_tile(lds, al, bl, SPLIT ? 3 * nk1 : nk1, acc);
        } else {
            ALoadBF16 al;
#pragma unroll
            for (int i = 0; i < 4; ++i) { const int p = tid + 256 * i; al.rp[i] = (const bf16_t*)A + (size_t)(tm * 128 + (p >> 3)) * lda + (p & 7) * 8; }
            gemm_tile(lds, al, bl, nk1, acc);
        }
#pragma unroll
        for (int m = 0; m < 4; ++m)
#pragma unroll
            for (int n = 0; n < 4; ++n) {
                const int row = tm * 128 + wr * 64 + m * 16 + fr, col = tn * 128 + wc * 64 + n * 16 + fq * 4;
                if (col < N) *(f32x4*)(C + (size_t)row * ldc + col) = acc[m][n];
            }
    }
}

__device__ __forceinline__ void ln_row_store(float (&v)[16], const float* g, const float* b, float* of, bf16_t* ob, int row, int lane) {
    float s = 0.f;
#pragma unroll
    for (int i = 0; i < 16; ++i) s += v[i];
    const float mu = wave_sum(s) * (1.0f / DM);
    float q = 0.f;
#pragma unroll
    for (int i = 0; i < 16; ++i) { const float d = v[i] - mu; q += d * d; }
    const float rstd = rsqrtf(wave_sum(q) * (1.0f / DM) + LN_EPS);
#pragma unroll
    for (int h = 0; h < 2; ++h) {
        const int c0 = h * 512 + lane * 8;
        float o[8];
#pragma unroll
        for (int i = 0; i < 8; ++i) o[i] = (v[h * 8 + i] - mu) * rstd * g[c0 + i] + b[c0 + i];
        *(f32x4*)(of + (size_t)row * DM + c0) = (f32x4){o[0], o[1], o[2], o[3]};
        *(f32x4*)(of + (size_t)row * DM + c0 + 4) = (f32x4){o[4], o[5], o[6], o[7]};
        if (ob) { u32x4 w; w.x = pack2(o[0], o[1]); w.y = pack2(o[2], o[3]); w.z = pack2(o[4], o[5]); w.w = pack2(o[6], o[7]); *(u32x4*)(ob + (size_t)row * DM + c0) = w; }
    }
}
__device__ __forceinline__ void phase_ln_add(int bid, int nb, const float* res, const float* add, const float* g, const float* b, float* of, bf16_t* ob) {
    const int lane = threadIdx.x & 63, wid = threadIdx.x >> 6;
    for (int row = bid * 4 + wid; row < NTOK; row += nb * 4) {
        float v[16];
#pragma unroll
        for (int h = 0; h < 2; ++h) {
            const size_t o = (size_t)row * DM + h * 512 + lane * 8;
            const f32x4 r0 = *(const f32x4*)(res + o), r1 = *(const f32x4*)(res + o + 4), a0 = *(const f32x4*)(add + o), a1 = *(const f32x4*)(add + o + 4);
#pragma unroll
            for (int i = 0; i < 4; ++i) { v[h * 8 + i] = DN_ALPHA * r0[i] + a0[i]; v[h * 8 + 4 + i] = DN_ALPHA * r1[i] + a1[i]; }
        }
        ln_row_store(v, g, b, of, ob, row, lane);
    }
}

__device__ __forceinline__ void phase_lru_gates(char* lds, int bid, int nb, const P& p) {
    float* xs = (float*)lds;
    const int tid = threadIdx.x;
    for (int tok = bid; tok < NTOK; tok += nb) {
        const int t = tok & (SEQ - 1);
        __syncthreads();
#pragma unroll
        for (int cc = 0; cc < 2; ++cc) {
            const int c = tid + 256 * cc;
            float xc = p.conv_b[c];
#pragma unroll
            for (int w = 0; w < 4; ++w) { const int tt = t - 3 + w; if (tt >= 0) xc += p.conv_w[w * 512 + c] * p.U[(size_t)(tok - 3 + w) * EVEN_IN + c]; }
            xs[c] = xc;
        }
        __syncthreads();
#pragma unroll
        for (int cc = 0; cc < 2; ++cc) {
            const int c = tid + 256 * cc, h = c >> 6, j = c & 63;
            float ra = p.ba[c], ri = p.bx[c];
#pragma unroll 8
            for (int i = 0; i < 64; ++i) { const float xv = xs[h * 64 + i]; ra += xv * p.wa[(h * 64 + i) * 64 + j]; ri += xv * p.wx[(h * 64 + i) * 64 + j]; }
            const float r = sigmoidf_(ra), ig = sigmoidf_(ri);
            const float nl = -p.lam[c];
            const float sp = fmaxf(nl, 0.f) + log1pf(expf(-fabsf(nl)));
            const float log_a = -8.0f * r * sp;
            const float a = expf(log_a);
            const float mult = (t == 0) ? 1.0f : sqrtf(-expm1f(2.0f * log_a));
            p.LA[(size_t)tok * 512 + c] = a;
            p.LB[(size_t)tok * 512 + c] = mult * ig * xs[c];
        }
    }
}
__device__ __forceinline__ void phase_lru_scan(int bid, int nb, const P& p) {
    for (int it = bid * 256 + threadIdx.x; it < NBATCH * 512; it += nb * 256) {
        const int b = it >> 9, c = it & 511;
        float h = 0.f;
        for (int t = 0; t < SEQ; ++t) {
            const size_t n = (size_t)b * SEQ + t;
            h = p.LA[n * 512 + c] * h + p.LB[n * 512 + c];
            const float gb = p.U[n * EVEN_IN + 512 + c];
            p.MIX[n * DM + c] = (bf16_t)f2bf(h * gelu_tanh(gb));
        }
    }
}
__device__ __forceinline__ void phase_hgrn_seq(char* lds, int bid, int nb, const P& p) {
    const int tid = threadIdx.x, half = tid >> 7, v = tid & 127;
    float* sq = (float*)lds + half * 512;
    float* sf = sq + 128;
    float* red = sq + 256;
    for (int u0 = bid * 2; u0 < NBATCH * 4; u0 += nb * 2) {
        const int u = u0 + half;
        const int b = u >> 2, h = u & 3;
        const int ch = h * 128 + v;
        float lbv; { const float l0 = p.hg_lb[ch], l1 = p.hg_lb[512 + ch], l2 = p.hg_lb[1024 + ch]; const float mx = fmaxf(l0, fmaxf(l1, l2));
            const float e0 = expf(l0 - mx), e1 = expf(l1 - mx), e2 = expf(l2 - mx); lbv = e0 / (e0 + e1 + e2); }
        const float ng = p.hg_ng[ch];
        float S[128];
#pragma unroll
        for (int k = 0; k < 128; ++k) S[k] = 0.f;
        for (int t = 0; t < SEQ; ++t) {
            const size_t n = (size_t)b * SEQ + t;
            const float* ur = p.U + n * EVEN_IN;
            const float qv = siluf_(ur[1024 + ch]);
            const float f = lbv + (1.0f - lbv) * sigmoidf_(ur[1536 + ch]);
            __syncthreads();
            sq[v] = qv; sf[v] = f;
            __syncthreads();
            const float vv = ur[2048 + ch];
            float o = 0.f;
#pragma unroll
            for (int k = 0; k < 128; ++k) { const float fk = sf[k]; S[k] = fk * S[k] + (1.0f - fk) * vv; o += sq[k] * S[k]; }
            const float ss = wave_sum(o * o);
            if ((tid & 63) == 0) red[(tid >> 6) & 1] = ss;
            __syncthreads();
            const float tot = red[0] + red[1];
            const float y = o * rsqrtf(tot * (1.0f / 128.0f) + 1e-6f) * ng * sigmoidf_(ur[2560 + ch]);
            p.MIX[n * DM + 512 + ch] = (bf16_t)f2bf(y);
        }
        __syncthreads();
    }
}

__device__ __forceinline__ void phase_route(int bid, int nb, const P& p, int layer) {
    const float* br = p.b_router + layer * NEXP;
    const int gt = bid * 256 + threadIdx.x, gs = nb * 256;
    for (int i = gt; i < NROWS; i += gs) p.rowtok[i] = (i >= SH_TILE0 * 128) ? (i - SH_TILE0 * 128) : 0;
    for (int t = gt; t < NTOK; t += gs) {
        const float* lg = p.LOG + (size_t)t * NEXP;
        float gsc[8];
#pragma unroll
        for (int g = 0; g < 8; ++g) {
            float t1 = -3e38f, t2 = -3e38f;
            for (int j = 0; j < 32; ++j) { const float s = sigmoidf_(lg[g * 32 + j]) + br[g * 32 + j]; if (s > t1) { t2 = t1; t1 = s; } else if (s > t2) t2 = s; }
            gsc[g] = t1 + t2;
        }
        unsigned allowed = 0;
#pragma unroll
        for (int g = 0; g < 8; ++g) {
            int rank = 0;
#pragma unroll
            for (int g2 = 0; g2 < 8; ++g2) rank += (gsc[g2] > gsc[g] || (gsc[g2] == gsc[g] && g2 < g)) ? 1 : 0;
            if (rank < 4) allowed |= 1u << g;
        }
        float pv = 3e38f; int pe = -1; float wsum = 0.f; float wk[8]; int ek[8];
#pragma unroll
        for (int k = 0; k < 8; ++k) {
            float bv = -3e38f; int be = 0; float bs = 0.f;
            for (int e = 0; e < NEXP; ++e) {
                if (!((allowed >> (e >> 5)) & 1u)) continue;
                const float sc = sigmoidf_(lg[e]); const float s = sc + br[e];
                const bool after = (s < pv) || (s == pv && e > pe);
                if (after && s > bv) { bv = s; be = e; bs = sc; }
            }
            pv = bv; pe = be; wk[k] = bs; ek[k] = be; wsum += bs;
        }
#pragma unroll
        for (int k = 0; k < 8; ++k) {
            p.eidx[t * 8 + k] = ek[k];
            p.ew[t * 8 + k] = wk[k] / wsum * 2.5f;
            p.erank[t * 8 + k] = atomicAdd(&p.cnt[ek[k]], 1);
        }
    }
}
__device__ __forceinline__ void phase_scatter(char* lds, int bid, int nb, const P& p) {
    int* base = (int*)lds;
    const int tid = threadIdx.x;
    __syncthreads();
    { int s = 0; for (int e = 0; e < tid; ++e) s += (p.cnt[e] + 127) & ~127; base[tid] = s; if (tid == 255) base[256] = s + ((p.cnt[255] + 127) & ~127); }
    __syncthreads();
    for (int a = bid * 256 + tid; a < NTOK * 8; a += nb * 256) {
        const int e = p.eidx[a]; const int row = base[e] + p.erank[a];
        p.rowtok[row] = a >> 3; p.epos[a] = row;
    }
    if (bid == 0) {
        const int nrt = base[256] >> 7;
        for (int i = tid; i < NTILES; i += 256) if (i >= nrt) p.tile_e[i] = (i >= SH_TILE0) ? NEXP : -1;
        const int t0 = base[tid] >> 7, t1 = base[tid + 1] >> 7;
        for (int i = t0; i < t1; ++i) p.tile_e[i] = tid;
    }
    __syncthreads();
}
__device__ __forceinline__ void phase_moe1(char* lds, int bid, int nb, const P& p, int layer, const bf16_t* Xb) {
    const int tid = threadIdx.x, lane = tid & 63, wid = tid >> 6, wr = wid >> 1, wc = wid & 1, fr = lane & 15, fq = lane >> 4;
    for (int u = bid; u < NTILES * 4; u += nb) {
        const int tile = u >> 2, nt = u & 3;
        const int e = p.tile_e[tile];
        if (e < 0) continue;
        const float* Wg = (e < NEXP) ? p.w_gate + ((size_t)layer * NEXP + e) * (DM * 256) : p.ws_gate + (size_t)layer * (DM * 256);
        const float* Wu = (e < NEXP) ? p.w_up + ((size_t)layer * NEXP + e) * (DM * 256) : p.ws_up + (size_t)layer * (DM * 256);
        ALoadBF16 al;
#pragma unroll
        for (int i = 0; i < 4; ++i) { const int pp = tid + 256 * i; const int tok = p.rowtok[tile * 128 + (pp >> 3)]; al.rp[i] = Xb + (size_t)tok * DM + (pp & 7) * 8; }
        BLoadF32 bl; { const int nq = tid & 31, kg = tid >> 5; const int j = nq * 4, jw = j & 63, w2 = j >> 6; const int col = nt * 64 + w2 * 32 + (jw & 31);
            bl.valid = true; bl.ldb = 256; bl.nk1 = 1 << 30; bl.bp = ((jw >= 32) ? Wu : Wg) + (size_t)(kg * 8) * 256 + col; }
        f32x4 acc[4][4];
        gemm_tile(lds, al, bl, DM / 64, acc);
#pragma unroll
        for (int m = 0; m < 4; ++m)
#pragma unroll
            for (int n = 0; n < 2; ++n) {
                const int row = tile * 128 + wr * 64 + m * 16 + fr, col = nt * 64 + wc * 32 + n * 16 + fq * 4;
                const f32x4 g = acc[m][n], uu = acc[m][n + 2];
                u32x2 w; w.x = pack2(siluf_(g[0]) * uu[0], siluf_(g[1]) * uu[1]); w.y = pack2(siluf_(g[2]) * uu[2], siluf_(g[3]) * uu[3]);
                *(u32x2*)(p.H + (size_t)row * 256 + col) = w;
            }
    }
}
__device__ __forceinline__ void phase_moe2(char* lds, int bid, int nb, const P& p, int layer) {
    const int tid = threadIdx.x, lane = tid & 63, wid = tid >> 6, wr = wid >> 1, wc = wid & 1, fr = lane & 15, fq = lane >> 4;
    for (int u = bid; u < NTILES * 8; u += nb) {
        const int tile = u >> 3, nt = u & 7;
        const int e = p.tile_e[tile];
        if (e < 0) continue;
        const float* Wd = (e < NEXP) ? p.w_down + ((size_t)layer * NEXP + e) * (256 * DM) : p.ws_down + (size_t)layer * (256 * DM);
        ALoadBF16 al;
#pragma unroll
        for (int i = 0; i < 4; ++i) { const int pp = tid + 256 * i; al.rp[i] = p.H + (size_t)(tile * 128 + (pp >> 3)) * 256 + (pp & 7) * 8; }
        BLoadF32 bl; { const int nq = tid & 31, kg = tid >> 5; bl.valid = true; bl.ldb = DM; bl.nk1 = 1 << 30; bl.bp = Wd + (size_t)(kg * 8) * DM + nt * 128 + nq * 4; }
        f32x4 acc[4][4];
        gemm_tile(lds, al, bl, 256 / 64, acc);
#pragma unroll
        for (int m = 0; m < 4; ++m)
#pragma unroll
            for (int n = 0; n < 4; ++n) {
                const int row = tile * 128 + wr * 64 + m * 16 + fr, col = nt * 128 + wc * 64 + n * 16 + fq * 4;
                const f32x4 a = acc[m][n];
                u32x2 w; w.x = pack2(a[0], a[1]); w.y = pack2(a[2], a[3]);
                *(u32x2*)(p.Y + (size_t)row * DM + col) = w;
            }
    }
}
__device__ __forceinline__ void phase_combine_ln(int bid, int nb, const P& p, const float* X, const float* g, const float* b, float* of, bf16_t* ob) {
    const int lane = threadIdx.x & 63, wid = threadIdx.x >> 6;
    for (int row = bid * 4 + wid; row < NTOK; row += nb * 4) {
        float v[16];
#pragma unroll
        for (int h = 0; h < 2; ++h) {
            const size_t o = (size_t)row * DM + h * 512 + lane * 8;
            const f32x4 r0 = *(const f32x4*)(X + o), r1 = *(const f32x4*)(X + o + 4);
#pragma unroll
            for (int i = 0; i < 4; ++i) { v[h * 8 + i] = DN_ALPHA * r0[i]; v[h * 8 + 4 + i] = DN_ALPHA * r1[i]; }
        }
#pragma unroll
        for (int k = 0; k < 9; ++k) {
            const int yr = (k < 8) ? p.epos[row * 8 + k] : (SH_TILE0 * 128 + row);
            const float w = (k < 8) ? p.ew[row * 8 + k] : 1.0f;
#pragma unroll
            for (int h = 0; h < 2; ++h) {
                const u32x4 y = *(const u32x4*)(p.Y + (size_t)yr * DM + h * 512 + lane * 8);
                v[h * 8 + 0] += w * bf2f(y.x & 0xffffu); v[h * 8 + 1] += w * bf2f(y.x >> 16);
                v[h * 8 + 2] += w * bf2f(y.y & 0xffffu); v[h * 8 + 3] += w * bf2f(y.y >> 16);
                v[h * 8 + 4] += w * bf2f(y.z & 0xffffu); v[h * 8 + 5] += w * bf2f(y.z >> 16);
                v[h * 8 + 6] += w * bf2f(y.w & 0xffffu); v[h * 8 + 7] += w * bf2f(y.w >> 16);
            }
        }
        ln_row_store(v, g, b, of, ob, row, lane);
    }
}

__device__ __forceinline__ void phase_nsa_compress(char* lds, int bid, int nb, const P& p) {
    float* blk = (float*)lds;
    float* hs = blk + 4096;
    const int tid = threadIdx.x, which = tid >> 7, j = tid & 127;
    const float* pe = which ? p.pe_v : p.pe_k; const float* w1 = which ? p.wv1 : p.wk1; const float* w2 = which ? p.wv2 : p.wk2;
    float* outp = which ? p.VC : p.KC;
    const int colbase = which ? 640 : 512;
    for (int u = bid; u < 16 * 127; u += nb) {
        const int bg = u / 127, c = u % 127, b = bg >> 1, g = bg & 1;
        __syncthreads();
        for (int i = j; i < 2048; i += 128) { const int l = i >> 6, d = i & 63; blk[which * 2048 + i] = p.U[(size_t)(b * SEQ + 16 * c + l) * ODD_IN + colbase + g * 64 + d] + pe[i]; }
        __syncthreads();
        float a = 0.f;
        for (int i = 0; i < 2048; ++i) a += blk[which * 2048 + i] * w1[i * 128 + j];
        hs[which * 128 + j] = gelu_tanh(a);
        __syncthreads();
        if (j < 64) { float o = 0.f; for (int i = 0; i < 128; ++i) o += hs[which * 128 + i] * w2[i * 64 + j]; outp[(size_t)(bg * 127 + c) * 64 + j] = o; }
    }
}
__device__ __forceinline__ void phase_moba_kmean(int bid, int nb, const P& p) {
    for (int it = bid * 256 + threadIdx.x; it < NBATCH * 8 * 8 * 64; it += nb * 256) {
        const int d = it & 63, j = (it >> 6) & 7, h = (it >> 9) & 7, b = it >> 12;
        float s = 0.f;
        for (int r = 0; r < 256; ++r) s += p.U[(size_t)(b * SEQ + j * 256 + r) * ODD_IN + 1816 + h * 64 + d];
        p.KM[it] = s * (1.0f / 256.0f);
    }
}
#define CMP_LDS ((127 * 65 + 127 * 64 + 4 * (64 + 128 + 128)) * 4)
__device__ __forceinline__ void phase_nsa_cmp(char* lds, int bid, int nb, const P& p) {
    float* kc = (float*)lds;
    float* vc = kc + 127 * 65;
    const int tid = threadIdx.x, lane = tid & 63, wid = tid >> 6;
    float* qs = vc + 127 * 64 + wid * 320;
    float* ps = qs + 64;
    float* pp = ps + 128;
    for (int u = bid; u < 16 * 32; u += nb) {
        const int bg = u >> 5, tb = u & 31, b = bg >> 1, g = bg & 1;
        __syncthreads();
        for (int i = tid; i < 127 * 64; i += 256) { const int c = i >> 6, d = i & 63; kc[c * 65 + d] = p.KC[(size_t)bg * 127 * 64 + i]; vc[i] = p.VC[(size_t)bg * 127 * 64 + i]; }
        __syncthreads();
        for (int qi = 0; qi < 16; ++qi) {
            const int t = tb * 64 + wid * 16 + qi;
            const size_t n = (size_t)b * SEQ + t;
            float psum0 = 0.f, psum1 = 0.f;
            for (int i = 0; i < 4; ++i) {
                const int hd = g * 4 + i;
                const float slope = exp2f(-((float)hd + 0.5f));
                qs[lane] = p.U[n * ODD_IN + hd * 64 + lane];
                __builtin_amdgcn_wave_barrier();
                float s0 = NEGF, s1 = NEGF;
                const int c0 = lane, c1 = lane + 64;
                const bool v0 = (16 * c0 + 31 <= t), v1 = (c1 < 127) && (16 * c1 + 31 <= t);
                if (v0) { float d = 0.f; for (int k = 0; k < 64; ++k) d += qs[k] * kc[c0 * 65 + k]; s0 = d * 0.125f - slope * (float)(t - (16 * c0 + 31)); }
                if (v1) { float d = 0.f; for (int k = 0; k < 64; ++k) d += qs[k] * kc[c1 * 65 + k]; s1 = d * 0.125f - slope * (float)(t - (16 * c1 + 31)); }
                const float m = wave_max(fmaxf(s0, s1));
                float p0 = v0 ? __expf(s0 - m) : 0.f, p1 = v1 ? __expf(s1 - m) : 0.f;
                const float den = fmaxf(wave_sum(p0 + p1), 1e-30f);
                p0 /= den; p1 /= den;
                psum0 += p0; psum1 += p1;
                ps[c0] = p0; ps[c1] = p1;
                __builtin_amdgcn_wave_barrier();
                float o = 0.f;
                for (int c = 0; c < 127; ++c) o += ps[c] * vc[c * 64 + lane];
                p.OC[n * 512 + hd * 64 + lane] = o;
                __builtin_amdgcn_wave_barrier();
            }
            pp[lane] = psum0; pp[lane + 64] = psum1;
            __builtin_amdgcn_wave_barrier();
            const int j = lane & 31, own = t >> 6;
            float imp = 0.f;
#pragma unroll
            for (int c = 4 * j - 1; c <= 4 * j + 3; ++c) if (c >= 0 && c < 127) imp += pp[c];
            const bool forced = (j == 0) || (j == own) || (j == own - 1);
            const bool valid = j <= own;
            const float val = valid ? (imp + (forced ? 1e4f : 0.f)) : NEGF;
            int rank = 0;
            for (int j2 = 0; j2 < 32; ++j2) { const float o2 = __shfl(val, j2); rank += (o2 > val || (o2 == val && j2 < j)) ? 1 : 0; }
            const unsigned long long bal = __ballot(valid && rank < 16 && lane < 32);
            if (lane == 0) p.SELM[(size_t)bg * SEQ + t] = (unsigned)bal;
            __builtin_amdgcn_wave_barrier();
        }
    }
}
struct AttnState { float m, l, o; };
__device__ __forceinline__ void attn_block(AttnState& st, const float* qs, float* ps, const float* Kb, const float* Vb, int s0, int t, float slope, bool lanevalid) {
    const int lane = threadIdx.x & 63;
    float sc = NEGF;
    if (lanevalid) {
        const float* kr = Kb + (size_t)lane * ODD_IN;
        float d = 0.f;
#pragma unroll
        for (int k = 0; k < 64; k += 4) { const f32x4 kv = *(const f32x4*)(kr + k); d += kv[0] * qs[k] + kv[1] * qs[k + 1] + kv[2] * qs[k + 2] + kv[3] * qs[k + 3]; }
        sc = d * 0.125f - slope * (float)(t - (s0 + lane));
    }
    const float mn = fmaxf(st.m, wave_max(sc));
    const float pr = lanevalid ? __expf(sc - mn) : 0.f;
    const float corr = __expf(st.m - mn);
    st.l = st.l * corr + wave_sum(pr);
    __builtin_amdgcn_wave_barrier();
    ps[lane] = pr;
    __builtin_amdgcn_wave_barrier();
    float acc = 0.f;
    for (int s = 0; s < 64; ++s) acc += ps[s] * Vb[(size_t)s * ODD_IN + lane];
    st.o = st.o * corr + acc; st.m = mn;
    __builtin_amdgcn_wave_barrier();
}
__device__ __forceinline__ void phase_nsa_attn(char* lds, int bid, int nb, const P& p) {
    const int tid = threadIdx.x, lane = tid & 63, wid = tid >> 6;
    float* qs = (float*)lds + wid * 128; float* ps = qs + 64;
    for (int it = bid * 4 + wid; it < NTOK * 8; it += nb * 4) {
        const int hd = it & 7; const int n = it >> 3; const int b = n >> 11, t = n & (SEQ - 1), g = hd >> 2;
        const float slope = exp2f(-((float)hd + 0.5f));
        __builtin_amdgcn_wave_barrier();
        qs[lane] = p.U[(size_t)n * ODD_IN + hd * 64 + lane];
        __builtin_amdgcn_wave_barrier();
        const unsigned mask = p.SELM[(size_t)(b * 2 + g) * SEQ + t];
        const int own = t >> 6;
        AttnState ss; ss.m = NEGF; ss.l = 0.f; ss.o = 0.f;
        for (int j = 0; j <= own; ++j) if ((mask >> j) & 1u) {
            const float* base = p.U + (size_t)(b * SEQ + j * 64) * ODD_IN + g * 64;
            attn_block(ss, qs, ps, base + 768, base + 896, j * 64, t, slope, (j * 64 + lane) <= t);
        }
        AttnState sw; sw.m = NEGF; sw.l = 0.f; sw.o = 0.f;
        const int jb0 = (t >= 511) ? ((t - 511) >> 6) : 0;
        for (int j = jb0; j <= own; ++j) {
            const float* base = p.U + (size_t)(b * SEQ + j * 64) * ODD_IN + g * 64;
            const int s = j * 64 + lane;
            attn_block(sw, qs, ps, base + 1024, base + 1152, j * 64, t, slope, (s <= t) && (t - s < 512));
        }
        const float os = ss.o / fmaxf(ss.l, 1e-30f), ow = sw.o / fmaxf(sw.l, 1e-30f);
        const float oc = p.OC[(size_t)n * 512 + hd * 64 + lane];
        const float* gp = p.U + (size_t)n * ODD_IN + 1280 + hd * 3;
        const float y = sigmoidf_(gp[0]) * oc + sigmoidf_(gp[1]) * os + sigmoidf_(gp[2]) * ow;
        p.MIX[(size_t)n * DM + hd * 64 + lane] = (bf16_t)f2bf(y);
    }
}
__device__ __forceinline__ void phase_moba_attn(char* lds, int bid, int nb, const P& p) {
    const int tid = threadIdx.x, lane = tid & 63, wid = tid >> 6;
    float* qs = (float*)lds + wid * 128; float* ps = qs + 64;
    for (int it = bid * 4 + wid; it < NTOK * 8; it += nb * 4) {
        const int hd = it & 7; const int n = it >> 3; const int b = n >> 11, t = n & (SEQ - 1);
        const float slope = exp2f(-((float)hd + 1.0f));
        const float qv = p.U[(size_t)n * ODD_IN + 1304 + hd * 64 + lane];
        __builtin_amdgcn_wave_barrier();
        qs[lane] = qv;
        __builtin_amdgcn_wave_barrier();
        const int ob = t >> 8;
        float gate[8];
#pragma unroll
        for (int j = 0; j < 8; ++j) gate[j] = (j < ob) ? wave_sum(qv * p.KM[((size_t)(b * 8 + hd) * 8 + j) * 64 + lane]) : NEGF;
        unsigned selm = 0;
#pragma unroll
        for (int j = 0; j < 8; ++j) {
            int rank = 0;
#pragma unroll
            for (int j2 = 0; j2 < 8; ++j2) rank += (gate[j2] > gate[j] || (gate[j2] == gate[j] && j2 < j)) ? 1 : 0;
            if (j < ob && rank < 3) selm |= 1u << j;
        }
        AttnState st; st.m = NEGF; st.l = 0.f; st.o = 0.f;
        for (int j = 0; j < ob; ++j) if ((selm >> j) & 1u) {
            for (int sb = 0; sb < 4; ++sb) {
                const float* base = p.U + (size_t)(b * SEQ + j * 256 + sb * 64) * ODD_IN + hd * 64;
                attn_block(st, qs, ps, base + 1816, base + 2328, j * 256 + sb * 64, t, slope, true);
            }
        }
        for (int sb = 0; sb <= ((t & 255) >> 6); ++sb) {
            const float* base = p.U + (size_t)(b * SEQ + ob * 256 + sb * 64) * ODD_IN + hd * 64;
            attn_block(st, qs, ps, base + 1816, base + 2328, ob * 256 + sb * 64, t, slope, (ob * 256 + sb * 64 + lane) <= t);
        }
        p.MIX[(size_t)n * DM + 512 + hd * 64 + lane] = (bf16_t)f2bf(st.o / fmaxf(st.l, 1e-30f));
    }
}

extern __shared__ __attribute__((aligned(16))) char dyn_lds[];
#define MEGA_LDS (((CMP_LDS + 255) & ~255) + 16)
#define GBAR() xcd_barrier(bar)

template <int LAYER>
__device__ __forceinline__ void moe_block(char* lds, int bid, int nb, const P& p, const XcdBarrier& bar, float* of, bf16_t* ob) {
    if (bid == 0) p.cnt[threadIdx.x] = 0;
    phase_gemm_dense<true, true>(lds, bid, nb, p.XA, DM, p.w_router + (size_t)LAYER * DM * NEXP, NEXP, NTOK, NEXP, DM, p.LOG, NEXP);
    GBAR();
    phase_route(bid, nb, p, LAYER);
    GBAR();
    phase_scatter(lds, bid, nb, p);
    GBAR();
    phase_moe1(lds, bid, nb, p, LAYER, p.XAb);
    GBAR();
    phase_moe2(lds, bid, nb, p, LAYER);
    GBAR();
    phase_combine_ln(bid, nb, p, p.XA, p.ln_g + (LAYER * 2 + 1) * DM, p.ln_b + (LAYER * 2 + 1) * DM, of, ob);
}

__global__ void __launch_bounds__(256, 2) mega(P p) {
    char* lds = dyn_lds;
    const int bid = blockIdx.x, nb = gridDim.x;
    volatile LAS unsigned* st = (volatile LAS unsigned*)(dyn_lds + MEGA_LDS - 16);
    if (threadIdx.x == 0) { st[0] = 0u; st[1] = 0u; st[2] = 0u; st[3] = 0u; }
    __syncthreads();
    const XcdBarrier bar = xcd_barrier_post(p.bar, st);
    phase_gemm_dense<true, false>(lds, bid, nb, p.x, DM, p.even_w_in, EVEN_IN, NTOK, EVEN_IN, DM, p.U, EVEN_IN);
    GBAR();
    phase_lru_gates(lds, bid, nb, p);
    GBAR();
    if (bid < 16) phase_hgrn_seq(lds, bid, 16, p);
    else phase_lru_scan(bid - 16, nb - 16, p);
    GBAR();
    phase_gemm_dense<false, false>(lds, bid, nb, p.MIX, DM, p.even_w_out, DM, NTOK, DM, DM, p.T0, DM);
    GBAR();
    phase_ln_add(bid, nb, p.x, p.T0, p.ln_g, p.ln_b, p.XA, p.XAb);
    GBAR();
    moe_block<0>(lds, bid, nb, p, bar, p.XB, p.XBb);
    GBAR();
    phase_gemm_dense<true, false>(lds, bid, nb, p.XB, DM, p.odd_w_in, ODD_IN, NTOK, ODD_IN, DM, p.U, ODD_IN);
    GBAR();
    phase_nsa_compress(lds, bid, nb, p);
    phase_moba_kmean(bid, nb, p);
    GBAR();
    phase_nsa_cmp(lds, bid, nb, p);
    GBAR();
    phase_nsa_attn(lds, bid, nb, p);
    phase_moba_attn(lds, bid, nb, p);
    GBAR();
    phase_gemm_dense<false, false>(lds, bid, nb, p.MIX, DM, p.odd_w_out, DM, NTOK, DM, DM, p.T0, DM);
    GBAR();
    phase_ln_add(bid, nb, p.XB, p.T0, p.ln_g + 2 * DM, p.ln_b + 2 * DM, p.XA, p.XAb);
    GBAR();
    moe_block<1>(lds, bid, nb, p, bar, p.out, nullptr);
}

static inline size_t al256(size_t x) { return (x + 255) & ~(size_t)255; }

extern "C" void kernel_launch(void* const* d_in, const int* in_sizes, int n_in, void* d_out, int out_size, void* d_ws, size_t ws_size, hipStream_t stream) {
    P p{};
    const float** ip = (const float**)&p.x;
    for (int i = 0; i < 30; ++i) ip[i] = (const float*)d_in[i];
    p.out = (float*)d_out;
    char* w = (char*)d_ws; size_t o = 0;
    auto take = [&](size_t bytes) { char* r = w + o; o = al256(o + bytes); return r; };
    p.bar = (unsigned*)take(XCD_BAR_WORDS * 4);
    p.U = (float*)take((size_t)NTOK * EVEN_IN * 4);
    p.MIX = (bf16_t*)take((size_t)NTOK * DM * 2);
    p.T0 = (float*)take((size_t)NTOK * DM * 4);
    p.XA = (float*)take((size_t)NTOK * DM * 4); p.XAb = (bf16_t*)take((size_t)NTOK * DM * 2);
    p.XB = (float*)take((size_t)NTOK * DM * 4); p.XBb = (bf16_t*)take((size_t)NTOK * DM * 2);
    p.LOG = (float*)take((size_t)NTOK * NEXP * 4);
    p.eidx = (int*)take(NTOK * 8 * 4); p.ew = (float*)take(NTOK * 8 * 4); p.erank = (int*)take(NTOK * 8 * 4); p.epos = (int*)take(NTOK * 8 * 4);
    p.cnt = (int*)take(NEXP * 4); p.tile_e = (int*)take(NTILES * 4); p.rowtok = (int*)take(NROWS * 4);
    p.H = (bf16_t*)take((size_t)NROWS * 256 * 2);
    p.Y = (bf16_t*)take((size_t)NROWS * DM * 2);
    p.LA = (float*)take((size_t)NTOK * 512 * 4); p.LB = (float*)take((size_t)NTOK * 512 * 4);
    p.KC = (float*)take(16 * 127 * 64 * 4); p.VC = (float*)take(16 * 127 * 64 * 4);
    p.OC = (float*)take((size_t)NTOK * 512 * 4);
    p.SELM = (unsigned*)take(16 * SEQ * 4);
    p.KM = (float*)take(8 * 8 * 8 * 64 * 4);
    if (o > ws_size) return;

    static int grid = 0;
    if (!grid) {
        int dev = 0, cus = 0, per_cu = 0;
        (void)hipGetDevice(&dev);
        (void)hipDeviceGetAttribute(&cus, hipDeviceAttributeMultiprocessorCount, dev);
        (void)hipFuncSetAttribute((const void*)mega, hipFuncAttributeMaxDynamicSharedMemorySize, MEGA_LDS);
        (void)hipOccupancyMaxActiveBlocksPerMultiprocessor(&per_cu, (const void*)mega, 256, MEGA_LDS);
        if (per_cu < 1) per_cu = 1;
        grid = cus * (per_cu < 2 ? per_cu : 2);
    }
    (void)hipMemsetAsync(p.bar, 0, XCD_BAR_WORDS * 4, stream);
    hipLaunchKernelGGL(mega, dim3(grid), dim3(256), MEGA_LDS, stream, p);
}
```

```cpp
#include <hip/hip_runtime.h>
#include <hip/hip_bf16.h>
#include <stdint.h>

#define NTOK 16384
#define DM 1024
#define SEQ 2048
#define NBATCH 8
#define EVEN_IN 3072
#define ODD_IN 2840
#define NEXP 256
#define NEGF (-1e30f)
#define LOG2E 1.4426950408889634f
#define DN_ALPHA 1.4142135623730951f
#define LN_EPS 1e-5f
#define MAXRT 1280
#define SH_TILE0 1280
#define NTILES (1280 + 128)
#define NROWS (NTILES * 128)

typedef unsigned short bf16_t;
typedef short bf16x8 __attribute__((ext_vector_type(8)));
typedef float f32x4 __attribute__((ext_vector_type(4)));
typedef unsigned u32x4 __attribute__((ext_vector_type(4)));
typedef unsigned u32x2 __attribute__((ext_vector_type(2)));

__device__ __forceinline__ int tidx() { int t = threadIdx.x; asm volatile("" : "+v"(t)); return t; }
__device__ __forceinline__ float wave_sum(float v) {
#pragma unroll
    for (int o = 32; o >= 1; o >>= 1) v += __shfl_xor(v, o);
    return v;
}
__device__ __forceinline__ float wave_max(float v) {
#pragma unroll
    for (int o = 32; o >= 1; o >>= 1) v = fmaxf(v, __shfl_xor(v, o));
    return v;
}
__device__ __forceinline__ unsigned f2bf(float f) {
    unsigned u = __float_as_uint(f);
    u += 0x7FFFu + ((u >> 16) & 1u);
    return u >> 16;
}
__device__ __forceinline__ float bf2f(unsigned b) { return __uint_as_float(b << 16); }
__device__ __forceinline__ unsigned pack2(float lo, float hi) { return f2bf(lo) | (f2bf(hi) << 16); }
__device__ __forceinline__ float sigmoidf_(float x) { return 1.0f / (1.0f + __expf(-x)); }
__device__ __forceinline__ float siluf_(float x) { return x / (1.0f + __expf(-x)); }
__device__ __forceinline__ float gelu_tanh(float x) {
    const float u = 0.7978845608028654f * (x + 0.044715f * x * x * x);
    return 0.5f * x * (1.0f + tanhf(u));
}


#define XB_TMO      128
#define XB_XCNT(j)  (256  + 64 * (j))
#define XB_XSUB(j)  (1280 + 64 * (j))
#define XB_XGEN(j)  (2304 + 64 * (j))
#define XB_TOP      3328
#define XB_TOPGEN   3392
#define XCD_BAR_WORDS 3456
#define XB_SPIN_CAP (1u << 18)
#define LAS __attribute__((address_space(3)))
__device__ __forceinline__ unsigned xb_ld(unsigned* p)              { return __hip_atomic_load(p, __ATOMIC_RELAXED, __HIP_MEMORY_SCOPE_AGENT); }
__device__ __forceinline__ unsigned xb_add(unsigned* p, unsigned v) { return __hip_atomic_fetch_add(p, v, __ATOMIC_RELAXED, __HIP_MEMORY_SCOPE_AGENT); }
__device__ __forceinline__ unsigned xb_xcc_id() { return (unsigned)__builtin_amdgcn_s_getreg((3 << 11) | 20) & 0xFu; }
#define XB_SPIN(cond, bar) do { unsigned _sp = 0; while (cond) { __builtin_amdgcn_s_sleep(1); \
    if ((++_sp & 255u) == 0u) { if (xb_ld(&(bar)[XB_TMO])) break; if (_sp > XB_SPIN_CAP) { atomicAdd(&(bar)[XB_TMO], 1u); break; } } } } while (0)
struct XcdBarrier { unsigned* bar; unsigned x; volatile LAS unsigned* st; };
__device__ __forceinline__ XcdBarrier xcd_barrier_post(unsigned* bar, volatile LAS unsigned* st) {
    XcdBarrier b; b.bar = bar; b.x = xb_xcc_id(); b.st = st;
    if (tidx() == 0) (void)xb_add(&bar[XB_XCNT(b.x)], 1u);
    return b;
}
__device__ __forceinline__ void xcd_barrier_complete(unsigned* bar, unsigned x, unsigned& nloc, unsigned& nx) {
    const unsigned G = gridDim.x * gridDim.y * gridDim.z;
    unsigned sum, cnt, mine, sp = 0u;
    for (;;) {
        sum = 0u; cnt = 0u; mine = 0u;
#pragma unroll
        for (unsigned j = 0; j < 16; ++j) { const unsigned c = xb_ld(&bar[XB_XCNT(j)]); sum += c; cnt += (c > 0u) ? 1u : 0u; mine = (j == x) ? c : mine; }
        if (sum == G) break;
        __builtin_amdgcn_s_sleep(1);
        if ((++sp & 255u) == 0u) { if (xb_ld(&bar[XB_TMO])) break; if (sp > XB_SPIN_CAP) { atomicAdd(&bar[XB_TMO], 1u); break; } }
    }
    nloc = mine > 0u ? mine : 1u; nx = cnt > 0u ? cnt : 1u;
}
__device__ __forceinline__ void xcd_barrier(const XcdBarrier& b) {
    asm volatile("s_waitcnt vmcnt(0)" ::: "memory");
    __syncthreads();
    if (tidx() == 0) {
        unsigned* bar = b.bar;
        __builtin_amdgcn_s_waitcnt(0);
        unsigned nloc = b.st[0], nx = b.st[1];
        if (nloc == 0u) { xcd_barrier_complete(bar, b.x, nloc, nx); b.st[0] = nloc; b.st[1] = nx; }
        const unsigned old = xb_add(&bar[XB_XSUB(b.x)], 1u);
        const unsigned gen = old / nloc;
        if (old + 1u == (gen + 1u) * nloc) {
            __builtin_amdgcn_fence(__ATOMIC_RELEASE, "agent");
            asm volatile("s_waitcnt vmcnt(0)" ::: "memory");
            const unsigned og = xb_add(&bar[XB_TOP], 1u);
            const unsigned tg = og / nx;
            if (og + 1u == (tg + 1u) * nx) xb_add(&bar[XB_TOPGEN], 1u);
            else XB_SPIN(xb_ld(&bar[XB_TOPGEN]) == tg, bar);
            __builtin_amdgcn_fence(__ATOMIC_ACQUIRE, "agent");
            xb_add(&bar[XB_XGEN(b.x)], 1u);
            asm volatile("s_waitcnt vmcnt(0)" ::: "memory");
        } else {
            XB_SPIN(xb_ld(&bar[XB_XGEN(b.x)]) == gen, bar);
            __builtin_amdgcn_fence(__ATOMIC_ACQUIRE, "agent");
            asm volatile("s_waitcnt vmcnt(0)" ::: "memory");
        }
    }
    __syncthreads();
}

struct P {
    const float *x, *even_w_in, *conv_w, *conv_b, *wa, *ba, *wx, *bx, *lam, *hg_lb, *hg_ng, *even_w_out;
    const float *odd_w_in, *pe_k, *pe_v, *wk1, *wk2, *wv1, *wv2, *odd_w_out, *ln_g, *ln_b, *w_router, *b_router;
    const float *w_gate, *w_up, *w_down, *ws_gate, *ws_up, *ws_down;
    float* out;
    float* U;
    bf16_t* MIX;
    float* T0;
    float* XA; bf16_t* XAb; float* XB; bf16_t* XBb;
    float* LOG;
    int* eidx; float* ew; int* erank; int* epos;
    int* cnt;
    int* tile_e;
    int* rowtok;
    bf16_t* H;
    bf16_t* Y;
    float* LA; float* LB;
    float* KC; float* VC;
    float* OC;
    unsigned* SELM;
    float* KM;
    unsigned* bar;
    bf16_t *Qb, *KS, *VSt, *KW, *VWt, *MQ, *MK, *MVt;
    float *KCV, *GATES, *OS; unsigned* MSEL;
    bf16_t *UB0;
    bf16_t *VHt;
    bf16_t *WAT, *WXT;
    float *CSA, *CSB;
    bf16_t *UT, *SP;
    float *DV;
    float *HID;
    bf16_t *KCb, *VCt;
};

__device__ __forceinline__ int lds_off(int r, int c) {
    const int st = (r >> 4) * 2 + (c >> 5), ob = (r & 15) * 64 + (c & 31) * 2;
    return st * 1024 + (ob ^ (((ob >> 9) & 1) << 5));
}
#define GEMM_LDS 32768

__device__ __forceinline__ float cvt_part(float v, int lo) { return lo ? (v - bf2f(f2bf(v))) : v; }

struct ALoadF32 {
    const float* rp[4];
    int nk1;
    struct Regs { f32x4 v[8]; };
    __device__ __forceinline__ void load(int kt, Regs& R) const {
        const int k = (kt % nk1) * 64;
#pragma unroll
        for (int i = 0; i < 4; ++i) { R.v[2 * i] = *(const f32x4*)(rp[i] + k); R.v[2 * i + 1] = *(const f32x4*)(rp[i] + k + 4); }
    }
    __device__ __forceinline__ void store(int kt, const Regs& R, char* lds) const {
        const int lo = (kt / nk1) == 2;
#pragma unroll
        for (int i = 0; i < 4; ++i) {
            const int p = tidx() + 256 * i, row = p >> 3, ch = p & 7;
            const f32x4 a = R.v[2 * i], b = R.v[2 * i + 1];
            u32x4 w;
            w.x = pack2(cvt_part(a[0], lo), cvt_part(a[1], lo)); w.y = pack2(cvt_part(a[2], lo), cvt_part(a[3], lo));
            w.z = pack2(cvt_part(b[0], lo), cvt_part(b[1], lo)); w.w = pack2(cvt_part(b[2], lo), cvt_part(b[3], lo));
            *(u32x4*)(lds + lds_off(row, ch * 8)) = w;
        }
    }
};
struct ALoadBF16 {
    const bf16_t* rp[4];
    struct Regs { u32x4 v[4]; };
    __device__ __forceinline__ void load(int kt, Regs& R) const {
#pragma unroll
        for (int i = 0; i < 4; ++i) R.v[i] = *(const u32x4*)(rp[i] + kt * 64);
    }
    __device__ __forceinline__ void store(int kt, const Regs& R, char* lds) const {
#pragma unroll
        for (int i = 0; i < 4; ++i) { const int p = tidx() + 256 * i; *(u32x4*)(lds + lds_off(p >> 3, (p & 7) * 8)) = R.v[i]; }
    }
};
struct ALoadF32S {
    const float* rp0; size_t rs32; int nk1;
    struct Regs { f32x4 v[8]; };
    __device__ __forceinline__ void load(int kt, Regs& R) const {
        const int k = (kt % nk1) * 64;
#pragma unroll
        for (int i = 0; i < 4; ++i) { const float* q = rp0 + i * rs32 + k; R.v[2 * i] = *(const f32x4*)q; R.v[2 * i + 1] = *(const f32x4*)(q + 4); }
    }
    __device__ __forceinline__ void store(int kt, const Regs& R, char* lds) const {
        const int lo = (kt / nk1) == 2;
#pragma unroll
        for (int i = 0; i < 4; ++i) {
            const int p = tidx() + 256 * i, row = p >> 3, ch = p & 7;
            const f32x4 a = R.v[2 * i], b = R.v[2 * i + 1];
            u32x4 w;
            w.x = pack2(cvt_part(a[0], lo), cvt_part(a[1], lo)); w.y = pack2(cvt_part(a[2], lo), cvt_part(a[3], lo));
            w.z = pack2(cvt_part(b[0], lo), cvt_part(b[1], lo)); w.w = pack2(cvt_part(b[2], lo), cvt_part(b[3], lo));
            *(u32x4*)(lds + lds_off(row, ch * 8)) = w;
        }
    }
};
struct ALoadBF16S {
    const bf16_t* rp0; size_t rs32;
    struct Regs { u32x4 v[4]; };
    __device__ __forceinline__ void load(int kt, Regs& R) const {
#pragma unroll
        for (int i = 0; i < 4; ++i) R.v[i] = *(const u32x4*)(rp0 + i * rs32 + kt * 64);
    }
    __device__ __forceinline__ void store(int kt, const Regs& R, char* lds) const {
#pragma unroll
        for (int i = 0; i < 4; ++i) { const int p = tidx() + 256 * i; *(u32x4*)(lds + lds_off(p >> 3, (p & 7) * 8)) = R.v[i]; }
    }
};
struct BLoadF32 {
    const float* bp; int ldb; bool valid; int nk1;
    struct Regs { f32x4 v[8]; };
    __device__ __forceinline__ void load(int kt, Regs& R) const {
        const float* p = bp + (size_t)((kt % nk1) * 64) * ldb;
#pragma unroll
        for (int j = 0; j < 8; ++j) R.v[j] = valid ? *(const f32x4*)(p + (size_t)j * ldb) : (f32x4){0.f, 0.f, 0.f, 0.f};
    }
    __device__ __forceinline__ void store(int kt, const Regs& R, char* lds) const {
        const int lo = (kt / nk1) == 1;
        const int nq = tidx() & 31, kg = tidx() >> 5;
#pragma unroll
        for (int i = 0; i < 4; ++i) {
            u32x4 w;
            w.x = pack2(cvt_part(R.v[0][i], lo), cvt_part(R.v[1][i], lo)); w.y = pack2(cvt_part(R.v[2][i], lo), cvt_part(R.v[3][i], lo));
            w.z = pack2(cvt_part(R.v[4][i], lo), cvt_part(R.v[5][i], lo)); w.w = pack2(cvt_part(R.v[6][i], lo), cvt_part(R.v[7][i], lo));
            *(u32x4*)(lds + lds_off(nq * 4 + i, kg * 8)) = w;
        }
    }
};

template <class AL, class BL>
__device__ __forceinline__ void gemm_tile(char* lds, const AL& al, const BL& bl, int nk, f32x4 (&acc)[4][4], bool swap = false) {
    const int lane = tidx() & 63, wid = tidx() >> 6, wr = wid >> 1, wc = wid & 1, fr = lane & 15, fq = lane >> 4;
    char* ldsA = lds; char* ldsB = lds + 16384;
    const char* t2 = swap ? ldsB : ldsA; const char* t1 = swap ? ldsA : ldsB; const int w2 = swap ? wc : wr, w1 = swap ? wr : wc;
#pragma unroll
    for (int m = 0; m < 4; ++m)
#pragma unroll
        for (int n = 0; n < 4; ++n) acc[m][n] = (f32x4){0.f, 0.f, 0.f, 0.f};
    typename AL::Regs ra; typename BL::Regs rb;
    al.load(0, ra); bl.load(0, rb);
    for (int kt = 0; kt < nk; ++kt) {
        __syncthreads();
        al.store(kt, ra, ldsA); bl.store(kt, rb, ldsB);
        __syncthreads();
        if (kt + 1 < nk) { al.load(kt + 1, ra); bl.load(kt + 1, rb); }
#pragma unroll
        for (int kk = 0; kk < 2; ++kk) {
            bf16x8 a[4], b[4];
#pragma unroll
            for (int m = 0; m < 4; ++m) a[m] = *(const bf16x8*)(t2 + lds_off(w2 * 64 + m * 16 + fr, kk * 32 + fq * 8));
#pragma unroll
            for (int n = 0; n < 4; ++n) b[n] = *(const bf16x8*)(t1 + lds_off(w1 * 64 + n * 16 + fr, kk * 32 + fq * 8));
#pragma unroll
            for (int m = 0; m < 4; ++m)
#pragma unroll
                for (int n = 0; n < 4; ++n) acc[m][n] = __builtin_amdgcn_mfma_f32_16x16x32_bf16(b[n], a[m], acc[m][n], 0, 0, 0);
        }
    }
}

template <bool AF32, bool SPLIT>
__device__ __forceinline__ void phase_gemm_dense(char* lds, int bid, int nb, const void* A, int lda, const float* W, int ldw, int M, int N, int K, float* C, int ldc) {
    const int ntn = (N + 127) / 128, ntm = M / 128, nk1 = K / 64;
    const int tid = tidx(), lane = tid & 63, wid = tid >> 6, wr = wid >> 1, wc = wid & 1, fr = lane & 15, fq = lane >> 4;
    for (int u = bid; u < ntm * ntn; u += nb) {
        const int tm = u / ntn, tn = u % ntn;
        BLoadF32 bl; { const int nq = tid & 31, kg = tid >> 5; const int col = tn * 128 + nq * 4; bl.valid = col < N; bl.ldb = ldw; bl.nk1 = SPLIT ? nk1 : (1 << 30);
            bl.bp = W + (size_t)(kg * 8) * ldw + (bl.valid ? col : 0); }
        f32x4 acc[4][4];
        if (AF32) {
            ALoadF32S al; al.nk1 = SPLIT ? nk1 : (1 << 30); al.rs32 = (size_t)32 * lda;
            al.rp0 = (const float*)A + (size_t)(tm * 128 + (tid >> 3)) * lda + (tid & 7) * 8;
            gemm_tile(lds, al, bl, SPLIT ? 3 * nk1 : nk1, acc);
        } else {
            ALoadBF16S al; al.rs32 = (size_t)32 * lda;
            al.rp0 = (const bf16_t*)A + (size_t)(tm * 128 + (tid >> 3)) * lda + (tid & 7) * 8;
            gemm_tile(lds, al, bl, nk1, acc);
        }
#pragma unroll
        for (int m = 0; m < 4; ++m)
#pragma unroll
            for (int n = 0; n < 4; ++n) {
                const int row = tm * 128 + wr * 64 + m * 16 + fr, col = tn * 128 + wc * 64 + n * 16 + fq * 4;
                if (col < N) *(f32x4*)(C + (size_t)row * ldc + col) = acc[m][n];
            }
    }
}

__device__ __forceinline__ void ln_row_store(float (&v)[16], const float* g, const float* b, float* of, bf16_t* ob, int row, int lane) {
    float s = 0.f;
#pragma unroll
    for (int i = 0; i < 16; ++i) s += v[i];
    const float mu = wave_sum(s) * (1.0f / DM);
    float q = 0.f;
#pragma unroll
    for (int i = 0; i < 16; ++i) { const float d = v[i] - mu; q += d * d; }
    const float rstd = rsqrtf(wave_sum(q) * (1.0f / DM) + LN_EPS);
#pragma unroll
    for (int h = 0; h < 2; ++h) {
        const int c0 = h * 512 + lane * 8;
        float o[8];
#pragma unroll
        for (int i = 0; i < 8; ++i) o[i] = (v[h * 8 + i] - mu) * rstd * g[c0 + i] + b[c0 + i];
        *(f32x4*)(of + (size_t)row * DM + c0) = (f32x4){o[0], o[1], o[2], o[3]};
        *(f32x4*)(of + (size_t)row * DM + c0 + 4) = (f32x4){o[4], o[5], o[6], o[7]};
        if (ob) { u32x4 w; w.x = pack2(o[0], o[1]); w.y = pack2(o[2], o[3]); w.z = pack2(o[4], o[5]); w.w = pack2(o[6], o[7]); *(u32x4*)(ob + (size_t)row * DM + c0) = w; }
    }
}
__device__ __forceinline__ void phase_ln_add(int bid, int nb, const float* res, const float* add, const float* g, const float* b, float* of, bf16_t* ob) {
    const int lane = tidx() & 63, wid = tidx() >> 6;
    for (int row = bid * 4 + wid; row < NTOK; row += nb * 4) {
        float v[16];
#pragma unroll
        for (int h = 0; h < 2; ++h) {
            const size_t o = (size_t)row * DM + h * 512 + lane * 8;
            const f32x4 r0 = *(const f32x4*)(res + o), r1 = *(const f32x4*)(res + o + 4), a0 = *(const f32x4*)(add + o), a1 = *(const f32x4*)(add + o + 4);
#pragma unroll
            for (int i = 0; i < 4; ++i) { v[h * 8 + i] = DN_ALPHA * r0[i] + a0[i]; v[h * 8 + 4 + i] = DN_ALPHA * r1[i] + a1[i]; }
        }
        ln_row_store(v, g, b, of, ob, row, lane);
    }
}

__device__ __forceinline__ void phase_lru_gates(char* lds, int bid, int nb, const P& p) {
    float* xs = (float*)lds;
    const int tid = tidx();
    for (int tok = bid; tok < NTOK; tok += nb) {
        const int t = tok & (SEQ - 1);
        __syncthreads();
#pragma unroll
        for (int cc = 0; cc < 2; ++cc) {
            const int c = tid + 256 * cc;
            float xc = p.conv_b[c];
#pragma unroll
            for (int w = 0; w < 4; ++w) { const int tt = t - 3 + w; if (tt >= 0) xc += p.conv_w[w * 512 + c] * p.U[(size_t)(tok - 3 + w) * EVEN_IN + c]; }
            xs[c] = xc;
        }
        __syncthreads();
#pragma unroll
        for (int cc = 0; cc < 2; ++cc) {
            const int c = tid + 256 * cc, h = c >> 6, j = c & 63;
            float ra = p.ba[c], ri = p.bx[c];
#pragma unroll 8
            for (int i = 0; i < 64; ++i) { const float xv = xs[h * 64 + i]; ra += xv * p.wa[(h * 64 + i) * 64 + j]; ri += xv * p.wx[(h * 64 + i) * 64 + j]; }
            const float r = sigmoidf_(ra), ig = sigmoidf_(ri);
            const float nl = -p.lam[c];
            const float sp = fmaxf(nl, 0.f) + log1pf(expf(-fabsf(nl)));
            const float log_a = -8.0f * r * sp;
            const float a = expf(log_a);
            const float mult = (t == 0) ? 1.0f : sqrtf(-expm1f(2.0f * log_a));
            p.LA[(size_t)tok * 512 + c] = a;
            p.LB[(size_t)tok * 512 + c] = mult * ig * xs[c];
        }
    }
}
__device__ __forceinline__ void phase_lru_scan(int bid, int nb, const P& p) {
    for (int it = bid * 256 + tidx(); it < NBATCH * 512; it += nb * 256) {
        const int b = it >> 9, c = it & 511;
        float h = 0.f;
        for (int t = 0; t < SEQ; ++t) {
            const size_t n = (size_t)b * SEQ + t;
            h = p.LA[n * 512 + c] * h + p.LB[n * 512 + c];
            const float gb = p.U[n * EVEN_IN + 512 + c];
            p.MIX[n * DM + c] = (bf16_t)f2bf(h * gelu_tanh(gb));
        }
    }
}
__device__ __forceinline__ void phase_hgrn_seq(char* lds, int bid, int nb, const P& p) {
    const int tid = tidx(), half = tid >> 7, v = tid & 127;
    float* sq = (float*)lds + half * 512;
    float* sf = sq + 128;
    float* red = sq + 256;
    for (int u0 = bid * 2; u0 < NBATCH * 4; u0 += nb * 2) {
        const int u = u0 + half;
        const int b = u >> 2, h = u & 3;
        const int ch = h * 128 + v;
        float lbv; { const float l0 = p.hg_lb[ch], l1 = p.hg_lb[512 + ch], l2 = p.hg_lb[1024 + ch]; const float mx = fmaxf(l0, fmaxf(l1, l2));
            const float e0 = expf(l0 - mx), e1 = expf(l1 - mx), e2 = expf(l2 - mx); lbv = e0 / (e0 + e1 + e2); }
        const float ng = p.hg_ng[ch];
        float S[128];
#pragma unroll
        for (int k = 0; k < 128; ++k) S[k] = 0.f;
        for (int t = 0; t < SEQ; ++t) {
            const size_t n = (size_t)b * SEQ + t;
            const float* ur = p.U + n * EVEN_IN;
            const float qv = siluf_(ur[1024 + ch]);
            const float f = lbv + (1.0f - lbv) * sigmoidf_(ur[1536 + ch]);
            __syncthreads();
            sq[v] = qv; sf[v] = f;
            __syncthreads();
            const float vv = ur[2048 + ch];
            float o = 0.f;
#pragma unroll
            for (int k = 0; k < 128; ++k) { const float fk = sf[k]; S[k] = fk * S[k] + (1.0f - fk) * vv; o += sq[k] * S[k]; }
            const float ss = wave_sum(o * o);
            if ((tid & 63) == 0) red[(tid >> 6) & 1] = ss;
            __syncthreads();
            const float tot = red[0] + red[1];
            const float y = o * rsqrtf(tot * (1.0f / 128.0f) + 1e-6f) * ng * sigmoidf_(ur[2560 + ch]);
            p.MIX[n * DM + 512 + ch] = (bf16_t)f2bf(y);
        }
        __syncthreads();
    }
}

__device__ __forceinline__ void phase_route(int bid, int nb, const P& p, int layer) {
    const float* br = p.b_router + layer * NEXP;
    const int tid = tidx(), lane = tid & 63, wid = tid >> 6;
    const int gt = bid * 256 + tid, gs = nb * 256;
    for (int i = gt; i < NROWS; i += gs) p.rowtok[i] = (i >= SH_TILE0 * 128) ? (i - SH_TILE0 * 128) : 0;
    const f32x4 bv = *(const f32x4*)(br + lane * 4);
    for (int t = bid * 4 + wid; t < NTOK; t += nb * 4) {
        const f32x4 lg = *(const f32x4*)(p.LOG + (size_t)t * NEXP + lane * 4);
        float sc[4], bs[4];
#pragma unroll
        for (int i = 0; i < 4; ++i) { sc[i] = sigmoidf_(lg[i]); bs[i] = sc[i] + bv[i]; }
        float t1 = fmaxf(bs[0], bs[1]), t2 = fminf(bs[0], bs[1]);
        { const float a = fmaxf(bs[2], bs[3]), c = fminf(bs[2], bs[3]); const float n1 = fmaxf(t1, a); t2 = fmaxf(fminf(t1, a), fmaxf(t2, c)); t1 = n1; }
#pragma unroll
        for (int o = 1; o <= 4; o <<= 1) { const float o1 = __shfl_xor(t1, o), o2 = __shfl_xor(t2, o); const float n1 = fmaxf(t1, o1); t2 = fmaxf(fminf(t1, o1), fmaxf(t2, o2)); t1 = n1; }
        const float gsc = t1 + t2;
        const int g = lane >> 3;
        int rank = 0;
#pragma unroll
        for (int g2 = 0; g2 < 8; ++g2) { const float o = __shfl(gsc, g2 * 8); rank += (o > gsc || (o == gsc && g2 < g)) ? 1 : 0; }
        const bool allowed = rank < 4;
        float cv[4];
#pragma unroll
        for (int i = 0; i < 4; ++i) cv[i] = allowed ? bs[i] : -3e38f;
        float wsel = 0.f; int esel = 0; float wsum = 0.f;
#pragma unroll
        for (int k = 0; k < 8; ++k) {
            float bvv = cv[0]; int bi = 0;
#pragma unroll
            for (int i = 1; i < 4; ++i) if (cv[i] > bvv) { bvv = cv[i]; bi = i; }
            int be = lane * 4 + bi;
#pragma unroll
            for (int o = 1; o <= 32; o <<= 1) { const float ov = __shfl_xor(bvv, o); const int oe = __shfl_xor(be, o); if (ov > bvv || (ov == bvv && oe < be)) { bvv = ov; be = oe; } }
            const int ol = be >> 2, oi = be & 3;
            float sown = 0.f;
#pragma unroll
            for (int i = 0; i < 4; ++i) if (oi == i) sown = sc[i];
            const float sv = __shfl(sown, ol);
            if (lane == ol) {
#pragma unroll
                for (int i = 0; i < 4; ++i) if (oi == i) cv[i] = -3e38f;
            }
            wsum += sv;
            if (lane == k) { wsel = sv; esel = be; }
        }
        if (lane < 8) {
            p.eidx[t * 8 + lane] = esel;
            p.ew[t * 8 + lane] = wsel / wsum * 2.5f;
            p.erank[t * 8 + lane] = atomicAdd(&p.cnt[esel], 1);
        }
    }
}
__device__ __forceinline__ void phase_scatter(char* lds, int bid, int nb, const P& p) {
    int* base = (int*)lds;
    const int tid = tidx();
    __syncthreads();
    int* pc = base + 260;
    pc[tid] = (p.cnt[tid] + 127) & ~127;
    __syncthreads();
    { int s = 0; for (int e = 0; e < tid; ++e) s += pc[e]; base[tid] = s; if (tid == 255) base[256] = s + pc[255]; }
    __syncthreads();
    for (int a = bid * 256 + tid; a < NTOK * 8; a += nb * 256) {
        const int e = p.eidx[a]; const int row = base[e] + p.erank[a];
        p.rowtok[row] = a >> 3; p.epos[a] = row;
    }
    if (bid == 0) {
        const int nrt = base[256] >> 7;
        for (int i = tid; i < NTILES; i += 256) if (i >= nrt) p.tile_e[i] = (i >= SH_TILE0) ? NEXP : -1;
        const int t0 = base[tid] >> 7, t1 = base[tid + 1] >> 7;
        for (int i = t0; i < t1; ++i) p.tile_e[i] = tid;
    }
    __syncthreads();
}
__device__ __forceinline__ void phase_moe1(char* lds, int bid, int nb, const P& p, int layer, const bf16_t* Xb) {
    const int tid = tidx(), lane = tid & 63, wid = tid >> 6, wr = wid >> 1, wc = wid & 1, fr = lane & 15, fq = lane >> 4;
    for (int u = bid; u < NTILES * 4; u += nb) {
        const int tile = u >> 2, nt = u & 3;
        const int e = p.tile_e[tile];
        if (e < 0) continue;
        const float* Wg = (e < NEXP) ? p.w_gate + ((size_t)layer * NEXP + e) * (DM * 256) : p.ws_gate + (size_t)layer * (DM * 256);
        const float* Wu = (e < NEXP) ? p.w_up + ((size_t)layer * NEXP + e) * (DM * 256) : p.ws_up + (size_t)layer * (DM * 256);
        ALoadBF16 al;
#pragma unroll
        for (int i = 0; i < 4; ++i) { const int pp = tid + 256 * i; const int tok = p.rowtok[tile * 128 + (pp >> 3)]; al.rp[i] = Xb + (size_t)tok * DM + (pp & 7) * 8; }
        BLoadF32 bl; { const int nq = tid & 31, kg = tid >> 5; const int j = nq * 4, jw = j & 63, w2 = j >> 6; const int col = nt * 64 + w2 * 32 + (jw & 31);
            bl.valid = true; bl.ldb = 256; bl.nk1 = 1 << 30; bl.bp = ((jw >= 32) ? Wu : Wg) + (size_t)(kg * 8) * 256 + col; }
        f32x4 acc[4][4];
        gemm_tile(lds, al, bl, DM / 64, acc);
#pragma unroll
        for (int m = 0; m < 4; ++m)
#pragma unroll
            for (int n = 0; n < 2; ++n) {
                const int row = tile * 128 + wr * 64 + m * 16 + fr, col = nt * 64 + wc * 32 + n * 16 + fq * 4;
                const f32x4 g = acc[m][n], uu = acc[m][n + 2];
                u32x2 w; w.x = pack2(siluf_(g[0]) * uu[0], siluf_(g[1]) * uu[1]); w.y = pack2(siluf_(g[2]) * uu[2], siluf_(g[3]) * uu[3]);
                *(u32x2*)(p.H + (size_t)row * 256 + col) = w;
            }
    }
}
__device__ __forceinline__ void phase_moe2(char* lds, int bid, int nb, const P& p, int layer) {
    const int tid = tidx(), lane = tid & 63, wid = tid >> 6, wr = wid >> 1, wc = wid & 1, fr = lane & 15, fq = lane >> 4;
    for (int u = bid; u < NTILES * 8; u += nb) {
        const int tile = u >> 3, nt = u & 7;
        const int e = p.tile_e[tile];
        if (e < 0) continue;
        const float* Wd = (e < NEXP) ? p.w_down + ((size_t)layer * NEXP + e) * (256 * DM) : p.ws_down + (size_t)layer * (256 * DM);
        ALoadBF16S al; al.rs32 = (size_t)32 * 256;
        al.rp0 = p.H + (size_t)(tile * 128 + (tid >> 3)) * 256 + (tid & 7) * 8;
        BLoadF32 bl; { const int nq = tid & 31, kg = tid >> 5; bl.valid = true; bl.ldb = DM; bl.nk1 = 1 << 30; bl.bp = Wd + (size_t)(kg * 8) * DM + nt * 128 + nq * 4; }
        f32x4 acc[4][4];
        gemm_tile(lds, al, bl, 256 / 64, acc);
#pragma unroll
        for (int m = 0; m < 4; ++m)
#pragma unroll
            for (int n = 0; n < 4; ++n) {
                const int row = tile * 128 + wr * 64 + m * 16 + fr, col = nt * 128 + wc * 64 + n * 16 + fq * 4;
                const f32x4 a = acc[m][n];
                u32x2 w; w.x = pack2(a[0], a[1]); w.y = pack2(a[2], a[3]);
                *(u32x2*)(p.Y + (size_t)row * DM + col) = w;
            }
    }
}
__device__ __forceinline__ void phase_combine_ln(int bid, int nb, const P& p, const float* X, const float* g, const float* b, float* of, bf16_t* ob) {
    const int lane = tidx() & 63, wid = tidx() >> 6;
    for (int row = bid * 4 + wid; row < NTOK; row += nb * 4) {
        float v[16];
#pragma unroll
        for (int h = 0; h < 2; ++h) {
            const size_t o = (size_t)row * DM + h * 512 + lane * 8;
            const f32x4 r0 = *(const f32x4*)(X + o), r1 = *(const f32x4*)(X + o + 4);
#pragma unroll
            for (int i = 0; i < 4; ++i) { v[h * 8 + i] = DN_ALPHA * r0[i]; v[h * 8 + 4 + i] = DN_ALPHA * r1[i]; }
        }
#pragma unroll
        for (int k = 0; k < 9; ++k) {
            const int yr = (k < 8) ? p.epos[row * 8 + k] : (SH_TILE0 * 128 + row);
            const float w = (k < 8) ? p.ew[row * 8 + k] : 1.0f;
#pragma unroll
            for (int h = 0; h < 2; ++h) {
                const u32x4 y = *(const u32x4*)(p.Y + (size_t)yr * DM + h * 512 + lane * 8);
                v[h * 8 + 0] += w * bf2f(y.x & 0xffffu); v[h * 8 + 1] += w * bf2f(y.x >> 16);
                v[h * 8 + 2] += w * bf2f(y.y & 0xffffu); v[h * 8 + 3] += w * bf2f(y.y >> 16);
                v[h * 8 + 4] += w * bf2f(y.z & 0xffffu); v[h * 8 + 5] += w * bf2f(y.z >> 16);
                v[h * 8 + 6] += w * bf2f(y.w & 0xffffu); v[h * 8 + 7] += w * bf2f(y.w >> 16);
            }
        }
        ln_row_store(v, g, b, of, ob, row, lane);
    }
}

__device__ __forceinline__ void phase_nsa_compress(char* lds, int bid, int nb, const P& p) {
    float* blk = (float*)lds;
    float* hs = blk + 4096;
    const int tid = tidx(), which = tid >> 7, j = tid & 127;
    const float* pe = which ? p.pe_v : p.pe_k; const float* w1 = which ? p.wv1 : p.wk1; const float* w2 = which ? p.wv2 : p.wk2;
    float* outp = which ? p.VC : p.KC;
    for (int u = bid; u < 16 * 127; u += nb) {
        const int bg = u / 127, c = u % 127, b = bg >> 1, g = bg & 1;
        __syncthreads();
        for (int i = j; i < 2048; i += 128) { const int l = i >> 6, d = i & 63; blk[which * 2048 + i] = p.KCV[(size_t)(b * SEQ + 16 * c + l) * 256 + which * 128 + g * 64 + d] + pe[i]; }
        __syncthreads();
        float a = 0.f;
        for (int i = 0; i < 2048; ++i) a += blk[which * 2048 + i] * w1[i * 128 + j];
        hs[which * 128 + j] = gelu_tanh(a);
        __syncthreads();
        if (j < 64) { float o = 0.f; for (int i = 0; i < 128; ++i) o += hs[which * 128 + i] * w2[i * 64 + j]; outp[(size_t)(bg * 127 + c) * 64 + j] = o; }
    }
}
__device__ __forceinline__ void phase_moba_kmean(int bid, int nb, const P& p) {
    const int tid = tidx();
    for (int u = bid; u < NBATCH * 8; u += nb) {
        const int b = u >> 3, j = u & 7;
        const bf16_t* src = p.MK + (size_t)(b * SEQ + j * 256) * 512 + tid * 2;
        float s0 = 0.f, s1 = 0.f;
        for (int r8 = 0; r8 < 256; r8 += 8) {
            unsigned v[8];
#pragma unroll
            for (int i = 0; i < 8; ++i) v[i] = *(const unsigned*)(src + (size_t)(r8 + i) * 512);
#pragma unroll
            for (int i = 0; i < 8; ++i) { s0 += bf2f(v[i] & 0xffffu); s1 += bf2f(v[i] >> 16); }
        }
        const int h = tid >> 5, d = (tid & 31) * 2;
        p.KM[((size_t)(b * 8 + h) * 8 + j) * 64 + d] = s0 * (1.0f / 256.0f);
        p.KM[((size_t)(b * 8 + h) * 8 + j) * 64 + d + 1] = s1 * (1.0f / 256.0f);
    }
}
#define CMP_LDS ((127 * 65 + 127 * 64 + 4 * (64 + 128 + 128)) * 4)
__device__ __forceinline__ void phase_nsa_cmp(char* lds, int bid, int nb, const P& p) {
    float* kc = (float*)lds;
    float* vc = kc + 127 * 65;
    const int tid = tidx(), lane = tid & 63, wid = tid >> 6;
    float* qs = vc + 127 * 64 + wid * 320;
    float* ps = qs + 64;
    float* pp = ps + 128;
    for (int u = bid; u < 16 * 32; u += nb) {
        const int bg = u >> 5, tb = u & 31, b = bg >> 1, g = bg & 1;
        __syncthreads();
        for (int i = tid; i < 127 * 64; i += 256) { const int c = i >> 6, d = i & 63; kc[c * 65 + d] = p.KC[(size_t)bg * 127 * 64 + i]; vc[i] = p.VC[(size_t)bg * 127 * 64 + i]; }
        __syncthreads();
        for (int qi = 0; qi < 16; ++qi) {
            const int t = tb * 64 + wid * 16 + qi;
            const size_t n = (size_t)b * SEQ + t;
            float psum0 = 0.f, psum1 = 0.f;
            for (int i = 0; i < 4; ++i) {
                const int hd = g * 4 + i;
                const float slope = exp2f(-((float)hd + 0.5f));
                qs[lane] = bf2f(p.Qb[n * 512 + hd * 64 + lane]);
                __builtin_amdgcn_wave_barrier();
                float s0 = NEGF, s1 = NEGF;
                const int c0 = lane, c1 = lane + 64;
                const bool v0 = (16 * c0 + 31 <= t), v1 = (c1 < 127) && (16 * c1 + 31 <= t);
                if (v0) { float d = 0.f; for (int k = 0; k < 64; ++k) d += qs[k] * kc[c0 * 65 + k]; s0 = d * 0.125f - slope * (float)(t - (16 * c0 + 31)); }
                if (v1) { float d = 0.f; for (int k = 0; k < 64; ++k) d += qs[k] * kc[c1 * 65 + k]; s1 = d * 0.125f - slope * (float)(t - (16 * c1 + 31)); }
                const float m = wave_max(fmaxf(s0, s1));
                float p0 = v0 ? __expf(s0 - m) : 0.f, p1 = v1 ? __expf(s1 - m) : 0.f;
                const float den = fmaxf(wave_sum(p0 + p1), 1e-30f);
                p0 /= den; p1 /= den;
                psum0 += p0; psum1 += p1;
                ps[c0] = p0; ps[c1] = p1;
                __builtin_amdgcn_wave_barrier();
                float o = 0.f;
                for (int c = 0; c < 127; ++c) o += ps[c] * vc[c * 64 + lane];
                p.OC[n * 512 + hd * 64 + lane] = o;
                __builtin_amdgcn_wave_barrier();
            }
            pp[lane] = psum0; pp[lane + 64] = psum1;
            __builtin_amdgcn_wave_barrier();
            const int j = lane & 31, own = t >> 6;
            float imp = 0.f;
#pragma unroll
            for (int c = 4 * j - 1; c <= 4 * j + 3; ++c) if (c >= 0 && c < 127) imp += pp[c];
            const bool forced = (j == 0) || (j == own) || (j == own - 1);
            const bool valid = j <= own;
            const float val = valid ? (imp + (forced ? 1e4f : 0.f)) : NEGF;
            int rank = 0;
            for (int j2 = 0; j2 < 32; ++j2) { const float o2 = __shfl(val, j2); rank += (o2 > val || (o2 == val && j2 < j)) ? 1 : 0; }
            const unsigned long long bal = __ballot(valid && rank < 16 && lane < 32);
            if (lane == 0) p.SELM[(size_t)bg * SEQ + t] = (unsigned)bal;
            __builtin_amdgcn_wave_barrier();
        }
    }
}
struct AttnState { float m, l, o; };
__device__ __forceinline__ void attn_block(AttnState& st, const float* qs, float* ps, const float* Kb, const float* Vb, int s0, int t, float slope, bool lanevalid) {
    const int lane = tidx() & 63;
    float sc = NEGF;
    if (lanevalid) {
        const float* kr = Kb + (size_t)lane * ODD_IN;
        float d = 0.f;
#pragma unroll
        for (int k = 0; k < 64; k += 4) { const f32x4 kv = *(const f32x4*)(kr + k); d += kv[0] * qs[k] + kv[1] * qs[k + 1] + kv[2] * qs[k + 2] + kv[3] * qs[k + 3]; }
        sc = d * 0.125f - slope * (float)(t - (s0 + lane));
    }
    const float mn = fmaxf(st.m, wave_max(sc));
    const float pr = lanevalid ? __expf(sc - mn) : 0.f;
    const float corr = __expf(st.m - mn);
    st.l = st.l * corr + wave_sum(pr);
    __builtin_amdgcn_wave_barrier();
    ps[lane] = pr;
    __builtin_amdgcn_wave_barrier();
    float acc = 0.f;
    for (int s = 0; s < 64; ++s) acc += ps[s] * Vb[(size_t)s * ODD_IN + lane];
    st.o = st.o * corr + acc; st.m = mn;
    __builtin_amdgcn_wave_barrier();
}
__device__ __forceinline__ void phase_nsa_attn(char* lds, int bid, int nb, const P& p) {
    const int tid = tidx(), lane = tid & 63, wid = tid >> 6;
    float* qs = (float*)lds + wid * 128; float* ps = qs + 64;
    for (int it = bid * 4 + wid; it < NTOK * 8; it += nb * 4) {
        const int hd = it & 7; const int n = it >> 3; const int b = n >> 11, t = n & (SEQ - 1), g = hd >> 2;
        const float slope = exp2f(-((float)hd + 0.5f));
        __builtin_amdgcn_wave_barrier();
        qs[lane] = p.U[(size_t)n * ODD_IN + hd * 64 + lane];
        __builtin_amdgcn_wave_barrier();
        const unsigned mask = p.SELM[(size_t)(b * 2 + g) * SEQ + t];
        const int own = t >> 6;
        AttnState ss; ss.m = NEGF; ss.l = 0.f; ss.o = 0.f;
        for (int j = 0; j <= own; ++j) if ((mask >> j) & 1u) {
            const float* base = p.U + (size_t)(b * SEQ + j * 64) * ODD_IN + g * 64;
            attn_block(ss, qs, ps, base + 768, base + 896, j * 64, t, slope, (j * 64 + lane) <= t);
        }
        AttnState sw; sw.m = NEGF; sw.l = 0.f; sw.o = 0.f;
        const int jb0 = (t >= 511) ? ((t - 511) >> 6) : 0;
        for (int j = jb0; j <= own; ++j) {
            const float* base = p.U + (size_t)(b * SEQ + j * 64) * ODD_IN + g * 64;
            const int s = j * 64 + lane;
            attn_block(sw, qs, ps, base + 1024, base + 1152, j * 64, t, slope, (s <= t) && (t - s < 512));
        }
        const float os = ss.o / fmaxf(ss.l, 1e-30f), ow = sw.o / fmaxf(sw.l, 1e-30f);
        const float oc = p.OC[(size_t)n * 512 + hd * 64 + lane];
        const float* gp = p.U + (size_t)n * ODD_IN + 1280 + hd * 3;
        const float y = sigmoidf_(gp[0]) * oc + sigmoidf_(gp[1]) * os + sigmoidf_(gp[2]) * ow;
        p.MIX[(size_t)n * DM + hd * 64 + lane] = (bf16_t)f2bf(y);
    }
}
__device__ __forceinline__ void phase_moba_attn(char* lds, int bid, int nb, const P& p) {
    const int tid = tidx(), lane = tid & 63, wid = tid >> 6;
    float* qs = (float*)lds + wid * 128; float* ps = qs + 64;
    for (int it = bid * 4 + wid; it < NTOK * 8; it += nb * 4) {
        const int hd = it & 7; const int n = it >> 3; const int b = n >> 11, t = n & (SEQ - 1);
        const float slope = exp2f(-((float)hd + 1.0f));
        const float qv = p.U[(size_t)n * ODD_IN + 1304 + hd * 64 + lane];
        __builtin_amdgcn_wave_barrier();
        qs[lane] = qv;
        __builtin_amdgcn_wave_barrier();
        const int ob = t >> 8;
        float gate[8];
#pragma unroll
        for (int j = 0; j < 8; ++j) gate[j] = (j < ob) ? wave_sum(qv * p.KM[((size_t)(b * 8 + hd) * 8 + j) * 64 + lane]) : NEGF;
        unsigned selm = 0;
#pragma unroll
        for (int j = 0; j < 8; ++j) {
            int rank = 0;
#pragma unroll
            for (int j2 = 0; j2 < 8; ++j2) rank += (gate[j2] > gate[j] || (gate[j2] == gate[j] && j2 < j)) ? 1 : 0;
            if (j < ob && rank < 3) selm |= 1u << j;
        }
        AttnState st; st.m = NEGF; st.l = 0.f; st.o = 0.f;
        for (int j = 0; j < ob; ++j) if ((selm >> j) & 1u) {
            for (int sb = 0; sb < 4; ++sb) {
                const float* base = p.U + (size_t)(b * SEQ + j * 256 + sb * 64) * ODD_IN + hd * 64;
                attn_block(st, qs, ps, base + 1816, base + 2328, j * 256 + sb * 64, t, slope, true);
            }
        }
        for (int sb = 0; sb <= ((t & 255) >> 6); ++sb) {
            const float* base = p.U + (size_t)(b * SEQ + ob * 256 + sb * 64) * ODD_IN + hd * 64;
            attn_block(st, qs, ps, base + 1816, base + 2328, ob * 256 + sb * 64, t, slope, (ob * 256 + sb * 64 + lane) <= t);
        }
        p.MIX[(size_t)n * DM + 512 + hd * 64 + lane] = (bf16_t)f2bf(st.o / fmaxf(st.l, 1e-30f));
    }
}


__device__ __forceinline__ void phase_inproj0(char* lds, int bid, int nb, const P& p) {
    const int ntn = 24, ntm = NTOK / 128, nk1 = DM / 64;
    const int tid = tidx(), lane = tid & 63, wid = tid >> 6, wr = wid >> 1, wc = wid & 1, fr = lane & 15, fq = lane >> 4;
    for (int i = bid * 256 + tid; i < 2 * 8 * 64 * 64; i += nb * 256) {
        const int which = i >> 15, e = i & 32767, h = e >> 12, j = (e >> 6) & 63, ii = e & 63;
        const float v = (which ? p.wx : p.wa)[(h * 64 + ii) * 64 + j];
        (which ? p.WXT : p.WAT)[e] = (bf16_t)f2bf(v);
    }
    for (int u = bid; u < ntm * ntn; u += nb) {
        const int tm = u / ntn, tn = u % ntn;
        BLoadF32 bl; { const int nq = tid & 31, kg = tid >> 5; bl.valid = true; bl.ldb = EVEN_IN; bl.nk1 = 1 << 30; bl.bp = p.even_w_in + (size_t)(kg * 8) * EVEN_IN + tn * 128 + nq * 4; }
        ALoadF32S al; al.nk1 = 1 << 30; al.rs32 = (size_t)32 * DM;
        al.rp0 = p.x + (size_t)(tm * 128 + (tid >> 3)) * DM + (tid & 7) * 8;
        f32x4 acc[4][4];
        const bool tr = (tn >= 16 && tn < 20);
        gemm_tile(lds, al, bl, nk1, acc, tr);
        if (tr) {
#pragma unroll
            for (int m = 0; m < 4; ++m)
#pragma unroll
                for (int n = 0; n < 4; ++n) {
                    const int r0 = tm * 128 + wr * 64 + n * 16 + fq * 4, vc = (tn - 16) * 128 + wc * 64 + m * 16 + fr;
                    const int b = r0 >> 11, t0 = r0 & (SEQ - 1);
                    const f32x4 a = acc[m][n];
                    u32x2 w; w.x = pack2(a[0], a[1]); w.y = pack2(a[2], a[3]);
                    *(u32x2*)(p.VHt + ((size_t)(b * 512 + vc)) * SEQ + t0) = w;
                }
        } else {
            const int cbase = (tn < 16) ? tn * 128 : 2048 + (tn - 20) * 128;
#pragma unroll
            for (int m = 0; m < 4; ++m)
#pragma unroll
                for (int n = 0; n < 4; ++n) {
                    const int row = tm * 128 + wr * 64 + m * 16 + fr, col = cbase + wc * 64 + n * 16 + fq * 4;
                    const f32x4 a = acc[m][n];
                    u32x2 w; w.x = pack2(a[0], a[1]); w.y = pack2(a[2], a[3]);
                    *(u32x2*)(p.UB0 + (size_t)row * 2560 + col) = w;
                }
        }
    }
}

__device__ __forceinline__ int lds_off128(int r, int c) {
    const int st = (r >> 4) * 4 + (c >> 5), ob = (r & 15) * 64 + (c & 31) * 2;
    return st * 1024 + (ob ^ (((ob >> 9) & 1) << 5));
}
__device__ __forceinline__ float softplusf_(float x) { return fmaxf(x, 0.f) + log1pf(__expf(-fabsf(x))); }

#define LRU1_LDS (4 * 8192)
__device__ __forceinline__ void lru1_unit(char* lds, const P& p, int b, int ck) {
    const int tid = tidx(), lane = tid & 63, w = tid >> 6, fr = lane & 15, fg = lane >> 4;
    char* xt = lds + w * 8192;
    const size_t n0 = (size_t)b * SEQ + ck * 64;
    __syncthreads();
    for (int hh = 0; hh < 2; ++hh) {
        const int h = w * 2 + hh, c = h * 64 + lane;
        const float cw0 = p.conv_w[c], cw1 = p.conv_w[512 + c], cw2 = p.conv_w[1024 + c], cw3 = p.conv_w[1536 + c], cb = p.conv_b[c];
        float xm3 = 0.f, xm2 = 0.f, xm1 = 0.f;
        if (ck > 0) { xm3 = bf2f(p.UB0[(n0 - 3) * 2560 + c]); xm2 = bf2f(p.UB0[(n0 - 2) * 2560 + c]); xm1 = bf2f(p.UB0[(n0 - 1) * 2560 + c]); }
        __builtin_amdgcn_wave_barrier();
#pragma unroll 8
        for (int t = 0; t < 64; ++t) {
            const float x = bf2f(p.UB0[(n0 + t) * 2560 + c]);
            const float xc = cb + cw0 * xm3 + cw1 * xm2 + cw2 * xm1 + cw3 * x;
            xm3 = xm2; xm2 = xm1; xm1 = x;
            *(bf16_t*)(xt + lds_off(t, lane & ~7) + (lane & 7) * 2) = (bf16_t)f2bf(xc);
        }
        __builtin_amdgcn_wave_barrier();
        for (int jt = 0; jt < 4; ++jt) {
            const int cj = h * 64 + jt * 16 + fr;
            bf16x8 wra[2], wri[2];
#pragma unroll
            for (int ks = 0; ks < 2; ++ks) {
                wra[ks] = *(const bf16x8*)(p.WAT + (size_t)(h * 64 + jt * 16 + fr) * 64 + ks * 32 + fg * 8);
                wri[ks] = *(const bf16x8*)(p.WXT + (size_t)(h * 64 + jt * 16 + fr) * 64 + ks * 32 + fg * 8);
            }
            const float bav = p.ba[cj], bxv = p.bx[cj], sp = softplusf_(-p.lam[cj]);
            float mA = 1.f, mB = 0.f;
#pragma unroll
            for (int tt = 0; tt < 4; ++tt) {
                const bf16x8 a0 = *(const bf16x8*)(xt + lds_off(tt * 16 + fr, fg * 8)), a1 = *(const bf16x8*)(xt + lds_off(tt * 16 + fr, 32 + fg * 8));
                f32x4 ar = __builtin_amdgcn_mfma_f32_16x16x32_bf16(a0, wra[0], (f32x4){0.f, 0.f, 0.f, 0.f}, 0, 0, 0);
                ar = __builtin_amdgcn_mfma_f32_16x16x32_bf16(a1, wra[1], ar, 0, 0, 0);
                f32x4 ai = __builtin_amdgcn_mfma_f32_16x16x32_bf16(a0, wri[0], (f32x4){0.f, 0.f, 0.f, 0.f}, 0, 0, 0);
                ai = __builtin_amdgcn_mfma_f32_16x16x32_bf16(a1, wri[1], ai, 0, 0, 0);
                float sA = 1.f, sB = 0.f;
#pragma unroll
                for (int r = 0; r < 4; ++r) {
                    const int t = tt * 16 + fg * 4 + r;
                    const float rg = sigmoidf_(ar[r] + bav), ig = sigmoidf_(ai[r] + bxv);
                    const float log_a = -8.0f * rg * sp;
                    const float a = __expf(log_a);
                    const float mult = (ck == 0 && t == 0) ? 1.0f : sqrtf(-expm1f(2.0f * log_a));
                    const int jj = jt * 16 + fr;
                    const float xcv = bf2f(*(const bf16_t*)(xt + lds_off(t, jj & ~7) + (jj & 7) * 2));
                    const float bt = mult * ig * xcv;
                    p.LA[(n0 + t) * 512 + cj] = a; p.LB[(n0 + t) * 512 + cj] = bt;
                    sB = a * sB + bt; sA = a * sA;
                }
                float tA = 1.f, tB = 0.f;
#pragma unroll
                for (int g2 = 0; g2 < 4; ++g2) {
                    const float oA = __shfl(sA, g2 * 16 + fr), oB = __shfl(sB, g2 * 16 + fr);
                    tB = oA * tB + oB; tA = oA * tA;
                }
                mB = tA * mB + tB; mA = tA * mA;
            }
            if (fg == 0) { p.CSA[((size_t)b * 32 + ck) * 512 + cj] = mA; p.CSB[((size_t)b * 32 + ck) * 512 + cj] = mB; }
        }
        __builtin_amdgcn_wave_barrier();
    }
}
__device__ __forceinline__ void lru2_unit(const P& p, int b, int ck) {
    const int tid = tidx();
    const size_t n0 = (size_t)b * SEQ + ck * 64;
#pragma unroll
    for (int cc = 0; cc < 2; ++cc) {
        const int c = tid + 256 * cc;
        float h = 0.f;
        for (int c2 = 0; c2 < ck; ++c2) h = p.CSA[((size_t)b * 32 + c2) * 512 + c] * h + p.CSB[((size_t)b * 32 + c2) * 512 + c];
        for (int t8 = 0; t8 < 64; t8 += 8) {
            float la[8], lb[8], gb[8];
#pragma unroll
            for (int i = 0; i < 8; ++i) { la[i] = p.LA[(n0 + t8 + i) * 512 + c]; lb[i] = p.LB[(n0 + t8 + i) * 512 + c]; gb[i] = bf2f(p.UB0[(n0 + t8 + i) * 2560 + 512 + c]); }
#pragma unroll
            for (int i = 0; i < 8; ++i) { h = la[i] * h + lb[i]; p.MIX[(n0 + t8 + i) * DM + c] = (bf16_t)f2bf(h * gelu_tanh(gb[i])); }
        }
    }
}

#define HG1_LDS (2 * 16384)
__device__ __forceinline__ float hg_lb(const P& p, int ch) {
    const float l0 = p.hg_lb[ch], l1 = p.hg_lb[512 + ch], l2 = p.hg_lb[1024 + ch]; const float mx = fmaxf(l0, fmaxf(l1, l2));
    const float e0 = __expf(l0 - mx), e1 = __expf(l1 - mx), e2 = __expf(l2 - mx); return e0 / (e0 + e1 + e2);
}
__device__ __forceinline__ void hg1_unit(char* lds, const P& p, int b, int h, int ck) {
    const int tid = tidx(), lane = tid & 63, w = tid >> 6, fr = lane & 15, fg = lane >> 4;
    char* kh = lds;
    char* vt = lds + 16384;
    const size_t n0 = (size_t)b * SEQ + ck * 64;
    const int bhc = (b * 4 + h) * 32 + ck;
    __syncthreads();
    if (tid < 128) {
        const int k = tid, ch = h * 128 + k;
        const float lbv = hg_lb(p, ch);
        float cl = 0.f;
        for (int t = 0; t < 64; ++t) { const float f = lbv + (1.0f - lbv) * sigmoidf_(bf2f(p.UB0[(n0 + t) * 2560 + 1536 + ch])); cl += __logf(f); }
        p.DV[(size_t)bhc * 128 + k] = __expf(cl);
        float cum = 0.f;
        for (int t8 = 0; t8 < 64; t8 += 8) {
            float kv[8];
#pragma unroll
            for (int i = 0; i < 8; ++i) { const float f = lbv + (1.0f - lbv) * sigmoidf_(bf2f(p.UB0[(n0 + t8 + i) * 2560 + 1536 + ch])); cum += __logf(f); kv[i] = (1.0f - f) * __expf(cl - cum); }
            u32x4 wv; wv.x = pack2(kv[0], kv[1]); wv.y = pack2(kv[2], kv[3]); wv.z = pack2(kv[4], kv[5]); wv.w = pack2(kv[6], kv[7]);
            *(u32x4*)(kh + lds_off(k, t8)) = wv;
        }
    } else {
        const int q = tid - 128;
#pragma unroll
        for (int i = 0; i < 8; ++i) { const int pc = q + 128 * i, v = pc >> 3, c8 = pc & 7;
            *(u32x4*)(vt + lds_off(v, c8 * 8)) = *(const u32x4*)(p.VHt + ((size_t)(b * 512 + h * 128 + v)) * SEQ + ck * 64 + c8 * 8); }
    }
    __syncthreads();
    bf16_t* ut = p.UT + (size_t)bhc * 16384;
#pragma unroll
    for (int kk = 0; kk < 2; ++kk) {
        const int kt = w * 2 + kk;
        const bf16x8 a0 = *(const bf16x8*)(kh + lds_off(kt * 16 + fr, fg * 8)), a1 = *(const bf16x8*)(kh + lds_off(kt * 16 + fr, 32 + fg * 8));
#pragma unroll
        for (int v8 = 0; v8 < 8; ++v8) {
            const bf16x8 b0 = *(const bf16x8*)(vt + lds_off(v8 * 16 + fr, fg * 8)), b1 = *(const bf16x8*)(vt + lds_off(v8 * 16 + fr, 32 + fg * 8));
            f32x4 acc = __builtin_amdgcn_mfma_f32_16x16x32_bf16(a0, b0, (f32x4){0.f, 0.f, 0.f, 0.f}, 0, 0, 0);
            acc = __builtin_amdgcn_mfma_f32_16x16x32_bf16(a1, b1, acc, 0, 0, 0);
            u32x2 wv; wv.x = pack2(acc[0], acc[1]); wv.y = pack2(acc[2], acc[3]);
            *(u32x2*)(ut + (size_t)(v8 * 16 + fr) * 128 + kt * 16 + fg * 4) = wv;
        }
    }
}
__device__ __forceinline__ void phase_hg2(int bid, int nb, const P& p) {
    for (int it = bid * 256 + tidx(); it < 32 * 4096; it += nb * 256) {
        const int bh = it >> 12, e4 = (it & 4095) * 4, k4 = e4 & 127;
        float S0 = 0.f, S1 = 0.f, S2 = 0.f, S3 = 0.f;
#pragma unroll 4
        for (int c = 0; c < 32; ++c) {
            const size_t o = ((size_t)(bh * 32 + c)) * 16384 + e4;
            u32x2 wv; wv.x = pack2(S0, S1); wv.y = pack2(S2, S3);
            *(u32x2*)(p.SP + o) = wv;
            const u32x2 uv = *(const u32x2*)(p.UT + o);
            const f32x4 dv = *(const f32x4*)(p.DV + (size_t)(bh * 32 + c) * 128 + k4);
            S0 = dv[0] * S0 + bf2f(uv.x & 0xffffu); S1 = dv[1] * S1 + bf2f(uv.x >> 16);
            S2 = dv[2] * S2 + bf2f(uv.y & 0xffffu); S3 = dv[3] * S3 + bf2f(uv.y >> 16);
        }
    }
}
#define HG3_QP 0
#define HG3_KP 40960
#define HG3_VT (40960 + 16384)
#define HG3_LDS (40960 + 16384 + 128 * 144)
__device__ __forceinline__ int hg3_qp_base(int j) { return j == 0 ? 0 : (j == 1 ? 16384 : (j == 2 ? 28672 : 36864)); }
__device__ __forceinline__ void hg3_unit(char* lds, const P& p, int b, int h, int ck) {
    const int tid = tidx(), lane = tid & 63, w = tid >> 6, fr = lane & 15, fg = lane >> 4;
    char* qp = lds + HG3_QP; char* kp = lds + HG3_KP; char* vt = lds + HG3_VT;
    const size_t n0 = (size_t)b * SEQ + ck * 64;
    const int bhc = (b * 4 + h) * 32 + ck;
    __syncthreads();
    if (tid < 128) {
        const int k = tid, ch = h * 128 + k;
        const float lbv = hg_lb(p, ch);
        const int ke = (k & 7) * 2, k8 = k & ~7;
        float cum = 0.f, r1 = 0.f, r2 = 0.f, r3 = 0.f;
#pragma unroll
        for (int t = 0; t < 64; ++t) {
            const int i = t >> 4;
            const float qv = siluf_(bf2f(p.UB0[(n0 + t) * 2560 + 1024 + ch]));
            const float f = lbv + (1.0f - lbv) * sigmoidf_(bf2f(p.UB0[(n0 + t) * 2560 + 1536 + ch]));
            cum += __logf(f);
            const float ri = (i == 0) ? 0.f : (i == 1 ? r1 : (i == 2 ? r2 : r3));
            *(bf16_t*)(kp + lds_off128(t, k8) + ke) = (bf16_t)f2bf((1.0f - f) * __expf(fminf(ri - cum, 80.0f)));
            *(bf16_t*)(qp + hg3_qp_base(0) + lds_off128(t, k8) + ke) = (bf16_t)f2bf(qv * __expf(cum));
            if (i >= 1) *(bf16_t*)(qp + hg3_qp_base(1) + lds_off128(t - 16, k8) + ke) = (bf16_t)f2bf(qv * __expf(cum - r1));
            if (i >= 2) *(bf16_t*)(qp + hg3_qp_base(2) + lds_off128(t - 32, k8) + ke) = (bf16_t)f2bf(qv * __expf(cum - r2));
            if (i >= 3) *(bf16_t*)(qp + hg3_qp_base(3) + lds_off128(t - 48, k8) + ke) = (bf16_t)f2bf(qv * __expf(cum - r3));
            if (t == 15) r1 = cum; if (t == 31) r2 = cum; if (t == 47) r3 = cum;
        }
    } else {
        const int q = tid - 128;
#pragma unroll
        for (int i = 0; i < 8; ++i) { const int pc = q + 128 * i, v = pc >> 3, c8 = pc & 7;
            *(u32x4*)(vt + v * 144 + c8 * 16) = *(const u32x4*)(p.VHt + ((size_t)(b * 512 + h * 128 + v)) * SEQ + ck * 64 + c8 * 8); }
    }
    __syncthreads();
    f32x4 acc[8];
#pragma unroll
    for (int v8 = 0; v8 < 8; ++v8) acc[v8] = (f32x4){0.f, 0.f, 0.f, 0.f};
    if (ck > 0) {
        const bf16_t* sp = p.SP + (size_t)bhc * 16384;
#pragma unroll
        for (int ks = 0; ks < 4; ++ks) {
            const bf16x8 bq = *(const bf16x8*)(qp + hg3_qp_base(0) + lds_off128(w * 16 + fr, ks * 32 + fg * 8));
#pragma unroll
            for (int v8 = 0; v8 < 8; ++v8) {
                const bf16x8 as = *(const bf16x8*)(sp + (size_t)(v8 * 16 + fr) * 128 + ks * 32 + fg * 8);
                acc[v8] = __builtin_amdgcn_mfma_f32_16x16x32_bf16(as, bq, acc[v8], 0, 0, 0);
            }
        }
    }
#pragma unroll
    for (int jp = 0; jp < 2; ++jp) {
        if (2 * jp > w) continue;
        f32x4 at[2];
#pragma unroll
        for (int jj = 0; jj < 2; ++jj) {
            const int j = 2 * jp + jj;
            at[jj] = (f32x4){0.f, 0.f, 0.f, 0.f};
            if (j <= w) {
#pragma unroll
                for (int ks = 0; ks < 4; ++ks) {
                    const bf16x8 ak = *(const bf16x8*)(kp + lds_off128(j * 16 + fr, ks * 32 + fg * 8));
                    const bf16x8 bq = *(const bf16x8*)(qp + hg3_qp_base(j) + lds_off128((w - j) * 16 + fr, ks * 32 + fg * 8));
                    at[jj] = __builtin_amdgcn_mfma_f32_16x16x32_bf16(ak, bq, at[jj], 0, 0, 0);
                }
                if (j == w) {
#pragma unroll
                    for (int r = 0; r < 4; ++r) at[jj][r] = (fg * 4 + r <= fr) ? at[jj][r] : 0.f;
                }
            }
        }
        u32x4 pw; pw.x = pack2(at[0][0], at[0][1]); pw.y = pack2(at[0][2], at[0][3]); pw.z = pack2(at[1][0], at[1][1]); pw.w = pack2(at[1][2], at[1][3]);
        const bf16x8 pf = __builtin_bit_cast(bf16x8, pw);
#pragma unroll
        for (int v8 = 0; v8 < 8; ++v8) {
            const char* vb = vt + (v8 * 16 + fr) * 144 + (jp * 32 + fg * 4) * 2;
            const u32x2 v0 = *(const u32x2*)vb, v1 = *(const u32x2*)(vb + 32);
            u32x4 vv; vv.x = v0.x; vv.y = v0.y; vv.z = v1.x; vv.w = v1.y;
            acc[v8] = __builtin_amdgcn_mfma_f32_16x16x32_bf16(__builtin_bit_cast(bf16x8, vv), pf, acc[v8], 0, 0, 0);
        }
    }
    float ss = 0.f;
#pragma unroll
    for (int v8 = 0; v8 < 8; ++v8)
#pragma unroll
        for (int r = 0; r < 4; ++r) ss += acc[v8][r] * acc[v8][r];
    ss += __shfl_xor(ss, 16); ss += __shfl_xor(ss, 32);
    const float rs = rsqrtf(ss * (1.0f / 128.0f) + 1e-6f);
    const size_t n = n0 + w * 16 + fr;
#pragma unroll
    for (int v8 = 0; v8 < 8; ++v8) {
        const int vcol = h * 128 + v8 * 16 + fg * 4;
        const u32x2 gv = *(const u32x2*)(p.UB0 + n * 2560 + 2048 + vcol);
        const f32x4 ng = *(const f32x4*)(p.hg_ng + vcol);
        const float y0 = acc[v8][0] * rs * ng[0] * sigmoidf_(bf2f(gv.x & 0xffffu)), y1 = acc[v8][1] * rs * ng[1] * sigmoidf_(bf2f(gv.x >> 16));
        const float y2 = acc[v8][2] * rs * ng[2] * sigmoidf_(bf2f(gv.y & 0xffffu)), y3 = acc[v8][3] * rs * ng[3] * sigmoidf_(bf2f(gv.y >> 16));
        u32x2 wv; wv.x = pack2(y0, y1); wv.y = pack2(y2, y3);
        *(u32x2*)(p.MIX + n * DM + 512 + vcol) = wv;
    }
}
__device__ __forceinline__ void phase_mix0_a(char* lds, int bid, int nb, const P& p) {
    for (int u = bid; u < 256 + 1024; u += nb) {
        if (u < 256) lru1_unit(lds, p, u >> 5, u & 31);
        else { const int v = u - 256; hg1_unit(lds, p, v >> 7, (v >> 5) & 3, v & 31); }
    }
    __syncthreads();
}
__device__ __forceinline__ void phase_mix0_c(char* lds, int bid, int nb, const P& p) {
    for (int u = bid; u < 1024 + 256; u += nb) {
        if (u < 1024) hg3_unit(lds, p, u >> 7, (u >> 5) & 3, u & 31);
        else { const int v = u - 1024; lru2_unit(p, v >> 5, v & 31); }
    }
    __syncthreads();
}

#ifndef KEEP_U
#define KEEP_U 0
#endif
__device__ __forceinline__ int vcol_actual(int v) { return v < 1280 ? v : (v < 2816 ? v + 24 : v - 1536); }
__device__ __forceinline__ void phase_inproj1(char* lds, int bid, int nb, const P& p) {
    const int ntn = 23, ntm = NTOK / 128, nk1 = DM / 64;
    const int tid = tidx(), lane = tid & 63, wid = tid >> 6, wr = wid >> 1, wc = wid & 1, fr = lane & 15, fq = lane >> 4;
    for (int i = bid * 256 + tid; i < 2 * 2048 * 128 / 4; i += nb * 256) *(f32x4*)(p.HID + (size_t)i * 4) = (f32x4){0.f, 0.f, 0.f, 0.f};
    for (int u = bid; u < ntm * ntn; u += nb) {
        const int tm = u / ntn, tn = u % ntn;
        BLoadF32 bl; { const int nq = tid & 31, kg = tid >> 5; const int v = tn * 128 + nq * 4; bl.valid = v < ODD_IN; bl.ldb = ODD_IN; bl.nk1 = 1 << 30;
            bl.bp = p.odd_w_in + (size_t)(kg * 8) * ODD_IN + (bl.valid ? vcol_actual(v) : 0); }
        ALoadBF16S al; al.rs32 = (size_t)32 * DM;
        al.rp0 = p.XBb + (size_t)(tm * 128 + (tid >> 3)) * DM + (tid & 7) * 8;
        f32x4 acc[4][4];
        const bool tr = (tn == 7) || (tn == 9) || (tn >= 18 && tn <= 21);
        gemm_tile(lds, al, bl, nk1, acc, tr);
        if (tr) {
            bf16_t* dst; int c0, ncol;
            if (tn == 7) { dst = p.VSt; c0 = 896; ncol = 128; } else if (tn == 9) { dst = p.VWt; c0 = 1152; ncol = 128; } else { dst = p.MVt; c0 = 2304; ncol = 512; }
#pragma unroll
            for (int m = 0; m < 4; ++m)
#pragma unroll
                for (int n = 0; n < 4; ++n) {
                    const int r0 = tm * 128 + wr * 64 + n * 16 + fq * 4, vc = tn * 128 + wc * 64 + m * 16 + fr;
                    const int b = r0 >> 11, t0 = r0 & (SEQ - 1);
                    const f32x4 a = acc[m][n];
                    u32x2 w; w.x = pack2(a[0], a[1]); w.y = pack2(a[2], a[3]);
                    *(u32x2*)(dst + ((size_t)(b * ncol + vc - c0)) * SEQ + t0) = w;
#if KEEP_U
                    for (int j = 0; j < 4; ++j) p.U[(size_t)(r0 + j) * ODD_IN + vcol_actual(vc)] = a[j];
#endif
                }
        } else {
#pragma unroll
            for (int m = 0; m < 4; ++m)
#pragma unroll
                for (int n = 0; n < 4; ++n) {
                    const int row = tm * 128 + wr * 64 + m * 16 + fr, vc = tn * 128 + wc * 64 + n * 16 + fq * 4;
                    const f32x4 a = acc[m][n];
                    u32x2 w; w.x = pack2(a[0], a[1]); w.y = pack2(a[2], a[3]);
                    if (tn < 4) *(u32x2*)(p.Qb + (size_t)row * 512 + vc) = w;
                    else if (tn < 6) *(f32x4*)(p.KCV + (size_t)row * 256 + vc - 512) = a;
                    else if (tn == 6) *(u32x2*)(p.KS + (size_t)row * 128 + vc - 768) = w;
                    else if (tn == 8) *(u32x2*)(p.KW + (size_t)row * 128 + vc - 1024) = w;
                    else if (tn < 14) *(u32x2*)(p.MQ + (size_t)row * 512 + vc - 1280) = w;
                    else if (tn < 18) *(u32x2*)(p.MK + (size_t)row * 512 + vc - 1792) = w;
                    else if (vc < ODD_IN) *(f32x4*)(p.GATES + (size_t)row * 24 + vc - 2816) = a;
#if KEEP_U
                    if (vc < ODD_IN) *(f32x4*)(p.U + (size_t)row * ODD_IN + vcol_actual(vc)) = a;
#endif
                }
        }
    }
}
__device__ __forceinline__ void phase_moba_gate(int bid, int nb, const P& p) {
    const int lane = tidx() & 63, wid = tidx() >> 6;
    for (int it = bid * 4 + wid; it < NTOK * 8; it += nb * 4) {
        const int hd = it & 7; const int n = it >> 3; const int b = n >> 11, t = n & (SEQ - 1);
        const float qv = bf2f(p.MQ[(size_t)n * 512 + hd * 64 + lane]);
        const int ob = t >> 8;
        float gate[8];
#pragma unroll
        for (int j = 0; j < 8; ++j) gate[j] = (j < ob) ? wave_sum(qv * p.KM[((size_t)(b * 8 + hd) * 8 + j) * 64 + lane]) : NEGF;
        unsigned selm = 0;
#pragma unroll
        for (int j = 0; j < 8; ++j) {
            int rank = 0;
#pragma unroll
            for (int j2 = 0; j2 < 8; ++j2) rank += (gate[j2] > gate[j] || (gate[j2] == gate[j] && j2 < j)) ? 1 : 0;
            if (j < ob && rank < 3) selm |= 1u << j;
        }
        if (lane == 0) p.MSEL[(size_t)(b * 8 + hd) * SEQ + t] = selm;
    }
}

#define ATT_K_BYTES 8192
#define ATT_V_STRIDE 144
#define ATT_TILE_BYTES (ATT_K_BYTES + 64 * ATT_V_STRIDE)
#define ATT_ORDER_OFF ATT_TILE_BYTES
#define ATT_RED_OFF (ATT_ORDER_OFF + 8192)
struct TileRegs { u32x4 k[2], v[2]; };
__device__ __forceinline__ void att_load_tile(TileRegs& R, const bf16_t* Kg, int ldk, const bf16_t* Vg) {
#pragma unroll
    for (int i = 0; i < 2; ++i) { const int pc = tidx() + 256 * i, row = pc >> 3, ch = pc & 7;
        R.k[i] = *(const u32x4*)(Kg + (size_t)row * ldk + ch * 8); R.v[i] = *(const u32x4*)(Vg + (size_t)row * SEQ + ch * 8); }
}
__device__ __forceinline__ void att_store_tile(const TileRegs& R, char* lds) {
#pragma unroll
    for (int i = 0; i < 2; ++i) { const int pc = tidx() + 256 * i, row = pc >> 3, ch = pc & 7;
        *(u32x4*)(lds + lds_off(row, ch * 8)) = R.k[i]; *(u32x4*)(lds + ATT_K_BYTES + row * ATT_V_STRIDE + ch * 16) = R.v[i]; }
}
struct AttState { f32x4 O[4][2]; float m[2], l[2]; };
__device__ __forceinline__ void att_reset(AttState& S) {
#pragma unroll
    for (int q = 0; q < 2; ++q) { S.m[q] = NEGF; S.l[q] = 0.f;
#pragma unroll
        for (int d = 0; d < 4; ++d) S.O[d][q] = (f32x4){0.f, 0.f, 0.f, 0.f}; }
}
template <bool MASKED>
__device__ __forceinline__ void att_step(const char* lds, const bf16x8 (&qf)[2][2], AttState& S, float c1, float slope2,
                                         int s0, int tq0, unsigned selbits  , int winlimit) {
    const int lane = tidx() & 63, fr = lane & 15, fg = lane >> 4;
    const char* ldsV = lds + ATT_K_BYTES;
    const float offbase = slope2 * (float)s0;
    const float cbase = slope2 * (float)(fg * 4);
    f32x4 s[2][4];
#pragma unroll
    for (int kt = 0; kt < 4; ++kt) {
        const bf16x8 k0 = *(const bf16x8*)(lds + lds_off(kt * 16 + fr, fg * 8)), k1 = *(const bf16x8*)(lds + lds_off(kt * 16 + fr, 32 + fg * 8));
#pragma unroll
        for (int qt = 0; qt < 2; ++qt) {
            s[qt][kt] = __builtin_amdgcn_mfma_f32_16x16x32_bf16(k0, qf[qt][0], (f32x4){0.f, 0.f, 0.f, 0.f}, 0, 0, 0);
            s[qt][kt] = __builtin_amdgcn_mfma_f32_16x16x32_bf16(k1, qf[qt][1], s[qt][kt], 0, 0, 0);
        }
    }
    __builtin_amdgcn_sched_barrier(0);
    u32x4 pf[2][2];
#pragma unroll
    for (int qt = 0; qt < 2; ++qt) {
        const int tq = tq0 + qt * 16 + fr;
        const float off = ((selbits >> qt) & 1u) ? (offbase - slope2 * (float)tq) : -INFINITY;
        float mx = -INFINITY;
#pragma unroll
        for (int kt = 0; kt < 4; ++kt)
#pragma unroll
            for (int r = 0; r < 4; ++r) {
                float y = fmaf(s[qt][kt][r], c1, fmaf(slope2, (float)(kt * 16 + r), cbase));
                if (MASKED) { const int key = s0 + kt * 16 + fg * 4 + r; const bool ok = (key <= tq) && (tq - key < winlimit); y = ok ? y : -INFINITY; }
                s[qt][kt][r] = y; mx = fmaxf(mx, y);
            }
        mx = fmaxf(mx, __shfl_xor(mx, 16)); mx = fmaxf(mx, __shfl_xor(mx, 32));
        const float mnew = fmaxf(S.m[qt], mx + off);
        const float alpha = __builtin_amdgcn_exp2f(S.m[qt] - mnew);
        S.m[qt] = mnew;
        const float thr = mnew - off;
        float ls = 0.f;
#pragma unroll
        for (int kt = 0; kt < 4; ++kt)
#pragma unroll
            for (int r = 0; r < 4; ++r) { const float pr = __builtin_amdgcn_exp2f(s[qt][kt][r] - thr); s[qt][kt][r] = pr; ls += pr; }
        S.l[qt] = S.l[qt] * alpha + ls;
#pragma unroll
        for (int dt = 0; dt < 4; ++dt) S.O[dt][qt] *= alpha;
#pragma unroll
        for (int kk = 0; kk < 2; ++kk) {
            pf[qt][kk].x = pack2(s[qt][2 * kk][0], s[qt][2 * kk][1]); pf[qt][kk].y = pack2(s[qt][2 * kk][2], s[qt][2 * kk][3]);
            pf[qt][kk].z = pack2(s[qt][2 * kk + 1][0], s[qt][2 * kk + 1][1]); pf[qt][kk].w = pack2(s[qt][2 * kk + 1][2], s[qt][2 * kk + 1][3]);
        }
    }
    __builtin_amdgcn_sched_barrier(0);
#pragma unroll
    for (int kk = 0; kk < 2; ++kk)
#pragma unroll
        for (int dt = 0; dt < 4; ++dt) {
            const char* vb = ldsV + (dt * 16 + fr) * ATT_V_STRIDE + (kk * 32 + fg * 4) * 2;
            const u32x2 v0 = *(const u32x2*)vb, v1 = *(const u32x2*)(vb + 32);
            u32x4 vv; vv.x = v0.x; vv.y = v0.y; vv.z = v1.x; vv.w = v1.y;
            const bf16x8 vf = __builtin_bit_cast(bf16x8, vv);
#pragma unroll
            for (int qt = 0; qt < 2; ++qt) S.O[dt][qt] = __builtin_amdgcn_mfma_f32_16x16x32_bf16(vf, __builtin_bit_cast(bf16x8, pf[qt][kk]), S.O[dt][qt], 0, 0, 0);
        }
    __builtin_amdgcn_sched_barrier(0);
}
__device__ __forceinline__ unsigned wave_or(unsigned v) {
#pragma unroll
    for (int o = 32; o >= 1; o >>= 1) v |= (unsigned)__shfl_xor((int)v, o);
    return v;
}
__device__ __forceinline__ void att_nsa_unit(char* lds, const P& p, int b, int g, int qtile) {
    const int tid = tidx(), lane = tid & 63, w = tid >> 6, fr = lane & 15, fg = lane >> 4;
    const int hd = g * 4 + w, t0 = qtile * 32, own = qtile >> 1;
    const float slope2 = exp2f(-((float)hd + 0.5f)) * LOG2E, c1 = 0.125f * LOG2E;
    bf16x8 qf[2][2];
#pragma unroll
    for (int qt = 0; qt < 2; ++qt)
#pragma unroll
        for (int ks = 0; ks < 2; ++ks) qf[qt][ks] = *(const bf16x8*)(p.Qb + (size_t)(b * SEQ + t0 + qt * 16 + fr) * 512 + hd * 64 + ks * 32 + fg * 8);
    unsigned selw[2];
#pragma unroll
    for (int qt = 0; qt < 2; ++qt) selw[qt] = p.SELM[(size_t)(b * 2 + g) * SEQ + t0 + qt * 16 + fr];
    const unsigned um = wave_or(selw[0] | selw[1]);
    AttState S; att_reset(S);
    unsigned rem = um & ((own >= 31) ? 0xffffffffu : ((2u << own) - 1u));
    int wj = own >= 8 ? own - 8 : 0;
    int cbr, cj, nbr = 0, nj = 0; bool has = true, hasn;
    if (rem) { cj = __ffs(rem) - 1; rem &= rem - 1; cbr = 0; } else { cj = wj++; cbr = 1; }
    const bf16_t* Ks = p.KS + (size_t)b * SEQ * 128 + g * 64; const bf16_t* Kw = p.KW + (size_t)b * SEQ * 128 + g * 64;
    const bf16_t* Vs = p.VSt + (size_t)(b * 128 + g * 64) * SEQ; const bf16_t* Vw = p.VWt + (size_t)(b * 128 + g * 64) * SEQ;
    TileRegs R;
    att_load_tile(R, (cbr ? Kw : Ks) + (size_t)cj * 64 * 128, 128, (cbr ? Vw : Vs) + cj * 64);
    bool switched = false;
    while (has) {
        __syncthreads();
        att_store_tile(R, lds);
        __syncthreads();
        if (rem) { nj = __ffs(rem) - 1; rem &= rem - 1; nbr = 0; hasn = true; } else if (wj <= own) { nj = wj++; nbr = 1; hasn = true; } else hasn = false;
        if (hasn) att_load_tile(R, (nbr ? Kw : Ks) + (size_t)nj * 64 * 128, 128, (nbr ? Vw : Vs) + nj * 64);
        if (cbr == 1 && !switched) {
            switched = true;
#pragma unroll
            for (int qt = 0; qt < 2; ++qt) {
                float lt = S.l[qt]; lt += __shfl_xor(lt, 16); lt += __shfl_xor(lt, 32);
                const size_t n = (size_t)b * SEQ + t0 + qt * 16 + fr;
                const float sc = sigmoidf_(p.GATES[n * 24 + hd * 3 + 1]) / fmaxf(lt, 1e-30f);
#pragma unroll
                for (int dt = 0; dt < 4; ++dt) *(f32x4*)(p.OS + n * 512 + hd * 64 + dt * 16 + fg * 4) = S.O[dt][qt] * sc;
            }
            att_reset(S);
        }
        unsigned sb = 3u; int wl = 1 << 30; bool msk;
        if (cbr == 0) { sb = ((selw[0] >> cj) & 1u) | (((selw[1] >> cj) & 1u) << 1); msk = (cj == own); }
        else { wl = 512; msk = (cj == own) || (cj + 8 == own); }
        if (msk) att_step<true>(lds, qf, S, c1, slope2, cj * 64, t0, sb, wl);
        else att_step<false>(lds, qf, S, c1, slope2, cj * 64, t0, sb, wl);
        cbr = nbr; cj = nj; has = hasn;
    }
#pragma unroll
    for (int qt = 0; qt < 2; ++qt) {
        float lt = S.l[qt]; lt += __shfl_xor(lt, 16); lt += __shfl_xor(lt, 32);
        const size_t n = (size_t)b * SEQ + t0 + qt * 16 + fr;
        const float sc = sigmoidf_(p.GATES[n * 24 + hd * 3 + 2]) / fmaxf(lt, 1e-30f);
        const float g0 = sigmoidf_(p.GATES[n * 24 + hd * 3 + 0]);
#pragma unroll
        for (int dt = 0; dt < 4; ++dt) {
            const size_t o = n * 512 + hd * 64 + dt * 16 + fg * 4;
            const f32x4 y = S.O[dt][qt] * sc + *(const f32x4*)(p.OS + o) + *(const f32x4*)(p.OC + o) * g0;
            u32x2 wv; wv.x = pack2(y[0], y[1]); wv.y = pack2(y[2], y[3]);
            *(u32x2*)(p.MIX + n * DM + hd * 64 + dt * 16 + fg * 4) = wv;
        }
    }
}
__device__ __forceinline__ void att_moba_unit(char* lds, const P& p, int b, int h, int ob, int half) {
    const int tid = tidx(), lane = tid & 63, w = tid >> 6, fr = lane & 15, fg = lane >> 4;
    const int tq0 = ob * 256 + half * 128 + w * 32;
    const int dsub = half * 2 + (w >> 1), lastsub = half * 2 + 1;
    const float slope2 = exp2f(-((float)h + 1.0f)) * LOG2E, c1 = 0.125f * LOG2E;
    bf16x8 qf[2][2];
#pragma unroll
    for (int qt = 0; qt < 2; ++qt)
#pragma unroll
        for (int ks = 0; ks < 2; ++ks) qf[qt][ks] = *(const bf16x8*)(p.MQ + (size_t)(b * SEQ + tq0 + qt * 16 + fr) * 512 + h * 64 + ks * 32 + fg * 8);
    unsigned selw[2];
#pragma unroll
    for (int qt = 0; qt < 2; ++qt) selw[qt] = p.MSEL[(size_t)(b * 8 + h) * SEQ + tq0 + qt * 16 + fr];
    unsigned* red = (unsigned*)(lds + ATT_RED_OFF);
    const unsigned umw = wave_or(selw[0] | selw[1]);
    __syncthreads();
    if (lane == 0) red[w] = umw;
    __syncthreads();
    unsigned rem = (red[0] | red[1] | red[2] | red[3]) & ((1u << ob) - 1u);
    AttState S; att_reset(S);
    int cj, csub = 0, nj = 0, nsub = 0; bool has = true, hasn;
    if (rem) { cj = __ffs(rem) - 1; rem &= rem - 1; } else cj = ob;
    const bf16_t* Kb = p.MK + (size_t)b * SEQ * 512 + h * 64; const bf16_t* Vb = p.MVt + (size_t)(b * 512 + h * 64) * SEQ;
    TileRegs R;
    att_load_tile(R, Kb + (size_t)(cj * 256 + csub * 64) * 512, 512, Vb + cj * 256 + csub * 64);
    while (has) {
        __syncthreads();
        att_store_tile(R, lds);
        __syncthreads();
        if (cj == ob) { if (csub < lastsub) { nj = cj; nsub = csub + 1; hasn = true; } else hasn = false; }
        else if (csub < 3) { nj = cj; nsub = csub + 1; hasn = true; }
        else { if (rem) { nj = __ffs(rem) - 1; rem &= rem - 1; } else nj = ob; nsub = 0; hasn = true; }
        if (hasn) att_load_tile(R, Kb + (size_t)(nj * 256 + nsub * 64) * 512, 512, Vb + nj * 256 + nsub * 64);
        const int s0 = cj * 256 + csub * 64;
        unsigned sb = 3u; bool msk = false, run = true;
        if (cj < ob) sb = ((selw[0] >> cj) & 1u) | (((selw[1] >> cj) & 1u) << 1);
        else { msk = (csub == dsub); run = (csub <= dsub); }
        if (run) {
            if (msk) att_step<true>(lds, qf, S, c1, slope2, s0, tq0, sb, 1 << 30);
            else att_step<false>(lds, qf, S, c1, slope2, s0, tq0, sb, 1 << 30);
        }
        cj = nj; csub = nsub; has = hasn;
    }
#pragma unroll
    for (int qt = 0; qt < 2; ++qt) {
        float lt = S.l[qt]; lt += __shfl_xor(lt, 16); lt += __shfl_xor(lt, 32);
        const size_t n = (size_t)b * SEQ + tq0 + qt * 16 + fr;
        const float sc = 1.0f / fmaxf(lt, 1e-30f);
#pragma unroll
        for (int dt = 0; dt < 4; ++dt) {
            const f32x4 y = S.O[dt][qt] * sc;
            u32x2 wv; wv.x = pack2(y[0], y[1]); wv.y = pack2(y[2], y[3]);
            *(u32x2*)(p.MIX + n * DM + 512 + h * 64 + dt * 16 + fg * 4) = wv;
        }
    }
}
#ifndef ATT_NSA
#define ATT_NSA 1
#endif
#ifndef ATT_MOBA
#define ATT_MOBA 1
#endif
__device__ __forceinline__ int att_class_key(int c) {
    if (c < 64) { const int a = (c >> 1) + 1; return (a < 16 ? a : 16) + (a < 9 ? a : 9); }
    const int ob = (c - 64) >> 1, half = (c - 64) & 1; return 4 * ob + 2 + 2 * half;
}
__device__ __forceinline__ void phase_attn(char* lds, int bid, int nb, const P& p) {
    int* order = (int*)(lds + ATT_ORDER_OFF);
    __syncthreads();
    for (int u = tidx(); u < 2048; u += 256) {
        int c, inst; if (u < 1024) { c = u & 63; inst = u >> 6; } else { c = 64 + ((u - 1024) & 15); inst = (u - 1024) >> 4; }
        const int key = att_class_key(c);
        int pos = inst;
        for (int c2 = 0; c2 < 80; ++c2) { const int k2 = att_class_key(c2); if (k2 > key || (k2 == key && c2 < c)) pos += (c2 < 64) ? 16 : 64; }
        order[pos] = u;
    }
    __syncthreads();
    for (int r = 0;; ++r) {
        const int idx = r * nb + ((r & 1) ? (nb - 1 - bid) : bid);
        if (idx >= 2048) break;
        const int u = order[idx];
        if (u < 1024) {
#if ATT_NSA
            att_nsa_unit(lds, p, u >> 7, (u >> 6) & 1, u & 63);
#endif
        } else {
#if ATT_MOBA
            const int v = u - 1024; att_moba_unit(lds, p, v >> 7, (v >> 4) & 7, (v >> 1) & 7, v & 1);
#endif
        }
    }
    __syncthreads();
}


struct ALoadCmp {
    const float* base;
    const float* pe;
    int kt0;
    struct Regs { f32x4 v[8]; };
    __device__ __forceinline__ void load(int kt, Regs& R) const {
        const int l = kt + kt0;
        const f32x4 p0 = *(const f32x4*)(pe + l * 64), p1 = *(const f32x4*)(pe + l * 64 + 4);
#pragma unroll
        for (int i = 0; i < 4; ++i) {
            const int row = (tidx() + 256 * i) >> 3; int tok = 16 * row + l; tok = tok > SEQ - 1 ? SEQ - 1 : tok;
            const float* q = base + (size_t)tok * 256;
            R.v[2 * i] = *(const f32x4*)q + p0; R.v[2 * i + 1] = *(const f32x4*)(q + 4) + p1;
        }
    }
    __device__ __forceinline__ void store(int kt, const Regs& R, char* lds) const {
#pragma unroll
        for (int i = 0; i < 4; ++i) {
            const int p = tidx() + 256 * i, row = p >> 3, ch = p & 7;
            const f32x4 a = R.v[2 * i], b = R.v[2 * i + 1];
            u32x4 w; w.x = pack2(a[0], a[1]); w.y = pack2(a[2], a[3]); w.z = pack2(b[0], b[1]); w.w = pack2(b[2], b[3]);
            *(u32x4*)(lds + lds_off(row, ch * 8)) = w;
        }
    }
};
__device__ __forceinline__ void phase_cmp1(char* lds, int bid, int nb, const P& p) {
    const int tid = tidx(), lane = tid & 63, wid = tid >> 6, wr = wid >> 1, wc = wid & 1, fr = lane & 15, fq = lane >> 4;
    for (int u = bid; u < 16 * 2 * 4; u += nb) {
        const int split = u & 3, which = (u >> 2) & 1, bg = u >> 3, b = bg >> 1, g = bg & 1;
        ALoadCmp al; al.kt0 = split * 8; al.base = p.KCV + (size_t)b * SEQ * 256 + which * 128 + g * 64 + (tid & 7) * 8; al.pe = (which ? p.pe_v : p.pe_k) + (tid & 7) * 8;
        BLoadF32 bl; { const int nq = tid & 31, kg = tid >> 5; bl.valid = true; bl.ldb = 128; bl.nk1 = 1 << 30; bl.bp = (which ? p.wv1 : p.wk1) + (size_t)(split * 8 * 64 + kg * 8) * 128 + nq * 4; }
        f32x4 acc[4][4];
        gemm_tile(lds, al, bl, 8, acc);
        float* hid = p.HID + ((size_t)which * 2048 + bg * 128) * 128;
#pragma unroll
        for (int m = 0; m < 4; ++m)
#pragma unroll
            for (int n = 0; n < 4; ++n) {
                const int row = wr * 64 + m * 16 + fr, col = wc * 64 + n * 16 + fq * 4;
#pragma unroll
                for (int j = 0; j < 4; ++j) atomicAdd(hid + (size_t)row * 128 + col + j, acc[m][n][j]);
            }
    }
}
__device__ __forceinline__ void phase_cmp2(char* lds, int bid, int nb, const P& p) {
    const int tid = tidx(), lane = tid & 63, wid = tid >> 6;
    float* hs = (float*)lds + wid * 128;
    for (int it = bid * 4 + wid; it < 2 * 16 * 128; it += nb * 4) {
        const int which = it >> 11, bg = (it >> 7) & 15, c = it & 127;
        float o = 0.f;
        if (c < 127) {
            const float* hid = p.HID + ((size_t)which * 2048 + bg * 128 + c) * 128;
            __builtin_amdgcn_wave_barrier();
            hs[lane] = gelu_tanh(hid[lane]); hs[lane + 64] = gelu_tanh(hid[lane + 64]);
            __builtin_amdgcn_wave_barrier();
            const float* w2 = which ? p.wv2 : p.wk2;
#pragma unroll 8
            for (int j = 0; j < 128; ++j) o += hs[j] * w2[j * 64 + lane];
        }
        if (which == 0) p.KCb[((size_t)bg * 128 + c) * 64 + lane] = (bf16_t)f2bf(o);
        else p.VCt[((size_t)bg * 64 + lane) * 128 + c] = (bf16_t)f2bf(o);
    }
}
#define CMPA_LDS (2 * 16384 + 4 * 2048)
__device__ __forceinline__ void cmpa_unit(char* lds, const P& p, int b, int g, int qt64) {
    const int tid = tidx(), lane = tid & 63, w = tid >> 6, fr = lane & 15, fg = lane >> 4;
    const int bg = b * 2 + g;
    char* kc = lds; char* vt = lds + 16384;
    __syncthreads();
#pragma unroll
    for (int i = 0; i < 4; ++i) { const int pc = tid + 256 * i;
        *(u32x4*)(kc + lds_off(pc >> 3, (pc & 7) * 8)) = *(const u32x4*)(p.KCb + (size_t)bg * 8192 + pc * 8);
        *(u32x4*)(vt + lds_off128(pc >> 4, (pc & 15) * 8)) = *(const u32x4*)(p.VCt + (size_t)bg * 8192 + pc * 8); }
    __syncthreads();
    const int t = qt64 * 64 + w * 16 + fr;
    const size_t n = (size_t)b * SEQ + t;
    const float c1 = 0.125f * LOG2E;
    f32x4 psum[8];
#pragma unroll
    for (int ct = 0; ct < 8; ++ct) psum[ct] = (f32x4){0.f, 0.f, 0.f, 0.f};
#pragma unroll 1
    for (int i = 0; i < 4; ++i) {
        const int hd = g * 4 + i;
        const float slope2 = exp2f(-((float)hd + 0.5f)) * LOG2E;
        const bf16x8 q0 = *(const bf16x8*)(p.Qb + n * 512 + hd * 64 + fg * 8), q1 = *(const bf16x8*)(p.Qb + n * 512 + hd * 64 + 32 + fg * 8);
        f32x4 s[8];
        float mx = -INFINITY;
#pragma unroll
        for (int ct = 0; ct < 8; ++ct) {
            const bf16x8 k0 = *(const bf16x8*)(kc + lds_off(ct * 16 + fr, fg * 8)), k1 = *(const bf16x8*)(kc + lds_off(ct * 16 + fr, 32 + fg * 8));
            s[ct] = __builtin_amdgcn_mfma_f32_16x16x32_bf16(k0, q0, (f32x4){0.f, 0.f, 0.f, 0.f}, 0, 0, 0);
            s[ct] = __builtin_amdgcn_mfma_f32_16x16x32_bf16(k1, q1, s[ct], 0, 0, 0);
#pragma unroll
            for (int r = 0; r < 4; ++r) {
                const int e = 16 * (ct * 16 + fg * 4 + r) + 31;
                const float y = (e <= t) ? fmaf(s[ct][r], c1, -slope2 * (float)(t - e)) : -INFINITY;
                s[ct][r] = y; mx = fmaxf(mx, y);
            }
        }
        __builtin_amdgcn_sched_barrier(0);
        mx = fmaxf(mx, __shfl_xor(mx, 16)); mx = fmaxf(mx, __shfl_xor(mx, 32));
        const float mm = (mx == -INFINITY) ? 0.f : mx;
        float ls = 0.f;
#pragma unroll
        for (int ct = 0; ct < 8; ++ct)
#pragma unroll
            for (int r = 0; r < 4; ++r) { const float e = __builtin_amdgcn_exp2f(s[ct][r] - mm); s[ct][r] = e; ls += e; }
        ls += __shfl_xor(ls, 16); ls += __shfl_xor(ls, 32);
        const float inv = 1.0f / fmaxf(ls, 1e-30f);
#pragma unroll
        for (int ct = 0; ct < 8; ++ct) { s[ct] *= inv; psum[ct] += s[ct]; }
        __builtin_amdgcn_sched_barrier(0);
        f32x4 o[4];
#pragma unroll
        for (int dt = 0; dt < 4; ++dt) o[dt] = (f32x4){0.f, 0.f, 0.f, 0.f};
#pragma unroll
        for (int kk = 0; kk < 4; ++kk) {
            u32x4 pw; pw.x = pack2(s[2 * kk][0], s[2 * kk][1]); pw.y = pack2(s[2 * kk][2], s[2 * kk][3]); pw.z = pack2(s[2 * kk + 1][0], s[2 * kk + 1][1]); pw.w = pack2(s[2 * kk + 1][2], s[2 * kk + 1][3]);
            const bf16x8 pf = __builtin_bit_cast(bf16x8, pw);
#pragma unroll
            for (int dt = 0; dt < 4; ++dt) {
                const int c0 = kk * 32 + fg * 4;
                const u32x2 v0 = *(const u32x2*)(vt + lds_off128(dt * 16 + fr, c0 & ~7) + (c0 & 7) * 2);
                const u32x2 v1 = *(const u32x2*)(vt + lds_off128(dt * 16 + fr, (c0 + 16) & ~7) + (c0 & 7) * 2);
                u32x4 vv; vv.x = v0.x; vv.y = v0.y; vv.z = v1.x; vv.w = v1.y;
                o[dt] = __builtin_amdgcn_mfma_f32_16x16x32_bf16(__builtin_bit_cast(bf16x8, vv), pf, o[dt], 0, 0, 0);
            }
        }
#pragma unroll
        for (int dt = 0; dt < 4; ++dt) *(f32x4*)(p.OC + n * 512 + hd * 64 + dt * 16 + fg * 4) = o[dt];
    }
    const int own = t >> 6;
    float val[8];
#pragma unroll
    for (int ct = 0; ct < 8; ++ct) {
        const float up = __shfl(psum[ct][3], (lane + 48) & 63);
        const float up0 = (ct > 0) ? __shfl(psum[ct > 0 ? ct - 1 : 0][3], (lane + 48) & 63) : 0.f;
        const float imp = (psum[ct][0] + psum[ct][1]) + (psum[ct][2] + psum[ct][3]) + (fg > 0 ? up : up0);
        const int j = ct * 4 + fg;
        const bool forced = (j == 0) || (j == own) || (j == own - 1);
        val[ct] = (j <= own) ? (imp + (forced ? 1e4f : 0.f)) : NEGF;
    }
    float* vs = (float*)(lds + 32768) + w * 512;
    __builtin_amdgcn_wave_barrier();
#pragma unroll
    for (int ct = 0; ct < 8; ++ct) vs[fr * 32 + ct * 4 + fg] = val[ct];
    __builtin_amdgcn_wave_barrier();
    int rank[8];
#pragma unroll
    for (int ct = 0; ct < 8; ++ct) rank[ct] = 0;
#pragma unroll 2
    for (int oj = 0; oj < 32; ++oj) {
        const float ov = vs[fr * 32 + oj];
#pragma unroll
        for (int ct = 0; ct < 8; ++ct) rank[ct] += (ov > val[ct] || (ov == val[ct] && oj < ct * 4 + fg)) ? 1 : 0;
    }
    __builtin_amdgcn_wave_barrier();
    unsigned bits = 0;
#pragma unroll
    for (int ct = 0; ct < 8; ++ct) if ((ct * 4 + fg <= own) && rank[ct] < 16) bits |= 1u << (ct * 4 + fg);
    bits |= (unsigned)__shfl_xor((int)bits, 16); bits |= (unsigned)__shfl_xor((int)bits, 32);
    if (fg == 0) p.SELM[(size_t)bg * SEQ + t] = bits;
}
__device__ __forceinline__ void phase_cmpa(char* lds, int bid, int nb, const P& p) {
    for (int u = bid; u < 16 * 32; u += nb) cmpa_unit(lds, p, u >> 6, (u >> 5) & 1, u & 31);
    __syncthreads();
}

extern __shared__ __attribute__((aligned(16))) char dyn_lds[];
#define MEGA_LDS (((HG3_LDS + 255) & ~255) + 16)
static_assert(HG3_LDS >= CMP_LDS && HG3_LDS >= GEMM_LDS && HG3_LDS >= ATT_RED_OFF + 16, "LDS map");
#define GBAR() xcd_barrier(bar)

template <int LAYER>
__device__ __forceinline__ void moe_block(char* lds, int bid, int nb, const P& p, const XcdBarrier& bar, float* of, bf16_t* ob) {
    if (bid == 0) p.cnt[tidx()] = 0;
    phase_gemm_dense<true, true>(lds, bid, nb, p.XA, DM, p.w_router + (size_t)LAYER * DM * NEXP, NEXP, NTOK, NEXP, DM, p.LOG, NEXP);
    GBAR();
    phase_route(bid, nb, p, LAYER);
    GBAR();
    phase_scatter(lds, bid, nb, p);
    GBAR();
    phase_moe1(lds, bid, nb, p, LAYER, p.XAb);
    GBAR();
    phase_moe2(lds, bid, nb, p, LAYER);
    GBAR();
    phase_combine_ln(bid, nb, p, p.XA, p.ln_g + (LAYER * 2 + 1) * DM, p.ln_b + (LAYER * 2 + 1) * DM, of, ob);
}

__global__ void __launch_bounds__(256, 2) mega(P p) {
    char* lds = dyn_lds;
    const int bid = blockIdx.x, nb = gridDim.x;
    volatile LAS unsigned* st = (volatile LAS unsigned*)(dyn_lds + MEGA_LDS - 16);
    if (tidx() == 0) { st[0] = 0u; st[1] = 0u; st[2] = 0u; st[3] = 0u; }
    __syncthreads();
    const XcdBarrier bar = xcd_barrier_post(p.bar, st);
    phase_inproj0(lds, bid, nb, p);
    GBAR();
    phase_mix0_a(lds, bid, nb, p);
    GBAR();
    phase_hg2(bid, nb, p);
    GBAR();
    phase_mix0_c(lds, bid, nb, p);
    GBAR();
    phase_gemm_dense<false, false>(lds, bid, nb, p.MIX, DM, p.even_w_out, DM, NTOK, DM, DM, p.T0, DM);
    GBAR();
    phase_ln_add(bid, nb, p.x, p.T0, p.ln_g, p.ln_b, p.XA, p.XAb);
    GBAR();
    moe_block<0>(lds, bid, nb, p, bar, p.XB, p.XBb);
    GBAR();
    phase_inproj1(lds, bid, nb, p);
    GBAR();
    phase_cmp1(lds, bid, nb, p);
    phase_moba_kmean(bid, nb, p);
    GBAR();
    phase_cmp2(lds, bid, nb, p);
    phase_moba_gate(bid, nb, p);
    GBAR();
    phase_cmpa(lds, bid, nb, p);
    GBAR();
#if !ATT_NSA
    phase_nsa_attn(lds, bid, nb, p);
#endif
#if !ATT_MOBA
    phase_moba_attn(lds, bid, nb, p);
#endif
    phase_attn(lds, bid, nb, p);
    GBAR();
    phase_gemm_dense<false, false>(lds, bid, nb, p.MIX, DM, p.odd_w_out, DM, NTOK, DM, DM, p.T0, DM);
    GBAR();
    phase_ln_add(bid, nb, p.XB, p.T0, p.ln_g + 2 * DM, p.ln_b + 2 * DM, p.XA, p.XAb);
    GBAR();
    moe_block<1>(lds, bid, nb, p, bar, p.out, nullptr);
}

static inline size_t al256(size_t x) { return (x + 255) & ~(size_t)255; }

extern "C" void kernel_launch(void* const* d_in, const int* in_sizes, int n_in, void* d_out, int out_size, void* d_ws, size_t ws_size, hipStream_t stream) {
    P p{};
    const float** ip = (const float**)&p.x;
    for (int i = 0; i < 30; ++i) ip[i] = (const float*)d_in[i];
    p.out = (float*)d_out;
    char* w = (char*)d_ws; size_t o = 0;
    auto take = [&](size_t bytes) { char* r = w + o; o = al256(o + bytes); return r; };
    p.bar = (unsigned*)take(XCD_BAR_WORDS * 4);
    p.U = (float*)take((size_t)NTOK * EVEN_IN * 4);
    p.MIX = (bf16_t*)take((size_t)NTOK * DM * 2);
    p.T0 = (float*)take((size_t)NTOK * DM * 4);
    p.XA = (float*)take((size_t)NTOK * DM * 4); p.XAb = (bf16_t*)take((size_t)NTOK * DM * 2);
    p.XB = (float*)take((size_t)NTOK * DM * 4); p.XBb = (bf16_t*)take((size_t)NTOK * DM * 2);
    p.LOG = (float*)take((size_t)NTOK * NEXP * 4);
    p.eidx = (int*)take(NTOK * 8 * 4); p.ew = (float*)take(NTOK * 8 * 4); p.erank = (int*)take(NTOK * 8 * 4); p.epos = (int*)take(NTOK * 8 * 4);
    p.cnt = (int*)take(NEXP * 4); p.tile_e = (int*)take(NTILES * 4); p.rowtok = (int*)take(NROWS * 4);
    p.H = (bf16_t*)take((size_t)NROWS * 256 * 2);
    p.Y = (bf16_t*)take((size_t)NROWS * DM * 2);
    p.LA = (float*)take((size_t)NTOK * 512 * 4); p.LB = (float*)take((size_t)NTOK * 512 * 4);
    p.KC = (float*)take(16 * 127 * 64 * 4); p.VC = (float*)take(16 * 127 * 64 * 4);
    p.OC = (float*)take((size_t)NTOK * 512 * 4);
    p.SELM = (unsigned*)take(16 * SEQ * 4);
    p.KM = (float*)take(8 * 8 * 8 * 64 * 4);
    p.Qb = (bf16_t*)take((size_t)NTOK * 512 * 2); p.KS = (bf16_t*)take((size_t)NTOK * 128 * 2); p.VSt = (bf16_t*)take((size_t)NTOK * 128 * 2);
    p.KW = (bf16_t*)take((size_t)NTOK * 128 * 2); p.VWt = (bf16_t*)take((size_t)NTOK * 128 * 2);
    p.MQ = (bf16_t*)take((size_t)NTOK * 512 * 2); p.MK = (bf16_t*)take((size_t)NTOK * 512 * 2); p.MVt = (bf16_t*)take((size_t)NTOK * 512 * 2);
    p.KCV = (float*)take((size_t)NTOK * 256 * 4); p.GATES = (float*)take((size_t)NTOK * 24 * 4); p.OS = (float*)take((size_t)NTOK * 512 * 4);
    p.MSEL = (unsigned*)take(64 * SEQ * 4);
    p.UB0 = (bf16_t*)take((size_t)NTOK * 2560 * 2); p.VHt = (bf16_t*)take((size_t)NTOK * 512 * 2);
    p.WAT = (bf16_t*)take(8 * 64 * 64 * 2); p.WXT = (bf16_t*)take(8 * 64 * 64 * 2);
    p.CSA = (float*)take(8 * 32 * 512 * 4); p.CSB = (float*)take(8 * 32 * 512 * 4);
    p.UT = (bf16_t*)take((size_t)1024 * 16384 * 2); p.SP = (bf16_t*)take((size_t)1024 * 16384 * 2);
    p.DV = (float*)take(1024 * 128 * 4);
    p.HID = (float*)take(2 * 2048 * 128 * 4); p.KCb = (bf16_t*)take(16 * 128 * 64 * 2); p.VCt = (bf16_t*)take(16 * 64 * 128 * 2);
    if (o > ws_size) return;

    static int grid = 0;
    if (!grid) {
        int dev = 0, cus = 0, per_cu = 0;
        (void)hipGetDevice(&dev);
        (void)hipDeviceGetAttribute(&cus, hipDeviceAttributeMultiprocessorCount, dev);
        (void)hipFuncSetAttribute((const void*)mega, hipFuncAttributeMaxDynamicSharedMemorySize, MEGA_LDS);
        (void)hipOccupancyMaxActiveBlocksPerMultiprocessor(&per_cu, (const void*)mega, 256, MEGA_LDS);
        if (per_cu < 1) per_cu = 1;
        grid = cus * (per_cu < 2 ? per_cu : 2);
    }
    (void)hipMemsetAsync(p.bar, 0, XCD_BAR_WORDS * 4, stream);
    hipLaunchKernelGGL(mega, dim3(grid), dim3(256), MEGA_LDS, stream, p);
}
```

```cpp
#include <hip/hip_runtime.h>
#include <hip/hip_bf16.h>
#include <stdint.h>

#define NTOK 16384
#define DM 1024
#define SEQ 2048
#define NBATCH 8
#define EVEN_IN 3072
#define ODD_IN 2840
#define NEXP 256
#define NEGF (-1e30f)
#define LOG2E 1.4426950408889634f
#define DN_ALPHA 1.4142135623730951f
#define LN_EPS 1e-5f
#define MAXRT 1280
#define SH_TILE0 1280
#define NTILES (1280 + 128)
#define NROWS (NTILES * 128)

typedef unsigned short bf16_t;
typedef short bf16x8 __attribute__((ext_vector_type(8)));
typedef float f32x4 __attribute__((ext_vector_type(4)));
typedef unsigned u32x4 __attribute__((ext_vector_type(4)));
typedef unsigned u32x2 __attribute__((ext_vector_type(2)));
extern __shared__ __attribute__((aligned(16))) char dyn_lds[];
#define LAS __attribute__((address_space(3)))

__device__ __forceinline__ int tidx() { int t = threadIdx.x; asm volatile("" : "+v"(t)); return t; }
__device__ __forceinline__ float wave_sum(float v) {
#pragma unroll
    for (int o = 32; o >= 1; o >>= 1) v += __shfl_xor(v, o);
    return v;
}
__device__ __forceinline__ float wave_max(float v) {
#pragma unroll
    for (int o = 32; o >= 1; o >>= 1) v = fmaxf(v, __shfl_xor(v, o));
    return v;
}
typedef __bf16 hwbf16x2 __attribute__((ext_vector_type(2)));
typedef float f32x2 __attribute__((ext_vector_type(2)));
__device__ __forceinline__ unsigned f2bf(float f) { const __bf16 h = (__bf16)f; return (unsigned)__builtin_bit_cast(unsigned short, h); }
__device__ __forceinline__ float bf2f(unsigned b) { return __uint_as_float(b << 16); }
__device__ __forceinline__ unsigned pack2(float lo, float hi) { const f32x2 f = {lo, hi}; const hwbf16x2 v = __builtin_convertvector(f, hwbf16x2); return __builtin_bit_cast(unsigned, v); }
__device__ __forceinline__ float sigmoidf_(float x) { return 1.0f / (1.0f + __expf(-x)); }
__device__ __forceinline__ float siluf_(float x) { return x / (1.0f + __expf(-x)); }
__device__ __forceinline__ float gelu_tanh(float x) {
    const float u = 0.7978845608028654f * (x + 0.044715f * x * x * x);
    return 0.5f * x * (1.0f + tanhf(u));
}


#define XB_TMO      128
#define XB_XCNT(j)  (256  + 64 * (j))
#define XB_XSUB(j)  (1280 + 64 * (j))
#define XB_XGEN(j)  (2304 + 64 * (j))
#define XB_TOP      3328
#define XB_TOPGEN   3392
#define XCD_BAR_WORDS 3456
#define XB_SPIN_CAP (1u << 18)
__device__ __forceinline__ unsigned xb_ld(unsigned* p)              { return __hip_atomic_load(p, __ATOMIC_RELAXED, __HIP_MEMORY_SCOPE_AGENT); }
__device__ __forceinline__ unsigned xb_add(unsigned* p, unsigned v) { return __hip_atomic_fetch_add(p, v, __ATOMIC_RELAXED, __HIP_MEMORY_SCOPE_AGENT); }
__device__ __forceinline__ unsigned xb_xcc_id() { return (unsigned)__builtin_amdgcn_s_getreg((3 << 11) | 20) & 0xFu; }
#define XB_SPIN(cond, bar) do { unsigned _sp = 0; while (cond) { __builtin_amdgcn_s_sleep(1); \
    if ((++_sp & 255u) == 0u) { if (xb_ld(&(bar)[XB_TMO])) break; if (_sp > XB_SPIN_CAP) { atomicAdd(&(bar)[XB_TMO], 1u); break; } } } } while (0)
struct XcdBarrier { unsigned* bar; unsigned x; volatile LAS unsigned* st; };
__device__ __forceinline__ XcdBarrier xcd_barrier_post(unsigned* bar, volatile LAS unsigned* st) {
    XcdBarrier b; b.bar = bar; b.x = xb_xcc_id(); b.st = st;
    if (tidx() == 0) (void)xb_add(&bar[XB_XCNT(b.x)], 1u);
    return b;
}
__device__ __forceinline__ void xcd_barrier_complete(unsigned* bar, unsigned x, unsigned& nloc, unsigned& nx) {
    const unsigned G = gridDim.x * gridDim.y * gridDim.z;
    unsigned sum, cnt, mine, sp = 0u;
    for (;;) {
        sum = 0u; cnt = 0u; mine = 0u;
#pragma unroll
        for (unsigned j = 0; j < 16; ++j) { const unsigned c = xb_ld(&bar[XB_XCNT(j)]); sum += c; cnt += (c > 0u) ? 1u : 0u; mine = (j == x) ? c : mine; }
        if (sum == G) break;
        __builtin_amdgcn_s_sleep(1);
        if ((++sp & 255u) == 0u) { if (xb_ld(&bar[XB_TMO])) break; if (sp > XB_SPIN_CAP) { atomicAdd(&bar[XB_TMO], 1u); break; } }
    }
    nloc = mine > 0u ? mine : 1u; nx = cnt > 0u ? cnt : 1u;
}
__device__ __forceinline__ void xcd_barrier(const XcdBarrier& b) {
    asm volatile("s_waitcnt vmcnt(0)" ::: "memory");
    __syncthreads();
    if (tidx() == 0) {
        unsigned* bar = b.bar;
        __builtin_amdgcn_s_waitcnt(0);
        unsigned nloc = b.st[0], nx = b.st[1];
        if (nloc == 0u) { xcd_barrier_complete(bar, b.x, nloc, nx); b.st[0] = nloc; b.st[1] = nx; }
        const unsigned old = xb_add(&bar[XB_XSUB(b.x)], 1u);
        const unsigned gen = old / nloc;
        if (old + 1u == (gen + 1u) * nloc) {
            __builtin_amdgcn_fence(__ATOMIC_RELEASE, "agent");
            asm volatile("s_waitcnt vmcnt(0)" ::: "memory");
            const unsigned og = xb_add(&bar[XB_TOP], 1u);
            const unsigned tg = og / nx;
            if (og + 1u == (tg + 1u) * nx) xb_add(&bar[XB_TOPGEN], 1u);
            else XB_SPIN(xb_ld(&bar[XB_TOPGEN]) == tg, bar);
            __builtin_amdgcn_fence(__ATOMIC_ACQUIRE, "agent");
            xb_add(&bar[XB_XGEN(b.x)], 1u);
            asm volatile("s_waitcnt vmcnt(0)" ::: "memory");
        } else {
            XB_SPIN(xb_ld(&bar[XB_XGEN(b.x)]) == gen, bar);
            __builtin_amdgcn_fence(__ATOMIC_ACQUIRE, "agent");
            asm volatile("s_waitcnt vmcnt(0)" ::: "memory");
        }
    }
    __syncthreads();
}

struct P {
    const float *x, *even_w_in, *conv_w, *conv_b, *wa, *ba, *wx, *bx, *lam, *hg_lb, *hg_ng, *even_w_out;
    const float *odd_w_in, *pe_k, *pe_v, *wk1, *wk2, *wv1, *wv2, *odd_w_out, *ln_g, *ln_b, *w_router, *b_router;
    const float *w_gate, *w_up, *w_down, *ws_gate, *ws_up, *ws_down;
    float* out;
    float* U;
    bf16_t* MIX;
    float* T0;
    float* XA; bf16_t* XAb; float* XB; bf16_t* XBb;
    float* LOG;
    int* eidx; float* ew; int* erank; int* epos;
    int* cnt;
    int* tile_e;
    int* rowtok;
    bf16_t* H;
    bf16_t* Y;
    float* LA; float* LB;
    float* KC; float* VC;
    float* OC;
    unsigned* SELM;
    float* KM;
    unsigned* bar;
    bf16_t *Qb, *KS, *VSt, *KW, *VWt, *MQ, *MK, *MVt;
    float *KCV, *GATES, *OS; unsigned* MSEL;
    bf16_t *UB0;
    bf16_t *VHt;
    bf16_t *WAT, *WXT;
    float *CSA, *CSB;
    bf16_t *UT, *SP;
    float *DV;
    float *HID;
    bf16_t *KCb, *VCt;
    bf16_t *XIb;
    int *plist; int *plen;
    bf16_t *WIN0, *WOUT0, *WIN1, *WOUT1, *WRH, *WRL;
};

__device__ __forceinline__ int lds_off(int r, int c) {
    const int st = (r >> 4) * 2 + (c >> 5), ob = (r & 15) * 64 + (c & 31) * 2;
    return st * 1024 + (ob ^ (((ob >> 9) & 1) << 5));
}
#define GEMM_LDS 32768

__device__ __forceinline__ float cvt_part(float v, int lo) { return lo ? (v - bf2f(f2bf(v))) : v; }

struct ALoadF32 {
    const float* rp[4];
    int nk1;
    struct Regs { f32x4 v[8]; };
    __device__ __forceinline__ void load(int kt, Regs& R) const {
        const int k = (kt % nk1) * 64;
#pragma unroll
        for (int i = 0; i < 4; ++i) { R.v[2 * i] = *(const f32x4*)(rp[i] + k); R.v[2 * i + 1] = *(const f32x4*)(rp[i] + k + 4); }
    }
    __device__ __forceinline__ void store(int kt, const Regs& R, char* lds) const {
        const int lo = (kt / nk1) == 2;
#pragma unroll
        for (int i = 0; i < 4; ++i) {
            const int p = tidx() + 256 * i, row = p >> 3, ch = p & 7;
            const f32x4 a = R.v[2 * i], b = R.v[2 * i + 1];
            u32x4 w;
            w.x = pack2(cvt_part(a[0], lo), cvt_part(a[1], lo)); w.y = pack2(cvt_part(a[2], lo), cvt_part(a[3], lo));
            w.z = pack2(cvt_part(b[0], lo), cvt_part(b[1], lo)); w.w = pack2(cvt_part(b[2], lo), cvt_part(b[3], lo));
            *(u32x4*)(lds + lds_off(row, ch * 8)) = w;
        }
    }
};
struct ALoadBF16 {
    const bf16_t* rp[4];
    struct Regs { u32x4 v[4]; };
    __device__ __forceinline__ void load(int kt, Regs& R) const {
#pragma unroll
        for (int i = 0; i < 4; ++i) R.v[i] = *(const u32x4*)(rp[i] + kt * 64);
    }
    __device__ __forceinline__ void store(int kt, const Regs& R, char* lds) const {
#pragma unroll
        for (int i = 0; i < 4; ++i) { const int p = tidx() + 256 * i; *(u32x4*)(lds + lds_off(p >> 3, (p & 7) * 8)) = R.v[i]; }
    }
};
struct ALoadF32S {
    const float* rp0; size_t rs32; int nk1;
    struct Regs { f32x4 v[8]; };
    __device__ __forceinline__ void load(int kt, Regs& R) const {
        const int k = (kt % nk1) * 64;
#pragma unroll
        for (int i = 0; i < 4; ++i) { const float* q = rp0 + i * rs32 + k; R.v[2 * i] = *(const f32x4*)q; R.v[2 * i + 1] = *(const f32x4*)(q + 4); }
    }
    __device__ __forceinline__ void store(int kt, const Regs& R, char* lds) const {
        const int lo = (kt / nk1) == 2;
#pragma unroll
        for (int i = 0; i < 4; ++i) {
            const int p = tidx() + 256 * i, row = p >> 3, ch = p & 7;
            const f32x4 a = R.v[2 * i], b = R.v[2 * i + 1];
            u32x4 w;
            w.x = pack2(cvt_part(a[0], lo), cvt_part(a[1], lo)); w.y = pack2(cvt_part(a[2], lo), cvt_part(a[3], lo));
            w.z = pack2(cvt_part(b[0], lo), cvt_part(b[1], lo)); w.w = pack2(cvt_part(b[2], lo), cvt_part(b[3], lo));
            *(u32x4*)(lds + lds_off(row, ch * 8)) = w;
        }
    }
};
struct ALoadBF16S {
    const bf16_t* rp0; size_t rs32;
    struct Regs { u32x4 v[4]; };
    __device__ __forceinline__ void load(int kt, Regs& R) const {
#pragma unroll
        for (int i = 0; i < 4; ++i) R.v[i] = *(const u32x4*)(rp0 + i * rs32 + kt * 64);
    }
    __device__ __forceinline__ void store(int kt, const Regs& R, char* lds) const {
#pragma unroll
        for (int i = 0; i < 4; ++i) { const int p = tidx() + 256 * i; *(u32x4*)(lds + lds_off(p >> 3, (p & 7) * 8)) = R.v[i]; }
    }
};
struct BLoadF32 {
    const float* bp; int ldb; bool valid; int nk1;
    struct Regs { f32x4 v[8]; };
    __device__ __forceinline__ void load(int kt, Regs& R) const {
        const float* p = bp + (size_t)((kt % nk1) * 64) * ldb;
#pragma unroll
        for (int j = 0; j < 8; ++j) R.v[j] = valid ? *(const f32x4*)(p + (size_t)j * ldb) : (f32x4){0.f, 0.f, 0.f, 0.f};
    }
    __device__ __forceinline__ void store(int kt, const Regs& R, char* lds) const {
        const int lo = (kt / nk1) == 1;
        const int nq = tidx() & 31, kg = tidx() >> 5;
#pragma unroll
        for (int i = 0; i < 4; ++i) {
            u32x4 w;
            w.x = pack2(cvt_part(R.v[0][i], lo), cvt_part(R.v[1][i], lo)); w.y = pack2(cvt_part(R.v[2][i], lo), cvt_part(R.v[3][i], lo));
            w.z = pack2(cvt_part(R.v[4][i], lo), cvt_part(R.v[5][i], lo)); w.w = pack2(cvt_part(R.v[6][i], lo), cvt_part(R.v[7][i], lo));
            *(u32x4*)(lds + lds_off(nq * 4 + i, kg * 8)) = w;
        }
    }
};

template <class AL, class BL>
__device__ __forceinline__ void gemm_tile(char* lds, const AL& al, const BL& bl, int nk, f32x4 (&acc)[4][4], bool swap = false) {
    const int lane = tidx() & 63, wid = tidx() >> 6, wr = wid >> 1, wc = wid & 1, fr = lane & 15, fq = lane >> 4;
    char* ldsA = lds; char* ldsB = lds + 16384;
    const char* t2 = swap ? ldsB : ldsA; const char* t1 = swap ? ldsA : ldsB; const int w2 = swap ? wc : wr, w1 = swap ? wr : wc;
#pragma unroll
    for (int m = 0; m < 4; ++m)
#pragma unroll
        for (int n = 0; n < 4; ++n) acc[m][n] = (f32x4){0.f, 0.f, 0.f, 0.f};
    typename AL::Regs ra; typename BL::Regs rb;
    al.load(0, ra); bl.load(0, rb);
    for (int kt = 0; kt < nk; ++kt) {
        __syncthreads();
        al.store(kt, ra, ldsA); bl.store(kt, rb, ldsB);
        __syncthreads();
        if (kt + 1 < nk) { al.load(kt + 1, ra); bl.load(kt + 1, rb); }
#pragma unroll
        for (int kk = 0; kk < 2; ++kk) {
            bf16x8 a[4], b[4];
#pragma unroll
            for (int m = 0; m < 4; ++m) a[m] = *(const bf16x8*)(t2 + lds_off(w2 * 64 + m * 16 + fr, kk * 32 + fq * 8));
#pragma unroll
            for (int n = 0; n < 4; ++n) b[n] = *(const bf16x8*)(t1 + lds_off(w1 * 64 + n * 16 + fr, kk * 32 + fq * 8));
#pragma unroll
            for (int m = 0; m < 4; ++m)
#pragma unroll
                for (int n = 0; n < 4; ++n) acc[m][n] = __builtin_amdgcn_mfma_f32_16x16x32_bf16(b[n], a[m], acc[m][n], 0, 0, 0);
        }
    }
}


#define G2_LDS 65536
__device__ __forceinline__ void dma_rc(int lane, int st, int& R, int& C) {
    const int sb = lane * 16, swz = sb ^ (((sb >> 9) & 1) << 5);
    R = (st >> 1) * 16 + (swz >> 6); C = (st & 1) * 32 + ((swz & 63) >> 1);
}
struct DmaLoad {
    static constexpr int LAYOUT = 0;
    const char* base; unsigned voff[4];
    __device__ __forceinline__ void set_dense(const bf16_t* b0, int row0, int ld) {
        base = (const char*)b0; const int lane = tidx() & 63, w = tidx() >> 6;
#pragma unroll
        for (int i = 0; i < 4; ++i) { int R, C; dma_rc(lane, w + 4 * i, R, C); voff[i] = (unsigned)(((size_t)(row0 + R) * ld + C) * 2); }
    }
    __device__ __forceinline__ void issue(int kt, int ldsoff) const {
        const int w = tidx() >> 6;
#pragma unroll
        for (int i = 0; i < 4; ++i)
            __builtin_amdgcn_global_load_lds((const unsigned*)(base + voff[i] + (size_t)kt * 128), (LAS unsigned*)((LAS char*)dyn_lds + ldsoff + (w + 4 * i) * 1024), 16, 0, 0);
    }
    __device__ __forceinline__ void commit(int, int) const {}
};
struct RegLoadA {
    const float* rp0; size_t rs32; int nk1; f32x4 v[8];
    __device__ __forceinline__ void issue(int kt, int) {
        const int k = (kt % nk1) * 64;
#pragma unroll
        for (int i = 0; i < 4; ++i) { const float* q = rp0 + i * rs32 + k; v[2 * i] = *(const f32x4*)q; v[2 * i + 1] = *(const f32x4*)(q + 4); }
    }
    __device__ __forceinline__ void commit(int kt, int ldsoff) const {
        const int lo = (kt / nk1) == 2;
#pragma unroll
        for (int i = 0; i < 4; ++i) {
            const int p = tidx() + 256 * i, row = p >> 3, ch = p & 7;
            const f32x4 a = v[2 * i], b = v[2 * i + 1];
            u32x4 w;
            w.x = pack2(cvt_part(a[0], lo), cvt_part(a[1], lo)); w.y = pack2(cvt_part(a[2], lo), cvt_part(a[3], lo));
            w.z = pack2(cvt_part(b[0], lo), cvt_part(b[1], lo)); w.w = pack2(cvt_part(b[2], lo), cvt_part(b[3], lo));
            *(u32x4*)(dyn_lds + ldsoff + lds_off(row, ch * 8)) = w;
        }
    }
};
struct RegLoadB {
    const float* bp; int ldb; f32x4 v[8];
    static constexpr int LAYOUT = 1;
    static __device__ __forceinline__ int nq_of(int tid) { return tid & 31; }
    static __device__ __forceinline__ int kg_of(int tid) { return tid >> 5; }
    __device__ __forceinline__ void issue(int kt, int) {
        const float* p = bp + (size_t)(kt * 64) * ldb;
#pragma unroll
        for (int j = 0; j < 8; ++j) v[j] = *(const f32x4*)(p + (size_t)j * ldb);
    }
    __device__ __forceinline__ void commit(int, int ldsoff) const {
        const int tid = tidx(), nq = nq_of(tid), kg = kg_of(tid);
        u32x4 w[4];
#pragma unroll
        for (int i = 0; i < 4; ++i) { w[i].x = pack2(v[0][i], v[1][i]); w[i].y = pack2(v[2][i], v[3][i]); w[i].z = pack2(v[4][i], v[5][i]); w[i].w = pack2(v[6][i], v[7][i]); }
        const int rot = (nq >> 1) & 3;
#pragma unroll
        for (int i = 0; i < 4; ++i) {
            const int e = (i + rot) & 3;
            u32x4 d;
            d.x = e == 0 ? w[0].x : (e == 1 ? w[1].x : (e == 2 ? w[2].x : w[3].x));
            d.y = e == 0 ? w[0].y : (e == 1 ? w[1].y : (e == 2 ? w[2].y : w[3].y));
            d.z = e == 0 ? w[0].z : (e == 1 ? w[1].z : (e == 2 ? w[2].z : w[3].z));
            d.w = e == 0 ? w[0].w : (e == 1 ? w[1].w : (e == 2 ? w[2].w : w[3].w));
            *(u32x4*)(dyn_lds + ldsoff + ((kg * 128 + nq * 4 + e) << 4)) = d;
        }
    }
};
template <class AL, class BL>
__device__ __forceinline__ void gemm_core(AL& al, BL& bl, int nk, f32x4 (&acc)[4][4], bool swap = false) {
    const int lane = tidx() & 63, wid = tidx() >> 6, wr = wid >> 1, wc = wid & 1, fr = lane & 15, fq = lane >> 4;
    const int w2 = swap ? wc : wr, w1 = swap ? wr : wc;
    const int o2 = swap ? 16384 : 0, o1 = swap ? 0 : 16384;
#pragma unroll
    for (int m = 0; m < 4; ++m)
#pragma unroll
        for (int n = 0; n < 4; ++n) acc[m][n] = (f32x4){0.f, 0.f, 0.f, 0.f};
    al.issue(0, 0); bl.issue(0, 16384); al.commit(0, 0); bl.commit(0, 16384);
    asm volatile("s_waitcnt vmcnt(0)" ::: "memory");
    __syncthreads();
    for (int kt = 0; kt < nk; ++kt) {
        const int cur = (kt & 1) * 32768, nxt = 32768 - cur;
        if (kt + 1 < nk) { al.issue(kt + 1, nxt); bl.issue(kt + 1, nxt + 16384); }
#pragma unroll
        for (int kk = 0; kk < 2; ++kk) {
            bf16x8 a[4], b[4];
#pragma unroll
            for (int m = 0; m < 4; ++m) a[m] = *(const bf16x8*)(dyn_lds + cur + o2 + lds_off(w2 * 64 + m * 16 + fr, kk * 32 + fq * 8));
#pragma unroll
            for (int n = 0; n < 4; ++n) b[n] = *(const bf16x8*)(dyn_lds + cur + o1 + (BL::LAYOUT == 1 ? (((kk * 4 + fq) * 128 + w1 * 64 + n * 16 + fr) << 4) : lds_off(w1 * 64 + n * 16 + fr, kk * 32 + fq * 8)));
#pragma unroll
            for (int m = 0; m < 4; ++m)
#pragma unroll
                for (int n = 0; n < 4; ++n) acc[m][n] = __builtin_amdgcn_mfma_f32_16x16x32_bf16(b[n], a[m], acc[m][n], 0, 0, 0);
        }
        if (kt + 1 < nk) { al.commit(kt + 1, nxt); bl.commit(kt + 1, nxt + 16384); }
        asm volatile("s_waitcnt vmcnt(0)" ::: "memory");
        __syncthreads();
    }
}


#define G3_STAGE 24576
#define G3_LDS (2 * G3_STAGE)
__device__ __forceinline__ int t32_off(int r, int c) { const int ob = (r & 15) * 64 + c * 2; return (r >> 4) * 1024 + (ob ^ (((ob >> 9) & 1) << 5)); }
__device__ __forceinline__ void dma_rc32(int lane, int st, int& R, int& C) { const int sb = lane * 16, swz = sb ^ (((sb >> 9) & 1) << 5); R = st * 16 + (swz >> 6); C = (swz & 63) >> 1; }
struct Dma3A {
    static constexpr int NV = 4;
    const char* base; unsigned voff[4];
    __device__ __forceinline__ void set_dense(const bf16_t* b0, int row0, int ld) {
        base = (const char*)b0; const int lane = tidx() & 63, w = tidx() >> 6;
#pragma unroll
        for (int i = 0; i < 4; ++i) { int R, C; dma_rc32(lane, w + 4 * i, R, C); voff[i] = (unsigned)(((size_t)(row0 + R) * ld + C) * 2); }
    }
    template <int SET = 0> __device__ __forceinline__ void issue(int kt, int ldsoff) const {
        const int w = tidx() >> 6;
#pragma unroll
        for (int i = 0; i < 4; ++i)
            __builtin_amdgcn_global_load_lds((const unsigned*)(base + voff[i] + (size_t)kt * 64), (LAS unsigned*)((LAS char*)dyn_lds + ldsoff + (w + 4 * i) * 1024), 16, 0, 0);
    }
    template <int SET = 0> __device__ __forceinline__ void commit(int, int) const {}
};
struct Dma3B {
    static constexpr int LAYOUT = 0, NV = 2;
    const char* hi; const char* lo; unsigned voff[2]; int nk1;
    __device__ __forceinline__ void set(const bf16_t* h, const bf16_t* l, int row0, int ld, int nk1_) {
        hi = (const char*)h; lo = (const char*)l; nk1 = nk1_; const int lane = tidx() & 63, w = tidx() >> 6;
#pragma unroll
        for (int i = 0; i < 2; ++i) { int R, C; dma_rc32(lane, w + 4 * i, R, C); voff[i] = (unsigned)(((size_t)(row0 + R) * ld + C) * 2); }
    }
    template <int SET = 0> __device__ __forceinline__ void issue(int kt, int ldsoff) const {
        const int w = tidx() >> 6; const char* base = ((kt / nk1) == 1) ? lo : hi; const size_t ko = (size_t)(kt % nk1) * 64;
#pragma unroll
        for (int i = 0; i < 2; ++i)
            __builtin_amdgcn_global_load_lds((const unsigned*)(base + voff[i] + ko), (LAS unsigned*)((LAS char*)dyn_lds + ldsoff + (w + 4 * i) * 1024), 16, 0, 0);
    }
    template <int SET = 0> __device__ __forceinline__ void commit(int, int) const {}
};
struct Reg3A {
    const float* rp0; size_t rs64; int nk1; f32x4 v[8];
    template <int SET = 0> __device__ __forceinline__ void issue(int kt, int) {
        const int k = (kt % nk1) * 32;
#pragma unroll
        for (int i = 0; i < 4; ++i) { const float* q = rp0 + i * rs64 + k; v[2 * i] = *(const f32x4*)q; v[2 * i + 1] = *(const f32x4*)(q + 4); }
    }
    template <int SET = 0> __device__ __forceinline__ void commit(int kt, int ldsoff) const {
        const int lo = (kt / nk1) == 2;
#pragma unroll
        for (int i = 0; i < 4; ++i) {
            const int p = tidx() + 256 * i, row = p >> 2, ch = p & 3;
            const f32x4 a = v[2 * i], b = v[2 * i + 1];
            u32x4 w;
            w.x = pack2(cvt_part(a[0], lo), cvt_part(a[1], lo)); w.y = pack2(cvt_part(a[2], lo), cvt_part(a[3], lo));
            w.z = pack2(cvt_part(b[0], lo), cvt_part(b[1], lo)); w.w = pack2(cvt_part(b[2], lo), cvt_part(b[3], lo));
            *(u32x4*)(dyn_lds + ldsoff + t32_off(row, ch * 8)) = w;
        }
    }
};
struct Reg3B {
    static constexpr int LAYOUT = 1, NV = 4;
    const float* bp; int ldb; f32x4 v[2][4];
    template <int SET = 0> __device__ __forceinline__ void issue(int kt, int) {
        const float* p = bp + (size_t)(kt * 32) * ldb;
#pragma unroll
        for (int j = 0; j < 4; ++j) v[SET][j] = *(const f32x4*)(p + (size_t)j * ldb);
    }
    template <int SET = 0> __device__ __forceinline__ void commit(int, int ldsoff) const {
        const int tid = tidx(), nq = tid & 31, kg = tid >> 5;
        u32x2 w[4];
#pragma unroll
        for (int i = 0; i < 4; ++i) { w[i].x = pack2(v[SET][0][i], v[SET][1][i]); w[i].y = pack2(v[SET][2][i], v[SET][3][i]); }
        const int rot = (nq >> 1) & 3;
#pragma unroll
        for (int i = 0; i < 4; ++i) {
            const int e = (i + rot) & 3;
            u32x2 d;
            d.x = e == 0 ? w[0].x : (e == 1 ? w[1].x : (e == 2 ? w[2].x : w[3].x));
            d.y = e == 0 ? w[0].y : (e == 1 ? w[1].y : (e == 2 ? w[2].y : w[3].y));
            *(u32x2*)(dyn_lds + ldsoff + ((((kg >> 1) * 128 + nq * 4 + e) << 4) + (kg & 1) * 8)) = d;
        }
    }
};
#define G4_LDS (3 * G3_STAGE)
template <class AL, class BL, int PAR>
__device__ __forceinline__ void g4_step(AL& al, BL& bl, int kt, int nk, f32x4 (&acc)[32]) {
    constexpr int NV = AL::NV + BL::NV;
    const int lane = tidx() & 63, wid = tidx() >> 6, wr = wid >> 1, wc = wid & 1, fr = lane & 15, fq = lane >> 4;
    const int s0 = kt % 3, cur = s0 * G3_STAGE, nx1 = (s0 == 2 ? 0 : s0 + 1) * G3_STAGE, nx2 = (s0 == 0 ? 2 : s0 - 1) * G3_STAGE;
    if (kt + 1 < nk) asm volatile("s_waitcnt vmcnt(%0) lgkmcnt(0)" :: "n"(NV) : "memory");
    else asm volatile("s_waitcnt vmcnt(0) lgkmcnt(0)" ::: "memory");
    __builtin_amdgcn_s_barrier();
    asm volatile("" ::: "memory");
    if (kt + 2 < nk) { al.template issue<PAR>(kt + 2, nx2); bl.template issue<PAR>(kt + 2, nx2 + 16384); }
    bf16x8 sm[4];
#pragma unroll
    for (int j = 0; j < 4; ++j) sm[j] = *(const bf16x8*)(dyn_lds + cur + 16384 + (BL::LAYOUT == 1 ? ((fq * 128 + wc * 64 + j * 16 + fr) << 4) : t32_off(wc * 64 + j * 16 + fr, fq * 8)));
    bf16x8 bigc = *(const bf16x8*)(dyn_lds + cur + t32_off(wr * 128 + fr, fq * 8));
#pragma unroll
    for (int i = 0; i < 8; ++i) {
        bf16x8 bign = bigc;
        if (i < 7) bign = *(const bf16x8*)(dyn_lds + cur + t32_off(wr * 128 + (i + 1) * 16 + fr, fq * 8));
        __builtin_amdgcn_sched_barrier(0);
#pragma unroll
        for (int j = 0; j < 4; ++j) acc[i * 4 + j] = __builtin_amdgcn_mfma_f32_16x16x32_bf16(sm[j], bigc, acc[i * 4 + j], 0, 0, 0);
        __builtin_amdgcn_sched_barrier(0);
        bigc = bign;
    }
    if (kt + 1 < nk) bl.template commit<PAR ^ 1>(kt + 1, nx1 + 16384);
}
template <class AL, class BL>
__device__ __forceinline__ void gemm_core4(AL& al, BL& bl, int nk, f32x4 (&acc)[32]) {
#pragma unroll
    for (int i = 0; i < 32; ++i) acc[i] = (f32x4){0.f, 0.f, 0.f, 0.f};
    al.template issue<0>(0, 0); bl.template issue<0>(0, 16384);
    if (nk > 1) { al.template issue<1>(1, G3_STAGE); bl.template issue<1>(1, G3_STAGE + 16384); }
    bl.template commit<0>(0, 16384);
    for (int kt = 0; kt < nk; kt += 2) {
        g4_step<AL, BL, 0>(al, bl, kt, nk, acc);
        if (kt + 1 < nk) g4_step<AL, BL, 1>(al, bl, kt + 1, nk, acc);
    }
    __syncthreads();
}
template <class AL, class BL>
__device__ __forceinline__ void gemm_core3(AL& al, BL& bl, int nk, f32x4 (&acc)[32]) {
    const int lane = tidx() & 63, wid = tidx() >> 6, wr = wid >> 1, wc = wid & 1, fr = lane & 15, fq = lane >> 4;
#pragma unroll
    for (int i = 0; i < 32; ++i) acc[i] = (f32x4){0.f, 0.f, 0.f, 0.f};
    al.issue(0, 0); bl.issue(0, 16384); al.commit(0, 0); bl.commit(0, 16384);
    asm volatile("s_waitcnt vmcnt(0)" ::: "memory");
    __syncthreads();
    for (int kt = 0; kt < nk; ++kt) {
        const int cur = (kt & 1) * G3_STAGE, nxt = G3_STAGE - cur;
        if (kt + 1 < nk) { al.issue(kt + 1, nxt); bl.issue(kt + 1, nxt + 16384); }
        bf16x8 sm[4];
#pragma unroll
        for (int j = 0; j < 4; ++j) sm[j] = *(const bf16x8*)(dyn_lds + cur + 16384 + (BL::LAYOUT == 1 ? ((fq * 128 + wc * 64 + j * 16 + fr) << 4) : t32_off(wc * 64 + j * 16 + fr, fq * 8)));
#pragma unroll
        for (int i = 0; i < 8; ++i) {
            const bf16x8 big = *(const bf16x8*)(dyn_lds + cur + t32_off(wr * 128 + i * 16 + fr, fq * 8));
#pragma unroll
            for (int j = 0; j < 4; ++j) acc[i * 4 + j] = __builtin_amdgcn_mfma_f32_16x16x32_bf16(sm[j], big, acc[i * 4 + j], 0, 0, 0);
        }
        if (kt + 1 < nk) { al.commit(kt + 1, nxt); bl.commit(kt + 1, nxt + 16384); }
        asm volatile("s_waitcnt vmcnt(0)" ::: "memory");
        __syncthreads();
    }
}
__device__ __forceinline__ bool dense_unit3(int bid, int nb, int j, int ntn, int& tm, int& tn) {
    if ((nb & 7) == 0) {
        const int x = bid & 7, r = bid >> 3, R = nb >> 3;
        const int li = r + R * j;
        if (li >= 8 * ntn) return false;
        tn = li >> 3; tm = x * 8 + (li & 7);
        return true;
    }
    const int u = bid + nb * j;
    if (u >= 64 * ntn) return false;
    tm = u / ntn; tn = u % ntn; return true;
}
__device__ __forceinline__ void prep_tile(char* lds, const float* W, int ldw, int k0, int scol0, bool colvalid, bf16_t* Bt, int K, int drow0, int mode) {
    const int tid = tidx();
    bf16_t* t = (bf16_t*)lds;
    __syncthreads();
#pragma unroll
    for (int i = 0; i < 4; ++i) {
        const int k = (tid >> 4) + 16 * i, q = tid & 15;
        f32x4 v = colvalid ? *(const f32x4*)(W + (size_t)(k0 + k) * ldw + scol0 + q * 4) : (f32x4){0.f, 0.f, 0.f, 0.f};
#pragma unroll
        for (int e = 0; e < 4; ++e) { float x = v[e]; if (mode == 2) x = x - bf2f(f2bf(x)); t[(q * 4 + e) * 72 + k] = (bf16_t)f2bf(x); }
    }
    __syncthreads();
#pragma unroll
    for (int i = 0; i < 2; ++i) { const int pc = tid + 256 * i, n = pc >> 3, ch = pc & 7;
        *(u32x4*)(Bt + (size_t)(drow0 + n) * K + k0 + ch * 8) = *(const u32x4*)(t + n * 72 + ch * 8); }
}
__device__ __forceinline__ int vcol_actual(int v);
__device__ __forceinline__ void phase_prep(char* lds, int bid, int nb, const P& p) {
    const int tid = tidx();
    for (size_t i = (size_t)bid * 256 + tid; i < (size_t)NTOK * DM / 8; i += (size_t)nb * 256) {
        const f32x4 a = *(const f32x4*)(p.x + i * 8), b = *(const f32x4*)(p.x + i * 8 + 4);
        u32x4 w; w.x = pack2(a[0], a[1]); w.y = pack2(a[2], a[3]); w.z = pack2(b[0], b[1]); w.w = pack2(b[2], b[3]);
        *(u32x4*)(p.XIb + i * 8) = w;
    }
    for (int u = bid; u < 2272; u += nb) {
        if (u < 768) { const int nt = u >> 4, kt = u & 15; const int d = nt * 64; const int sc = d < 2048 ? d : (d < 2560 ? d + 512 : d - 512);
            prep_tile(lds, p.even_w_in, EVEN_IN, kt * 64, sc, true, p.WIN0, DM, d, 0); }
        else if (u < 1024) { const int v = u - 768, nt = v >> 4, kt = v & 15; prep_tile(lds, p.even_w_out, DM, kt * 64, nt * 64, true, p.WOUT0, DM, nt * 64, 0); }
        else if (u < 1760) { const int v = u - 1024, nt = v >> 4, kt = v & 15; const int d = nt * 64;
            int sc; bool ok = true;
            if (d < 896) sc = d; else if (d < 1024) sc = d + 128; else if (d < 1536) sc = d + 280; else if (d < 2048) sc = d + 280;
            else if (d < 2112) sc = 1280; else if (d < 2176) { sc = 0; ok = false; } else if (d < 2304) sc = d - 1280; else if (d < 2432) sc = d - 1152; else sc = d - 104;
            prep_tile(lds, p.odd_w_in, ODD_IN, kt * 64, sc, ok, p.WIN1, DM, d, 0); }
        else if (u < 2016) { const int v = u - 1760, nt = v >> 4, kt = v & 15; prep_tile(lds, p.odd_w_out, DM, kt * 64, nt * 64, true, p.WOUT1, DM, nt * 64, 0); }
        else { const int v = u - 2016, layer = v >> 7, lo = (v >> 6) & 1, nt = (v >> 4) & 3, kt = v & 15;
            prep_tile(lds, p.w_router + (size_t)layer * DM * NEXP, NEXP, kt * 64, nt * 64, true, (lo ? p.WRL : p.WRH) + (size_t)layer * NEXP * DM, DM, nt * 64, lo ? 2 : 1); }
    }
    __syncthreads();
}


__device__ __forceinline__ bool dense_unit(int bid, int nb, int j, int ntn, int& tm, int& tn) {
    if ((nb & 7) == 0) {
        const int x = bid & 7, r = bid >> 3, R = nb >> 3;
        const int li = r + R * j;
        if (li >= 16 * ntn) return false;
        const int pg = li / (8 * ntn), rest = li - pg * 8 * ntn;
        tn = rest >> 3; tm = x * 16 + pg * 8 + (rest & 7);
        return true;
    }
    const int u = bid + nb * j;
    if (u >= 128 * ntn) return false;
    tm = u / ntn; tn = u % ntn; return true;
}
struct DmaLoadSplit {
    static constexpr int LAYOUT = 0;
    const char* hi; const char* lo; unsigned voff[4]; int nk1;
    __device__ __forceinline__ void set(const bf16_t* h, const bf16_t* l, int row0, int ld, int nk1_) {
        hi = (const char*)h; lo = (const char*)l; nk1 = nk1_; const int lane = tidx() & 63, w = tidx() >> 6;
#pragma unroll
        for (int i = 0; i < 4; ++i) { int R, C; dma_rc(lane, w + 4 * i, R, C); voff[i] = (unsigned)(((size_t)(row0 + R) * ld + C) * 2); }
    }
    __device__ __forceinline__ void issue(int kt, int ldsoff) const {
        const int w = tidx() >> 6; const char* base = ((kt / nk1) == 1) ? lo : hi; const size_t ko = (size_t)(kt % nk1) * 128;
#pragma unroll
        for (int i = 0; i < 4; ++i)
            __builtin_amdgcn_global_load_lds((const unsigned*)(base + voff[i] + ko), (LAS unsigned*)((LAS char*)dyn_lds + ldsoff + (w + 4 * i) * 1024), 16, 0, 0);
    }
    __device__ __forceinline__ void commit(int, int) const {}
};
__device__ __forceinline__ void phase_gemm_f32out(int bid, int nb, const bf16_t* A, const bf16_t* Bt, int N, int K, float* C) {
    const int ntn = N / 128;
    const int tid = tidx(), lane = tid & 63, wid = tid >> 6, wr = wid >> 1, wc = wid & 1, fr = lane & 15, fq = lane >> 4;
    for (int j = 0;; ++j) {
        int tm, tn; if (!dense_unit3(bid, nb, j, ntn, tm, tn)) break;
        Dma3A al; al.set_dense(A, tm * 256, K); Dma3B bl; bl.set(Bt, Bt, tn * 128, K, 1 << 30);
        f32x4 acc[32];
        gemm_core4(al, bl, K / 32, acc);
#pragma unroll
        for (int i = 0; i < 8; ++i)
#pragma unroll
            for (int n = 0; n < 4; ++n) *(f32x4*)(C + (size_t)(tm * 256 + wr * 128 + i * 16 + fr) * N + tn * 128 + wc * 64 + n * 16 + fq * 4) = acc[i * 4 + n];
    }
}
__device__ __forceinline__ void phase_router(int bid, int nb, const P& p, int layer) {
    const int tid = tidx(), lane = tid & 63, wid = tid >> 6, wr = wid >> 1, wc = wid & 1, fr = lane & 15, fq = lane >> 4;
    for (int j = 0;; ++j) {
        int tm, tn; if (!dense_unit3(bid, nb, j, 2, tm, tn)) break;
        Reg3A al; al.nk1 = 32; al.rs64 = (size_t)64 * DM; al.rp0 = p.XA + (size_t)(tm * 256 + (tid >> 2)) * DM + (tid & 3) * 8;
        Dma3B bl; bl.set(p.WRH + (size_t)layer * NEXP * DM, p.WRL + (size_t)layer * NEXP * DM, tn * 128, DM, 32);
        f32x4 acc[32];
        gemm_core3(al, bl, 96, acc);
#pragma unroll
        for (int i = 0; i < 8; ++i)
#pragma unroll
            for (int n = 0; n < 4; ++n) *(f32x4*)(p.LOG + (size_t)(tm * 256 + wr * 128 + i * 16 + fr) * NEXP + tn * 128 + wc * 64 + n * 16 + fq * 4) = acc[i * 4 + n];
    }
}
template <bool AF32, bool SPLIT>
__device__ __forceinline__ void phase_gemm_dense(char* lds, int bid, int nb, const void* A, int lda, const float* W, int ldw, int M, int N, int K, float* C, int ldc) {
    const int ntn = (N + 127) / 128, ntm = M / 128, nk1 = K / 64;
    const int tid = tidx(), lane = tid & 63, wid = tid >> 6, wr = wid >> 1, wc = wid & 1, fr = lane & 15, fq = lane >> 4;
    for (int u = bid; u < ntm * ntn; u += nb) {
        const int tm = u / ntn, tn = u % ntn;
        BLoadF32 bl; { const int nq = tid & 31, kg = tid >> 5; const int col = tn * 128 + nq * 4; bl.valid = col < N; bl.ldb = ldw; bl.nk1 = SPLIT ? nk1 : (1 << 30);
            bl.bp = W + (size_t)(kg * 8) * ldw + (bl.valid ? col : 0); }
        f32x4 acc[4][4];
        if (AF32) {
            ALoadF32S al; al.nk1 = SPLIT ? nk1 : (1 << 30); al.rs32 = (size_t)32 * lda;
            al.rp0 = (const float*)A + (size_t)(tm * 128 + (tid >> 3)) * lda + (tid & 7) * 8;
            gemm_tile(lds, al, bl, SPLIT ? 3 * nk1 : nk1, acc);
        } else {
            ALoadBF16S al; al.rs32 = (size_t)32 * lda;
            al.rp0 = (const bf16_t*)A + (size_t)(tm * 128 + (tid >> 3)) * lda + (tid & 7) * 8;
            gemm_tile(lds, al, bl, nk1, acc);
        }
#pragma unroll
        for (int m = 0; m < 4; ++m)
#pragma unroll
            for (int n = 0; n < 4; ++n) {
                const int row = tm * 128 + wr * 64 + m * 16 + fr, col = tn * 128 + wc * 64 + n * 16 + fq * 4;
                if (col < N) *(f32x4*)(C + (size_t)row * ldc + col) = acc[m][n];
            }
    }
}

__device__ __forceinline__ void ln_row_store(float (&v)[16], const float* g, const float* b, float* of, bf16_t* ob, int row, int lane) {
    float s = 0.f;
#pragma unroll
    for (int i = 0; i < 16; ++i) s += v[i];
    const float mu = wave_sum(s) * (1.0f / DM);
    float q = 0.f;
#pragma unroll
    for (int i = 0; i < 16; ++i) { const float d = v[i] - mu; q += d * d; }
    const float rstd = rsqrtf(wave_sum(q) * (1.0f / DM) + LN_EPS);
#pragma unroll
    for (int h = 0; h < 2; ++h) {
        const int c0 = h * 512 + lane * 8;
        float o[8];
#pragma unroll
        for (int i = 0; i < 8; ++i) o[i] = (v[h * 8 + i] - mu) * rstd * g[c0 + i] + b[c0 + i];
        *(f32x4*)(of + (size_t)row * DM + c0) = (f32x4){o[0], o[1], o[2], o[3]};
        *(f32x4*)(of + (size_t)row * DM + c0 + 4) = (f32x4){o[4], o[5], o[6], o[7]};
        if (ob) { u32x4 w; w.x = pack2(o[0], o[1]); w.y = pack2(o[2], o[3]); w.z = pack2(o[4], o[5]); w.w = pack2(o[6], o[7]); *(u32x4*)(ob + (size_t)row * DM + c0) = w; }
    }
}
__device__ __forceinline__ void phase_ln_add(int bid, int nb, const float* res, const float* add, const float* g, const float* b, float* of, bf16_t* ob) {
    const int lane = tidx() & 63, wid = tidx() >> 6;
    for (int row = bid * 4 + wid; row < NTOK; row += nb * 4) {
        float v[16];
#pragma unroll
        for (int h = 0; h < 2; ++h) {
            const size_t o = (size_t)row * DM + h * 512 + lane * 8;
            const f32x4 r0 = *(const f32x4*)(res + o), r1 = *(const f32x4*)(res + o + 4), a0 = *(const f32x4*)(add + o), a1 = *(const f32x4*)(add + o + 4);
#pragma unroll
            for (int i = 0; i < 4; ++i) { v[h * 8 + i] = DN_ALPHA * r0[i] + a0[i]; v[h * 8 + 4 + i] = DN_ALPHA * r1[i] + a1[i]; }
        }
        ln_row_store(v, g, b, of, ob, row, lane);
    }
}

__device__ __forceinline__ void phase_lru_gates(char* lds, int bid, int nb, const P& p) {
    float* xs = (float*)lds;
    const int tid = tidx();
    for (int tok = bid; tok < NTOK; tok += nb) {
        const int t = tok & (SEQ - 1);
        __syncthreads();
#pragma unroll
        for (int cc = 0; cc < 2; ++cc) {
            const int c = tid + 256 * cc;
            float xc = p.conv_b[c];
#pragma unroll
            for (int w = 0; w < 4; ++w) { const int tt = t - 3 + w; if (tt >= 0) xc += p.conv_w[w * 512 + c] * p.U[(size_t)(tok - 3 + w) * EVEN_IN + c]; }
            xs[c] = xc;
        }
        __syncthreads();
#pragma unroll
        for (int cc = 0; cc < 2; ++cc) {
            const int c = tid + 256 * cc, h = c >> 6, j = c & 63;
            float ra = p.ba[c], ri = p.bx[c];
#pragma unroll 8
            for (int i = 0; i < 64; ++i) { const float xv = xs[h * 64 + i]; ra += xv * p.wa[(h * 64 + i) * 64 + j]; ri += xv * p.wx[(h * 64 + i) * 64 + j]; }
            const float r = sigmoidf_(ra), ig = sigmoidf_(ri);
            const float nl = -p.lam[c];
            const float sp = fmaxf(nl, 0.f) + log1pf(expf(-fabsf(nl)));
            const float log_a = -8.0f * r * sp;
            const float a = expf(log_a);
            const float mult = (t == 0) ? 1.0f : sqrtf(-expm1f(2.0f * log_a));
            p.LA[(size_t)tok * 512 + c] = a;
            p.LB[(size_t)tok * 512 + c] = mult * ig * xs[c];
        }
    }
}
__device__ __forceinline__ void phase_lru_scan(int bid, int nb, const P& p) {
    for (int it = bid * 256 + tidx(); it < NBATCH * 512; it += nb * 256) {
        const int b = it >> 9, c = it & 511;
        float h = 0.f;
        for (int t = 0; t < SEQ; ++t) {
            const size_t n = (size_t)b * SEQ + t;
            h = p.LA[n * 512 + c] * h + p.LB[n * 512 + c];
            const float gb = p.U[n * EVEN_IN + 512 + c];
            p.MIX[n * DM + c] = (bf16_t)f2bf(h * gelu_tanh(gb));
        }
    }
}
__device__ __forceinline__ void phase_hgrn_seq(char* lds, int bid, int nb, const P& p) {
    const int tid = tidx(), half = tid >> 7, v = tid & 127;
    float* sq = (float*)lds + half * 512;
    float* sf = sq + 128;
    float* red = sq + 256;
    for (int u0 = bid * 2; u0 < NBATCH * 4; u0 += nb * 2) {
        const int u = u0 + half;
        const int b = u >> 2, h = u & 3;
        const int ch = h * 128 + v;
        float lbv; { const float l0 = p.hg_lb[ch], l1 = p.hg_lb[512 + ch], l2 = p.hg_lb[1024 + ch]; const float mx = fmaxf(l0, fmaxf(l1, l2));
            const float e0 = expf(l0 - mx), e1 = expf(l1 - mx), e2 = expf(l2 - mx); lbv = e0 / (e0 + e1 + e2); }
        const float ng = p.hg_ng[ch];
        float S[128];
#pragma unroll
        for (int k = 0; k < 128; ++k) S[k] = 0.f;
        for (int t = 0; t < SEQ; ++t) {
            const size_t n = (size_t)b * SEQ + t;
            const float* ur = p.U + n * EVEN_IN;
            const float qv = siluf_(ur[1024 + ch]);
            const float f = lbv + (1.0f - lbv) * sigmoidf_(ur[1536 + ch]);
            __syncthreads();
            sq[v] = qv; sf[v] = f;
            __syncthreads();
            const float vv = ur[2048 + ch];
            float o = 0.f;
#pragma unroll
            for (int k = 0; k < 128; ++k) { const float fk = sf[k]; S[k] = fk * S[k] + (1.0f - fk) * vv; o += sq[k] * S[k]; }
            const float ss = wave_sum(o * o);
            if ((tid & 63) == 0) red[(tid >> 6) & 1] = ss;
            __syncthreads();
            const float tot = red[0] + red[1];
            const float y = o * rsqrtf(tot * (1.0f / 128.0f) + 1e-6f) * ng * sigmoidf_(ur[2560 + ch]);
            p.MIX[n * DM + 512 + ch] = (bf16_t)f2bf(y);
        }
        __syncthreads();
    }
}

__device__ __forceinline__ void phase_route(int bid, int nb, const P& p, int layer) {
    const float* br = p.b_router + layer * NEXP;
    const int tid = tidx(), lane = tid & 63, wid = tid >> 6;
    const int gt = bid * 256 + tid, gs = nb * 256;
    for (int i = gt; i < NROWS; i += gs) p.rowtok[i] = (i >= SH_TILE0 * 128) ? (i - SH_TILE0 * 128) : 0;
    const f32x4 bv = *(const f32x4*)(br + lane * 4);
    for (int t = bid * 4 + wid; t < NTOK; t += nb * 4) {
        const f32x4 lg = *(const f32x4*)(p.LOG + (size_t)t * NEXP + lane * 4);
        float sc[4], bs[4];
#pragma unroll
        for (int i = 0; i < 4; ++i) { sc[i] = sigmoidf_(lg[i]); bs[i] = sc[i] + bv[i]; }
        float t1 = fmaxf(bs[0], bs[1]), t2 = fminf(bs[0], bs[1]);
        { const float a = fmaxf(bs[2], bs[3]), c = fminf(bs[2], bs[3]); const float n1 = fmaxf(t1, a); t2 = fmaxf(fminf(t1, a), fmaxf(t2, c)); t1 = n1; }
#pragma unroll
        for (int o = 1; o <= 4; o <<= 1) { const float o1 = __shfl_xor(t1, o), o2 = __shfl_xor(t2, o); const float n1 = fmaxf(t1, o1); t2 = fmaxf(fminf(t1, o1), fmaxf(t2, o2)); t1 = n1; }
        const float gsc = t1 + t2;
        const int g = lane >> 3;
        int rank = 0;
#pragma unroll
        for (int g2 = 0; g2 < 8; ++g2) { const float o = __shfl(gsc, g2 * 8); rank += (o > gsc || (o == gsc && g2 < g)) ? 1 : 0; }
        const bool allowed = rank < 4;
        float cv[4];
#pragma unroll
        for (int i = 0; i < 4; ++i) cv[i] = allowed ? bs[i] : -3e38f;
        float wsel = 0.f; int esel = 0; float wsum = 0.f;
#pragma unroll
        for (int k = 0; k < 8; ++k) {
            float bvv = cv[0]; int bi = 0;
#pragma unroll
            for (int i = 1; i < 4; ++i) if (cv[i] > bvv) { bvv = cv[i]; bi = i; }
            int be = lane * 4 + bi;
#pragma unroll
            for (int o = 1; o <= 32; o <<= 1) { const float ov = __shfl_xor(bvv, o); const int oe = __shfl_xor(be, o); if (ov > bvv || (ov == bvv && oe < be)) { bvv = ov; be = oe; } }
            const int ol = be >> 2, oi = be & 3;
            float sown = 0.f;
#pragma unroll
            for (int i = 0; i < 4; ++i) if (oi == i) sown = sc[i];
            const float sv = __shfl(sown, ol);
            if (lane == ol) {
#pragma unroll
                for (int i = 0; i < 4; ++i) if (oi == i) cv[i] = -3e38f;
            }
            wsum += sv;
            if (lane == k) { wsel = sv; esel = be; }
        }
        if (lane < 8) {
            p.eidx[t * 8 + lane] = esel;
            p.ew[t * 8 + lane] = wsel / wsum * 2.5f;
            p.erank[t * 8 + lane] = atomicAdd(&p.cnt[esel], 1);
        }
    }
}
__device__ __forceinline__ void phase_scatter(char* lds, int bid, int nb, const P& p) {
    int* base = (int*)lds;
    const int tid = tidx();
    __syncthreads();
    int* pc = base + 260;
    pc[tid] = (p.cnt[tid] + 127) & ~127;
    __syncthreads();
    { int s = 0; for (int e = 0; e < tid; ++e) s += pc[e]; base[tid] = s; if (tid == 255) base[256] = s + pc[255]; }
    __syncthreads();
    for (int a = bid * 256 + tid; a < NTOK * 8; a += nb * 256) {
        const int e = p.eidx[a]; const int row = base[e] + p.erank[a];
        p.rowtok[row] = a >> 3; p.epos[a] = row;
    }
    if (bid == 0) {
        {
            const int xq = tid & 7; int off = 0, tot = 0;
            for (int e = xq; e < 256; e += 8) { const int n = ((pc[e] >> 7) + 1) >> 1; if (e < tid) off += n; tot += n; }
            const int t0 = base[tid] >> 7, nte = pc[tid] >> 7;
            for (int i = 0; i < nte; i += 2) p.plist[xq * 192 + off + (i >> 1)] = (t0 + i) | ((i + 1 < nte) ? 0 : 0x40000000);
            if (tid < 64) { int totp = 0; for (int e = (tid & 7); e < 256; e += 8) totp += ((pc[e] >> 7) + 1) >> 1; p.plist[(tid & 7) * 192 + totp + (tid >> 3)] = SH_TILE0 + 2 * tid; }
            if (tid < 8) p.plen[tid] = tot + 8;
        }
        const int nrt = base[256] >> 7;
        for (int i = tid; i < NTILES; i += 256) if (i >= nrt) p.tile_e[i] = (i >= SH_TILE0) ? NEXP : -1;
        const int t0 = base[tid] >> 7, t1 = base[tid + 1] >> 7;
        for (int i = t0; i < t1; ++i) p.tile_e[i] = tid;
    }
    __syncthreads();
}
__device__ __forceinline__ void phase_moe1(char* lds, int bid, int nb, const P& p, int layer, const bf16_t* Xb) {
    const int tid = tidx(), lane = tid & 63, wid = tid >> 6, wr = wid >> 1, wc = wid & 1, fr = lane & 15, fq = lane >> 4;
    const int xq = bid & 7, plen = p.plen[xq];
    for (int ui = bid >> 3; ui < plen * 4; ui += (nb >> 3)) {
        const int nt = ui & 3;
        const int ent = p.plist[xq * 192 + (ui >> 2)];
        const int tile0 = ent & 0xffff, single = (ent >> 30) & 1, tile1 = single ? tile0 : tile0 + 1;
        const int e = p.tile_e[tile0];
        const float* Wg = (e < NEXP) ? p.w_gate + ((size_t)layer * NEXP + e) * (DM * 256) : p.ws_gate + (size_t)layer * (DM * 256);
        const float* Wu = (e < NEXP) ? p.w_up + ((size_t)layer * NEXP + e) * (DM * 256) : p.ws_up + (size_t)layer * (DM * 256);
        Dma3A al; al.base = (const char*)Xb;
#pragma unroll
        for (int i = 0; i < 4; ++i) { int R, C; dma_rc32(lane, wid + 4 * i, R, C); const int tok = p.rowtok[(R < 128 ? tile0 : tile1) * 128 + (R & 127)]; al.voff[i] = (unsigned)(((size_t)tok * DM + C) * 2); }
        Reg3B bl; { const int nq = tid & 31, kg = tid >> 5; const int j = nq * 4, jw = j & 63, w2 = j >> 6; const int col = nt * 64 + w2 * 32 + (jw & 31);
            bl.ldb = 256; bl.bp = ((jw >= 32) ? Wu : Wg) + (size_t)(kg * 4) * 256 + col; }
        f32x4 acc[32];
        gemm_core4(al, bl, DM / 32, acc);
        if (!(wr && single)) {
            const int tile = wr ? tile1 : tile0;
#pragma unroll
            for (int i = 0; i < 8; ++i)
#pragma unroll
                for (int n = 0; n < 2; ++n) {
                    const int row = tile * 128 + i * 16 + fr, col = nt * 64 + wc * 32 + n * 16 + fq * 4;
                    const f32x4 g = acc[i * 4 + n], uu = acc[i * 4 + n + 2];
                    u32x2 w; w.x = pack2(siluf_(g[0]) * uu[0], siluf_(g[1]) * uu[1]); w.y = pack2(siluf_(g[2]) * uu[2], siluf_(g[3]) * uu[3]);
                    *(u32x2*)(p.H + (size_t)row * 256 + col) = w;
                }
        }
    }
}
__device__ __forceinline__ void phase_moe2(char* lds, int bid, int nb, const P& p, int layer) {
    const int tid = tidx(), lane = tid & 63, wid = tid >> 6, wr = wid >> 1, wc = wid & 1, fr = lane & 15, fq = lane >> 4;
    const int xq = bid & 7, plen = p.plen[xq];
    for (int ui = bid >> 3; ui < plen * 8; ui += (nb >> 3)) {
        const int nt = ui & 7;
        const int ent = p.plist[xq * 192 + (ui >> 3)];
        const int tile0 = ent & 0xffff, single = (ent >> 30) & 1, tile1 = single ? tile0 : tile0 + 1;
        const int e = p.tile_e[tile0];
        const float* Wd = (e < NEXP) ? p.w_down + ((size_t)layer * NEXP + e) * (256 * DM) : p.ws_down + (size_t)layer * (256 * DM);
        Dma3A al; al.base = (const char*)p.H;
#pragma unroll
        for (int i = 0; i < 4; ++i) { int R, C; dma_rc32(lane, wid + 4 * i, R, C); al.voff[i] = (unsigned)(((size_t)((R < 128 ? tile0 : tile1) * 128 + (R & 127)) * 256 + C) * 2); }
        Reg3B bl; { const int nq = tid & 31, kg = tid >> 5; bl.ldb = DM; bl.bp = Wd + (size_t)(kg * 4) * DM + nt * 128 + nq * 4; }
        f32x4 acc[32];
        gemm_core4(al, bl, 256 / 32, acc);
        if (!(wr && single)) {
            const int tile = wr ? tile1 : tile0;
#pragma unroll
            for (int i = 0; i < 8; ++i)
#pragma unroll
                for (int n = 0; n < 4; ++n) {
                    const int row = tile * 128 + i * 16 + fr, col = nt * 128 + wc * 64 + n * 16 + fq * 4;
                    const f32x4 a = acc[i * 4 + n];
                    u32x2 w; w.x = pack2(a[0], a[1]); w.y = pack2(a[2], a[3]);
                    *(u32x2*)(p.Y + (size_t)row * DM + col) = w;
                }
        }
    }
}
__device__ __forceinline__ void phase_combine_ln(int bid, int nb, const P& p, const float* X, const float* g, const float* b, float* of, bf16_t* ob) {
    const int lane = tidx() & 63, wid = tidx() >> 6;
    for (int row = bid * 4 + wid; row < NTOK; row += nb * 4) {
        float v[16];
#pragma unroll
        for (int h = 0; h < 2; ++h) {
            const size_t o = (size_t)row * DM + h * 512 + lane * 8;
            const f32x4 r0 = *(const f32x4*)(X + o), r1 = *(const f32x4*)(X + o + 4);
#pragma unroll
            for (int i = 0; i < 4; ++i) { v[h * 8 + i] = DN_ALPHA * r0[i]; v[h * 8 + 4 + i] = DN_ALPHA * r1[i]; }
        }
#pragma unroll
        for (int k = 0; k < 9; ++k) {
            const int yr = (k < 8) ? p.epos[row * 8 + k] : (SH_TILE0 * 128 + row);
            const float w = (k < 8) ? p.ew[row * 8 + k] : 1.0f;
#pragma unroll
            for (int h = 0; h < 2; ++h) {
                const u32x4 y = *(const u32x4*)(p.Y + (size_t)yr * DM + h * 512 + lane * 8);
                v[h * 8 + 0] += w * bf2f(y.x & 0xffffu); v[h * 8 + 1] += w * bf2f(y.x >> 16);
                v[h * 8 + 2] += w * bf2f(y.y & 0xffffu); v[h * 8 + 3] += w * bf2f(y.y >> 16);
                v[h * 8 + 4] += w * bf2f(y.z & 0xffffu); v[h * 8 + 5] += w * bf2f(y.z >> 16);
                v[h * 8 + 6] += w * bf2f(y.w & 0xffffu); v[h * 8 + 7] += w * bf2f(y.w >> 16);
            }
        }
        ln_row_store(v, g, b, of, ob, row, lane);
    }
}

__device__ __forceinline__ void phase_nsa_compress(char* lds, int bid, int nb, const P& p) {
    float* blk = (float*)lds;
    float* hs = blk + 4096;
    const int tid = tidx(), which = tid >> 7, j = tid & 127;
    const float* pe = which ? p.pe_v : p.pe_k; const float* w1 = which ? p.wv1 : p.wk1; const float* w2 = which ? p.wv2 : p.wk2;
    float* outp = which ? p.VC : p.KC;
    for (int u = bid; u < 16 * 127; u += nb) {
        const int bg = u / 127, c = u % 127, b = bg >> 1, g = bg & 1;
        __syncthreads();
        for (int i = j; i < 2048; i += 128) { const int l = i >> 6, d = i & 63; blk[which * 2048 + i] = p.KCV[(size_t)(b * SEQ + 16 * c + l) * 256 + which * 128 + g * 64 + d] + pe[i]; }
        __syncthreads();
        float a = 0.f;
        for (int i = 0; i < 2048; ++i) a += blk[which * 2048 + i] * w1[i * 128 + j];
        hs[which * 128 + j] = gelu_tanh(a);
        __syncthreads();
        if (j < 64) { float o = 0.f; for (int i = 0; i < 128; ++i) o += hs[which * 128 + i] * w2[i * 64 + j]; outp[(size_t)(bg * 127 + c) * 64 + j] = o; }
    }
}
__device__ __forceinline__ void phase_moba_kmean(int bid, int nb, const P& p) {
    const int tid = tidx();
    for (int u = bid; u < NBATCH * 8; u += nb) {
        const int b = u >> 3, j = u & 7;
        const bf16_t* src = p.MK + (size_t)(b * SEQ + j * 256) * 512 + tid * 2;
        float s0 = 0.f, s1 = 0.f;
        for (int r8 = 0; r8 < 256; r8 += 8) {
            unsigned v[8];
#pragma unroll
            for (int i = 0; i < 8; ++i) v[i] = *(const unsigned*)(src + (size_t)(r8 + i) * 512);
#pragma unroll
            for (int i = 0; i < 8; ++i) { s0 += bf2f(v[i] & 0xffffu); s1 += bf2f(v[i] >> 16); }
        }
        const int h = tid >> 5, d = (tid & 31) * 2;
        p.KM[((size_t)(b * 8 + h) * 8 + j) * 64 + d] = s0 * (1.0f / 256.0f);
        p.KM[((size_t)(b * 8 + h) * 8 + j) * 64 + d + 1] = s1 * (1.0f / 256.0f);
    }
}
#define CMP_LDS ((127 * 65 + 127 * 64 + 4 * (64 + 128 + 128)) * 4)
__device__ __forceinline__ void phase_nsa_cmp(char* lds, int bid, int nb, const P& p) {
    float* kc = (float*)lds;
    float* vc = kc + 127 * 65;
    const int tid = tidx(), lane = tid & 63, wid = tid >> 6;
    float* qs = vc + 127 * 64 + wid * 320;
    float* ps = qs + 64;
    float* pp = ps + 128;
    for (int u = bid; u < 16 * 32; u += nb) {
        const int bg = u >> 5, tb = u & 31, b = bg >> 1, g = bg & 1;
        __syncthreads();
        for (int i = tid; i < 127 * 64; i += 256) { const int c = i >> 6, d = i & 63; kc[c * 65 + d] = p.KC[(size_t)bg * 127 * 64 + i]; vc[i] = p.VC[(size_t)bg * 127 * 64 + i]; }
        __syncthreads();
        for (int qi = 0; qi < 16; ++qi) {
            const int t = tb * 64 + wid * 16 + qi;
            const size_t n = (size_t)b * SEQ + t;
            float psum0 = 0.f, psum1 = 0.f;
            for (int i = 0; i < 4; ++i) {
                const int hd = g * 4 + i;
                const float slope = exp2f(-((float)hd + 0.5f));
                qs[lane] = bf2f(p.Qb[n * 512 + hd * 64 + lane]);
                __builtin_amdgcn_wave_barrier();
                float s0 = NEGF, s1 = NEGF;
                const int c0 = lane, c1 = lane + 64;
                const bool v0 = (16 * c0 + 31 <= t), v1 = (c1 < 127) && (16 * c1 + 31 <= t);
                if (v0) { float d = 0.f; for (int k = 0; k < 64; ++k) d += qs[k] * kc[c0 * 65 + k]; s0 = d * 0.125f - slope * (float)(t - (16 * c0 + 31)); }
                if (v1) { float d = 0.f; for (int k = 0; k < 64; ++k) d += qs[k] * kc[c1 * 65 + k]; s1 = d * 0.125f - slope * (float)(t - (16 * c1 + 31)); }
                const float m = wave_max(fmaxf(s0, s1));
                float p0 = v0 ? __expf(s0 - m) : 0.f, p1 = v1 ? __expf(s1 - m) : 0.f;
                const float den = fmaxf(wave_sum(p0 + p1), 1e-30f);
                p0 /= den; p1 /= den;
                psum0 += p0; psum1 += p1;
                ps[c0] = p0; ps[c1] = p1;
                __builtin_amdgcn_wave_barrier();
                float o = 0.f;
                for (int c = 0; c < 127; ++c) o += ps[c] * vc[c * 64 + lane];
                p.OC[n * 512 + hd * 64 + lane] = o;
                __builtin_amdgcn_wave_barrier();
            }
            pp[lane] = psum0; pp[lane + 64] = psum1;
            __builtin_amdgcn_wave_barrier();
            const int j = lane & 31, own = t >> 6;
            float imp = 0.f;
#pragma unroll
            for (int c = 4 * j - 1; c <= 4 * j + 3; ++c) if (c >= 0 && c < 127) imp += pp[c];
            const bool forced = (j == 0) || (j == own) || (j == own - 1);
            const bool valid = j <= own;
            const float val = valid ? (imp + (forced ? 1e4f : 0.f)) : NEGF;
            int rank = 0;
            for (int j2 = 0; j2 < 32; ++j2) { const float o2 = __shfl(val, j2); rank += (o2 > val || (o2 == val && j2 < j)) ? 1 : 0; }
            const unsigned long long bal = __ballot(valid && rank < 16 && lane < 32);
            if (lane == 0) p.SELM[(size_t)bg * SEQ + t] = (unsigned)bal;
            __builtin_amdgcn_wave_barrier();
        }
    }
}
struct AttnState { float m, l, o; };
__device__ __forceinline__ void attn_block(AttnState& st, const float* qs, float* ps, const float* Kb, const float* Vb, int s0, int t, float slope, bool lanevalid) {
    const int lane = tidx() & 63;
    float sc = NEGF;
    if (lanevalid) {
        const float* kr = Kb + (size_t)lane * ODD_IN;
        float d = 0.f;
#pragma unroll
        for (int k = 0; k < 64; k += 4) { const f32x4 kv = *(const f32x4*)(kr + k); d += kv[0] * qs[k] + kv[1] * qs[k + 1] + kv[2] * qs[k + 2] + kv[3] * qs[k + 3]; }
        sc = d * 0.125f - slope * (float)(t - (s0 + lane));
    }
    const float mn = fmaxf(st.m, wave_max(sc));
    const float pr = lanevalid ? __expf(sc - mn) : 0.f;
    const float corr = __expf(st.m - mn);
    st.l = st.l * corr + wave_sum(pr);
    __builtin_amdgcn_wave_barrier();
    ps[lane] = pr;
    __builtin_amdgcn_wave_barrier();
    float acc = 0.f;
    for (int s = 0; s < 64; ++s) acc += ps[s] * Vb[(size_t)s * ODD_IN + lane];
    st.o = st.o * corr + acc; st.m = mn;
    __builtin_amdgcn_wave_barrier();
}
__device__ __forceinline__ void phase_nsa_attn(char* lds, int bid, int nb, const P& p) {
    const int tid = tidx(), lane = tid & 63, wid = tid >> 6;
    float* qs = (float*)lds + wid * 128; float* ps = qs + 64;
    for (int it = bid * 4 + wid; it < NTOK * 8; it += nb * 4) {
        const int hd = it & 7; const int n = it >> 3; const int b = n >> 11, t = n & (SEQ - 1), g = hd >> 2;
        const float slope = exp2f(-((float)hd + 0.5f));
        __builtin_amdgcn_wave_barrier();
        qs[lane] = p.U[(size_t)n * ODD_IN + hd * 64 + lane];
        __builtin_amdgcn_wave_barrier();
        const unsigned mask = p.SELM[(size_t)(b * 2 + g) * SEQ + t];
        const int own = t >> 6;
        AttnState ss; ss.m = NEGF; ss.l = 0.f; ss.o = 0.f;
        for (int j = 0; j <= own; ++j) if ((mask >> j) & 1u) {
            const float* base = p.U + (size_t)(b * SEQ + j * 64) * ODD_IN + g * 64;
            attn_block(ss, qs, ps, base + 768, base + 896, j * 64, t, slope, (j * 64 + lane) <= t);
        }
        AttnState sw; sw.m = NEGF; sw.l = 0.f; sw.o = 0.f;
        const int jb0 = (t >= 511) ? ((t - 511) >> 6) : 0;
        for (int j = jb0; j <= own; ++j) {
            const float* base = p.U + (size_t)(b * SEQ + j * 64) * ODD_IN + g * 64;
            const int s = j * 64 + lane;
            attn_block(sw, qs, ps, base + 1024, base + 1152, j * 64, t, slope, (s <= t) && (t - s < 512));
        }
        const float os = ss.o / fmaxf(ss.l, 1e-30f), ow = sw.o / fmaxf(sw.l, 1e-30f);
        const float oc = p.OC[(size_t)n * 512 + hd * 64 + lane];
        const float* gp = p.U + (size_t)n * ODD_IN + 1280 + hd * 3;
        const float y = sigmoidf_(gp[0]) * oc + sigmoidf_(gp[1]) * os + sigmoidf_(gp[2]) * ow;
        p.MIX[(size_t)n * DM + hd * 64 + lane] = (bf16_t)f2bf(y);
    }
}
__device__ __forceinline__ void phase_moba_attn(char* lds, int bid, int nb, const P& p) {
    const int tid = tidx(), lane = tid & 63, wid = tid >> 6;
    float* qs = (float*)lds + wid * 128; float* ps = qs + 64;
    for (int it = bid * 4 + wid; it < NTOK * 8; it += nb * 4) {
        const int hd = it & 7; const int n = it >> 3; const int b = n >> 11, t = n & (SEQ - 1);
        const float slope = exp2f(-((float)hd + 1.0f));
        const float qv = p.U[(size_t)n * ODD_IN + 1304 + hd * 64 + lane];
        __builtin_amdgcn_wave_barrier();
        qs[lane] = qv;
        __builtin_amdgcn_wave_barrier();
        const int ob = t >> 8;
        float gate[8];
#pragma unroll
        for (int j = 0; j < 8; ++j) gate[j] = (j < ob) ? wave_sum(qv * p.KM[((size_t)(b * 8 + hd) * 8 + j) * 64 + lane]) : NEGF;
        unsigned selm = 0;
#pragma unroll
        for (int j = 0; j < 8; ++j) {
            int rank = 0;
#pragma unroll
            for (int j2 = 0; j2 < 8; ++j2) rank += (gate[j2] > gate[j] || (gate[j2] == gate[j] && j2 < j)) ? 1 : 0;
            if (j < ob && rank < 3) selm |= 1u << j;
        }
        AttnState st; st.m = NEGF; st.l = 0.f; st.o = 0.f;
        for (int j = 0; j < ob; ++j) if ((selm >> j) & 1u) {
            for (int sb = 0; sb < 4; ++sb) {
                const float* base = p.U + (size_t)(b * SEQ + j * 256 + sb * 64) * ODD_IN + hd * 64;
                attn_block(st, qs, ps, base + 1816, base + 2328, j * 256 + sb * 64, t, slope, true);
            }
        }
        for (int sb = 0; sb <= ((t & 255) >> 6); ++sb) {
            const float* base = p.U + (size_t)(b * SEQ + ob * 256 + sb * 64) * ODD_IN + hd * 64;
            attn_block(st, qs, ps, base + 1816, base + 2328, ob * 256 + sb * 64, t, slope, (ob * 256 + sb * 64 + lane) <= t);
        }
        p.MIX[(size_t)n * DM + 512 + hd * 64 + lane] = (bf16_t)f2bf(st.o / fmaxf(st.l, 1e-30f));
    }
}


__device__ __forceinline__ void gemm_t_unit(const bf16_t* Wt, int wrow0, const bf16_t* X, int tok0, bf16_t* dst, int ncol, int col0) {
    const int tid = tidx(), lane = tid & 63, wid = tid >> 6, wr = wid >> 1, wc = wid & 1, fr = lane & 15, fq = lane >> 4;
    Dma3A al; al.set_dense(Wt, wrow0, DM); Dma3B bl; bl.set(X, X, tok0, DM, 1 << 30);
    f32x4 acc[32];
    gemm_core4(al, bl, DM / 32, acc);
#pragma unroll
    for (int i = 0; i < 8; ++i)
#pragma unroll
        for (int n = 0; n < 4; ++n) {
            const int vc = col0 + wr * 128 + i * 16 + fr, r0 = tok0 + wc * 64 + n * 16 + fq * 4;
            const int b = r0 >> 11, t0 = r0 & (SEQ - 1);
            const f32x4 a = acc[i * 4 + n];
            u32x2 w; w.x = pack2(a[0], a[1]); w.y = pack2(a[2], a[3]);
            *(u32x2*)(dst + ((size_t)(b * ncol + vc)) * SEQ + t0) = w;
        }
}
__device__ __forceinline__ void phase_inproj0(char* lds, int bid, int nb, const P& p) {
    const int ntn = 20, nk = DM / 32;
    const int tid = tidx(), lane = tid & 63, wid = tid >> 6, wr = wid >> 1, wc = wid & 1, fr = lane & 15, fq = lane >> 4;
    for (int i = bid * 256 + tid; i < 2 * 8 * 64 * 64; i += nb * 256) {
        const int which = i >> 15, e = i & 32767, h = e >> 12, j = (e >> 6) & 63, ii = e & 63;
        const float v = (which ? p.wx : p.wa)[(h * 64 + ii) * 64 + j];
        (which ? p.WXT : p.WAT)[e] = (bf16_t)f2bf(v);
    }
    for (int jj = 0;; ++jj) {
        int tm, tn; if (!dense_unit3(bid, nb, jj, ntn, tm, tn)) break;
        Dma3A al; al.set_dense(p.XIb, tm * 256, DM); Dma3B bl; bl.set(p.WIN0, p.WIN0, tn * 128, DM, 1 << 30);
        f32x4 acc[32];
        gemm_core4(al, bl, nk, acc);
#pragma unroll
        for (int i = 0; i < 8; ++i)
#pragma unroll
            for (int n = 0; n < 4; ++n) {
                const int row = tm * 256 + wr * 128 + i * 16 + fr, col = tn * 128 + wc * 64 + n * 16 + fq * 4;
                const f32x4 a = acc[i * 4 + n];
                u32x2 w; w.x = pack2(a[0], a[1]); w.y = pack2(a[2], a[3]);
                *(u32x2*)(p.UB0 + (size_t)row * 2560 + col) = w;
            }
    }
    for (int u = bid; u < 2 * 128; u += nb) { const int pn = u & 1, tt = u >> 1; gemm_t_unit(p.WIN0, 2560 + pn * 256, p.XIb, tt * 128, p.VHt, 512, pn * 256); }
}

__device__ __forceinline__ int lds_off128(int r, int c) {
    const int st = (r >> 4) * 4 + (c >> 5), ob = (r & 15) * 64 + (c & 31) * 2;
    return st * 1024 + (ob ^ (((ob >> 9) & 1) << 5));
}
__device__ __forceinline__ float softplusf_(float x) { return fmaxf(x, 0.f) + log1pf(__expf(-fabsf(x))); }

#define LRU1_LDS (4 * 8192)
__device__ __forceinline__ void lru1_unit(char* lds, const P& p, int b, int ck) {
    const int tid = tidx(), lane = tid & 63, w = tid >> 6, fr = lane & 15, fg = lane >> 4;
    char* xt = lds + w * 8192;
    const size_t n0 = (size_t)b * SEQ + ck * 64;
    __syncthreads();
    for (int hh = 0; hh < 2; ++hh) {
        const int h = w * 2 + hh, c = h * 64 + lane;
        const float cw0 = p.conv_w[c], cw1 = p.conv_w[512 + c], cw2 = p.conv_w[1024 + c], cw3 = p.conv_w[1536 + c], cb = p.conv_b[c];
        float xm3 = 0.f, xm2 = 0.f, xm1 = 0.f;
        if (ck > 0) { xm3 = bf2f(p.UB0[(n0 - 3) * 2560 + c]); xm2 = bf2f(p.UB0[(n0 - 2) * 2560 + c]); xm1 = bf2f(p.UB0[(n0 - 1) * 2560 + c]); }
        __builtin_amdgcn_wave_barrier();
#pragma unroll 8
        for (int t = 0; t < 64; ++t) {
            const float x = bf2f(p.UB0[(n0 + t) * 2560 + c]);
            const float xc = cb + cw0 * xm3 + cw1 * xm2 + cw2 * xm1 + cw3 * x;
            xm3 = xm2; xm2 = xm1; xm1 = x;
            *(bf16_t*)(xt + lds_off(t, lane & ~7) + (lane & 7) * 2) = (bf16_t)f2bf(xc);
        }
        __builtin_amdgcn_wave_barrier();
        for (int jt = 0; jt < 4; ++jt) {
            const int cj = h * 64 + jt * 16 + fr;
            bf16x8 wra[2], wri[2];
#pragma unroll
            for (int ks = 0; ks < 2; ++ks) {
                wra[ks] = *(const bf16x8*)(p.WAT + (size_t)(h * 64 + jt * 16 + fr) * 64 + ks * 32 + fg * 8);
                wri[ks] = *(const bf16x8*)(p.WXT + (size_t)(h * 64 + jt * 16 + fr) * 64 + ks * 32 + fg * 8);
            }
            const float bav = p.ba[cj], bxv = p.bx[cj], sp = softplusf_(-p.lam[cj]);
            float mA = 1.f, mB = 0.f;
#pragma unroll
            for (int tt = 0; tt < 4; ++tt) {
                const bf16x8 a0 = *(const bf16x8*)(xt + lds_off(tt * 16 + fr, fg * 8)), a1 = *(const bf16x8*)(xt + lds_off(tt * 16 + fr, 32 + fg * 8));
                f32x4 ar = __builtin_amdgcn_mfma_f32_16x16x32_bf16(a0, wra[0], (f32x4){0.f, 0.f, 0.f, 0.f}, 0, 0, 0);
                ar = __builtin_amdgcn_mfma_f32_16x16x32_bf16(a1, wra[1], ar, 0, 0, 0);
                f32x4 ai = __builtin_amdgcn_mfma_f32_16x16x32_bf16(a0, wri[0], (f32x4){0.f, 0.f, 0.f, 0.f}, 0, 0, 0);
                ai = __builtin_amdgcn_mfma_f32_16x16x32_bf16(a1, wri[1], ai, 0, 0, 0);
                float sA = 1.f, sB = 0.f;
#pragma unroll
                for (int r = 0; r < 4; ++r) {
                    const int t = tt * 16 + fg * 4 + r;
                    const float rg = sigmoidf_(ar[r] + bav), ig = sigmoidf_(ai[r] + bxv);
                    const float log_a = -8.0f * rg * sp;
                    const float a = __expf(log_a);
                    const float mult = (ck == 0 && t == 0) ? 1.0f : sqrtf(-expm1f(2.0f * log_a));
                    const int jj = jt * 16 + fr;
                    const float xcv = bf2f(*(const bf16_t*)(xt + lds_off(t, jj & ~7) + (jj & 7) * 2));
                    const float bt = mult * ig * xcv;
                    p.LA[(n0 + t) * 512 + cj] = a; p.LB[(n0 + t) * 512 + cj] = bt;
                    sB = a * sB + bt; sA = a * sA;
                }
                float tA = 1.f, tB = 0.f;
#pragma unroll
                for (int g2 = 0; g2 < 4; ++g2) {
                    const float oA = __shfl(sA, g2 * 16 + fr), oB = __shfl(sB, g2 * 16 + fr);
                    tB = oA * tB + oB; tA = oA * tA;
                }
                mB = tA * mB + tB; mA = tA * mA;
            }
            if (fg == 0) { p.CSA[((size_t)b * 32 + ck) * 512 + cj] = mA; p.CSB[((size_t)b * 32 + ck) * 512 + cj] = mB; }
        }
        __builtin_amdgcn_wave_barrier();
    }
}
__device__ __forceinline__ void lru2_unit(const P& p, int b, int ck) {
    const int tid = tidx();
    const size_t n0 = (size_t)b * SEQ + ck * 64;
#pragma unroll
    for (int cc = 0; cc < 2; ++cc) {
        const int c = tid + 256 * cc;
        float h = 0.f;
        for (int c2 = 0; c2 < ck; ++c2) h = p.CSA[((size_t)b * 32 + c2) * 512 + c] * h + p.CSB[((size_t)b * 32 + c2) * 512 + c];
        for (int t8 = 0; t8 < 64; t8 += 8) {
            float la[8], lb[8], gb[8];
#pragma unroll
            for (int i = 0; i < 8; ++i) { la[i] = p.LA[(n0 + t8 + i) * 512 + c]; lb[i] = p.LB[(n0 + t8 + i) * 512 + c]; gb[i] = bf2f(p.UB0[(n0 + t8 + i) * 2560 + 512 + c]); }
#pragma unroll
            for (int i = 0; i < 8; ++i) { h = la[i] * h + lb[i]; p.MIX[(n0 + t8 + i) * DM + c] = (bf16_t)f2bf(h * gelu_tanh(gb[i])); }
        }
    }
}

#define HG1_LDS (2 * 16384)
__device__ __forceinline__ float hg_lb(const P& p, int ch) {
    const float l0 = p.hg_lb[ch], l1 = p.hg_lb[512 + ch], l2 = p.hg_lb[1024 + ch]; const float mx = fmaxf(l0, fmaxf(l1, l2));
    const float e0 = __expf(l0 - mx), e1 = __expf(l1 - mx), e2 = __expf(l2 - mx); return e0 / (e0 + e1 + e2);
}
__device__ __forceinline__ void hg1_unit(char* lds, const P& p, int b, int h, int ck) {
    const int tid = tidx(), lane = tid & 63, w = tid >> 6, fr = lane & 15, fg = lane >> 4;
    char* kh = lds;
    char* vt = lds + 16384;
    const size_t n0 = (size_t)b * SEQ + ck * 64;
    const int bhc = (b * 4 + h) * 32 + ck;
    __syncthreads();
    if (tid < 128) {
        const int k = tid, ch = h * 128 + k;
        const float lbv = hg_lb(p, ch);
        float cl = 0.f;
        for (int t = 0; t < 64; ++t) { const float f = lbv + (1.0f - lbv) * sigmoidf_(bf2f(p.UB0[(n0 + t) * 2560 + 1536 + ch])); cl += __logf(f); }
        p.DV[(size_t)bhc * 128 + k] = __expf(cl);
        float cum = 0.f;
        for (int t8 = 0; t8 < 64; t8 += 8) {
            float kv[8];
#pragma unroll
            for (int i = 0; i < 8; ++i) { const float f = lbv + (1.0f - lbv) * sigmoidf_(bf2f(p.UB0[(n0 + t8 + i) * 2560 + 1536 + ch])); cum += __logf(f); kv[i] = (1.0f - f) * __expf(cl - cum); }
            u32x4 wv; wv.x = pack2(kv[0], kv[1]); wv.y = pack2(kv[2], kv[3]); wv.z = pack2(kv[4], kv[5]); wv.w = pack2(kv[6], kv[7]);
            *(u32x4*)(kh + lds_off(k, t8)) = wv;
        }
    } else {
        const int q = tid - 128;
#pragma unroll
        for (int i = 0; i < 8; ++i) { const int pc = q + 128 * i, v = pc >> 3, c8 = pc & 7;
            *(u32x4*)(vt + lds_off(v, c8 * 8)) = *(const u32x4*)(p.VHt + ((size_t)(b * 512 + h * 128 + v)) * SEQ + ck * 64 + c8 * 8); }
    }
    __syncthreads();
    bf16_t* ut = p.UT + (size_t)bhc * 16384;
#pragma unroll
    for (int kk = 0; kk < 2; ++kk) {
        const int kt = w * 2 + kk;
        const bf16x8 a0 = *(const bf16x8*)(kh + lds_off(kt * 16 + fr, fg * 8)), a1 = *(const bf16x8*)(kh + lds_off(kt * 16 + fr, 32 + fg * 8));
#pragma unroll
        for (int v8 = 0; v8 < 8; ++v8) {
            const bf16x8 b0 = *(const bf16x8*)(vt + lds_off(v8 * 16 + fr, fg * 8)), b1 = *(const bf16x8*)(vt + lds_off(v8 * 16 + fr, 32 + fg * 8));
            f32x4 acc = __builtin_amdgcn_mfma_f32_16x16x32_bf16(a0, b0, (f32x4){0.f, 0.f, 0.f, 0.f}, 0, 0, 0);
            acc = __builtin_amdgcn_mfma_f32_16x16x32_bf16(a1, b1, acc, 0, 0, 0);
            u32x2 wv; wv.x = pack2(acc[0], acc[1]); wv.y = pack2(acc[2], acc[3]);
            *(u32x2*)(ut + (size_t)(v8 * 16 + fr) * 128 + kt * 16 + fg * 4) = wv;
        }
    }
}
__device__ __forceinline__ void phase_hg2(int bid, int nb, const P& p) {
    for (int it = bid * 256 + tidx(); it < 32 * 4096; it += nb * 256) {
        const int bh = it >> 12, e4 = (it & 4095) * 4, k4 = e4 & 127;
        float S0 = 0.f, S1 = 0.f, S2 = 0.f, S3 = 0.f;
#pragma unroll 4
        for (int c = 0; c < 32; ++c) {
            const size_t o = ((size_t)(bh * 32 + c)) * 16384 + e4;
            u32x2 wv; wv.x = pack2(S0, S1); wv.y = pack2(S2, S3);
            *(u32x2*)(p.SP + o) = wv;
            const u32x2 uv = *(const u32x2*)(p.UT + o);
            const f32x4 dv = *(const f32x4*)(p.DV + (size_t)(bh * 32 + c) * 128 + k4);
            S0 = dv[0] * S0 + bf2f(uv.x & 0xffffu); S1 = dv[1] * S1 + bf2f(uv.x >> 16);
            S2 = dv[2] * S2 + bf2f(uv.y & 0xffffu); S3 = dv[3] * S3 + bf2f(uv.y >> 16);
        }
    }
}
#define HG3_QP 0
#define HG3_KP 40960
#define HG3_VT (40960 + 16384)
#define HG3_LDS (40960 + 16384 + 128 * 144)
__device__ __forceinline__ int hg3_qp_base(int j) { return j == 0 ? 0 : (j == 1 ? 16384 : (j == 2 ? 28672 : 36864)); }
__device__ __forceinline__ void hg3_unit(char* lds, const P& p, int b, int h, int ck) {
    const int tid = tidx(), lane = tid & 63, w = tid >> 6, fr = lane & 15, fg = lane >> 4;
    char* qp = lds + HG3_QP; char* kp = lds + HG3_KP; char* vt = lds + HG3_VT;
    const size_t n0 = (size_t)b * SEQ + ck * 64;
    const int bhc = (b * 4 + h) * 32 + ck;
    __syncthreads();
    if (tid < 128) {
        const int k = tid, ch = h * 128 + k;
        const float lbv = hg_lb(p, ch);
        const int ke = (k & 7) * 2, k8 = k & ~7;
        float cum = 0.f, r1 = 0.f, r2 = 0.f, r3 = 0.f;
#pragma unroll
        for (int t = 0; t < 64; ++t) {
            const int i = t >> 4;
            const float qv = siluf_(bf2f(p.UB0[(n0 + t) * 2560 + 1024 + ch]));
            const float f = lbv + (1.0f - lbv) * sigmoidf_(bf2f(p.UB0[(n0 + t) * 2560 + 1536 + ch]));
            cum += __logf(f);
            const float ri = (i == 0) ? 0.f : (i == 1 ? r1 : (i == 2 ? r2 : r3));
            *(bf16_t*)(kp + lds_off128(t, k8) + ke) = (bf16_t)f2bf((1.0f - f) * __expf(fminf(ri - cum, 80.0f)));
            *(bf16_t*)(qp + hg3_qp_base(0) + lds_off128(t, k8) + ke) = (bf16_t)f2bf(qv * __expf(cum));
            if (i >= 1) *(bf16_t*)(qp + hg3_qp_base(1) + lds_off128(t - 16, k8) + ke) = (bf16_t)f2bf(qv * __expf(cum - r1));
            if (i >= 2) *(bf16_t*)(qp + hg3_qp_base(2) + lds_off128(t - 32, k8) + ke) = (bf16_t)f2bf(qv * __expf(cum - r2));
            if (i >= 3) *(bf16_t*)(qp + hg3_qp_base(3) + lds_off128(t - 48, k8) + ke) = (bf16_t)f2bf(qv * __expf(cum - r3));
            if (t == 15) r1 = cum; if (t == 31) r2 = cum; if (t == 47) r3 = cum;
        }
    } else {
        const int q = tid - 128;
#pragma unroll
        for (int i = 0; i < 8; ++i) { const int pc = q + 128 * i, v = pc >> 3, c8 = pc & 7;
            *(u32x4*)(vt + v * 144 + c8 * 16) = *(const u32x4*)(p.VHt + ((size_t)(b * 512 + h * 128 + v)) * SEQ + ck * 64 + c8 * 8); }
    }
    __syncthreads();
    f32x4 acc[8];
#pragma unroll
    for (int v8 = 0; v8 < 8; ++v8) acc[v8] = (f32x4){0.f, 0.f, 0.f, 0.f};
    if (ck > 0) {
        const bf16_t* sp = p.SP + (size_t)bhc * 16384;
#pragma unroll
        for (int ks = 0; ks < 4; ++ks) {
            const bf16x8 bq = *(const bf16x8*)(qp + hg3_qp_base(0) + lds_off128(w * 16 + fr, ks * 32 + fg * 8));
#pragma unroll
            for (int v8 = 0; v8 < 8; ++v8) {
                const bf16x8 as = *(const bf16x8*)(sp + (size_t)(v8 * 16 + fr) * 128 + ks * 32 + fg * 8);
                acc[v8] = __builtin_amdgcn_mfma_f32_16x16x32_bf16(as, bq, acc[v8], 0, 0, 0);
            }
        }
    }
#pragma unroll
    for (int jp = 0; jp < 2; ++jp) {
        if (2 * jp > w) continue;
        f32x4 at[2];
#pragma unroll
        for (int jj = 0; jj < 2; ++jj) {
            const int j = 2 * jp + jj;
            at[jj] = (f32x4){0.f, 0.f, 0.f, 0.f};
            if (j <= w) {
#pragma unroll
                for (int ks = 0; ks < 4; ++ks) {
                    const bf16x8 ak = *(const bf16x8*)(kp + lds_off128(j * 16 + fr, ks * 32 + fg * 8));
                    const bf16x8 bq = *(const bf16x8*)(qp + hg3_qp_base(j) + lds_off128((w - j) * 16 + fr, ks * 32 + fg * 8));
                    at[jj] = __builtin_amdgcn_mfma_f32_16x16x32_bf16(ak, bq, at[jj], 0, 0, 0);
                }
                if (j == w) {
#pragma unroll
                    for (int r = 0; r < 4; ++r) at[jj][r] = (fg * 4 + r <= fr) ? at[jj][r] : 0.f;
                }
            }
        }
        u32x4 pw; pw.x = pack2(at[0][0], at[0][1]); pw.y = pack2(at[0][2], at[0][3]); pw.z = pack2(at[1][0], at[1][1]); pw.w = pack2(at[1][2], at[1][3]);
        const bf16x8 pf = __builtin_bit_cast(bf16x8, pw);
#pragma unroll
        for (int v8 = 0; v8 < 8; ++v8) {
            const char* vb = vt + (v8 * 16 + fr) * 144 + (jp * 32 + fg * 4) * 2;
            const u32x2 v0 = *(const u32x2*)vb, v1 = *(const u32x2*)(vb + 32);
            u32x4 vv; vv.x = v0.x; vv.y = v0.y; vv.z = v1.x; vv.w = v1.y;
            acc[v8] = __builtin_amdgcn_mfma_f32_16x16x32_bf16(__builtin_bit_cast(bf16x8, vv), pf, acc[v8], 0, 0, 0);
        }
    }
    float ss = 0.f;
#pragma unroll
    for (int v8 = 0; v8 < 8; ++v8)
#pragma unroll
        for (int r = 0; r < 4; ++r) ss += acc[v8][r] * acc[v8][r];
    ss += __shfl_xor(ss, 16); ss += __shfl_xor(ss, 32);
    const float rs = rsqrtf(ss * (1.0f / 128.0f) + 1e-6f);
    const size_t n = n0 + w * 16 + fr;
#pragma unroll
    for (int v8 = 0; v8 < 8; ++v8) {
        const int vcol = h * 128 + v8 * 16 + fg * 4;
        const u32x2 gv = *(const u32x2*)(p.UB0 + n * 2560 + 2048 + vcol);
        const f32x4 ng = *(const f32x4*)(p.hg_ng + vcol);
        const float y0 = acc[v8][0] * rs * ng[0] * sigmoidf_(bf2f(gv.x & 0xffffu)), y1 = acc[v8][1] * rs * ng[1] * sigmoidf_(bf2f(gv.x >> 16));
        const float y2 = acc[v8][2] * rs * ng[2] * sigmoidf_(bf2f(gv.y & 0xffffu)), y3 = acc[v8][3] * rs * ng[3] * sigmoidf_(bf2f(gv.y >> 16));
        u32x2 wv; wv.x = pack2(y0, y1); wv.y = pack2(y2, y3);
        *(u32x2*)(p.MIX + n * DM + 512 + vcol) = wv;
    }
}
__device__ __forceinline__ void phase_mix0_a(char* lds, int bid, int nb, const P& p) {
    for (int u = bid; u < 256 + 1024; u += nb) {
        if (u < 256) lru1_unit(lds, p, u >> 5, u & 31);
        else { const int v = u - 256; hg1_unit(lds, p, v >> 7, (v >> 5) & 3, v & 31); }
    }
    __syncthreads();
}
__device__ __forceinline__ void phase_mix0_c(char* lds, int bid, int nb, const P& p) {
    for (int u = bid; u < 1024 + 256; u += nb) {
        if (u < 1024) hg3_unit(lds, p, u >> 7, (u >> 5) & 3, u & 31);
        else { const int v = u - 1024; lru2_unit(p, v >> 5, v & 31); }
    }
    __syncthreads();
}

#ifndef KEEP_U
#define KEEP_U 0
#endif
__device__ __forceinline__ int vcol_actual(int v) { return v < 1280 ? v : (v < 2816 ? v + 24 : v - 1536); }
__device__ __forceinline__ void phase_inproj1(char* lds, int bid, int nb, const P& p) {
    const int ntn = 17, nk = DM / 32;
    const int tid = tidx(), lane = tid & 63, wid = tid >> 6, wr = wid >> 1, wc = wid & 1, fr = lane & 15, fq = lane >> 4;
    for (int i = bid * 256 + tid; i < 2 * 2048 * 128 / 4; i += nb * 256) *(f32x4*)(p.HID + (size_t)i * 4) = (f32x4){0.f, 0.f, 0.f, 0.f};
    for (int jj = 0;; ++jj) {
        int tm, tn; if (!dense_unit3(bid, nb, jj, ntn, tm, tn)) break;
        Dma3A al; al.set_dense(p.XBb, tm * 256, DM); Dma3B bl; bl.set(p.WIN1, p.WIN1, tn * 128, DM, 1 << 30);
        f32x4 acc[32];
        gemm_core4(al, bl, nk, acc);
#pragma unroll
        for (int i = 0; i < 8; ++i)
#pragma unroll
            for (int n = 0; n < 4; ++n) {
                const int row = tm * 256 + wr * 128 + i * 16 + fr, vc = tn * 128 + wc * 64 + n * 16 + fq * 4;
                const f32x4 a = acc[i * 4 + n];
                u32x2 w; w.x = pack2(a[0], a[1]); w.y = pack2(a[2], a[3]);
                if (tn < 4) *(u32x2*)(p.Qb + (size_t)row * 512 + vc) = w;
                else if (tn < 6) *(f32x4*)(p.KCV + (size_t)row * 256 + vc - 512) = a;
                else if (tn == 6) *(u32x2*)(p.KS + (size_t)row * 128 + vc - 768) = w;
                else if (tn == 7) *(u32x2*)(p.KW + (size_t)row * 128 + vc - 896) = w;
                else if (tn < 12) *(u32x2*)(p.MQ + (size_t)row * 512 + vc - 1024) = w;
                else if (tn < 16) *(u32x2*)(p.MK + (size_t)row * 512 + vc - 1536) = w;
                else if (vc < 2072) *(f32x4*)(p.GATES + (size_t)row * 24 + vc - 2048) = a;
            }
    }
    for (int u = bid; u < 3 * 128; u += nb) {
        const int pn = u % 3, tt = u / 3;
        if (pn == 0) {
            const int wrr = tidx() >> 7;
            gemm_t_unit(p.WIN1, 2176, p.XBb, tt * 128, wrr ? p.VWt - (size_t)128 * SEQ : p.VSt, 128, 0);
        } else gemm_t_unit(p.WIN1, 2432 + (pn - 1) * 256, p.XBb, tt * 128, p.MVt, 512, (pn - 1) * 256);
    }
}
__device__ __forceinline__ void phase_moba_gate(int bid, int nb, const P& p) {
    const int lane = tidx() & 63, wid = tidx() >> 6;
    for (int it = bid * 4 + wid; it < NTOK * 8; it += nb * 4) {
        const int hd = it & 7; const int n = it >> 3; const int b = n >> 11, t = n & (SEQ - 1);
        const float qv = bf2f(p.MQ[(size_t)n * 512 + hd * 64 + lane]);
        const int ob = t >> 8;
        float gate[8];
#pragma unroll
        for (int j = 0; j < 8; ++j) gate[j] = (j < ob) ? wave_sum(qv * p.KM[((size_t)(b * 8 + hd) * 8 + j) * 64 + lane]) : NEGF;
        unsigned selm = 0;
#pragma unroll
        for (int j = 0; j < 8; ++j) {
            int rank = 0;
#pragma unroll
            for (int j2 = 0; j2 < 8; ++j2) rank += (gate[j2] > gate[j] || (gate[j2] == gate[j] && j2 < j)) ? 1 : 0;
            if (j < ob && rank < 3) selm |= 1u << j;
        }
        if (lane == 0) p.MSEL[(size_t)(b * 8 + hd) * SEQ + t] = selm;
    }
}

#define ATT_K_BYTES 8192
#define ATT_V_STRIDE 144
#define ATT_TILE_BYTES (ATT_K_BYTES + 64 * ATT_V_STRIDE)
#define ATT_ORDER_OFF ATT_TILE_BYTES
#define ATT_RED_OFF (ATT_ORDER_OFF + 8192)
struct TileRegs { u32x4 k[2], v[2]; };
__device__ __forceinline__ void att_load_tile(TileRegs& R, const bf16_t* Kg, int ldk, const bf16_t* Vg) {
#pragma unroll
    for (int i = 0; i < 2; ++i) { const int pc = tidx() + 256 * i, row = pc >> 3, ch = pc & 7;
        R.k[i] = *(const u32x4*)(Kg + (size_t)row * ldk + ch * 8); R.v[i] = *(const u32x4*)(Vg + (size_t)row * SEQ + ch * 8); }
}
__device__ __forceinline__ void att_store_tile(const TileRegs& R, char* lds) {
#pragma unroll
    for (int i = 0; i < 2; ++i) { const int pc = tidx() + 256 * i, row = pc >> 3, ch = pc & 7;
        *(u32x4*)(lds + lds_off(row, ch * 8)) = R.k[i]; *(u32x4*)(lds + ATT_K_BYTES + row * ATT_V_STRIDE + ch * 16) = R.v[i]; }
}
struct AttState { f32x4 O[4][2]; float m[2], l[2]; };
__device__ __forceinline__ void att_reset(AttState& S) {
#pragma unroll
    for (int q = 0; q < 2; ++q) { S.m[q] = NEGF; S.l[q] = 0.f;
#pragma unroll
        for (int d = 0; d < 4; ++d) S.O[d][q] = (f32x4){0.f, 0.f, 0.f, 0.f}; }
}
template <bool MASKED>
__device__ __forceinline__ void att_step(const char* lds, const bf16x8 (&qf)[2][2], AttState& S, float c1, float slope2,
                                         int s0, int tq0, unsigned selbits  , int winlimit) {
    const int lane = tidx() & 63, fr = lane & 15, fg = lane >> 4;
    const char* ldsV = lds + ATT_K_BYTES;
    const float offbase = slope2 * (float)s0;
    const float cbase = slope2 * (float)(fg * 4);
    f32x4 s[2][4];
#pragma unroll
    for (int kt = 0; kt < 4; ++kt) {
        const bf16x8 k0 = *(const bf16x8*)(lds + lds_off(kt * 16 + fr, fg * 8)), k1 = *(const bf16x8*)(lds + lds_off(kt * 16 + fr, 32 + fg * 8));
#pragma unroll
        for (int qt = 0; qt < 2; ++qt) {
            s[qt][kt] = __builtin_amdgcn_mfma_f32_16x16x32_bf16(k0, qf[qt][0], (f32x4){0.f, 0.f, 0.f, 0.f}, 0, 0, 0);
            s[qt][kt] = __builtin_amdgcn_mfma_f32_16x16x32_bf16(k1, qf[qt][1], s[qt][kt], 0, 0, 0);
        }
    }
    __builtin_amdgcn_sched_barrier(0);
    u32x4 pf[2][2];
#pragma unroll
    for (int qt = 0; qt < 2; ++qt) {
        const int tq = tq0 + qt * 16 + fr;
        const float off = ((selbits >> qt) & 1u) ? (offbase - slope2 * (float)tq) : -INFINITY;
        float mx = -INFINITY;
#pragma unroll
        for (int kt = 0; kt < 4; ++kt)
#pragma unroll
            for (int r = 0; r < 4; ++r) {
                float y = fmaf(s[qt][kt][r], c1, fmaf(slope2, (float)(kt * 16 + r), cbase));
                if (MASKED) { const int key = s0 + kt * 16 + fg * 4 + r; const bool ok = (key <= tq) && (tq - key < winlimit); y = ok ? y : -INFINITY; }
                s[qt][kt][r] = y; mx = fmaxf(mx, y);
            }
        mx = fmaxf(mx, __shfl_xor(mx, 16)); mx = fmaxf(mx, __shfl_xor(mx, 32));
        const float mnew = fmaxf(S.m[qt], mx + off);
        const float alpha = __builtin_amdgcn_exp2f(S.m[qt] - mnew);
        S.m[qt] = mnew;
        const float thr = mnew - off;
        float ls = 0.f;
#pragma unroll
        for (int kt = 0; kt < 4; ++kt)
#pragma unroll
            for (int r = 0; r < 4; ++r) { const float pr = __builtin_amdgcn_exp2f(s[qt][kt][r] - thr); s[qt][kt][r] = pr; ls += pr; }
        S.l[qt] = S.l[qt] * alpha + ls;
#pragma unroll
        for (int dt = 0; dt < 4; ++dt) S.O[dt][qt] *= alpha;
#pragma unroll
        for (int kk = 0; kk < 2; ++kk) {
            pf[qt][kk].x = pack2(s[qt][2 * kk][0], s[qt][2 * kk][1]); pf[qt][kk].y = pack2(s[qt][2 * kk][2], s[qt][2 * kk][3]);
            pf[qt][kk].z = pack2(s[qt][2 * kk + 1][0], s[qt][2 * kk + 1][1]); pf[qt][kk].w = pack2(s[qt][2 * kk + 1][2], s[qt][2 * kk + 1][3]);
        }
    }
    __builtin_amdgcn_sched_barrier(0);
#pragma unroll
    for (int kk = 0; kk < 2; ++kk)
#pragma unroll
        for (int dt = 0; dt < 4; ++dt) {
            const char* vb = ldsV + (dt * 16 + fr) * ATT_V_STRIDE + (kk * 32 + fg * 4) * 2;
            const u32x2 v0 = *(const u32x2*)vb, v1 = *(const u32x2*)(vb + 32);
            u32x4 vv; vv.x = v0.x; vv.y = v0.y; vv.z = v1.x; vv.w = v1.y;
            const bf16x8 vf = __builtin_bit_cast(bf16x8, vv);
#pragma unroll
            for (int qt = 0; qt < 2; ++qt) S.O[dt][qt] = __builtin_amdgcn_mfma_f32_16x16x32_bf16(vf, __builtin_bit_cast(bf16x8, pf[qt][kk]), S.O[dt][qt], 0, 0, 0);
        }
    __builtin_amdgcn_sched_barrier(0);
}
__device__ __forceinline__ unsigned wave_or(unsigned v) {
#pragma unroll
    for (int o = 32; o >= 1; o >>= 1) v |= (unsigned)__shfl_xor((int)v, o);
    return v;
}
__device__ __forceinline__ void att_nsa_unit(char* lds, const P& p, int b, int g, int qtile) {
    const int tid = tidx(), lane = tid & 63, w = tid >> 6, fr = lane & 15, fg = lane >> 4;
    const int hd = g * 4 + w, t0 = qtile * 32, own = qtile >> 1;
    const float slope2 = exp2f(-((float)hd + 0.5f)) * LOG2E, c1 = 0.125f * LOG2E;
    bf16x8 qf[2][2];
#pragma unroll
    for (int qt = 0; qt < 2; ++qt)
#pragma unroll
        for (int ks = 0; ks < 2; ++ks) qf[qt][ks] = *(const bf16x8*)(p.Qb + (size_t)(b * SEQ + t0 + qt * 16 + fr) * 512 + hd * 64 + ks * 32 + fg * 8);
    unsigned selw[2];
#pragma unroll
    for (int qt = 0; qt < 2; ++qt) selw[qt] = p.SELM[(size_t)(b * 2 + g) * SEQ + t0 + qt * 16 + fr];
    const unsigned um = wave_or(selw[0] | selw[1]);
    AttState S; att_reset(S);
    unsigned rem = um & ((own >= 31) ? 0xffffffffu : ((2u << own) - 1u));
    int wj = own >= 8 ? own - 8 : 0;
    int cbr, cj, nbr = 0, nj = 0; bool has = true, hasn;
    if (rem) { cj = __ffs(rem) - 1; rem &= rem - 1; cbr = 0; } else { cj = wj++; cbr = 1; }
    const bf16_t* Ks = p.KS + (size_t)b * SEQ * 128 + g * 64; const bf16_t* Kw = p.KW + (size_t)b * SEQ * 128 + g * 64;
    const bf16_t* Vs = p.VSt + (size_t)(b * 128 + g * 64) * SEQ; const bf16_t* Vw = p.VWt + (size_t)(b * 128 + g * 64) * SEQ;
    TileRegs R;
    att_load_tile(R, (cbr ? Kw : Ks) + (size_t)cj * 64 * 128, 128, (cbr ? Vw : Vs) + cj * 64);
    bool switched = false;
    while (has) {
        __syncthreads();
        att_store_tile(R, lds);
        __syncthreads();
        if (rem) { nj = __ffs(rem) - 1; rem &= rem - 1; nbr = 0; hasn = true; } else if (wj <= own) { nj = wj++; nbr = 1; hasn = true; } else hasn = false;
        if (hasn) att_load_tile(R, (nbr ? Kw : Ks) + (size_t)nj * 64 * 128, 128, (nbr ? Vw : Vs) + nj * 64);
        if (cbr == 1 && !switched) {
            switched = true;
#pragma unroll
            for (int qt = 0; qt < 2; ++qt) {
                float lt = S.l[qt]; lt += __shfl_xor(lt, 16); lt += __shfl_xor(lt, 32);
                const size_t n = (size_t)b * SEQ + t0 + qt * 16 + fr;
                const float sc = sigmoidf_(p.GATES[n * 24 + hd * 3 + 1]) / fmaxf(lt, 1e-30f);
#pragma unroll
                for (int dt = 0; dt < 4; ++dt) *(f32x4*)(p.OS + n * 512 + hd * 64 + dt * 16 + fg * 4) = S.O[dt][qt] * sc;
            }
            att_reset(S);
        }
        unsigned sb = 3u; int wl = 1 << 30; bool msk;
        if (cbr == 0) { sb = ((selw[0] >> cj) & 1u) | (((selw[1] >> cj) & 1u) << 1); msk = (cj == own); }
        else { wl = 512; msk = (cj == own) || (cj + 8 == own); }
        if (msk) att_step<true>(lds, qf, S, c1, slope2, cj * 64, t0, sb, wl);
        else att_step<false>(lds, qf, S, c1, slope2, cj * 64, t0, sb, wl);
        cbr = nbr; cj = nj; has = hasn;
    }
#pragma unroll
    for (int qt = 0; qt < 2; ++qt) {
        float lt = S.l[qt]; lt += __shfl_xor(lt, 16); lt += __shfl_xor(lt, 32);
        const size_t n = (size_t)b * SEQ + t0 + qt * 16 + fr;
        const float sc = sigmoidf_(p.GATES[n * 24 + hd * 3 + 2]) / fmaxf(lt, 1e-30f);
        const float g0 = sigmoidf_(p.GATES[n * 24 + hd * 3 + 0]);
#pragma unroll
        for (int dt = 0; dt < 4; ++dt) {
            const size_t o = n * 512 + hd * 64 + dt * 16 + fg * 4;
            const f32x4 y = S.O[dt][qt] * sc + *(const f32x4*)(p.OS + o) + *(const f32x4*)(p.OC + o) * g0;
            u32x2 wv; wv.x = pack2(y[0], y[1]); wv.y = pack2(y[2], y[3]);
            *(u32x2*)(p.MIX + n * DM + hd * 64 + dt * 16 + fg * 4) = wv;
        }
    }
}
__device__ __forceinline__ void att_moba_unit(char* lds, const P& p, int b, int h, int ob, int half) {
    const int tid = tidx(), lane = tid & 63, w = tid >> 6, fr = lane & 15, fg = lane >> 4;
    const int tq0 = ob * 256 + half * 128 + w * 32;
    const int dsub = half * 2 + (w >> 1), lastsub = half * 2 + 1;
    const float slope2 = exp2f(-((float)h + 1.0f)) * LOG2E, c1 = 0.125f * LOG2E;
    bf16x8 qf[2][2];
#pragma unroll
    for (int qt = 0; qt < 2; ++qt)
#pragma unroll
        for (int ks = 0; ks < 2; ++ks) qf[qt][ks] = *(const bf16x8*)(p.MQ + (size_t)(b * SEQ + tq0 + qt * 16 + fr) * 512 + h * 64 + ks * 32 + fg * 8);
    unsigned selw[2];
#pragma unroll
    for (int qt = 0; qt < 2; ++qt) selw[qt] = p.MSEL[(size_t)(b * 8 + h) * SEQ + tq0 + qt * 16 + fr];
    unsigned* red = (unsigned*)(lds + ATT_RED_OFF);
    const unsigned umw = wave_or(selw[0] | selw[1]);
    __syncthreads();
    if (lane == 0) red[w] = umw;
    __syncthreads();
    unsigned rem = (red[0] | red[1] | red[2] | red[3]) & ((1u << ob) - 1u);
    AttState S; att_reset(S);
    int cj, csub = 0, nj = 0, nsub = 0; bool has = true, hasn;
    if (rem) { cj = __ffs(rem) - 1; rem &= rem - 1; } else cj = ob;
    const bf16_t* Kb = p.MK + (size_t)b * SEQ * 512 + h * 64; const bf16_t* Vb = p.MVt + (size_t)(b * 512 + h * 64) * SEQ;
    TileRegs R;
    att_load_tile(R, Kb + (size_t)(cj * 256 + csub * 64) * 512, 512, Vb + cj * 256 + csub * 64);
    while (has) {
        __syncthreads();
        att_store_tile(R, lds);
        __syncthreads();
        if (cj == ob) { if (csub < lastsub) { nj = cj; nsub = csub + 1; hasn = true; } else hasn = false; }
        else if (csub < 3) { nj = cj; nsub = csub + 1; hasn = true; }
        else { if (rem) { nj = __ffs(rem) - 1; rem &= rem - 1; } else nj = ob; nsub = 0; hasn = true; }
        if (hasn) att_load_tile(R, Kb + (size_t)(nj * 256 + nsub * 64) * 512, 512, Vb + nj * 256 + nsub * 64);
        const int s0 = cj * 256 + csub * 64;
        unsigned sb = 3u; bool msk = false, run = true;
        if (cj < ob) sb = ((selw[0] >> cj) & 1u) | (((selw[1] >> cj) & 1u) << 1);
        else { msk = (csub == dsub); run = (csub <= dsub); }
        if (run) {
            if (msk) att_step<true>(lds, qf, S, c1, slope2, s0, tq0, sb, 1 << 30);
            else att_step<false>(lds, qf, S, c1, slope2, s0, tq0, sb, 1 << 30);
        }
        cj = nj; csub = nsub; has = hasn;
    }
#pragma unroll
    for (int qt = 0; qt < 2; ++qt) {
        float lt = S.l[qt]; lt += __shfl_xor(lt, 16); lt += __shfl_xor(lt, 32);
        const size_t n = (size_t)b * SEQ + tq0 + qt * 16 + fr;
        const float sc = 1.0f / fmaxf(lt, 1e-30f);
#pragma unroll
        for (int dt = 0; dt < 4; ++dt) {
            const f32x4 y = S.O[dt][qt] * sc;
            u32x2 wv; wv.x = pack2(y[0], y[1]); wv.y = pack2(y[2], y[3]);
            *(u32x2*)(p.MIX + n * DM + 512 + h * 64 + dt * 16 + fg * 4) = wv;
        }
    }
}
#ifndef ATT_NSA
#define ATT_NSA 1
#endif
#ifndef ATT_MOBA
#define ATT_MOBA 1
#endif
__device__ __forceinline__ int att_class_key(int c) {
    if (c < 64) { const int a = (c >> 1) + 1; return (a < 16 ? a : 16) + (a < 9 ? a : 9); }
    const int ob = (c - 64) >> 1, half = (c - 64) & 1; return 4 * ob + 2 + 2 * half;
}
__device__ __forceinline__ void phase_attn(char* lds, int bid, int nb, const P& p) {
    int* order = (int*)(lds + ATT_ORDER_OFF);
    __syncthreads();
    for (int u = tidx(); u < 2048; u += 256) {
        int c, inst; if (u < 1024) { c = u & 63; inst = u >> 6; } else { c = 64 + ((u - 1024) & 15); inst = (u - 1024) >> 4; }
        const int key = att_class_key(c);
        int pos = inst;
        for (int c2 = 0; c2 < 80; ++c2) { const int k2 = att_class_key(c2); if (k2 > key || (k2 == key && c2 < c)) pos += (c2 < 64) ? 16 : 64; }
        order[pos] = u;
    }
    __syncthreads();
    for (int r = 0;; ++r) {
        const int idx = r * nb + ((r & 1) ? (nb - 1 - bid) : bid);
        if (idx >= 2048) break;
        const int u = order[idx];
        if (u < 1024) {
#if ATT_NSA
            att_nsa_unit(lds, p, u >> 7, (u >> 6) & 1, u & 63);
#endif
        } else {
#if ATT_MOBA
            const int v = u - 1024; att_moba_unit(lds, p, v >> 7, (v >> 4) & 7, (v >> 1) & 7, v & 1);
#endif
        }
    }
    __syncthreads();
}


struct ALoadCmp {
    const float* base;
    const float* pe;
    int kt0;
    struct Regs { f32x4 v[8]; };
    __device__ __forceinline__ void load(int kt, Regs& R) const {
        const int l = kt + kt0;
        const f32x4 p0 = *(const f32x4*)(pe + l * 64), p1 = *(const f32x4*)(pe + l * 64 + 4);
#pragma unroll
        for (int i = 0; i < 4; ++i) {
            const int row = (tidx() + 256 * i) >> 3; int tok = 16 * row + l; tok = tok > SEQ - 1 ? SEQ - 1 : tok;
            const float* q = base + (size_t)tok * 256;
            R.v[2 * i] = *(const f32x4*)q + p0; R.v[2 * i + 1] = *(const f32x4*)(q + 4) + p1;
        }
    }
    __device__ __forceinline__ void store(int kt, const Regs& R, char* lds) const {
#pragma unroll
        for (int i = 0; i < 4; ++i) {
            const int p = tidx() + 256 * i, row = p >> 3, ch = p & 7;
            const f32x4 a = R.v[2 * i], b = R.v[2 * i + 1];
            u32x4 w; w.x = pack2(a[0], a[1]); w.y = pack2(a[2], a[3]); w.z = pack2(b[0], b[1]); w.w = pack2(b[2], b[3]);
            *(u32x4*)(lds + lds_off(row, ch * 8)) = w;
        }
    }
};
__device__ __forceinline__ void phase_cmp1(char* lds, int bid, int nb, const P& p) {
    const int tid = tidx(), lane = tid & 63, wid = tid >> 6, wr = wid >> 1, wc = wid & 1, fr = lane & 15, fq = lane >> 4;
    for (int u = bid; u < 16 * 2 * 4; u += nb) {
        const int split = u & 3, which = (u >> 2) & 1, bg = u >> 3, b = bg >> 1, g = bg & 1;
        ALoadCmp al; al.kt0 = split * 8; al.base = p.KCV + (size_t)b * SEQ * 256 + which * 128 + g * 64 + (tid & 7) * 8; al.pe = (which ? p.pe_v : p.pe_k) + (tid & 7) * 8;
        BLoadF32 bl; { const int nq = tid & 31, kg = tid >> 5; bl.valid = true; bl.ldb = 128; bl.nk1 = 1 << 30; bl.bp = (which ? p.wv1 : p.wk1) + (size_t)(split * 8 * 64 + kg * 8) * 128 + nq * 4; }
        f32x4 acc[4][4];
        gemm_tile(lds, al, bl, 8, acc);
        float* hid = p.HID + ((size_t)which * 2048 + bg * 128) * 128;
#pragma unroll
        for (int m = 0; m < 4; ++m)
#pragma unroll
            for (int n = 0; n < 4; ++n) {
                const int row = wr * 64 + m * 16 + fr, col = wc * 64 + n * 16 + fq * 4;
#pragma unroll
                for (int j = 0; j < 4; ++j) atomicAdd(hid + (size_t)row * 128 + col + j, acc[m][n][j]);
            }
    }
}
__device__ __forceinline__ void phase_cmp2(char* lds, int bid, int nb, const P& p) {
    const int tid = tidx(), lane = tid & 63, wid = tid >> 6;
    float* hs = (float*)lds + wid * 128;
    for (int it = bid * 4 + wid; it < 2 * 16 * 128; it += nb * 4) {
        const int which = it >> 11, bg = (it >> 7) & 15, c = it & 127;
        float o = 0.f;
        if (c < 127) {
            const float* hid = p.HID + ((size_t)which * 2048 + bg * 128 + c) * 128;
            __builtin_amdgcn_wave_barrier();
            hs[lane] = gelu_tanh(hid[lane]); hs[lane + 64] = gelu_tanh(hid[lane + 64]);
            __builtin_amdgcn_wave_barrier();
            const float* w2 = which ? p.wv2 : p.wk2;
#pragma unroll 8
            for (int j = 0; j < 128; ++j) o += hs[j] * w2[j * 64 + lane];
        }
        if (which == 0) p.KCb[((size_t)bg * 128 + c) * 64 + lane] = (bf16_t)f2bf(o);
        else p.VCt[((size_t)bg * 64 + lane) * 128 + c] = (bf16_t)f2bf(o);
    }
}
#define CMPA_LDS (2 * 16384 + 4 * 2048)
__device__ __forceinline__ void cmpa_unit(char* lds, const P& p, int b, int g, int qt64) {
    const int tid = tidx(), lane = tid & 63, w = tid >> 6, fr = lane & 15, fg = lane >> 4;
    const int bg = b * 2 + g;
    char* kc = lds; char* vt = lds + 16384;
    __syncthreads();
#pragma unroll
    for (int i = 0; i < 4; ++i) { const int pc = tid + 256 * i;
        *(u32x4*)(kc + lds_off(pc >> 3, (pc & 7) * 8)) = *(const u32x4*)(p.KCb + (size_t)bg * 8192 + pc * 8);
        *(u32x4*)(vt + lds_off128(pc >> 4, (pc & 15) * 8)) = *(const u32x4*)(p.VCt + (size_t)bg * 8192 + pc * 8); }
    __syncthreads();
    const int t = qt64 * 64 + w * 16 + fr;
    const size_t n = (size_t)b * SEQ + t;
    const float c1 = 0.125f * LOG2E;
    f32x4 psum[8];
#pragma unroll
    for (int ct = 0; ct < 8; ++ct) psum[ct] = (f32x4){0.f, 0.f, 0.f, 0.f};
#pragma unroll 1
    for (int i = 0; i < 4; ++i) {
        const int hd = g * 4 + i;
        const float slope2 = exp2f(-((float)hd + 0.5f)) * LOG2E;
        const bf16x8 q0 = *(const bf16x8*)(p.Qb + n * 512 + hd * 64 + fg * 8), q1 = *(const bf16x8*)(p.Qb + n * 512 + hd * 64 + 32 + fg * 8);
        f32x4 s[8];
        float mx = -INFINITY;
#pragma unroll
        for (int ct = 0; ct < 8; ++ct) {
            const bf16x8 k0 = *(const bf16x8*)(kc + lds_off(ct * 16 + fr, fg * 8)), k1 = *(const bf16x8*)(kc + lds_off(ct * 16 + fr, 32 + fg * 8));
            s[ct] = __builtin_amdgcn_mfma_f32_16x16x32_bf16(k0, q0, (f32x4){0.f, 0.f, 0.f, 0.f}, 0, 0, 0);
            s[ct] = __builtin_amdgcn_mfma_f32_16x16x32_bf16(k1, q1, s[ct], 0, 0, 0);
#pragma unroll
            for (int r = 0; r < 4; ++r) {
                const int e = 16 * (ct * 16 + fg * 4 + r) + 31;
                const float y = (e <= t) ? fmaf(s[ct][r], c1, -slope2 * (float)(t - e)) : -INFINITY;
                s[ct][r] = y; mx = fmaxf(mx, y);
            }
        }
        __builtin_amdgcn_sched_barrier(0);
        mx = fmaxf(mx, __shfl_xor(mx, 16)); mx = fmaxf(mx, __shfl_xor(mx, 32));
        const float mm = (mx == -INFINITY) ? 0.f : mx;
        float ls = 0.f;
#pragma unroll
        for (int ct = 0; ct < 8; ++ct)
#pragma unroll
            for (int r = 0; r < 4; ++r) { const float e = __builtin_amdgcn_exp2f(s[ct][r] - mm); s[ct][r] = e; ls += e; }
        ls += __shfl_xor(ls, 16); ls += __shfl_xor(ls, 32);
        const float inv = 1.0f / fmaxf(ls, 1e-30f);
#pragma unroll
        for (int ct = 0; ct < 8; ++ct) { s[ct] *= inv; psum[ct] += s[ct]; }
        __builtin_amdgcn_sched_barrier(0);
        f32x4 o[4];
#pragma unroll
        for (int dt = 0; dt < 4; ++dt) o[dt] = (f32x4){0.f, 0.f, 0.f, 0.f};
#pragma unroll
        for (int kk = 0; kk < 4; ++kk) {
            u32x4 pw; pw.x = pack2(s[2 * kk][0], s[2 * kk][1]); pw.y = pack2(s[2 * kk][2], s[2 * kk][3]); pw.z = pack2(s[2 * kk + 1][0], s[2 * kk + 1][1]); pw.w = pack2(s[2 * kk + 1][2], s[2 * kk + 1][3]);
            const bf16x8 pf = __builtin_bit_cast(bf16x8, pw);
#pragma unroll
            for (int dt = 0; dt < 4; ++dt) {
                const int c0 = kk * 32 + fg * 4;
                const u32x2 v0 = *(const u32x2*)(vt + lds_off128(dt * 16 + fr, c0 & ~7) + (c0 & 7) * 2);
                const u32x2 v1 = *(const u32x2*)(vt + lds_off128(dt * 16 + fr, (c0 + 16) & ~7) + (c0 & 7) * 2);
                u32x4 vv; vv.x = v0.x; vv.y = v0.y; vv.z = v1.x; vv.w = v1.y;
                o[dt] = __builtin_amdgcn_mfma_f32_16x16x32_bf16(__builtin_bit_cast(bf16x8, vv), pf, o[dt], 0, 0, 0);
            }
        }
#pragma unroll
        for (int dt = 0; dt < 4; ++dt) *(f32x4*)(p.OC + n * 512 + hd * 64 + dt * 16 + fg * 4) = o[dt];
    }
    const int own = t >> 6;
    float val[8];
#pragma unroll
    for (int ct = 0; ct < 8; ++ct) {
        const float up = __shfl(psum[ct][3], (lane + 48) & 63);
        const float up0 = (ct > 0) ? __shfl(psum[ct > 0 ? ct - 1 : 0][3], (lane + 48) & 63) : 0.f;
        const float imp = (psum[ct][0] + psum[ct][1]) + (psum[ct][2] + psum[ct][3]) + (fg > 0 ? up : up0);
        const int j = ct * 4 + fg;
        const bool forced = (j == 0) || (j == own) || (j == own - 1);
        val[ct] = (j <= own) ? (imp + (forced ? 1e4f : 0.f)) : NEGF;
    }
    float* vs = (float*)(lds + 32768) + w * 512;
    __builtin_amdgcn_wave_barrier();
#pragma unroll
    for (int ct = 0; ct < 8; ++ct) vs[fr * 32 + ct * 4 + fg] = val[ct];
    __builtin_amdgcn_wave_barrier();
    int rank[8];
#pragma unroll
    for (int ct = 0; ct < 8; ++ct) rank[ct] = 0;
#pragma unroll 2
    for (int oj = 0; oj < 32; ++oj) {
        const float ov = vs[fr * 32 + oj];
#pragma unroll
        for (int ct = 0; ct < 8; ++ct) rank[ct] += (ov > val[ct] || (ov == val[ct] && oj < ct * 4 + fg)) ? 1 : 0;
    }
    __builtin_amdgcn_wave_barrier();
    unsigned bits = 0;
#pragma unroll
    for (int ct = 0; ct < 8; ++ct) if ((ct * 4 + fg <= own) && rank[ct] < 16) bits |= 1u << (ct * 4 + fg);
    bits |= (unsigned)__shfl_xor((int)bits, 16); bits |= (unsigned)__shfl_xor((int)bits, 32);
    if (fg == 0) p.SELM[(size_t)bg * SEQ + t] = bits;
}
__device__ __forceinline__ void phase_cmpa(char* lds, int bid, int nb, const P& p) {
    for (int u = bid; u < 16 * 32; u += nb) cmpa_unit(lds, p, u >> 6, (u >> 5) & 1, u & 31);
    __syncthreads();
}

#define MEGA_LDS (((HG3_LDS + 255) & ~255) + 16)
static_assert(HG3_LDS >= G4_LDS && HG3_LDS >= CMP_LDS && HG3_LDS >= G2_LDS && HG3_LDS >= ATT_RED_OFF + 16, "LDS map");
#define GBAR() xcd_barrier(bar)

template <int LAYER>
__device__ __forceinline__ void moe_block(char* lds, int bid, int nb, const P& p, const XcdBarrier& bar, float* of, bf16_t* ob) {
    if (bid == 0) p.cnt[tidx()] = 0;
    phase_router(bid, nb, p, LAYER);
    GBAR();
    phase_route(bid, nb, p, LAYER);
    GBAR();
    phase_scatter(lds, bid, nb, p);
    GBAR();
    phase_moe1(lds, bid, nb, p, LAYER, p.XAb);
    GBAR();
    phase_moe2(lds, bid, nb, p, LAYER);
    GBAR();
    phase_combine_ln(bid, nb, p, p.XA, p.ln_g + (LAYER * 2 + 1) * DM, p.ln_b + (LAYER * 2 + 1) * DM, of, ob);
}

__global__ void __launch_bounds__(256, 2) mega(P p) {
    char* lds = dyn_lds;
    const int bid = blockIdx.x, nb = gridDim.x;
    volatile LAS unsigned* st = (volatile LAS unsigned*)(dyn_lds + MEGA_LDS - 16);
    if (tidx() == 0) { st[0] = 0u; st[1] = 0u; st[2] = 0u; st[3] = 0u; }
    __syncthreads();
    const XcdBarrier bar = xcd_barrier_post(p.bar, st);
    phase_prep(lds, bid, nb, p);
    GBAR();
    phase_inproj0(lds, bid, nb, p);
    GBAR();
    phase_mix0_a(lds, bid, nb, p);
    GBAR();
    phase_hg2(bid, nb, p);
    GBAR();
    phase_mix0_c(lds, bid, nb, p);
    GBAR();
    phase_gemm_f32out(bid, nb, p.MIX, p.WOUT0, DM, DM, p.T0);
    GBAR();
    phase_ln_add(bid, nb, p.x, p.T0, p.ln_g, p.ln_b, p.XA, p.XAb);
    GBAR();
    moe_block<0>(lds, bid, nb, p, bar, p.XB, p.XBb);
    GBAR();
    phase_inproj1(lds, bid, nb, p);
    GBAR();
    phase_cmp1(lds, bid, nb, p);
    phase_moba_kmean(bid, nb, p);
    GBAR();
    phase_cmp2(lds, bid, nb, p);
    phase_moba_gate(bid, nb, p);
    GBAR();
    phase_cmpa(lds, bid, nb, p);
    GBAR();
#if !ATT_NSA
    phase_nsa_attn(lds, bid, nb, p);
#endif
#if !ATT_MOBA
    phase_moba_attn(lds, bid, nb, p);
#endif
    phase_attn(lds, bid, nb, p);
    GBAR();
    phase_gemm_f32out(bid, nb, p.MIX, p.WOUT1, DM, DM, p.T0);
    GBAR();
    phase_ln_add(bid, nb, p.XB, p.T0, p.ln_g + 2 * DM, p.ln_b + 2 * DM, p.XA, p.XAb);
    GBAR();
    moe_block<1>(lds, bid, nb, p, bar, p.out, nullptr);
}

static inline size_t al256(size_t x) { return (x + 255) & ~(size_t)255; }

extern "C" void kernel_launch(void* const* d_in, const int* in_sizes, int n_in, void* d_out, int out_size, void* d_ws, size_t ws_size, hipStream_t stream) {
    P p{};
    const float** ip = (const float**)&p.x;
    for (int i = 0; i < 30; ++i) ip[i] = (const float*)d_in[i];
    p.out = (float*)d_out;
    char* w = (char*)d_ws; size_t o = 0;
    auto take = [&](size_t bytes) { char* r = w + o; o = al256(o + bytes); return r; };
    p.bar = (unsigned*)take(XCD_BAR_WORDS * 4);
    p.U = (float*)take((size_t)NTOK * EVEN_IN * 4);
    p.MIX = (bf16_t*)take((size_t)NTOK * DM * 2);
    p.T0 = (float*)take((size_t)NTOK * DM * 4);
    p.XA = (float*)take((size_t)NTOK * DM * 4); p.XAb = (bf16_t*)take((size_t)NTOK * DM * 2);
    p.XB = (float*)take((size_t)NTOK * DM * 4); p.XBb = (bf16_t*)take((size_t)NTOK * DM * 2);
    p.LOG = (float*)take((size_t)NTOK * NEXP * 4);
    p.eidx = (int*)take(NTOK * 8 * 4); p.ew = (float*)take(NTOK * 8 * 4); p.erank = (int*)take(NTOK * 8 * 4); p.epos = (int*)take(NTOK * 8 * 4);
    p.cnt = (int*)take(NEXP * 4); p.tile_e = (int*)take(NTILES * 4); p.rowtok = (int*)take(NROWS * 4);
    p.H = (bf16_t*)take((size_t)NROWS * 256 * 2);
    p.Y = (bf16_t*)take((size_t)NROWS * DM * 2);
    p.LA = (float*)take((size_t)NTOK * 512 * 4); p.LB = (float*)take((size_t)NTOK * 512 * 4);
    p.KC = (float*)take(16 * 127 * 64 * 4); p.VC = (float*)take(16 * 127 * 64 * 4);
    p.OC = (float*)take((size_t)NTOK * 512 * 4);
    p.SELM = (unsigned*)take(16 * SEQ * 4);
    p.KM = (float*)take(8 * 8 * 8 * 64 * 4);
    p.Qb = (bf16_t*)take((size_t)NTOK * 512 * 2); p.KS = (bf16_t*)take((size_t)NTOK * 128 * 2); p.VSt = (bf16_t*)take((size_t)NTOK * 128 * 2);
    p.KW = (bf16_t*)take((size_t)NTOK * 128 * 2); p.VWt = (bf16_t*)take((size_t)NTOK * 128 * 2);
    p.MQ = (bf16_t*)take((size_t)NTOK * 512 * 2); p.MK = (bf16_t*)take((size_t)NTOK * 512 * 2); p.MVt = (bf16_t*)take((size_t)NTOK * 512 * 2);
    p.KCV = (float*)take((size_t)NTOK * 256 * 4); p.GATES = (float*)take((size_t)NTOK * 24 * 4); p.OS = (float*)take((size_t)NTOK * 512 * 4);
    p.MSEL = (unsigned*)take(64 * SEQ * 4);
    p.UB0 = (bf16_t*)take((size_t)NTOK * 2560 * 2); p.VHt = (bf16_t*)take((size_t)NTOK * 512 * 2);
    p.WAT = (bf16_t*)take(8 * 64 * 64 * 2); p.WXT = (bf16_t*)take(8 * 64 * 64 * 2);
    p.CSA = (float*)take(8 * 32 * 512 * 4); p.CSB = (float*)take(8 * 32 * 512 * 4);
    p.UT = (bf16_t*)take((size_t)1024 * 16384 * 2); p.SP = (bf16_t*)take((size_t)1024 * 16384 * 2);
    p.DV = (float*)take(1024 * 128 * 4);
    p.XIb = (bf16_t*)take((size_t)NTOK * DM * 2);
    p.plist = (int*)take(2 * 1536 * 4); p.plen = (int*)take(64);
    p.WIN0 = (bf16_t*)take((size_t)EVEN_IN * DM * 2); p.WOUT0 = (bf16_t*)take((size_t)DM * DM * 2); p.WIN1 = (bf16_t*)take((size_t)2944 * DM * 2); p.WOUT1 = (bf16_t*)take((size_t)DM * DM * 2);
    p.WRH = (bf16_t*)take((size_t)2 * NEXP * DM * 2); p.WRL = (bf16_t*)take((size_t)2 * NEXP * DM * 2);
    p.HID = (float*)take(2 * 2048 * 128 * 4); p.KCb = (bf16_t*)take(16 * 128 * 64 * 2); p.VCt = (bf16_t*)take(16 * 64 * 128 * 2);
    if (o > ws_size) return;

    static int grid = 0;
    if (!grid) {
        int dev = 0, cus = 0, per_cu = 0;
        (void)hipGetDevice(&dev);
        (void)hipDeviceGetAttribute(&cus, hipDeviceAttributeMultiprocessorCount, dev);
        (void)hipFuncSetAttribute((const void*)mega, hipFuncAttributeMaxDynamicSharedMemorySize, MEGA_LDS);
        (void)hipOccupancyMaxActiveBlocksPerMultiprocessor(&per_cu, (const void*)mega, 256, MEGA_LDS);
        if (per_cu < 1) per_cu = 1;
        grid = cus * (per_cu < 2 ? per_cu : 2);
    }
    (void)hipMemsetAsync(p.bar, 0, XCD_BAR_WORDS * 4, stream);
    hipLaunchKernelGGL(mega, dim3(grid), dim3(256), MEGA_LDS, stream, p);
}
```

```cpp
#include <hip/hip_runtime.h>
#include <hip/hip_bf16.h>
#include <stdint.h>

#define NTOK 16384
#define DM 1024
#define SEQ 2048
#define NBATCH 8
#define EVEN_IN 3072
#define ODD_IN 2840
#define NEXP 256
#define NEGF (-1e30f)
#define LOG2E 1.4426950408889634f
#define DN_ALPHA 1.4142135623730951f
#define LN_EPS 1e-5f
#define MAXRT 1280
#define SH_TILE0 1280
#define NTILES (1280 + 128)
#define NROWS (NTILES * 128)

typedef unsigned short bf16_t;
typedef short bf16x8 __attribute__((ext_vector_type(8)));
typedef float f32x4 __attribute__((ext_vector_type(4)));
typedef unsigned u32x4 __attribute__((ext_vector_type(4)));
typedef unsigned u32x2 __attribute__((ext_vector_type(2)));
extern __shared__ __attribute__((aligned(16))) char dyn_lds[];
#define LAS __attribute__((address_space(3)))

__device__ __forceinline__ int tidx() { int t = threadIdx.x; asm volatile("" : "+v"(t)); return t; }
__device__ __forceinline__ float wave_sum(float v) {
#pragma unroll
    for (int o = 32; o >= 1; o >>= 1) v += __shfl_xor(v, o);
    return v;
}
__device__ __forceinline__ float wave_max(float v) {
#pragma unroll
    for (int o = 32; o >= 1; o >>= 1) v = fmaxf(v, __shfl_xor(v, o));
    return v;
}
typedef __bf16 hwbf16x2 __attribute__((ext_vector_type(2)));
typedef float f32x2 __attribute__((ext_vector_type(2)));
__device__ __forceinline__ unsigned f2bf(float f) { const __bf16 h = (__bf16)f; return (unsigned)__builtin_bit_cast(unsigned short, h); }
__device__ __forceinline__ float bf2f(unsigned b) { return __uint_as_float(b << 16); }
__device__ __forceinline__ unsigned pack2(float lo, float hi) { const f32x2 f = {lo, hi}; const hwbf16x2 v = __builtin_convertvector(f, hwbf16x2); return __builtin_bit_cast(unsigned, v); }
__device__ __forceinline__ float sigmoidf_(float x) { return 1.0f / (1.0f + __expf(-x)); }
__device__ __forceinline__ float siluf_(float x) { return x / (1.0f + __expf(-x)); }
__device__ __forceinline__ float gelu_tanh(float x) {
    const float u = 0.7978845608028654f * (x + 0.044715f * x * x * x);
    return 0.5f * x * (1.0f + tanhf(u));
}


#define XB_TMO      128
#define XB_XCNT(j)  (256  + 64 * (j))
#define XB_XSUB(j)  (1280 + 64 * (j))
#define XB_XGEN(j)  (2304 + 64 * (j))
#define XB_TOP      3328
#define XB_TOPGEN   3392
#define XCD_BAR_WORDS 3456
#define XB_SPIN_CAP (1u << 18)
__device__ __forceinline__ unsigned xb_ld(unsigned* p)              { return __hip_atomic_load(p, __ATOMIC_RELAXED, __HIP_MEMORY_SCOPE_AGENT); }
__device__ __forceinline__ unsigned xb_add(unsigned* p, unsigned v) { return __hip_atomic_fetch_add(p, v, __ATOMIC_RELAXED, __HIP_MEMORY_SCOPE_AGENT); }
__device__ __forceinline__ unsigned xb_xcc_id() { return (unsigned)__builtin_amdgcn_s_getreg((3 << 11) | 20) & 0xFu; }
#define XB_SPIN(cond, bar) do { unsigned _sp = 0; while (cond) { __builtin_amdgcn_s_sleep(1); \
    if ((++_sp & 255u) == 0u) { if (xb_ld(&(bar)[XB_TMO])) break; if (_sp > XB_SPIN_CAP) { atomicAdd(&(bar)[XB_TMO], 1u); break; } } } } while (0)
struct XcdBarrier { unsigned* bar; unsigned x; volatile LAS unsigned* st; };
__device__ __forceinline__ XcdBarrier xcd_barrier_post(unsigned* bar, volatile LAS unsigned* st) {
    XcdBarrier b; b.bar = bar; b.x = xb_xcc_id(); b.st = st;
    if (tidx() == 0) (void)xb_add(&bar[XB_XCNT(b.x)], 1u);
    return b;
}
__device__ __forceinline__ void xcd_barrier_complete(unsigned* bar, unsigned x, unsigned& nloc, unsigned& nx) {
    const unsigned G = gridDim.x * gridDim.y * gridDim.z;
    unsigned sum, cnt, mine, sp = 0u;
    for (;;) {
        sum = 0u; cnt = 0u; mine = 0u;
#pragma unroll
        for (unsigned j = 0; j < 16; ++j) { const unsigned c = xb_ld(&bar[XB_XCNT(j)]); sum += c; cnt += (c > 0u) ? 1u : 0u; mine = (j == x) ? c : mine; }
        if (sum == G) break;
        __builtin_amdgcn_s_sleep(1);
        if ((++sp & 255u) == 0u) { if (xb_ld(&bar[XB_TMO])) break; if (sp > XB_SPIN_CAP) { atomicAdd(&bar[XB_TMO], 1u); break; } }
    }
    nloc = mine > 0u ? mine : 1u; nx = cnt > 0u ? cnt : 1u;
}
__device__ __forceinline__ void xcd_barrier(const XcdBarrier& b) {
    asm volatile("s_waitcnt vmcnt(0)" ::: "memory");
    __syncthreads();
    if (tidx() == 0) {
        unsigned* bar = b.bar;
        __builtin_amdgcn_s_waitcnt(0);
        unsigned nloc = b.st[0], nx = b.st[1];
        if (nloc == 0u) { xcd_barrier_complete(bar, b.x, nloc, nx); b.st[0] = nloc; b.st[1] = nx; }
        const unsigned old = xb_add(&bar[XB_XSUB(b.x)], 1u);
        const unsigned gen = old / nloc;
        if (old + 1u == (gen + 1u) * nloc) {
            __builtin_amdgcn_fence(__ATOMIC_RELEASE, "agent");
            asm volatile("s_waitcnt vmcnt(0)" ::: "memory");
            const unsigned og = xb_add(&bar[XB_TOP], 1u);
            const unsigned tg = og / nx;
            if (og + 1u == (tg + 1u) * nx) xb_add(&bar[XB_TOPGEN], 1u);
            else XB_SPIN(xb_ld(&bar[XB_TOPGEN]) == tg, bar);
            __builtin_amdgcn_fence(__ATOMIC_ACQUIRE, "agent");
            xb_add(&bar[XB_XGEN(b.x)], 1u);
            asm volatile("s_waitcnt vmcnt(0)" ::: "memory");
        } else {
            XB_SPIN(xb_ld(&bar[XB_XGEN(b.x)]) == gen, bar);
            __builtin_amdgcn_fence(__ATOMIC_ACQUIRE, "agent");
            asm volatile("s_waitcnt vmcnt(0)" ::: "memory");
        }
    }
    __syncthreads();
}

struct P {
    const float *x, *even_w_in, *conv_w, *conv_b, *wa, *ba, *wx, *bx, *lam, *hg_lb, *hg_ng, *even_w_out;
    const float *odd_w_in, *pe_k, *pe_v, *wk1, *wk2, *wv1, *wv2, *odd_w_out, *ln_g, *ln_b, *w_router, *b_router;
    const float *w_gate, *w_up, *w_down, *ws_gate, *ws_up, *ws_down;
    float* out;
    float* U;
    bf16_t* MIX;
    float* T0;
    float* XA; bf16_t* XAb; float* XB; bf16_t* XBb; bf16_t* XAl;
    float* LOG;
    int* eidx; float* ew; int* erank; int* epos;
    int* cnt;
    int* tile_e;
    int* rowtok;
    bf16_t* H;
    bf16_t* Y;
    float* LA; float* LB;
    float* KC; float* VC;
    float* OC;
    unsigned* SELM;
    float* KM;
    unsigned* bar;
    bf16_t *Qb, *KS, *VSt, *KW, *VWt, *MQ, *MK, *MVt;
    float *KCV, *GATES, *OS; unsigned* MSEL;
    bf16_t *UB0;
    bf16_t *VHt;
    bf16_t *WAT, *WXT;
    float *CSA, *CSB;
    bf16_t *UT, *SP;
    float *DV;
    float *HID;
    bf16_t *KCb, *VCt;
    bf16_t *XIb;
    int *plist; int *plen;
    bf16_t *WIN0, *WOUT0, *WIN1, *WOUT1, *WRH, *WRL;
};

__device__ __forceinline__ int lds_off(int r, int c) {
    const int st = (r >> 4) * 2 + (c >> 5), ob = (r & 15) * 64 + (c & 31) * 2;
    return st * 1024 + (ob ^ (((ob >> 9) & 1) << 5));
}
#define GEMM_LDS 32768

__device__ __forceinline__ float cvt_part(float v, int lo) { return lo ? (v - bf2f(f2bf(v))) : v; }

struct ALoadF32 {
    const float* rp[4];
    int nk1;
    struct Regs { f32x4 v[8]; };
    __device__ __forceinline__ void load(int kt, Regs& R) const {
        const int k = (kt % nk1) * 64;
#pragma unroll
        for (int i = 0; i < 4; ++i) { R.v[2 * i] = *(const f32x4*)(rp[i] + k); R.v[2 * i + 1] = *(const f32x4*)(rp[i] + k + 4); }
    }
    __device__ __forceinline__ void store(int kt, const Regs& R, char* lds) const {
        const int lo = (kt / nk1) == 2;
#pragma unroll
        for (int i = 0; i < 4; ++i) {
            const int p = tidx() + 256 * i, row = p >> 3, ch = p & 7;
            const f32x4 a = R.v[2 * i], b = R.v[2 * i + 1];
            u32x4 w;
            w.x = pack2(cvt_part(a[0], lo), cvt_part(a[1], lo)); w.y = pack2(cvt_part(a[2], lo), cvt_part(a[3], lo));
            w.z = pack2(cvt_part(b[0], lo), cvt_part(b[1], lo)); w.w = pack2(cvt_part(b[2], lo), cvt_part(b[3], lo));
            *(u32x4*)(lds + lds_off(row, ch * 8)) = w;
        }
    }
};
struct ALoadBF16 {
    const bf16_t* rp[4];
    struct Regs { u32x4 v[4]; };
    __device__ __forceinline__ void load(int kt, Regs& R) const {
#pragma unroll
        for (int i = 0; i < 4; ++i) R.v[i] = *(const u32x4*)(rp[i] + kt * 64);
    }
    __device__ __forceinline__ void store(int kt, const Regs& R, char* lds) const {
#pragma unroll
        for (int i = 0; i < 4; ++i) { const int p = tidx() + 256 * i; *(u32x4*)(lds + lds_off(p >> 3, (p & 7) * 8)) = R.v[i]; }
    }
};
struct ALoadF32S {
    const float* rp0; size_t rs32; int nk1;
    struct Regs { f32x4 v[8]; };
    __device__ __forceinline__ void load(int kt, Regs& R) const {
        const int k = (kt % nk1) * 64;
#pragma unroll
        for (int i = 0; i < 4; ++i) { const float* q = rp0 + i * rs32 + k; R.v[2 * i] = *(const f32x4*)q; R.v[2 * i + 1] = *(const f32x4*)(q + 4); }
    }
    __device__ __forceinline__ void store(int kt, const Regs& R, char* lds) const {
        const int lo = (kt / nk1) == 2;
#pragma unroll
        for (int i = 0; i < 4; ++i) {
            const int p = tidx() + 256 * i, row = p >> 3, ch = p & 7;
            const f32x4 a = R.v[2 * i], b = R.v[2 * i + 1];
            u32x4 w;
            w.x = pack2(cvt_part(a[0], lo), cvt_part(a[1], lo)); w.y = pack2(cvt_part(a[2], lo), cvt_part(a[3], lo));
            w.z = pack2(cvt_part(b[0], lo), cvt_part(b[1], lo)); w.w = pack2(cvt_part(b[2], lo), cvt_part(b[3], lo));
            *(u32x4*)(lds + lds_off(row, ch * 8)) = w;
        }
    }
};
struct ALoadBF16S {
    const bf16_t* rp0; size_t rs32;
    struct Regs { u32x4 v[4]; };
    __device__ __forceinline__ void load(int kt, Regs& R) const {
#pragma unroll
        for (int i = 0; i < 4; ++i) R.v[i] = *(const u32x4*)(rp0 + i * rs32 + kt * 64);
    }
    __device__ __forceinline__ void store(int kt, const Regs& R, char* lds) const {
#pragma unroll
        for (int i = 0; i < 4; ++i) { const int p = tidx() + 256 * i; *(u32x4*)(lds + lds_off(p >> 3, (p & 7) * 8)) = R.v[i]; }
    }
};
struct BLoadF32 {
    const float* bp; int ldb; bool valid; int nk1;
    struct Regs { f32x4 v[8]; };
    __device__ __forceinline__ void load(int kt, Regs& R) const {
        const float* p = bp + (size_t)((kt % nk1) * 64) * ldb;
#pragma unroll
        for (int j = 0; j < 8; ++j) R.v[j] = valid ? *(const f32x4*)(p + (size_t)j * ldb) : (f32x4){0.f, 0.f, 0.f, 0.f};
    }
    __device__ __forceinline__ void store(int kt, const Regs& R, char* lds) const {
        const int lo = (kt / nk1) == 1;
        const int nq = tidx() & 31, kg = tidx() >> 5;
#pragma unroll
        for (int i = 0; i < 4; ++i) {
            u32x4 w;
            w.x = pack2(cvt_part(R.v[0][i], lo), cvt_part(R.v[1][i], lo)); w.y = pack2(cvt_part(R.v[2][i], lo), cvt_part(R.v[3][i], lo));
            w.z = pack2(cvt_part(R.v[4][i], lo), cvt_part(R.v[5][i], lo)); w.w = pack2(cvt_part(R.v[6][i], lo), cvt_part(R.v[7][i], lo));
            *(u32x4*)(lds + lds_off(nq * 4 + i, kg * 8)) = w;
        }
    }
};

template <class AL, class BL>
__device__ __forceinline__ void gemm_tile(char* lds, const AL& al, const BL& bl, int nk, f32x4 (&acc)[4][4], bool swap = false) {
    const int lane = tidx() & 63, wid = tidx() >> 6, wr = wid >> 1, wc = wid & 1, fr = lane & 15, fq = lane >> 4;
    char* ldsA = lds; char* ldsB = lds + 16384;
    const char* t2 = swap ? ldsB : ldsA; const char* t1 = swap ? ldsA : ldsB; const int w2 = swap ? wc : wr, w1 = swap ? wr : wc;
#pragma unroll
    for (int m = 0; m < 4; ++m)
#pragma unroll
        for (int n = 0; n < 4; ++n) acc[m][n] = (f32x4){0.f, 0.f, 0.f, 0.f};
    typename AL::Regs ra; typename BL::Regs rb;
    al.load(0, ra); bl.load(0, rb);
    for (int kt = 0; kt < nk; ++kt) {
        __syncthreads();
        al.store(kt, ra, ldsA); bl.store(kt, rb, ldsB);
        __syncthreads();
        if (kt + 1 < nk) { al.load(kt + 1, ra); bl.load(kt + 1, rb); }
#pragma unroll
        for (int kk = 0; kk < 2; ++kk) {
            bf16x8 a[4], b[4];
#pragma unroll
            for (int m = 0; m < 4; ++m) a[m] = *(const bf16x8*)(t2 + lds_off(w2 * 64 + m * 16 + fr, kk * 32 + fq * 8));
#pragma unroll
            for (int n = 0; n < 4; ++n) b[n] = *(const bf16x8*)(t1 + lds_off(w1 * 64 + n * 16 + fr, kk * 32 + fq * 8));
#pragma unroll
            for (int m = 0; m < 4; ++m)
#pragma unroll
                for (int n = 0; n < 4; ++n) acc[m][n] = __builtin_amdgcn_mfma_f32_16x16x32_bf16(b[n], a[m], acc[m][n], 0, 0, 0);
        }
    }
}


#define G2_LDS 65536
__device__ __forceinline__ void dma_rc(int lane, int st, int& R, int& C) {
    const int sb = lane * 16, swz = sb ^ (((sb >> 9) & 1) << 5);
    R = (st >> 1) * 16 + (swz >> 6); C = (st & 1) * 32 + ((swz & 63) >> 1);
}
struct DmaLoad {
    static constexpr int LAYOUT = 0;
    const char* base; unsigned voff[4];
    __device__ __forceinline__ void set_dense(const bf16_t* b0, int row0, int ld) {
        base = (const char*)b0; const int lane = tidx() & 63, w = tidx() >> 6;
#pragma unroll
        for (int i = 0; i < 4; ++i) { int R, C; dma_rc(lane, w + 4 * i, R, C); voff[i] = (unsigned)(((size_t)(row0 + R) * ld + C) * 2); }
    }
    __device__ __forceinline__ void issue(int kt, int ldsoff) const {
        const int w = tidx() >> 6;
#pragma unroll
        for (int i = 0; i < 4; ++i)
            __builtin_amdgcn_global_load_lds((const unsigned*)(base + voff[i] + (size_t)kt * 128), (LAS unsigned*)((LAS char*)dyn_lds + ldsoff + (w + 4 * i) * 1024), 16, 0, 0);
    }
    __device__ __forceinline__ void commit(int, int) const {}
};
struct RegLoadA {
    const float* rp0; size_t rs32; int nk1; f32x4 v[8];
    __device__ __forceinline__ void issue(int kt, int) {
        const int k = (kt % nk1) * 64;
#pragma unroll
        for (int i = 0; i < 4; ++i) { const float* q = rp0 + i * rs32 + k; v[2 * i] = *(const f32x4*)q; v[2 * i + 1] = *(const f32x4*)(q + 4); }
    }
    __device__ __forceinline__ void commit(int kt, int ldsoff) const {
        const int lo = (kt / nk1) == 2;
#pragma unroll
        for (int i = 0; i < 4; ++i) {
            const int p = tidx() + 256 * i, row = p >> 3, ch = p & 7;
            const f32x4 a = v[2 * i], b = v[2 * i + 1];
            u32x4 w;
            w.x = pack2(cvt_part(a[0], lo), cvt_part(a[1], lo)); w.y = pack2(cvt_part(a[2], lo), cvt_part(a[3], lo));
            w.z = pack2(cvt_part(b[0], lo), cvt_part(b[1], lo)); w.w = pack2(cvt_part(b[2], lo), cvt_part(b[3], lo));
            *(u32x4*)(dyn_lds + ldsoff + lds_off(row, ch * 8)) = w;
        }
    }
};
struct RegLoadB {
    const float* bp; int ldb; f32x4 v[8];
    static constexpr int LAYOUT = 1;
    static __device__ __forceinline__ int nq_of(int tid) { return tid & 31; }
    static __device__ __forceinline__ int kg_of(int tid) { return tid >> 5; }
    __device__ __forceinline__ void issue(int kt, int) {
        const float* p = bp + (size_t)(kt * 64) * ldb;
#pragma unroll
        for (int j = 0; j < 8; ++j) v[j] = *(const f32x4*)(p + (size_t)j * ldb);
    }
    __device__ __forceinline__ void commit(int, int ldsoff) const {
        const int tid = tidx(), nq = nq_of(tid), kg = kg_of(tid);
        u32x4 w[4];
#pragma unroll
        for (int i = 0; i < 4; ++i) { w[i].x = pack2(v[0][i], v[1][i]); w[i].y = pack2(v[2][i], v[3][i]); w[i].z = pack2(v[4][i], v[5][i]); w[i].w = pack2(v[6][i], v[7][i]); }
        const int rot = (nq >> 1) & 3;
#pragma unroll
        for (int i = 0; i < 4; ++i) {
            const int e = (i + rot) & 3;
            u32x4 d;
            d.x = e == 0 ? w[0].x : (e == 1 ? w[1].x : (e == 2 ? w[2].x : w[3].x));
            d.y = e == 0 ? w[0].y : (e == 1 ? w[1].y : (e == 2 ? w[2].y : w[3].y));
            d.z = e == 0 ? w[0].z : (e == 1 ? w[1].z : (e == 2 ? w[2].z : w[3].z));
            d.w = e == 0 ? w[0].w : (e == 1 ? w[1].w : (e == 2 ? w[2].w : w[3].w));
            *(u32x4*)(dyn_lds + ldsoff + ((kg * 128 + nq * 4 + e) << 4)) = d;
        }
    }
};
template <class AL, class BL>
__device__ __forceinline__ void gemm_core(AL& al, BL& bl, int nk, f32x4 (&acc)[4][4], bool swap = false) {
    const int lane = tidx() & 63, wid = tidx() >> 6, wr = wid >> 1, wc = wid & 1, fr = lane & 15, fq = lane >> 4;
    const int w2 = swap ? wc : wr, w1 = swap ? wr : wc;
    const int o2 = swap ? 16384 : 0, o1 = swap ? 0 : 16384;
#pragma unroll
    for (int m = 0; m < 4; ++m)
#pragma unroll
        for (int n = 0; n < 4; ++n) acc[m][n] = (f32x4){0.f, 0.f, 0.f, 0.f};
    al.issue(0, 0); bl.issue(0, 16384); al.commit(0, 0); bl.commit(0, 16384);
    asm volatile("s_waitcnt vmcnt(0)" ::: "memory");
    __syncthreads();
    for (int kt = 0; kt < nk; ++kt) {
        const int cur = (kt & 1) * 32768, nxt = 32768 - cur;
        if (kt + 1 < nk) { al.issue(kt + 1, nxt); bl.issue(kt + 1, nxt + 16384); }
#pragma unroll
        for (int kk = 0; kk < 2; ++kk) {
            bf16x8 a[4], b[4];
#pragma unroll
            for (int m = 0; m < 4; ++m) a[m] = *(const bf16x8*)(dyn_lds + cur + o2 + lds_off(w2 * 64 + m * 16 + fr, kk * 32 + fq * 8));
#pragma unroll
            for (int n = 0; n < 4; ++n) b[n] = *(const bf16x8*)(dyn_lds + cur + o1 + (BL::LAYOUT == 1 ? (((kk * 4 + fq) * 128 + w1 * 64 + n * 16 + fr) << 4) : lds_off(w1 * 64 + n * 16 + fr, kk * 32 + fq * 8)));
#pragma unroll
            for (int m = 0; m < 4; ++m)
#pragma unroll
                for (int n = 0; n < 4; ++n) acc[m][n] = __builtin_amdgcn_mfma_f32_16x16x32_bf16(b[n], a[m], acc[m][n], 0, 0, 0);
        }
        if (kt + 1 < nk) { al.commit(kt + 1, nxt); bl.commit(kt + 1, nxt + 16384); }
        asm volatile("s_waitcnt vmcnt(0)" ::: "memory");
        __syncthreads();
    }
}


#define G3_STAGE 24576
#define G3_LDS (2 * G3_STAGE)
__device__ __forceinline__ int t32_off(int r, int c) { const int ob = (r & 15) * 64 + c * 2; return (r >> 4) * 1024 + (ob ^ (((ob >> 9) & 1) << 5)); }
__device__ __forceinline__ void dma_rc32(int lane, int st, int& R, int& C) { const int sb = lane * 16, swz = sb ^ (((sb >> 9) & 1) << 5); R = st * 16 + (swz >> 6); C = (swz & 63) >> 1; }
struct Dma3A {
    static constexpr int NV = 4;
    const char* base; unsigned voff[4];
    const char* lo = nullptr; int nk1 = 1 << 30;
    __device__ __forceinline__ void set_dense(const bf16_t* b0, int row0, int ld) {
        base = (const char*)b0; const int lane = tidx() & 63, w = tidx() >> 6;
#pragma unroll
        for (int i = 0; i < 4; ++i) { int R, C; dma_rc32(lane, w + 4 * i, R, C); voff[i] = (unsigned)(((size_t)(row0 + R) * ld + C) * 2); }
    }
    template <int SET = 0> __device__ __forceinline__ void issue(int kt, int ldsoff) const {
        const int w = tidx() >> 6;
#pragma unroll
        for (int i = 0; i < 4; ++i)
            __builtin_amdgcn_global_load_lds((const unsigned*)((((kt / nk1) == 2) ? lo : base) + voff[i] + (size_t)(kt % nk1) * 64), (LAS unsigned*)((LAS char*)dyn_lds + ldsoff + (w + 4 * i) * 1024), 16, 0, 0);
    }
    template <int SET = 0> __device__ __forceinline__ void commit(int, int) const {}
};
struct Dma3B {
    static constexpr int LAYOUT = 0, NV = 2;
    const char* hi; const char* lo; unsigned voff[2]; int nk1;
    __device__ __forceinline__ void set(const bf16_t* h, const bf16_t* l, int row0, int ld, int nk1_) {
        hi = (const char*)h; lo = (const char*)l; nk1 = nk1_; const int lane = tidx() & 63, w = tidx() >> 6;
#pragma unroll
        for (int i = 0; i < 2; ++i) { int R, C; dma_rc32(lane, w + 4 * i, R, C); voff[i] = (unsigned)(((size_t)(row0 + R) * ld + C) * 2); }
    }
    template <int SET = 0> __device__ __forceinline__ void issue(int kt, int ldsoff) const {
        const int w = tidx() >> 6; const char* base = ((kt / nk1) == 1) ? lo : hi; const size_t ko = (size_t)(kt % nk1) * 64;
#pragma unroll
        for (int i = 0; i < 2; ++i)
            __builtin_amdgcn_global_load_lds((const unsigned*)(base + voff[i] + ko), (LAS unsigned*)((LAS char*)dyn_lds + ldsoff + (w + 4 * i) * 1024), 16, 0, 0);
    }
    template <int SET = 0> __device__ __forceinline__ void commit(int, int) const {}
};
struct Reg3A {
    const float* rp0; size_t rs64; int nk1; f32x4 v[8];
    template <int SET = 0> __device__ __forceinline__ void issue(int kt, int) {
        const int k = (kt % nk1) * 32;
#pragma unroll
        for (int i = 0; i < 4; ++i) { const float* q = rp0 + i * rs64 + k; v[2 * i] = *(const f32x4*)q; v[2 * i + 1] = *(const f32x4*)(q + 4); }
    }
    template <int SET = 0> __device__ __forceinline__ void commit(int kt, int ldsoff) const {
        const int lo = (kt / nk1) == 2;
#pragma unroll
        for (int i = 0; i < 4; ++i) {
            const int p = tidx() + 256 * i, row = p >> 2, ch = p & 3;
            const f32x4 a = v[2 * i], b = v[2 * i + 1];
            u32x4 w;
            w.x = pack2(cvt_part(a[0], lo), cvt_part(a[1], lo)); w.y = pack2(cvt_part(a[2], lo), cvt_part(a[3], lo));
            w.z = pack2(cvt_part(b[0], lo), cvt_part(b[1], lo)); w.w = pack2(cvt_part(b[2], lo), cvt_part(b[3], lo));
            *(u32x4*)(dyn_lds + ldsoff + t32_off(row, ch * 8)) = w;
        }
    }
};
struct Reg3B {
    static constexpr int LAYOUT = 1, NV = 4;
    const float* bp; int ldb; f32x4 v[2][4];
    template <int SET = 0> __device__ __forceinline__ void issue(int kt, int) {
        const float* p = bp + (size_t)(kt * 32) * ldb;
#pragma unroll
        for (int j = 0; j < 4; ++j) v[SET][j] = *(const f32x4*)(p + (size_t)j * ldb);
    }
    template <int SET = 0> __device__ __forceinline__ void commit(int, int ldsoff) const {
        const int tid = tidx(), nq = tid & 31, kg = tid >> 5;
        u32x2 w[4];
#pragma unroll
        for (int i = 0; i < 4; ++i) { w[i].x = pack2(v[SET][0][i], v[SET][1][i]); w[i].y = pack2(v[SET][2][i], v[SET][3][i]); }
        const int rot = (nq >> 1) & 3;
#pragma unroll
        for (int i = 0; i < 4; ++i) {
            const int e = (i + rot) & 3;
            u32x2 d;
            d.x = e == 0 ? w[0].x : (e == 1 ? w[1].x : (e == 2 ? w[2].x : w[3].x));
            d.y = e == 0 ? w[0].y : (e == 1 ? w[1].y : (e == 2 ? w[2].y : w[3].y));
            *(u32x2*)(dyn_lds + ldsoff + ((((kg >> 1) * 128 + nq * 4 + e) << 4) + (kg & 1) * 8)) = d;
        }
    }
};
#define G4_LDS (3 * G3_STAGE)
template <class AL, class BL, int PAR>
__device__ __forceinline__ void g4_step(AL& al, BL& bl, int kt, int nk, f32x4 (&acc)[32]) {
    constexpr int NV = AL::NV + BL::NV;
    const int lane = tidx() & 63, wid = tidx() >> 6, wr = wid >> 1, wc = wid & 1, fr = lane & 15, fq = lane >> 4;
    const int s0 = kt % 3, cur = s0 * G3_STAGE, nx1 = (s0 == 2 ? 0 : s0 + 1) * G3_STAGE, nx2 = (s0 == 0 ? 2 : s0 - 1) * G3_STAGE;
    if (kt + 1 < nk) asm volatile("s_waitcnt vmcnt(%0) lgkmcnt(0)" :: "n"(NV) : "memory");
    else asm volatile("s_waitcnt vmcnt(0) lgkmcnt(0)" ::: "memory");
    __builtin_amdgcn_s_barrier();
    asm volatile("" ::: "memory");
    if (kt + 2 < nk) { al.template issue<PAR>(kt + 2, nx2); bl.template issue<PAR>(kt + 2, nx2 + 16384); }
    bf16x8 sm[4];
#pragma unroll
    for (int j = 0; j < 4; ++j) sm[j] = *(const bf16x8*)(dyn_lds + cur + 16384 + (BL::LAYOUT == 1 ? ((fq * 128 + wc * 64 + j * 16 + fr) << 4) : t32_off(wc * 64 + j * 16 + fr, fq * 8)));
    bf16x8 bigc = *(const bf16x8*)(dyn_lds + cur + t32_off(wr * 128 + fr, fq * 8));
#pragma unroll
    for (int i = 0; i < 8; ++i) {
        bf16x8 bign = bigc;
        if (i < 7) bign = *(const bf16x8*)(dyn_lds + cur + t32_off(wr * 128 + (i + 1) * 16 + fr, fq * 8));
        __builtin_amdgcn_sched_barrier(0);
#pragma unroll
        for (int j = 0; j < 4; ++j) acc[i * 4 + j] = __builtin_amdgcn_mfma_f32_16x16x32_bf16(sm[j], bigc, acc[i * 4 + j], 0, 0, 0);
        __builtin_amdgcn_sched_barrier(0);
        bigc = bign;
    }
    if (kt + 1 < nk) bl.template commit<PAR ^ 1>(kt + 1, nx1 + 16384);
}
template <class AL, class BL>
__device__ __forceinline__ void gemm_core4(AL& al, BL& bl, int nk, f32x4 (&acc)[32]) {
#pragma unroll
    for (int i = 0; i < 32; ++i) acc[i] = (f32x4){0.f, 0.f, 0.f, 0.f};
    al.template issue<0>(0, 0); bl.template issue<0>(0, 16384);
    if (nk > 1) { al.template issue<1>(1, G3_STAGE); bl.template issue<1>(1, G3_STAGE + 16384); }
    bl.template commit<0>(0, 16384);
    for (int kt = 0; kt < nk; kt += 2) {
        g4_step<AL, BL, 0>(al, bl, kt, nk, acc);
        if (kt + 1 < nk) g4_step<AL, BL, 1>(al, bl, kt + 1, nk, acc);
    }
    __syncthreads();
}
template <class AL, class BL>
__device__ __forceinline__ void gemm_core3(AL& al, BL& bl, int nk, f32x4 (&acc)[32]) {
    const int lane = tidx() & 63, wid = tidx() >> 6, wr = wid >> 1, wc = wid & 1, fr = lane & 15, fq = lane >> 4;
#pragma unroll
    for (int i = 0; i < 32; ++i) acc[i] = (f32x4){0.f, 0.f, 0.f, 0.f};
    al.issue(0, 0); bl.issue(0, 16384); al.commit(0, 0); bl.commit(0, 16384);
    asm volatile("s_waitcnt vmcnt(0)" ::: "memory");
    __syncthreads();
    for (int kt = 0; kt < nk; ++kt) {
        const int cur = (kt & 1) * G3_STAGE, nxt = G3_STAGE - cur;
        if (kt + 1 < nk) { al.issue(kt + 1, nxt); bl.issue(kt + 1, nxt + 16384); }
        bf16x8 sm[4];
#pragma unroll
        for (int j = 0; j < 4; ++j) sm[j] = *(const bf16x8*)(dyn_lds + cur + 16384 + (BL::LAYOUT == 1 ? ((fq * 128 + wc * 64 + j * 16 + fr) << 4) : t32_off(wc * 64 + j * 16 + fr, fq * 8)));
#pragma unroll
        for (int i = 0; i < 8; ++i) {
            const bf16x8 big = *(const bf16x8*)(dyn_lds + cur + t32_off(wr * 128 + i * 16 + fr, fq * 8));
#pragma unroll
            for (int j = 0; j < 4; ++j) acc[i * 4 + j] = __builtin_amdgcn_mfma_f32_16x16x32_bf16(sm[j], big, acc[i * 4 + j], 0, 0, 0);
        }
        if (kt + 1 < nk) { al.commit(kt + 1, nxt); bl.commit(kt + 1, nxt + 16384); }
        asm volatile("s_waitcnt vmcnt(0)" ::: "memory");
        __syncthreads();
    }
}
__device__ __forceinline__ bool dense_unit3(int bid, int nb, int j, int ntn, int& tm, int& tn) {
    if ((nb & 7) == 0) {
        const int x = bid & 7, r = bid >> 3, R = nb >> 3;
        const int li = r + R * j;
        if (li >= 8 * ntn) return false;
        tn = li >> 3; tm = x * 8 + (li & 7);
        return true;
    }
    const int u = bid + nb * j;
    if (u >= 64 * ntn) return false;
    tm = u / ntn; tn = u % ntn; return true;
}
__device__ __forceinline__ void prep_tile(char* lds, const float* W, int ldw, int k0, int scol0, bool colvalid, bf16_t* Bt, int K, int drow0, int mode) {
    const int tid = tidx();
    bf16_t* t = (bf16_t*)lds;
    __syncthreads();
#pragma unroll
    for (int i = 0; i < 4; ++i) {
        const int k = (tid >> 4) + 16 * i, q = tid & 15;
        f32x4 v = colvalid ? *(const f32x4*)(W + (size_t)(k0 + k) * ldw + scol0 + q * 4) : (f32x4){0.f, 0.f, 0.f, 0.f};
#pragma unroll
        for (int e = 0; e < 4; ++e) { float x = v[e]; if (mode == 2) x = x - bf2f(f2bf(x)); t[(q * 4 + e) * 72 + k] = (bf16_t)f2bf(x); }
    }
    __syncthreads();
#pragma unroll
    for (int i = 0; i < 2; ++i) { const int pc = tid + 256 * i, n = pc >> 3, ch = pc & 7;
        *(u32x4*)(Bt + (size_t)(drow0 + n) * K + k0 + ch * 8) = *(const u32x4*)(t + n * 72 + ch * 8); }
}
__device__ __forceinline__ int vcol_actual(int v);
__device__ __forceinline__ void phase_prep(char* lds, int bid, int nb, const P& p) {
    const int tid = tidx();
    for (size_t i = (size_t)bid * 256 + tid; i < (size_t)NTOK * DM / 8; i += (size_t)nb * 256) {
        const f32x4 a = *(const f32x4*)(p.x + i * 8), b = *(const f32x4*)(p.x + i * 8 + 4);
        u32x4 w; w.x = pack2(a[0], a[1]); w.y = pack2(a[2], a[3]); w.z = pack2(b[0], b[1]); w.w = pack2(b[2], b[3]);
        *(u32x4*)(p.XIb + i * 8) = w;
    }
    for (int u = bid; u < 2272; u += nb) {
        if (u < 768) { const int nt = u >> 4, kt = u & 15; const int d = nt * 64; const int sc = d < 2048 ? d : (d < 2560 ? d + 512 : d - 512);
            prep_tile(lds, p.even_w_in, EVEN_IN, kt * 64, sc, true, p.WIN0, DM, d, 0); }
        else if (u < 1024) { const int v = u - 768, nt = v >> 4, kt = v & 15; prep_tile(lds, p.even_w_out, DM, kt * 64, nt * 64, true, p.WOUT0, DM, nt * 64, 0); }
        else if (u < 1760) { const int v = u - 1024, nt = v >> 4, kt = v & 15; const int d = nt * 64;
            int sc; bool ok = true;
            if (d < 896) sc = d; else if (d < 1024) sc = d + 128; else if (d < 1536) sc = d + 280; else if (d < 2048) sc = d + 280;
            else if (d < 2112) sc = 1280; else if (d < 2176) { sc = 0; ok = false; } else if (d < 2304) sc = d - 1280; else if (d < 2432) sc = d - 1152; else sc = d - 104;
            prep_tile(lds, p.odd_w_in, ODD_IN, kt * 64, sc, ok, p.WIN1, DM, d, 0); }
        else if (u < 2016) { const int v = u - 1760, nt = v >> 4, kt = v & 15; prep_tile(lds, p.odd_w_out, DM, kt * 64, nt * 64, true, p.WOUT1, DM, nt * 64, 0); }
        else { const int v = u - 2016, layer = v >> 7, lo = (v >> 6) & 1, nt = (v >> 4) & 3, kt = v & 15;
            prep_tile(lds, p.w_router + (size_t)layer * DM * NEXP, NEXP, kt * 64, nt * 64, true, (lo ? p.WRL : p.WRH) + (size_t)layer * NEXP * DM, DM, nt * 64, lo ? 2 : 1); }
    }
    __syncthreads();
}


__device__ __forceinline__ bool dense_unit(int bid, int nb, int j, int ntn, int& tm, int& tn) {
    if ((nb & 7) == 0) {
        const int x = bid & 7, r = bid >> 3, R = nb >> 3;
        const int li = r + R * j;
        if (li >= 16 * ntn) return false;
        const int pg = li / (8 * ntn), rest = li - pg * 8 * ntn;
        tn = rest >> 3; tm = x * 16 + pg * 8 + (rest & 7);
        return true;
    }
    const int u = bid + nb * j;
    if (u >= 128 * ntn) return false;
    tm = u / ntn; tn = u % ntn; return true;
}
struct DmaLoadSplit {
    static constexpr int LAYOUT = 0;
    const char* hi; const char* lo; unsigned voff[4]; int nk1;
    __device__ __forceinline__ void set(const bf16_t* h, const bf16_t* l, int row0, int ld, int nk1_) {
        hi = (const char*)h; lo = (const char*)l; nk1 = nk1_; const int lane = tidx() & 63, w = tidx() >> 6;
#pragma unroll
        for (int i = 0; i < 4; ++i) { int R, C; dma_rc(lane, w + 4 * i, R, C); voff[i] = (unsigned)(((size_t)(row0 + R) * ld + C) * 2); }
    }
    __device__ __forceinline__ void issue(int kt, int ldsoff) const {
        const int w = tidx() >> 6; const char* base = ((kt / nk1) == 1) ? lo : hi; const size_t ko = (size_t)(kt % nk1) * 128;
#pragma unroll
        for (int i = 0; i < 4; ++i)
            __builtin_amdgcn_global_load_lds((const unsigned*)(base + voff[i] + ko), (LAS unsigned*)((LAS char*)dyn_lds + ldsoff + (w + 4 * i) * 1024), 16, 0, 0);
    }
    __device__ __forceinline__ void commit(int, int) const {}
};
__device__ __forceinline__ void phase_gemm_f32out(int bid, int nb, const bf16_t* A, const bf16_t* Bt, int N, int K, float* C) {
    const int ntn = N / 128;
    const int tid = tidx(), lane = tid & 63, wid = tid >> 6, wr = wid >> 1, wc = wid & 1, fr = lane & 15, fq = lane >> 4;
    for (int j = 0;; ++j) {
        int tm, tn; if (!dense_unit3(bid, nb, j, ntn, tm, tn)) break;
        Dma3A al; al.set_dense(A, tm * 256, K); Dma3B bl; bl.set(Bt, Bt, tn * 128, K, 1 << 30);
        f32x4 acc[32];
        gemm_core4(al, bl, K / 32, acc);
#pragma unroll
        for (int i = 0; i < 8; ++i)
#pragma unroll
            for (int n = 0; n < 4; ++n) *(f32x4*)(C + (size_t)(tm * 256 + wr * 128 + i * 16 + fr) * N + tn * 128 + wc * 64 + n * 16 + fq * 4) = acc[i * 4 + n];
    }
}
__device__ __forceinline__ void phase_router(int bid, int nb, const P& p, int layer) {
    const int tid = tidx(), lane = tid & 63, wid = tid >> 6, wr = wid >> 1, wc = wid & 1, fr = lane & 15, fq = lane >> 4;
    for (int j = 0;; ++j) {
        int tm, tn; if (!dense_unit3(bid, nb, j, 2, tm, tn)) break;
        Dma3A al; al.set_dense(p.XAb, tm * 256, DM); al.lo = (const char*)p.XAl; al.nk1 = 32;
        Dma3B bl; bl.set(p.WRH + (size_t)layer * NEXP * DM, p.WRL + (size_t)layer * NEXP * DM, tn * 128, DM, 32);
        f32x4 acc[32];
        gemm_core4(al, bl, 96, acc);
#pragma unroll
        for (int i = 0; i < 8; ++i)
#pragma unroll
            for (int n = 0; n < 4; ++n) *(f32x4*)(p.LOG + (size_t)(tm * 256 + wr * 128 + i * 16 + fr) * NEXP + tn * 128 + wc * 64 + n * 16 + fq * 4) = acc[i * 4 + n];
    }
}
template <bool AF32, bool SPLIT>
__device__ __forceinline__ void phase_gemm_dense(char* lds, int bid, int nb, const void* A, int lda, const float* W, int ldw, int M, int N, int K, float* C, int ldc) {
    const int ntn = (N + 127) / 128, ntm = M / 128, nk1 = K / 64;
    const int tid = tidx(), lane = tid & 63, wid = tid >> 6, wr = wid >> 1, wc = wid & 1, fr = lane & 15, fq = lane >> 4;
    for (int u = bid; u < ntm * ntn; u += nb) {
        const int tm = u / ntn, tn = u % ntn;
        BLoadF32 bl; { const int nq = tid & 31, kg = tid >> 5; const int col = tn * 128 + nq * 4; bl.valid = col < N; bl.ldb = ldw; bl.nk1 = SPLIT ? nk1 : (1 << 30);
            bl.bp = W + (size_t)(kg * 8) * ldw + (bl.valid ? col : 0); }
        f32x4 acc[4][4];
        if (AF32) {
            ALoadF32S al; al.nk1 = SPLIT ? nk1 : (1 << 30); al.rs32 = (size_t)32 * lda;
            al.rp0 = (const float*)A + (size_t)(tm * 128 + (tid >> 3)) * lda + (tid & 7) * 8;
            gemm_tile(lds, al, bl, SPLIT ? 3 * nk1 : nk1, acc);
        } else {
            ALoadBF16S al; al.rs32 = (size_t)32 * lda;
            al.rp0 = (const bf16_t*)A + (size_t)(tm * 128 + (tid >> 3)) * lda + (tid & 7) * 8;
            gemm_tile(lds, al, bl, nk1, acc);
        }
#pragma unroll
        for (int m = 0; m < 4; ++m)
#pragma unroll
            for (int n = 0; n < 4; ++n) {
                const int row = tm * 128 + wr * 64 + m * 16 + fr, col = tn * 128 + wc * 64 + n * 16 + fq * 4;
                if (col < N) *(f32x4*)(C + (size_t)row * ldc + col) = acc[m][n];
            }
    }
}

__device__ __forceinline__ void ln_row_store(float (&v)[16], const float* g, const float* b, float* of, bf16_t* ob, int row, int lane, bf16_t* ol = nullptr) {
    float s = 0.f;
#pragma unroll
    for (int i = 0; i < 16; ++i) s += v[i];
    const float mu = wave_sum(s) * (1.0f / DM);
    float q = 0.f;
#pragma unroll
    for (int i = 0; i < 16; ++i) { const float d = v[i] - mu; q += d * d; }
    const float rstd = rsqrtf(wave_sum(q) * (1.0f / DM) + LN_EPS);
#pragma unroll
    for (int h = 0; h < 2; ++h) {
        const int c0 = h * 512 + lane * 8;
        float o[8];
#pragma unroll
        for (int i = 0; i < 8; ++i) o[i] = (v[h * 8 + i] - mu) * rstd * g[c0 + i] + b[c0 + i];
        *(f32x4*)(of + (size_t)row * DM + c0) = (f32x4){o[0], o[1], o[2], o[3]};
        *(f32x4*)(of + (size_t)row * DM + c0 + 4) = (f32x4){o[4], o[5], o[6], o[7]};
        if (ob) { u32x4 w; w.x = pack2(o[0], o[1]); w.y = pack2(o[2], o[3]); w.z = pack2(o[4], o[5]); w.w = pack2(o[6], o[7]); *(u32x4*)(ob + (size_t)row * DM + c0) = w;
            if (ol) { float l[8];
#pragma unroll
                for (int i = 0; i < 8; ++i) l[i] = o[i] - bf2f(f2bf(o[i]));
                u32x4 wl; wl.x = pack2(l[0], l[1]); wl.y = pack2(l[2], l[3]); wl.z = pack2(l[4], l[5]); wl.w = pack2(l[6], l[7]); *(u32x4*)(ol + (size_t)row * DM + c0) = wl; } }
    }
}
__device__ __forceinline__ void phase_ln_add(int bid, int nb, const float* res, const float* add, const float* g, const float* b, float* of, bf16_t* ob, bf16_t* ol) {
    const int lane = tidx() & 63, wid = tidx() >> 6;
    for (int row = bid * 4 + wid; row < NTOK; row += nb * 4) {
        float v[16];
#pragma unroll
        for (int h = 0; h < 2; ++h) {
            const size_t o = (size_t)row * DM + h * 512 + lane * 8;
            const f32x4 r0 = *(const f32x4*)(res + o), r1 = *(const f32x4*)(res + o + 4), a0 = *(const f32x4*)(add + o), a1 = *(const f32x4*)(add + o + 4);
#pragma unroll
            for (int i = 0; i < 4; ++i) { v[h * 8 + i] = DN_ALPHA * r0[i] + a0[i]; v[h * 8 + 4 + i] = DN_ALPHA * r1[i] + a1[i]; }
        }
        ln_row_store(v, g, b, of, ob, row, lane, ol);
    }
}

__device__ __forceinline__ void phase_lru_gates(char* lds, int bid, int nb, const P& p) {
    float* xs = (float*)lds;
    const int tid = tidx();
    for (int tok = bid; tok < NTOK; tok += nb) {
        const int t = tok & (SEQ - 1);
        __syncthreads();
#pragma unroll
        for (int cc = 0; cc < 2; ++cc) {
            const int c = tid + 256 * cc;
            float xc = p.conv_b[c];
#pragma unroll
            for (int w = 0; w < 4; ++w) { const int tt = t - 3 + w; if (tt >= 0) xc += p.conv_w[w * 512 + c] * p.U[(size_t)(tok - 3 + w) * EVEN_IN + c]; }
            xs[c] = xc;
        }
        __syncthreads();
#pragma unroll
        for (int cc = 0; cc < 2; ++cc) {
            const int c = tid + 256 * cc, h = c >> 6, j = c & 63;
            float ra = p.ba[c], ri = p.bx[c];
#pragma unroll 8
            for (int i = 0; i < 64; ++i) { const float xv = xs[h * 64 + i]; ra += xv * p.wa[(h * 64 + i) * 64 + j]; ri += xv * p.wx[(h * 64 + i) * 64 + j]; }
            const float r = sigmoidf_(ra), ig = sigmoidf_(ri);
            const float nl = -p.lam[c];
            const float sp = fmaxf(nl, 0.f) + log1pf(expf(-fabsf(nl)));
            const float log_a = -8.0f * r * sp;
            const float a = expf(log_a);
            const float mult = (t == 0) ? 1.0f : sqrtf(-expm1f(2.0f * log_a));
            p.LA[(size_t)tok * 512 + c] = a;
            p.LB[(size_t)tok * 512 + c] = mult * ig * xs[c];
        }
    }
}
__device__ __forceinline__ void phase_lru_scan(int bid, int nb, const P& p) {
    for (int it = bid * 256 + tidx(); it < NBATCH * 512; it += nb * 256) {
        const int b = it >> 9, c = it & 511;
        float h = 0.f;
        for (int t = 0; t < SEQ; ++t) {
            const size_t n = (size_t)b * SEQ + t;
            h = p.LA[n * 512 + c] * h + p.LB[n * 512 + c];
            const float gb = p.U[n * EVEN_IN + 512 + c];
            p.MIX[n * DM + c] = (bf16_t)f2bf(h * gelu_tanh(gb));
        }
    }
}
__device__ __forceinline__ void phase_hgrn_seq(char* lds, int bid, int nb, const P& p) {
    const int tid = tidx(), half = tid >> 7, v = tid & 127;
    float* sq = (float*)lds + half * 512;
    float* sf = sq + 128;
    float* red = sq + 256;
    for (int u0 = bid * 2; u0 < NBATCH * 4; u0 += nb * 2) {
        const int u = u0 + half;
        const int b = u >> 2, h = u & 3;
        const int ch = h * 128 + v;
        float lbv; { const float l0 = p.hg_lb[ch], l1 = p.hg_lb[512 + ch], l2 = p.hg_lb[1024 + ch]; const float mx = fmaxf(l0, fmaxf(l1, l2));
            const float e0 = expf(l0 - mx), e1 = expf(l1 - mx), e2 = expf(l2 - mx); lbv = e0 / (e0 + e1 + e2); }
        const float ng = p.hg_ng[ch];
        float S[128];
#pragma unroll
        for (int k = 0; k < 128; ++k) S[k] = 0.f;
        for (int t = 0; t < SEQ; ++t) {
            const size_t n = (size_t)b * SEQ + t;
            const float* ur = p.U + n * EVEN_IN;
            const float qv = siluf_(ur[1024 + ch]);
            const float f = lbv + (1.0f - lbv) * sigmoidf_(ur[1536 + ch]);
            __syncthreads();
            sq[v] = qv; sf[v] = f;
            __syncthreads();
            const float vv = ur[2048 + ch];
            float o = 0.f;
#pragma unroll
            for (int k = 0; k < 128; ++k) { const float fk = sf[k]; S[k] = fk * S[k] + (1.0f - fk) * vv; o += sq[k] * S[k]; }
            const float ss = wave_sum(o * o);
            if ((tid & 63) == 0) red[(tid >> 6) & 1] = ss;
            __syncthreads();
            const float tot = red[0] + red[1];
            const float y = o * rsqrtf(tot * (1.0f / 128.0f) + 1e-6f) * ng * sigmoidf_(ur[2560 + ch]);
            p.MIX[n * DM + 512 + ch] = (bf16_t)f2bf(y);
        }
        __syncthreads();
    }
}

__device__ __forceinline__ void phase_route(int bid, int nb, const P& p, int layer) {
    const float* br = p.b_router + layer * NEXP;
    const int tid = tidx(), lane = tid & 63, wid = tid >> 6;
    const int gt = bid * 256 + tid, gs = nb * 256;
    for (int i = gt; i < NROWS; i += gs) p.rowtok[i] = (i >= SH_TILE0 * 128) ? (i - SH_TILE0 * 128) : 0;
    const f32x4 bv = *(const f32x4*)(br + lane * 4);
    for (int tb = bid * 4 + wid; tb < NTOK; tb += nb * 4 * 8) {
        int es[8]; float ws[8];
#pragma unroll
        for (int q = 0; q < 8; ++q) {
            const int t = tb + q * nb * 4;
            es[q] = 0; ws[q] = 0.f;
            if (t < NTOK) {
        const f32x4 lg = *(const f32x4*)(p.LOG + (size_t)t * NEXP + lane * 4);
        float sc[4], bs[4];
#pragma unroll
        for (int i = 0; i < 4; ++i) { sc[i] = sigmoidf_(lg[i]); bs[i] = sc[i] + bv[i]; }
        float t1 = fmaxf(bs[0], bs[1]), t2 = fminf(bs[0], bs[1]);
        { const float a = fmaxf(bs[2], bs[3]), c = fminf(bs[2], bs[3]); const float n1 = fmaxf(t1, a); t2 = fmaxf(fminf(t1, a), fmaxf(t2, c)); t1 = n1; }
#pragma unroll
        for (int o = 1; o <= 4; o <<= 1) { const float o1 = __shfl_xor(t1, o), o2 = __shfl_xor(t2, o); const float n1 = fmaxf(t1, o1); t2 = fmaxf(fminf(t1, o1), fmaxf(t2, o2)); t1 = n1; }
        const float gsc = t1 + t2;
        const int g = lane >> 3;
        int rank = 0;
#pragma unroll
        for (int g2 = 0; g2 < 8; ++g2) { const float o = __shfl(gsc, g2 * 8); rank += (o > gsc || (o == gsc && g2 < g)) ? 1 : 0; }
        const bool allowed = rank < 4;
        float cv[4];
#pragma unroll
        for (int i = 0; i < 4; ++i) cv[i] = allowed ? bs[i] : -3e38f;
        float wsel = 0.f; int esel = 0; float wsum = 0.f;
#pragma unroll
        for (int k = 0; k < 8; ++k) {
            float bvv = cv[0]; int bi = 0;
#pragma unroll
            for (int i = 1; i < 4; ++i) if (cv[i] > bvv) { bvv = cv[i]; bi = i; }
            int be = lane * 4 + bi;
#pragma unroll
            for (int o = 1; o <= 32; o <<= 1) { const float ov = __shfl_xor(bvv, o); const int oe = __shfl_xor(be, o); if (ov > bvv || (ov == bvv && oe < be)) { bvv = ov; be = oe; } }
            const int ol = be >> 2, oi = be & 3;
            float sown = 0.f;
#pragma unroll
            for (int i = 0; i < 4; ++i) if (oi == i) sown = sc[i];
            const float sv = __shfl(sown, ol);
            if (lane == ol) {
#pragma unroll
                for (int i = 0; i < 4; ++i) if (oi == i) cv[i] = -3e38f;
            }
            wsum += sv;
            if (lane == k) { wsel = sv; esel = be; }
        }
        es[q] = esel; ws[q] = wsel / wsum * 2.5f;
            }
        }
        int rk[8];
#pragma unroll
        for (int q = 0; q < 8; ++q) { rk[q] = 0; if (lane < 8 && tb + q * nb * 4 < NTOK) rk[q] = atomicAdd(&p.cnt[es[q]], 1); }
#pragma unroll
        for (int q = 0; q < 8; ++q) { const int t = tb + q * nb * 4; if (lane < 8 && t < NTOK) { p.eidx[t * 8 + lane] = es[q]; p.ew[t * 8 + lane] = ws[q]; p.erank[t * 8 + lane] = rk[q]; } }
    }
}
__device__ __forceinline__ void phase_scatter(char* lds, int bid, int nb, const P& p) {
    int* base = (int*)lds;
    const int tid = tidx();
    __syncthreads();
    int* pc = base + 260;
    pc[tid] = (p.cnt[tid] + 127) & ~127;
    __syncthreads();
    { int s = 0; for (int e = 0; e < tid; ++e) s += pc[e]; base[tid] = s; if (tid == 255) base[256] = s + pc[255]; }
    __syncthreads();
    for (int a = bid * 256 + tid; a < NTOK * 8; a += nb * 256) {
        const int e = p.eidx[a]; const int row = base[e] + p.erank[a];
        p.rowtok[row] = a >> 3; p.epos[a] = row;
    }
    if (bid == 0) {
        {
            const int xq = tid & 7; int off = 0, tot = 0;
            for (int e = xq; e < 256; e += 8) { const int n = ((pc[e] >> 7) + 1) >> 1; if (e < tid) off += n; tot += n; }
            const int t0 = base[tid] >> 7, nte = pc[tid] >> 7;
            for (int i = 0; i < nte; i += 2) p.plist[xq * 320 + off + (i >> 1)] = (t0 + i) | ((i + 1 < nte) ? 0 : 0x40000000);
            if (tid < 64) { int totp = 0; for (int e = (tid & 7); e < 256; e += 8) totp += ((pc[e] >> 7) + 1) >> 1; p.plist[(tid & 7) * 320 + totp + (tid >> 3)] = SH_TILE0 + 2 * tid; }
            if (tid < 8) p.plen[tid] = tot + 8;
        }
        const int nrt = base[256] >> 7;
        for (int i = tid; i < NTILES; i += 256) if (i >= nrt) p.tile_e[i] = (i >= SH_TILE0) ? NEXP : -1;
        const int t0 = base[tid] >> 7, t1 = base[tid + 1] >> 7;
        for (int i = t0; i < t1; ++i) p.tile_e[i] = tid;
    }
    __syncthreads();
}
__device__ __forceinline__ void phase_moe1(char* lds, int bid, int nb, const P& p, int layer, const bf16_t* Xb) {
    const int tid = tidx(), lane = tid & 63, wid = tid >> 6, wr = wid >> 1, wc = wid & 1, fr = lane & 15, fq = lane >> 4;
    const int xq = bid & 7, plen = p.plen[xq];
    for (int ui = bid >> 3; ui < plen * 4; ui += (nb >> 3)) {
        const int nt = ui & 3;
        const int ent = p.plist[xq * 320 + (ui >> 2)];
        const int tile0 = ent & 0xffff, single = (ent >> 30) & 1, tile1 = single ? tile0 : tile0 + 1;
        const int e = p.tile_e[tile0];
        const float* Wg = (e < NEXP) ? p.w_gate + ((size_t)layer * NEXP + e) * (DM * 256) : p.ws_gate + (size_t)layer * (DM * 256);
        const float* Wu = (e < NEXP) ? p.w_up + ((size_t)layer * NEXP + e) * (DM * 256) : p.ws_up + (size_t)layer * (DM * 256);
        Dma3A al; al.base = (const char*)Xb;
#pragma unroll
        for (int i = 0; i < 4; ++i) { int R, C; dma_rc32(lane, wid + 4 * i, R, C); const int tok = p.rowtok[(R < 128 ? tile0 : tile1) * 128 + (R & 127)]; al.voff[i] = (unsigned)(((size_t)tok * DM + C) * 2); }
        Reg3B bl; { const int nq = tid & 31, kg = tid >> 5; const int j = nq * 4, jw = j & 63, w2 = j >> 6; const int col = nt * 64 + w2 * 32 + (jw & 31);
            bl.ldb = 256; bl.bp = ((jw >= 32) ? Wu : Wg) + (size_t)(kg * 4) * 256 + col; }
        f32x4 acc[32];
        gemm_core4(al, bl, DM / 32, acc);
        if (!(wr && single)) {
            const int tile = wr ? tile1 : tile0;
#pragma unroll
            for (int i = 0; i < 8; ++i)
#pragma unroll
                for (int n = 0; n < 2; ++n) {
                    const int row = tile * 128 + i * 16 + fr, col = nt * 64 + wc * 32 + n * 16 + fq * 4;
                    const f32x4 g = acc[i * 4 + n], uu = acc[i * 4 + n + 2];
                    u32x2 w; w.x = pack2(siluf_(g[0]) * uu[0], siluf_(g[1]) * uu[1]); w.y = pack2(siluf_(g[2]) * uu[2], siluf_(g[3]) * uu[3]);
                    *(u32x2*)(p.H + (size_t)row * 256 + col) = w;
                }
        }
    }
}
__device__ __forceinline__ void phase_moe2(char* lds, int bid, int nb, const P& p, int layer) {
    const int tid = tidx(), lane = tid & 63, wid = tid >> 6, wr = wid >> 1, wc = wid & 1, fr = lane & 15, fq = lane >> 4;
    const int xq = bid & 7, plen = p.plen[xq];
    for (int ui = bid >> 3; ui < plen * 8; ui += (nb >> 3)) {
        const int nt = ui & 7;
        const int ent = p.plist[xq * 320 + (ui >> 3)];
        const int tile0 = ent & 0xffff, single = (ent >> 30) & 1, tile1 = single ? tile0 : tile0 + 1;
        const int e = p.tile_e[tile0];
        const float* Wd = (e < NEXP) ? p.w_down + ((size_t)layer * NEXP + e) * (256 * DM) : p.ws_down + (size_t)layer * (256 * DM);
        Dma3A al; al.base = (const char*)p.H;
#pragma unroll
        for (int i = 0; i < 4; ++i) { int R, C; dma_rc32(lane, wid + 4 * i, R, C); al.voff[i] = (unsigned)(((size_t)((R < 128 ? tile0 : tile1) * 128 + (R & 127)) * 256 + C) * 2); }
        Reg3B bl; { const int nq = tid & 31, kg = tid >> 5; bl.ldb = DM; bl.bp = Wd + (size_t)(kg * 4) * DM + nt * 128 + nq * 4; }
        f32x4 acc[32];
        gemm_core4(al, bl, 256 / 32, acc);
        if (!(wr && single)) {
            const int tile = wr ? tile1 : tile0;
#pragma unroll
            for (int i = 0; i < 8; ++i)
#pragma unroll
                for (int n = 0; n < 4; ++n) {
                    const int row = tile * 128 + i * 16 + fr, col = nt * 128 + wc * 64 + n * 16 + fq * 4;
                    const f32x4 a = acc[i * 4 + n];
                    u32x2 w; w.x = pack2(a[0], a[1]); w.y = pack2(a[2], a[3]);
                    *(u32x2*)(p.Y + (size_t)row * DM + col) = w;
                }
        }
    }
}
__device__ __forceinline__ void phase_combine_ln(int bid, int nb, const P& p, const float* X, const float* g, const float* b, float* of, bf16_t* ob) {
    const int lane = tidx() & 63, wid = tidx() >> 6;
    for (int row = bid * 4 + wid; row < NTOK; row += nb * 4) {
        float v[16];
#pragma unroll
        for (int h = 0; h < 2; ++h) {
            const size_t o = (size_t)row * DM + h * 512 + lane * 8;
            const f32x4 r0 = *(const f32x4*)(X + o), r1 = *(const f32x4*)(X + o + 4);
#pragma unroll
            for (int i = 0; i < 4; ++i) { v[h * 8 + i] = DN_ALPHA * r0[i]; v[h * 8 + 4 + i] = DN_ALPHA * r1[i]; }
        }
#pragma unroll
        for (int k = 0; k < 9; ++k) {
            const int yr = (k < 8) ? p.epos[row * 8 + k] : (SH_TILE0 * 128 + row);
            const float w = (k < 8) ? p.ew[row * 8 + k] : 1.0f;
#pragma unroll
            for (int h = 0; h < 2; ++h) {
                const u32x4 y = *(const u32x4*)(p.Y + (size_t)yr * DM + h * 512 + lane * 8);
                v[h * 8 + 0] += w * bf2f(y.x & 0xffffu); v[h * 8 + 1] += w * bf2f(y.x >> 16);
                v[h * 8 + 2] += w * bf2f(y.y & 0xffffu); v[h * 8 + 3] += w * bf2f(y.y >> 16);
                v[h * 8 + 4] += w * bf2f(y.z & 0xffffu); v[h * 8 + 5] += w * bf2f(y.z >> 16);
                v[h * 8 + 6] += w * bf2f(y.w & 0xffffu); v[h * 8 + 7] += w * bf2f(y.w >> 16);
            }
        }
        ln_row_store(v, g, b, of, ob, row, lane);
    }
}

__device__ __forceinline__ void phase_nsa_compress(char* lds, int bid, int nb, const P& p) {
    float* blk = (float*)lds;
    float* hs = blk + 4096;
    const int tid = tidx(), which = tid >> 7, j = tid & 127;
    const float* pe = which ? p.pe_v : p.pe_k; const float* w1 = which ? p.wv1 : p.wk1; const float* w2 = which ? p.wv2 : p.wk2;
    float* outp = which ? p.VC : p.KC;
    for (int u = bid; u < 16 * 127; u += nb) {
        const int bg = u / 127, c = u % 127, b = bg >> 1, g = bg & 1;
        __syncthreads();
        for (int i = j; i < 2048; i += 128) { const int l = i >> 6, d = i & 63; blk[which * 2048 + i] = p.KCV[(size_t)(b * SEQ + 16 * c + l) * 256 + which * 128 + g * 64 + d] + pe[i]; }
        __syncthreads();
        float a = 0.f;
        for (int i = 0; i < 2048; ++i) a += blk[which * 2048 + i] * w1[i * 128 + j];
        hs[which * 128 + j] = gelu_tanh(a);
        __syncthreads();
        if (j < 64) { float o = 0.f; for (int i = 0; i < 128; ++i) o += hs[which * 128 + i] * w2[i * 64 + j]; outp[(size_t)(bg * 127 + c) * 64 + j] = o; }
    }
}
__device__ __forceinline__ void phase_moba_kmean(int bid, int nb, const P& p) {
    const int tid = tidx();
    for (int u = bid; u < NBATCH * 8; u += nb) {
        const int b = u >> 3, j = u & 7;
        const bf16_t* src = p.MK + (size_t)(b * SEQ + j * 256) * 512 + tid * 2;
        float s0 = 0.f, s1 = 0.f;
        for (int r8 = 0; r8 < 256; r8 += 8) {
            unsigned v[8];
#pragma unroll
            for (int i = 0; i < 8; ++i) v[i] = *(const unsigned*)(src + (size_t)(r8 + i) * 512);
#pragma unroll
            for (int i = 0; i < 8; ++i) { s0 += bf2f(v[i] & 0xffffu); s1 += bf2f(v[i] >> 16); }
        }
        const int h = tid >> 5, d = (tid & 31) * 2;
        p.KM[((size_t)(b * 8 + h) * 8 + j) * 64 + d] = s0 * (1.0f / 256.0f);
        p.KM[((size_t)(b * 8 + h) * 8 + j) * 64 + d + 1] = s1 * (1.0f / 256.0f);
    }
}
#define CMP_LDS ((127 * 65 + 127 * 64 + 4 * (64 + 128 + 128)) * 4)
__device__ __forceinline__ void phase_nsa_cmp(char* lds, int bid, int nb, const P& p) {
    float* kc = (float*)lds;
    float* vc = kc + 127 * 65;
    const int tid = tidx(), lane = tid & 63, wid = tid >> 6;
    float* qs = vc + 127 * 64 + wid * 320;
    float* ps = qs + 64;
    float* pp = ps + 128;
    for (int u = bid; u < 16 * 32; u += nb) {
        const int bg = u >> 5, tb = u & 31, b = bg >> 1, g = bg & 1;
        __syncthreads();
        for (int i = tid; i < 127 * 64; i += 256) { const int c = i >> 6, d = i & 63; kc[c * 65 + d] = p.KC[(size_t)bg * 127 * 64 + i]; vc[i] = p.VC[(size_t)bg * 127 * 64 + i]; }
        __syncthreads();
        for (int qi = 0; qi < 16; ++qi) {
            const int t = tb * 64 + wid * 16 + qi;
            const size_t n = (size_t)b * SEQ + t;
            float psum0 = 0.f, psum1 = 0.f;
            for (int i = 0; i < 4; ++i) {
                const int hd = g * 4 + i;
                const float slope = exp2f(-((float)hd + 0.5f));
                qs[lane] = bf2f(p.Qb[n * 512 + hd * 64 + lane]);
                __builtin_amdgcn_wave_barrier();
                float s0 = NEGF, s1 = NEGF;
                const int c0 = lane, c1 = lane + 64;
                const bool v0 = (16 * c0 + 31 <= t), v1 = (c1 < 127) && (16 * c1 + 31 <= t);
                if (v0) { float d = 0.f; for (int k = 0; k < 64; ++k) d += qs[k] * kc[c0 * 65 + k]; s0 = d * 0.125f - slope * (float)(t - (16 * c0 + 31)); }
                if (v1) { float d = 0.f; for (int k = 0; k < 64; ++k) d += qs[k] * kc[c1 * 65 + k]; s1 = d * 0.125f - slope * (float)(t - (16 * c1 + 31)); }
                const float m = wave_max(fmaxf(s0, s1));
                float p0 = v0 ? __expf(s0 - m) : 0.f, p1 = v1 ? __expf(s1 - m) : 0.f;
                const float den = fmaxf(wave_sum(p0 + p1), 1e-30f);
                p0 /= den; p1 /= den;
                psum0 += p0; psum1 += p1;
                ps[c0] = p0; ps[c1] = p1;
                __builtin_amdgcn_wave_barrier();
                float o = 0.f;
                for (int c = 0; c < 127; ++c) o += ps[c] * vc[c * 64 + lane];
                p.OC[n * 512 + hd * 64 + lane] = o;
                __builtin_amdgcn_wave_barrier();
            }
            pp[lane] = psum0; pp[lane + 64] = psum1;
            __builtin_amdgcn_wave_barrier();
            const int j = lane & 31, own = t >> 6;
            float imp = 0.f;
#pragma unroll
            for (int c = 4 * j - 1; c <= 4 * j + 3; ++c) if (c >= 0 && c < 127) imp += pp[c];
            const bool forced = (j == 0) || (j == own) || (j == own - 1);
            const bool valid = j <= own;
            const float val = valid ? (imp + (forced ? 1e4f : 0.f)) : NEGF;
            int rank = 0;
            for (int j2 = 0; j2 < 32; ++j2) { const float o2 = __shfl(val, j2); rank += (o2 > val || (o2 == val && j2 < j)) ? 1 : 0; }
            const unsigned long long bal = __ballot(valid && rank < 16 && lane < 32);
            if (lane == 0) p.SELM[(size_t)bg * SEQ + t] = (unsigned)bal;
            __builtin_amdgcn_wave_barrier();
        }
    }
}
struct AttnState { float m, l, o; };
__device__ __forceinline__ void attn_block(AttnState& st, const float* qs, float* ps, const float* Kb, const float* Vb, int s0, int t, float slope, bool lanevalid) {
    const int lane = tidx() & 63;
    float sc = NEGF;
    if (lanevalid) {
        const float* kr = Kb + (size_t)lane * ODD_IN;
        float d = 0.f;
#pragma unroll
        for (int k = 0; k < 64; k += 4) { const f32x4 kv = *(const f32x4*)(kr + k); d += kv[0] * qs[k] + kv[1] * qs[k + 1] + kv[2] * qs[k + 2] + kv[3] * qs[k + 3]; }
        sc = d * 0.125f - slope * (float)(t - (s0 + lane));
    }
    const float mn = fmaxf(st.m, wave_max(sc));
    const float pr = lanevalid ? __expf(sc - mn) : 0.f;
    const float corr = __expf(st.m - mn);
    st.l = st.l * corr + wave_sum(pr);
    __builtin_amdgcn_wave_barrier();
    ps[lane] = pr;
    __builtin_amdgcn_wave_barrier();
    float acc = 0.f;
    for (int s = 0; s < 64; ++s) acc += ps[s] * Vb[(size_t)s * ODD_IN + lane];
    st.o = st.o * corr + acc; st.m = mn;
    __builtin_amdgcn_wave_barrier();
}
__device__ __forceinline__ void phase_nsa_attn(char* lds, int bid, int nb, const P& p) {
    const int tid = tidx(), lane = tid & 63, wid = tid >> 6;
    float* qs = (float*)lds + wid * 128; float* ps = qs + 64;
    for (int it = bid * 4 + wid; it < NTOK * 8; it += nb * 4) {
        const int hd = it & 7; const int n = it >> 3; const int b = n >> 11, t = n & (SEQ - 1), g = hd >> 2;
        const float slope = exp2f(-((float)hd + 0.5f));
        __builtin_amdgcn_wave_barrier();
        qs[lane] = p.U[(size_t)n * ODD_IN + hd * 64 + lane];
        __builtin_amdgcn_wave_barrier();
        const unsigned mask = p.SELM[(size_t)(b * 2 + g) * SEQ + t];
        const int own = t >> 6;
        AttnState ss; ss.m = NEGF; ss.l = 0.f; ss.o = 0.f;
        for (int j = 0; j <= own; ++j) if ((mask >> j) & 1u) {
            const float* base = p.U + (size_t)(b * SEQ + j * 64) * ODD_IN + g * 64;
            attn_block(ss, qs, ps, base + 768, base + 896, j * 64, t, slope, (j * 64 + lane) <= t);
        }
        AttnState sw; sw.m = NEGF; sw.l = 0.f; sw.o = 0.f;
        const int jb0 = (t >= 511) ? ((t - 511) >> 6) : 0;
        for (int j = jb0; j <= own; ++j) {
            const float* base = p.U + (size_t)(b * SEQ + j * 64) * ODD_IN + g * 64;
            const int s = j * 64 + lane;
            attn_block(sw, qs, ps, base + 1024, base + 1152, j * 64, t, slope, (s <= t) && (t - s < 512));
        }
        const float os = ss.o / fmaxf(ss.l, 1e-30f), ow = sw.o / fmaxf(sw.l, 1e-30f);
        const float oc = p.OC[(size_t)n * 512 + hd * 64 + lane];
        const float* gp = p.U + (size_t)n * ODD_IN + 1280 + hd * 3;
        const float y = sigmoidf_(gp[0]) * oc + sigmoidf_(gp[1]) * os + sigmoidf_(gp[2]) * ow;
        p.MIX[(size_t)n * DM + hd * 64 + lane] = (bf16_t)f2bf(y);
    }
}
__device__ __forceinline__ void phase_moba_attn(char* lds, int bid, int nb, const P& p) {
    const int tid = tidx(), lane = tid & 63, wid = tid >> 6;
    float* qs = (float*)lds + wid * 128; float* ps = qs + 64;
    for (int it = bid * 4 + wid; it < NTOK * 8; it += nb * 4) {
        const int hd = it & 7; const int n = it >> 3; const int b = n >> 11, t = n & (SEQ - 1);
        const float slope = exp2f(-((float)hd + 1.0f));
        const float qv = p.U[(size_t)n * ODD_IN + 1304 + hd * 64 + lane];
        __builtin_amdgcn_wave_barrier();
        qs[lane] = qv;
        __builtin_amdgcn_wave_barrier();
        const int ob = t >> 8;
        float gate[8];
#pragma unroll
        for (int j = 0; j < 8; ++j) gate[j] = (j < ob) ? wave_sum(qv * p.KM[((size_t)(b * 8 + hd) * 8 + j) * 64 + lane]) : NEGF;
        unsigned selm = 0;
#pragma unroll
        for (int j = 0; j < 8; ++j) {
            int rank = 0;
#pragma unroll
            for (int j2 = 0; j2 < 8; ++j2) rank += (gate[j2] > gate[j] || (gate[j2] == gate[j] && j2 < j)) ? 1 : 0;
            if (j < ob && rank < 3) selm |= 1u << j;
        }
        AttnState st; st.m = NEGF; st.l = 0.f; st.o = 0.f;
        for (int j = 0; j < ob; ++j) if ((selm >> j) & 1u) {
            for (int sb = 0; sb < 4; ++sb) {
                const float* base = p.U + (size_t)(b * SEQ + j * 256 + sb * 64) * ODD_IN + hd * 64;
                attn_block(st, qs, ps, base + 1816, base + 2328, j * 256 + sb * 64, t, slope, true);
            }
        }
        for (int sb = 0; sb <= ((t & 255) >> 6); ++sb) {
            const float* base = p.U + (size_t)(b * SEQ + ob * 256 + sb * 64) * ODD_IN + hd * 64;
            attn_block(st, qs, ps, base + 1816, base + 2328, ob * 256 + sb * 64, t, slope, (ob * 256 + sb * 64 + lane) <= t);
        }
        p.MIX[(size_t)n * DM + 512 + hd * 64 + lane] = (bf16_t)f2bf(st.o / fmaxf(st.l, 1e-30f));
    }
}


__device__ __forceinline__ void gemm_t_unit(const bf16_t* Wt, int wrow0, const bf16_t* X, int tok0, bf16_t* dst, int ncol, int col0) {
    const int tid = tidx(), lane = tid & 63, wid = tid >> 6, wr = wid >> 1, wc = wid & 1, fr = lane & 15, fq = lane >> 4;
    Dma3A al; al.set_dense(Wt, wrow0, DM); Dma3B bl; bl.set(X, X, tok0, DM, 1 << 30);
    f32x4 acc[32];
    gemm_core4(al, bl, DM / 32, acc);
#pragma unroll
    for (int i = 0; i < 8; ++i)
#pragma unroll
        for (int n = 0; n < 4; ++n) {
            const int vc = col0 + wr * 128 + i * 16 + fr, r0 = tok0 + wc * 64 + n * 16 + fq * 4;
            const int b = r0 >> 11, t0 = r0 & (SEQ - 1);
            const f32x4 a = acc[i * 4 + n];
            u32x2 w; w.x = pack2(a[0], a[1]); w.y = pack2(a[2], a[3]);
            *(u32x2*)(dst + ((size_t)(b * ncol + vc)) * SEQ + t0) = w;
        }
}
__device__ __forceinline__ void phase_inproj0(char* lds, int bid, int nb, const P& p) {
    const int ntn = 20, nk = DM / 32;
    const int tid = tidx(), lane = tid & 63, wid = tid >> 6, wr = wid >> 1, wc = wid & 1, fr = lane & 15, fq = lane >> 4;
    for (int i = bid * 256 + tid; i < 2 * 8 * 64 * 64; i += nb * 256) {
        const int which = i >> 15, e = i & 32767, h = e >> 12, j = (e >> 6) & 63, ii = e & 63;
        const float v = (which ? p.wx : p.wa)[(h * 64 + ii) * 64 + j];
        (which ? p.WXT : p.WAT)[e] = (bf16_t)f2bf(v);
    }
    for (int jj = 0;; ++jj) {
        int tm, tn; if (!dense_unit3(bid, nb, jj, ntn, tm, tn)) break;
        Dma3A al; al.set_dense(p.XIb, tm * 256, DM); Dma3B bl; bl.set(p.WIN0, p.WIN0, tn * 128, DM, 1 << 30);
        f32x4 acc[32];
        gemm_core4(al, bl, nk, acc);
#pragma unroll
        for (int i = 0; i < 8; ++i)
#pragma unroll
            for (int n = 0; n < 4; ++n) {
                const int row = tm * 256 + wr * 128 + i * 16 + fr, col = tn * 128 + wc * 64 + n * 16 + fq * 4;
                const f32x4 a = acc[i * 4 + n];
                u32x2 w; w.x = pack2(a[0], a[1]); w.y = pack2(a[2], a[3]);
                *(u32x2*)(p.UB0 + (size_t)row * 2560 + col) = w;
            }
    }
    for (int u = bid; u < 2 * 128; u += nb) { const int pn = u & 1, tt = u >> 1; gemm_t_unit(p.WIN0, 2560 + pn * 256, p.XIb, tt * 128, p.VHt, 512, pn * 256); }
}

__device__ __forceinline__ int lds_off128(int r, int c) {
    const int st = (r >> 4) * 4 + (c >> 5), ob = (r & 15) * 64 + (c & 31) * 2;
    return st * 1024 + (ob ^ (((ob >> 9) & 1) << 5));
}
__device__ __forceinline__ float softplusf_(float x) { return fmaxf(x, 0.f) + log1pf(__expf(-fabsf(x))); }

#define LRU1_LDS (4 * 8192)
__device__ __forceinline__ void lru1_unit(char* lds, const P& p, int b, int ck) {
    const int tid = tidx(), lane = tid & 63, w = tid >> 6, fr = lane & 15, fg = lane >> 4;
    char* xt = lds + w * 8192;
    const size_t n0 = (size_t)b * SEQ + ck * 64;
    __syncthreads();
    for (int hh = 0; hh < 2; ++hh) {
        const int h = w * 2 + hh, c = h * 64 + lane;
        const float cw0 = p.conv_w[c], cw1 = p.conv_w[512 + c], cw2 = p.conv_w[1024 + c], cw3 = p.conv_w[1536 + c], cb = p.conv_b[c];
        float xm3 = 0.f, xm2 = 0.f, xm1 = 0.f;
        if (ck > 0) { xm3 = bf2f(p.UB0[(n0 - 3) * 2560 + c]); xm2 = bf2f(p.UB0[(n0 - 2) * 2560 + c]); xm1 = bf2f(p.UB0[(n0 - 1) * 2560 + c]); }
        __builtin_amdgcn_wave_barrier();
        for (int t16 = 0; t16 < 64; t16 += 16) {
            bf16_t raw[16];
#pragma unroll
            for (int i = 0; i < 16; ++i) raw[i] = p.UB0[(n0 + t16 + i) * 2560 + c];
#pragma unroll
            for (int i = 0; i < 16; ++i) {
                const float x = bf2f(raw[i]);
                const float xc = cb + cw0 * xm3 + cw1 * xm2 + cw2 * xm1 + cw3 * x;
                xm3 = xm2; xm2 = xm1; xm1 = x;
                *(bf16_t*)(xt + lds_off(t16 + i, lane & ~7) + (lane & 7) * 2) = (bf16_t)f2bf(xc);
            }
        }
        __builtin_amdgcn_wave_barrier();
        for (int jt = 0; jt < 4; ++jt) {
            const int cj = h * 64 + jt * 16 + fr;
            bf16x8 wra[2], wri[2];
#pragma unroll
            for (int ks = 0; ks < 2; ++ks) {
                wra[ks] = *(const bf16x8*)(p.WAT + (size_t)(h * 64 + jt * 16 + fr) * 64 + ks * 32 + fg * 8);
                wri[ks] = *(const bf16x8*)(p.WXT + (size_t)(h * 64 + jt * 16 + fr) * 64 + ks * 32 + fg * 8);
            }
            const float bav = p.ba[cj], bxv = p.bx[cj], sp = softplusf_(-p.lam[cj]);
            float mA = 1.f, mB = 0.f;
#pragma unroll
            for (int tt = 0; tt < 4; ++tt) {
                const bf16x8 a0 = *(const bf16x8*)(xt + lds_off(tt * 16 + fr, fg * 8)), a1 = *(const bf16x8*)(xt + lds_off(tt * 16 + fr, 32 + fg * 8));
                f32x4 ar = __builtin_amdgcn_mfma_f32_16x16x32_bf16(a0, wra[0], (f32x4){0.f, 0.f, 0.f, 0.f}, 0, 0, 0);
                ar = __builtin_amdgcn_mfma_f32_16x16x32_bf16(a1, wra[1], ar, 0, 0, 0);
                f32x4 ai = __builtin_amdgcn_mfma_f32_16x16x32_bf16(a0, wri[0], (f32x4){0.f, 0.f, 0.f, 0.f}, 0, 0, 0);
                ai = __builtin_amdgcn_mfma_f32_16x16x32_bf16(a1, wri[1], ai, 0, 0, 0);
                float sA = 1.f, sB = 0.f;
#pragma unroll
                for (int r = 0; r < 4; ++r) {
                    const int t = tt * 16 + fg * 4 + r;
                    const float rg = sigmoidf_(ar[r] + bav), ig = sigmoidf_(ai[r] + bxv);
                    const float log_a = -8.0f * rg * sp;
                    const float a = __expf(log_a);
                    const float mult = (ck == 0 && t == 0) ? 1.0f : sqrtf(fmaxf(1.0f - a * a, 0.f));
                    const int jj = jt * 16 + fr;
                    const float xcv = bf2f(*(const bf16_t*)(xt + lds_off(t, jj & ~7) + (jj & 7) * 2));
                    const float bt = mult * ig * xcv;
                    p.LA[(n0 + t) * 512 + cj] = a; p.LB[(n0 + t) * 512 + cj] = bt;
                    sB = a * sB + bt; sA = a * sA;
                }
                float tA = 1.f, tB = 0.f;
#pragma unroll
                for (int g2 = 0; g2 < 4; ++g2) {
                    const float oA = __shfl(sA, g2 * 16 + fr), oB = __shfl(sB, g2 * 16 + fr);
                    tB = oA * tB + oB; tA = oA * tA;
                }
                mB = tA * mB + tB; mA = tA * mA;
            }
            if (fg == 0) { p.CSA[((size_t)b * 32 + ck) * 512 + cj] = mA; p.CSB[((size_t)b * 32 + ck) * 512 + cj] = mB; }
        }
        __builtin_amdgcn_wave_barrier();
    }
}
__device__ __forceinline__ void lru2_unit(const P& p, int b, int ck) {
    const int tid = tidx();
    const size_t n0 = (size_t)b * SEQ + ck * 64;
#pragma unroll
    for (int cc = 0; cc < 2; ++cc) {
        const int c = tid + 256 * cc;
        float h = 0.f;
        for (int c2 = 0; c2 < ck; ++c2) h = p.CSA[((size_t)b * 32 + c2) * 512 + c] * h + p.CSB[((size_t)b * 32 + c2) * 512 + c];
        for (int t8 = 0; t8 < 64; t8 += 8) {
            float la[8], lb[8], gb[8];
#pragma unroll
            for (int i = 0; i < 8; ++i) { la[i] = p.LA[(n0 + t8 + i) * 512 + c]; lb[i] = p.LB[(n0 + t8 + i) * 512 + c]; gb[i] = bf2f(p.UB0[(n0 + t8 + i) * 2560 + 512 + c]); }
#pragma unroll
            for (int i = 0; i < 8; ++i) { h = la[i] * h + lb[i]; p.MIX[(n0 + t8 + i) * DM + c] = (bf16_t)f2bf(h * gelu_tanh(gb[i])); }
        }
    }
}

#define HG1_LDS (2 * 16384)
__device__ __forceinline__ float hg_lb(const P& p, int ch) {
    const float l0 = p.hg_lb[ch], l1 = p.hg_lb[512 + ch], l2 = p.hg_lb[1024 + ch]; const float mx = fmaxf(l0, fmaxf(l1, l2));
    const float e0 = __expf(l0 - mx), e1 = __expf(l1 - mx), e2 = __expf(l2 - mx); return e0 / (e0 + e1 + e2);
}
__device__ __forceinline__ void hg1_unit(char* lds, const P& p, int b, int h, int ck) {
    const int tid = tidx(), lane = tid & 63, w = tid >> 6, fr = lane & 15, fg = lane >> 4;
    char* kh = lds;
    char* vt = lds + 16384;
    const size_t n0 = (size_t)b * SEQ + ck * 64;
    const int bhc = (b * 4 + h) * 32 + ck;
    __syncthreads();
    if (tid < 128) {
        const int k = tid, ch = h * 128 + k;
        const float lbv = hg_lb(p, ch);
        float cl = 0.f;
        for (int t16 = 0; t16 < 64; t16 += 16) {
            bf16_t raw[16];
#pragma unroll
            for (int i = 0; i < 16; ++i) raw[i] = p.UB0[(n0 + t16 + i) * 2560 + 1536 + ch];
#pragma unroll
            for (int i = 0; i < 16; ++i) { const float f = lbv + (1.0f - lbv) * sigmoidf_(bf2f(raw[i])); cl += __logf(f); }
        }
        p.DV[(size_t)bhc * 128 + k] = __expf(cl);
        float cum = 0.f;
        for (int t8 = 0; t8 < 64; t8 += 8) {
            float kv[8]; bf16_t raw[8];
#pragma unroll
            for (int i = 0; i < 8; ++i) raw[i] = p.UB0[(n0 + t8 + i) * 2560 + 1536 + ch];
#pragma unroll
            for (int i = 0; i < 8; ++i) { const float f = lbv + (1.0f - lbv) * sigmoidf_(bf2f(raw[i])); cum += __logf(f); kv[i] = (1.0f - f) * __expf(cl - cum); }
            u32x4 wv; wv.x = pack2(kv[0], kv[1]); wv.y = pack2(kv[2], kv[3]); wv.z = pack2(kv[4], kv[5]); wv.w = pack2(kv[6], kv[7]);
            *(u32x4*)(kh + lds_off(k, t8)) = wv;
        }
    } else {
        const int q = tid - 128;
#pragma unroll
        for (int i = 0; i < 8; ++i) { const int pc = q + 128 * i, v = pc >> 3, c8 = pc & 7;
            *(u32x4*)(vt + lds_off(v, c8 * 8)) = *(const u32x4*)(p.VHt + ((size_t)(b * 512 + h * 128 + v)) * SEQ + ck * 64 + c8 * 8); }
    }
    __syncthreads();
    bf16_t* ut = p.UT + (size_t)bhc * 16384;
#pragma unroll
    for (int kk = 0; kk < 2; ++kk) {
        const int kt = w * 2 + kk;
        const bf16x8 a0 = *(const bf16x8*)(kh + lds_off(kt * 16 + fr, fg * 8)), a1 = *(const bf16x8*)(kh + lds_off(kt * 16 + fr, 32 + fg * 8));
#pragma unroll
        for (int v8 = 0; v8 < 8; ++v8) {
            const bf16x8 b0 = *(const bf16x8*)(vt + lds_off(v8 * 16 + fr, fg * 8)), b1 = *(const bf16x8*)(vt + lds_off(v8 * 16 + fr, 32 + fg * 8));
            f32x4 acc = __builtin_amdgcn_mfma_f32_16x16x32_bf16(a0, b0, (f32x4){0.f, 0.f, 0.f, 0.f}, 0, 0, 0);
            acc = __builtin_amdgcn_mfma_f32_16x16x32_bf16(a1, b1, acc, 0, 0, 0);
            u32x2 wv; wv.x = pack2(acc[0], acc[1]); wv.y = pack2(acc[2], acc[3]);
            *(u32x2*)(ut + (size_t)(v8 * 16 + fr) * 128 + kt * 16 + fg * 4) = wv;
        }
    }
}
__device__ __forceinline__ void phase_hg2(int bid, int nb, const P& p) {
    for (int it = bid * 256 + tidx(); it < 32 * 4096; it += nb * 256) {
        const int bh = it >> 12, e4 = (it & 4095) * 4, k4 = e4 & 127;
        float S0 = 0.f, S1 = 0.f, S2 = 0.f, S3 = 0.f;
        for (int c8 = 0; c8 < 32; c8 += 8) {
            u32x2 uv[8]; f32x4 dv[8];
#pragma unroll
            for (int i = 0; i < 8; ++i) { uv[i] = *(const u32x2*)(p.UT + ((size_t)(bh * 32 + c8 + i)) * 16384 + e4); dv[i] = *(const f32x4*)(p.DV + (size_t)(bh * 32 + c8 + i) * 128 + k4); }
#pragma unroll
            for (int i = 0; i < 8; ++i) {
                u32x2 wv; wv.x = pack2(S0, S1); wv.y = pack2(S2, S3);
                *(u32x2*)(p.SP + ((size_t)(bh * 32 + c8 + i)) * 16384 + e4) = wv;
                S0 = dv[i][0] * S0 + bf2f(uv[i].x & 0xffffu); S1 = dv[i][1] * S1 + bf2f(uv[i].x >> 16);
                S2 = dv[i][2] * S2 + bf2f(uv[i].y & 0xffffu); S3 = dv[i][3] * S3 + bf2f(uv[i].y >> 16);
            }
        }
    }
}
#define HG3_QP 0
#define HG3_KP 40960
#define HG3_VT (40960 + 16384)
#define HG3_LDS (40960 + 16384 + 128 * 144)
__device__ __forceinline__ int hg3_qp_base(int j) { return j == 0 ? 0 : (j == 1 ? 16384 : (j == 2 ? 28672 : 36864)); }
__device__ __forceinline__ void hg3_unit(char* lds, const P& p, int b, int h, int ck) {
    const int tid = tidx(), lane = tid & 63, w = tid >> 6, fr = lane & 15, fg = lane >> 4;
    char* qp = lds + HG3_QP; char* kp = lds + HG3_KP; char* vt = lds + HG3_VT;
    const size_t n0 = (size_t)b * SEQ + ck * 64;
    const int bhc = (b * 4 + h) * 32 + ck;
    __syncthreads();
    if (tid < 128) {
        const int k = tid, ch = h * 128 + k;
        const float lbv = hg_lb(p, ch);
        const int ke = (k & 7) * 2, k8 = k & ~7;
        float cum = 0.f, r1 = 0.f, r2 = 0.f, r3 = 0.f;
#pragma unroll
        for (int i = 0; i < 4; ++i) {
            bf16_t rq[16], rf[16];
#pragma unroll
            for (int tt = 0; tt < 16; ++tt) { rq[tt] = p.UB0[(n0 + i * 16 + tt) * 2560 + 1024 + ch]; rf[tt] = p.UB0[(n0 + i * 16 + tt) * 2560 + 1536 + ch]; }
#pragma unroll
            for (int tt = 0; tt < 16; ++tt) {
                const int t = i * 16 + tt;
                const float qv = siluf_(bf2f(rq[tt]));
                const float f = lbv + (1.0f - lbv) * sigmoidf_(bf2f(rf[tt]));
                cum += __logf(f);
                const float ri = (i == 0) ? 0.f : (i == 1 ? r1 : (i == 2 ? r2 : r3));
                *(bf16_t*)(kp + lds_off128(t, k8) + ke) = (bf16_t)f2bf((1.0f - f) * __expf(fminf(ri - cum, 80.0f)));
                *(bf16_t*)(qp + hg3_qp_base(0) + lds_off128(t, k8) + ke) = (bf16_t)f2bf(qv * __expf(cum));
                if (i >= 1) *(bf16_t*)(qp + hg3_qp_base(1) + lds_off128(t - 16, k8) + ke) = (bf16_t)f2bf(qv * __expf(cum - r1));
                if (i >= 2) *(bf16_t*)(qp + hg3_qp_base(2) + lds_off128(t - 32, k8) + ke) = (bf16_t)f2bf(qv * __expf(cum - r2));
                if (i >= 3) *(bf16_t*)(qp + hg3_qp_base(3) + lds_off128(t - 48, k8) + ke) = (bf16_t)f2bf(qv * __expf(cum - r3));
            }
            if (i == 0) r1 = cum; if (i == 1) r2 = cum; if (i == 2) r3 = cum;
        }
    } else {
        const int q = tid - 128;
#pragma unroll
        for (int i = 0; i < 8; ++i) { const int pc = q + 128 * i, v = pc >> 3, c8 = pc & 7;
            *(u32x4*)(vt + v * 144 + c8 * 16) = *(const u32x4*)(p.VHt + ((size_t)(b * 512 + h * 128 + v)) * SEQ + ck * 64 + c8 * 8); }
    }
    __syncthreads();
    f32x4 acc[8];
#pragma unroll
    for (int v8 = 0; v8 < 8; ++v8) acc[v8] = (f32x4){0.f, 0.f, 0.f, 0.f};
    if (ck > 0) {
        const bf16_t* sp = p.SP + (size_t)bhc * 16384;
#pragma unroll
        for (int ks = 0; ks < 4; ++ks) {
            const bf16x8 bq = *(const bf16x8*)(qp + hg3_qp_base(0) + lds_off128(w * 16 + fr, ks * 32 + fg * 8));
#pragma unroll
            for (int v8 = 0; v8 < 8; ++v8) {
                const bf16x8 as = *(const bf16x8*)(sp + (size_t)(v8 * 16 + fr) * 128 + ks * 32 + fg * 8);
                acc[v8] = __builtin_amdgcn_mfma_f32_16x16x32_bf16(as, bq, acc[v8], 0, 0, 0);
            }
        }
    }
#pragma unroll
    for (int jp = 0; jp < 2; ++jp) {
        if (2 * jp > w) continue;
        f32x4 at[2];
#pragma unroll
        for (int jj = 0; jj < 2; ++jj) {
            const int j = 2 * jp + jj;
            at[jj] = (f32x4){0.f, 0.f, 0.f, 0.f};
            if (j <= w) {
#pragma unroll
                for (int ks = 0; ks < 4; ++ks) {
                    const bf16x8 ak = *(const bf16x8*)(kp + lds_off128(j * 16 + fr, ks * 32 + fg * 8));
                    const bf16x8 bq = *(const bf16x8*)(qp + hg3_qp_base(j) + lds_off128((w - j) * 16 + fr, ks * 32 + fg * 8));
                    at[jj] = __builtin_amdgcn_mfma_f32_16x16x32_bf16(ak, bq, at[jj], 0, 0, 0);
                }
                if (j == w) {
#pragma unroll
                    for (int r = 0; r < 4; ++r) at[jj][r] = (fg * 4 + r <= fr) ? at[jj][r] : 0.f;
                }
            }
        }
        u32x4 pw; pw.x = pack2(at[0][0], at[0][1]); pw.y = pack2(at[0][2], at[0][3]); pw.z = pack2(at[1][0], at[1][1]); pw.w = pack2(at[1][2], at[1][3]);
        const bf16x8 pf = __builtin_bit_cast(bf16x8, pw);
#pragma unroll
        for (int v8 = 0; v8 < 8; ++v8) {
            const char* vb = vt + (v8 * 16 + fr) * 144 + (jp * 32 + fg * 4) * 2;
            const u32x2 v0 = *(const u32x2*)vb, v1 = *(const u32x2*)(vb + 32);
            u32x4 vv; vv.x = v0.x; vv.y = v0.y; vv.z = v1.x; vv.w = v1.y;
            acc[v8] = __builtin_amdgcn_mfma_f32_16x16x32_bf16(__builtin_bit_cast(bf16x8, vv), pf, acc[v8], 0, 0, 0);
        }
    }
    float ss = 0.f;
#pragma unroll
    for (int v8 = 0; v8 < 8; ++v8)
#pragma unroll
        for (int r = 0; r < 4; ++r) ss += acc[v8][r] * acc[v8][r];
    ss += __shfl_xor(ss, 16); ss += __shfl_xor(ss, 32);
    const float rs = rsqrtf(ss * (1.0f / 128.0f) + 1e-6f);
    const size_t n = n0 + w * 16 + fr;
#pragma unroll
    for (int v8 = 0; v8 < 8; ++v8) {
        const int vcol = h * 128 + v8 * 16 + fg * 4;
        const u32x2 gv = *(const u32x2*)(p.UB0 + n * 2560 + 2048 + vcol);
        const f32x4 ng = *(const f32x4*)(p.hg_ng + vcol);
        const float y0 = acc[v8][0] * rs * ng[0] * sigmoidf_(bf2f(gv.x & 0xffffu)), y1 = acc[v8][1] * rs * ng[1] * sigmoidf_(bf2f(gv.x >> 16));
        const float y2 = acc[v8][2] * rs * ng[2] * sigmoidf_(bf2f(gv.y & 0xffffu)), y3 = acc[v8][3] * rs * ng[3] * sigmoidf_(bf2f(gv.y >> 16));
        u32x2 wv; wv.x = pack2(y0, y1); wv.y = pack2(y2, y3);
        *(u32x2*)(p.MIX + n * DM + 512 + vcol) = wv;
    }
}
__device__ __forceinline__ void phase_mix0_a(char* lds, int bid, int nb, const P& p) {
    for (int u = bid; u < 256 + 1024; u += nb) {
        if (u < 256) lru1_unit(lds, p, u >> 5, u & 31);
        else { const int v = u - 256; hg1_unit(lds, p, v >> 7, (v >> 5) & 3, v & 31); }
    }
    __syncthreads();
}
__device__ __forceinline__ void phase_mix0_c(char* lds, int bid, int nb, const P& p) {
    for (int u = bid; u < 1024 + 256; u += nb) {
        if (u < 1024) hg3_unit(lds, p, u >> 7, (u >> 5) & 3, u & 31);
        else { const int v = u - 1024; lru2_unit(p, v >> 5, v & 31); }
    }
    __syncthreads();
}

#ifndef KEEP_U
#define KEEP_U 0
#endif
__device__ __forceinline__ int vcol_actual(int v) { return v < 1280 ? v : (v < 2816 ? v + 24 : v - 1536); }
__device__ __forceinline__ void phase_inproj1(char* lds, int bid, int nb, const P& p) {
    const int ntn = 17, nk = DM / 32;
    const int tid = tidx(), lane = tid & 63, wid = tid >> 6, wr = wid >> 1, wc = wid & 1, fr = lane & 15, fq = lane >> 4;
    for (int i = bid * 256 + tid; i < 2 * 2048 * 128 / 4; i += nb * 256) *(f32x4*)(p.HID + (size_t)i * 4) = (f32x4){0.f, 0.f, 0.f, 0.f};
    for (int jj = 0;; ++jj) {
        int tm, tn; if (!dense_unit3(bid, nb, jj, ntn, tm, tn)) break;
        Dma3A al; al.set_dense(p.XBb, tm * 256, DM); Dma3B bl; bl.set(p.WIN1, p.WIN1, tn * 128, DM, 1 << 30);
        f32x4 acc[32];
        gemm_core4(al, bl, nk, acc);
#pragma unroll
        for (int i = 0; i < 8; ++i)
#pragma unroll
            for (int n = 0; n < 4; ++n) {
                const int row = tm * 256 + wr * 128 + i * 16 + fr, vc = tn * 128 + wc * 64 + n * 16 + fq * 4;
                const f32x4 a = acc[i * 4 + n];
                u32x2 w; w.x = pack2(a[0], a[1]); w.y = pack2(a[2], a[3]);
                if (tn < 4) *(u32x2*)(p.Qb + (size_t)row * 512 + vc) = w;
                else if (tn < 6) *(f32x4*)(p.KCV + (size_t)row * 256 + vc - 512) = a;
                else if (tn == 6) *(u32x2*)(p.KS + (size_t)row * 128 + vc - 768) = w;
                else if (tn == 7) *(u32x2*)(p.KW + (size_t)row * 128 + vc - 896) = w;
                else if (tn < 12) *(u32x2*)(p.MQ + (size_t)row * 512 + vc - 1024) = w;
                else if (tn < 16) *(u32x2*)(p.MK + (size_t)row * 512 + vc - 1536) = w;
                else if (vc < 2072) *(f32x4*)(p.GATES + (size_t)row * 24 + vc - 2048) = a;
            }
    }
    for (int u = bid; u < 3 * 128; u += nb) {
        const int pn = u % 3, tt = u / 3;
        if (pn == 0) {
            const int wrr = tidx() >> 7;
            gemm_t_unit(p.WIN1, 2176, p.XBb, tt * 128, wrr ? p.VWt - (size_t)128 * SEQ : p.VSt, 128, 0);
        } else gemm_t_unit(p.WIN1, 2432 + (pn - 1) * 256, p.XBb, tt * 128, p.MVt, 512, (pn - 1) * 256);
    }
}
__device__ __forceinline__ void phase_moba_gate(int bid, int nb, const P& p) {
    const int lane = tidx() & 63, wid = tidx() >> 6;
    for (int it = bid * 4 + wid; it < NTOK * 8; it += nb * 4) {
        const int hd = it & 7; const int n = it >> 3; const int b = n >> 11, t = n & (SEQ - 1);
        const float qv = bf2f(p.MQ[(size_t)n * 512 + hd * 64 + lane]);
        const int ob = t >> 8;
        float gate[8];
#pragma unroll
        for (int j = 0; j < 8; ++j) gate[j] = (j < ob) ? wave_sum(qv * p.KM[((size_t)(b * 8 + hd) * 8 + j) * 64 + lane]) : NEGF;
        unsigned selm = 0;
#pragma unroll
        for (int j = 0; j < 8; ++j) {
            int rank = 0;
#pragma unroll
            for (int j2 = 0; j2 < 8; ++j2) rank += (gate[j2] > gate[j] || (gate[j2] == gate[j] && j2 < j)) ? 1 : 0;
            if (j < ob && rank < 3) selm |= 1u << j;
        }
        if (lane == 0) p.MSEL[(size_t)(b * 8 + hd) * SEQ + t] = selm;
    }
}

#define ATT_K_BYTES 8192
#define ATT_V_STRIDE 144
#define ATT_TILE_BYTES (ATT_K_BYTES + 64 * ATT_V_STRIDE)
#define ATT_ORDER_OFF ATT_TILE_BYTES
#define ATT_RED_OFF (ATT_ORDER_OFF + 8192)
struct TileRegs { u32x4 k[2], v[2]; };
__device__ __forceinline__ void att_load_tile(TileRegs& R, const bf16_t* Kg, int ldk, const bf16_t* Vg) {
#pragma unroll
    for (int i = 0; i < 2; ++i) { const int pc = tidx() + 256 * i, row = pc >> 3, ch = pc & 7;
        R.k[i] = *(const u32x4*)(Kg + (size_t)row * ldk + ch * 8); R.v[i] = *(const u32x4*)(Vg + (size_t)row * SEQ + ch * 8); }
}
__device__ __forceinline__ void att_store_tile(const TileRegs& R, char* lds) {
#pragma unroll
    for (int i = 0; i < 2; ++i) { const int pc = tidx() + 256 * i, row = pc >> 3, ch = pc & 7;
        *(u32x4*)(lds + lds_off(row, ch * 8)) = R.k[i]; *(u32x4*)(lds + ATT_K_BYTES + row * ATT_V_STRIDE + ch * 16) = R.v[i]; }
}
struct AttState { f32x4 O[4][2]; float m[2], l[2]; };
__device__ __forceinline__ void att_reset(AttState& S) {
#pragma unroll
    for (int q = 0; q < 2; ++q) { S.m[q] = NEGF; S.l[q] = 0.f;
#pragma unroll
        for (int d = 0; d < 4; ++d) S.O[d][q] = (f32x4){0.f, 0.f, 0.f, 0.f}; }
}
template <bool MASKED>
__device__ __forceinline__ void att_step(const char* lds, const bf16x8 (&qf)[2][2], AttState& S, float c1, float slope2,
                                         int s0, int tq0, unsigned selbits  , int winlimit) {
    const int lane = tidx() & 63, fr = lane & 15, fg = lane >> 4;
    const char* ldsV = lds + ATT_K_BYTES;
    const float offbase = slope2 * (float)s0;
    const float cbase = slope2 * (float)(fg * 4);
    f32x4 s[2][4];
#pragma unroll
    for (int kt = 0; kt < 4; ++kt) {
        const bf16x8 k0 = *(const bf16x8*)(lds + lds_off(kt * 16 + fr, fg * 8)), k1 = *(const bf16x8*)(lds + lds_off(kt * 16 + fr, 32 + fg * 8));
#pragma unroll
        for (int qt = 0; qt < 2; ++qt) {
            s[qt][kt] = __builtin_amdgcn_mfma_f32_16x16x32_bf16(k0, qf[qt][0], (f32x4){0.f, 0.f, 0.f, 0.f}, 0, 0, 0);
            s[qt][kt] = __builtin_amdgcn_mfma_f32_16x16x32_bf16(k1, qf[qt][1], s[qt][kt], 0, 0, 0);
        }
    }
    __builtin_amdgcn_sched_barrier(0);
    u32x4 pf[2][2];
#pragma unroll
    for (int qt = 0; qt < 2; ++qt) {
        const int tq = tq0 + qt * 16 + fr;
        const float off = ((selbits >> qt) & 1u) ? (offbase - slope2 * (float)tq) : -INFINITY;
        float mx = -INFINITY;
#pragma unroll
        for (int kt = 0; kt < 4; ++kt)
#pragma unroll
            for (int r = 0; r < 4; ++r) {
                float y = fmaf(s[qt][kt][r], c1, fmaf(slope2, (float)(kt * 16 + r), cbase));
                if (MASKED) { const int key = s0 + kt * 16 + fg * 4 + r; const bool ok = (key <= tq) && (tq - key < winlimit); y = ok ? y : -INFINITY; }
                s[qt][kt][r] = y; mx = fmaxf(mx, y);
            }
        mx = fmaxf(mx, __shfl_xor(mx, 16)); mx = fmaxf(mx, __shfl_xor(mx, 32));
        const float mnew = fmaxf(S.m[qt], mx + off);
        const float alpha = __builtin_amdgcn_exp2f(S.m[qt] - mnew);
        S.m[qt] = mnew;
        const float thr = mnew - off;
        float ls = 0.f;
#pragma unroll
        for (int kt = 0; kt < 4; ++kt)
#pragma unroll
            for (int r = 0; r < 4; ++r) { const float pr = __builtin_amdgcn_exp2f(s[qt][kt][r] - thr); s[qt][kt][r] = pr; ls += pr; }
        S.l[qt] = S.l[qt] * alpha + ls;
#pragma unroll
        for (int dt = 0; dt < 4; ++dt) S.O[dt][qt] *= alpha;
#pragma unroll
        for (int kk = 0; kk < 2; ++kk) {
            pf[qt][kk].x = pack2(s[qt][2 * kk][0], s[qt][2 * kk][1]); pf[qt][kk].y = pack2(s[qt][2 * kk][2], s[qt][2 * kk][3]);
            pf[qt][kk].z = pack2(s[qt][2 * kk + 1][0], s[qt][2 * kk + 1][1]); pf[qt][kk].w = pack2(s[qt][2 * kk + 1][2], s[qt][2 * kk + 1][3]);
        }
    }
    __builtin_amdgcn_sched_barrier(0);
#pragma unroll
    for (int kk = 0; kk < 2; ++kk)
#pragma unroll
        for (int dt = 0; dt < 4; ++dt) {
            const char* vb = ldsV + (dt * 16 + fr) * ATT_V_STRIDE + (kk * 32 + fg * 4) * 2;
            const u32x2 v0 = *(const u32x2*)vb, v1 = *(const u32x2*)(vb + 32);
            u32x4 vv; vv.x = v0.x; vv.y = v0.y; vv.z = v1.x; vv.w = v1.y;
            const bf16x8 vf = __builtin_bit_cast(bf16x8, vv);
#pragma unroll
            for (int qt = 0; qt < 2; ++qt) S.O[dt][qt] = __builtin_amdgcn_mfma_f32_16x16x32_bf16(vf, __builtin_bit_cast(bf16x8, pf[qt][kk]), S.O[dt][qt], 0, 0, 0);
        }
    __builtin_amdgcn_sched_barrier(0);
}
__device__ __forceinline__ unsigned wave_or(unsigned v) {
#pragma unroll
    for (int o = 32; o >= 1; o >>= 1) v |= (unsigned)__shfl_xor((int)v, o);
    return v;
}
__device__ __forceinline__ void att_nsa_unit(char* lds, const P& p, int b, int g, int qtile) {
    const int tid = tidx(), lane = tid & 63, w = tid >> 6, fr = lane & 15, fg = lane >> 4;
    const int hd = g * 4 + w, t0 = qtile * 32, own = qtile >> 1;
    const float slope2 = exp2f(-((float)hd + 0.5f)) * LOG2E, c1 = 0.125f * LOG2E;
    bf16x8 qf[2][2];
#pragma unroll
    for (int qt = 0; qt < 2; ++qt)
#pragma unroll
        for (int ks = 0; ks < 2; ++ks) qf[qt][ks] = *(const bf16x8*)(p.Qb + (size_t)(b * SEQ + t0 + qt * 16 + fr) * 512 + hd * 64 + ks * 32 + fg * 8);
    unsigned selw[2];
#pragma unroll
    for (int qt = 0; qt < 2; ++qt) selw[qt] = p.SELM[(size_t)(b * 2 + g) * SEQ + t0 + qt * 16 + fr];
    const unsigned um = wave_or(selw[0] | selw[1]);
    AttState S; att_reset(S);
    unsigned rem = um & ((own >= 31) ? 0xffffffffu : ((2u << own) - 1u));
    int wj = own >= 8 ? own - 8 : 0;
    int cbr, cj, nbr = 0, nj = 0; bool has = true, hasn;
    if (rem) { cj = __ffs(rem) - 1; rem &= rem - 1; cbr = 0; } else { cj = wj++; cbr = 1; }
    const bf16_t* Ks = p.KS + (size_t)b * SEQ * 128 + g * 64; const bf16_t* Kw = p.KW + (size_t)b * SEQ * 128 + g * 64;
    const bf16_t* Vs = p.VSt + (size_t)(b * 128 + g * 64) * SEQ; const bf16_t* Vw = p.VWt + (size_t)(b * 128 + g * 64) * SEQ;
    TileRegs R;
    att_load_tile(R, (cbr ? Kw : Ks) + (size_t)cj * 64 * 128, 128, (cbr ? Vw : Vs) + cj * 64);
    bool switched = false;
    while (has) {
        __syncthreads();
        att_store_tile(R, lds);
        __syncthreads();
        if (rem) { nj = __ffs(rem) - 1; rem &= rem - 1; nbr = 0; hasn = true; } else if (wj <= own) { nj = wj++; nbr = 1; hasn = true; } else hasn = false;
        if (hasn) att_load_tile(R, (nbr ? Kw : Ks) + (size_t)nj * 64 * 128, 128, (nbr ? Vw : Vs) + nj * 64);
        if (cbr == 1 && !switched) {
            switched = true;
#pragma unroll
            for (int qt = 0; qt < 2; ++qt) {
                float lt = S.l[qt]; lt += __shfl_xor(lt, 16); lt += __shfl_xor(lt, 32);
                const size_t n = (size_t)b * SEQ + t0 + qt * 16 + fr;
                const float sc = sigmoidf_(p.GATES[n * 24 + hd * 3 + 1]) / fmaxf(lt, 1e-30f);
#pragma unroll
                for (int dt = 0; dt < 4; ++dt) *(f32x4*)(p.OS + n * 512 + hd * 64 + dt * 16 + fg * 4) = S.O[dt][qt] * sc;
            }
            att_reset(S);
        }
        unsigned sb = 3u; int wl = 1 << 30; bool msk;
        if (cbr == 0) { sb = ((selw[0] >> cj) & 1u) | (((selw[1] >> cj) & 1u) << 1); msk = (cj == own); }
        else { wl = 512; msk = (cj == own) || (cj + 8 == own); }
        if (msk) att_step<true>(lds, qf, S, c1, slope2, cj * 64, t0, sb, wl);
        else att_step<false>(lds, qf, S, c1, slope2, cj * 64, t0, sb, wl);
        cbr = nbr; cj = nj; has = hasn;
    }
#pragma unroll
    for (int qt = 0; qt < 2; ++qt) {
        float lt = S.l[qt]; lt += __shfl_xor(lt, 16); lt += __shfl_xor(lt, 32);
        const size_t n = (size_t)b * SEQ + t0 + qt * 16 + fr;
        const float sc = sigmoidf_(p.GATES[n * 24 + hd * 3 + 2]) / fmaxf(lt, 1e-30f);
        const float g0 = sigmoidf_(p.GATES[n * 24 + hd * 3 + 0]);
#pragma unroll
        for (int dt = 0; dt < 4; ++dt) {
            const size_t o = n * 512 + hd * 64 + dt * 16 + fg * 4;
            const f32x4 y = S.O[dt][qt] * sc + *(const f32x4*)(p.OS + o) + *(const f32x4*)(p.OC + o) * g0;
            u32x2 wv; wv.x = pack2(y[0], y[1]); wv.y = pack2(y[2], y[3]);
            *(u32x2*)(p.MIX + n * DM + hd * 64 + dt * 16 + fg * 4) = wv;
        }
    }
}
__device__ __forceinline__ void att_moba_unit(char* lds, const P& p, int b, int h, int ob, int half) {
    const int tid = tidx(), lane = tid & 63, w = tid >> 6, fr = lane & 15, fg = lane >> 4;
    const int tq0 = ob * 256 + half * 128 + w * 32;
    const int dsub = half * 2 + (w >> 1), lastsub = half * 2 + 1;
    const float slope2 = exp2f(-((float)h + 1.0f)) * LOG2E, c1 = 0.125f * LOG2E;
    bf16x8 qf[2][2];
#pragma unroll
    for (int qt = 0; qt < 2; ++qt)
#pragma unroll
        for (int ks = 0; ks < 2; ++ks) qf[qt][ks] = *(const bf16x8*)(p.MQ + (size_t)(b * SEQ + tq0 + qt * 16 + fr) * 512 + h * 64 + ks * 32 + fg * 8);
    unsigned selw[2];
#pragma unroll
    for (int qt = 0; qt < 2; ++qt) selw[qt] = p.MSEL[(size_t)(b * 8 + h) * SEQ + tq0 + qt * 16 + fr];
    unsigned* red = (unsigned*)(lds + ATT_RED_OFF);
    const unsigned umw = wave_or(selw[0] | selw[1]);
    __syncthreads();
    if (lane == 0) red[w] = umw;
    __syncthreads();
    unsigned rem = (red[0] | red[1] | red[2] | red[3]) & ((1u << ob) - 1u);
    AttState S; att_reset(S);
    int cj, csub = 0, nj = 0, nsub = 0; bool has = true, hasn;
    if (rem) { cj = __ffs(rem) - 1; rem &= rem - 1; } else cj = ob;
    const bf16_t* Kb = p.MK + (size_t)b * SEQ * 512 + h * 64; const bf16_t* Vb = p.MVt + (size_t)(b * 512 + h * 64) * SEQ;
    TileRegs R;
    att_load_tile(R, Kb + (size_t)(cj * 256 + csub * 64) * 512, 512, Vb + cj * 256 + csub * 64);
    while (has) {
        __syncthreads();
        att_store_tile(R, lds);
        __syncthreads();
        if (cj == ob) { if (csub < lastsub) { nj = cj; nsub = csub + 1; hasn = true; } else hasn = false; }
        else if (csub < 3) { nj = cj; nsub = csub + 1; hasn = true; }
        else { if (rem) { nj = __ffs(rem) - 1; rem &= rem - 1; } else nj = ob; nsub = 0; hasn = true; }
        if (hasn) att_load_tile(R, Kb + (size_t)(nj * 256 + nsub * 64) * 512, 512, Vb + nj * 256 + nsub * 64);
        const int s0 = cj * 256 + csub * 64;
        unsigned sb = 3u; bool msk = false, run = true;
        if (cj < ob) sb = ((selw[0] >> cj) & 1u) | (((selw[1] >> cj) & 1u) << 1);
        else { msk = (csub == dsub); run = (csub <= dsub); }
        if (run) {
            if (msk) att_step<true>(lds, qf, S, c1, slope2, s0, tq0, sb, 1 << 30);
            else att_step<false>(lds, qf, S, c1, slope2, s0, tq0, sb, 1 << 30);
        }
        cj = nj; csub = nsub; has = hasn;
    }
#pragma unroll
    for (int qt = 0; qt < 2; ++qt) {
        float lt = S.l[qt]; lt += __shfl_xor(lt, 16); lt += __shfl_xor(lt, 32);
        const size_t n = (size_t)b * SEQ + tq0 + qt * 16 + fr;
        const float sc = 1.0f / fmaxf(lt, 1e-30f);
#pragma unroll
        for (int dt = 0; dt < 4; ++dt) {
            const f32x4 y = S.O[dt][qt] * sc;
            u32x2 wv; wv.x = pack2(y[0], y[1]); wv.y = pack2(y[2], y[3]);
            *(u32x2*)(p.MIX + n * DM + 512 + h * 64 + dt * 16 + fg * 4) = wv;
        }
    }
}
#ifndef ATT_NSA
#define ATT_NSA 1
#endif
#ifndef ATT_MOBA
#define ATT_MOBA 1
#endif
__device__ __forceinline__ int att_class_key(int c) {
    if (c < 64) { const int a = (c >> 1) + 1; return (a < 16 ? a : 16) + (a < 9 ? a : 9); }
    const int ob = (c - 64) >> 1, half = (c - 64) & 1; return 4 * ob + 2 + 2 * half;
}
__device__ __forceinline__ void phase_attn(char* lds, int bid, int nb, const P& p) {
    int* order = (int*)(lds + ATT_ORDER_OFF);
    __syncthreads();
    for (int u = tidx(); u < 2048; u += 256) {
        int c, inst; if (u < 1024) { c = u & 63; inst = u >> 6; } else { c = 64 + ((u - 1024) & 15); inst = (u - 1024) >> 4; }
        const int key = att_class_key(c);
        int pos = inst;
        for (int c2 = 0; c2 < 80; ++c2) { const int k2 = att_class_key(c2); if (k2 > key || (k2 == key && c2 < c)) pos += (c2 < 64) ? 16 : 64; }
        order[pos] = u;
    }
    __syncthreads();
    for (int r = 0;; ++r) {
        const int idx = r * nb + ((r & 1) ? (nb - 1 - bid) : bid);
        if (idx >= 2048) break;
        const int u = order[idx];
        if (u < 1024) {
#if ATT_NSA
            att_nsa_unit(lds, p, u >> 7, (u >> 6) & 1, u & 63);
#endif
        } else {
#if ATT_MOBA
            const int v = u - 1024; att_moba_unit(lds, p, v >> 7, (v >> 4) & 7, (v >> 1) & 7, v & 1);
#endif
        }
    }
    __syncthreads();
}


struct ALoadCmp {
    const float* base;
    const float* pe;
    int kt0;
    struct Regs { f32x4 v[8]; };
    __device__ __forceinline__ void load(int kt, Regs& R) const {
        const int l = kt + kt0;
        const f32x4 p0 = *(const f32x4*)(pe + l * 64), p1 = *(const f32x4*)(pe + l * 64 + 4);
#pragma unroll
        for (int i = 0; i < 4; ++i) {
            const int row = (tidx() + 256 * i) >> 3; int tok = 16 * row + l; tok = tok > SEQ - 1 ? SEQ - 1 : tok;
            const float* q = base + (size_t)tok * 256;
            R.v[2 * i] = *(const f32x4*)q + p0; R.v[2 * i + 1] = *(const f32x4*)(q + 4) + p1;
        }
    }
    __device__ __forceinline__ void store(int kt, const Regs& R, char* lds) const {
#pragma unroll
        for (int i = 0; i < 4; ++i) {
            const int p = tidx() + 256 * i, row = p >> 3, ch = p & 7;
            const f32x4 a = R.v[2 * i], b = R.v[2 * i + 1];
            u32x4 w; w.x = pack2(a[0], a[1]); w.y = pack2(a[2], a[3]); w.z = pack2(b[0], b[1]); w.w = pack2(b[2], b[3]);
            *(u32x4*)(lds + lds_off(row, ch * 8)) = w;
        }
    }
};
__device__ __forceinline__ void phase_cmp1(char* lds, int bid, int nb, const P& p) {
    const int tid = tidx(), lane = tid & 63, wid = tid >> 6, wr = wid >> 1, wc = wid & 1, fr = lane & 15, fq = lane >> 4;
    for (int u = bid; u < 16 * 2 * 4; u += nb) {
        const int split = u & 3, which = (u >> 2) & 1, bg = u >> 3, b = bg >> 1, g = bg & 1;
        ALoadCmp al; al.kt0 = split * 8; al.base = p.KCV + (size_t)b * SEQ * 256 + which * 128 + g * 64 + (tid & 7) * 8; al.pe = (which ? p.pe_v : p.pe_k) + (tid & 7) * 8;
        BLoadF32 bl; { const int nq = tid & 31, kg = tid >> 5; bl.valid = true; bl.ldb = 128; bl.nk1 = 1 << 30; bl.bp = (which ? p.wv1 : p.wk1) + (size_t)(split * 8 * 64 + kg * 8) * 128 + nq * 4; }
        f32x4 acc[4][4];
        gemm_tile(lds, al, bl, 8, acc);
        float* hid = p.HID + ((size_t)which * 2048 + bg * 128) * 128;
#pragma unroll
        for (int m = 0; m < 4; ++m)
#pragma unroll
            for (int n = 0; n < 4; ++n) {
                const int row = wr * 64 + m * 16 + fr, col = wc * 64 + n * 16 + fq * 4;
#pragma unroll
                for (int j = 0; j < 4; ++j) atomicAdd(hid + (size_t)row * 128 + col + j, acc[m][n][j]);
            }
    }
}
__device__ __forceinline__ void phase_cmp2(char* lds, int bid, int nb, const P& p) {
    const int tid = tidx(), lane = tid & 63, wid = tid >> 6;
    float* hs = (float*)lds + wid * 128;
    for (int it = bid * 4 + wid; it < 2 * 16 * 128; it += nb * 4) {
        const int which = it >> 11, bg = (it >> 7) & 15, c = it & 127;
        float o = 0.f;
        if (c < 127) {
            const float* hid = p.HID + ((size_t)which * 2048 + bg * 128 + c) * 128;
            __builtin_amdgcn_wave_barrier();
            hs[lane] = gelu_tanh(hid[lane]); hs[lane + 64] = gelu_tanh(hid[lane + 64]);
            __builtin_amdgcn_wave_barrier();
            const float* w2 = which ? p.wv2 : p.wk2;
#pragma unroll 8
            for (int j = 0; j < 128; ++j) o += hs[j] * w2[j * 64 + lane];
        }
        if (which == 0) p.KCb[((size_t)bg * 128 + c) * 64 + lane] = (bf16_t)f2bf(o);
        else p.VCt[((size_t)bg * 64 + lane) * 128 + c] = (bf16_t)f2bf(o);
    }
}
#define CMPA_LDS (2 * 16384 + 4 * 2048)
__device__ __forceinline__ void cmpa_unit(char* lds, const P& p, int b, int g, int qt64) {
    const int tid = tidx(), lane = tid & 63, w = tid >> 6, fr = lane & 15, fg = lane >> 4;
    const int bg = b * 2 + g;
    char* kc = lds; char* vt = lds + 16384;
    __syncthreads();
#pragma unroll
    for (int i = 0; i < 4; ++i) { const int pc = tid + 256 * i;
        *(u32x4*)(kc + lds_off(pc >> 3, (pc & 7) * 8)) = *(const u32x4*)(p.KCb + (size_t)bg * 8192 + pc * 8);
        *(u32x4*)(vt + lds_off128(pc >> 4, (pc & 15) * 8)) = *(const u32x4*)(p.VCt + (size_t)bg * 8192 + pc * 8); }
    __syncthreads();
    const int t = qt64 * 64 + w * 16 + fr;
    const size_t n = (size_t)b * SEQ + t;
    const float c1 = 0.125f * LOG2E;
    f32x4 psum[8];
#pragma unroll
    for (int ct = 0; ct < 8; ++ct) psum[ct] = (f32x4){0.f, 0.f, 0.f, 0.f};
#pragma unroll 1
    for (int i = 0; i < 4; ++i) {
        const int hd = g * 4 + i;
        const float slope2 = exp2f(-((float)hd + 0.5f)) * LOG2E;
        const bf16x8 q0 = *(const bf16x8*)(p.Qb + n * 512 + hd * 64 + fg * 8), q1 = *(const bf16x8*)(p.Qb + n * 512 + hd * 64 + 32 + fg * 8);
        f32x4 s[8];
        float mx = -INFINITY;
#pragma unroll
        for (int ct = 0; ct < 8; ++ct) {
            const bf16x8 k0 = *(const bf16x8*)(kc + lds_off(ct * 16 + fr, fg * 8)), k1 = *(const bf16x8*)(kc + lds_off(ct * 16 + fr, 32 + fg * 8));
            s[ct] = __builtin_amdgcn_mfma_f32_16x16x32_bf16(k0, q0, (f32x4){0.f, 0.f, 0.f, 0.f}, 0, 0, 0);
            s[ct] = __builtin_amdgcn_mfma_f32_16x16x32_bf16(k1, q1, s[ct], 0, 0, 0);
#pragma unroll
            for (int r = 0; r < 4; ++r) {
                const int e = 16 * (ct * 16 + fg * 4 + r) + 31;
                const float y = (e <= t) ? fmaf(s[ct][r], c1, -slope2 * (float)(t - e)) : -INFINITY;
                s[ct][r] = y; mx = fmaxf(mx, y);
            }
        }
        __builtin_amdgcn_sched_barrier(0);
        mx = fmaxf(mx, __shfl_xor(mx, 16)); mx = fmaxf(mx, __shfl_xor(mx, 32));
        const float mm = (mx == -INFINITY) ? 0.f : mx;
        float ls = 0.f;
#pragma unroll
        for (int ct = 0; ct < 8; ++ct)
#pragma unroll
            for (int r = 0; r < 4; ++r) { const float e = __builtin_amdgcn_exp2f(s[ct][r] - mm); s[ct][r] = e; ls += e; }
        ls += __shfl_xor(ls, 16); ls += __shfl_xor(ls, 32);
        const float inv = 1.0f / fmaxf(ls, 1e-30f);
#pragma unroll
        for (int ct = 0; ct < 8; ++ct) { s[ct] *= inv; psum[ct] += s[ct]; }
        __builtin_amdgcn_sched_barrier(0);
        f32x4 o[4];
#pragma unroll
        for (int dt = 0; dt < 4; ++dt) o[dt] = (f32x4){0.f, 0.f, 0.f, 0.f};
#pragma unroll
        for (int kk = 0; kk < 4; ++kk) {
            u32x4 pw; pw.x = pack2(s[2 * kk][0], s[2 * kk][1]); pw.y = pack2(s[2 * kk][2], s[2 * kk][3]); pw.z = pack2(s[2 * kk + 1][0], s[2 * kk + 1][1]); pw.w = pack2(s[2 * kk + 1][2], s[2 * kk + 1][3]);
            const bf16x8 pf = __builtin_bit_cast(bf16x8, pw);
#pragma unroll
            for (int dt = 0; dt < 4; ++dt) {
                const int c0 = kk * 32 + fg * 4;
                const u32x2 v0 = *(const u32x2*)(vt + lds_off128(dt * 16 + fr, c0 & ~7) + (c0 & 7) * 2);
                const u32x2 v1 = *(const u32x2*)(vt + lds_off128(dt * 16 + fr, (c0 + 16) & ~7) + (c0 & 7) * 2);
                u32x4 vv; vv.x = v0.x; vv.y = v0.y; vv.z = v1.x; vv.w = v1.y;
                o[dt] = __builtin_amdgcn_mfma_f32_16x16x32_bf16(__builtin_bit_cast(bf16x8, vv), pf, o[dt], 0, 0, 0);
            }
        }
#pragma unroll
        for (int dt = 0; dt < 4; ++dt) *(f32x4*)(p.OC + n * 512 + hd * 64 + dt * 16 + fg * 4) = o[dt];
    }
    const int own = t >> 6;
    float val[8];
#pragma unroll
    for (int ct = 0; ct < 8; ++ct) {
        const float up = __shfl(psum[ct][3], (lane + 48) & 63);
        const float up0 = (ct > 0) ? __shfl(psum[ct > 0 ? ct - 1 : 0][3], (lane + 48) & 63) : 0.f;
        const float imp = (psum[ct][0] + psum[ct][1]) + (psum[ct][2] + psum[ct][3]) + (fg > 0 ? up : up0);
        const int j = ct * 4 + fg;
        const bool forced = (j == 0) || (j == own) || (j == own - 1);
        val[ct] = (j <= own) ? (imp + (forced ? 1e4f : 0.f)) : NEGF;
    }
    float* vs = (float*)(lds + 32768) + w * 512;
    __builtin_amdgcn_wave_barrier();
#pragma unroll
    for (int ct = 0; ct < 8; ++ct) vs[fr * 32 + ct * 4 + fg] = val[ct];
    __builtin_amdgcn_wave_barrier();
    int rank[8];
#pragma unroll
    for (int ct = 0; ct < 8; ++ct) rank[ct] = 0;
#pragma unroll 2
    for (int oj = 0; oj < 32; ++oj) {
        const float ov = vs[fr * 32 + oj];
#pragma unroll
        for (int ct = 0; ct < 8; ++ct) rank[ct] += (ov > val[ct] || (ov == val[ct] && oj < ct * 4 + fg)) ? 1 : 0;
    }
    __builtin_amdgcn_wave_barrier();
    unsigned bits = 0;
#pragma unroll
    for (int ct = 0; ct < 8; ++ct) if ((ct * 4 + fg <= own) && rank[ct] < 16) bits |= 1u << (ct * 4 + fg);
    bits |= (unsigned)__shfl_xor((int)bits, 16); bits |= (unsigned)__shfl_xor((int)bits, 32);
    if (fg == 0) p.SELM[(size_t)bg * SEQ + t] = bits;
}
__device__ __forceinline__ void phase_cmpa(char* lds, int bid, int nb, const P& p) {
    for (int u = bid; u < 16 * 32; u += nb) cmpa_unit(lds, p, u >> 6, (u >> 5) & 1, u & 31);
    __syncthreads();
}

#define MEGA_LDS (((HG3_LDS + 255) & ~255) + 16)
static_assert(HG3_LDS >= G4_LDS && HG3_LDS >= CMP_LDS && HG3_LDS >= G2_LDS && HG3_LDS >= ATT_RED_OFF + 16, "LDS map");
#define GBAR() xcd_barrier(bar)

template <int LAYER>
__device__ __forceinline__ void moe_block(char* lds, int bid, int nb, const P& p, const XcdBarrier& bar, float* of, bf16_t* ob) {
    if (bid == 0) p.cnt[tidx()] = 0;
    phase_router(bid, nb, p, LAYER);
    GBAR();
    phase_route(bid, nb, p, LAYER);
    GBAR();
    phase_scatter(lds, bid, nb, p);
    GBAR();
    phase_moe1(lds, bid, nb, p, LAYER, p.XAb);
    GBAR();
    phase_moe2(lds, bid, nb, p, LAYER);
    GBAR();
    phase_combine_ln(bid, nb, p, p.XA, p.ln_g + (LAYER * 2 + 1) * DM, p.ln_b + (LAYER * 2 + 1) * DM, of, ob);
}

__global__ void __launch_bounds__(256, 2) mega(P p) {
    char* lds = dyn_lds;
    const int bid = blockIdx.x, nb = gridDim.x;
    volatile LAS unsigned* st = (volatile LAS unsigned*)(dyn_lds + MEGA_LDS - 16);
    if (tidx() == 0) { st[0] = 0u; st[1] = 0u; st[2] = 0u; st[3] = 0u; }
    __syncthreads();
    const XcdBarrier bar = xcd_barrier_post(p.bar, st);
    phase_prep(lds, bid, nb, p);
    GBAR();
    phase_inproj0(lds, bid, nb, p);
    GBAR();
    phase_mix0_a(lds, bid, nb, p);
    GBAR();
    phase_hg2(bid, nb, p);
    GBAR();
    phase_mix0_c(lds, bid, nb, p);
    GBAR();
    phase_gemm_f32out(bid, nb, p.MIX, p.WOUT0, DM, DM, p.T0);
    GBAR();
    phase_ln_add(bid, nb, p.x, p.T0, p.ln_g, p.ln_b, p.XA, p.XAb, p.XAl);
    GBAR();
    moe_block<0>(lds, bid, nb, p, bar, p.XB, p.XBb);
    GBAR();
    phase_inproj1(lds, bid, nb, p);
    GBAR();
    phase_cmp1(lds, bid, nb, p);
    phase_moba_kmean(bid, nb, p);
    GBAR();
    phase_cmp2(lds, bid, nb, p);
    phase_moba_gate(bid, nb, p);
    GBAR();
    phase_cmpa(lds, bid, nb, p);
    GBAR();
#if !ATT_NSA
    phase_nsa_attn(lds, bid, nb, p);
#endif
#if !ATT_MOBA
    phase_moba_attn(lds, bid, nb, p);
#endif
    phase_attn(lds, bid, nb, p);
    GBAR();
    phase_gemm_f32out(bid, nb, p.MIX, p.WOUT1, DM, DM, p.T0);
    GBAR();
    phase_ln_add(bid, nb, p.XB, p.T0, p.ln_g + 2 * DM, p.ln_b + 2 * DM, p.XA, p.XAb, p.XAl);
    GBAR();
    moe_block<1>(lds, bid, nb, p, bar, p.out, nullptr);
}

static inline size_t al256(size_t x) { return (x + 255) & ~(size_t)255; }

extern "C" void kernel_launch(void* const* d_in, const int* in_sizes, int n_in, void* d_out, int out_size, void* d_ws, size_t ws_size, hipStream_t stream) {
    P p{};
    const float** ip = (const float**)&p.x;
    for (int i = 0; i < 30; ++i) ip[i] = (const float*)d_in[i];
    p.out = (float*)d_out;
    char* w = (char*)d_ws; size_t o = 0;
    auto take = [&](size_t bytes) { char* r = w + o; o = al256(o + bytes); return r; };
    p.bar = (unsigned*)take(XCD_BAR_WORDS * 4);
    p.U = (float*)take((size_t)NTOK * EVEN_IN * 4);
    p.MIX = (bf16_t*)take((size_t)NTOK * DM * 2);
    p.T0 = (float*)take((size_t)NTOK * DM * 4);
    p.XA = (float*)take((size_t)NTOK * DM * 4); p.XAb = (bf16_t*)take((size_t)NTOK * DM * 2); p.XAl = (bf16_t*)take((size_t)NTOK * DM * 2);
    p.XB = (float*)take((size_t)NTOK * DM * 4); p.XBb = (bf16_t*)take((size_t)NTOK * DM * 2);
    p.LOG = (float*)take((size_t)NTOK * NEXP * 4);
    p.eidx = (int*)take(NTOK * 8 * 4); p.ew = (float*)take(NTOK * 8 * 4); p.erank = (int*)take(NTOK * 8 * 4); p.epos = (int*)take(NTOK * 8 * 4);
    p.cnt = (int*)take(NEXP * 4); p.tile_e = (int*)take(NTILES * 4); p.rowtok = (int*)take(NROWS * 4);
    p.H = (bf16_t*)take((size_t)NROWS * 256 * 2);
    p.Y = (bf16_t*)take((size_t)NROWS * DM * 2);
    p.LA = (float*)take((size_t)NTOK * 512 * 4); p.LB = (float*)take((size_t)NTOK * 512 * 4);
    p.KC = (float*)take(16 * 127 * 64 * 4); p.VC = (float*)take(16 * 127 * 64 * 4);
    p.OC = (float*)take((size_t)NTOK * 512 * 4);
    p.SELM = (unsigned*)take(16 * SEQ * 4);
    p.KM = (float*)take(8 * 8 * 8 * 64 * 4);
    p.Qb = (bf16_t*)take((size_t)NTOK * 512 * 2); p.KS = (bf16_t*)take((size_t)NTOK * 128 * 2); p.VSt = (bf16_t*)take((size_t)NTOK * 128 * 2);
    p.KW = (bf16_t*)take((size_t)NTOK * 128 * 2); p.VWt = (bf16_t*)take((size_t)NTOK * 128 * 2);
    p.MQ = (bf16_t*)take((size_t)NTOK * 512 * 2); p.MK = (bf16_t*)take((size_t)NTOK * 512 * 2); p.MVt = (bf16_t*)take((size_t)NTOK * 512 * 2);
    p.KCV = (float*)take((size_t)NTOK * 256 * 4); p.GATES = (float*)take((size_t)NTOK * 24 * 4); p.OS = (float*)take((size_t)NTOK * 512 * 4);
    p.MSEL = (unsigned*)take(64 * SEQ * 4);
    p.UB0 = (bf16_t*)take((size_t)NTOK * 2560 * 2); p.VHt = (bf16_t*)take((size_t)NTOK * 512 * 2);
    p.WAT = (bf16_t*)take(8 * 64 * 64 * 2); p.WXT = (bf16_t*)take(8 * 64 * 64 * 2);
    p.CSA = (float*)take(8 * 32 * 512 * 4); p.CSB = (float*)take(8 * 32 * 512 * 4);
    p.UT = (bf16_t*)take((size_t)1024 * 16384 * 2); p.SP = (bf16_t*)take((size_t)1024 * 16384 * 2);
    p.DV = (float*)take(1024 * 128 * 4);
    p.XIb = (bf16_t*)take((size_t)NTOK * DM * 2);
    p.plist = (int*)take(8 * 320 * 4); p.plen = (int*)take(64);
    p.WIN0 = (bf16_t*)take((size_t)EVEN_IN * DM * 2); p.WOUT0 = (bf16_t*)take((size_t)DM * DM * 2); p.WIN1 = (bf16_t*)take((size_t)2944 * DM * 2); p.WOUT1 = (bf16_t*)take((size_t)DM * DM * 2);
    p.WRH = (bf16_t*)take((size_t)2 * NEXP * DM * 2); p.WRL = (bf16_t*)take((size_t)2 * NEXP * DM * 2);
    p.HID = (float*)take(2 * 2048 * 128 * 4); p.KCb = (bf16_t*)take(16 * 128 * 64 * 2); p.VCt = (bf16_t*)take(16 * 64 * 128 * 2);
    if (o > ws_size) return;

    static int grid = 0;
    if (!grid) {
        int dev = 0, cus = 0, per_cu = 0;
        (void)hipGetDevice(&dev);
        (void)hipDeviceGetAttribute(&cus, hipDeviceAttributeMultiprocessorCount, dev);
        (void)hipFuncSetAttribute((const void*)mega, hipFuncAttributeMaxDynamicSharedMemorySize, MEGA_LDS);
        (void)hipOccupancyMaxActiveBlocksPerMultiprocessor(&per_cu, (const void*)mega, 256, MEGA_LDS);
        if (per_cu < 1) per_cu = 1;
        grid = cus * (per_cu < 2 ? per_cu : 2);
    }
    (void)hipMemsetAsync(p.bar, 0, XCD_BAR_WORDS * 4, stream);
    hipLaunchKernelGGL(mega, dim3(grid), dim3(256), MEGA_LDS, stream, p);
}
```

```cpp
#include <hip/hip_runtime.h>
#include <hip/hip_bf16.h>
#include <stdint.h>

#define NTOK 16384
#define DM 1024
#define SEQ 2048
#define NBATCH 8
#define EVEN_IN 3072
#define ODD_IN 2840
#define NEXP 256
#define NEGF (-1e30f)
#define LOG2E 1.4426950408889634f
#define DN_ALPHA 1.4142135623730951f
#define LN_EPS 1e-5f
#define MAXRT 1280
#define SH_TILE0 1280
#define NTILES (1280 + 128)
#define NROWS (NTILES * 128)

typedef unsigned short bf16_t;
typedef short bf16x8 __attribute__((ext_vector_type(8)));
typedef float f32x4 __attribute__((ext_vector_type(4)));
typedef unsigned u32x4 __attribute__((ext_vector_type(4)));
typedef unsigned u32x2 __attribute__((ext_vector_type(2)));
extern __shared__ __attribute__((aligned(16))) char dyn_lds[];
#define LAS __attribute__((address_space(3)))

__device__ __forceinline__ int tidx() { int t = threadIdx.x; asm volatile("" : "+v"(t)); return t; }
__device__ __forceinline__ float wave_sum(float v) {
#pragma unroll
    for (int o = 32; o >= 1; o >>= 1) v += __shfl_xor(v, o);
    return v;
}
__device__ __forceinline__ float wave_max(float v) {
#pragma unroll
    for (int o = 32; o >= 1; o >>= 1) v = fmaxf(v, __shfl_xor(v, o));
    return v;
}
typedef __bf16 hwbf16x2 __attribute__((ext_vector_type(2)));
typedef float f32x2 __attribute__((ext_vector_type(2)));
__device__ __forceinline__ unsigned f2bf(float f) { const __bf16 h = (__bf16)f; return (unsigned)__builtin_bit_cast(unsigned short, h); }
__device__ __forceinline__ float bf2f(unsigned b) { return __uint_as_float(b << 16); }
__device__ __forceinline__ unsigned pack2(float lo, float hi) { const f32x2 f = {lo, hi}; const hwbf16x2 v = __builtin_convertvector(f, hwbf16x2); return __builtin_bit_cast(unsigned, v); }
__device__ __forceinline__ float sigmoidf_(float x) { return 1.0f / (1.0f + __expf(-x)); }
__device__ __forceinline__ float siluf_(float x) { return x / (1.0f + __expf(-x)); }
__device__ __forceinline__ float gelu_tanh(float x) {
    const float u = 0.7978845608028654f * (x + 0.044715f * x * x * x);
    return 0.5f * x * (1.0f + tanhf(u));
}


#define XB_TMO      128
#define XB_XCNT(j)  (256  + 64 * (j))
#define XB_XSUB(j)  (1280 + 64 * (j))
#define XB_XGEN(j)  (2304 + 64 * (j))
#define XB_TOP      3328
#define XB_TOPGEN   3392
#define XCD_BAR_WORDS 3456
#define XB_SPIN_CAP (1u << 18)
__device__ __forceinline__ unsigned xb_ld(unsigned* p)              { return __hip_atomic_load(p, __ATOMIC_RELAXED, __HIP_MEMORY_SCOPE_AGENT); }
__device__ __forceinline__ unsigned xb_add(unsigned* p, unsigned v) { return __hip_atomic_fetch_add(p, v, __ATOMIC_RELAXED, __HIP_MEMORY_SCOPE_AGENT); }
__device__ __forceinline__ unsigned xb_xcc_id() { return (unsigned)__builtin_amdgcn_s_getreg((3 << 11) | 20) & 0xFu; }
#define XB_SPIN(cond, bar) do { unsigned _sp = 0; while (cond) { __builtin_amdgcn_s_sleep(1); \
    if ((++_sp & 255u) == 0u) { if (xb_ld(&(bar)[XB_TMO])) break; if (_sp > XB_SPIN_CAP) { atomicAdd(&(bar)[XB_TMO], 1u); break; } } } } while (0)
struct XcdBarrier { unsigned* bar; unsigned x; volatile LAS unsigned* st; };
__device__ __forceinline__ XcdBarrier xcd_barrier_post(unsigned* bar, volatile LAS unsigned* st) {
    XcdBarrier b; b.bar = bar; b.x = xb_xcc_id(); b.st = st;
    if (tidx() == 0) (void)xb_add(&bar[XB_XCNT(b.x)], 1u);
    return b;
}
__device__ __forceinline__ void xcd_barrier_complete(unsigned* bar, unsigned x, unsigned& nloc, unsigned& nx) {
    const unsigned G = gridDim.x * gridDim.y * gridDim.z;
    unsigned sum, cnt, mine, sp = 0u;
    for (;;) {
        sum = 0u; cnt = 0u; mine = 0u;
#pragma unroll
        for (unsigned j = 0; j < 16; ++j) { const unsigned c = xb_ld(&bar[XB_XCNT(j)]); sum += c; cnt += (c > 0u) ? 1u : 0u; mine = (j == x) ? c : mine; }
        if (sum == G) break;
        __builtin_amdgcn_s_sleep(1);
        if ((++sp & 255u) == 0u) { if (xb_ld(&bar[XB_TMO])) break; if (sp > XB_SPIN_CAP) { atomicAdd(&bar[XB_TMO], 1u); break; } }
    }
    nloc = mine > 0u ? mine : 1u; nx = cnt > 0u ? cnt : 1u;
}
__device__ __forceinline__ void xcd_barrier(const XcdBarrier& b) {
    asm volatile("s_waitcnt vmcnt(0)" ::: "memory");
    __syncthreads();
    if (tidx() == 0) {
        unsigned* bar = b.bar;
        __builtin_amdgcn_s_waitcnt(0);
        unsigned nloc = b.st[0], nx = b.st[1];
        if (nloc == 0u) { xcd_barrier_complete(bar, b.x, nloc, nx); b.st[0] = nloc; b.st[1] = nx; }
        const unsigned old = xb_add(&bar[XB_XSUB(b.x)], 1u);
        const unsigned gen = old / nloc;
        if (old + 1u == (gen + 1u) * nloc) {
            __builtin_amdgcn_fence(__ATOMIC_RELEASE, "agent");
            asm volatile("s_waitcnt vmcnt(0)" ::: "memory");
            const unsigned og = xb_add(&bar[XB_TOP], 1u);
            const unsigned tg = og / nx;
            if (og + 1u == (tg + 1u) * nx) xb_add(&bar[XB_TOPGEN], 1u);
            else XB_SPIN(xb_ld(&bar[XB_TOPGEN]) == tg, bar);
            __builtin_amdgcn_fence(__ATOMIC_ACQUIRE, "agent");
            xb_add(&bar[XB_XGEN(b.x)], 1u);
            asm volatile("s_waitcnt vmcnt(0)" ::: "memory");
        } else {
            XB_SPIN(xb_ld(&bar[XB_XGEN(b.x)]) == gen, bar);
            __builtin_amdgcn_fence(__ATOMIC_ACQUIRE, "agent");
            asm volatile("s_waitcnt vmcnt(0)" ::: "memory");
        }
    }
    __syncthreads();
}

struct P {
    const float *x, *even_w_in, *conv_w, *conv_b, *wa, *ba, *wx, *bx, *lam, *hg_lb, *hg_ng, *even_w_out;
    const float *odd_w_in, *pe_k, *pe_v, *wk1, *wk2, *wv1, *wv2, *odd_w_out, *ln_g, *ln_b, *w_router, *b_router;
    const float *w_gate, *w_up, *w_down, *ws_gate, *ws_up, *ws_down;
    float* out;
    float* U;
    bf16_t* MIX;
    float* T0;
    float* XA; bf16_t* XAb; float* XB; bf16_t* XBb; bf16_t* XAl;
    float* LOG;
    int* eidx; float* ew; int* erank; int* epos;
    int* cnt;
    int* tile_e;
    int* rowtok;
    bf16_t* H;
    bf16_t* Y;
    float* LA; float* LB;
    float* KC; float* VC;
    float* OC;
    unsigned* SELM;
    float* KM;
    unsigned* bar;
    bf16_t *Qb, *KS, *VSt, *KW, *VWt, *MQ, *MK, *MVt;
    float *KCV, *GATES, *OS; unsigned* MSEL;
    bf16_t *UB0;
    bf16_t *VHt;
    bf16_t *WAT, *WXT;
    float *CSA, *CSB;
    bf16_t *UT, *SP;
    float *DV;
    float *HID;
    bf16_t *KCb, *VCt;
    bf16_t *XIb;
    int *plist; int *plen;
    bf16_t *WIN0, *WOUT0, *WIN1, *WOUT1, *WRH, *WRL;
};

__device__ __forceinline__ int lds_off(int r, int c) {
    const int st = (r >> 4) * 2 + (c >> 5), ob = (r & 15) * 64 + (c & 31) * 2;
    return st * 1024 + (ob ^ (((ob >> 9) & 1) << 5));
}
#define GEMM_LDS 32768

__device__ __forceinline__ float cvt_part(float v, int lo) { return lo ? (v - bf2f(f2bf(v))) : v; }

struct ALoadF32 {
    const float* rp[4];
    int nk1;
    struct Regs { f32x4 v[8]; };
    __device__ __forceinline__ void load(int kt, Regs& R) const {
        const int k = (kt % nk1) * 64;
#pragma unroll
        for (int i = 0; i < 4; ++i) { R.v[2 * i] = *(const f32x4*)(rp[i] + k); R.v[2 * i + 1] = *(const f32x4*)(rp[i] + k + 4); }
    }
    __device__ __forceinline__ void store(int kt, const Regs& R, char* lds) const {
        const int lo = (kt / nk1) == 2;
#pragma unroll
        for (int i = 0; i < 4; ++i) {
            const int p = tidx() + 256 * i, row = p >> 3, ch = p & 7;
            const f32x4 a = R.v[2 * i], b = R.v[2 * i + 1];
            u32x4 w;
            w.x = pack2(cvt_part(a[0], lo), cvt_part(a[1], lo)); w.y = pack2(cvt_part(a[2], lo), cvt_part(a[3], lo));
            w.z = pack2(cvt_part(b[0], lo), cvt_part(b[1], lo)); w.w = pack2(cvt_part(b[2], lo), cvt_part(b[3], lo));
            *(u32x4*)(lds + lds_off(row, ch * 8)) = w;
        }
    }
};
struct ALoadBF16 {
    const bf16_t* rp[4];
    struct Regs { u32x4 v[4]; };
    __device__ __forceinline__ void load(int kt, Regs& R) const {
#pragma unroll
        for (int i = 0; i < 4; ++i) R.v[i] = *(const u32x4*)(rp[i] + kt * 64);
    }
    __device__ __forceinline__ void store(int kt, const Regs& R, char* lds) const {
#pragma unroll
        for (int i = 0; i < 4; ++i) { const int p = tidx() + 256 * i; *(u32x4*)(lds + lds_off(p >> 3, (p & 7) * 8)) = R.v[i]; }
    }
};
struct ALoadF32S {
    const float* rp0; size_t rs32; int nk1;
    struct Regs { f32x4 v[8]; };
    __device__ __forceinline__ void load(int kt, Regs& R) const {
        const int k = (kt % nk1) * 64;
#pragma unroll
        for (int i = 0; i < 4; ++i) { const float* q = rp0 + i * rs32 + k; R.v[2 * i] = *(const f32x4*)q; R.v[2 * i + 1] = *(const f32x4*)(q + 4); }
    }
    __device__ __forceinline__ void store(int kt, const Regs& R, char* lds) const {
        const int lo = (kt / nk1) == 2;
#pragma unroll
        for (int i = 0; i < 4; ++i) {
            const int p = tidx() + 256 * i, row = p >> 3, ch = p & 7;
            const f32x4 a = R.v[2 * i], b = R.v[2 * i + 1];
            u32x4 w;
            w.x = pack2(cvt_part(a[0], lo), cvt_part(a[1], lo)); w.y = pack2(cvt_part(a[2], lo), cvt_part(a[3], lo));
            w.z = pack2(cvt_part(b[0], lo), cvt_part(b[1], lo)); w.w = pack2(cvt_part(b[2], lo), cvt_part(b[3], lo));
            *(u32x4*)(lds + lds_off(row, ch * 8)) = w;
        }
    }
};
struct ALoadBF16S {
    const bf16_t* rp0; size_t rs32;
    struct Regs { u32x4 v[4]; };
    __device__ __forceinline__ void load(int kt, Regs& R) const {
#pragma unroll
        for (int i = 0; i < 4; ++i) R.v[i] = *(const u32x4*)(rp0 + i * rs32 + kt * 64);
    }
    __device__ __forceinline__ void store(int kt, const Regs& R, char* lds) const {
#pragma unroll
        for (int i = 0; i < 4; ++i) { const int p = tidx() + 256 * i; *(u32x4*)(lds + lds_off(p >> 3, (p & 7) * 8)) = R.v[i]; }
    }
};
struct BLoadF32 {
    const float* bp; int ldb; bool valid; int nk1;
    struct Regs { f32x4 v[8]; };
    __device__ __forceinline__ void load(int kt, Regs& R) const {
        const float* p = bp + (size_t)((kt % nk1) * 64) * ldb;
#pragma unroll
        for (int j = 0; j < 8; ++j) R.v[j] = valid ? *(const f32x4*)(p + (size_t)j * ldb) : (f32x4){0.f, 0.f, 0.f, 0.f};
    }
    __device__ __forceinline__ void store(int kt, const Regs& R, char* lds) const {
        const int lo = (kt / nk1) == 1;
        const int nq = tidx() & 31, kg = tidx() >> 5;
#pragma unroll
        for (int i = 0; i < 4; ++i) {
            u32x4 w;
            w.x = pack2(cvt_part(R.v[0][i], lo), cvt_part(R.v[1][i], lo)); w.y = pack2(cvt_part(R.v[2][i], lo), cvt_part(R.v[3][i], lo));
            w.z = pack2(cvt_part(R.v[4][i], lo), cvt_part(R.v[5][i], lo)); w.w = pack2(cvt_part(R.v[6][i], lo), cvt_part(R.v[7][i], lo));
            *(u32x4*)(lds + lds_off(nq * 4 + i, kg * 8)) = w;
        }
    }
};

template <class AL, class BL>
__device__ __forceinline__ void gemm_tile(char* lds, const AL& al, const BL& bl, int nk, f32x4 (&acc)[4][4], bool swap = false) {
    const int lane = tidx() & 63, wid = tidx() >> 6, wr = wid >> 1, wc = wid & 1, fr = lane & 15, fq = lane >> 4;
    char* ldsA = lds; char* ldsB = lds + 16384;
    const char* t2 = swap ? ldsB : ldsA; const char* t1 = swap ? ldsA : ldsB; const int w2 = swap ? wc : wr, w1 = swap ? wr : wc;
#pragma unroll
    for (int m = 0; m < 4; ++m)
#pragma unroll
        for (int n = 0; n < 4; ++n) acc[m][n] = (f32x4){0.f, 0.f, 0.f, 0.f};
    typename AL::Regs ra; typename BL::Regs rb;
    al.load(0, ra); bl.load(0, rb);
    for (int kt = 0; kt < nk; ++kt) {
        __syncthreads();
        al.store(kt, ra, ldsA); bl.store(kt, rb, ldsB);
        __syncthreads();
        if (kt + 1 < nk) { al.load(kt + 1, ra); bl.load(kt + 1, rb); }
#pragma unroll
        for (int kk = 0; kk < 2; ++kk) {
            bf16x8 a[4], b[4];
#pragma unroll
            for (int m = 0; m < 4; ++m) a[m] = *(const bf16x8*)(t2 + lds_off(w2 * 64 + m * 16 + fr, kk * 32 + fq * 8));
#pragma unroll
            for (int n = 0; n < 4; ++n) b[n] = *(const bf16x8*)(t1 + lds_off(w1 * 64 + n * 16 + fr, kk * 32 + fq * 8));
#pragma unroll
            for (int m = 0; m < 4; ++m)
#pragma unroll
                for (int n = 0; n < 4; ++n) acc[m][n] = __builtin_amdgcn_mfma_f32_16x16x32_bf16(b[n], a[m], acc[m][n], 0, 0, 0);
        }
    }
}


#define G2_LDS 65536
__device__ __forceinline__ void dma_rc(int lane, int st, int& R, int& C) {
    const int sb = lane * 16, swz = sb ^ (((sb >> 9) & 1) << 5);
    R = (st >> 1) * 16 + (swz >> 6); C = (st & 1) * 32 + ((swz & 63) >> 1);
}
struct DmaLoad {
    static constexpr int LAYOUT = 0;
    const char* base; unsigned voff[4];
    __device__ __forceinline__ void set_dense(const bf16_t* b0, int row0, int ld) {
        base = (const char*)b0; const int lane = tidx() & 63, w = tidx() >> 6;
#pragma unroll
        for (int i = 0; i < 4; ++i) { int R, C; dma_rc(lane, w + 4 * i, R, C); voff[i] = (unsigned)(((size_t)(row0 + R) * ld + C) * 2); }
    }
    __device__ __forceinline__ void issue(int kt, int ldsoff) const {
        const int w = tidx() >> 6;
#pragma unroll
        for (int i = 0; i < 4; ++i)
            __builtin_amdgcn_global_load_lds((const unsigned*)(base + voff[i] + (size_t)kt * 128), (LAS unsigned*)((LAS char*)dyn_lds + ldsoff + (w + 4 * i) * 1024), 16, 0, 0);
    }
    __device__ __forceinline__ void commit(int, int) const {}
};
struct RegLoadA {
    const float* rp0; size_t rs32; int nk1; f32x4 v[8];
    __device__ __forceinline__ void issue(int kt, int) {
        const int k = (kt % nk1) * 64;
#pragma unroll
        for (int i = 0; i < 4; ++i) { const float* q = rp0 + i * rs32 + k; v[2 * i] = *(const f32x4*)q; v[2 * i + 1] = *(const f32x4*)(q + 4); }
    }
    __device__ __forceinline__ void commit(int kt, int ldsoff) const {
        const int lo = (kt / nk1) == 2;
#pragma unroll
        for (int i = 0; i < 4; ++i) {
            const int p = tidx() + 256 * i, row = p >> 3, ch = p & 7;
            const f32x4 a = v[2 * i], b = v[2 * i + 1];
            u32x4 w;
            w.x = pack2(cvt_part(a[0], lo), cvt_part(a[1], lo)); w.y = pack2(cvt_part(a[2], lo), cvt_part(a[3], lo));
            w.z = pack2(cvt_part(b[0], lo), cvt_part(b[1], lo)); w.w = pack2(cvt_part(b[2], lo), cvt_part(b[3], lo));
            *(u32x4*)(dyn_lds + ldsoff + lds_off(row, ch * 8)) = w;
        }
    }
};
struct RegLoadB {
    const float* bp; int ldb; f32x4 v[8];
    static constexpr int LAYOUT = 1;
    static __device__ __forceinline__ int nq_of(int tid) { return tid & 31; }
    static __device__ __forceinline__ int kg_of(int tid) { return tid >> 5; }
    __device__ __forceinline__ void issue(int kt, int) {
        const float* p = bp + (size_t)(kt * 64) * ldb;
#pragma unroll
        for (int j = 0; j < 8; ++j) v[j] = *(const f32x4*)(p + (size_t)j * ldb);
    }
    __device__ __forceinline__ void commit(int, int ldsoff) const {
        const int tid = tidx(), nq = nq_of(tid), kg = kg_of(tid);
        u32x4 w[4];
#pragma unroll
        for (int i = 0; i < 4; ++i) { w[i].x = pack2(v[0][i], v[1][i]); w[i].y = pack2(v[2][i], v[3][i]); w[i].z = pack2(v[4][i], v[5][i]); w[i].w = pack2(v[6][i], v[7][i]); }
        const int rot = (nq >> 1) & 3;
#pragma unroll
        for (int i = 0; i < 4; ++i) {
            const int e = (i + rot) & 3;
            u32x4 d;
            d.x = e == 0 ? w[0].x : (e == 1 ? w[1].x : (e == 2 ? w[2].x : w[3].x));
            d.y = e == 0 ? w[0].y : (e == 1 ? w[1].y : (e == 2 ? w[2].y : w[3].y));
            d.z = e == 0 ? w[0].z : (e == 1 ? w[1].z : (e == 2 ? w[2].z : w[3].z));
            d.w = e == 0 ? w[0].w : (e == 1 ? w[1].w : (e == 2 ? w[2].w : w[3].w));
            *(u32x4*)(dyn_lds + ldsoff + ((kg * 128 + nq * 4 + e) << 4)) = d;
        }
    }
};
template <class AL, class BL>
__device__ __forceinline__ void gemm_core(AL& al, BL& bl, int nk, f32x4 (&acc)[4][4], bool swap = false) {
    const int lane = tidx() & 63, wid = tidx() >> 6, wr = wid >> 1, wc = wid & 1, fr = lane & 15, fq = lane >> 4;
    const int w2 = swap ? wc : wr, w1 = swap ? wr : wc;
    const int o2 = swap ? 16384 : 0, o1 = swap ? 0 : 16384;
#pragma unroll
    for (int m = 0; m < 4; ++m)
#pragma unroll
        for (int n = 0; n < 4; ++n) acc[m][n] = (f32x4){0.f, 0.f, 0.f, 0.f};
    al.issue(0, 0); bl.issue(0, 16384); al.commit(0, 0); bl.commit(0, 16384);
    asm volatile("s_waitcnt vmcnt(0)" ::: "memory");
    __syncthreads();
    for (int kt = 0; kt < nk; ++kt) {
        const int cur = (kt & 1) * 32768, nxt = 32768 - cur;
        if (kt + 1 < nk) { al.issue(kt + 1, nxt); bl.issue(kt + 1, nxt + 16384); }
#pragma unroll
        for (int kk = 0; kk < 2; ++kk) {
            bf16x8 a[4], b[4];
#pragma unroll
            for (int m = 0; m < 4; ++m) a[m] = *(const bf16x8*)(dyn_lds + cur + o2 + lds_off(w2 * 64 + m * 16 + fr, kk * 32 + fq * 8));
#pragma unroll
            for (int n = 0; n < 4; ++n) b[n] = *(const bf16x8*)(dyn_lds + cur + o1 + (BL::LAYOUT == 1 ? (((kk * 4 + fq) * 128 + w1 * 64 + n * 16 + fr) << 4) : lds_off(w1 * 64 + n * 16 + fr, kk * 32 + fq * 8)));
#pragma unroll
            for (int m = 0; m < 4; ++m)
#pragma unroll
                for (int n = 0; n < 4; ++n) acc[m][n] = __builtin_amdgcn_mfma_f32_16x16x32_bf16(b[n], a[m], acc[m][n], 0, 0, 0);
        }
        if (kt + 1 < nk) { al.commit(kt + 1, nxt); bl.commit(kt + 1, nxt + 16384); }
        asm volatile("s_waitcnt vmcnt(0)" ::: "memory");
        __syncthreads();
    }
}


#define G3_STAGE 24576
#define G3_LDS (2 * G3_STAGE)
__device__ __forceinline__ int t32_off(int r, int c) { const int ob = (r & 15) * 64 + c * 2; return (r >> 4) * 1024 + (ob ^ (((ob >> 9) & 1) << 5)); }
__device__ __forceinline__ void dma_rc32(int lane, int st, int& R, int& C) { const int sb = lane * 16, swz = sb ^ (((sb >> 9) & 1) << 5); R = st * 16 + (swz >> 6); C = (swz & 63) >> 1; }
struct Dma3A {
    static constexpr int NV = 4;
    const char* base; unsigned voff[4];
    const char* lo = nullptr; int nk1 = 1 << 30;
    __device__ __forceinline__ void set_dense(const bf16_t* b0, int row0, int ld) {
        base = (const char*)b0; const int lane = tidx() & 63, w = tidx() >> 6;
#pragma unroll
        for (int i = 0; i < 4; ++i) { int R, C; dma_rc32(lane, w + 4 * i, R, C); voff[i] = (unsigned)(((size_t)(row0 + R) * ld + C) * 2); }
    }
    template <int SET = 0> __device__ __forceinline__ void issue(int kt, int ldsoff) const {
        const int w = tidx() >> 6;
#pragma unroll
        for (int i = 0; i < 4; ++i)
            __builtin_amdgcn_global_load_lds((const unsigned*)((((kt / nk1) == 2) ? lo : base) + voff[i] + (size_t)(kt % nk1) * 64), (LAS unsigned*)((LAS char*)dyn_lds + ldsoff + (w + 4 * i) * 1024), 16, 0, 0);
    }
    template <int SET = 0> __device__ __forceinline__ void commit(int, int) const {}
};
struct Dma3B {
    static constexpr int LAYOUT = 0, NV = 2;
    const char* hi; const char* lo; unsigned voff[2]; int nk1;
    __device__ __forceinline__ void set(const bf16_t* h, const bf16_t* l, int row0, int ld, int nk1_) {
        hi = (const char*)h; lo = (const char*)l; nk1 = nk1_; const int lane = tidx() & 63, w = tidx() >> 6;
#pragma unroll
        for (int i = 0; i < 2; ++i) { int R, C; dma_rc32(lane, w + 4 * i, R, C); voff[i] = (unsigned)(((size_t)(row0 + R) * ld + C) * 2); }
    }
    template <int SET = 0> __device__ __forceinline__ void issue(int kt, int ldsoff) const {
        const int w = tidx() >> 6; const char* base = ((kt / nk1) == 1) ? lo : hi; const size_t ko = (size_t)(kt % nk1) * 64;
#pragma unroll
        for (int i = 0; i < 2; ++i)
            __builtin_amdgcn_global_load_lds((const unsigned*)(base + voff[i] + ko), (LAS unsigned*)((LAS char*)dyn_lds + ldsoff + (w + 4 * i) * 1024), 16, 0, 0);
    }
    template <int SET = 0> __device__ __forceinline__ void commit(int, int) const {}
};
struct Reg3A {
    const float* rp0; size_t rs64; int nk1; f32x4 v[8];
    template <int SET = 0> __device__ __forceinline__ void issue(int kt, int) {
        const int k = (kt % nk1) * 32;
#pragma unroll
        for (int i = 0; i < 4; ++i) { const float* q = rp0 + i * rs64 + k; v[2 * i] = *(const f32x4*)q; v[2 * i + 1] = *(const f32x4*)(q + 4); }
    }
    template <int SET = 0> __device__ __forceinline__ void commit(int kt, int ldsoff) const {
        const int lo = (kt / nk1) == 2;
#pragma unroll
        for (int i = 0; i < 4; ++i) {
            const int p = tidx() + 256 * i, row = p >> 2, ch = p & 3;
            const f32x4 a = v[2 * i], b = v[2 * i + 1];
            u32x4 w;
            w.x = pack2(cvt_part(a[0], lo), cvt_part(a[1], lo)); w.y = pack2(cvt_part(a[2], lo), cvt_part(a[3], lo));
            w.z = pack2(cvt_part(b[0], lo), cvt_part(b[1], lo)); w.w = pack2(cvt_part(b[2], lo), cvt_part(b[3], lo));
            *(u32x4*)(dyn_lds + ldsoff + t32_off(row, ch * 8)) = w;
        }
    }
};
struct Reg3B {
    static constexpr int LAYOUT = 1, NV = 4;
    const float* bp; int ldb; f32x4 v[2][4];
    template <int SET = 0> __device__ __forceinline__ void issue(int kt, int) {
        const float* p = bp + (size_t)(kt * 32) * ldb;
#pragma unroll
        for (int j = 0; j < 4; ++j) v[SET][j] = *(const f32x4*)(p + (size_t)j * ldb);
    }
    template <int SET = 0> __device__ __forceinline__ void commit(int, int ldsoff) const {
        const int tid = tidx(), nq = tid & 31, kg = tid >> 5;
        u32x2 w[4];
#pragma unroll
        for (int i = 0; i < 4; ++i) { w[i].x = pack2(v[SET][0][i], v[SET][1][i]); w[i].y = pack2(v[SET][2][i], v[SET][3][i]); }
        const int rot = (nq >> 1) & 3;
#pragma unroll
        for (int i = 0; i < 4; ++i) {
            const int e = (i + rot) & 3;
            u32x2 d;
            d.x = e == 0 ? w[0].x : (e == 1 ? w[1].x : (e == 2 ? w[2].x : w[3].x));
            d.y = e == 0 ? w[0].y : (e == 1 ? w[1].y : (e == 2 ? w[2].y : w[3].y));
            *(u32x2*)(dyn_lds + ldsoff + ((((kg >> 1) * 128 + nq * 4 + e) << 4) + (kg & 1) * 8)) = d;
        }
    }
};
#define G4_LDS (3 * G3_STAGE)
template <class AL, class BL, int PAR>
__device__ __forceinline__ void g4_step(AL& al, BL& bl, int kt, int nk, f32x4 (&acc)[32], bool idle) {
    constexpr int NV = AL::NV + BL::NV;
    const int lane = tidx() & 63, wid = tidx() >> 6, wr = wid >> 1, wc = wid & 1, fr = lane & 15, fq = lane >> 4;
    const int s0 = kt % 3, cur = s0 * G3_STAGE, nx1 = (s0 == 2 ? 0 : s0 + 1) * G3_STAGE, nx2 = (s0 == 0 ? 2 : s0 - 1) * G3_STAGE;
    if (kt + 1 < nk) asm volatile("s_waitcnt vmcnt(%0) lgkmcnt(0)" :: "n"(NV) : "memory");
    else asm volatile("s_waitcnt vmcnt(0) lgkmcnt(0)" ::: "memory");
    __builtin_amdgcn_s_barrier();
    asm volatile("" ::: "memory");
    if (kt + 2 < nk) { al.template issue<PAR>(kt + 2, nx2); bl.template issue<PAR>(kt + 2, nx2 + 16384); }
    if (!idle) {
    bf16x8 sm[4];
#pragma unroll
    for (int j = 0; j < 4; ++j) sm[j] = *(const bf16x8*)(dyn_lds + cur + 16384 + (BL::LAYOUT == 1 ? ((fq * 128 + wc * 64 + j * 16 + fr) << 4) : t32_off(wc * 64 + j * 16 + fr, fq * 8)));
    bf16x8 bigc = *(const bf16x8*)(dyn_lds + cur + t32_off(wr * 128 + fr, fq * 8));
#pragma unroll
    for (int i = 0; i < 8; ++i) {
        bf16x8 bign = bigc;
        if (i < 7) bign = *(const bf16x8*)(dyn_lds + cur + t32_off(wr * 128 + (i + 1) * 16 + fr, fq * 8));
        __builtin_amdgcn_sched_barrier(0);
#pragma unroll
        for (int j = 0; j < 4; ++j) acc[i * 4 + j] = __builtin_amdgcn_mfma_f32_16x16x32_bf16(sm[j], bigc, acc[i * 4 + j], 0, 0, 0);
        __builtin_amdgcn_sched_barrier(0);
        bigc = bign;
    }
    }
    if (kt + 1 < nk) bl.template commit<PAR ^ 1>(kt + 1, nx1 + 16384);
}
template <class AL, class BL>
__device__ __forceinline__ void gemm_core4(AL& al, BL& bl, int nk, f32x4 (&acc)[32], bool idle_hi = false) {
    const bool idle = idle_hi && (tidx() >> 7);
#pragma unroll
    for (int i = 0; i < 32; ++i) acc[i] = (f32x4){0.f, 0.f, 0.f, 0.f};
    al.template issue<0>(0, 0); bl.template issue<0>(0, 16384);
    if (nk > 1) { al.template issue<1>(1, G3_STAGE); bl.template issue<1>(1, G3_STAGE + 16384); }
    bl.template commit<0>(0, 16384);
    for (int kt = 0; kt < nk; kt += 2) {
        g4_step<AL, BL, 0>(al, bl, kt, nk, acc, idle);
        if (kt + 1 < nk) g4_step<AL, BL, 1>(al, bl, kt + 1, nk, acc, idle);
    }
    __syncthreads();
}
template <class AL, class BL>
__device__ __forceinline__ void gemm_core3(AL& al, BL& bl, int nk, f32x4 (&acc)[32]) {
    const int lane = tidx() & 63, wid = tidx() >> 6, wr = wid >> 1, wc = wid & 1, fr = lane & 15, fq = lane >> 4;
#pragma unroll
    for (int i = 0; i < 32; ++i) acc[i] = (f32x4){0.f, 0.f, 0.f, 0.f};
    al.issue(0, 0); bl.issue(0, 16384); al.commit(0, 0); bl.commit(0, 16384);
    asm volatile("s_waitcnt vmcnt(0)" ::: "memory");
    __syncthreads();
    for (int kt = 0; kt < nk; ++kt) {
        const int cur = (kt & 1) * G3_STAGE, nxt = G3_STAGE - cur;
        if (kt + 1 < nk) { al.issue(kt + 1, nxt); bl.issue(kt + 1, nxt + 16384); }
        bf16x8 sm[4];
#pragma unroll
        for (int j = 0; j < 4; ++j) sm[j] = *(const bf16x8*)(dyn_lds + cur + 16384 + (BL::LAYOUT == 1 ? ((fq * 128 + wc * 64 + j * 16 + fr) << 4) : t32_off(wc * 64 + j * 16 + fr, fq * 8)));
#pragma unroll
        for (int i = 0; i < 8; ++i) {
            const bf16x8 big = *(const bf16x8*)(dyn_lds + cur + t32_off(wr * 128 + i * 16 + fr, fq * 8));
#pragma unroll
            for (int j = 0; j < 4; ++j) acc[i * 4 + j] = __builtin_amdgcn_mfma_f32_16x16x32_bf16(sm[j], big, acc[i * 4 + j], 0, 0, 0);
        }
        if (kt + 1 < nk) { al.commit(kt + 1, nxt); bl.commit(kt + 1, nxt + 16384); }
        asm volatile("s_waitcnt vmcnt(0)" ::: "memory");
        __syncthreads();
    }
}
__device__ __forceinline__ bool dense_unit3(int bid, int nb, int j, int ntn, int& tm, int& tn) {
    if ((nb & 7) == 0) {
        const int x = bid & 7, r = bid >> 3, R = nb >> 3;
        const int li = r + R * j;
        if (li >= 8 * ntn) return false;
        tn = li >> 3; tm = x * 8 + (li & 7);
        return true;
    }
    const int u = bid + nb * j;
    if (u >= 64 * ntn) return false;
    tm = u / ntn; tn = u % ntn; return true;
}
__device__ __forceinline__ void prep_tile(char* lds, const float* W, int ldw, int k0, int scol0, bool colvalid, bf16_t* Bt, int K, int drow0, int mode) {
    const int tid = tidx();
    bf16_t* t = (bf16_t*)lds;
    __syncthreads();
#pragma unroll
    for (int i = 0; i < 4; ++i) {
        const int k = (tid >> 4) + 16 * i, q = tid & 15;
        f32x4 v = colvalid ? *(const f32x4*)(W + (size_t)(k0 + k) * ldw + scol0 + q * 4) : (f32x4){0.f, 0.f, 0.f, 0.f};
#pragma unroll
        for (int e = 0; e < 4; ++e) { float x = v[e]; if (mode == 2) x = x - bf2f(f2bf(x)); t[(q * 4 + e) * 72 + k] = (bf16_t)f2bf(x); }
    }
    __syncthreads();
#pragma unroll
    for (int i = 0; i < 2; ++i) { const int pc = tid + 256 * i, n = pc >> 3, ch = pc & 7;
        *(u32x4*)(Bt + (size_t)(drow0 + n) * K + k0 + ch * 8) = *(const u32x4*)(t + n * 72 + ch * 8); }
}
__device__ __forceinline__ int vcol_actual(int v);
__device__ __forceinline__ void phase_prep(char* lds, int bid, int nb, const P& p) {
    const int tid = tidx();
    for (size_t i = (size_t)bid * 256 + tid; i < (size_t)NTOK * DM / 8; i += (size_t)nb * 256) {
        const f32x4 a = *(const f32x4*)(p.x + i * 8), b = *(const f32x4*)(p.x + i * 8 + 4);
        u32x4 w; w.x = pack2(a[0], a[1]); w.y = pack2(a[2], a[3]); w.z = pack2(b[0], b[1]); w.w = pack2(b[2], b[3]);
        *(u32x4*)(p.XIb + i * 8) = w;
    }
    for (int u = bid; u < 2272; u += nb) {
        if (u < 768) { const int nt = u >> 4, kt = u & 15; const int d = nt * 64; const int sc = d < 2048 ? d : (d < 2560 ? d + 512 : d - 512);
            prep_tile(lds, p.even_w_in, EVEN_IN, kt * 64, sc, true, p.WIN0, DM, d, 0); }
        else if (u < 1024) { const int v = u - 768, nt = v >> 4, kt = v & 15; prep_tile(lds, p.even_w_out, DM, kt * 64, nt * 64, true, p.WOUT0, DM, nt * 64, 0); }
        else if (u < 1760) { const int v = u - 1024, nt = v >> 4, kt = v & 15; const int d = nt * 64;
            int sc; bool ok = true;
            if (d < 896) sc = d; else if (d < 1024) sc = d + 128; else if (d < 1536) sc = d + 280; else if (d < 2048) sc = d + 280;
            else if (d < 2112) sc = 1280; else if (d < 2176) { sc = 0; ok = false; } else if (d < 2304) sc = d - 1280; else if (d < 2432) sc = d - 1152; else sc = d - 104;
            prep_tile(lds, p.odd_w_in, ODD_IN, kt * 64, sc, ok, p.WIN1, DM, d, 0); }
        else if (u < 2016) { const int v = u - 1760, nt = v >> 4, kt = v & 15; prep_tile(lds, p.odd_w_out, DM, kt * 64, nt * 64, true, p.WOUT1, DM, nt * 64, 0); }
        else { const int v = u - 2016, layer = v >> 7, lo = (v >> 6) & 1, nt = (v >> 4) & 3, kt = v & 15;
            prep_tile(lds, p.w_router + (size_t)layer * DM * NEXP, NEXP, kt * 64, nt * 64, true, (lo ? p.WRL : p.WRH) + (size_t)layer * NEXP * DM, DM, nt * 64, lo ? 2 : 1); }
    }
    __syncthreads();
}


__device__ __forceinline__ bool dense_unit(int bid, int nb, int j, int ntn, int& tm, int& tn) {
    if ((nb & 7) == 0) {
        const int x = bid & 7, r = bid >> 3, R = nb >> 3;
        const int li = r + R * j;
        if (li >= 16 * ntn) return false;
        const int pg = li / (8 * ntn), rest = li - pg * 8 * ntn;
        tn = rest >> 3; tm = x * 16 + pg * 8 + (rest & 7);
        return true;
    }
    const int u = bid + nb * j;
    if (u >= 128 * ntn) return false;
    tm = u / ntn; tn = u % ntn; return true;
}
struct DmaLoadSplit {
    static constexpr int LAYOUT = 0;
    const char* hi; const char* lo; unsigned voff[4]; int nk1;
    __device__ __forceinline__ void set(const bf16_t* h, const bf16_t* l, int row0, int ld, int nk1_) {
        hi = (const char*)h; lo = (const char*)l; nk1 = nk1_; const int lane = tidx() & 63, w = tidx() >> 6;
#pragma unroll
        for (int i = 0; i < 4; ++i) { int R, C; dma_rc(lane, w + 4 * i, R, C); voff[i] = (unsigned)(((size_t)(row0 + R) * ld + C) * 2); }
    }
    __device__ __forceinline__ void issue(int kt, int ldsoff) const {
        const int w = tidx() >> 6; const char* base = ((kt / nk1) == 1) ? lo : hi; const size_t ko = (size_t)(kt % nk1) * 128;
#pragma unroll
        for (int i = 0; i < 4; ++i)
            __builtin_amdgcn_global_load_lds((const unsigned*)(base + voff[i] + ko), (LAS unsigned*)((LAS char*)dyn_lds + ldsoff + (w + 4 * i) * 1024), 16, 0, 0);
    }
    __device__ __forceinline__ void commit(int, int) const {}
};
__device__ __forceinline__ void phase_gemm_f32out(int bid, int nb, const bf16_t* A, const bf16_t* Bt, int N, int K, float* C) {
    const int ntn = N / 128;
    const int tid = tidx(), lane = tid & 63, wid = tid >> 6, wr = wid >> 1, wc = wid & 1, fr = lane & 15, fq = lane >> 4;
    for (int j = 0;; ++j) {
        int tm, tn; if (!dense_unit3(bid, nb, j, ntn, tm, tn)) break;
        Dma3A al; al.set_dense(A, tm * 256, K); Dma3B bl; bl.set(Bt, Bt, tn * 128, K, 1 << 30);
        f32x4 acc[32];
        gemm_core4(al, bl, K / 32, acc);
#pragma unroll
        for (int i = 0; i < 8; ++i)
#pragma unroll
            for (int n = 0; n < 4; ++n) *(f32x4*)(C + (size_t)(tm * 256 + wr * 128 + i * 16 + fr) * N + tn * 128 + wc * 64 + n * 16 + fq * 4) = acc[i * 4 + n];
    }
}
__device__ __forceinline__ void phase_router(int bid, int nb, const P& p, int layer) {
    const int tid = tidx(), lane = tid & 63, wid = tid >> 6, wr = wid >> 1, wc = wid & 1, fr = lane & 15, fq = lane >> 4;
    for (int j = 0;; ++j) {
        int tm, t6; if (!dense_unit3(bid, nb, j, 6, tm, t6)) break;
        const int tn = t6 & 1, part = t6 >> 1;
        Dma3A al; al.set_dense(part == 2 ? p.XAl : p.XAb, tm * 256, DM);
        const bf16_t* wsrc = (part == 1 ? p.WRL : p.WRH) + (size_t)layer * NEXP * DM;
        Dma3B bl; bl.set(wsrc, wsrc, tn * 128, DM, 1 << 30);
        f32x4 acc[32];
        gemm_core4(al, bl, 32, acc);
        float* dst = p.LOG + (size_t)part * NTOK * NEXP;
#pragma unroll
        for (int i = 0; i < 8; ++i)
#pragma unroll
            for (int n = 0; n < 4; ++n) *(f32x4*)(dst + (size_t)(tm * 256 + wr * 128 + i * 16 + fr) * NEXP + tn * 128 + wc * 64 + n * 16 + fq * 4) = acc[i * 4 + n];
    }
}
template <bool AF32, bool SPLIT>
__device__ __forceinline__ void phase_gemm_dense(char* lds, int bid, int nb, const void* A, int lda, const float* W, int ldw, int M, int N, int K, float* C, int ldc) {
    const int ntn = (N + 127) / 128, ntm = M / 128, nk1 = K / 64;
    const int tid = tidx(), lane = tid & 63, wid = tid >> 6, wr = wid >> 1, wc = wid & 1, fr = lane & 15, fq = lane >> 4;
    for (int u = bid; u < ntm * ntn; u += nb) {
        const int tm = u / ntn, tn = u % ntn;
        BLoadF32 bl; { const int nq = tid & 31, kg = tid >> 5; const int col = tn * 128 + nq * 4; bl.valid = col < N; bl.ldb = ldw; bl.nk1 = SPLIT ? nk1 : (1 << 30);
            bl.bp = W + (size_t)(kg * 8) * ldw + (bl.valid ? col : 0); }
        f32x4 acc[4][4];
        if (AF32) {
            ALoadF32S al; al.nk1 = SPLIT ? nk1 : (1 << 30); al.rs32 = (size_t)32 * lda;
            al.rp0 = (const float*)A + (size_t)(tm * 128 + (tid >> 3)) * lda + (tid & 7) * 8;
            gemm_tile(lds, al, bl, SPLIT ? 3 * nk1 : nk1, acc);
        } else {
            ALoadBF16S al; al.rs32 = (size_t)32 * lda;
            al.rp0 = (const bf16_t*)A + (size_t)(tm * 128 + (tid >> 3)) * lda + (tid & 7) * 8;
            gemm_tile(lds, al, bl, nk1, acc);
        }
#pragma unroll
        for (int m = 0; m < 4; ++m)
#pragma unroll
            for (int n = 0; n < 4; ++n) {
                const int row = tm * 128 + wr * 64 + m * 16 + fr, col = tn * 128 + wc * 64 + n * 16 + fq * 4;
                if (col < N) *(f32x4*)(C + (size_t)row * ldc + col) = acc[m][n];
            }
    }
}

__device__ __forceinline__ void ln_row_store(float (&v)[16], const float* g, const float* b, float* of, bf16_t* ob, int row, int lane, bf16_t* ol = nullptr) {
    float s = 0.f;
#pragma unroll
    for (int i = 0; i < 16; ++i) s += v[i];
    const float mu = wave_sum(s) * (1.0f / DM);
    float q = 0.f;
#pragma unroll
    for (int i = 0; i < 16; ++i) { const float d = v[i] - mu; q += d * d; }
    const float rstd = rsqrtf(wave_sum(q) * (1.0f / DM) + LN_EPS);
#pragma unroll
    for (int h = 0; h < 2; ++h) {
        const int c0 = h * 512 + lane * 8;
        float o[8];
#pragma unroll
        for (int i = 0; i < 8; ++i) o[i] = (v[h * 8 + i] - mu) * rstd * g[c0 + i] + b[c0 + i];
        *(f32x4*)(of + (size_t)row * DM + c0) = (f32x4){o[0], o[1], o[2], o[3]};
        *(f32x4*)(of + (size_t)row * DM + c0 + 4) = (f32x4){o[4], o[5], o[6], o[7]};
        if (ob) { u32x4 w; w.x = pack2(o[0], o[1]); w.y = pack2(o[2], o[3]); w.z = pack2(o[4], o[5]); w.w = pack2(o[6], o[7]); *(u32x4*)(ob + (size_t)row * DM + c0) = w;
            if (ol) { float l[8];
#pragma unroll
                for (int i = 0; i < 8; ++i) l[i] = o[i] - bf2f(f2bf(o[i]));
                u32x4 wl; wl.x = pack2(l[0], l[1]); wl.y = pack2(l[2], l[3]); wl.z = pack2(l[4], l[5]); wl.w = pack2(l[6], l[7]); *(u32x4*)(ol + (size_t)row * DM + c0) = wl; } }
    }
}
__device__ __forceinline__ void phase_ln_add(int bid, int nb, const float* res, const float* add, const float* g, const float* b, float* of, bf16_t* ob, bf16_t* ol) {
    const int lane = tidx() & 63, wid = tidx() >> 6;
    for (int row = bid * 4 + wid; row < NTOK; row += nb * 4) {
        float v[16];
#pragma unroll
        for (int h = 0; h < 2; ++h) {
            const size_t o = (size_t)row * DM + h * 512 + lane * 8;
            const f32x4 r0 = *(const f32x4*)(res + o), r1 = *(const f32x4*)(res + o + 4), a0 = *(const f32x4*)(add + o), a1 = *(const f32x4*)(add + o + 4);
#pragma unroll
            for (int i = 0; i < 4; ++i) { v[h * 8 + i] = DN_ALPHA * r0[i] + a0[i]; v[h * 8 + 4 + i] = DN_ALPHA * r1[i] + a1[i]; }
        }
        ln_row_store(v, g, b, of, ob, row, lane, ol);
    }
}

__device__ __forceinline__ void phase_lru_gates(char* lds, int bid, int nb, const P& p) {
    float* xs = (float*)lds;
    const int tid = tidx();
    for (int tok = bid; tok < NTOK; tok += nb) {
        const int t = tok & (SEQ - 1);
        __syncthreads();
#pragma unroll
        for (int cc = 0; cc < 2; ++cc) {
            const int c = tid + 256 * cc;
            float xc = p.conv_b[c];
#pragma unroll
            for (int w = 0; w < 4; ++w) { const int tt = t - 3 + w; if (tt >= 0) xc += p.conv_w[w * 512 + c] * p.U[(size_t)(tok - 3 + w) * EVEN_IN + c]; }
            xs[c] = xc;
        }
        __syncthreads();
#pragma unroll
        for (int cc = 0; cc < 2; ++cc) {
            const int c = tid + 256 * cc, h = c >> 6, j = c & 63;
            float ra = p.ba[c], ri = p.bx[c];
#pragma unroll 8
            for (int i = 0; i < 64; ++i) { const float xv = xs[h * 64 + i]; ra += xv * p.wa[(h * 64 + i) * 64 + j]; ri += xv * p.wx[(h * 64 + i) * 64 + j]; }
            const float r = sigmoidf_(ra), ig = sigmoidf_(ri);
            const float nl = -p.lam[c];
            const float sp = fmaxf(nl, 0.f) + log1pf(expf(-fabsf(nl)));
            const float log_a = -8.0f * r * sp;
            const float a = expf(log_a);
            const float mult = (t == 0) ? 1.0f : sqrtf(-expm1f(2.0f * log_a));
            p.LA[(size_t)tok * 512 + c] = a;
            p.LB[(size_t)tok * 512 + c] = mult * ig * xs[c];
        }
    }
}
__device__ __forceinline__ void phase_lru_scan(int bid, int nb, const P& p) {
    for (int it = bid * 256 + tidx(); it < NBATCH * 512; it += nb * 256) {
        const int b = it >> 9, c = it & 511;
        float h = 0.f;
        for (int t = 0; t < SEQ; ++t) {
            const size_t n = (size_t)b * SEQ + t;
            h = p.LA[n * 512 + c] * h + p.LB[n * 512 + c];
            const float gb = p.U[n * EVEN_IN + 512 + c];
            p.MIX[n * DM + c] = (bf16_t)f2bf(h * gelu_tanh(gb));
        }
    }
}
__device__ __forceinline__ void phase_hgrn_seq(char* lds, int bid, int nb, const P& p) {
    const int tid = tidx(), half = tid >> 7, v = tid & 127;
    float* sq = (float*)lds + half * 512;
    float* sf = sq + 128;
    float* red = sq + 256;
    for (int u0 = bid * 2; u0 < NBATCH * 4; u0 += nb * 2) {
        const int u = u0 + half;
        const int b = u >> 2, h = u & 3;
        const int ch = h * 128 + v;
        float lbv; { const float l0 = p.hg_lb[ch], l1 = p.hg_lb[512 + ch], l2 = p.hg_lb[1024 + ch]; const float mx = fmaxf(l0, fmaxf(l1, l2));
            const float e0 = expf(l0 - mx), e1 = expf(l1 - mx), e2 = expf(l2 - mx); lbv = e0 / (e0 + e1 + e2); }
        const float ng = p.hg_ng[ch];
        float S[128];
#pragma unroll
        for (int k = 0; k < 128; ++k) S[k] = 0.f;
        for (int t = 0; t < SEQ; ++t) {
            const size_t n = (size_t)b * SEQ + t;
            const float* ur = p.U + n * EVEN_IN;
            const float qv = siluf_(ur[1024 + ch]);
            const float f = lbv + (1.0f - lbv) * sigmoidf_(ur[1536 + ch]);
            __syncthreads();
            sq[v] = qv; sf[v] = f;
            __syncthreads();
            const float vv = ur[2048 + ch];
            float o = 0.f;
#pragma unroll
            for (int k = 0; k < 128; ++k) { const float fk = sf[k]; S[k] = fk * S[k] + (1.0f - fk) * vv; o += sq[k] * S[k]; }
            const float ss = wave_sum(o * o);
            if ((tid & 63) == 0) red[(tid >> 6) & 1] = ss;
            __syncthreads();
            const float tot = red[0] + red[1];
            const float y = o * rsqrtf(tot * (1.0f / 128.0f) + 1e-6f) * ng * sigmoidf_(ur[2560 + ch]);
            p.MIX[n * DM + 512 + ch] = (bf16_t)f2bf(y);
        }
        __syncthreads();
    }
}

__device__ __forceinline__ void phase_route(int bid, int nb, const P& p, int layer) {
    const float* br = p.b_router + layer * NEXP;
    const int tid = tidx(), lane = tid & 63, wid = tid >> 6;
    const int gt = bid * 256 + tid, gs = nb * 256;
    for (int i = gt; i < NROWS; i += gs) p.rowtok[i] = (i >= SH_TILE0 * 128) ? (i - SH_TILE0 * 128) : 0;
    const f32x4 bv = *(const f32x4*)(br + lane * 4);
    for (int tb = bid * 4 + wid; tb < NTOK; tb += nb * 4 * 8) {
        int es[8]; float ws[8];
#pragma unroll
        for (int q = 0; q < 8; ++q) {
            const int t = tb + q * nb * 4;
            es[q] = 0; ws[q] = 0.f;
            if (t < NTOK) {
        const f32x4 lg = (*(const f32x4*)(p.LOG + (size_t)t * NEXP + lane * 4) + *(const f32x4*)(p.LOG + (size_t)NTOK * NEXP + (size_t)t * NEXP + lane * 4)) + *(const f32x4*)(p.LOG + (size_t)2 * NTOK * NEXP + (size_t)t * NEXP + lane * 4);
        float sc[4], bs[4];
#pragma unroll
        for (int i = 0; i < 4; ++i) { sc[i] = sigmoidf_(lg[i]); bs[i] = sc[i] + bv[i]; }
        float t1 = fmaxf(bs[0], bs[1]), t2 = fminf(bs[0], bs[1]);
        { const float a = fmaxf(bs[2], bs[3]), c = fminf(bs[2], bs[3]); const float n1 = fmaxf(t1, a); t2 = fmaxf(fminf(t1, a), fmaxf(t2, c)); t1 = n1; }
#pragma unroll
        for (int o = 1; o <= 4; o <<= 1) { const float o1 = __shfl_xor(t1, o), o2 = __shfl_xor(t2, o); const float n1 = fmaxf(t1, o1); t2 = fmaxf(fminf(t1, o1), fmaxf(t2, o2)); t1 = n1; }
        const float gsc = t1 + t2;
        const int g = lane >> 3;
        int rank = 0;
#pragma unroll
        for (int g2 = 0; g2 < 8; ++g2) { const float o = __shfl(gsc, g2 * 8); rank += (o > gsc || (o == gsc && g2 < g)) ? 1 : 0; }
        const bool allowed = rank < 4;
        float cv[4];
#pragma unroll
        for (int i = 0; i < 4; ++i) cv[i] = allowed ? bs[i] : -3e38f;
        float wsel = 0.f; int esel = 0; float wsum = 0.f;
#pragma unroll
        for (int k = 0; k < 8; ++k) {
            float bvv = cv[0]; int bi = 0;
#pragma unroll
            for (int i = 1; i < 4; ++i) if (cv[i] > bvv) { bvv = cv[i]; bi = i; }
            int be = lane * 4 + bi;
#pragma unroll
            for (int o = 1; o <= 32; o <<= 1) { const float ov = __shfl_xor(bvv, o); const int oe = __shfl_xor(be, o); if (ov > bvv || (ov == bvv && oe < be)) { bvv = ov; be = oe; } }
            const int ol = be >> 2, oi = be & 3;
            float sown = 0.f;
#pragma unroll
            for (int i = 0; i < 4; ++i) if (oi == i) sown = sc[i];
            const float sv = __shfl(sown, ol);
            if (lane == ol) {
#pragma unroll
                for (int i = 0; i < 4; ++i) if (oi == i) cv[i] = -3e38f;
            }
            wsum += sv;
            if (lane == k) { wsel = sv; esel = be; }
        }
        es[q] = esel; ws[q] = wsel / wsum * 2.5f;
            }
        }
        int rk[8];
#pragma unroll
        for (int q = 0; q < 8; ++q) { rk[q] = 0; if (lane < 8 && tb + q * nb * 4 < NTOK) rk[q] = atomicAdd(&p.cnt[(bid & 31) * NEXP + es[q]], 1); }
#pragma unroll
        for (int q = 0; q < 8; ++q) { const int t = tb + q * nb * 4; if (lane < 8 && t < NTOK) { p.eidx[t * 8 + lane] = es[q]; p.ew[t * 8 + lane] = ws[q]; p.erank[t * 8 + lane] = rk[q]; } }
    }
}
__device__ __forceinline__ void phase_scatter(char* lds, int bid, int nb, const P& p) {
    int* base = (int*)lds;
    int* pc = base + 260;
    int* so = base + 520;
    const int tid = tidx();
    __syncthreads();
    { int c = 0;
#pragma unroll
      for (int sb = 0; sb < 32; ++sb) { so[sb * 256 + tid] = c; c += p.cnt[sb * NEXP + tid]; }
      pc[tid] = (c + 127) & ~127; }
    __syncthreads();
    { int s = 0; for (int e = 0; e < tid; ++e) s += pc[e]; base[tid] = s; if (tid == 255) base[256] = s + pc[255]; }
    __syncthreads();
    const int tpb = nb * 4;
    for (int a = bid * 256 + tid; a < NTOK * 8; a += nb * 256) {
        const int e = p.eidx[a]; const int t = a >> 3; const int sb = ((t % tpb) >> 2) & 31;
        const int row = base[e] + so[sb * 256 + e] + p.erank[a];
        p.rowtok[row] = t; p.epos[a] = row;
    }
    if (bid == 0) {
        {
            const int xq = tid & 7; int off = 0, tot = 0;
            for (int e = xq; e < 256; e += 8) { const int n = ((pc[e] >> 7) + 1) >> 1; if (e < tid) off += n; tot += n; }
            const int t0 = base[tid] >> 7, nte = pc[tid] >> 7;
            for (int i = 0; i < nte; i += 2) p.plist[xq * 320 + off + (i >> 1)] = (t0 + i) | ((i + 1 < nte) ? 0 : 0x40000000);
            if (tid < 64) { int totp = 0; for (int e = (tid & 7); e < 256; e += 8) totp += ((pc[e] >> 7) + 1) >> 1; p.plist[(tid & 7) * 320 + totp + (tid >> 3)] = SH_TILE0 + 2 * tid; }
            if (tid < 8) p.plen[tid] = tot + 8;
        }
        const int nrt = base[256] >> 7;
        for (int i = tid; i < NTILES; i += 256) if (i >= nrt) p.tile_e[i] = (i >= SH_TILE0) ? NEXP : -1;
        const int t0 = base[tid] >> 7, t1 = base[tid + 1] >> 7;
        for (int i = t0; i < t1; ++i) p.tile_e[i] = tid;
    }
    __syncthreads();
}
__device__ __forceinline__ void phase_moe1(char* lds, int bid, int nb, const P& p, int layer, const bf16_t* Xb) {
    const int tid = tidx(), lane = tid & 63, wid = tid >> 6, wr = wid >> 1, wc = wid & 1, fr = lane & 15, fq = lane >> 4;
    const int xq = bid & 7, plen = p.plen[xq];
    for (int ui = bid >> 3; ui < plen * 4; ui += (nb >> 3)) {
        const int nt = ui & 3;
        const int ent = p.plist[xq * 320 + (ui >> 2)];
        const int tile0 = ent & 0xffff, single = (ent >> 30) & 1, tile1 = single ? tile0 : tile0 + 1;
        const int e = p.tile_e[tile0];
        const float* Wg = (e < NEXP) ? p.w_gate + ((size_t)layer * NEXP + e) * (DM * 256) : p.ws_gate + (size_t)layer * (DM * 256);
        const float* Wu = (e < NEXP) ? p.w_up + ((size_t)layer * NEXP + e) * (DM * 256) : p.ws_up + (size_t)layer * (DM * 256);
        Dma3A al; al.base = (const char*)Xb;
#pragma unroll
        for (int i = 0; i < 4; ++i) { int R, C; dma_rc32(lane, wid + 4 * i, R, C); const int tok = p.rowtok[(R < 128 ? tile0 : tile1) * 128 + (R & 127)]; al.voff[i] = (unsigned)(((size_t)tok * DM + C) * 2); }
        Reg3B bl; { const int nq = tid & 31, kg = tid >> 5; const int j = nq * 4, jw = j & 63, w2 = j >> 6; const int col = nt * 64 + w2 * 32 + (jw & 31);
            bl.ldb = 256; bl.bp = ((jw >= 32) ? Wu : Wg) + (size_t)(kg * 4) * 256 + col; }
        f32x4 acc[32];
        gemm_core4(al, bl, DM / 32, acc, single != 0);
        if (!(wr && single)) {
            const int tile = wr ? tile1 : tile0;
#pragma unroll
            for (int i = 0; i < 8; ++i)
#pragma unroll
                for (int n = 0; n < 2; ++n) {
                    const int row = tile * 128 + i * 16 + fr, col = nt * 64 + wc * 32 + n * 16 + fq * 4;
                    const f32x4 g = acc[i * 4 + n], uu = acc[i * 4 + n + 2];
                    u32x2 w; w.x = pack2(siluf_(g[0]) * uu[0], siluf_(g[1]) * uu[1]); w.y = pack2(siluf_(g[2]) * uu[2], siluf_(g[3]) * uu[3]);
                    *(u32x2*)(p.H + (size_t)row * 256 + col) = w;
                }
        }
    }
}
__device__ __forceinline__ void phase_moe2(char* lds, int bid, int nb, const P& p, int layer) {
    const int tid = tidx(), lane = tid & 63, wid = tid >> 6, wr = wid >> 1, wc = wid & 1, fr = lane & 15, fq = lane >> 4;
    const int xq = bid & 7, plen = p.plen[xq];
    for (int ui = bid >> 3; ui < plen * 8; ui += (nb >> 3)) {
        const int nt = ui & 7;
        const int ent = p.plist[xq * 320 + (ui >> 3)];
        const int tile0 = ent & 0xffff, single = (ent >> 30) & 1, tile1 = single ? tile0 : tile0 + 1;
        const int e = p.tile_e[tile0];
        const float* Wd = (e < NEXP) ? p.w_down + ((size_t)layer * NEXP + e) * (256 * DM) : p.ws_down + (size_t)layer * (256 * DM);
        Dma3A al; al.base = (const char*)p.H;
#pragma unroll
        for (int i = 0; i < 4; ++i) { int R, C; dma_rc32(lane, wid + 4 * i, R, C); al.voff[i] = (unsigned)(((size_t)((R < 128 ? tile0 : tile1) * 128 + (R & 127)) * 256 + C) * 2); }
        Reg3B bl; { const int nq = tid & 31, kg = tid >> 5; bl.ldb = DM; bl.bp = Wd + (size_t)(kg * 4) * DM + nt * 128 + nq * 4; }
        f32x4 acc[32];
        gemm_core4(al, bl, 256 / 32, acc, single != 0);
        if (!(wr && single)) {
            const int tile = wr ? tile1 : tile0;
#pragma unroll
            for (int i = 0; i < 8; ++i)
#pragma unroll
                for (int n = 0; n < 4; ++n) {
                    const int row = tile * 128 + i * 16 + fr, col = nt * 128 + wc * 64 + n * 16 + fq * 4;
                    const f32x4 a = acc[i * 4 + n];
                    u32x2 w; w.x = pack2(a[0], a[1]); w.y = pack2(a[2], a[3]);
                    *(u32x2*)(p.Y + (size_t)row * DM + col) = w;
                }
        }
    }
}
__device__ __forceinline__ void phase_combine_ln(int bid, int nb, const P& p, const float* X, const float* g, const float* b, float* of, bf16_t* ob) {
    const int lane = tidx() & 63, wid = tidx() >> 6;
    int row = bid * 4 + wid;
    int npos = 0; float nw = 0.f;
    if (row < NTOK && lane < 8) { npos = p.epos[row * 8 + lane]; nw = p.ew[row * 8 + lane]; }
    for (; row < NTOK; row += nb * 4) {
        const int cpos = npos; const float cw = nw;
        { const int nr = row + nb * 4; if (nr < NTOK && lane < 8) { npos = p.epos[nr * 8 + lane]; nw = p.ew[nr * 8 + lane]; } }
        float v[16];
#pragma unroll
        for (int h = 0; h < 2; ++h) {
            const size_t o = (size_t)row * DM + h * 512 + lane * 8;
            const f32x4 r0 = *(const f32x4*)(X + o), r1 = *(const f32x4*)(X + o + 4);
#pragma unroll
            for (int i = 0; i < 4; ++i) { v[h * 8 + i] = DN_ALPHA * r0[i]; v[h * 8 + 4 + i] = DN_ALPHA * r1[i]; }
        }
#pragma unroll
        for (int k = 0; k < 9; ++k) {
            const int yr = (k < 8) ? __shfl(cpos, k) : (SH_TILE0 * 128 + row);
            const float w = (k < 8) ? __shfl(cw, k) : 1.0f;
#pragma unroll
            for (int h = 0; h < 2; ++h) {
                const u32x4 y = *(const u32x4*)(p.Y + (size_t)yr * DM + h * 512 + lane * 8);
                v[h * 8 + 0] += w * bf2f(y.x & 0xffffu); v[h * 8 + 1] += w * bf2f(y.x >> 16);
                v[h * 8 + 2] += w * bf2f(y.y & 0xffffu); v[h * 8 + 3] += w * bf2f(y.y >> 16);
                v[h * 8 + 4] += w * bf2f(y.z & 0xffffu); v[h * 8 + 5] += w * bf2f(y.z >> 16);
                v[h * 8 + 6] += w * bf2f(y.w & 0xffffu); v[h * 8 + 7] += w * bf2f(y.w >> 16);
            }
        }
        ln_row_store(v, g, b, of, ob, row, lane);
    }
}

__device__ __forceinline__ void phase_nsa_compress(char* lds, int bid, int nb, const P& p) {
    float* blk = (float*)lds;
    float* hs = blk + 4096;
    const int tid = tidx(), which = tid >> 7, j = tid & 127;
    const float* pe = which ? p.pe_v : p.pe_k; const float* w1 = which ? p.wv1 : p.wk1; const float* w2 = which ? p.wv2 : p.wk2;
    float* outp = which ? p.VC : p.KC;
    for (int u = bid; u < 16 * 127; u += nb) {
        const int bg = u / 127, c = u % 127, b = bg >> 1, g = bg & 1;
        __syncthreads();
        for (int i = j; i < 2048; i += 128) { const int l = i >> 6, d = i & 63; blk[which * 2048 + i] = p.KCV[(size_t)(b * SEQ + 16 * c + l) * 256 + which * 128 + g * 64 + d] + pe[i]; }
        __syncthreads();
        float a = 0.f;
        for (int i = 0; i < 2048; ++i) a += blk[which * 2048 + i] * w1[i * 128 + j];
        hs[which * 128 + j] = gelu_tanh(a);
        __syncthreads();
        if (j < 64) { float o = 0.f; for (int i = 0; i < 128; ++i) o += hs[which * 128 + i] * w2[i * 64 + j]; outp[(size_t)(bg * 127 + c) * 64 + j] = o; }
    }
}
__device__ __forceinline__ void phase_moba_kmean(int bid, int nb, const P& p) {
    const int tid = tidx();
    for (int u = (nb >= 256 ? bid - 128 : bid); u < NBATCH * 8; u += nb) {
        if (u < 0) continue;
        const int b = u >> 3, j = u & 7;
        const bf16_t* src = p.MK + (size_t)(b * SEQ + j * 256) * 512 + tid * 2;
        float s0 = 0.f, s1 = 0.f;
        for (int r8 = 0; r8 < 256; r8 += 8) {
            unsigned v[8];
#pragma unroll
            for (int i = 0; i < 8; ++i) v[i] = *(const unsigned*)(src + (size_t)(r8 + i) * 512);
#pragma unroll
            for (int i = 0; i < 8; ++i) { s0 += bf2f(v[i] & 0xffffu); s1 += bf2f(v[i] >> 16); }
        }
        const int h = tid >> 5, d = (tid & 31) * 2;
        p.KM[((size_t)(b * 8 + h) * 8 + j) * 64 + d] = s0 * (1.0f / 256.0f);
        p.KM[((size_t)(b * 8 + h) * 8 + j) * 64 + d + 1] = s1 * (1.0f / 256.0f);
    }
}
#define CMP_LDS ((127 * 65 + 127 * 64 + 4 * (64 + 128 + 128)) * 4)
__device__ __forceinline__ void phase_nsa_cmp(char* lds, int bid, int nb, const P& p) {
    float* kc = (float*)lds;
    float* vc = kc + 127 * 65;
    const int tid = tidx(), lane = tid & 63, wid = tid >> 6;
    float* qs = vc + 127 * 64 + wid * 320;
    float* ps = qs + 64;
    float* pp = ps + 128;
    for (int u = bid; u < 16 * 32; u += nb) {
        const int bg = u >> 5, tb = u & 31, b = bg >> 1, g = bg & 1;
        __syncthreads();
        for (int i = tid; i < 127 * 64; i += 256) { const int c = i >> 6, d = i & 63; kc[c * 65 + d] = p.KC[(size_t)bg * 127 * 64 + i]; vc[i] = p.VC[(size_t)bg * 127 * 64 + i]; }
        __syncthreads();
        for (int qi = 0; qi < 16; ++qi) {
            const int t = tb * 64 + wid * 16 + qi;
            const size_t n = (size_t)b * SEQ + t;
            float psum0 = 0.f, psum1 = 0.f;
            for (int i = 0; i < 4; ++i) {
                const int hd = g * 4 + i;
                const float slope = exp2f(-((float)hd + 0.5f));
                qs[lane] = bf2f(p.Qb[n * 512 + hd * 64 + lane]);
                __builtin_amdgcn_wave_barrier();
                float s0 = NEGF, s1 = NEGF;
                const int c0 = lane, c1 = lane + 64;
                const bool v0 = (16 * c0 + 31 <= t), v1 = (c1 < 127) && (16 * c1 + 31 <= t);
                if (v0) { float d = 0.f; for (int k = 0; k < 64; ++k) d += qs[k] * kc[c0 * 65 + k]; s0 = d * 0.125f - slope * (float)(t - (16 * c0 + 31)); }
                if (v1) { float d = 0.f; for (int k = 0; k < 64; ++k) d += qs[k] * kc[c1 * 65 + k]; s1 = d * 0.125f - slope * (float)(t - (16 * c1 + 31)); }
                const float m = wave_max(fmaxf(s0, s1));
                float p0 = v0 ? __expf(s0 - m) : 0.f, p1 = v1 ? __expf(s1 - m) : 0.f;
                const float den = fmaxf(wave_sum(p0 + p1), 1e-30f);
                p0 /= den; p1 /= den;
                psum0 += p0; psum1 += p1;
                ps[c0] = p0; ps[c1] = p1;
                __builtin_amdgcn_wave_barrier();
                float o = 0.f;
                for (int c = 0; c < 127; ++c) o += ps[c] * vc[c * 64 + lane];
                p.OC[n * 512 + hd * 64 + lane] = o;
                __builtin_amdgcn_wave_barrier();
            }
            pp[lane] = psum0; pp[lane + 64] = psum1;
            __builtin_amdgcn_wave_barrier();
            const int j = lane & 31, own = t >> 6;
            float imp = 0.f;
#pragma unroll
            for (int c = 4 * j - 1; c <= 4 * j + 3; ++c) if (c >= 0 && c < 127) imp += pp[c];
            const bool forced = (j == 0) || (j == own) || (j == own - 1);
            const bool valid = j <= own;
            const float val = valid ? (imp + (forced ? 1e4f : 0.f)) : NEGF;
            int rank = 0;
            for (int j2 = 0; j2 < 32; ++j2) { const float o2 = __shfl(val, j2); rank += (o2 > val || (o2 == val && j2 < j)) ? 1 : 0; }
            const unsigned long long bal = __ballot(valid && rank < 16 && lane < 32);
            if (lane == 0) p.SELM[(size_t)bg * SEQ + t] = (unsigned)bal;
            __builtin_amdgcn_wave_barrier();
        }
    }
}
struct AttnState { float m, l, o; };
__device__ __forceinline__ void attn_block(AttnState& st, const float* qs, float* ps, const float* Kb, const float* Vb, int s0, int t, float slope, bool lanevalid) {
    const int lane = tidx() & 63;
    float sc = NEGF;
    if (lanevalid) {
        const float* kr = Kb + (size_t)lane * ODD_IN;
        float d = 0.f;
#pragma unroll
        for (int k = 0; k < 64; k += 4) { const f32x4 kv = *(const f32x4*)(kr + k); d += kv[0] * qs[k] + kv[1] * qs[k + 1] + kv[2] * qs[k + 2] + kv[3] * qs[k + 3]; }
        sc = d * 0.125f - slope * (float)(t - (s0 + lane));
    }
    const float mn = fmaxf(st.m, wave_max(sc));
    const float pr = lanevalid ? __expf(sc - mn) : 0.f;
    const float corr = __expf(st.m - mn);
    st.l = st.l * corr + wave_sum(pr);
    __builtin_amdgcn_wave_barrier();
    ps[lane] = pr;
    __builtin_amdgcn_wave_barrier();
    float acc = 0.f;
    for (int s = 0; s < 64; ++s) acc += ps[s] * Vb[(size_t)s * ODD_IN + lane];
    st.o = st.o * corr + acc; st.m = mn;
    __builtin_amdgcn_wave_barrier();
}
__device__ __forceinline__ void phase_nsa_attn(char* lds, int bid, int nb, const P& p) {
    const int tid = tidx(), lane = tid & 63, wid = tid >> 6;
    float* qs = (float*)lds + wid * 128; float* ps = qs + 64;
    for (int it = bid * 4 + wid; it < NTOK * 8; it += nb * 4) {
        const int hd = it & 7; const int n = it >> 3; const int b = n >> 11, t = n & (SEQ - 1), g = hd >> 2;
        const float slope = exp2f(-((float)hd + 0.5f));
        __builtin_amdgcn_wave_barrier();
        qs[lane] = p.U[(size_t)n * ODD_IN + hd * 64 + lane];
        __builtin_amdgcn_wave_barrier();
        const unsigned mask = p.SELM[(size_t)(b * 2 + g) * SEQ + t];
        const int own = t >> 6;
        AttnState ss; ss.m = NEGF; ss.l = 0.f; ss.o = 0.f;
        for (int j = 0; j <= own; ++j) if ((mask >> j) & 1u) {
            const float* base = p.U + (size_t)(b * SEQ + j * 64) * ODD_IN + g * 64;
            attn_block(ss, qs, ps, base + 768, base + 896, j * 64, t, slope, (j * 64 + lane) <= t);
        }
        AttnState sw; sw.m = NEGF; sw.l = 0.f; sw.o = 0.f;
        const int jb0 = (t >= 511) ? ((t - 511) >> 6) : 0;
        for (int j = jb0; j <= own; ++j) {
            const float* base = p.U + (size_t)(b * SEQ + j * 64) * ODD_IN + g * 64;
            const int s = j * 64 + lane;
            attn_block(sw, qs, ps, base + 1024, base + 1152, j * 64, t, slope, (s <= t) && (t - s < 512));
        }
        const float os = ss.o / fmaxf(ss.l, 1e-30f), ow = sw.o / fmaxf(sw.l, 1e-30f);
        const float oc = p.OC[(size_t)n * 512 + hd * 64 + lane];
        const float* gp = p.U + (size_t)n * ODD_IN + 1280 + hd * 3;
        const float y = sigmoidf_(gp[0]) * oc + sigmoidf_(gp[1]) * os + sigmoidf_(gp[2]) * ow;
        p.MIX[(size_t)n * DM + hd * 64 + lane] = (bf16_t)f2bf(y);
    }
}
__device__ __forceinline__ void phase_moba_attn(char* lds, int bid, int nb, const P& p) {
    const int tid = tidx(), lane = tid & 63, wid = tid >> 6;
    float* qs = (float*)lds + wid * 128; float* ps = qs + 64;
    for (int it = bid * 4 + wid; it < NTOK * 8; it += nb * 4) {
        const int hd = it & 7; const int n = it >> 3; const int b = n >> 11, t = n & (SEQ - 1);
        const float slope = exp2f(-((float)hd + 1.0f));
        const float qv = p.U[(size_t)n * ODD_IN + 1304 + hd * 64 + lane];
        __builtin_amdgcn_wave_barrier();
        qs[lane] = qv;
        __builtin_amdgcn_wave_barrier();
        const int ob = t >> 8;
        float gate[8];
#pragma unroll
        for (int j = 0; j < 8; ++j) gate[j] = (j < ob) ? wave_sum(qv * p.KM[((size_t)(b * 8 + hd) * 8 + j) * 64 + lane]) : NEGF;
        unsigned selm = 0;
#pragma unroll
        for (int j = 0; j < 8; ++j) {
            int rank = 0;
#pragma unroll
            for (int j2 = 0; j2 < 8; ++j2) rank += (gate[j2] > gate[j] || (gate[j2] == gate[j] && j2 < j)) ? 1 : 0;
            if (j < ob && rank < 3) selm |= 1u << j;
        }
        AttnState st; st.m = NEGF; st.l = 0.f; st.o = 0.f;
        for (int j = 0; j < ob; ++j) if ((selm >> j) & 1u) {
            for (int sb = 0; sb < 4; ++sb) {
                const float* base = p.U + (size_t)(b * SEQ + j * 256 + sb * 64) * ODD_IN + hd * 64;
                attn_block(st, qs, ps, base + 1816, base + 2328, j * 256 + sb * 64, t, slope, true);
            }
        }
        for (int sb = 0; sb <= ((t & 255) >> 6); ++sb) {
            const float* base = p.U + (size_t)(b * SEQ + ob * 256 + sb * 64) * ODD_IN + hd * 64;
            attn_block(st, qs, ps, base + 1816, base + 2328, ob * 256 + sb * 64, t, slope, (ob * 256 + sb * 64 + lane) <= t);
        }
        p.MIX[(size_t)n * DM + 512 + hd * 64 + lane] = (bf16_t)f2bf(st.o / fmaxf(st.l, 1e-30f));
    }
}


__device__ __forceinline__ void gemm_t_unit(const bf16_t* Wt, int wrow0, const bf16_t* X, int tok0, bf16_t* dst, int ncol, int col0) {
    const int tid = tidx(), lane = tid & 63, wid = tid >> 6, wr = wid >> 1, wc = wid & 1, fr = lane & 15, fq = lane >> 4;
    Dma3A al; al.set_dense(Wt, wrow0, DM); Dma3B bl; bl.set(X, X, tok0, DM, 1 << 30);
    f32x4 acc[32];
    gemm_core4(al, bl, DM / 32, acc);
#pragma unroll
    for (int i = 0; i < 8; ++i)
#pragma unroll
        for (int n = 0; n < 4; ++n) {
            const int vc = col0 + wr * 128 + i * 16 + fr, r0 = tok0 + wc * 64 + n * 16 + fq * 4;
            const int b = r0 >> 11, t0 = r0 & (SEQ - 1);
            const f32x4 a = acc[i * 4 + n];
            u32x2 w; w.x = pack2(a[0], a[1]); w.y = pack2(a[2], a[3]);
            *(u32x2*)(dst + ((size_t)(b * ncol + vc)) * SEQ + t0) = w;
        }
}
__device__ __forceinline__ void phase_inproj0(char* lds, int bid, int nb, const P& p) {
    const int ntn = 20, nk = DM / 32;
    const int tid = tidx(), lane = tid & 63, wid = tid >> 6, wr = wid >> 1, wc = wid & 1, fr = lane & 15, fq = lane >> 4;
    for (int i = bid * 256 + tid; i < 2 * 8 * 64 * 64; i += nb * 256) {
        const int which = i >> 15, e = i & 32767, h = e >> 12, j = (e >> 6) & 63, ii = e & 63;
        const float v = (which ? p.wx : p.wa)[(h * 64 + ii) * 64 + j];
        (which ? p.WXT : p.WAT)[e] = (bf16_t)f2bf(v);
    }
    for (int jj = 0;; ++jj) {
        int tm, tn; if (!dense_unit3(bid, nb, jj, ntn, tm, tn)) break;
        Dma3A al; al.set_dense(p.XIb, tm * 256, DM); Dma3B bl; bl.set(p.WIN0, p.WIN0, tn * 128, DM, 1 << 30);
        f32x4 acc[32];
        gemm_core4(al, bl, nk, acc);
#pragma unroll
        for (int i = 0; i < 8; ++i)
#pragma unroll
            for (int n = 0; n < 4; ++n) {
                const int row = tm * 256 + wr * 128 + i * 16 + fr, col = tn * 128 + wc * 64 + n * 16 + fq * 4;
                const f32x4 a = acc[i * 4 + n];
                u32x2 w; w.x = pack2(a[0], a[1]); w.y = pack2(a[2], a[3]);
                *(u32x2*)(p.UB0 + (size_t)row * 2560 + col) = w;
            }
    }
    for (int u = (nb >= 512 ? bid - 256 : bid); u < 2 * 128; u += nb) { if (u < 0) continue; const int pn = u & 1, tt = u >> 1; gemm_t_unit(p.WIN0, 2560 + pn * 256, p.XIb, tt * 128, p.VHt, 512, pn * 256); }
}

__device__ __forceinline__ int lds_off128(int r, int c) {
    const int st = (r >> 4) * 4 + (c >> 5), ob = (r & 15) * 64 + (c & 31) * 2;
    return st * 1024 + (ob ^ (((ob >> 9) & 1) << 5));
}
__device__ __forceinline__ float softplusf_(float x) { return fmaxf(x, 0.f) + log1pf(__expf(-fabsf(x))); }

#define LRU1_LDS (4 * 8192)
__device__ __forceinline__ void lru1_unit(char* lds, const P& p, int b, int ck, int half) {
    const int tid = tidx(), lane = tid & 63, w = tid >> 6, fr = lane & 15, fg = lane >> 4;
    char* xt = lds + w * 8192;
    const size_t n0 = (size_t)b * SEQ + ck * 64;
    __syncthreads();
    {
        const int h = half * 4 + w, c = h * 64 + lane;
        const float cw0 = p.conv_w[c], cw1 = p.conv_w[512 + c], cw2 = p.conv_w[1024 + c], cw3 = p.conv_w[1536 + c], cb = p.conv_b[c];
        float xm3 = 0.f, xm2 = 0.f, xm1 = 0.f;
        if (ck > 0) { xm3 = bf2f(p.UB0[(n0 - 3) * 2560 + c]); xm2 = bf2f(p.UB0[(n0 - 2) * 2560 + c]); xm1 = bf2f(p.UB0[(n0 - 1) * 2560 + c]); }
        __builtin_amdgcn_wave_barrier();
        for (int t16 = 0; t16 < 64; t16 += 16) {
            bf16_t raw[16];
#pragma unroll
            for (int i = 0; i < 16; ++i) raw[i] = p.UB0[(n0 + t16 + i) * 2560 + c];
#pragma unroll
            for (int i = 0; i < 16; ++i) {
                const float x = bf2f(raw[i]);
                const float xc = cb + cw0 * xm3 + cw1 * xm2 + cw2 * xm1 + cw3 * x;
                xm3 = xm2; xm2 = xm1; xm1 = x;
                *(bf16_t*)(xt + lds_off(t16 + i, lane & ~7) + (lane & 7) * 2) = (bf16_t)f2bf(xc);
            }
        }
        __builtin_amdgcn_wave_barrier();
        for (int jt = 0; jt < 4; ++jt) {
            const int cj = h * 64 + jt * 16 + fr;
            bf16x8 wra[2], wri[2];
#pragma unroll
            for (int ks = 0; ks < 2; ++ks) {
                wra[ks] = *(const bf16x8*)(p.WAT + (size_t)(h * 64 + jt * 16 + fr) * 64 + ks * 32 + fg * 8);
                wri[ks] = *(const bf16x8*)(p.WXT + (size_t)(h * 64 + jt * 16 + fr) * 64 + ks * 32 + fg * 8);
            }
            const float bav = p.ba[cj], bxv = p.bx[cj], sp = softplusf_(-p.lam[cj]);
            float mA = 1.f, mB = 0.f;
#pragma unroll
            for (int tt = 0; tt < 4; ++tt) {
                const bf16x8 a0 = *(const bf16x8*)(xt + lds_off(tt * 16 + fr, fg * 8)), a1 = *(const bf16x8*)(xt + lds_off(tt * 16 + fr, 32 + fg * 8));
                f32x4 ar = __builtin_amdgcn_mfma_f32_16x16x32_bf16(a0, wra[0], (f32x4){0.f, 0.f, 0.f, 0.f}, 0, 0, 0);
                ar = __builtin_amdgcn_mfma_f32_16x16x32_bf16(a1, wra[1], ar, 0, 0, 0);
                f32x4 ai = __builtin_amdgcn_mfma_f32_16x16x32_bf16(a0, wri[0], (f32x4){0.f, 0.f, 0.f, 0.f}, 0, 0, 0);
                ai = __builtin_amdgcn_mfma_f32_16x16x32_bf16(a1, wri[1], ai, 0, 0, 0);
                float sA = 1.f, sB = 0.f;
#pragma unroll
                for (int r = 0; r < 4; ++r) {
                    const int t = tt * 16 + fg * 4 + r;
                    const float rg = sigmoidf_(ar[r] + bav), ig = sigmoidf_(ai[r] + bxv);
                    const float log_a = -8.0f * rg * sp;
                    const float a = __expf(log_a);
                    const float mult = (ck == 0 && t == 0) ? 1.0f : sqrtf(fmaxf(1.0f - a * a, 0.f));
                    const int jj = jt * 16 + fr;
                    const float xcv = bf2f(*(const bf16_t*)(xt + lds_off(t, jj & ~7) + (jj & 7) * 2));
                    const float bt = mult * ig * xcv;
                    p.LA[(n0 + t) * 512 + cj] = a; p.LB[(n0 + t) * 512 + cj] = bt;
                    sB = a * sB + bt; sA = a * sA;
                }
                float tA = 1.f, tB = 0.f;
#pragma unroll
                for (int g2 = 0; g2 < 4; ++g2) {
                    const float oA = __shfl(sA, g2 * 16 + fr), oB = __shfl(sB, g2 * 16 + fr);
                    tB = oA * tB + oB; tA = oA * tA;
                }
                mB = tA * mB + tB; mA = tA * mA;
            }
            if (fg == 0) { p.CSA[((size_t)b * 32 + ck) * 512 + cj] = mA; p.CSB[((size_t)b * 32 + ck) * 512 + cj] = mB; }
        }
        __builtin_amdgcn_wave_barrier();
    }
}
__device__ __forceinline__ void lru2_unit(const P& p, int b, int ck, int half) {
    const int tid = tidx();
    const size_t n0 = (size_t)b * SEQ + ck * 64;
    {
        const int c = tid + 256 * half;
        float h = 0.f;
        for (int c8 = 0; c8 < ck; c8 += 8) {
            float ca[8], cb[8];
#pragma unroll
            for (int i = 0; i < 8; ++i) { const bool ok = c8 + i < ck; ca[i] = ok ? p.CSA[((size_t)b * 32 + c8 + i) * 512 + c] : 1.f; cb[i] = ok ? p.CSB[((size_t)b * 32 + c8 + i) * 512 + c] : 0.f; }
#pragma unroll
            for (int i = 0; i < 8; ++i) h = ca[i] * h + cb[i];
        }
        for (int t8 = 0; t8 < 64; t8 += 8) {
            float la[8], lb[8], gb[8];
#pragma unroll
            for (int i = 0; i < 8; ++i) { la[i] = p.LA[(n0 + t8 + i) * 512 + c]; lb[i] = p.LB[(n0 + t8 + i) * 512 + c]; gb[i] = bf2f(p.UB0[(n0 + t8 + i) * 2560 + 512 + c]); }
#pragma unroll
            for (int i = 0; i < 8; ++i) { h = la[i] * h + lb[i]; p.MIX[(n0 + t8 + i) * DM + c] = (bf16_t)f2bf(h * gelu_tanh(gb[i])); }
        }
    }
}

#define HG1_LDS (2 * 16384)
__device__ __forceinline__ float hg_lb(const P& p, int ch) {
    const float l0 = p.hg_lb[ch], l1 = p.hg_lb[512 + ch], l2 = p.hg_lb[1024 + ch]; const float mx = fmaxf(l0, fmaxf(l1, l2));
    const float e0 = __expf(l0 - mx), e1 = __expf(l1 - mx), e2 = __expf(l2 - mx); return e0 / (e0 + e1 + e2);
}
__device__ __forceinline__ void hg1_unit(char* lds, const P& p, int b, int h, int ck) {
    const int tid = tidx(), lane = tid & 63, w = tid >> 6, fr = lane & 15, fg = lane >> 4;
    char* kh = lds;
    char* vt = lds + 16384;
    const size_t n0 = (size_t)b * SEQ + ck * 64;
    const int bhc = (b * 4 + h) * 32 + ck;
    __syncthreads();
    if (tid < 128) {
        const int k = tid, ch = h * 128 + k;
        const float lbv = hg_lb(p, ch);
        float cl = 0.f;
        for (int t16 = 0; t16 < 64; t16 += 16) {
            bf16_t raw[16];
#pragma unroll
            for (int i = 0; i < 16; ++i) raw[i] = p.UB0[(n0 + t16 + i) * 2560 + 1536 + ch];
#pragma unroll
            for (int i = 0; i < 16; ++i) { const float f = lbv + (1.0f - lbv) * sigmoidf_(bf2f(raw[i])); cl += __logf(f); }
        }
        p.DV[(size_t)bhc * 128 + k] = __expf(cl);
        float cum = 0.f;
        for (int t8 = 0; t8 < 64; t8 += 8) {
            float kv[8]; bf16_t raw[8];
#pragma unroll
            for (int i = 0; i < 8; ++i) raw[i] = p.UB0[(n0 + t8 + i) * 2560 + 1536 + ch];
#pragma unroll
            for (int i = 0; i < 8; ++i) { const float f = lbv + (1.0f - lbv) * sigmoidf_(bf2f(raw[i])); cum += __logf(f); kv[i] = (1.0f - f) * __expf(cl - cum); }
            u32x4 wv; wv.x = pack2(kv[0], kv[1]); wv.y = pack2(kv[2], kv[3]); wv.z = pack2(kv[4], kv[5]); wv.w = pack2(kv[6], kv[7]);
            *(u32x4*)(kh + lds_off(k, t8)) = wv;
        }
    } else {
        const int q = tid - 128;
#pragma unroll
        for (int i = 0; i < 8; ++i) { const int pc = q + 128 * i, v = pc >> 3, c8 = pc & 7;
            *(u32x4*)(vt + lds_off(v, c8 * 8)) = *(const u32x4*)(p.VHt + ((size_t)(b * 512 + h * 128 + v)) * SEQ + ck * 64 + c8 * 8); }
    }
    __syncthreads();
    bf16_t* ut = p.UT + (size_t)bhc * 16384;
#pragma unroll
    for (int kk = 0; kk < 2; ++kk) {
        const int kt = w * 2 + kk;
        const bf16x8 a0 = *(const bf16x8*)(kh + lds_off(kt * 16 + fr, fg * 8)), a1 = *(const bf16x8*)(kh + lds_off(kt * 16 + fr, 32 + fg * 8));
#pragma unroll
        for (int v8 = 0; v8 < 8; ++v8) {
            const bf16x8 b0 = *(const bf16x8*)(vt + lds_off(v8 * 16 + fr, fg * 8)), b1 = *(const bf16x8*)(vt + lds_off(v8 * 16 + fr, 32 + fg * 8));
            f32x4 acc = __builtin_amdgcn_mfma_f32_16x16x32_bf16(a0, b0, (f32x4){0.f, 0.f, 0.f, 0.f}, 0, 0, 0);
            acc = __builtin_amdgcn_mfma_f32_16x16x32_bf16(a1, b1, acc, 0, 0, 0);
            u32x2 wv; wv.x = pack2(acc[0], acc[1]); wv.y = pack2(acc[2], acc[3]);
            *(u32x2*)(ut + (size_t)(v8 * 16 + fr) * 128 + kt * 16 + fg * 4) = wv;
        }
    }
}
__device__ __forceinline__ void phase_hg2(int bid, int nb, const P& p) {
    for (int it = bid * 256 + tidx(); it < 32 * 4096; it += nb * 256) {
        const int bh = it >> 12, e4 = (it & 4095) * 4, k4 = e4 & 127;
        float S0 = 0.f, S1 = 0.f, S2 = 0.f, S3 = 0.f;
        for (int c8 = 0; c8 < 32; c8 += 8) {
            u32x2 uv[8]; f32x4 dv[8];
#pragma unroll
            for (int i = 0; i < 8; ++i) { uv[i] = *(const u32x2*)(p.UT + ((size_t)(bh * 32 + c8 + i)) * 16384 + e4); dv[i] = *(const f32x4*)(p.DV + (size_t)(bh * 32 + c8 + i) * 128 + k4); }
#pragma unroll
            for (int i = 0; i < 8; ++i) {
                u32x2 wv; wv.x = pack2(S0, S1); wv.y = pack2(S2, S3);
                *(u32x2*)(p.SP + ((size_t)(bh * 32 + c8 + i)) * 16384 + e4) = wv;
                S0 = dv[i][0] * S0 + bf2f(uv[i].x & 0xffffu); S1 = dv[i][1] * S1 + bf2f(uv[i].x >> 16);
                S2 = dv[i][2] * S2 + bf2f(uv[i].y & 0xffffu); S3 = dv[i][3] * S3 + bf2f(uv[i].y >> 16);
            }
        }
    }
}
#define HG3_QP 0
#define HG3_KP 40960
#define HG3_VT (40960 + 16384)
#define HG3_LDS (40960 + 16384 + 128 * 144)
__device__ __forceinline__ int hg3_qp_base(int j) { return j == 0 ? 0 : (j == 1 ? 16384 : (j == 2 ? 28672 : 36864)); }
__device__ __forceinline__ void hg3_unit(char* lds, const P& p, int b, int h, int ck) {
    const int tid = tidx(), lane = tid & 63, w = tid >> 6, fr = lane & 15, fg = lane >> 4;
    char* qp = lds + HG3_QP; char* kp = lds + HG3_KP; char* vt = lds + HG3_VT;
    const size_t n0 = (size_t)b * SEQ + ck * 64;
    const int bhc = (b * 4 + h) * 32 + ck;
    __syncthreads();
    if (tid < 128) {
        const int k = tid, ch = h * 128 + k;
        const float lbv = hg_lb(p, ch);
        const int ke = (k & 7) * 2, k8 = k & ~7;
        float cum = 0.f, r1 = 0.f, r2 = 0.f, r3 = 0.f;
#pragma unroll
        for (int i = 0; i < 4; ++i) {
            bf16_t rq[16], rf[16];
#pragma unroll
            for (int tt = 0; tt < 16; ++tt) { rq[tt] = p.UB0[(n0 + i * 16 + tt) * 2560 + 1024 + ch]; rf[tt] = p.UB0[(n0 + i * 16 + tt) * 2560 + 1536 + ch]; }
#pragma unroll
            for (int tt = 0; tt < 16; ++tt) {
                const int t = i * 16 + tt;
                const float qv = siluf_(bf2f(rq[tt]));
                const float f = lbv + (1.0f - lbv) * sigmoidf_(bf2f(rf[tt]));
                cum += __logf(f);
                const float ri = (i == 0) ? 0.f : (i == 1 ? r1 : (i == 2 ? r2 : r3));
                *(bf16_t*)(kp + lds_off128(t, k8) + ke) = (bf16_t)f2bf((1.0f - f) * __expf(fminf(ri - cum, 80.0f)));
                *(bf16_t*)(qp + hg3_qp_base(0) + lds_off128(t, k8) + ke) = (bf16_t)f2bf(qv * __expf(cum));
                if (i >= 1) *(bf16_t*)(qp + hg3_qp_base(1) + lds_off128(t - 16, k8) + ke) = (bf16_t)f2bf(qv * __expf(cum - r1));
                if (i >= 2) *(bf16_t*)(qp + hg3_qp_base(2) + lds_off128(t - 32, k8) + ke) = (bf16_t)f2bf(qv * __expf(cum - r2));
                if (i >= 3) *(bf16_t*)(qp + hg3_qp_base(3) + lds_off128(t - 48, k8) + ke) = (bf16_t)f2bf(qv * __expf(cum - r3));
            }
            if (i == 0) r1 = cum; if (i == 1) r2 = cum; if (i == 2) r3 = cum;
        }
    } else {
        const int q = tid - 128;
#pragma unroll
        for (int i = 0; i < 8; ++i) { const int pc = q + 128 * i, v = pc >> 3, c8 = pc & 7;
            *(u32x4*)(vt + v * 144 + c8 * 16) = *(const u32x4*)(p.VHt + ((size_t)(b * 512 + h * 128 + v)) * SEQ + ck * 64 + c8 * 8); }
    }
    __syncthreads();
    f32x4 acc[8];
#pragma unroll
    for (int v8 = 0; v8 < 8; ++v8) acc[v8] = (f32x4){0.f, 0.f, 0.f, 0.f};
    if (ck > 0) {
        const bf16_t* sp = p.SP + (size_t)bhc * 16384;
#pragma unroll
        for (int ks = 0; ks < 4; ++ks) {
            const bf16x8 bq = *(const bf16x8*)(qp + hg3_qp_base(0) + lds_off128(w * 16 + fr, ks * 32 + fg * 8));
#pragma unroll
            for (int v8 = 0; v8 < 8; ++v8) {
                const bf16x8 as = *(const bf16x8*)(sp + (size_t)(v8 * 16 + fr) * 128 + ks * 32 + fg * 8);
                acc[v8] = __builtin_amdgcn_mfma_f32_16x16x32_bf16(as, bq, acc[v8], 0, 0, 0);
            }
        }
    }
#pragma unroll
    for (int jp = 0; jp < 2; ++jp) {
        if (2 * jp > w) continue;
        f32x4 at[2];
#pragma unroll
        for (int jj = 0; jj < 2; ++jj) {
            const int j = 2 * jp + jj;
            at[jj] = (f32x4){0.f, 0.f, 0.f, 0.f};
            if (j <= w) {
#pragma unroll
                for (int ks = 0; ks < 4; ++ks) {
                    const bf16x8 ak = *(const bf16x8*)(kp + lds_off128(j * 16 + fr, ks * 32 + fg * 8));
                    const bf16x8 bq = *(const bf16x8*)(qp + hg3_qp_base(j) + lds_off128((w - j) * 16 + fr, ks * 32 + fg * 8));
                    at[jj] = __builtin_amdgcn_mfma_f32_16x16x32_bf16(ak, bq, at[jj], 0, 0, 0);
                }
                if (j == w) {
#pragma unroll
                    for (int r = 0; r < 4; ++r) at[jj][r] = (fg * 4 + r <= fr) ? at[jj][r] : 0.f;
                }
            }
        }
        u32x4 pw; pw.x = pack2(at[0][0], at[0][1]); pw.y = pack2(at[0][2], at[0][3]); pw.z = pack2(at[1][0], at[1][1]); pw.w = pack2(at[1][2], at[1][3]);
        const bf16x8 pf = __builtin_bit_cast(bf16x8, pw);
#pragma unroll
        for (int v8 = 0; v8 < 8; ++v8) {
            const char* vb = vt + (v8 * 16 + fr) * 144 + (jp * 32 + fg * 4) * 2;
            const u32x2 v0 = *(const u32x2*)vb, v1 = *(const u32x2*)(vb + 32);
            u32x4 vv; vv.x = v0.x; vv.y = v0.y; vv.z = v1.x; vv.w = v1.y;
            acc[v8] = __builtin_amdgcn_mfma_f32_16x16x32_bf16(__builtin_bit_cast(bf16x8, vv), pf, acc[v8], 0, 0, 0);
        }
    }
    float ss = 0.f;
#pragma unroll
    for (int v8 = 0; v8 < 8; ++v8)
#pragma unroll
        for (int r = 0; r < 4; ++r) ss += acc[v8][r] * acc[v8][r];
    ss += __shfl_xor(ss, 16); ss += __shfl_xor(ss, 32);
    const float rs = rsqrtf(ss * (1.0f / 128.0f) + 1e-6f);
    const size_t n = n0 + w * 16 + fr;
#pragma unroll
    for (int v8 = 0; v8 < 8; ++v8) {
        const int vcol = h * 128 + v8 * 16 + fg * 4;
        const u32x2 gv = *(const u32x2*)(p.UB0 + n * 2560 + 2048 + vcol);
        const f32x4 ng = *(const f32x4*)(p.hg_ng + vcol);
        const float y0 = acc[v8][0] * rs * ng[0] * sigmoidf_(bf2f(gv.x & 0xffffu)), y1 = acc[v8][1] * rs * ng[1] * sigmoidf_(bf2f(gv.x >> 16));
        const float y2 = acc[v8][2] * rs * ng[2] * sigmoidf_(bf2f(gv.y & 0xffffu)), y3 = acc[v8][3] * rs * ng[3] * sigmoidf_(bf2f(gv.y >> 16));
        u32x2 wv; wv.x = pack2(y0, y1); wv.y = pack2(y2, y3);
        *(u32x2*)(p.MIX + n * DM + 512 + vcol) = wv;
    }
}
__device__ __forceinline__ void phase_mix0_a(char* lds, int bid, int nb, const P& p) {
    for (int u = bid; u < 512 + 1024; u += nb) {
        if (u < 512) lru1_unit(lds, p, u >> 6, (u >> 1) & 31, u & 1);
        else { const int v = u - 512; hg1_unit(lds, p, v >> 7, (v >> 5) & 3, v & 31); }
    }
    __syncthreads();
}
__device__ __forceinline__ void phase_mix0_c(char* lds, int bid, int nb, const P& p) {
    for (int u = bid; u < 1024; u += nb) hg3_unit(lds, p, u >> 7, (u >> 5) & 3, u & 31);
    __syncthreads();
}

#ifndef KEEP_U
#define KEEP_U 0
#endif
__device__ __forceinline__ int vcol_actual(int v) { return v < 1280 ? v : (v < 2816 ? v + 24 : v - 1536); }
__device__ __forceinline__ void phase_inproj1(char* lds, int bid, int nb, const P& p) {
    const int ntn = 17, nk = DM / 32;
    const int tid = tidx(), lane = tid & 63, wid = tid >> 6, wr = wid >> 1, wc = wid & 1, fr = lane & 15, fq = lane >> 4;
    for (int jj = 0;; ++jj) {
        int tm, tn; if (!dense_unit3(bid, nb, jj, ntn, tm, tn)) break;
        Dma3A al; al.set_dense(p.XBb, tm * 256, DM); Dma3B bl; bl.set(p.WIN1, p.WIN1, tn * 128, DM, 1 << 30);
        f32x4 acc[32];
        gemm_core4(al, bl, nk, acc);
#pragma unroll
        for (int i = 0; i < 8; ++i)
#pragma unroll
            for (int n = 0; n < 4; ++n) {
                const int row = tm * 256 + wr * 128 + i * 16 + fr, vc = tn * 128 + wc * 64 + n * 16 + fq * 4;
                const f32x4 a = acc[i * 4 + n];
                u32x2 w; w.x = pack2(a[0], a[1]); w.y = pack2(a[2], a[3]);
                if (tn < 4) *(u32x2*)(p.Qb + (size_t)row * 512 + vc) = w;
                else if (tn < 6) *(f32x4*)(p.KCV + (size_t)row * 256 + vc - 512) = a;
                else if (tn == 6) *(u32x2*)(p.KS + (size_t)row * 128 + vc - 768) = w;
                else if (tn == 7) *(u32x2*)(p.KW + (size_t)row * 128 + vc - 896) = w;
                else if (tn < 12) *(u32x2*)(p.MQ + (size_t)row * 512 + vc - 1024) = w;
                else if (tn < 16) *(u32x2*)(p.MK + (size_t)row * 512 + vc - 1536) = w;
                else if (vc < 2072) *(f32x4*)(p.GATES + (size_t)row * 24 + vc - 2048) = a;
            }
    }
    for (int u = (nb >= 512 ? bid - 64 : bid); u < 3 * 128; u += nb) {
        if (u < 0) continue;
        const int pn = u % 3, tt = u / 3;
        if (pn == 0) {
            const int wrr = tidx() >> 7;
            gemm_t_unit(p.WIN1, 2176, p.XBb, tt * 128, wrr ? p.VWt - (size_t)128 * SEQ : p.VSt, 128, 0);
        } else gemm_t_unit(p.WIN1, 2432 + (pn - 1) * 256, p.XBb, tt * 128, p.MVt, 512, (pn - 1) * 256);
    }
}
__device__ __forceinline__ void phase_moba_gate(char* lds, int bid, int nb, const P& p) {
    const int lane = tidx() & 63, wid = tidx() >> 6;
    float* km = (float*)lds + 4096 + wid * 512;
    for (int it = bid * 4 + wid; it < 64 * 32; it += nb * 4) {
        const int bh = it >> 5, tb = it & 31, b = bh >> 3, h = bh & 7;
        const int t = tb * 64 + lane, ob = t >> 8;
        __builtin_amdgcn_wave_barrier();
#pragma unroll
        for (int i = 0; i < 8; ++i) km[i * 64 + lane] = p.KM[(size_t)bh * 512 + i * 64 + lane];
        __builtin_amdgcn_wave_barrier();
        u32x4 qr[8];
#pragma unroll
        for (int i = 0; i < 8; ++i) qr[i] = *(const u32x4*)(p.MQ + (size_t)(b * SEQ + t) * 512 + h * 64 + i * 8);
        float gate[8];
#pragma unroll
        for (int j = 0; j < 8; ++j) gate[j] = 0.f;
#pragma unroll
        for (int i = 0; i < 8; ++i) {
            float q[8];
            q[0] = bf2f(qr[i].x & 0xffffu); q[1] = bf2f(qr[i].x >> 16); q[2] = bf2f(qr[i].y & 0xffffu); q[3] = bf2f(qr[i].y >> 16);
            q[4] = bf2f(qr[i].z & 0xffffu); q[5] = bf2f(qr[i].z >> 16); q[6] = bf2f(qr[i].w & 0xffffu); q[7] = bf2f(qr[i].w >> 16);
#pragma unroll
            for (int j = 0; j < 8; ++j)
#pragma unroll
                for (int e = 0; e < 8; ++e) gate[j] += q[e] * km[j * 64 + i * 8 + e];
        }
#pragma unroll
        for (int j = 0; j < 8; ++j) gate[j] = (j < ob) ? gate[j] : NEGF;
        unsigned selm = 0;
#pragma unroll
        for (int j = 0; j < 8; ++j) {
            int rank = 0;
#pragma unroll
            for (int j2 = 0; j2 < 8; ++j2) rank += (gate[j2] > gate[j] || (gate[j2] == gate[j] && j2 < j)) ? 1 : 0;
            if (j < ob && rank < 3) selm |= 1u << j;
        }
        p.MSEL[(size_t)bh * SEQ + t] = selm;
    }
}

#define ATT_K_BYTES 8192
#define ATT_STAGE 16384
#define ATT_TILE_BYTES (3 * ATT_STAGE)
#define ATT_ORDER_OFF ATT_TILE_BYTES
#define ATT_RED_OFF (ATT_ORDER_OFF + 8192)
__device__ __forceinline__ void att_issue_tile(int stage, const bf16_t* Kg, int ldk, const bf16_t* Vg) {
    const int lane = tidx() & 63, w = tidx() >> 6;
#pragma unroll
    for (int i = 0; i < 2; ++i) { int R, C; dma_rc(lane, w + 4 * i, R, C);
        __builtin_amdgcn_global_load_lds((const unsigned*)(Kg + (size_t)R * ldk + C), (LAS unsigned*)((LAS char*)dyn_lds + stage * ATT_STAGE + (w + 4 * i) * 1024), 16, 0, 0);
        __builtin_amdgcn_global_load_lds((const unsigned*)(Vg + (size_t)R * SEQ + C), (LAS unsigned*)((LAS char*)dyn_lds + stage * ATT_STAGE + ATT_K_BYTES + (w + 4 * i) * 1024), 16, 0, 0); }
}
#define ATT_WAIT_BAR(n) do { asm volatile("s_waitcnt vmcnt(" #n ") lgkmcnt(0)" ::: "memory"); __builtin_amdgcn_s_barrier(); asm volatile("" ::: "memory"); } while (0)
struct AttState { f32x4 O[4][2]; float m[2], l[2]; };
__device__ __forceinline__ void att_reset(AttState& S) {
#pragma unroll
    for (int q = 0; q < 2; ++q) { S.m[q] = NEGF; S.l[q] = 0.f;
#pragma unroll
        for (int d = 0; d < 4; ++d) S.O[d][q] = (f32x4){0.f, 0.f, 0.f, 0.f}; }
}
template <bool MASKED>
__device__ __forceinline__ void att_step(const char* lds, const bf16x8 (&qf)[2][2], AttState& S, const f32x4 (&bini)[4], float slope2,
                                         int s0, int tq0, unsigned selbits  , int winlimit) {
    const int lane = tidx() & 63, fr = lane & 15, fg = lane >> 4;
    const char* ldsV = lds + ATT_K_BYTES;
    const float offbase = slope2 * (float)s0;
    f32x4 s[2][4];
#pragma unroll
    for (int kt = 0; kt < 4; ++kt) {
        const bf16x8 k0 = *(const bf16x8*)(lds + lds_off(kt * 16 + fr, fg * 8)), k1 = *(const bf16x8*)(lds + lds_off(kt * 16 + fr, 32 + fg * 8));
#pragma unroll
        for (int qt = 0; qt < 2; ++qt) {
            s[qt][kt] = __builtin_amdgcn_mfma_f32_16x16x32_bf16(k0, qf[qt][0], bini[kt], 0, 0, 0);
            s[qt][kt] = __builtin_amdgcn_mfma_f32_16x16x32_bf16(k1, qf[qt][1], s[qt][kt], 0, 0, 0);
        }
    }
    __builtin_amdgcn_sched_barrier(0);
    u32x4 pf[2][2];
#pragma unroll
    for (int qt = 0; qt < 2; ++qt) {
        const int tq = tq0 + qt * 16 + fr;
        const float off = ((selbits >> qt) & 1u) ? (offbase - slope2 * (float)tq) : -INFINITY;
        float mx = -INFINITY;
#pragma unroll
        for (int kt = 0; kt < 4; ++kt)
#pragma unroll
            for (int r = 0; r < 4; ++r) {
                float y = s[qt][kt][r];
                if (MASKED) { const int key = s0 + kt * 16 + fg * 4 + r; const bool ok = (key <= tq) && (tq - key < winlimit); y = ok ? y : -INFINITY; s[qt][kt][r] = y; }
                mx = fmaxf(mx, y);
            }
        mx = fmaxf(mx, __shfl_xor(mx, 16)); mx = fmaxf(mx, __shfl_xor(mx, 32));
        const float mnew = fmaxf(S.m[qt], mx + off);
        const float alpha = __builtin_amdgcn_exp2f(S.m[qt] - mnew);
        S.m[qt] = mnew;
        const float thr = mnew - off;
        float ls = 0.f;
#pragma unroll
        for (int kt = 0; kt < 4; ++kt)
#pragma unroll
            for (int r = 0; r < 4; ++r) { const float pr = __builtin_amdgcn_exp2f(s[qt][kt][r] - thr); s[qt][kt][r] = pr; ls += pr; }
        S.l[qt] = S.l[qt] * alpha + ls;
#pragma unroll
        for (int dt = 0; dt < 4; ++dt) S.O[dt][qt] *= alpha;
#pragma unroll
        for (int kk = 0; kk < 2; ++kk) {
            pf[qt][kk].x = pack2(s[qt][2 * kk][0], s[qt][2 * kk][1]); pf[qt][kk].y = pack2(s[qt][2 * kk][2], s[qt][2 * kk][3]);
            pf[qt][kk].z = pack2(s[qt][2 * kk + 1][0], s[qt][2 * kk + 1][1]); pf[qt][kk].w = pack2(s[qt][2 * kk + 1][2], s[qt][2 * kk + 1][3]);
        }
    }
    __builtin_amdgcn_sched_barrier(0);
#pragma unroll
    for (int kk = 0; kk < 2; ++kk)
#pragma unroll
        for (int dt = 0; dt < 4; ++dt) {
            const char* vb = ldsV + (fg & 1) * 8;
            const u32x2 v0 = *(const u32x2*)(vb + lds_off(dt * 16 + fr, kk * 32 + (fg >> 1) * 8)), v1 = *(const u32x2*)(vb + lds_off(dt * 16 + fr, kk * 32 + 16 + (fg >> 1) * 8));
            u32x4 vv; vv.x = v0.x; vv.y = v0.y; vv.z = v1.x; vv.w = v1.y;
            const bf16x8 vf = __builtin_bit_cast(bf16x8, vv);
#pragma unroll
            for (int qt = 0; qt < 2; ++qt) S.O[dt][qt] = __builtin_amdgcn_mfma_f32_16x16x32_bf16(vf, __builtin_bit_cast(bf16x8, pf[qt][kk]), S.O[dt][qt], 0, 0, 0);
        }
    __builtin_amdgcn_sched_barrier(0);
}
__device__ __forceinline__ unsigned wave_or(unsigned v) {
#pragma unroll
    for (int o = 32; o >= 1; o >>= 1) v |= (unsigned)__shfl_xor((int)v, o);
    return v;
}
__device__ __forceinline__ void att_nsa_unit(char* lds, const P& p, int b, int g, int qtile) {
    const int tid = tidx(), lane = tid & 63, w = tid >> 6, fr = lane & 15, fg = lane >> 4;
    const int hd = g * 4 + w, t0 = qtile * 32, own = qtile >> 1;
    const float slope2 = exp2f(-((float)hd + 0.5f)) * LOG2E, c1 = 0.125f * LOG2E;
    bf16x8 qf[2][2];
#pragma unroll
    for (int qt = 0; qt < 2; ++qt)
#pragma unroll
        for (int ks = 0; ks < 2; ++ks) qf[qt][ks] = *(const bf16x8*)(p.Qb + (size_t)(b * SEQ + t0 + qt * 16 + fr) * 512 + hd * 64 + ks * 32 + fg * 8);
#pragma unroll
    for (int qt = 0; qt < 2; ++qt)
#pragma unroll
        for (int ks = 0; ks < 2; ++ks) {
            const u32x4 raw = __builtin_bit_cast(u32x4, qf[qt][ks]); u32x4 o;
            o.x = pack2(bf2f(raw.x & 0xffffu) * c1, bf2f(raw.x >> 16) * c1); o.y = pack2(bf2f(raw.y & 0xffffu) * c1, bf2f(raw.y >> 16) * c1);
            o.z = pack2(bf2f(raw.z & 0xffffu) * c1, bf2f(raw.z >> 16) * c1); o.w = pack2(bf2f(raw.w & 0xffffu) * c1, bf2f(raw.w >> 16) * c1);
            qf[qt][ks] = __builtin_bit_cast(bf16x8, o);
        }
    f32x4 bini[4];
#pragma unroll
    for (int kt = 0; kt < 4; ++kt)
#pragma unroll
        for (int r = 0; r < 4; ++r) bini[kt][r] = slope2 * (float)(kt * 16 + fg * 4 + r);
    unsigned selw[2];
#pragma unroll
    for (int qt = 0; qt < 2; ++qt) selw[qt] = p.SELM[(size_t)(b * 2 + g) * SEQ + t0 + qt * 16 + fr];
    const unsigned um = wave_or(selw[0] | selw[1]);
    AttState S; att_reset(S);
    unsigned rem = um & ((own >= 31) ? 0xffffffffu : ((2u << own) - 1u));
    int wj = own >= 8 ? own - 8 : 0;
    int cbr, cj; bool has = true;
    if (rem) { cj = __ffs(rem) - 1; rem &= rem - 1; cbr = 0; } else { cj = wj++; cbr = 1; }
    const bf16_t* Ks = p.KS + (size_t)b * SEQ * 128 + g * 64; const bf16_t* Kw = p.KW + (size_t)b * SEQ * 128 + g * 64;
    const bf16_t* Vs = p.VSt + (size_t)(b * 128 + g * 64) * SEQ; const bf16_t* Vw = p.VWt + (size_t)(b * 128 + g * 64) * SEQ;
    int n1br = 0, n1j = 0; bool has1;
    if (rem) { n1j = __ffs(rem) - 1; rem &= rem - 1; n1br = 0; has1 = true; } else if (wj <= own) { n1j = wj++; n1br = 1; has1 = true; } else has1 = false;
    __syncthreads();
    att_issue_tile(0, (cbr ? Kw : Ks) + (size_t)cj * 64 * 128, 128, (cbr ? Vw : Vs) + cj * 64);
    if (has1) att_issue_tile(1, (n1br ? Kw : Ks) + (size_t)n1j * 64 * 128, 128, (n1br ? Vw : Vs) + n1j * 64);
    bool switched = false;
    int st = 0;
    while (has) {
        if (has1) ATT_WAIT_BAR(4); else ATT_WAIT_BAR(0);
        int n2br = 0, n2j = 0; bool has2;
        if (!has1) has2 = false;
        else if (rem) { n2j = __ffs(rem) - 1; rem &= rem - 1; n2br = 0; has2 = true; } else if (wj <= own) { n2j = wj++; n2br = 1; has2 = true; } else has2 = false;
        if (has2) att_issue_tile(st == 0 ? 2 : st - 1, (n2br ? Kw : Ks) + (size_t)n2j * 64 * 128, 128, (n2br ? Vw : Vs) + n2j * 64);
        const char* sl = lds + st * ATT_STAGE;
        if (cbr == 1 && !switched) {
            switched = true;
#pragma unroll
            for (int qt = 0; qt < 2; ++qt) {
                float lt = S.l[qt]; lt += __shfl_xor(lt, 16); lt += __shfl_xor(lt, 32);
                const size_t n = (size_t)b * SEQ + t0 + qt * 16 + fr;
                const float sc = sigmoidf_(p.GATES[n * 24 + hd * 3 + 1]) / fmaxf(lt, 1e-30f);
#pragma unroll
                for (int dt = 0; dt < 4; ++dt) *(f32x4*)(p.OS + n * 512 + hd * 64 + dt * 16 + fg * 4) = S.O[dt][qt] * sc;
            }
            att_reset(S);
        }
        unsigned sb = 3u; int wl = 1 << 30; bool msk;
        if (cbr == 0) { sb = ((selw[0] >> cj) & 1u) | (((selw[1] >> cj) & 1u) << 1); msk = (cj == own); }
        else { wl = 512; msk = (cj == own) || (cj + 8 == own); }
        if (msk) att_step<true>(sl, qf, S, bini, slope2, cj * 64, t0, sb, wl);
        else att_step<false>(sl, qf, S, bini, slope2, cj * 64, t0, sb, wl);
        cbr = n1br; cj = n1j; has = has1; n1br = n2br; n1j = n2j; has1 = has2;
        st = (st == 2) ? 0 : st + 1;
    }
#pragma unroll
    for (int qt = 0; qt < 2; ++qt) {
        float lt = S.l[qt]; lt += __shfl_xor(lt, 16); lt += __shfl_xor(lt, 32);
        const size_t n = (size_t)b * SEQ + t0 + qt * 16 + fr;
        const float sc = sigmoidf_(p.GATES[n * 24 + hd * 3 + 2]) / fmaxf(lt, 1e-30f);
        const float g0 = sigmoidf_(p.GATES[n * 24 + hd * 3 + 0]);
#pragma unroll
        for (int dt = 0; dt < 4; ++dt) {
            const size_t o = n * 512 + hd * 64 + dt * 16 + fg * 4;
            const f32x4 y = S.O[dt][qt] * sc + *(const f32x4*)(p.OS + o) + *(const f32x4*)(p.OC + o) * g0;
            u32x2 wv; wv.x = pack2(y[0], y[1]); wv.y = pack2(y[2], y[3]);
            *(u32x2*)(p.MIX + n * DM + hd * 64 + dt * 16 + fg * 4) = wv;
        }
    }
}
__device__ __forceinline__ void att_moba_unit(char* lds, const P& p, int b, int h, int ob, int half) {
    const int tid = tidx(), lane = tid & 63, w = tid >> 6, fr = lane & 15, fg = lane >> 4;
    const int tq0 = ob * 256 + half * 128 + w * 32;
    const int dsub = half * 2 + (w >> 1), lastsub = half * 2 + 1;
    const float slope2 = exp2f(-((float)h + 1.0f)) * LOG2E, c1 = 0.125f * LOG2E;
    bf16x8 qf[2][2];
#pragma unroll
    for (int qt = 0; qt < 2; ++qt)
#pragma unroll
        for (int ks = 0; ks < 2; ++ks) qf[qt][ks] = *(const bf16x8*)(p.MQ + (size_t)(b * SEQ + tq0 + qt * 16 + fr) * 512 + h * 64 + ks * 32 + fg * 8);
#pragma unroll
    for (int qt = 0; qt < 2; ++qt)
#pragma unroll
        for (int ks = 0; ks < 2; ++ks) {
            const u32x4 raw = __builtin_bit_cast(u32x4, qf[qt][ks]); u32x4 o;
            o.x = pack2(bf2f(raw.x & 0xffffu) * c1, bf2f(raw.x >> 16) * c1); o.y = pack2(bf2f(raw.y & 0xffffu) * c1, bf2f(raw.y >> 16) * c1);
            o.z = pack2(bf2f(raw.z & 0xffffu) * c1, bf2f(raw.z >> 16) * c1); o.w = pack2(bf2f(raw.w & 0xffffu) * c1, bf2f(raw.w >> 16) * c1);
            qf[qt][ks] = __builtin_bit_cast(bf16x8, o);
        }
    f32x4 bini[4];
#pragma unroll
    for (int kt = 0; kt < 4; ++kt)
#pragma unroll
        for (int r = 0; r < 4; ++r) bini[kt][r] = slope2 * (float)(kt * 16 + fg * 4 + r);
    unsigned selw[2];
#pragma unroll
    for (int qt = 0; qt < 2; ++qt) selw[qt] = p.MSEL[(size_t)(b * 8 + h) * SEQ + tq0 + qt * 16 + fr];
    unsigned* red = (unsigned*)(lds + ATT_RED_OFF);
    const unsigned umw = wave_or(selw[0] | selw[1]);
    __syncthreads();
    if (lane == 0) red[w] = umw;
    __syncthreads();
    unsigned rem = (red[0] | red[1] | red[2] | red[3]) & ((1u << ob) - 1u);
    AttState S; att_reset(S);
    int cj, csub = 0; bool has = true;
    if (rem) { cj = __ffs(rem) - 1; rem &= rem - 1; } else cj = ob;
    const bf16_t* Kb = p.MK + (size_t)b * SEQ * 512 + h * 64; const bf16_t* Vb = p.MVt + (size_t)(b * 512 + h * 64) * SEQ;
#define MOBA_NEXT(J, SUB, NJ, NSUB, HAS) do { \
        if ((J) == ob) { if ((SUB) < lastsub) { NJ = (J); NSUB = (SUB) + 1; HAS = true; } else HAS = false; } \
        else if ((SUB) < 3) { NJ = (J); NSUB = (SUB) + 1; HAS = true; } \
        else { if (rem) { NJ = __ffs(rem) - 1; rem &= rem - 1; } else NJ = ob; NSUB = 0; HAS = true; } } while (0)
    int n1j = 0, n1sub = 0; bool has1;
    MOBA_NEXT(cj, csub, n1j, n1sub, has1);
    __syncthreads();
    att_issue_tile(0, Kb + (size_t)(cj * 256 + csub * 64) * 512, 512, Vb + cj * 256 + csub * 64);
    if (has1) att_issue_tile(1, Kb + (size_t)(n1j * 256 + n1sub * 64) * 512, 512, Vb + n1j * 256 + n1sub * 64);
    int st = 0;
    while (has) {
        if (has1) ATT_WAIT_BAR(4); else ATT_WAIT_BAR(0);
        int n2j = 0, n2sub = 0; bool has2 = false;
        if (has1) MOBA_NEXT(n1j, n1sub, n2j, n2sub, has2);
        if (has2) att_issue_tile(st == 0 ? 2 : st - 1, Kb + (size_t)(n2j * 256 + n2sub * 64) * 512, 512, Vb + n2j * 256 + n2sub * 64);
        const char* sl = lds + st * ATT_STAGE;
        const int s0 = cj * 256 + csub * 64;
        unsigned sb = 3u; bool msk = false, run = true;
        if (cj < ob) sb = ((selw[0] >> cj) & 1u) | (((selw[1] >> cj) & 1u) << 1);
        else { msk = (csub == dsub); run = (csub <= dsub); }
        if (run) {
            if (msk) att_step<true>(sl, qf, S, bini, slope2, s0, tq0, sb, 1 << 30);
            else att_step<false>(sl, qf, S, bini, slope2, s0, tq0, sb, 1 << 30);
        }
        cj = n1j; csub = n1sub; has = has1; n1j = n2j; n1sub = n2sub; has1 = has2;
        st = (st == 2) ? 0 : st + 1;
    }
#undef MOBA_NEXT
#pragma unroll
    for (int qt = 0; qt < 2; ++qt) {
        float lt = S.l[qt]; lt += __shfl_xor(lt, 16); lt += __shfl_xor(lt, 32);
        const size_t n = (size_t)b * SEQ + tq0 + qt * 16 + fr;
        const float sc = 1.0f / fmaxf(lt, 1e-30f);
#pragma unroll
        for (int dt = 0; dt < 4; ++dt) {
            const f32x4 y = S.O[dt][qt] * sc;
            u32x2 wv; wv.x = pack2(y[0], y[1]); wv.y = pack2(y[2], y[3]);
            *(u32x2*)(p.MIX + n * DM + 512 + h * 64 + dt * 16 + fg * 4) = wv;
        }
    }
}
#ifndef ATT_NSA
#define ATT_NSA 1
#endif
#ifndef ATT_MOBA
#define ATT_MOBA 1
#endif
__device__ __forceinline__ int att_class_key(int c) {
    if (c < 64) { const int a = (c >> 1) + 1; return (a < 16 ? a : 16) + (a < 9 ? a : 9); }
    const int ob = (c - 64) >> 1, half = (c - 64) & 1; return 4 * ob + 2 + 2 * half;
}
__device__ __forceinline__ void cmpa_unit(char* lds, const P& p, int b, int g, int qt64);
__device__ __forceinline__ void phase_attn_a(char* lds, int bid, int nb, const P& p) {
    int* order = (int*)(lds + 49152);
    __syncthreads();
    for (int u = tidx(); u < 1024; u += 256) {
        const int c = u & 15, inst = u >> 4;
        const int key = att_class_key(64 + c);
        int pos = inst;
        for (int c2 = 0; c2 < 16; ++c2) { const int k2 = att_class_key(64 + c2); if (k2 > key || (k2 == key && c2 < c)) pos += 64; }
        order[pos] = u;
    }
    __syncthreads();
    for (int r = 0;; ++r) {
        const int idx = r * nb + ((r & 1) ? (nb - 1 - bid) : bid);
        if (idx >= 512 + 1024) break;
        if (idx < 512) cmpa_unit(lds, p, idx >> 6, (idx >> 5) & 1, idx & 31);
        else { const int v = order[idx - 512]; att_moba_unit(lds, p, v >> 7, (v >> 4) & 7, (v >> 1) & 7, v & 1); }
    }
    __syncthreads();
}
__device__ __forceinline__ void phase_attn_b(char* lds, int bid, int nb, const P& p) {
    int* order = (int*)(lds + ATT_ORDER_OFF);
    __syncthreads();
    for (int u = tidx(); u < 1024; u += 256) {
        const int c = u & 63, inst = u >> 6;
        const int key = att_class_key(c);
        int pos = inst;
        for (int c2 = 0; c2 < 64; ++c2) { const int k2 = att_class_key(c2); if (k2 > key || (k2 == key && c2 < c)) pos += 16; }
        order[pos] = u;
    }
    __syncthreads();
    for (int r = 0;; ++r) {
        const int idx = r * nb + ((r & 1) ? (nb - 1 - bid) : bid);
        if (idx >= 1024) break;
        const int u = order[idx];
        att_nsa_unit(lds, p, u >> 7, (u >> 6) & 1, u & 63);
    }
    __syncthreads();
}

struct ALoadCmp {
    const float* base;
    const float* pe;
    int kt0;
    struct Regs { f32x4 v[8]; };
    __device__ __forceinline__ void load(int kt, Regs& R) const {
        const int l = kt + kt0;
        const f32x4 p0 = *(const f32x4*)(pe + l * 64), p1 = *(const f32x4*)(pe + l * 64 + 4);
#pragma unroll
        for (int i = 0; i < 4; ++i) {
            const int row = (tidx() + 256 * i) >> 3; int tok = 16 * row + l; tok = tok > SEQ - 1 ? SEQ - 1 : tok;
            const float* q = base + (size_t)tok * 256;
            R.v[2 * i] = *(const f32x4*)q + p0; R.v[2 * i + 1] = *(const f32x4*)(q + 4) + p1;
        }
    }
    __device__ __forceinline__ void store(int kt, const Regs& R, char* lds) const {
#pragma unroll
        for (int i = 0; i < 4; ++i) {
            const int p = tidx() + 256 * i, row = p >> 3, ch = p & 7;
            const f32x4 a = R.v[2 * i], b = R.v[2 * i + 1];
            u32x4 w; w.x = pack2(a[0], a[1]); w.y = pack2(a[2], a[3]); w.z = pack2(b[0], b[1]); w.w = pack2(b[2], b[3]);
            *(u32x4*)(lds + lds_off(row, ch * 8)) = w;
        }
    }
};
__device__ __forceinline__ void phase_cmp1(char* lds, int bid, int nb, const P& p) {
    const int tid = tidx(), lane = tid & 63, wid = tid >> 6, wr = wid >> 1, wc = wid & 1, fr = lane & 15, fq = lane >> 4;
    for (int u = bid; u < 16 * 2 * 4; u += nb) {
        const int split = u & 3, which = (u >> 2) & 1, bg = u >> 3, b = bg >> 1, g = bg & 1;
        ALoadCmp al; al.kt0 = split * 8; al.base = p.KCV + (size_t)b * SEQ * 256 + which * 128 + g * 64 + (tid & 7) * 8; al.pe = (which ? p.pe_v : p.pe_k) + (tid & 7) * 8;
        BLoadF32 bl; { const int nq = tid & 31, kg = tid >> 5; bl.valid = true; bl.ldb = 128; bl.nk1 = 1 << 30; bl.bp = (which ? p.wv1 : p.wk1) + (size_t)(split * 8 * 64 + kg * 8) * 128 + nq * 4; }
        f32x4 acc[4][4];
        gemm_tile(lds, al, bl, 8, acc);
        float* hid = p.HID + (((size_t)split * 2 + which) * 2048 + bg * 128) * 128;
#pragma unroll
        for (int m = 0; m < 4; ++m)
#pragma unroll
            for (int n = 0; n < 4; ++n) {
                const int row = wr * 64 + m * 16 + fr, col = wc * 64 + n * 16 + fq * 4;
                *(f32x4*)(hid + (size_t)row * 128 + col) = acc[m][n];
            }
    }
}
__device__ __forceinline__ void phase_cmp2(char* lds, int bid, int nb, const P& p) {
    const int tid = tidx(), lane = tid & 63, wid = tid >> 6;
    float* hs = (float*)lds + wid * 128;
    for (int it = bid * 4 + wid; it < 2 * 16 * 128; it += nb * 4) {
        const int which = it >> 11, bg = (it >> 7) & 15, c = it & 127;
        float o = 0.f;
        if (c < 127) {
            const float* hid = p.HID + ((size_t)which * 2048 + bg * 128 + c) * 128;
            const size_t ss = (size_t)2 * 2048 * 128;
            __builtin_amdgcn_wave_barrier();
            hs[lane] = gelu_tanh((hid[lane] + hid[ss + lane]) + (hid[2 * ss + lane] + hid[3 * ss + lane]));
            hs[lane + 64] = gelu_tanh((hid[lane + 64] + hid[ss + lane + 64]) + (hid[2 * ss + lane + 64] + hid[3 * ss + lane + 64]));
            __builtin_amdgcn_wave_barrier();
            const float* w2 = which ? p.wv2 : p.wk2;
#pragma unroll 8
            for (int j = 0; j < 128; ++j) o += hs[j] * w2[j * 64 + lane];
        }
        if (which == 0) p.KCb[((size_t)bg * 128 + c) * 64 + lane] = (bf16_t)f2bf(o);
        else p.VCt[((size_t)bg * 64 + lane) * 128 + c] = (bf16_t)f2bf(o);
    }
}
#define CMPA_LDS (2 * 16384 + 4 * 2048)
__device__ __forceinline__ void cmpa_unit(char* lds, const P& p, int b, int g, int qt64) {
    const int tid = tidx(), lane = tid & 63, w = tid >> 6, fr = lane & 15, fg = lane >> 4;
    const int bg = b * 2 + g;
    char* kc = lds; char* vt = lds + 16384;
    __syncthreads();
#pragma unroll
    for (int i = 0; i < 4; ++i) { const int pc = tid + 256 * i;
        *(u32x4*)(kc + lds_off(pc >> 3, (pc & 7) * 8)) = *(const u32x4*)(p.KCb + (size_t)bg * 8192 + pc * 8);
        *(u32x4*)(vt + lds_off128(pc >> 4, (pc & 15) * 8)) = *(const u32x4*)(p.VCt + (size_t)bg * 8192 + pc * 8); }
    __syncthreads();
    const int t = qt64 * 64 + w * 16 + fr;
    const size_t n = (size_t)b * SEQ + t;
    const float c1 = 0.125f * LOG2E;
    f32x4 psum[8];
#pragma unroll
    for (int ct = 0; ct < 8; ++ct) psum[ct] = (f32x4){0.f, 0.f, 0.f, 0.f};
    bf16x8 qall[4][2];
#pragma unroll
    for (int i = 0; i < 4; ++i) { qall[i][0] = *(const bf16x8*)(p.Qb + n * 512 + (g * 4 + i) * 64 + fg * 8); qall[i][1] = *(const bf16x8*)(p.Qb + n * 512 + (g * 4 + i) * 64 + 32 + fg * 8); }
#pragma unroll
    for (int i = 0; i < 4; ++i) {
        const int hd = g * 4 + i;
        const float slope2 = exp2f(-((float)hd + 0.5f)) * LOG2E;
        const bf16x8 q0 = qall[i][0], q1 = qall[i][1];
        __builtin_amdgcn_sched_barrier(0);
        f32x4 s[8];
        float mx = -INFINITY;
#pragma unroll
        for (int ct = 0; ct < 8; ++ct) {
            const bf16x8 k0 = *(const bf16x8*)(kc + lds_off(ct * 16 + fr, fg * 8)), k1 = *(const bf16x8*)(kc + lds_off(ct * 16 + fr, 32 + fg * 8));
            s[ct] = __builtin_amdgcn_mfma_f32_16x16x32_bf16(k0, q0, (f32x4){0.f, 0.f, 0.f, 0.f}, 0, 0, 0);
            s[ct] = __builtin_amdgcn_mfma_f32_16x16x32_bf16(k1, q1, s[ct], 0, 0, 0);
#pragma unroll
            for (int r = 0; r < 4; ++r) {
                const int e = 16 * (ct * 16 + fg * 4 + r) + 31;
                const float y = (e <= t) ? fmaf(s[ct][r], c1, -slope2 * (float)(t - e)) : -INFINITY;
                s[ct][r] = y; mx = fmaxf(mx, y);
            }
        }
        __builtin_amdgcn_sched_barrier(0);
        mx = fmaxf(mx, __shfl_xor(mx, 16)); mx = fmaxf(mx, __shfl_xor(mx, 32));
        const float mm = (mx == -INFINITY) ? 0.f : mx;
        float ls = 0.f;
#pragma unroll
        for (int ct = 0; ct < 8; ++ct)
#pragma unroll
            for (int r = 0; r < 4; ++r) { const float e = __builtin_amdgcn_exp2f(s[ct][r] - mm); s[ct][r] = e; ls += e; }
        ls += __shfl_xor(ls, 16); ls += __shfl_xor(ls, 32);
        const float inv = 1.0f / fmaxf(ls, 1e-30f);
#pragma unroll
        for (int ct = 0; ct < 8; ++ct) { s[ct] *= inv; psum[ct] += s[ct]; }
        __builtin_amdgcn_sched_barrier(0);
        f32x4 o[4];
#pragma unroll
        for (int dt = 0; dt < 4; ++dt) o[dt] = (f32x4){0.f, 0.f, 0.f, 0.f};
#pragma unroll
        for (int kk = 0; kk < 4; ++kk) {
            u32x4 pw; pw.x = pack2(s[2 * kk][0], s[2 * kk][1]); pw.y = pack2(s[2 * kk][2], s[2 * kk][3]); pw.z = pack2(s[2 * kk + 1][0], s[2 * kk + 1][1]); pw.w = pack2(s[2 * kk + 1][2], s[2 * kk + 1][3]);
            const bf16x8 pf = __builtin_bit_cast(bf16x8, pw);
#pragma unroll
            for (int dt = 0; dt < 4; ++dt) {
                const int c0 = kk * 32 + fg * 4;
                const u32x2 v0 = *(const u32x2*)(vt + lds_off128(dt * 16 + fr, c0 & ~7) + (c0 & 7) * 2);
                const u32x2 v1 = *(const u32x2*)(vt + lds_off128(dt * 16 + fr, (c0 + 16) & ~7) + (c0 & 7) * 2);
                u32x4 vv; vv.x = v0.x; vv.y = v0.y; vv.z = v1.x; vv.w = v1.y;
                o[dt] = __builtin_amdgcn_mfma_f32_16x16x32_bf16(__builtin_bit_cast(bf16x8, vv), pf, o[dt], 0, 0, 0);
            }
        }
#pragma unroll
        for (int dt = 0; dt < 4; ++dt) *(f32x4*)(p.OC + n * 512 + hd * 64 + dt * 16 + fg * 4) = o[dt];
    }
    const int own = t >> 6;
    float val[8];
#pragma unroll
    for (int ct = 0; ct < 8; ++ct) {
        const float up = __shfl(psum[ct][3], (lane + 48) & 63);
        const float up0 = (ct > 0) ? __shfl(psum[ct > 0 ? ct - 1 : 0][3], (lane + 48) & 63) : 0.f;
        const float imp = (psum[ct][0] + psum[ct][1]) + (psum[ct][2] + psum[ct][3]) + (fg > 0 ? up : up0);
        const int j = ct * 4 + fg;
        const bool forced = (j == 0) || (j == own) || (j == own - 1);
        val[ct] = (j <= own) ? (imp + (forced ? 1e4f : 0.f)) : NEGF;
    }
    float* vs = (float*)(lds + 32768) + w * 512;
    __builtin_amdgcn_wave_barrier();
#pragma unroll
    for (int ct = 0; ct < 8; ++ct) vs[fr * 32 + ct * 4 + fg] = val[ct];
    __builtin_amdgcn_wave_barrier();
    int rank[8];
#pragma unroll
    for (int ct = 0; ct < 8; ++ct) rank[ct] = 0;
#pragma unroll 2
    for (int oj = 0; oj < 32; ++oj) {
        const float ov = vs[fr * 32 + oj];
#pragma unroll
        for (int ct = 0; ct < 8; ++ct) rank[ct] += (ov > val[ct] || (ov == val[ct] && oj < ct * 4 + fg)) ? 1 : 0;
    }
    __builtin_amdgcn_wave_barrier();
    unsigned bits = 0;
#pragma unroll
    for (int ct = 0; ct < 8; ++ct) if ((ct * 4 + fg <= own) && rank[ct] < 16) bits |= 1u << (ct * 4 + fg);
    bits |= (unsigned)__shfl_xor((int)bits, 16); bits |= (unsigned)__shfl_xor((int)bits, 32);
    if (fg == 0) p.SELM[(size_t)bg * SEQ + t] = bits;
}
__device__ __forceinline__ void phase_cmpa(char* lds, int bid, int nb, const P& p) {
    for (int u = bid; u < 16 * 32; u += nb) cmpa_unit(lds, p, u >> 6, (u >> 5) & 1, u & 31);
    __syncthreads();
}

#define MEGA_LDS (((HG3_LDS + 255) & ~255) + 16)
static_assert(HG3_LDS >= G4_LDS && HG3_LDS >= CMP_LDS && HG3_LDS >= G2_LDS && HG3_LDS >= ATT_RED_OFF + 16, "LDS map");
#define GBAR() xcd_barrier(bar)

template <int LAYER>
__device__ __forceinline__ void moe_block(char* lds, int bid, int nb, const P& p, const XcdBarrier& bar, float* of, bf16_t* ob) {
    if (bid < 32) p.cnt[bid * NEXP + tidx()] = 0;
    phase_router(bid, nb, p, LAYER);
    GBAR();
    phase_route(bid, nb, p, LAYER);
    GBAR();
    phase_scatter(lds, bid, nb, p);
    GBAR();
    phase_moe1(lds, bid, nb, p, LAYER, p.XAb);
    GBAR();
    phase_moe2(lds, bid, nb, p, LAYER);
    GBAR();
    phase_combine_ln(bid, nb, p, p.XA, p.ln_g + (LAYER * 2 + 1) * DM, p.ln_b + (LAYER * 2 + 1) * DM, of, ob);
}

__global__ void __launch_bounds__(256, 2) mega(P p) {
    char* lds = dyn_lds;
    const int bid = blockIdx.x, nb = gridDim.x;
    volatile LAS unsigned* st = (volatile LAS unsigned*)(dyn_lds + MEGA_LDS - 16);
    if (tidx() == 0) { st[0] = 0u; st[1] = 0u; st[2] = 0u; st[3] = 0u; }
    __syncthreads();
    const XcdBarrier bar = xcd_barrier_post(p.bar, st);
    phase_prep(lds, bid, nb, p);
    GBAR();
    phase_inproj0(lds, bid, nb, p);
    GBAR();
    phase_mix0_a(lds, bid, nb, p);
    GBAR();
    phase_hg2(bid, nb, p);
    for (int u = nb - 1 - bid; u < 512; u += nb) lru2_unit(p, u >> 6, (u >> 1) & 31, u & 1);
    GBAR();
    phase_mix0_c(lds, bid, nb, p);
    GBAR();
    phase_gemm_f32out(bid, nb, p.MIX, p.WOUT0, DM, DM, p.T0);
    GBAR();
    phase_ln_add(bid, nb, p.x, p.T0, p.ln_g, p.ln_b, p.XA, p.XAb, p.XAl);
    GBAR();
    moe_block<0>(lds, bid, nb, p, bar, p.XB, p.XBb);
    GBAR();
    phase_inproj1(lds, bid, nb, p);
    GBAR();
    phase_cmp1(lds, bid, nb, p);
    phase_moba_kmean(bid, nb, p);
    GBAR();
    phase_cmp2(lds, bid, nb, p);
    phase_moba_gate(lds, bid, nb, p);
    GBAR();
    phase_attn_a(lds, bid, nb, p);
    GBAR();
    phase_attn_b(lds, bid, nb, p);
    GBAR();
    phase_gemm_f32out(bid, nb, p.MIX, p.WOUT1, DM, DM, p.T0);
    GBAR();
    phase_ln_add(bid, nb, p.XB, p.T0, p.ln_g + 2 * DM, p.ln_b + 2 * DM, p.XA, p.XAb, p.XAl);
    GBAR();
    moe_block<1>(lds, bid, nb, p, bar, p.out, nullptr);
}

static inline size_t al256(size_t x) { return (x + 255) & ~(size_t)255; }

extern "C" void kernel_launch(void* const* d_in, const int* in_sizes, int n_in, void* d_out, int out_size, void* d_ws, size_t ws_size, hipStream_t stream) {
    P p{};
    const float** ip = (const float**)&p.x;
    for (int i = 0; i < 30; ++i) ip[i] = (const float*)d_in[i];
    p.out = (float*)d_out;
    char* w = (char*)d_ws; size_t o = 0;
    auto take = [&](size_t bytes) { char* r = w + o; o = al256(o + bytes); return r; };
    p.bar = (unsigned*)take(XCD_BAR_WORDS * 4);
    p.U = (float*)take((size_t)NTOK * EVEN_IN * 4);
    p.MIX = (bf16_t*)take((size_t)NTOK * DM * 2);
    p.T0 = (float*)take((size_t)NTOK * DM * 4);
    p.XA = (float*)take((size_t)NTOK * DM * 4); p.XAb = (bf16_t*)take((size_t)NTOK * DM * 2); p.XAl = (bf16_t*)take((size_t)NTOK * DM * 2);
    p.XB = (float*)take((size_t)NTOK * DM * 4); p.XBb = (bf16_t*)take((size_t)NTOK * DM * 2);
    p.LOG = (float*)take((size_t)3 * NTOK * NEXP * 4);
    p.eidx = (int*)take(NTOK * 8 * 4); p.ew = (float*)take(NTOK * 8 * 4); p.erank = (int*)take(NTOK * 8 * 4); p.epos = (int*)take(NTOK * 8 * 4);
    p.cnt = (int*)take(32 * NEXP * 4); p.tile_e = (int*)take(NTILES * 4); p.rowtok = (int*)take(NROWS * 4);
    p.H = (bf16_t*)take((size_t)NROWS * 256 * 2);
    p.Y = (bf16_t*)take((size_t)NROWS * DM * 2);
    p.LA = (float*)take((size_t)NTOK * 512 * 4); p.LB = (float*)take((size_t)NTOK * 512 * 4);
    p.KC = (float*)take(16 * 127 * 64 * 4); p.VC = (float*)take(16 * 127 * 64 * 4);
    p.OC = (float*)take((size_t)NTOK * 512 * 4);
    p.SELM = (unsigned*)take(16 * SEQ * 4);
    p.KM = (float*)take(8 * 8 * 8 * 64 * 4);
    p.Qb = (bf16_t*)take((size_t)NTOK * 512 * 2); p.KS = (bf16_t*)take((size_t)NTOK * 128 * 2); p.VSt = (bf16_t*)take((size_t)NTOK * 128 * 2);
    p.KW = (bf16_t*)take((size_t)NTOK * 128 * 2); p.VWt = (bf16_t*)take((size_t)NTOK * 128 * 2);
    p.MQ = (bf16_t*)take((size_t)NTOK * 512 * 2); p.MK = (bf16_t*)take((size_t)NTOK * 512 * 2); p.MVt = (bf16_t*)take((size_t)NTOK * 512 * 2);
    p.KCV = (float*)take((size_t)NTOK * 256 * 4); p.GATES = (float*)take((size_t)NTOK * 24 * 4); p.OS = (float*)take((size_t)NTOK * 512 * 4);
    p.MSEL = (unsigned*)take(64 * SEQ * 4);
    p.UB0 = (bf16_t*)take((size_t)NTOK * 2560 * 2); p.VHt = (bf16_t*)take((size_t)NTOK * 512 * 2);
    p.WAT = (bf16_t*)take(8 * 64 * 64 * 2); p.WXT = (bf16_t*)take(8 * 64 * 64 * 2);
    p.CSA = (float*)take(8 * 32 * 512 * 4); p.CSB = (float*)take(8 * 32 * 512 * 4);
    p.UT = (bf16_t*)take((size_t)1024 * 16384 * 2); p.SP = (bf16_t*)take((size_t)1024 * 16384 * 2);
    p.DV = (float*)take(1024 * 128 * 4);
    p.XIb = (bf16_t*)take((size_t)NTOK * DM * 2);
    p.plist = (int*)take(8 * 320 * 4); p.plen = (int*)take(64);
    p.WIN0 = (bf16_t*)take((size_t)EVEN_IN * DM * 2); p.WOUT0 = (bf16_t*)take((size_t)DM * DM * 2); p.WIN1 = (bf16_t*)take((size_t)2944 * DM * 2); p.WOUT1 = (bf16_t*)take((size_t)DM * DM * 2);
    p.WRH = (bf16_t*)take((size_t)2 * NEXP * DM * 2); p.WRL = (bf16_t*)take((size_t)2 * NEXP * DM * 2);
    p.HID = (float*)take((size_t)4 * 2 * 2048 * 128 * 4); p.KCb = (bf16_t*)take(16 * 128 * 64 * 2); p.VCt = (bf16_t*)take(16 * 64 * 128 * 2);
    if (o > ws_size) return;

    static int grid = 0;
    if (!grid) {
        int dev = 0, cus = 0, per_cu = 0;
        (void)hipGetDevice(&dev);
        (void)hipDeviceGetAttribute(&cus, hipDeviceAttributeMultiprocessorCount, dev);
        (void)hipFuncSetAttribute((const void*)mega, hipFuncAttributeMaxDynamicSharedMemorySize, MEGA_LDS);
        (void)hipOccupancyMaxActiveBlocksPerMultiprocessor(&per_cu, (const void*)mega, 256, MEGA_LDS);
        if (per_cu < 1) per_cu = 1;
        grid = cus * (per_cu < 2 ? per_cu : 2);
    }
    (void)hipMemsetAsync(p.bar, 0, XCD_BAR_WORDS * 4, stream);
    hipLaunchKernelGGL(mega, dim3(grid), dim3(256), MEGA_LDS, stream, p);
}
```

```cpp
#include <hip/hip_runtime.h>
#include <hip/hip_bf16.h>
#include <stdint.h>

#define NTOK 16384
#define DM 1024
#define SEQ 2048
#define NBATCH 8
#define EVEN_IN 3072
#define ODD_IN 2840
#define NEXP 256
#define NEGF (-1e30f)
#define LOG2E 1.4426950408889634f
#define DN_ALPHA 1.4142135623730951f
#define LN_EPS 1e-5f
#define MAXRT 1280
#define SH_TILE0 1280
#define NTILES (1280 + 128)
#define NROWS (NTILES * 128)

typedef unsigned short bf16_t;
typedef short bf16x8 __attribute__((ext_vector_type(8)));
typedef float f32x4 __attribute__((ext_vector_type(4)));
typedef unsigned u32x4 __attribute__((ext_vector_type(4)));
typedef unsigned u32x2 __attribute__((ext_vector_type(2)));
extern __shared__ __attribute__((aligned(16))) char dyn_lds[];
#define LAS __attribute__((address_space(3)))

__device__ __forceinline__ int tidx() { int t = threadIdx.x; asm volatile("" : "+v"(t)); return t; }
__device__ __forceinline__ float wave_sum(float v) {
#pragma unroll
    for (int o = 32; o >= 1; o >>= 1) v += __shfl_xor(v, o);
    return v;
}
__device__ __forceinline__ float wave_max(float v) {
#pragma unroll
    for (int o = 32; o >= 1; o >>= 1) v = fmaxf(v, __shfl_xor(v, o));
    return v;
}
typedef __bf16 hwbf16x2 __attribute__((ext_vector_type(2)));
typedef float f32x2 __attribute__((ext_vector_type(2)));
__device__ __forceinline__ unsigned f2bf(float f) { const __bf16 h = (__bf16)f; return (unsigned)__builtin_bit_cast(unsigned short, h); }
__device__ __forceinline__ float bf2f(unsigned b) { return __uint_as_float(b << 16); }
__device__ __forceinline__ unsigned pack2(float lo, float hi) { const f32x2 f = {lo, hi}; const hwbf16x2 v = __builtin_convertvector(f, hwbf16x2); return __builtin_bit_cast(unsigned, v); }
__device__ __forceinline__ float sigmoidf_(float x) { return 1.0f / (1.0f + __expf(-x)); }
__device__ __forceinline__ float siluf_(float x) { return x / (1.0f + __expf(-x)); }
__device__ __forceinline__ float gelu_tanh(float x) {
    const float u2 = 1.5957691216057308f * (x + 0.044715f * x * x * x);
    return x / (1.0f + __expf(-u2));
}


#define XB_TMO      128
#define XB_XCNT(j)  (256  + 64 * (j))
#define XB_XSUB(j)  (1280 + 64 * (j))
#define XB_XGEN(j)  (2304 + 64 * (j))
#define XB_TOP      3328
#define XB_TOPGEN   3392
#define XCD_BAR_WORDS 3456
#define XB_SPIN_CAP (1u << 18)
__device__ __forceinline__ unsigned xb_ld(unsigned* p)              { return __hip_atomic_load(p, __ATOMIC_RELAXED, __HIP_MEMORY_SCOPE_AGENT); }
__device__ __forceinline__ unsigned xb_add(unsigned* p, unsigned v) { return __hip_atomic_fetch_add(p, v, __ATOMIC_RELAXED, __HIP_MEMORY_SCOPE_AGENT); }
__device__ __forceinline__ unsigned xb_xcc_id() { return (unsigned)__builtin_amdgcn_s_getreg((3 << 11) | 20) & 0xFu; }
#define XB_SPIN(cond, bar) do { unsigned _sp = 0; while (cond) { __builtin_amdgcn_s_sleep(1); \
    if ((++_sp & 255u) == 0u) { if (xb_ld(&(bar)[XB_TMO])) break; if (_sp > XB_SPIN_CAP) { atomicAdd(&(bar)[XB_TMO], 1u); break; } } } } while (0)
struct XcdBarrier { unsigned* bar; unsigned x; volatile LAS unsigned* st; };
__device__ __forceinline__ XcdBarrier xcd_barrier_post(unsigned* bar, volatile LAS unsigned* st) {
    XcdBarrier b; b.bar = bar; b.x = xb_xcc_id(); b.st = st;
    if (tidx() == 0) (void)xb_add(&bar[XB_XCNT(b.x)], 1u);
    return b;
}
__device__ __forceinline__ void xcd_barrier_complete(unsigned* bar, unsigned x, unsigned& nloc, unsigned& nx) {
    const unsigned G = gridDim.x * gridDim.y * gridDim.z;
    unsigned sum, cnt, mine, sp = 0u;
    for (;;) {
        sum = 0u; cnt = 0u; mine = 0u;
#pragma unroll
        for (unsigned j = 0; j < 16; ++j) { const unsigned c = xb_ld(&bar[XB_XCNT(j)]); sum += c; cnt += (c > 0u) ? 1u : 0u; mine = (j == x) ? c : mine; }
        if (sum == G) break;
        __builtin_amdgcn_s_sleep(1);
        if ((++sp & 255u) == 0u) { if (xb_ld(&bar[XB_TMO])) break; if (sp > XB_SPIN_CAP) { atomicAdd(&bar[XB_TMO], 1u); break; } }
    }
    nloc = mine > 0u ? mine : 1u; nx = cnt > 0u ? cnt : 1u;
}
__device__ __forceinline__ void xcd_barrier(const XcdBarrier& b) {
    asm volatile("s_waitcnt vmcnt(0)" ::: "memory");
    __syncthreads();
    if (tidx() == 0) {
        unsigned* bar = b.bar;
        __builtin_amdgcn_s_waitcnt(0);
        unsigned nloc = b.st[0], nx = b.st[1];
        if (nloc == 0u) { xcd_barrier_complete(bar, b.x, nloc, nx); b.st[0] = nloc; b.st[1] = nx; }
        const unsigned old = xb_add(&bar[XB_XSUB(b.x)], 1u);
        const unsigned gen = old / nloc;
        if (old + 1u == (gen + 1u) * nloc) {
            __builtin_amdgcn_fence(__ATOMIC_RELEASE, "agent");
            asm volatile("s_waitcnt vmcnt(0)" ::: "memory");
            const unsigned og = xb_add(&bar[XB_TOP], 1u);
            const unsigned tg = og / nx;
            if (og + 1u == (tg + 1u) * nx) xb_add(&bar[XB_TOPGEN], 1u);
            else XB_SPIN(xb_ld(&bar[XB_TOPGEN]) == tg, bar);
            __builtin_amdgcn_fence(__ATOMIC_ACQUIRE, "agent");
            xb_add(&bar[XB_XGEN(b.x)], 1u);
            asm volatile("s_waitcnt vmcnt(0)" ::: "memory");
        } else {
            XB_SPIN(xb_ld(&bar[XB_XGEN(b.x)]) == gen, bar);
            __builtin_amdgcn_fence(__ATOMIC_ACQUIRE, "agent");
            asm volatile("s_waitcnt vmcnt(0)" ::: "memory");
        }
    }
    __syncthreads();
}

struct P {
    const float *x, *even_w_in, *conv_w, *conv_b, *wa, *ba, *wx, *bx, *lam, *hg_lb, *hg_ng, *even_w_out;
    const float *odd_w_in, *pe_k, *pe_v, *wk1, *wk2, *wv1, *wv2, *odd_w_out, *ln_g, *ln_b, *w_router, *b_router;
    const float *w_gate, *w_up, *w_down, *ws_gate, *ws_up, *ws_down;
    float* out;
    float* U;
    bf16_t* MIX;
    float* T0;
    float* XA; bf16_t* XAb; float* XB; bf16_t* XBb; bf16_t* XAl; bf16_t* XBl;
    float* LOG;
    int* eidx; float* ew; int* erank; int* epos;
    int* cnt;
    int* tile_e;
    int* rowtok;
    bf16_t* H;
    bf16_t* Y;
    float* LA; float* LB;
    float* KC; float* VC;
    float* OC;
    unsigned* SELM;
    float* KM;
    unsigned* bar;
    bf16_t *Qb, *KS, *VSt, *KW, *VWt, *MQ, *MK, *MVt;
    float *KCV, *GATES, *OS; unsigned* MSEL;
    bf16_t *UB0;
    bf16_t *VHt;
    bf16_t *WAT, *WXT;
    float *CSA, *CSB;
    bf16_t *UT, *SP;
    float *DV;
    float *HID;
    bf16_t *KCb, *VCt;
    bf16_t *XIb;
    int *plist; int *plen;
    bf16_t *WIN0, *WOUT0, *WIN1, *WOUT1, *WRH, *WRL;
};

__device__ __forceinline__ int lds_off(int r, int c) {
    const int st = (r >> 4) * 2 + (c >> 5), ob = (r & 15) * 64 + (c & 31) * 2;
    return st * 1024 + (ob ^ (((ob >> 9) & 1) << 5));
}
#define GEMM_LDS 32768

__device__ __forceinline__ float cvt_part(float v, int lo) { return lo ? (v - bf2f(f2bf(v))) : v; }

struct BLoadF32 {
    const float* bp; int ldb; bool valid; int nk1;
    struct Regs { f32x4 v[8]; };
    __device__ __forceinline__ void load(int kt, Regs& R) const {
        const float* p = bp + (size_t)((kt % nk1) * 64) * ldb;
#pragma unroll
        for (int j = 0; j < 8; ++j) R.v[j] = valid ? *(const f32x4*)(p + (size_t)j * ldb) : (f32x4){0.f, 0.f, 0.f, 0.f};
    }
    __device__ __forceinline__ void store(int kt, const Regs& R, char* lds) const {
        const int lo = (kt / nk1) == 1;
        const int nq = tidx() & 31, kg = tidx() >> 5;
#pragma unroll
        for (int i = 0; i < 4; ++i) {
            u32x4 w;
            w.x = pack2(cvt_part(R.v[0][i], lo), cvt_part(R.v[1][i], lo)); w.y = pack2(cvt_part(R.v[2][i], lo), cvt_part(R.v[3][i], lo));
            w.z = pack2(cvt_part(R.v[4][i], lo), cvt_part(R.v[5][i], lo)); w.w = pack2(cvt_part(R.v[6][i], lo), cvt_part(R.v[7][i], lo));
            *(u32x4*)(lds + lds_off(nq * 4 + i, kg * 8)) = w;
        }
    }
};

template <class AL, class BL>
__device__ __forceinline__ void gemm_tile(char* lds, const AL& al, const BL& bl, int nk, f32x4 (&acc)[4][4], bool swap = false) {
    const int lane = tidx() & 63, wid = tidx() >> 6, wr = wid >> 1, wc = wid & 1, fr = lane & 15, fq = lane >> 4;
    char* ldsA = lds; char* ldsB = lds + 16384;
    const char* t2 = swap ? ldsB : ldsA; const char* t1 = swap ? ldsA : ldsB; const int w2 = swap ? wc : wr, w1 = swap ? wr : wc;
#pragma unroll
    for (int m = 0; m < 4; ++m)
#pragma unroll
        for (int n = 0; n < 4; ++n) acc[m][n] = (f32x4){0.f, 0.f, 0.f, 0.f};
    typename AL::Regs ra; typename BL::Regs rb;
    al.load(0, ra); bl.load(0, rb);
    for (int kt = 0; kt < nk; ++kt) {
        __syncthreads();
        al.store(kt, ra, ldsA); bl.store(kt, rb, ldsB);
        __syncthreads();
        if (kt + 1 < nk) { al.load(kt + 1, ra); bl.load(kt + 1, rb); }
#pragma unroll
        for (int kk = 0; kk < 2; ++kk) {
            bf16x8 a[4], b[4];
#pragma unroll
            for (int m = 0; m < 4; ++m) a[m] = *(const bf16x8*)(t2 + lds_off(w2 * 64 + m * 16 + fr, kk * 32 + fq * 8));
#pragma unroll
            for (int n = 0; n < 4; ++n) b[n] = *(const bf16x8*)(t1 + lds_off(w1 * 64 + n * 16 + fr, kk * 32 + fq * 8));
#pragma unroll
            for (int m = 0; m < 4; ++m)
#pragma unroll
                for (int n = 0; n < 4; ++n) acc[m][n] = __builtin_amdgcn_mfma_f32_16x16x32_bf16(b[n], a[m], acc[m][n], 0, 0, 0);
        }
    }
}


__device__ __forceinline__ void dma_rc(int lane, int st, int& R, int& C) {
    const int sb = lane * 16, swz = sb ^ (((sb >> 9) & 1) << 5);
    R = (st >> 1) * 16 + (swz >> 6); C = (st & 1) * 32 + ((swz & 63) >> 1);
}
#define G3_STAGE 24576
#define G3_LDS (2 * G3_STAGE)
__device__ __forceinline__ int t32_off(int r, int c) { const int ob = (r & 15) * 64 + c * 2; return (r >> 4) * 1024 + (ob ^ (((ob >> 9) & 1) << 5)); }
__device__ __forceinline__ void dma_rc32(int lane, int st, int& R, int& C) { const int sb = lane * 16, swz = sb ^ (((sb >> 9) & 1) << 5); R = st * 16 + (swz >> 6); C = (swz & 63) >> 1; }
struct Dma3A {
    static constexpr int NV = 4;
    const char* base; unsigned voff[4];
    const char* lo = nullptr; int nk1 = 1 << 30;
    __device__ __forceinline__ void set_dense(const bf16_t* b0, int row0, int ld) {
        base = (const char*)b0; const int lane = tidx() & 63, w = tidx() >> 6;
#pragma unroll
        for (int i = 0; i < 4; ++i) { int R, C; dma_rc32(lane, w + 4 * i, R, C); voff[i] = (unsigned)(((size_t)(row0 + R) * ld + C) * 2); }
    }
    template <int SET = 0> __device__ __forceinline__ void issue(int kt, int ldsoff) const {
        const int w = tidx() >> 6;
#pragma unroll
        for (int i = 0; i < 4; ++i)
            __builtin_amdgcn_global_load_lds((const unsigned*)((((kt / nk1) == 2) ? lo : base) + voff[i] + (size_t)(kt % nk1) * 64), (LAS unsigned*)((LAS char*)dyn_lds + ldsoff + (w + 4 * i) * 1024), 16, 0, 0);
    }
    template <int SET = 0> __device__ __forceinline__ void commit(int, int) const {}
};
struct Dma3B {
    static constexpr int LAYOUT = 0, NV = 2;
    const char* hi; const char* lo; unsigned voff[2]; int nk1;
    __device__ __forceinline__ void set(const bf16_t* h, const bf16_t* l, int row0, int ld, int nk1_) {
        hi = (const char*)h; lo = (const char*)l; nk1 = nk1_; const int lane = tidx() & 63, w = tidx() >> 6;
#pragma unroll
        for (int i = 0; i < 2; ++i) { int R, C; dma_rc32(lane, w + 4 * i, R, C); voff[i] = (unsigned)(((size_t)(row0 + R) * ld + C) * 2); }
    }
    template <int SET = 0> __device__ __forceinline__ void issue(int kt, int ldsoff) const {
        const int w = tidx() >> 6; const char* base = ((kt / nk1) == 1) ? lo : hi; const size_t ko = (size_t)(kt % nk1) * 64;
#pragma unroll
        for (int i = 0; i < 2; ++i)
            __builtin_amdgcn_global_load_lds((const unsigned*)(base + voff[i] + ko), (LAS unsigned*)((LAS char*)dyn_lds + ldsoff + (w + 4 * i) * 1024), 16, 0, 0);
    }
    template <int SET = 0> __device__ __forceinline__ void commit(int, int) const {}
};
struct Reg3B {
    static constexpr int LAYOUT = 1, NV = 4;
    const float* bp; int ldb; f32x4 v[2][4];
    template <int SET = 0> __device__ __forceinline__ void issue(int kt, int) {
        const float* p = bp + (size_t)(kt * 32) * ldb;
#pragma unroll
        for (int j = 0; j < 4; ++j) v[SET][j] = *(const f32x4*)(p + (size_t)j * ldb);
    }
    template <int SET = 0> __device__ __forceinline__ void commit(int, int ldsoff) const {
        const int tid = tidx(), nq = tid & 31, kg = tid >> 5;
        u32x2 w[4];
#pragma unroll
        for (int i = 0; i < 4; ++i) { w[i].x = pack2(v[SET][0][i], v[SET][1][i]); w[i].y = pack2(v[SET][2][i], v[SET][3][i]); }
        const int rot = (nq >> 1) & 3;
#pragma unroll
        for (int i = 0; i < 4; ++i) {
            const int e = (i + rot) & 3;
            u32x2 d;
            d.x = e == 0 ? w[0].x : (e == 1 ? w[1].x : (e == 2 ? w[2].x : w[3].x));
            d.y = e == 0 ? w[0].y : (e == 1 ? w[1].y : (e == 2 ? w[2].y : w[3].y));
            *(u32x2*)(dyn_lds + ldsoff + ((((kg >> 1) * 128 + nq * 4 + e) << 4) + (kg & 1) * 8)) = d;
        }
    }
};
#define G4_LDS (3 * G3_STAGE)
template <class AL, class BL, int PAR>
__device__ __forceinline__ void g4_step(AL& al, BL& bl, int kt, int nk, f32x4 (&acc)[32], bool idle) {
    constexpr int NV = AL::NV + BL::NV;
    const int lane = tidx() & 63, wid = tidx() >> 6, wr = wid >> 1, wc = wid & 1, fr = lane & 15, fq = lane >> 4;
    const int s0 = kt % 3, cur = s0 * G3_STAGE, nx1 = (s0 == 2 ? 0 : s0 + 1) * G3_STAGE, nx2 = (s0 == 0 ? 2 : s0 - 1) * G3_STAGE;
    if (kt + 1 < nk) asm volatile("s_waitcnt vmcnt(%0) lgkmcnt(0)" :: "n"(NV) : "memory");
    else asm volatile("s_waitcnt vmcnt(0) lgkmcnt(0)" ::: "memory");
    __builtin_amdgcn_s_barrier();
    asm volatile("" ::: "memory");
    if (kt + 2 < nk) { al.template issue<PAR>(kt + 2, nx2); bl.template issue<PAR>(kt + 2, nx2 + 16384); }
    if (!idle) {
    bf16x8 sm[4];
#pragma unroll
    for (int j = 0; j < 4; ++j) sm[j] = *(const bf16x8*)(dyn_lds + cur + 16384 + (BL::LAYOUT == 1 ? ((fq * 128 + wc * 64 + j * 16 + fr) << 4) : t32_off(wc * 64 + j * 16 + fr, fq * 8)));
    bf16x8 bigc = *(const bf16x8*)(dyn_lds + cur + t32_off(wr * 128 + fr, fq * 8));
#pragma unroll
    for (int i = 0; i < 8; ++i) {
        bf16x8 bign = bigc;
        if (i < 7) bign = *(const bf16x8*)(dyn_lds + cur + t32_off(wr * 128 + (i + 1) * 16 + fr, fq * 8));
        __builtin_amdgcn_sched_barrier(0);
#pragma unroll
        for (int j = 0; j < 4; ++j) acc[i * 4 + j] = __builtin_amdgcn_mfma_f32_16x16x32_bf16(sm[j], bigc, acc[i * 4 + j], 0, 0, 0);
        __builtin_amdgcn_sched_barrier(0);
        bigc = bign;
    }
    }
    if (kt + 1 < nk) bl.template commit<PAR ^ 1>(kt + 1, nx1 + 16384);
}
template <class AL, class BL>
__device__ __forceinline__ void gemm_core4(AL& al, BL& bl, int nk, f32x4 (&acc)[32], bool idle_hi = false) {
    const bool idle = idle_hi && (tidx() >> 7);
#pragma unroll
    for (int i = 0; i < 32; ++i) acc[i] = (f32x4){0.f, 0.f, 0.f, 0.f};
    al.template issue<0>(0, 0); bl.template issue<0>(0, 16384);
    if (nk > 1) { al.template issue<1>(1, G3_STAGE); bl.template issue<1>(1, G3_STAGE + 16384); }
    bl.template commit<0>(0, 16384);
    for (int kt = 0; kt < nk; kt += 2) {
        g4_step<AL, BL, 0>(al, bl, kt, nk, acc, idle);
        if (kt + 1 < nk) g4_step<AL, BL, 1>(al, bl, kt + 1, nk, acc, idle);
    }
    __syncthreads();
}
__device__ __forceinline__ bool dense_unit3(int bid, int nb, int j, int ntn, int& tm, int& tn) {
    if ((nb & 7) == 0) {
        const int x = bid & 7, r = bid >> 3, R = nb >> 3;
        const int li = r + R * j;
        if (li >= 8 * ntn) return false;
        tn = li >> 3; tm = x * 8 + (li & 7);
        return true;
    }
    const int u = bid + nb * j;
    if (u >= 64 * ntn) return false;
    tm = u / ntn; tn = u % ntn; return true;
}
__device__ __forceinline__ void prep_tile(char* lds, const float* W, int ldw, int k0, int scol0, bool colvalid, bf16_t* Bt, int K, int drow0, int mode) {
    const int tid = tidx();
    bf16_t* t = (bf16_t*)lds;
    __syncthreads();
#pragma unroll
    for (int i = 0; i < 4; ++i) {
        const int k = (tid >> 4) + 16 * i, q = tid & 15;
        f32x4 v = colvalid ? *(const f32x4*)(W + (size_t)(k0 + k) * ldw + scol0 + q * 4) : (f32x4){0.f, 0.f, 0.f, 0.f};
#pragma unroll
        for (int e = 0; e < 4; ++e) { float x = v[e]; if (mode == 2) x = x - bf2f(f2bf(x)); t[(q * 4 + e) * 72 + k] = (bf16_t)f2bf(x); }
    }
    __syncthreads();
#pragma unroll
    for (int i = 0; i < 2; ++i) { const int pc = tid + 256 * i, n = pc >> 3, ch = pc & 7;
        *(u32x4*)(Bt + (size_t)(drow0 + n) * K + k0 + ch * 8) = *(const u32x4*)(t + n * 72 + ch * 8); }
}
__device__ __forceinline__ int vcol_actual(int v);
__device__ __forceinline__ void phase_prep(char* lds, int bid, int nb, const P& p) {
    const int tid = tidx();
    for (size_t i = (size_t)bid * 256 + tid; i < (size_t)NTOK * DM / 8; i += (size_t)nb * 256) {
        const f32x4 a = *(const f32x4*)(p.x + i * 8), b = *(const f32x4*)(p.x + i * 8 + 4);
        u32x4 w; w.x = pack2(a[0], a[1]); w.y = pack2(a[2], a[3]); w.z = pack2(b[0], b[1]); w.w = pack2(b[2], b[3]);
        *(u32x4*)(p.XIb + i * 8) = w;
    }
    for (int u = bid; u < 2272; u += nb) {
        if (u < 768) { const int nt = u >> 4, kt = u & 15; const int d = nt * 64; const int sc = d < 2048 ? d : (d < 2560 ? d + 512 : d - 512);
            prep_tile(lds, p.even_w_in, EVEN_IN, kt * 64, sc, true, p.WIN0, DM, d, 0); }
        else if (u < 1024) { const int v = u - 768, nt = v >> 4, kt = v & 15; prep_tile(lds, p.even_w_out, DM, kt * 64, nt * 64, true, p.WOUT0, DM, nt * 64, 0); }
        else if (u < 1760) { const int v = u - 1024, nt = v >> 4, kt = v & 15; const int d = nt * 64;
            int sc; bool ok = true;
            if (d < 896) sc = d; else if (d < 1024) sc = d + 128; else if (d < 1536) sc = d + 280; else if (d < 2048) sc = d + 280;
            else if (d < 2112) sc = 1280; else if (d < 2176) { sc = 0; ok = false; } else if (d < 2304) sc = d - 1280; else if (d < 2432) sc = d - 1152; else sc = d - 104;
            prep_tile(lds, p.odd_w_in, ODD_IN, kt * 64, sc, ok, p.WIN1, DM, d, 0); }
        else if (u < 2016) { const int v = u - 1760, nt = v >> 4, kt = v & 15; prep_tile(lds, p.odd_w_out, DM, kt * 64, nt * 64, true, p.WOUT1, DM, nt * 64, 0); }
        else { const int v = u - 2016, layer = v >> 7, lo = (v >> 6) & 1, nt = (v >> 4) & 3, kt = v & 15;
            prep_tile(lds, p.w_router + (size_t)layer * DM * NEXP, NEXP, kt * 64, nt * 64, true, (lo ? p.WRL : p.WRH) + (size_t)layer * NEXP * DM, DM, nt * 64, lo ? 2 : 1); }
    }
    __syncthreads();
}


__device__ __forceinline__ void phase_gemm_f32out(int bid, int nb, const bf16_t* A, const bf16_t* Bt, int N, int K, float* C) {
    const int ntn = N / 128;
    const int tid = tidx(), lane = tid & 63, wid = tid >> 6, wr = wid >> 1, wc = wid & 1, fr = lane & 15, fq = lane >> 4;
    for (int j = 0;; ++j) {
        int tm, tn; if (!dense_unit3(bid, nb, j, ntn, tm, tn)) break;
        Dma3A al; al.set_dense(A, tm * 256, K); Dma3B bl; bl.set(Bt, Bt, tn * 128, K, 1 << 30);
        f32x4 acc[32];
        gemm_core4(al, bl, K / 32, acc);
#pragma unroll
        for (int i = 0; i < 8; ++i)
#pragma unroll
            for (int n = 0; n < 4; ++n) { const f32x4 a = acc[i * 4 + n]; u32x2 w; w.x = pack2(a[0], a[1]); w.y = pack2(a[2], a[3]);
                *(u32x2*)((bf16_t*)C + (size_t)(tm * 256 + wr * 128 + i * 16 + fr) * N + tn * 128 + wc * 64 + n * 16 + fq * 4) = w; }
    }
}
__device__ __forceinline__ void phase_router(int bid, int nb, const P& p, int layer) {
    const int tid = tidx(), lane = tid & 63, wid = tid >> 6, wr = wid >> 1, wc = wid & 1, fr = lane & 15, fq = lane >> 4;
    for (int j = 0;; ++j) {
        int tm, t6; if (!dense_unit3(bid, nb, j, 6, tm, t6)) break;
        const int tn = t6 & 1, part = t6 >> 1;
        Dma3A al; al.set_dense(part == 2 ? p.XAl : p.XAb, tm * 256, DM);
        const bf16_t* wsrc = (part == 1 ? p.WRL : p.WRH) + (size_t)layer * NEXP * DM;
        Dma3B bl; bl.set(wsrc, wsrc, tn * 128, DM, 1 << 30);
        f32x4 acc[32];
        gemm_core4(al, bl, 32, acc);
        float* dst = p.LOG + (size_t)part * NTOK * NEXP;
#pragma unroll
        for (int i = 0; i < 8; ++i)
#pragma unroll
            for (int n = 0; n < 4; ++n) *(f32x4*)(dst + (size_t)(tm * 256 + wr * 128 + i * 16 + fr) * NEXP + tn * 128 + wc * 64 + n * 16 + fq * 4) = acc[i * 4 + n];
    }
}
__device__ __forceinline__ void ln_row_store(float (&v)[16], const float* g, const float* b, float* of, bf16_t* ob, int row, int lane, bf16_t* ol = nullptr) {
    float s = 0.f;
#pragma unroll
    for (int i = 0; i < 16; ++i) s += v[i];
    const float mu = wave_sum(s) * (1.0f / DM);
    float q = 0.f;
#pragma unroll
    for (int i = 0; i < 16; ++i) { const float d = v[i] - mu; q += d * d; }
    const float rstd = rsqrtf(wave_sum(q) * (1.0f / DM) + LN_EPS);
#pragma unroll
    for (int h = 0; h < 2; ++h) {
        const int c0 = h * 512 + lane * 8;
        float o[8];
#pragma unroll
        for (int i = 0; i < 8; ++i) o[i] = (v[h * 8 + i] - mu) * rstd * g[c0 + i] + b[c0 + i];
        if (of) { *(f32x4*)(of + (size_t)row * DM + c0) = (f32x4){o[0], o[1], o[2], o[3]};
                  *(f32x4*)(of + (size_t)row * DM + c0 + 4) = (f32x4){o[4], o[5], o[6], o[7]}; }
        if (ob) { u32x4 w; w.x = pack2(o[0], o[1]); w.y = pack2(o[2], o[3]); w.z = pack2(o[4], o[5]); w.w = pack2(o[6], o[7]); *(u32x4*)(ob + (size_t)row * DM + c0) = w;
            if (ol) { float l[8];
#pragma unroll
                for (int i = 0; i < 8; ++i) l[i] = o[i] - bf2f(f2bf(o[i]));
                u32x4 wl; wl.x = pack2(l[0], l[1]); wl.y = pack2(l[2], l[3]); wl.z = pack2(l[4], l[5]); wl.w = pack2(l[6], l[7]); *(u32x4*)(ol + (size_t)row * DM + c0) = wl; } }
    }
}
__device__ __forceinline__ void phase_ln_add(int bid, int nb, const float* res, const bf16_t* resh, const bf16_t* resl, const float* add, const float* g, const float* b, float* of, bf16_t* ob, bf16_t* ol) {
    const int lane = tidx() & 63, wid = tidx() >> 6;
    for (int row = bid * 4 + wid; row < NTOK; row += nb * 4) {
        float v[16];
#pragma unroll
        for (int h = 0; h < 2; ++h) {
            const size_t o = (size_t)row * DM + h * 512 + lane * 8;
            f32x4 r0, r1;
            if (res) { r0 = *(const f32x4*)(res + o); r1 = *(const f32x4*)(res + o + 4); }
            else { const u32x4 xh = *(const u32x4*)(resh + o), xl = *(const u32x4*)(resl + o);
                r0[0] = bf2f(xh.x & 0xffffu) + bf2f(xl.x & 0xffffu); r0[1] = bf2f(xh.x >> 16) + bf2f(xl.x >> 16); r0[2] = bf2f(xh.y & 0xffffu) + bf2f(xl.y & 0xffffu); r0[3] = bf2f(xh.y >> 16) + bf2f(xl.y >> 16);
                r1[0] = bf2f(xh.z & 0xffffu) + bf2f(xl.z & 0xffffu); r1[1] = bf2f(xh.z >> 16) + bf2f(xl.z >> 16); r1[2] = bf2f(xh.w & 0xffffu) + bf2f(xl.w & 0xffffu); r1[3] = bf2f(xh.w >> 16) + bf2f(xl.w >> 16); }
            const u32x4 ab = *(const u32x4*)((const bf16_t*)add + o);
            const float a0[4] = {bf2f(ab.x & 0xffffu), bf2f(ab.x >> 16), bf2f(ab.y & 0xffffu), bf2f(ab.y >> 16)};
            const float a1[4] = {bf2f(ab.z & 0xffffu), bf2f(ab.z >> 16), bf2f(ab.w & 0xffffu), bf2f(ab.w >> 16)};
#pragma unroll
            for (int i = 0; i < 4; ++i) { v[h * 8 + i] = DN_ALPHA * r0[i] + a0[i]; v[h * 8 + 4 + i] = DN_ALPHA * r1[i] + a1[i]; }
        }
        ln_row_store(v, g, b, of, ob, row, lane, ol);
    }
}

__device__ __forceinline__ void phase_route(int bid, int nb, const P& p, int layer) {
    const float* br = p.b_router + layer * NEXP;
    const int tid = tidx(), lane = tid & 63, wid = tid >> 6;
    const int gt = bid * 256 + tid, gs = nb * 256;
    for (int i = gt; i < NROWS; i += gs) p.rowtok[i] = (i >= SH_TILE0 * 128) ? (i - SH_TILE0 * 128) : 0;
    const f32x4 bv = *(const f32x4*)(br + lane * 4);
    for (int tb = bid * 4 + wid; tb < NTOK; tb += nb * 4 * 8) {
        int es[8]; float ws[8];
#pragma unroll
        for (int q = 0; q < 8; ++q) {
            const int t = tb + q * nb * 4;
            es[q] = 0; ws[q] = 0.f;
            if (t < NTOK) {
        const f32x4 lg = (*(const f32x4*)(p.LOG + (size_t)t * NEXP + lane * 4) + *(const f32x4*)(p.LOG + (size_t)NTOK * NEXP + (size_t)t * NEXP + lane * 4)) + *(const f32x4*)(p.LOG + (size_t)2 * NTOK * NEXP + (size_t)t * NEXP + lane * 4);
        float sc[4], bs[4];
#pragma unroll
        for (int i = 0; i < 4; ++i) { sc[i] = sigmoidf_(lg[i]); bs[i] = sc[i] + bv[i]; }
        float t1 = fmaxf(bs[0], bs[1]), t2 = fminf(bs[0], bs[1]);
        { const float a = fmaxf(bs[2], bs[3]), c = fminf(bs[2], bs[3]); const float n1 = fmaxf(t1, a); t2 = fmaxf(fminf(t1, a), fmaxf(t2, c)); t1 = n1; }
#pragma unroll
        for (int o = 1; o <= 4; o <<= 1) { const float o1 = __shfl_xor(t1, o), o2 = __shfl_xor(t2, o); const float n1 = fmaxf(t1, o1); t2 = fmaxf(fminf(t1, o1), fmaxf(t2, o2)); t1 = n1; }
        const float gsc = t1 + t2;
        const int g = lane >> 3;
        int rank = 0;
#pragma unroll
        for (int g2 = 0; g2 < 8; ++g2) { const float o = __shfl(gsc, g2 * 8); rank += (o > gsc || (o == gsc && g2 < g)) ? 1 : 0; }
        const bool allowed = rank < 4;
        float cv[4];
#pragma unroll
        for (int i = 0; i < 4; ++i) cv[i] = allowed ? bs[i] : -3e38f;
        float wsel = 0.f; int esel = 0; float wsum = 0.f;
#pragma unroll
        for (int k = 0; k < 8; ++k) {
            float bvv = cv[0]; int bi = 0;
#pragma unroll
            for (int i = 1; i < 4; ++i) if (cv[i] > bvv) { bvv = cv[i]; bi = i; }
            int be = lane * 4 + bi;
#pragma unroll
            for (int o = 1; o <= 32; o <<= 1) { const float ov = __shfl_xor(bvv, o); const int oe = __shfl_xor(be, o); if (ov > bvv || (ov == bvv && oe < be)) { bvv = ov; be = oe; } }
            const int ol = be >> 2, oi = be & 3;
            float sown = 0.f;
#pragma unroll
            for (int i = 0; i < 4; ++i) if (oi == i) sown = sc[i];
            const float sv = __shfl(sown, ol);
            if (lane == ol) {
#pragma unroll
                for (int i = 0; i < 4; ++i) if (oi == i) cv[i] = -3e38f;
            }
            wsum += sv;
            if (lane == k) { wsel = sv; esel = be; }
        }
        es[q] = esel; ws[q] = wsel / wsum * 2.5f;
            }
        }
        int rk[8];
#pragma unroll
        for (int q = 0; q < 8; ++q) { rk[q] = 0; if (lane < 8 && tb + q * nb * 4 < NTOK) rk[q] = atomicAdd(&p.cnt[(bid & 31) * NEXP + es[q]], 1); }
#pragma unroll
        for (int q = 0; q < 8; ++q) { const int t = tb + q * nb * 4; if (lane < 8 && t < NTOK) { p.eidx[t * 8 + lane] = es[q]; p.ew[t * 8 + lane] = ws[q]; p.erank[t * 8 + lane] = rk[q]; } }
    }
}
__device__ __forceinline__ void phase_scatter(char* lds, int bid, int nb, const P& p) {
    int* base = (int*)lds;
    int* pc = base + 260;
    int* so = base + 520;
    const int tid = tidx();
    __syncthreads();
    { int c = 0;
#pragma unroll
      for (int sb = 0; sb < 32; ++sb) { so[sb * 256 + tid] = c; c += p.cnt[sb * NEXP + tid]; }
      pc[tid] = (c + 127) & ~127; }
    __syncthreads();
    { int s = 0; for (int e = 0; e < tid; ++e) s += pc[e]; base[tid] = s; if (tid == 255) base[256] = s + pc[255]; }
    __syncthreads();
    const int tpb = nb * 4;
    for (int a = bid * 256 + tid; a < NTOK * 8; a += nb * 256) {
        const int e = p.eidx[a]; const int t = a >> 3; const int sb = ((t % tpb) >> 2) & 31;
        const int row = base[e] + so[sb * 256 + e] + p.erank[a];
        p.rowtok[row] = t; p.epos[a] = row;
    }
    if (bid == 0) {
        {
            const int xq = tid & 7; int off = 0, tot = 0;
            for (int e = xq; e < 256; e += 8) { const int n = ((pc[e] >> 7) + 1) >> 1; if (e < tid) off += n; tot += n; }
            const int t0 = base[tid] >> 7, nte = pc[tid] >> 7;
            for (int i = 0; i < nte; i += 2) p.plist[xq * 320 + off + (i >> 1)] = (t0 + i) | ((i + 1 < nte) ? 0 : 0x40000000);
            if (tid < 64) { int totp = 0; for (int e = (tid & 7); e < 256; e += 8) totp += ((pc[e] >> 7) + 1) >> 1; p.plist[(tid & 7) * 320 + totp + (tid >> 3)] = SH_TILE0 + 2 * tid; }
            if (tid < 8) p.plen[tid] = tot + 8;
        }
        const int nrt = base[256] >> 7;
        for (int i = tid; i < NTILES; i += 256) if (i >= nrt) p.tile_e[i] = (i >= SH_TILE0) ? NEXP : -1;
        const int t0 = base[tid] >> 7, t1 = base[tid + 1] >> 7;
        for (int i = t0; i < t1; ++i) p.tile_e[i] = tid;
    }
    __syncthreads();
}
__device__ __forceinline__ void phase_moe1(char* lds, int bid, int nb, const P& p, int layer, const bf16_t* Xb) {
    const int tid = tidx(), lane = tid & 63, wid = tid >> 6, wr = wid >> 1, wc = wid & 1, fr = lane & 15, fq = lane >> 4;
    const int xq = bid & 7, tot = p.plen[xq] * 4, stp = nb >> 3;
    int Rr[4], Cc[4];
#pragma unroll
    for (int i = 0; i < 4; ++i) dma_rc32(lane, wid + 4 * i, Rr[i], Cc[i]);
    int ui = bid >> 3;
    int ent0 = 0, e0 = 0, tok0[4] = {0, 0, 0, 0}, ent1 = 0;
    if (ui < tot) { ent0 = p.plist[xq * 320 + (ui >> 2)]; const int t0 = ent0 & 0xffff, t1 = ((ent0 >> 30) & 1) ? t0 : t0 + 1; e0 = p.tile_e[t0];
#pragma unroll
        for (int i = 0; i < 4; ++i) tok0[i] = p.rowtok[(Rr[i] < 128 ? t0 : t1) * 128 + (Rr[i] & 127)]; }
    if (ui + stp < tot) ent1 = p.plist[xq * 320 + ((ui + stp) >> 2)];
    for (; ui < tot; ui += stp) {
        const int nt = ui & 3;
        const int ent = ent0, e = e0;
        const int tile0 = ent & 0xffff, single = (ent >> 30) & 1, tile1 = single ? tile0 : tile0 + 1;
        Dma3A al; al.base = (const char*)Xb;
#pragma unroll
        for (int i = 0; i < 4; ++i) al.voff[i] = (unsigned)(((size_t)tok0[i] * DM + Cc[i]) * 2);
        if (ui + stp < tot) { ent0 = ent1; const int t0 = ent0 & 0xffff, t1 = ((ent0 >> 30) & 1) ? t0 : t0 + 1; e0 = p.tile_e[t0];
#pragma unroll
            for (int i = 0; i < 4; ++i) tok0[i] = p.rowtok[(Rr[i] < 128 ? t0 : t1) * 128 + (Rr[i] & 127)]; }
        if (ui + 2 * stp < tot) ent1 = p.plist[xq * 320 + ((ui + 2 * stp) >> 2)];
        const float* Wg = (e < NEXP) ? p.w_gate + ((size_t)layer * NEXP + e) * (DM * 256) : p.ws_gate + (size_t)layer * (DM * 256);
        const float* Wu = (e < NEXP) ? p.w_up + ((size_t)layer * NEXP + e) * (DM * 256) : p.ws_up + (size_t)layer * (DM * 256);
        Reg3B bl; { const int nq = tid & 31, kg = tid >> 5; const int j = nq * 4, jw = j & 63, w2 = j >> 6; const int col = nt * 64 + w2 * 32 + (jw & 31);
            bl.ldb = 256; bl.bp = ((jw >= 32) ? Wu : Wg) + (size_t)(kg * 4) * 256 + col; }
        f32x4 acc[32];
        gemm_core4(al, bl, DM / 32, acc, single != 0);
        if (!(wr && single)) {
            const int tile = wr ? tile1 : tile0;
#pragma unroll
            for (int i = 0; i < 8; ++i)
#pragma unroll
                for (int n = 0; n < 2; ++n) {
                    const int row = tile * 128 + i * 16 + fr, col = nt * 64 + wc * 32 + n * 16 + fq * 4;
                    const f32x4 g = acc[i * 4 + n], uu = acc[i * 4 + n + 2];
                    u32x2 w; w.x = pack2(siluf_(g[0]) * uu[0], siluf_(g[1]) * uu[1]); w.y = pack2(siluf_(g[2]) * uu[2], siluf_(g[3]) * uu[3]);
                    *(u32x2*)(p.H + (size_t)row * 256 + col) = w;
                }
        }
    }
}
__device__ __forceinline__ void phase_moe2(char* lds, int bid, int nb, const P& p, int layer) {
    const int tid = tidx(), lane = tid & 63, wid = tid >> 6, wr = wid >> 1, wc = wid & 1, fr = lane & 15, fq = lane >> 4;
    const int xq = bid & 7, tot = p.plen[xq] * 8, stp = nb >> 3;
    int Rr[4], Cc[4];
#pragma unroll
    for (int i = 0; i < 4; ++i) dma_rc32(lane, wid + 4 * i, Rr[i], Cc[i]);
    int ui = bid >> 3;
    int ent0 = 0, e0 = 0, ent1 = 0;
    if (ui < tot) { ent0 = p.plist[xq * 320 + (ui >> 3)]; e0 = p.tile_e[ent0 & 0xffff]; }
    if (ui + stp < tot) ent1 = p.plist[xq * 320 + ((ui + stp) >> 3)];
    for (; ui < tot; ui += stp) {
        const int nt = ui & 7;
        const int ent = ent0, e = e0;
        const int tile0 = ent & 0xffff, single = (ent >> 30) & 1, tile1 = single ? tile0 : tile0 + 1;
        if (ui + stp < tot) { ent0 = ent1; e0 = p.tile_e[ent0 & 0xffff]; }
        if (ui + 2 * stp < tot) ent1 = p.plist[xq * 320 + ((ui + 2 * stp) >> 3)];
        const float* Wd = (e < NEXP) ? p.w_down + ((size_t)layer * NEXP + e) * (256 * DM) : p.ws_down + (size_t)layer * (256 * DM);
        Dma3A al; al.base = (const char*)p.H;
#pragma unroll
        for (int i = 0; i < 4; ++i) al.voff[i] = (unsigned)(((size_t)((Rr[i] < 128 ? tile0 : tile1) * 128 + (Rr[i] & 127)) * 256 + Cc[i]) * 2);
        Reg3B bl; { const int nq = tid & 31, kg = tid >> 5; bl.ldb = DM; bl.bp = Wd + (size_t)(kg * 4) * DM + nt * 128 + nq * 4; }
        f32x4 acc[32];
        gemm_core4(al, bl, 256 / 32, acc, single != 0);
        if (!(wr && single)) {
            const int tile = wr ? tile1 : tile0;
#pragma unroll
            for (int i = 0; i < 8; ++i)
#pragma unroll
                for (int n = 0; n < 4; ++n) {
                    const int row = tile * 128 + i * 16 + fr, col = nt * 128 + wc * 64 + n * 16 + fq * 4;
                    const f32x4 a = acc[i * 4 + n];
                    u32x2 w; w.x = pack2(a[0], a[1]); w.y = pack2(a[2], a[3]);
                    *(u32x2*)(p.Y + (size_t)row * DM + col) = w;
                }
        }
    }
}
__device__ __forceinline__ void phase_combine_ln(int bid, int nb, const P& p, const float* X, const float* g, const float* b, float* of, bf16_t* ob, bf16_t* ol) {
    const int lane = tidx() & 63, wid = tidx() >> 6;
    int row = bid * 4 + wid;
    int npos = 0; float nw = 0.f;
    if (row < NTOK && lane < 8) { npos = p.epos[row * 8 + lane]; nw = p.ew[row * 8 + lane]; }
    for (; row < NTOK; row += nb * 4) {
        const int cpos = npos; const float cw = nw;
        { const int nr = row + nb * 4; if (nr < NTOK && lane < 8) { npos = p.epos[nr * 8 + lane]; nw = p.ew[nr * 8 + lane]; } }
        float v[16];
#pragma unroll
        for (int h = 0; h < 2; ++h) {
            const size_t o = (size_t)row * DM + h * 512 + lane * 8;
            const u32x4 xh = *(const u32x4*)(p.XAb + o), xl = *(const u32x4*)(p.XAl + o);
            v[h * 8 + 0] = DN_ALPHA * (bf2f(xh.x & 0xffffu) + bf2f(xl.x & 0xffffu)); v[h * 8 + 1] = DN_ALPHA * (bf2f(xh.x >> 16) + bf2f(xl.x >> 16));
            v[h * 8 + 2] = DN_ALPHA * (bf2f(xh.y & 0xffffu) + bf2f(xl.y & 0xffffu)); v[h * 8 + 3] = DN_ALPHA * (bf2f(xh.y >> 16) + bf2f(xl.y >> 16));
            v[h * 8 + 4] = DN_ALPHA * (bf2f(xh.z & 0xffffu) + bf2f(xl.z & 0xffffu)); v[h * 8 + 5] = DN_ALPHA * (bf2f(xh.z >> 16) + bf2f(xl.z >> 16));
            v[h * 8 + 6] = DN_ALPHA * (bf2f(xh.w & 0xffffu) + bf2f(xl.w & 0xffffu)); v[h * 8 + 7] = DN_ALPHA * (bf2f(xh.w >> 16) + bf2f(xl.w >> 16));
        }
#pragma unroll
        for (int k = 0; k < 9; ++k) {
            const int yr = (k < 8) ? __shfl(cpos, k) : (SH_TILE0 * 128 + row);
            const float w = (k < 8) ? __shfl(cw, k) : 1.0f;
#pragma unroll
            for (int h = 0; h < 2; ++h) {
                const u32x4 y = *(const u32x4*)(p.Y + (size_t)yr * DM + h * 512 + lane * 8);
                v[h * 8 + 0] += w * bf2f(y.x & 0xffffu); v[h * 8 + 1] += w * bf2f(y.x >> 16);
                v[h * 8 + 2] += w * bf2f(y.y & 0xffffu); v[h * 8 + 3] += w * bf2f(y.y >> 16);
                v[h * 8 + 4] += w * bf2f(y.z & 0xffffu); v[h * 8 + 5] += w * bf2f(y.z >> 16);
                v[h * 8 + 6] += w * bf2f(y.w & 0xffffu); v[h * 8 + 7] += w * bf2f(y.w >> 16);
            }
        }
        ln_row_store(v, g, b, of, ob, row, lane, ol);
    }
}

__device__ __forceinline__ void phase_moba_kmean(int bid, int nb, const P& p) {
    const int tid = tidx();
    for (int u = (nb >= 256 ? bid - 128 : bid); u < NBATCH * 8; u += nb) {
        if (u < 0) continue;
        const int b = u >> 3, j = u & 7;
        const bf16_t* src = p.MK + (size_t)(b * SEQ + j * 256) * 512 + tid * 2;
        float s0 = 0.f, s1 = 0.f;
        for (int r8 = 0; r8 < 256; r8 += 8) {
            unsigned v[8];
#pragma unroll
            for (int i = 0; i < 8; ++i) v[i] = *(const unsigned*)(src + (size_t)(r8 + i) * 512);
#pragma unroll
            for (int i = 0; i < 8; ++i) { s0 += bf2f(v[i] & 0xffffu); s1 += bf2f(v[i] >> 16); }
        }
        const int h = tid >> 5, d = (tid & 31) * 2;
        p.KM[((size_t)(b * 8 + h) * 8 + j) * 64 + d] = s0 * (1.0f / 256.0f);
        p.KM[((size_t)(b * 8 + h) * 8 + j) * 64 + d + 1] = s1 * (1.0f / 256.0f);
    }
}
__device__ __forceinline__ void gemm_t_unit(const bf16_t* Wt, int wrow0, const bf16_t* X, int tok0, bf16_t* dst, int ncol, int col0) {
    const int tid = tidx(), lane = tid & 63, wid = tid >> 6, wr = wid >> 1, wc = wid & 1, fr = lane & 15, fq = lane >> 4;
    Dma3A al; al.set_dense(Wt, wrow0, DM); Dma3B bl; bl.set(X, X, tok0, DM, 1 << 30);
    f32x4 acc[32];
    gemm_core4(al, bl, DM / 32, acc);
#pragma unroll
    for (int i = 0; i < 8; ++i)
#pragma unroll
        for (int n = 0; n < 4; ++n) {
            const int vc = col0 + wr * 128 + i * 16 + fr, r0 = tok0 + wc * 64 + n * 16 + fq * 4;
            const int b = r0 >> 11, t0 = r0 & (SEQ - 1);
            const f32x4 a = acc[i * 4 + n];
            u32x2 w; w.x = pack2(a[0], a[1]); w.y = pack2(a[2], a[3]);
            *(u32x2*)(dst + ((size_t)(b * ncol + vc)) * SEQ + t0) = w;
        }
}
__device__ __forceinline__ void phase_inproj0(char* lds, int bid, int nb, const P& p) {
    const int ntn = 20, nk = DM / 32;
    const int tid = tidx(), lane = tid & 63, wid = tid >> 6, wr = wid >> 1, wc = wid & 1, fr = lane & 15, fq = lane >> 4;
    for (int i = bid * 256 + tid; i < 2 * 8 * 64 * 64; i += nb * 256) {
        const int which = i >> 15, e = i & 32767, h = e >> 12, j = (e >> 6) & 63, ii = e & 63;
        const float v = (which ? p.wx : p.wa)[(h * 64 + ii) * 64 + j];
        (which ? p.WXT : p.WAT)[e] = (bf16_t)f2bf(v);
    }
    for (int jj = 0;; ++jj) {
        int tm, tn; if (!dense_unit3(bid, nb, jj, ntn, tm, tn)) break;
        Dma3A al; al.set_dense(p.XIb, tm * 256, DM); Dma3B bl; bl.set(p.WIN0, p.WIN0, tn * 128, DM, 1 << 30);
        f32x4 acc[32];
        gemm_core4(al, bl, nk, acc);
#pragma unroll
        for (int i = 0; i < 8; ++i)
#pragma unroll
            for (int n = 0; n < 4; ++n) {
                const int row = tm * 256 + wr * 128 + i * 16 + fr, col = tn * 128 + wc * 64 + n * 16 + fq * 4;
                const f32x4 a = acc[i * 4 + n];
                u32x2 w; w.x = pack2(a[0], a[1]); w.y = pack2(a[2], a[3]);
                *(u32x2*)(p.UB0 + (size_t)row * 2560 + col) = w;
            }
    }
    for (int u = (nb >= 512 ? bid - 256 : bid); u < 2 * 128; u += nb) { if (u < 0) continue; const int pn = u & 1, tt = u >> 1; gemm_t_unit(p.WIN0, 2560 + pn * 256, p.XIb, tt * 128, p.VHt, 512, pn * 256); }
}

__device__ __forceinline__ int lds_off128(int r, int c) {
    const int st = (r >> 4) * 4 + (c >> 5), ob = (r & 15) * 64 + (c & 31) * 2;
    return st * 1024 + (ob ^ (((ob >> 9) & 1) << 5));
}
__device__ __forceinline__ float softplusf_(float x) { return fmaxf(x, 0.f) + log1pf(__expf(-fabsf(x))); }

#define LRU1_LDS (4 * 8192)
__device__ __forceinline__ void lru1_unit(char* lds, const P& p, int b, int ck, int half) {
    const int tid = tidx(), lane = tid & 63, w = tid >> 6, fr = lane & 15, fg = lane >> 4;
    char* xt = lds + w * 8192;
    const size_t n0 = (size_t)b * SEQ + ck * 64;
    __syncthreads();
    {
        const int h = half * 4 + w, c = h * 64 + lane;
        const float cw0 = p.conv_w[c], cw1 = p.conv_w[512 + c], cw2 = p.conv_w[1024 + c], cw3 = p.conv_w[1536 + c], cb = p.conv_b[c];
        float xm3 = 0.f, xm2 = 0.f, xm1 = 0.f;
        if (ck > 0) { xm3 = bf2f(p.UB0[(n0 - 3) * 2560 + c]); xm2 = bf2f(p.UB0[(n0 - 2) * 2560 + c]); xm1 = bf2f(p.UB0[(n0 - 1) * 2560 + c]); }
        __builtin_amdgcn_wave_barrier();
        for (int t16 = 0; t16 < 64; t16 += 16) {
            bf16_t raw[16];
#pragma unroll
            for (int i = 0; i < 16; ++i) raw[i] = p.UB0[(n0 + t16 + i) * 2560 + c];
#pragma unroll
            for (int i = 0; i < 16; ++i) {
                const float x = bf2f(raw[i]);
                const float xc = cb + cw0 * xm3 + cw1 * xm2 + cw2 * xm1 + cw3 * x;
                xm3 = xm2; xm2 = xm1; xm1 = x;
                *(bf16_t*)(xt + lds_off(t16 + i, lane & ~7) + (lane & 7) * 2) = (bf16_t)f2bf(xc);
            }
        }
        __builtin_amdgcn_wave_barrier();
        for (int jt = 0; jt < 4; ++jt) {
            const int cj = h * 64 + jt * 16 + fr;
            bf16x8 wra[2], wri[2];
#pragma unroll
            for (int ks = 0; ks < 2; ++ks) {
                wra[ks] = *(const bf16x8*)(p.WAT + (size_t)(h * 64 + jt * 16 + fr) * 64 + ks * 32 + fg * 8);
                wri[ks] = *(const bf16x8*)(p.WXT + (size_t)(h * 64 + jt * 16 + fr) * 64 + ks * 32 + fg * 8);
            }
            const float bav = p.ba[cj], bxv = p.bx[cj], sp = softplusf_(-p.lam[cj]);
            float mA = 1.f, mB = 0.f;
#pragma unroll
            for (int tt = 0; tt < 4; ++tt) {
                const bf16x8 a0 = *(const bf16x8*)(xt + lds_off(tt * 16 + fr, fg * 8)), a1 = *(const bf16x8*)(xt + lds_off(tt * 16 + fr, 32 + fg * 8));
                f32x4 ar = __builtin_amdgcn_mfma_f32_16x16x32_bf16(a0, wra[0], (f32x4){0.f, 0.f, 0.f, 0.f}, 0, 0, 0);
                ar = __builtin_amdgcn_mfma_f32_16x16x32_bf16(a1, wra[1], ar, 0, 0, 0);
                f32x4 ai = __builtin_amdgcn_mfma_f32_16x16x32_bf16(a0, wri[0], (f32x4){0.f, 0.f, 0.f, 0.f}, 0, 0, 0);
                ai = __builtin_amdgcn_mfma_f32_16x16x32_bf16(a1, wri[1], ai, 0, 0, 0);
                float sA = 1.f, sB = 0.f;
#pragma unroll
                for (int r = 0; r < 4; ++r) {
                    const int t = tt * 16 + fg * 4 + r;
                    const float rg = sigmoidf_(ar[r] + bav), ig = sigmoidf_(ai[r] + bxv);
                    const float log_a = -8.0f * rg * sp;
                    const float a = __expf(log_a);
                    const float mult = (ck == 0 && t == 0) ? 1.0f : sqrtf(fmaxf(1.0f - a * a, 0.f));
                    const int jj = jt * 16 + fr;
                    const float xcv = bf2f(*(const bf16_t*)(xt + lds_off(t, jj & ~7) + (jj & 7) * 2));
                    const float bt = mult * ig * xcv;
                    p.LA[(n0 + t) * 512 + cj] = a; p.LB[(n0 + t) * 512 + cj] = bt;
                    sB = a * sB + bt; sA = a * sA;
                }
                float tA = 1.f, tB = 0.f;
#pragma unroll
                for (int g2 = 0; g2 < 4; ++g2) {
                    const float oA = __shfl(sA, g2 * 16 + fr), oB = __shfl(sB, g2 * 16 + fr);
                    tB = oA * tB + oB; tA = oA * tA;
                }
                mB = tA * mB + tB; mA = tA * mA;
            }
            if (fg == 0) { p.CSA[((size_t)b * 32 + ck) * 512 + cj] = mA; p.CSB[((size_t)b * 32 + ck) * 512 + cj] = mB; }
        }
        __builtin_amdgcn_wave_barrier();
    }
}
__device__ __forceinline__ void lru2_unit(const P& p, int b, int ck, int half) {
    const int tid = tidx();
    const size_t n0 = (size_t)b * SEQ + ck * 64;
    {
        const int c = tid + 256 * half;
        float h = 0.f;
        for (int c8 = 0; c8 < ck; c8 += 8) {
            float ca[8], cb[8];
#pragma unroll
            for (int i = 0; i < 8; ++i) { const bool ok = c8 + i < ck; ca[i] = ok ? p.CSA[((size_t)b * 32 + c8 + i) * 512 + c] : 1.f; cb[i] = ok ? p.CSB[((size_t)b * 32 + c8 + i) * 512 + c] : 0.f; }
#pragma unroll
            for (int i = 0; i < 8; ++i) h = ca[i] * h + cb[i];
        }
        for (int t8 = 0; t8 < 64; t8 += 8) {
            float la[8], lb[8], gb[8];
#pragma unroll
            for (int i = 0; i < 8; ++i) { la[i] = p.LA[(n0 + t8 + i) * 512 + c]; lb[i] = p.LB[(n0 + t8 + i) * 512 + c]; gb[i] = bf2f(p.UB0[(n0 + t8 + i) * 2560 + 512 + c]); }
#pragma unroll
            for (int i = 0; i < 8; ++i) { h = la[i] * h + lb[i]; p.MIX[(n0 + t8 + i) * DM + c] = (bf16_t)f2bf(h * gelu_tanh(gb[i])); }
        }
    }
}

#define HG1_LDS (2 * 16384)
__device__ __forceinline__ float hg_lb(const P& p, int ch) {
    const float l0 = p.hg_lb[ch], l1 = p.hg_lb[512 + ch], l2 = p.hg_lb[1024 + ch]; const float mx = fmaxf(l0, fmaxf(l1, l2));
    const float e0 = __expf(l0 - mx), e1 = __expf(l1 - mx), e2 = __expf(l2 - mx); return e0 / (e0 + e1 + e2);
}
__device__ __forceinline__ void hg1_unit(char* lds, const P& p, int b, int h, int ck) {
    const int tid = tidx(), lane = tid & 63, w = tid >> 6, fr = lane & 15, fg = lane >> 4;
    char* kh = lds;
    char* vt = lds + 16384;
    const size_t n0 = (size_t)b * SEQ + ck * 64;
    const int bhc = (b * 4 + h) * 32 + ck;
    __syncthreads();
    if (tid < 128) {
        const int k = tid, ch = h * 128 + k;
        const float lbv = hg_lb(p, ch);
        float f[64];
#pragma unroll
        for (int t16 = 0; t16 < 64; t16 += 16) {
            bf16_t raw[16];
#pragma unroll
            for (int i = 0; i < 16; ++i) raw[i] = p.UB0[(n0 + t16 + i) * 2560 + 1536 + ch];
#pragma unroll
            for (int i = 0; i < 16; ++i) f[t16 + i] = lbv + (1.0f - lbv) * sigmoidf_(bf2f(raw[i]));
        }
        float suf = 1.0f;
#pragma unroll
        for (int t8 = 56; t8 >= 0; t8 -= 8) {
            float kv[8];
#pragma unroll
            for (int i = 7; i >= 0; --i) { kv[i] = (1.0f - f[t8 + i]) * suf; suf *= f[t8 + i]; }
            u32x4 wv; wv.x = pack2(kv[0], kv[1]); wv.y = pack2(kv[2], kv[3]); wv.z = pack2(kv[4], kv[5]); wv.w = pack2(kv[6], kv[7]);
            *(u32x4*)(kh + lds_off(k, t8)) = wv;
        }
        p.DV[(size_t)bhc * 128 + k] = suf;
    } else {
        const int q = tid - 128;
#pragma unroll
        for (int i = 0; i < 8; ++i) { const int pc = q + 128 * i, v = pc >> 3, c8 = pc & 7;
            *(u32x4*)(vt + lds_off(v, c8 * 8)) = *(const u32x4*)(p.VHt + ((size_t)(b * 512 + h * 128 + v)) * SEQ + ck * 64 + c8 * 8); }
    }
    __syncthreads();
    bf16_t* ut = p.UT + (size_t)bhc * 16384;
#pragma unroll
    for (int kk = 0; kk < 2; ++kk) {
        const int kt = w * 2 + kk;
        const bf16x8 a0 = *(const bf16x8*)(kh + lds_off(kt * 16 + fr, fg * 8)), a1 = *(const bf16x8*)(kh + lds_off(kt * 16 + fr, 32 + fg * 8));
#pragma unroll
        for (int v8 = 0; v8 < 8; ++v8) {
            const bf16x8 b0 = *(const bf16x8*)(vt + lds_off(v8 * 16 + fr, fg * 8)), b1 = *(const bf16x8*)(vt + lds_off(v8 * 16 + fr, 32 + fg * 8));
            f32x4 acc = __builtin_amdgcn_mfma_f32_16x16x32_bf16(a0, b0, (f32x4){0.f, 0.f, 0.f, 0.f}, 0, 0, 0);
            acc = __builtin_amdgcn_mfma_f32_16x16x32_bf16(a1, b1, acc, 0, 0, 0);
            u32x2 wv; wv.x = pack2(acc[0], acc[1]); wv.y = pack2(acc[2], acc[3]);
            *(u32x2*)(ut + (size_t)(v8 * 16 + fr) * 128 + kt * 16 + fg * 4) = wv;
        }
    }
}
__device__ __forceinline__ void phase_hg2(int bid, int nb, const P& p) {
    for (int it = bid * 256 + tidx(); it < 32 * 4096; it += nb * 256) {
        const int bh = it >> 12, e4 = (it & 4095) * 4, k4 = e4 & 127;
        float S0 = 0.f, S1 = 0.f, S2 = 0.f, S3 = 0.f;
        for (int c8 = 0; c8 < 32; c8 += 8) {
            u32x2 uv[8]; f32x4 dv[8];
#pragma unroll
            for (int i = 0; i < 8; ++i) { uv[i] = *(const u32x2*)(p.UT + ((size_t)(bh * 32 + c8 + i)) * 16384 + e4); dv[i] = *(const f32x4*)(p.DV + (size_t)(bh * 32 + c8 + i) * 128 + k4); }
#pragma unroll
            for (int i = 0; i < 8; ++i) {
                u32x2 wv; wv.x = pack2(S0, S1); wv.y = pack2(S2, S3);
                *(u32x2*)(p.SP + ((size_t)(bh * 32 + c8 + i)) * 16384 + e4) = wv;
                S0 = dv[i][0] * S0 + bf2f(uv[i].x & 0xffffu); S1 = dv[i][1] * S1 + bf2f(uv[i].x >> 16);
                S2 = dv[i][2] * S2 + bf2f(uv[i].y & 0xffffu); S3 = dv[i][3] * S3 + bf2f(uv[i].y >> 16);
            }
        }
    }
}
#define HG3_QP 0
#define HG3_KP 40960
#define HG3_VT (40960 + 16384)
#define HG3_LDS (40960 + 16384 + 128 * 144)
__device__ __forceinline__ int hg3_qp_base(int j) { return j == 0 ? 0 : (j == 1 ? 16384 : (j == 2 ? 28672 : 36864)); }
__device__ __forceinline__ void hg3_unit(char* lds, const P& p, int b, int h, int ck) {
    const int tid = tidx(), lane = tid & 63, w = tid >> 6, fr = lane & 15, fg = lane >> 4;
    char* qp = lds + HG3_QP; char* kp = lds + HG3_KP; char* vt = lds + HG3_VT;
    const size_t n0 = (size_t)b * SEQ + ck * 64;
    const int bhc = (b * 4 + h) * 32 + ck;
    __syncthreads();
    if (tid < 128) {
        const int k = tid, ch = h * 128 + k;
        const float lbv = hg_lb(p, ch);
        const int ke = (k & 7) * 2, k8 = k & ~7;
        float d0 = 1.f, d1 = 1.f, d2 = 1.f, d3 = 1.f;
#pragma unroll
        for (int i = 0; i < 4; ++i) {
            bf16_t rq[16], rf[16];
#pragma unroll
            for (int tt = 0; tt < 16; ++tt) { rq[tt] = p.UB0[(n0 + i * 16 + tt) * 2560 + 1024 + ch]; rf[tt] = p.UB0[(n0 + i * 16 + tt) * 2560 + 1536 + ch]; }
#pragma unroll
            for (int tt = 0; tt < 16; ++tt) {
                const int t = i * 16 + tt;
                const float qv = siluf_(bf2f(rq[tt]));
                const float f = lbv + (1.0f - lbv) * sigmoidf_(bf2f(rf[tt]));
                d0 *= f; if (i >= 1) d1 *= f; if (i >= 2) d2 *= f; if (i >= 3) d3 *= f;
                const float di = (i == 0) ? d0 : (i == 1 ? d1 : (i == 2 ? d2 : d3));
                *(bf16_t*)(kp + lds_off128(t, k8) + ke) = (bf16_t)f2bf((1.0f - f) * __builtin_amdgcn_rcpf(fmaxf(di, 1.8e-35f)));
                *(bf16_t*)(qp + hg3_qp_base(0) + lds_off128(t, k8) + ke) = (bf16_t)f2bf(qv * d0);
                if (i >= 1) *(bf16_t*)(qp + hg3_qp_base(1) + lds_off128(t - 16, k8) + ke) = (bf16_t)f2bf(qv * d1);
                if (i >= 2) *(bf16_t*)(qp + hg3_qp_base(2) + lds_off128(t - 32, k8) + ke) = (bf16_t)f2bf(qv * d2);
                if (i >= 3) *(bf16_t*)(qp + hg3_qp_base(3) + lds_off128(t - 48, k8) + ke) = (bf16_t)f2bf(qv * d3);
            }
        }
    } else {
        const int q = tid - 128;
#pragma unroll
        for (int i = 0; i < 8; ++i) { const int pc = q + 128 * i, v = pc >> 3, c8 = pc & 7;
            *(u32x4*)(vt + v * 144 + c8 * 16) = *(const u32x4*)(p.VHt + ((size_t)(b * 512 + h * 128 + v)) * SEQ + ck * 64 + c8 * 8); }
    }
    __syncthreads();
    f32x4 acc[8];
#pragma unroll
    for (int v8 = 0; v8 < 8; ++v8) acc[v8] = (f32x4){0.f, 0.f, 0.f, 0.f};
    if (ck > 0) {
        const bf16_t* sp = p.SP + (size_t)bhc * 16384;
#pragma unroll
        for (int ks = 0; ks < 4; ++ks) {
            const bf16x8 bq = *(const bf16x8*)(qp + hg3_qp_base(0) + lds_off128(w * 16 + fr, ks * 32 + fg * 8));
#pragma unroll
            for (int v8 = 0; v8 < 8; ++v8) {
                const bf16x8 as = *(const bf16x8*)(sp + (size_t)(v8 * 16 + fr) * 128 + ks * 32 + fg * 8);
                acc[v8] = __builtin_amdgcn_mfma_f32_16x16x32_bf16(as, bq, acc[v8], 0, 0, 0);
            }
        }
    }
#pragma unroll
    for (int jp = 0; jp < 2; ++jp) {
        if (2 * jp > w) continue;
        f32x4 at[2];
#pragma unroll
        for (int jj = 0; jj < 2; ++jj) {
            const int j = 2 * jp + jj;
            at[jj] = (f32x4){0.f, 0.f, 0.f, 0.f};
            if (j <= w) {
#pragma unroll
                for (int ks = 0; ks < 4; ++ks) {
                    const bf16x8 ak = *(const bf16x8*)(kp + lds_off128(j * 16 + fr, ks * 32 + fg * 8));
                    const bf16x8 bq = *(const bf16x8*)(qp + hg3_qp_base(j) + lds_off128((w - j) * 16 + fr, ks * 32 + fg * 8));
                    at[jj] = __builtin_amdgcn_mfma_f32_16x16x32_bf16(ak, bq, at[jj], 0, 0, 0);
                }
                if (j == w) {
#pragma unroll
                    for (int r = 0; r < 4; ++r) at[jj][r] = (fg * 4 + r <= fr) ? at[jj][r] : 0.f;
                }
            }
        }
        u32x4 pw; pw.x = pack2(at[0][0], at[0][1]); pw.y = pack2(at[0][2], at[0][3]); pw.z = pack2(at[1][0], at[1][1]); pw.w = pack2(at[1][2], at[1][3]);
        const bf16x8 pf = __builtin_bit_cast(bf16x8, pw);
#pragma unroll
        for (int v8 = 0; v8 < 8; ++v8) {
            const char* vb = vt + (v8 * 16 + fr) * 144 + (jp * 32 + fg * 4) * 2;
            const u32x2 v0 = *(const u32x2*)vb, v1 = *(const u32x2*)(vb + 32);
            u32x4 vv; vv.x = v0.x; vv.y = v0.y; vv.z = v1.x; vv.w = v1.y;
            acc[v8] = __builtin_amdgcn_mfma_f32_16x16x32_bf16(__builtin_bit_cast(bf16x8, vv), pf, acc[v8], 0, 0, 0);
        }
    }
    float ss = 0.f;
#pragma unroll
    for (int v8 = 0; v8 < 8; ++v8)
#pragma unroll
        for (int r = 0; r < 4; ++r) ss += acc[v8][r] * acc[v8][r];
    ss += __shfl_xor(ss, 16); ss += __shfl_xor(ss, 32);
    const float rs = rsqrtf(ss * (1.0f / 128.0f) + 1e-6f);
    const size_t n = n0 + w * 16 + fr;
#pragma unroll
    for (int v8 = 0; v8 < 8; ++v8) {
        const int vcol = h * 128 + v8 * 16 + fg * 4;
        const u32x2 gv = *(const u32x2*)(p.UB0 + n * 2560 + 2048 + vcol);
        const f32x4 ng = *(const f32x4*)(p.hg_ng + vcol);
        const float y0 = acc[v8][0] * rs * ng[0] * sigmoidf_(bf2f(gv.x & 0xffffu)), y1 = acc[v8][1] * rs * ng[1] * sigmoidf_(bf2f(gv.x >> 16));
        const float y2 = acc[v8][2] * rs * ng[2] * sigmoidf_(bf2f(gv.y & 0xffffu)), y3 = acc[v8][3] * rs * ng[3] * sigmoidf_(bf2f(gv.y >> 16));
        u32x2 wv; wv.x = pack2(y0, y1); wv.y = pack2(y2, y3);
        *(u32x2*)(p.MIX + n * DM + 512 + vcol) = wv;
    }
}
__device__ __forceinline__ void phase_mix0_a(char* lds, int bid, int nb, const P& p) {
    for (int u = bid; u < 512 + 1024; u += nb) {
        if (u < 512) lru1_unit(lds, p, u >> 6, (u >> 1) & 31, u & 1);
        else { const int v = u - 512; hg1_unit(lds, p, v >> 7, (v >> 5) & 3, v & 31); }
    }
    __syncthreads();
}
__device__ __forceinline__ void phase_mix0_c(char* lds, int bid, int nb, const P& p) {
    for (int u = bid; u < 1024; u += nb) hg3_unit(lds, p, u >> 7, (u >> 5) & 3, u & 31);
    __syncthreads();
}

#ifndef KEEP_U
#define KEEP_U 0
#endif
__device__ __forceinline__ int vcol_actual(int v) { return v < 1280 ? v : (v < 2816 ? v + 24 : v - 1536); }
__device__ __forceinline__ void phase_inproj1(char* lds, int bid, int nb, const P& p) {
    const int ntn = 17, nk = DM / 32;
    const int tid = tidx(), lane = tid & 63, wid = tid >> 6, wr = wid >> 1, wc = wid & 1, fr = lane & 15, fq = lane >> 4;
    for (int jj = 0;; ++jj) {
        int tm, tn; if (!dense_unit3(bid, nb, jj, ntn, tm, tn)) break;
        Dma3A al; al.set_dense(p.XBb, tm * 256, DM); Dma3B bl; bl.set(p.WIN1, p.WIN1, tn * 128, DM, 1 << 30);
        f32x4 acc[32];
        gemm_core4(al, bl, nk, acc);
#pragma unroll
        for (int i = 0; i < 8; ++i)
#pragma unroll
            for (int n = 0; n < 4; ++n) {
                const int row = tm * 256 + wr * 128 + i * 16 + fr, vc = tn * 128 + wc * 64 + n * 16 + fq * 4;
                const f32x4 a = acc[i * 4 + n];
                u32x2 w; w.x = pack2(a[0], a[1]); w.y = pack2(a[2], a[3]);
                if (tn < 4) *(u32x2*)(p.Qb + (size_t)row * 512 + vc) = w;
                else if (tn < 6) *(f32x4*)(p.KCV + (size_t)row * 256 + vc - 512) = a;
                else if (tn == 6) *(u32x2*)(p.KS + (size_t)row * 128 + vc - 768) = w;
                else if (tn == 7) *(u32x2*)(p.KW + (size_t)row * 128 + vc - 896) = w;
                else if (tn < 12) *(u32x2*)(p.MQ + (size_t)row * 512 + vc - 1024) = w;
                else if (tn < 16) *(u32x2*)(p.MK + (size_t)row * 512 + vc - 1536) = w;
                else if (vc < 2072) *(f32x4*)(p.GATES + (size_t)row * 24 + vc - 2048) = a;
            }
    }
    for (int u = (nb >= 512 ? bid - 64 : bid); u < 3 * 128; u += nb) {
        if (u < 0) continue;
        const int pn = u % 3, tt = u / 3;
        if (pn == 0) {
            const int wrr = tidx() >> 7;
            gemm_t_unit(p.WIN1, 2176, p.XBb, tt * 128, wrr ? p.VWt - (size_t)128 * SEQ : p.VSt, 128, 0);
        } else gemm_t_unit(p.WIN1, 2432 + (pn - 1) * 256, p.XBb, tt * 128, p.MVt, 512, (pn - 1) * 256);
    }
}
__device__ __forceinline__ void phase_moba_gate(char* lds, int bid, int nb, const P& p) {
    const int lane = tidx() & 63, wid = tidx() >> 6;
    float* km = (float*)lds + 4096 + wid * 512;
    for (int it = bid * 4 + wid; it < 64 * 32; it += nb * 4) {
        const int bh = it >> 5, tb = it & 31, b = bh >> 3, h = bh & 7;
        const int t = tb * 64 + lane, ob = t >> 8;
        __builtin_amdgcn_wave_barrier();
#pragma unroll
        for (int i = 0; i < 8; ++i) km[i * 64 + lane] = p.KM[(size_t)bh * 512 + i * 64 + lane];
        __builtin_amdgcn_wave_barrier();
        u32x4 qr[8];
#pragma unroll
        for (int i = 0; i < 8; ++i) qr[i] = *(const u32x4*)(p.MQ + (size_t)(b * SEQ + t) * 512 + h * 64 + i * 8);
        float gate[8];
#pragma unroll
        for (int j = 0; j < 8; ++j) gate[j] = 0.f;
#pragma unroll
        for (int i = 0; i < 8; ++i) {
            float q[8];
            q[0] = bf2f(qr[i].x & 0xffffu); q[1] = bf2f(qr[i].x >> 16); q[2] = bf2f(qr[i].y & 0xffffu); q[3] = bf2f(qr[i].y >> 16);
            q[4] = bf2f(qr[i].z & 0xffffu); q[5] = bf2f(qr[i].z >> 16); q[6] = bf2f(qr[i].w & 0xffffu); q[7] = bf2f(qr[i].w >> 16);
#pragma unroll
            for (int j = 0; j < 8; ++j)
#pragma unroll
                for (int e = 0; e < 8; ++e) gate[j] += q[e] * km[j * 64 + i * 8 + e];
        }
#pragma unroll
        for (int j = 0; j < 8; ++j) gate[j] = (j < ob) ? gate[j] : NEGF;
        unsigned selm = 0;
#pragma unroll
        for (int j = 0; j < 8; ++j) {
            int rank = 0;
#pragma unroll
            for (int j2 = 0; j2 < 8; ++j2) rank += (gate[j2] > gate[j] || (gate[j2] == gate[j] && j2 < j)) ? 1 : 0;
            if (j < ob && rank < 3) selm |= 1u << j;
        }
        p.MSEL[(size_t)bh * SEQ + t] = selm;
    }
}

#define ATT_K_BYTES 8192
#define ATT_STAGE 16384
#define ATT_TILE_BYTES (3 * ATT_STAGE)
#define ATT_ORDER_OFF ATT_TILE_BYTES
#define ATT_RED_OFF (ATT_ORDER_OFF + 8192)
__device__ __forceinline__ void att_issue_tile(int stage, const bf16_t* Kg, int ldk, const bf16_t* Vg) {
    const int lane = tidx() & 63, w = tidx() >> 6;
#pragma unroll
    for (int i = 0; i < 2; ++i) { int R, C; dma_rc(lane, w + 4 * i, R, C);
        __builtin_amdgcn_global_load_lds((const unsigned*)(Kg + (size_t)R * ldk + C), (LAS unsigned*)((LAS char*)dyn_lds + stage * ATT_STAGE + (w + 4 * i) * 1024), 16, 0, 0);
        __builtin_amdgcn_global_load_lds((const unsigned*)(Vg + (size_t)R * SEQ + C), (LAS unsigned*)((LAS char*)dyn_lds + stage * ATT_STAGE + ATT_K_BYTES + (w + 4 * i) * 1024), 16, 0, 0); }
}
#define ATT_WAIT_BAR(n) do { asm volatile("s_waitcnt vmcnt(" #n ") lgkmcnt(0)" ::: "memory"); __builtin_amdgcn_s_barrier(); asm volatile("" ::: "memory"); } while (0)
struct AttState { f32x4 O[4][2]; float m[2], l[2]; };
__device__ __forceinline__ void att_reset(AttState& S) {
#pragma unroll
    for (int q = 0; q < 2; ++q) { S.m[q] = NEGF; S.l[q] = 0.f;
#pragma unroll
        for (int d = 0; d < 4; ++d) S.O[d][q] = (f32x4){0.f, 0.f, 0.f, 0.f}; }
}
template <bool MASKED>
__device__ __forceinline__ void att_step(const char* lds, const bf16x8 (&qf)[2][2], AttState& S, const f32x4 (&bini)[4], float slope2,
                                         int s0, int tq0, unsigned selbits  , int winlimit) {
    const int lane = tidx() & 63, fr = lane & 15, fg = lane >> 4;
    const char* ldsV = lds + ATT_K_BYTES;
    const float offbase = slope2 * (float)s0;
    f32x4 s[2][4];
#pragma unroll
    for (int kt = 0; kt < 4; ++kt) {
        const bf16x8 k0 = *(const bf16x8*)(lds + lds_off(kt * 16 + fr, fg * 8)), k1 = *(const bf16x8*)(lds + lds_off(kt * 16 + fr, 32 + fg * 8));
#pragma unroll
        for (int qt = 0; qt < 2; ++qt) {
            s[qt][kt] = __builtin_amdgcn_mfma_f32_16x16x32_bf16(k0, qf[qt][0], bini[kt], 0, 0, 0);
            s[qt][kt] = __builtin_amdgcn_mfma_f32_16x16x32_bf16(k1, qf[qt][1], s[qt][kt], 0, 0, 0);
        }
    }
    __builtin_amdgcn_sched_barrier(0);
    u32x4 pf[2][2];
#pragma unroll
    for (int qt = 0; qt < 2; ++qt) {
        const int tq = tq0 + qt * 16 + fr;
        const float off = ((selbits >> qt) & 1u) ? (offbase - slope2 * (float)tq) : -INFINITY;
        float mx = -INFINITY;
#pragma unroll
        for (int kt = 0; kt < 4; ++kt)
#pragma unroll
            for (int r = 0; r < 4; ++r) {
                float y = s[qt][kt][r];
                if (MASKED) { const int key = s0 + kt * 16 + fg * 4 + r; const bool ok = (key <= tq) && (tq - key < winlimit); y = ok ? y : -INFINITY; s[qt][kt][r] = y; }
                mx = fmaxf(mx, y);
            }
        mx = fmaxf(mx, __shfl_xor(mx, 16)); mx = fmaxf(mx, __shfl_xor(mx, 32));
        const float mnew = fmaxf(S.m[qt], mx + off);
        const float alpha = __builtin_amdgcn_exp2f(S.m[qt] - mnew);
        S.m[qt] = mnew;
        const float thr = mnew - off;
        float ls = 0.f;
#pragma unroll
        for (int kt = 0; kt < 4; ++kt)
#pragma unroll
            for (int r = 0; r < 4; ++r) { const float pr = __builtin_amdgcn_exp2f(s[qt][kt][r] - thr); s[qt][kt][r] = pr; ls += pr; }
        S.l[qt] = S.l[qt] * alpha + ls;
#pragma unroll
        for (int dt = 0; dt < 4; ++dt) S.O[dt][qt] *= alpha;
#pragma unroll
        for (int kk = 0; kk < 2; ++kk) {
            pf[qt][kk].x = pack2(s[qt][2 * kk][0], s[qt][2 * kk][1]); pf[qt][kk].y = pack2(s[qt][2 * kk][2], s[qt][2 * kk][3]);
            pf[qt][kk].z = pack2(s[qt][2 * kk + 1][0], s[qt][2 * kk + 1][1]); pf[qt][kk].w = pack2(s[qt][2 * kk + 1][2], s[qt][2 * kk + 1][3]);
        }
    }
    __builtin_amdgcn_sched_barrier(0);
#pragma unroll
    for (int kk = 0; kk < 2; ++kk)
#pragma unroll
        for (int dt = 0; dt < 4; ++dt) {
            const char* vb = ldsV + (fg & 1) * 8;
            const u32x2 v0 = *(const u32x2*)(vb + lds_off(dt * 16 + fr, kk * 32 + (fg >> 1) * 8)), v1 = *(const u32x2*)(vb + lds_off(dt * 16 + fr, kk * 32 + 16 + (fg >> 1) * 8));
            u32x4 vv; vv.x = v0.x; vv.y = v0.y; vv.z = v1.x; vv.w = v1.y;
            const bf16x8 vf = __builtin_bit_cast(bf16x8, vv);
#pragma unroll
            for (int qt = 0; qt < 2; ++qt) S.O[dt][qt] = __builtin_amdgcn_mfma_f32_16x16x32_bf16(vf, __builtin_bit_cast(bf16x8, pf[qt][kk]), S.O[dt][qt], 0, 0, 0);
        }
    __builtin_amdgcn_sched_barrier(0);
}
__device__ __forceinline__ unsigned wave_or(unsigned v) {
#pragma unroll
    for (int o = 32; o >= 1; o >>= 1) v |= (unsigned)__shfl_xor((int)v, o);
    return v;
}
__device__ __forceinline__ void att_nsa_unit(char* lds, const P& p, int b, int g, int qtile) {
    const int tid = tidx(), lane = tid & 63, w = tid >> 6, fr = lane & 15, fg = lane >> 4;
    const int hd = g * 4 + w, t0 = qtile * 32, own = qtile >> 1;
    const float slope2 = exp2f(-((float)hd + 0.5f)) * LOG2E, c1 = 0.125f * LOG2E;
    bf16x8 qf[2][2];
#pragma unroll
    for (int qt = 0; qt < 2; ++qt)
#pragma unroll
        for (int ks = 0; ks < 2; ++ks) qf[qt][ks] = *(const bf16x8*)(p.Qb + (size_t)(b * SEQ + t0 + qt * 16 + fr) * 512 + hd * 64 + ks * 32 + fg * 8);
#pragma unroll
    for (int qt = 0; qt < 2; ++qt)
#pragma unroll
        for (int ks = 0; ks < 2; ++ks) {
            const u32x4 raw = __builtin_bit_cast(u32x4, qf[qt][ks]); u32x4 o;
            o.x = pack2(bf2f(raw.x & 0xffffu) * c1, bf2f(raw.x >> 16) * c1); o.y = pack2(bf2f(raw.y & 0xffffu) * c1, bf2f(raw.y >> 16) * c1);
            o.z = pack2(bf2f(raw.z & 0xffffu) * c1, bf2f(raw.z >> 16) * c1); o.w = pack2(bf2f(raw.w & 0xffffu) * c1, bf2f(raw.w >> 16) * c1);
            qf[qt][ks] = __builtin_bit_cast(bf16x8, o);
        }
    f32x4 bini[4];
#pragma unroll
    for (int kt = 0; kt < 4; ++kt)
#pragma unroll
        for (int r = 0; r < 4; ++r) bini[kt][r] = slope2 * (float)(kt * 16 + fg * 4 + r);
    unsigned selw[2];
#pragma unroll
    for (int qt = 0; qt < 2; ++qt) selw[qt] = p.SELM[(size_t)(b * 2 + g) * SEQ + t0 + qt * 16 + fr];
    const unsigned um = wave_or(selw[0] | selw[1]);
    AttState S; att_reset(S);
    unsigned rem = um & ((own >= 31) ? 0xffffffffu : ((2u << own) - 1u));
    int wj = own >= 8 ? own - 8 : 0;
    int cbr, cj; bool has = true;
    if (rem) { cj = __ffs(rem) - 1; rem &= rem - 1; cbr = 0; } else { cj = wj++; cbr = 1; }
    const bf16_t* Ks = p.KS + (size_t)b * SEQ * 128 + g * 64; const bf16_t* Kw = p.KW + (size_t)b * SEQ * 128 + g * 64;
    const bf16_t* Vs = p.VSt + (size_t)(b * 128 + g * 64) * SEQ; const bf16_t* Vw = p.VWt + (size_t)(b * 128 + g * 64) * SEQ;
    int n1br = 0, n1j = 0; bool has1;
    if (rem) { n1j = __ffs(rem) - 1; rem &= rem - 1; n1br = 0; has1 = true; } else if (wj <= own) { n1j = wj++; n1br = 1; has1 = true; } else has1 = false;
    __syncthreads();
    att_issue_tile(0, (cbr ? Kw : Ks) + (size_t)cj * 64 * 128, 128, (cbr ? Vw : Vs) + cj * 64);
    if (has1) att_issue_tile(1, (n1br ? Kw : Ks) + (size_t)n1j * 64 * 128, 128, (n1br ? Vw : Vs) + n1j * 64);
    bool switched = false;
    int st = 0;
    while (has) {
        if (has1) ATT_WAIT_BAR(4); else ATT_WAIT_BAR(0);
        int n2br = 0, n2j = 0; bool has2;
        if (!has1) has2 = false;
        else if (rem) { n2j = __ffs(rem) - 1; rem &= rem - 1; n2br = 0; has2 = true; } else if (wj <= own) { n2j = wj++; n2br = 1; has2 = true; } else has2 = false;
        if (has2) att_issue_tile(st == 0 ? 2 : st - 1, (n2br ? Kw : Ks) + (size_t)n2j * 64 * 128, 128, (n2br ? Vw : Vs) + n2j * 64);
        const char* sl = lds + st * ATT_STAGE;
        if (cbr == 1 && !switched) {
            switched = true;
#pragma unroll
            for (int qt = 0; qt < 2; ++qt) {
                float lt = S.l[qt]; lt += __shfl_xor(lt, 16); lt += __shfl_xor(lt, 32);
                const size_t n = (size_t)b * SEQ + t0 + qt * 16 + fr;
                const float sc = sigmoidf_(p.GATES[n * 24 + hd * 3 + 1]) / fmaxf(lt, 1e-30f);
#pragma unroll
                for (int dt = 0; dt < 4; ++dt) { const f32x4 y = S.O[dt][qt] * sc; u32x2 w; w.x = pack2(y[0], y[1]); w.y = pack2(y[2], y[3]); *(u32x2*)((bf16_t*)p.OS + n * 512 + hd * 64 + dt * 16 + fg * 4) = w; }
            }
            att_reset(S);
        }
        unsigned sb = 3u; int wl = 1 << 30; bool msk;
        if (cbr == 0) { sb = ((selw[0] >> cj) & 1u) | (((selw[1] >> cj) & 1u) << 1); msk = (cj == own); }
        else { wl = 512; msk = (cj == own) || (cj + 8 == own); }
        if (msk) att_step<true>(sl, qf, S, bini, slope2, cj * 64, t0, sb, wl);
        else att_step<false>(sl, qf, S, bini, slope2, cj * 64, t0, sb, wl);
        cbr = n1br; cj = n1j; has = has1; n1br = n2br; n1j = n2j; has1 = has2;
        st = (st == 2) ? 0 : st + 1;
    }
#pragma unroll
    for (int qt = 0; qt < 2; ++qt) {
        float lt = S.l[qt]; lt += __shfl_xor(lt, 16); lt += __shfl_xor(lt, 32);
        const size_t n = (size_t)b * SEQ + t0 + qt * 16 + fr;
        const float sc = sigmoidf_(p.GATES[n * 24 + hd * 3 + 2]) / fmaxf(lt, 1e-30f);
        const float g0 = sigmoidf_(p.GATES[n * 24 + hd * 3 + 0]);
#pragma unroll
        for (int dt = 0; dt < 4; ++dt) {
            const size_t o = n * 512 + hd * 64 + dt * 16 + fg * 4;
            const u32x2 osv = *(const u32x2*)((const bf16_t*)p.OS + o), ocv = *(const u32x2*)((const bf16_t*)p.OC + o);
            const f32x4 osf = {bf2f(osv.x & 0xffffu), bf2f(osv.x >> 16), bf2f(osv.y & 0xffffu), bf2f(osv.y >> 16)};
            const f32x4 ocf = {bf2f(ocv.x & 0xffffu), bf2f(ocv.x >> 16), bf2f(ocv.y & 0xffffu), bf2f(ocv.y >> 16)};
            const f32x4 y = S.O[dt][qt] * sc + osf + ocf * g0;
            u32x2 wv; wv.x = pack2(y[0], y[1]); wv.y = pack2(y[2], y[3]);
            *(u32x2*)(p.MIX + n * DM + hd * 64 + dt * 16 + fg * 4) = wv;
        }
    }
}
__device__ __forceinline__ void att_moba_unit(char* lds, const P& p, int b, int h, int ob, int half) {
    const int tid = tidx(), lane = tid & 63, w = tid >> 6, fr = lane & 15, fg = lane >> 4;
    const int tq0 = ob * 256 + half * 128 + w * 32;
    const int dsub = half * 2 + (w >> 1), lastsub = half * 2 + 1;
    const float slope2 = exp2f(-((float)h + 1.0f)) * LOG2E, c1 = 0.125f * LOG2E;
    bf16x8 qf[2][2];
#pragma unroll
    for (int qt = 0; qt < 2; ++qt)
#pragma unroll
        for (int ks = 0; ks < 2; ++ks) qf[qt][ks] = *(const bf16x8*)(p.MQ + (size_t)(b * SEQ + tq0 + qt * 16 + fr) * 512 + h * 64 + ks * 32 + fg * 8);
#pragma unroll
    for (int qt = 0; qt < 2; ++qt)
#pragma unroll
        for (int ks = 0; ks < 2; ++ks) {
            const u32x4 raw = __builtin_bit_cast(u32x4, qf[qt][ks]); u32x4 o;
            o.x = pack2(bf2f(raw.x & 0xffffu) * c1, bf2f(raw.x >> 16) * c1); o.y = pack2(bf2f(raw.y & 0xffffu) * c1, bf2f(raw.y >> 16) * c1);
            o.z = pack2(bf2f(raw.z & 0xffffu) * c1, bf2f(raw.z >> 16) * c1); o.w = pack2(bf2f(raw.w & 0xffffu) * c1, bf2f(raw.w >> 16) * c1);
            qf[qt][ks] = __builtin_bit_cast(bf16x8, o);
        }
    f32x4 bini[4];
#pragma unroll
    for (int kt = 0; kt < 4; ++kt)
#pragma unroll
        for (int r = 0; r < 4; ++r) bini[kt][r] = slope2 * (float)(kt * 16 + fg * 4 + r);
    unsigned selw[2];
#pragma unroll
    for (int qt = 0; qt < 2; ++qt) selw[qt] = p.MSEL[(size_t)(b * 8 + h) * SEQ + tq0 + qt * 16 + fr];
    unsigned* red = (unsigned*)(lds + ATT_RED_OFF);
    const unsigned umw = wave_or(selw[0] | selw[1]);
    __syncthreads();
    if (lane == 0) red[w] = umw;
    __syncthreads();
    unsigned rem = (red[0] | red[1] | red[2] | red[3]) & ((1u << ob) - 1u);
    AttState S; att_reset(S);
    int cj, csub = 0; bool has = true;
    if (rem) { cj = __ffs(rem) - 1; rem &= rem - 1; } else cj = ob;
    const bf16_t* Kb = p.MK + (size_t)b * SEQ * 512 + h * 64; const bf16_t* Vb = p.MVt + (size_t)(b * 512 + h * 64) * SEQ;
#define MOBA_NEXT(J, SUB, NJ, NSUB, HAS) do { \
        if ((J) == ob) { if ((SUB) < lastsub) { NJ = (J); NSUB = (SUB) + 1; HAS = true; } else HAS = false; } \
        else if ((SUB) < 3) { NJ = (J); NSUB = (SUB) + 1; HAS = true; } \
        else { if (rem) { NJ = __ffs(rem) - 1; rem &= rem - 1; } else NJ = ob; NSUB = 0; HAS = true; } } while (0)
    int n1j = 0, n1sub = 0; bool has1;
    MOBA_NEXT(cj, csub, n1j, n1sub, has1);
    __syncthreads();
    att_issue_tile(0, Kb + (size_t)(cj * 256 + csub * 64) * 512, 512, Vb + cj * 256 + csub * 64);
    if (has1) att_issue_tile(1, Kb + (size_t)(n1j * 256 + n1sub * 64) * 512, 512, Vb + n1j * 256 + n1sub * 64);
    int st = 0;
    while (has) {
        if (has1) ATT_WAIT_BAR(4); else ATT_WAIT_BAR(0);
        int n2j = 0, n2sub = 0; bool has2 = false;
        if (has1) MOBA_NEXT(n1j, n1sub, n2j, n2sub, has2);
        if (has2) att_issue_tile(st == 0 ? 2 : st - 1, Kb + (size_t)(n2j * 256 + n2sub * 64) * 512, 512, Vb + n2j * 256 + n2sub * 64);
        const char* sl = lds + st * ATT_STAGE;
        const int s0 = cj * 256 + csub * 64;
        unsigned sb = 3u; bool msk = false, run = true;
        if (cj < ob) sb = ((selw[0] >> cj) & 1u) | (((selw[1] >> cj) & 1u) << 1);
        else { msk = (csub == dsub); run = (csub <= dsub); }
        if (run) {
            if (msk) att_step<true>(sl, qf, S, bini, slope2, s0, tq0, sb, 1 << 30);
            else att_step<false>(sl, qf, S, bini, slope2, s0, tq0, sb, 1 << 30);
        }
        cj = n1j; csub = n1sub; has = has1; n1j = n2j; n1sub = n2sub; has1 = has2;
        st = (st == 2) ? 0 : st + 1;
    }
#undef MOBA_NEXT
#pragma unroll
    for (int qt = 0; qt < 2; ++qt) {
        float lt = S.l[qt]; lt += __shfl_xor(lt, 16); lt += __shfl_xor(lt, 32);
        const size_t n = (size_t)b * SEQ + tq0 + qt * 16 + fr;
        const float sc = 1.0f / fmaxf(lt, 1e-30f);
#pragma unroll
        for (int dt = 0; dt < 4; ++dt) {
            const f32x4 y = S.O[dt][qt] * sc;
            u32x2 wv; wv.x = pack2(y[0], y[1]); wv.y = pack2(y[2], y[3]);
            *(u32x2*)(p.MIX + n * DM + 512 + h * 64 + dt * 16 + fg * 4) = wv;
        }
    }
}
#ifndef ATT_NSA
#define ATT_NSA 1
#endif
#ifndef ATT_MOBA
#define ATT_MOBA 1
#endif
__device__ __forceinline__ int att_class_key(int c) {
    if (c < 64) { const int a = (c >> 1) + 1; return (a < 16 ? a : 16) + (a < 9 ? a : 9); }
    const int ob = (c - 64) >> 1, half = (c - 64) & 1; return 4 * ob + 2 + 2 * half;
}
__device__ __forceinline__ void cmpa_unit(char* lds, const P& p, int b, int g, int qt64);
__device__ __forceinline__ void phase_attn_a(char* lds, int bid, int nb, const P& p) {
    int* order = (int*)(lds + 49152);
    __syncthreads();
    for (int u = tidx(); u < 1024; u += 256) {
        const int c = u & 15, inst = u >> 4;
        const int key = att_class_key(64 + c);
        int pos = inst;
        for (int c2 = 0; c2 < 16; ++c2) { const int k2 = att_class_key(64 + c2); if (k2 > key || (k2 == key && c2 < c)) pos += 64; }
        order[pos] = u;
    }
    __syncthreads();
    for (int r = 0;; ++r) {
        const int idx = r * nb + ((r & 1) ? (nb - 1 - bid) : bid);
        if (idx >= 512 + 1024) break;
        if (idx < 512) cmpa_unit(lds, p, idx >> 6, (idx >> 5) & 1, idx & 31);
        else { const int v = order[idx - 512]; att_moba_unit(lds, p, v >> 7, (v >> 4) & 7, (v >> 1) & 7, v & 1); }
    }
    __syncthreads();
}
__device__ __forceinline__ void phase_attn_b(char* lds, int bid, int nb, const P& p) {
    int* order = (int*)(lds + ATT_ORDER_OFF);
    __syncthreads();
    for (int u = tidx(); u < 1024; u += 256) {
        const int c = u & 63, inst = u >> 6;
        const int key = att_class_key(c);
        int pos = inst;
        for (int c2 = 0; c2 < 64; ++c2) { const int k2 = att_class_key(c2); if (k2 > key || (k2 == key && c2 < c)) pos += 16; }
        order[pos] = u;
    }
    __syncthreads();
    for (int r = 0;; ++r) {
        const int idx = r * nb + ((r & 1) ? (nb - 1 - bid) : bid);
        if (idx >= 1024) break;
        const int u = order[idx];
        att_nsa_unit(lds, p, u >> 7, (u >> 6) & 1, u & 63);
    }
    __syncthreads();
}

struct ALoadCmp {
    const float* base;
    const float* pe;
    int kt0;
    struct Regs { f32x4 v[8]; };
    __device__ __forceinline__ void load(int kt, Regs& R) const {
        const int l = kt + kt0;
        const f32x4 p0 = *(const f32x4*)(pe + l * 64), p1 = *(const f32x4*)(pe + l * 64 + 4);
#pragma unroll
        for (int i = 0; i < 4; ++i) {
            const int row = (tidx() + 256 * i) >> 3; int tok = 16 * row + l; tok = tok > SEQ - 1 ? SEQ - 1 : tok;
            const float* q = base + (size_t)tok * 256;
            R.v[2 * i] = *(const f32x4*)q + p0; R.v[2 * i + 1] = *(const f32x4*)(q + 4) + p1;
        }
    }
    __device__ __forceinline__ void store(int kt, const Regs& R, char* lds) const {
#pragma unroll
        for (int i = 0; i < 4; ++i) {
            const int p = tidx() + 256 * i, row = p >> 3, ch = p & 7;
            const f32x4 a = R.v[2 * i], b = R.v[2 * i + 1];
            u32x4 w; w.x = pack2(a[0], a[1]); w.y = pack2(a[2], a[3]); w.z = pack2(b[0], b[1]); w.w = pack2(b[2], b[3]);
            *(u32x4*)(lds + lds_off(row, ch * 8)) = w;
        }
    }
};
__device__ __forceinline__ void phase_cmp1(char* lds, int bid, int nb, const P& p) {
    const int tid = tidx(), lane = tid & 63, wid = tid >> 6, wr = wid >> 1, wc = wid & 1, fr = lane & 15, fq = lane >> 4;
    for (int u = bid; u < 16 * 2 * 4; u += nb) {
        const int split = u & 3, which = (u >> 2) & 1, bg = u >> 3, b = bg >> 1, g = bg & 1;
        ALoadCmp al; al.kt0 = split * 8; al.base = p.KCV + (size_t)b * SEQ * 256 + which * 128 + g * 64 + (tid & 7) * 8; al.pe = (which ? p.pe_v : p.pe_k) + (tid & 7) * 8;
        BLoadF32 bl; { const int nq = tid & 31, kg = tid >> 5; bl.valid = true; bl.ldb = 128; bl.nk1 = 1 << 30; bl.bp = (which ? p.wv1 : p.wk1) + (size_t)(split * 8 * 64 + kg * 8) * 128 + nq * 4; }
        f32x4 acc[4][4];
        gemm_tile(lds, al, bl, 8, acc);
        float* hid = p.HID + (((size_t)split * 2 + which) * 2048 + bg * 128) * 128;
#pragma unroll
        for (int m = 0; m < 4; ++m)
#pragma unroll
            for (int n = 0; n < 4; ++n) {
                const int row = wr * 64 + m * 16 + fr, col = wc * 64 + n * 16 + fq * 4;
                *(f32x4*)(hid + (size_t)row * 128 + col) = acc[m][n];
            }
    }
}
__device__ __forceinline__ void phase_cmp2(char* lds, int bid, int nb, const P& p) {
    const int tid = tidx(), lane = tid & 63, wid = tid >> 6;
    float* hs = (float*)lds + wid * 128;
    for (int it = bid * 4 + wid; it < 2 * 16 * 128; it += nb * 4) {
        const int which = it >> 11, bg = (it >> 7) & 15, c = it & 127;
        float o = 0.f;
        if (c < 127) {
            const float* hid = p.HID + ((size_t)which * 2048 + bg * 128 + c) * 128;
            const size_t ss = (size_t)2 * 2048 * 128;
            __builtin_amdgcn_wave_barrier();
            hs[lane] = gelu_tanh((hid[lane] + hid[ss + lane]) + (hid[2 * ss + lane] + hid[3 * ss + lane]));
            hs[lane + 64] = gelu_tanh((hid[lane + 64] + hid[ss + lane + 64]) + (hid[2 * ss + lane + 64] + hid[3 * ss + lane + 64]));
            __builtin_amdgcn_wave_barrier();
            const float* w2 = which ? p.wv2 : p.wk2;
#pragma unroll 8
            for (int j = 0; j < 128; ++j) o += hs[j] * w2[j * 64 + lane];
        }
        if (which == 0) p.KCb[((size_t)bg * 128 + c) * 64 + lane] = (bf16_t)f2bf(o);
        else p.VCt[((size_t)bg * 64 + lane) * 128 + c] = (bf16_t)f2bf(o);
    }
}
#define CMPA_LDS (2 * 16384 + 4 * 2048)
__device__ __forceinline__ void cmpa_unit(char* lds, const P& p, int b, int g, int qt64) {
    const int tid = tidx(), lane = tid & 63, w = tid >> 6, fr = lane & 15, fg = lane >> 4;
    const int bg = b * 2 + g;
    char* kc = lds; char* vt = lds + 16384;
    __syncthreads();
#pragma unroll
    for (int i = 0; i < 4; ++i) { const int pc = tid + 256 * i;
        *(u32x4*)(kc + lds_off(pc >> 3, (pc & 7) * 8)) = *(const u32x4*)(p.KCb + (size_t)bg * 8192 + pc * 8);
        *(u32x4*)(vt + lds_off128(pc >> 4, (pc & 15) * 8)) = *(const u32x4*)(p.VCt + (size_t)bg * 8192 + pc * 8); }
    __syncthreads();
    const int t = qt64 * 64 + w * 16 + fr;
    const size_t n = (size_t)b * SEQ + t;
    const float c1 = 0.125f * LOG2E;
    f32x4 psum[8];
#pragma unroll
    for (int ct = 0; ct < 8; ++ct) psum[ct] = (f32x4){0.f, 0.f, 0.f, 0.f};
    bf16x8 qall[4][2];
#pragma unroll
    for (int i = 0; i < 4; ++i) { qall[i][0] = *(const bf16x8*)(p.Qb + n * 512 + (g * 4 + i) * 64 + fg * 8); qall[i][1] = *(const bf16x8*)(p.Qb + n * 512 + (g * 4 + i) * 64 + 32 + fg * 8); }
#pragma unroll
    for (int i = 0; i < 4; ++i) {
        const int hd = g * 4 + i;
        const float slope2 = exp2f(-((float)hd + 0.5f)) * LOG2E;
        const bf16x8 q0 = qall[i][0], q1 = qall[i][1];
        __builtin_amdgcn_sched_barrier(0);
        f32x4 s[8];
        float mx = -INFINITY;
#pragma unroll
        for (int ct = 0; ct < 8; ++ct) {
            const bf16x8 k0 = *(const bf16x8*)(kc + lds_off(ct * 16 + fr, fg * 8)), k1 = *(const bf16x8*)(kc + lds_off(ct * 16 + fr, 32 + fg * 8));
            s[ct] = __builtin_amdgcn_mfma_f32_16x16x32_bf16(k0, q0, (f32x4){0.f, 0.f, 0.f, 0.f}, 0, 0, 0);
            s[ct] = __builtin_amdgcn_mfma_f32_16x16x32_bf16(k1, q1, s[ct], 0, 0, 0);
#pragma unroll
            for (int r = 0; r < 4; ++r) {
                const int e = 16 * (ct * 16 + fg * 4 + r) + 31;
                const float y = (e <= t) ? fmaf(s[ct][r], c1, -slope2 * (float)(t - e)) : -INFINITY;
                s[ct][r] = y; mx = fmaxf(mx, y);
            }
        }
        __builtin_amdgcn_sched_barrier(0);
        mx = fmaxf(mx, __shfl_xor(mx, 16)); mx = fmaxf(mx, __shfl_xor(mx, 32));
        const float mm = (mx == -INFINITY) ? 0.f : mx;
        float ls = 0.f;
#pragma unroll
        for (int ct = 0; ct < 8; ++ct)
#pragma unroll
            for (int r = 0; r < 4; ++r) { const float e = __builtin_amdgcn_exp2f(s[ct][r] - mm); s[ct][r] = e; ls += e; }
        ls += __shfl_xor(ls, 16); ls += __shfl_xor(ls, 32);
        const float inv = 1.0f / fmaxf(ls, 1e-30f);
#pragma unroll
        for (int ct = 0; ct < 8; ++ct) { s[ct] *= inv; psum[ct] += s[ct]; }
        __builtin_amdgcn_sched_barrier(0);
        f32x4 o[4];
#pragma unroll
        for (int dt = 0; dt < 4; ++dt) o[dt] = (f32x4){0.f, 0.f, 0.f, 0.f};
#pragma unroll
        for (int kk = 0; kk < 4; ++kk) {
            u32x4 pw; pw.x = pack2(s[2 * kk][0], s[2 * kk][1]); pw.y = pack2(s[2 * kk][2], s[2 * kk][3]); pw.z = pack2(s[2 * kk + 1][0], s[2 * kk + 1][1]); pw.w = pack2(s[2 * kk + 1][2], s[2 * kk + 1][3]);
            const bf16x8 pf = __builtin_bit_cast(bf16x8, pw);
#pragma unroll
            for (int dt = 0; dt < 4; ++dt) {
                const int c0 = kk * 32 + fg * 4;
                const u32x2 v0 = *(const u32x2*)(vt + lds_off128(dt * 16 + fr, c0 & ~7) + (c0 & 7) * 2);
                const u32x2 v1 = *(const u32x2*)(vt + lds_off128(dt * 16 + fr, (c0 + 16) & ~7) + (c0 & 7) * 2);
                u32x4 vv; vv.x = v0.x; vv.y = v0.y; vv.z = v1.x; vv.w = v1.y;
                o[dt] = __builtin_amdgcn_mfma_f32_16x16x32_bf16(__builtin_bit_cast(bf16x8, vv), pf, o[dt], 0, 0, 0);
            }
        }
#pragma unroll
        for (int dt = 0; dt < 4; ++dt) { u32x2 w; w.x = pack2(o[dt][0], o[dt][1]); w.y = pack2(o[dt][2], o[dt][3]); *(u32x2*)((bf16_t*)p.OC + n * 512 + hd * 64 + dt * 16 + fg * 4) = w; }
    }
    const int own = t >> 6;
    float val[8];
#pragma unroll
    for (int ct = 0; ct < 8; ++ct) {
        const float up = __shfl(psum[ct][3], (lane + 48) & 63);
        const float up0 = (ct > 0) ? __shfl(psum[ct > 0 ? ct - 1 : 0][3], (lane + 48) & 63) : 0.f;
        const float imp = (psum[ct][0] + psum[ct][1]) + (psum[ct][2] + psum[ct][3]) + (fg > 0 ? up : up0);
        const int j = ct * 4 + fg;
        const bool forced = (j == 0) || (j == own) || (j == own - 1);
        val[ct] = (j <= own) ? (imp + (forced ? 1e4f : 0.f)) : NEGF;
    }
    float* vs = (float*)(lds + 32768) + w * 512;
    __builtin_amdgcn_wave_barrier();
#pragma unroll
    for (int ct = 0; ct < 8; ++ct) vs[fr * 32 + ct * 4 + fg] = val[ct];
    __builtin_amdgcn_wave_barrier();
    int rank[8];
#pragma unroll
    for (int ct = 0; ct < 8; ++ct) rank[ct] = 0;
#pragma unroll 2
    for (int oj = 0; oj < 32; ++oj) {
        const float ov = vs[fr * 32 + oj];
#pragma unroll
        for (int ct = 0; ct < 8; ++ct) rank[ct] += (ov > val[ct] || (ov == val[ct] && oj < ct * 4 + fg)) ? 1 : 0;
    }
    __builtin_amdgcn_wave_barrier();
    unsigned bits = 0;
#pragma unroll
    for (int ct = 0; ct < 8; ++ct) if ((ct * 4 + fg <= own) && rank[ct] < 16) bits |= 1u << (ct * 4 + fg);
    bits |= (unsigned)__shfl_xor((int)bits, 16); bits |= (unsigned)__shfl_xor((int)bits, 32);
    if (fg == 0) p.SELM[(size_t)bg * SEQ + t] = bits;
}
#define MEGA_LDS (((HG3_LDS + 255) & ~255) + 16)
static_assert(HG3_LDS >= G4_LDS && HG3_LDS >= CMPA_LDS && HG3_LDS >= GEMM_LDS && HG3_LDS >= ATT_RED_OFF + 16, "LDS map");
#define GBAR() xcd_barrier(bar)

template <int LAYER>
__device__ __forceinline__ void moe_block(char* lds, int bid, int nb, const P& p, const XcdBarrier& bar, float* of, bf16_t* ob, bf16_t* ol) {
    if (bid < 32) p.cnt[bid * NEXP + tidx()] = 0;
    phase_router(bid, nb, p, LAYER);
    GBAR();
    phase_route(bid, nb, p, LAYER);
    GBAR();
    phase_scatter(lds, bid, nb, p);
    GBAR();
    phase_moe1(lds, bid, nb, p, LAYER, p.XAb);
    GBAR();
    phase_moe2(lds, bid, nb, p, LAYER);
    GBAR();
    phase_combine_ln(bid, nb, p, p.XA, p.ln_g + (LAYER * 2 + 1) * DM, p.ln_b + (LAYER * 2 + 1) * DM, of, ob, ol);
}

__global__ void __launch_bounds__(256, 2) mega(P p) {
    char* lds = dyn_lds;
    const int bid = blockIdx.x, nb = gridDim.x;
    volatile LAS unsigned* st = (volatile LAS unsigned*)(dyn_lds + MEGA_LDS - 16);
    if (tidx() == 0) { st[0] = 0u; st[1] = 0u; st[2] = 0u; st[3] = 0u; }
    __syncthreads();
    const XcdBarrier bar = xcd_barrier_post(p.bar, st);
    phase_prep(lds, bid, nb, p);
    GBAR();
    phase_inproj0(lds, bid, nb, p);
    GBAR();
    phase_mix0_a(lds, bid, nb, p);
    GBAR();
    phase_hg2(bid, nb, p);
    for (int u = nb - 1 - bid; u < 512; u += nb) lru2_unit(p, u >> 6, (u >> 1) & 31, u & 1);
    GBAR();
    phase_mix0_c(lds, bid, nb, p);
    GBAR();
    phase_gemm_f32out(bid, nb, p.MIX, p.WOUT0, DM, DM, p.T0);
    GBAR();
    phase_ln_add(bid, nb, p.x, nullptr, nullptr, p.T0, p.ln_g, p.ln_b, nullptr, p.XAb, p.XAl);
    GBAR();
    moe_block<0>(lds, bid, nb, p, bar, nullptr, p.XBb, p.XBl);
    GBAR();
    phase_inproj1(lds, bid, nb, p);
    GBAR();
    phase_cmp1(lds, bid, nb, p);
    phase_moba_kmean(bid, nb, p);
    GBAR();
    phase_cmp2(lds, bid, nb, p);
    phase_moba_gate(lds, bid, nb, p);
    GBAR();
    phase_attn_a(lds, bid, nb, p);
    GBAR();
    phase_attn_b(lds, bid, nb, p);
    GBAR();
    phase_gemm_f32out(bid, nb, p.MIX, p.WOUT1, DM, DM, p.T0);
    GBAR();
    phase_ln_add(bid, nb, nullptr, p.XBb, p.XBl, p.T0, p.ln_g + 2 * DM, p.ln_b + 2 * DM, nullptr, p.XAb, p.XAl);
    GBAR();
    moe_block<1>(lds, bid, nb, p, bar, p.out, nullptr, nullptr);
}

static inline size_t al256(size_t x) { return (x + 255) & ~(size_t)255; }

extern "C" void kernel_launch(void* const* d_in, const int* in_sizes, int n_in, void* d_out, int out_size, void* d_ws, size_t ws_size, hipStream_t stream) {
    P p{};
    const float** ip = (const float**)&p.x;
    for (int i = 0; i < 30; ++i) ip[i] = (const float*)d_in[i];
    p.out = (float*)d_out;
    char* w = (char*)d_ws; size_t o = 0;
    auto take = [&](size_t bytes) { char* r = w + o; o = al256(o + bytes); return r; };
    p.bar = (unsigned*)take(XCD_BAR_WORDS * 4);
    p.U = (float*)take((size_t)NTOK * EVEN_IN * 4);
    p.MIX = (bf16_t*)take((size_t)NTOK * DM * 2);
    p.T0 = (float*)take((size_t)NTOK * DM * 4);
    p.XA = (float*)take((size_t)NTOK * DM * 4); p.XAb = (bf16_t*)take((size_t)NTOK * DM * 2); p.XAl = (bf16_t*)take((size_t)NTOK * DM * 2); p.XBl = (bf16_t*)take((size_t)NTOK * DM * 2);
    p.XB = (float*)take((size_t)NTOK * DM * 4); p.XBb = (bf16_t*)take((size_t)NTOK * DM * 2);
    p.LOG = (float*)take((size_t)3 * NTOK * NEXP * 4);
    p.eidx = (int*)take(NTOK * 8 * 4); p.ew = (float*)take(NTOK * 8 * 4); p.erank = (int*)take(NTOK * 8 * 4); p.epos = (int*)take(NTOK * 8 * 4);
    p.cnt = (int*)take(32 * NEXP * 4); p.tile_e = (int*)take(NTILES * 4); p.rowtok = (int*)take(NROWS * 4);
    p.H = (bf16_t*)take((size_t)NROWS * 256 * 2);
    p.Y = (bf16_t*)take((size_t)NROWS * DM * 2);
    p.LA = (float*)take((size_t)NTOK * 512 * 4); p.LB = (float*)take((size_t)NTOK * 512 * 4);
    p.KC = (float*)take(16 * 127 * 64 * 4); p.VC = (float*)take(16 * 127 * 64 * 4);
    p.OC = (float*)take((size_t)NTOK * 512 * 4);
    p.SELM = (unsigned*)take(16 * SEQ * 4);
    p.KM = (float*)take(8 * 8 * 8 * 64 * 4);
    p.Qb = (bf16_t*)take((size_t)NTOK * 512 * 2); p.KS = (bf16_t*)take((size_t)NTOK * 128 * 2); p.VSt = (bf16_t*)take((size_t)NTOK * 128 * 2);
    p.KW = (bf16_t*)take((size_t)NTOK * 128 * 2); p.VWt = (bf16_t*)take((size_t)NTOK * 128 * 2);
    p.MQ = (bf16_t*)take((size_t)NTOK * 512 * 2); p.MK = (bf16_t*)take((size_t)NTOK * 512 * 2); p.MVt = (bf16_t*)take((size_t)NTOK * 512 * 2);
    p.KCV = (float*)take((size_t)NTOK * 256 * 4); p.GATES = (float*)take((size_t)NTOK * 24 * 4); p.OS = (float*)take((size_t)NTOK * 512 * 4);
    p.MSEL = (unsigned*)take(64 * SEQ * 4);
    p.UB0 = (bf16_t*)take((size_t)NTOK * 2560 * 2); p.VHt = (bf16_t*)take((size_t)NTOK * 512 * 2);
    p.WAT = (bf16_t*)take(8 * 64 * 64 * 2); p.WXT = (bf16_t*)take(8 * 64 * 64 * 2);
    p.CSA = (float*)take(8 * 32 * 512 * 4); p.CSB = (float*)take(8 * 32 * 512 * 4);
    p.UT = (bf16_t*)take((size_t)1024 * 16384 * 2); p.SP = (bf16_t*)take((size_t)1024 * 16384 * 2);
    p.DV = (float*)take(1024 * 128 * 4);
    p.XIb = (bf16_t*)take((size_t)NTOK * DM * 2);
    p.plist = (int*)take(8 * 320 * 4); p.plen = (int*)take(64);
    p.WIN0 = (bf16_t*)take((size_t)EVEN_IN * DM * 2); p.WOUT0 = (bf16_t*)take((size_t)DM * DM * 2); p.WIN1 = (bf16_t*)take((size_t)2944 * DM * 2); p.WOUT1 = (bf16_t*)take((size_t)DM * DM * 2);
    p.WRH = (bf16_t*)take((size_t)2 * NEXP * DM * 2); p.WRL = (bf16_t*)take((size_t)2 * NEXP * DM * 2);
    p.HID = (float*)take((size_t)4 * 2 * 2048 * 128 * 4); p.KCb = (bf16_t*)take(16 * 128 * 64 * 2); p.VCt = (bf16_t*)take(16 * 64 * 128 * 2);
    if (o > ws_size) return;

    static int grid = 0;
    if (!grid) {
        int dev = 0, cus = 0, per_cu = 0;
        (void)hipGetDevice(&dev);
        (void)hipDeviceGetAttribute(&cus, hipDeviceAttributeMultiprocessorCount, dev);
        (void)hipFuncSetAttribute((const void*)mega, hipFuncAttributeMaxDynamicSharedMemorySize, MEGA_LDS);
        (void)hipOccupancyMaxActiveBlocksPerMultiprocessor(&per_cu, (const void*)mega, 256, MEGA_LDS);
        if (per_cu < 1) per_cu = 1;
        grid = cus * (per_cu < 2 ? per_cu : 2);
    }
    (void)hipMemsetAsync(p.bar, 0, XCD_BAR_WORDS * 4, stream);
    hipLaunchKernelGGL(mega, dim3(grid), dim3(256), MEGA_LDS, stream, p);
}
```

```cpp
#include <hip/hip_runtime.h>
#include <hip/hip_bf16.h>
#include <stdint.h>

#define NTOK 16384
#define DM 1024
#define SEQ 2048
#define NBATCH 8
#define EVEN_IN 3072
#define ODD_IN 2840
#define NEXP 256
#define NEGF (-1e30f)
#define LOG2E 1.4426950408889634f
#define DN_ALPHA 1.4142135623730951f
#define LN_EPS 1e-5f
#define MAXRT 1280
#define SH_TILE0 1280
#define NTILES (1280 + 128)
#define NROWS (NTILES * 128)

typedef unsigned short bf16_t;
typedef short bf16x8 __attribute__((ext_vector_type(8)));
typedef float f32x4 __attribute__((ext_vector_type(4)));
typedef unsigned u32x4 __attribute__((ext_vector_type(4)));
typedef unsigned u32x2 __attribute__((ext_vector_type(2)));
extern __shared__ __attribute__((aligned(16))) char dyn_lds[];
#define LAS __attribute__((address_space(3)))

__device__ __forceinline__ int tidx() { int t = threadIdx.x; asm volatile("" : "+v"(t)); return t; }
__device__ __forceinline__ float wave_sum(float v) {
#pragma unroll
    for (int o = 32; o >= 1; o >>= 1) v += __shfl_xor(v, o);
    return v;
}
__device__ __forceinline__ float wave_max(float v) {
#pragma unroll
    for (int o = 32; o >= 1; o >>= 1) v = fmaxf(v, __shfl_xor(v, o));
    return v;
}
typedef __bf16 hwbf16x2 __attribute__((ext_vector_type(2)));
typedef float f32x2 __attribute__((ext_vector_type(2)));
__device__ __forceinline__ unsigned f2bf(float f) { const __bf16 h = (__bf16)f; return (unsigned)__builtin_bit_cast(unsigned short, h); }
__device__ __forceinline__ float bf2f(unsigned b) { return __uint_as_float(b << 16); }
__device__ __forceinline__ unsigned pack2(float lo, float hi) { const f32x2 f = {lo, hi}; const hwbf16x2 v = __builtin_convertvector(f, hwbf16x2); return __builtin_bit_cast(unsigned, v); }
__device__ __forceinline__ float sigmoidf_(float x) { return 1.0f / (1.0f + __expf(-x)); }
__device__ __forceinline__ float siluf_(float x) { return x / (1.0f + __expf(-x)); }
__device__ __forceinline__ float gelu_tanh(float x) {
    const float u2 = 1.5957691216057308f * (x + 0.044715f * x * x * x);
    return x / (1.0f + __expf(-u2));
}


#define XB_TMO      128
#define XB_XCNT(j)  (256  + 64 * (j))
#define XB_XSUB(j)  (1280 + 64 * (j))
#define XB_XGEN(j)  (2304 + 64 * (j))
#define XB_TOP      3328
#define XB_TOPGEN   3392
#define XCD_BAR_WORDS 3456
#define XB_SPIN_CAP (1u << 18)
__device__ __forceinline__ unsigned xb_ld(unsigned* p)              { return __hip_atomic_load(p, __ATOMIC_RELAXED, __HIP_MEMORY_SCOPE_AGENT); }
__device__ __forceinline__ unsigned xb_add(unsigned* p, unsigned v) { return __hip_atomic_fetch_add(p, v, __ATOMIC_RELAXED, __HIP_MEMORY_SCOPE_AGENT); }
__device__ __forceinline__ unsigned xb_xcc_id() { return (unsigned)__builtin_amdgcn_s_getreg((3 << 11) | 20) & 0xFu; }
#define XB_SPIN(cond, bar) do { unsigned _sp = 0; while (cond) { __builtin_amdgcn_s_sleep(1); \
    if ((++_sp & 255u) == 0u) { if (xb_ld(&(bar)[XB_TMO])) break; if (_sp > XB_SPIN_CAP) { atomicAdd(&(bar)[XB_TMO], 1u); break; } } } } while (0)
struct XcdBarrier { unsigned* bar; unsigned x; volatile LAS unsigned* st; };
__device__ __forceinline__ XcdBarrier xcd_barrier_post(unsigned* bar, volatile LAS unsigned* st) {
    XcdBarrier b; b.bar = bar; b.x = xb_xcc_id(); b.st = st;
    if (tidx() == 0) (void)xb_add(&bar[XB_XCNT(b.x)], 1u);
    return b;
}
__device__ __forceinline__ void xcd_barrier_complete(unsigned* bar, unsigned x, unsigned& nloc, unsigned& nx) {
    const unsigned G = gridDim.x * gridDim.y * gridDim.z;
    unsigned sum, cnt, mine, sp = 0u;
    for (;;) {
        sum = 0u; cnt = 0u; mine = 0u;
#pragma unroll
        for (unsigned j = 0; j < 16; ++j) { const unsigned c = xb_ld(&bar[XB_XCNT(j)]); sum += c; cnt += (c > 0u) ? 1u : 0u; mine = (j == x) ? c : mine; }
        if (sum == G) break;
        __builtin_amdgcn_s_sleep(1);
        if ((++sp & 255u) == 0u) { if (xb_ld(&bar[XB_TMO])) break; if (sp > XB_SPIN_CAP) { atomicAdd(&bar[XB_TMO], 1u); break; } }
    }
    nloc = mine > 0u ? mine : 1u; nx = cnt > 0u ? cnt : 1u;
}
__device__ __forceinline__ void xcd_barrier(const XcdBarrier& b) {
    asm volatile("s_waitcnt vmcnt(0)" ::: "memory");
    __syncthreads();
    if (tidx() == 0) {
        unsigned* bar = b.bar;
        __builtin_amdgcn_s_waitcnt(0);
        unsigned nloc = b.st[0], nx = b.st[1];
        if (nloc == 0u) { xcd_barrier_complete(bar, b.x, nloc, nx); b.st[0] = nloc; b.st[1] = nx; }
        const unsigned old = xb_add(&bar[XB_XSUB(b.x)], 1u);
        const unsigned gen = old / nloc;
        if (old + 1u == (gen + 1u) * nloc) {
            __builtin_amdgcn_fence(__ATOMIC_RELEASE, "agent");
            asm volatile("s_waitcnt vmcnt(0)" ::: "memory");
            const unsigned og = xb_add(&bar[XB_TOP], 1u);
            const unsigned tg = og / nx;
            if (og + 1u == (tg + 1u) * nx) xb_add(&bar[XB_TOPGEN], 1u);
            else XB_SPIN(xb_ld(&bar[XB_TOPGEN]) == tg, bar);
            __builtin_amdgcn_fence(__ATOMIC_ACQUIRE, "agent");
            xb_add(&bar[XB_XGEN(b.x)], 1u);
            asm volatile("s_waitcnt vmcnt(0)" ::: "memory");
        } else {
            XB_SPIN(xb_ld(&bar[XB_XGEN(b.x)]) == gen, bar);
            __builtin_amdgcn_fence(__ATOMIC_ACQUIRE, "agent");
            asm volatile("s_waitcnt vmcnt(0)" ::: "memory");
        }
    }
    __syncthreads();
}

struct P {
    const float *x, *even_w_in, *conv_w, *conv_b, *wa, *ba, *wx, *bx, *lam, *hg_lb, *hg_ng, *even_w_out;
    const float *odd_w_in, *pe_k, *pe_v, *wk1, *wk2, *wv1, *wv2, *odd_w_out, *ln_g, *ln_b, *w_router, *b_router;
    const float *w_gate, *w_up, *w_down, *ws_gate, *ws_up, *ws_down;
    float* out;
    float* U;
    bf16_t* MIX;
    float* T0;
    float* XA; bf16_t* XAb; float* XB; bf16_t* XBb; bf16_t* XAl; bf16_t* XBl;
    float* LOG;
    int* eidx; float* ew; int* erank; int* epos;
    int* cnt;
    int* tile_e;
    int* rowtok;
    bf16_t* H;
    bf16_t* Y;
    float* LA; float* LB;
    float* KC; float* VC;
    float* OC;
    unsigned* SELM;
    float* KM;
    unsigned* bar;
    bf16_t *Qb, *KS, *VSt, *KW, *VWt, *MQ, *MK, *MVt;
    float *KCV, *GATES, *OS; unsigned* MSEL;
    bf16_t *UB0;
    bf16_t *VHt;
    bf16_t *WAT, *WXT;
    float *CSA, *CSB;
    bf16_t *UT, *SP;
    float *DV;
    float *HID;
    bf16_t *KCb, *VCt;
    bf16_t *XIb;
    int *plist; int *plen;
    bf16_t *WIN0, *WOUT0, *WIN1, *WOUT1, *WRH, *WRL;
};

__device__ __forceinline__ int lds_off(int r, int c) {
    const int st = (r >> 4) * 2 + (c >> 5), ob = (r & 15) * 64 + (c & 31) * 2;
    return st * 1024 + (ob ^ (((ob >> 9) & 1) << 5));
}
#define GEMM_LDS 32768

__device__ __forceinline__ float cvt_part(float v, int lo) { return lo ? (v - bf2f(f2bf(v))) : v; }

struct BLoadF32 {
    const float* bp; int ldb; bool valid; int nk1;
    struct Regs { f32x4 v[8]; };
    __device__ __forceinline__ void load(int kt, Regs& R) const {
        const float* p = bp + (size_t)((kt % nk1) * 64) * ldb;
#pragma unroll
        for (int j = 0; j < 8; ++j) R.v[j] = valid ? *(const f32x4*)(p + (size_t)j * ldb) : (f32x4){0.f, 0.f, 0.f, 0.f};
    }
    __device__ __forceinline__ void store(int kt, const Regs& R, char* lds) const {
        const int lo = (kt / nk1) == 1;
        const int nq = tidx() & 31, kg = tidx() >> 5;
#pragma unroll
        for (int i = 0; i < 4; ++i) {
            u32x4 w;
            w.x = pack2(cvt_part(R.v[0][i], lo), cvt_part(R.v[1][i], lo)); w.y = pack2(cvt_part(R.v[2][i], lo), cvt_part(R.v[3][i], lo));
            w.z = pack2(cvt_part(R.v[4][i], lo), cvt_part(R.v[5][i], lo)); w.w = pack2(cvt_part(R.v[6][i], lo), cvt_part(R.v[7][i], lo));
            *(u32x4*)(lds + lds_off(nq * 4 + i, kg * 8)) = w;
        }
    }
};

template <class AL, class BL>
__device__ __forceinline__ void gemm_tile(char* lds, const AL& al, const BL& bl, int nk, f32x4 (&acc)[4][4], bool swap = false) {
    const int lane = tidx() & 63, wid = tidx() >> 6, wr = wid >> 1, wc = wid & 1, fr = lane & 15, fq = lane >> 4;
    char* ldsA = lds; char* ldsB = lds + 16384;
    const char* t2 = swap ? ldsB : ldsA; const char* t1 = swap ? ldsA : ldsB; const int w2 = swap ? wc : wr, w1 = swap ? wr : wc;
#pragma unroll
    for (int m = 0; m < 4; ++m)
#pragma unroll
        for (int n = 0; n < 4; ++n) acc[m][n] = (f32x4){0.f, 0.f, 0.f, 0.f};
    typename AL::Regs ra; typename BL::Regs rb;
    al.load(0, ra); bl.load(0, rb);
    for (int kt = 0; kt < nk; ++kt) {
        __syncthreads();
        al.store(kt, ra, ldsA); bl.store(kt, rb, ldsB);
        __syncthreads();
        if (kt + 1 < nk) { al.load(kt + 1, ra); bl.load(kt + 1, rb); }
#pragma unroll
        for (int kk = 0; kk < 2; ++kk) {
            bf16x8 a[4], b[4];
#pragma unroll
            for (int m = 0; m < 4; ++m) a[m] = *(const bf16x8*)(t2 + lds_off(w2 * 64 + m * 16 + fr, kk * 32 + fq * 8));
#pragma unroll
            for (int n = 0; n < 4; ++n) b[n] = *(const bf16x8*)(t1 + lds_off(w1 * 64 + n * 16 + fr, kk * 32 + fq * 8));
#pragma unroll
            for (int m = 0; m < 4; ++m)
#pragma unroll
                for (int n = 0; n < 4; ++n) acc[m][n] = __builtin_amdgcn_mfma_f32_16x16x32_bf16(b[n], a[m], acc[m][n], 0, 0, 0);
        }
    }
}


__device__ __forceinline__ void dma_rc(int lane, int st, int& R, int& C) {
    const int sb = lane * 16, swz = sb ^ (((sb >> 9) & 1) << 5);
    R = (st >> 1) * 16 + (swz >> 6); C = (st & 1) * 32 + ((swz & 63) >> 1);
}
#define G3_STAGE 24576
#define G3_LDS (2 * G3_STAGE)
__device__ __forceinline__ int t32_off(int r, int c) { const int ob = (r & 15) * 64 + c * 2; return (r >> 4) * 1024 + (ob ^ (((ob >> 9) & 1) << 5)); }
__device__ __forceinline__ void dma_rc32(int lane, int st, int& R, int& C) { const int sb = lane * 16, swz = sb ^ (((sb >> 9) & 1) << 5); R = st * 16 + (swz >> 6); C = (swz & 63) >> 1; }
struct Dma3A {
    static constexpr int NV = 4;
    const char* base; unsigned voff[4];
    const char* lo = nullptr; int nk1 = 1 << 30;
    __device__ __forceinline__ void set_dense(const bf16_t* b0, int row0, int ld) {
        base = (const char*)b0; const int lane = tidx() & 63, w = tidx() >> 6;
#pragma unroll
        for (int i = 0; i < 4; ++i) { int R, C; dma_rc32(lane, w + 4 * i, R, C); voff[i] = (unsigned)(((size_t)(row0 + R) * ld + C) * 2); }
    }
    template <int SET = 0> __device__ __forceinline__ void issue(int kt, int ldsoff) const {
        const int w = tidx() >> 6;
#pragma unroll
        for (int i = 0; i < 4; ++i)
            __builtin_amdgcn_global_load_lds((const unsigned*)((((kt / nk1) == 2) ? lo : base) + voff[i] + (size_t)(kt % nk1) * 64), (LAS unsigned*)((LAS char*)dyn_lds + ldsoff + (w + 4 * i) * 1024), 16, 0, 0);
    }
    template <int SET = 0> __device__ __forceinline__ void commit(int, int) const {}
};
struct Dma3B {
    static constexpr int LAYOUT = 0, NV = 2;
    const char* hi; const char* lo; unsigned voff[2]; int nk1;
    __device__ __forceinline__ void set(const bf16_t* h, const bf16_t* l, int row0, int ld, int nk1_) {
        hi = (const char*)h; lo = (const char*)l; nk1 = nk1_; const int lane = tidx() & 63, w = tidx() >> 6;
#pragma unroll
        for (int i = 0; i < 2; ++i) { int R, C; dma_rc32(lane, w + 4 * i, R, C); voff[i] = (unsigned)(((size_t)(row0 + R) * ld + C) * 2); }
    }
    template <int SET = 0> __device__ __forceinline__ void issue(int kt, int ldsoff) const {
        const int w = tidx() >> 6; const char* base = ((kt / nk1) == 1) ? lo : hi; const size_t ko = (size_t)(kt % nk1) * 64;
#pragma unroll
        for (int i = 0; i < 2; ++i)
            __builtin_amdgcn_global_load_lds((const unsigned*)(base + voff[i] + ko), (LAS unsigned*)((LAS char*)dyn_lds + ldsoff + (w + 4 * i) * 1024), 16, 0, 0);
    }
    template <int SET = 0> __device__ __forceinline__ void commit(int, int) const {}
};
struct Reg3B {
    static constexpr int LAYOUT = 1, NV = 4;
    const float* bp; int ldb; f32x4 v[2][4];
    template <int SET = 0> __device__ __forceinline__ void issue(int kt, int) {
        const float* p = bp + (size_t)(kt * 32) * ldb;
#pragma unroll
        for (int j = 0; j < 4; ++j) v[SET][j] = *(const f32x4*)(p + (size_t)j * ldb);
    }
    template <int SET = 0> __device__ __forceinline__ void commit(int, int ldsoff) const {
        const int tid = tidx(), nq = tid & 31, kg = tid >> 5;
        u32x2 w[4];
#pragma unroll
        for (int i = 0; i < 4; ++i) { w[i].x = pack2(v[SET][0][i], v[SET][1][i]); w[i].y = pack2(v[SET][2][i], v[SET][3][i]); }
        const int rot = (nq >> 1) & 3;
#pragma unroll
        for (int i = 0; i < 4; ++i) {
            const int e = (i + rot) & 3;
            u32x2 d;
            d.x = e == 0 ? w[0].x : (e == 1 ? w[1].x : (e == 2 ? w[2].x : w[3].x));
            d.y = e == 0 ? w[0].y : (e == 1 ? w[1].y : (e == 2 ? w[2].y : w[3].y));
            *(u32x2*)(dyn_lds + ldsoff + ((((kg >> 1) * 128 + nq * 4 + e) << 4) + (kg & 1) * 8)) = d;
        }
    }
};
#define G4_LDS (3 * G3_STAGE)
template <class AL, class BL, int PAR>
__device__ __forceinline__ void g4_step(AL& al, BL& bl, int kt, int nk, f32x4 (&acc)[32], bool idle) {
    constexpr int NV = AL::NV + BL::NV;
    const int lane = tidx() & 63, wid = tidx() >> 6, wr = wid >> 1, wc = wid & 1, fr = lane & 15, fq = lane >> 4;
    const int s0 = kt % 3, cur = s0 * G3_STAGE, nx1 = (s0 == 2 ? 0 : s0 + 1) * G3_STAGE, nx2 = (s0 == 0 ? 2 : s0 - 1) * G3_STAGE;
    if (kt + 1 < nk) asm volatile("s_waitcnt vmcnt(%0) lgkmcnt(0)" :: "n"(NV) : "memory");
    else asm volatile("s_waitcnt vmcnt(0) lgkmcnt(0)" ::: "memory");
    __builtin_amdgcn_s_barrier();
    asm volatile("" ::: "memory");
    if (kt + 2 < nk) { al.template issue<PAR>(kt + 2, nx2); bl.template issue<PAR>(kt + 2, nx2 + 16384); }
    if (!idle) {
    bf16x8 sm[4];
#pragma unroll
    for (int j = 0; j < 4; ++j) sm[j] = *(const bf16x8*)(dyn_lds + cur + 16384 + (BL::LAYOUT == 1 ? ((fq * 128 + wc * 64 + j * 16 + fr) << 4) : t32_off(wc * 64 + j * 16 + fr, fq * 8)));
    bf16x8 bigc = *(const bf16x8*)(dyn_lds + cur + t32_off(wr * 128 + fr, fq * 8));
#pragma unroll
    for (int i = 0; i < 8; ++i) {
        bf16x8 bign = bigc;
        if (i < 7) bign = *(const bf16x8*)(dyn_lds + cur + t32_off(wr * 128 + (i + 1) * 16 + fr, fq * 8));
        __builtin_amdgcn_sched_barrier(0);
#pragma unroll
        for (int j = 0; j < 4; ++j) acc[i * 4 + j] = __builtin_amdgcn_mfma_f32_16x16x32_bf16(sm[j], bigc, acc[i * 4 + j], 0, 0, 0);
        __builtin_amdgcn_sched_barrier(0);
        bigc = bign;
    }
    }
    if (kt + 1 < nk) bl.template commit<PAR ^ 1>(kt + 1, nx1 + 16384);
}
template <class AL, class BL>
__device__ __forceinline__ void gemm_core4(AL& al, BL& bl, int nk, f32x4 (&acc)[32], bool idle_hi = false) {
    const bool idle = idle_hi && (tidx() >> 7);
#pragma unroll
    for (int i = 0; i < 32; ++i) acc[i] = (f32x4){0.f, 0.f, 0.f, 0.f};
    al.template issue<0>(0, 0); bl.template issue<0>(0, 16384);
    if (nk > 1) { al.template issue<1>(1, G3_STAGE); bl.template issue<1>(1, G3_STAGE + 16384); }
    bl.template commit<0>(0, 16384);
    for (int kt = 0; kt < nk; kt += 2) {
        g4_step<AL, BL, 0>(al, bl, kt, nk, acc, idle);
        if (kt + 1 < nk) g4_step<AL, BL, 1>(al, bl, kt + 1, nk, acc, idle);
    }
    __syncthreads();
}
__device__ __forceinline__ bool dense_unit3(int bid, int nb, int j, int ntn, int& tm, int& tn) {
    if ((nb & 7) == 0) {
        const int x = bid & 7, r = bid >> 3, R = nb >> 3;
        const int li = r + R * j;
        if (li >= 8 * ntn) return false;
        tn = li >> 3; tm = x * 8 + (li & 7);
        return true;
    }
    const int u = bid + nb * j;
    if (u >= 64 * ntn) return false;
    tm = u / ntn; tn = u % ntn; return true;
}
__device__ __forceinline__ void prep_tile(char* lds, const float* W, int ldw, int k0, int scol0, bool colvalid, bf16_t* Bt, int K, int drow0, int mode) {
    const int tid = tidx();
    bf16_t* t = (bf16_t*)lds;
    __syncthreads();
#pragma unroll
    for (int i = 0; i < 4; ++i) {
        const int k = (tid >> 4) + 16 * i, q = tid & 15;
        f32x4 v = colvalid ? *(const f32x4*)(W + (size_t)(k0 + k) * ldw + scol0 + q * 4) : (f32x4){0.f, 0.f, 0.f, 0.f};
#pragma unroll
        for (int e = 0; e < 4; ++e) { float x = v[e]; if (mode == 2) x = x - bf2f(f2bf(x)); t[(q * 4 + e) * 72 + k] = (bf16_t)f2bf(x); }
    }
    __syncthreads();
#pragma unroll
    for (int i = 0; i < 2; ++i) { const int pc = tid + 256 * i, n = pc >> 3, ch = pc & 7;
        *(u32x4*)(Bt + (size_t)(drow0 + n) * K + k0 + ch * 8) = *(const u32x4*)(t + n * 72 + ch * 8); }
}
__device__ __forceinline__ int vcol_actual(int v);
__device__ __forceinline__ void phase_prep(char* lds, int bid, int nb, const P& p) {
    const int tid = tidx();
    for (size_t i = (size_t)bid * 256 + tid; i < (size_t)NTOK * DM / 8; i += (size_t)nb * 256) {
        const f32x4 a = *(const f32x4*)(p.x + i * 8), b = *(const f32x4*)(p.x + i * 8 + 4);
        u32x4 w; w.x = pack2(a[0], a[1]); w.y = pack2(a[2], a[3]); w.z = pack2(b[0], b[1]); w.w = pack2(b[2], b[3]);
        *(u32x4*)(p.XIb + i * 8) = w;
    }
    for (int u = bid; u < 2272; u += nb) {
        if (u < 768) { const int nt = u >> 4, kt = u & 15; const int d = nt * 64; const int sc = d < 2048 ? d : (d < 2560 ? d + 512 : d - 512);
            prep_tile(lds, p.even_w_in, EVEN_IN, kt * 64, sc, true, p.WIN0, DM, d, 0); }
        else if (u < 1024) { const int v = u - 768, nt = v >> 4, kt = v & 15; prep_tile(lds, p.even_w_out, DM, kt * 64, nt * 64, true, p.WOUT0, DM, nt * 64, 0); }
        else if (u < 1760) { const int v = u - 1024, nt = v >> 4, kt = v & 15; const int d = nt * 64;
            int sc; bool ok = true;
            if (d < 896) sc = d; else if (d < 1024) sc = d + 128; else if (d < 1536) sc = d + 280; else if (d < 2048) sc = d + 280;
            else if (d < 2112) sc = 1280; else if (d < 2176) { sc = 0; ok = false; } else if (d < 2304) sc = d - 1280; else if (d < 2432) sc = d - 1152; else sc = d - 104;
            prep_tile(lds, p.odd_w_in, ODD_IN, kt * 64, sc, ok, p.WIN1, DM, d, 0); }
        else if (u < 2016) { const int v = u - 1760, nt = v >> 4, kt = v & 15; prep_tile(lds, p.odd_w_out, DM, kt * 64, nt * 64, true, p.WOUT1, DM, nt * 64, 0); }
        else { const int v = u - 2016, layer = v >> 7, lo = (v >> 6) & 1, nt = (v >> 4) & 3, kt = v & 15;
            prep_tile(lds, p.w_router + (size_t)layer * DM * NEXP, NEXP, kt * 64, nt * 64, true, (lo ? p.WRL : p.WRH) + (size_t)layer * NEXP * DM, DM, nt * 64, lo ? 2 : 1); }
    }
    __syncthreads();
}


__device__ __forceinline__ void phase_gemm_f32out(int bid, int nb, const bf16_t* A, const bf16_t* Bt, int N, int K, float* C) {
    const int ntn = N / 128;
    const int tid = tidx(), lane = tid & 63, wid = tid >> 6, wr = wid >> 1, wc = wid & 1, fr = lane & 15, fq = lane >> 4;
    for (int j = 0;; ++j) {
        int tm, tn; if (!dense_unit3(bid, nb, j, ntn, tm, tn)) break;
        Dma3A al; al.set_dense(A, tm * 256, K); Dma3B bl; bl.set(Bt, Bt, tn * 128, K, 1 << 30);
        f32x4 acc[32];
        gemm_core4(al, bl, K / 32, acc);
#pragma unroll
        for (int i = 0; i < 8; ++i)
#pragma unroll
            for (int n = 0; n < 4; ++n) { const f32x4 a = acc[i * 4 + n]; u32x2 w; w.x = pack2(a[0], a[1]); w.y = pack2(a[2], a[3]);
                *(u32x2*)((bf16_t*)C + (size_t)(tm * 256 + wr * 128 + i * 16 + fr) * N + tn * 128 + wc * 64 + n * 16 + fq * 4) = w; }
    }
}
__device__ __forceinline__ void phase_router(int bid, int nb, const P& p, int layer) {
    const int tid = tidx(), lane = tid & 63, wid = tid >> 6, wr = wid >> 1, wc = wid & 1, fr = lane & 15, fq = lane >> 4;
    for (int j = 0;; ++j) {
        int tm, t6; if (!dense_unit3(bid, nb, j, 6, tm, t6)) break;
        const int tn = t6 & 1, part = t6 >> 1;
        Dma3A al; al.set_dense(part == 2 ? p.XAl : p.XAb, tm * 256, DM);
        const bf16_t* wsrc = (part == 1 ? p.WRL : p.WRH) + (size_t)layer * NEXP * DM;
        Dma3B bl; bl.set(wsrc, wsrc, tn * 128, DM, 1 << 30);
        f32x4 acc[32];
        gemm_core4(al, bl, 32, acc);
        float* dst = p.LOG + (size_t)part * NTOK * NEXP;
#pragma unroll
        for (int i = 0; i < 8; ++i)
#pragma unroll
            for (int n = 0; n < 4; ++n) *(f32x4*)(dst + (size_t)(tm * 256 + wr * 128 + i * 16 + fr) * NEXP + tn * 128 + wc * 64 + n * 16 + fq * 4) = acc[i * 4 + n];
    }
}
__device__ __forceinline__ void ln_row_store(float (&v)[16], const float* g, const float* b, float* of, bf16_t* ob, int row, int lane, bf16_t* ol = nullptr) {
    float s = 0.f;
#pragma unroll
    for (int i = 0; i < 16; ++i) s += v[i];
    const float mu = wave_sum(s) * (1.0f / DM);
    float q = 0.f;
#pragma unroll
    for (int i = 0; i < 16; ++i) { const float d = v[i] - mu; q += d * d; }
    const float rstd = rsqrtf(wave_sum(q) * (1.0f / DM) + LN_EPS);
#pragma unroll
    for (int h = 0; h < 2; ++h) {
        const int c0 = h * 512 + lane * 8;
        float o[8];
#pragma unroll
        for (int i = 0; i < 8; ++i) o[i] = (v[h * 8 + i] - mu) * rstd * g[c0 + i] + b[c0 + i];
        if (of) { *(f32x4*)(of + (size_t)row * DM + c0) = (f32x4){o[0], o[1], o[2], o[3]};
                  *(f32x4*)(of + (size_t)row * DM + c0 + 4) = (f32x4){o[4], o[5], o[6], o[7]}; }
        if (ob) { u32x4 w; w.x = pack2(o[0], o[1]); w.y = pack2(o[2], o[3]); w.z = pack2(o[4], o[5]); w.w = pack2(o[6], o[7]); *(u32x4*)(ob + (size_t)row * DM + c0) = w;
            if (ol) { float l[8];
#pragma unroll
                for (int i = 0; i < 8; ++i) l[i] = o[i] - bf2f(f2bf(o[i]));
                u32x4 wl; wl.x = pack2(l[0], l[1]); wl.y = pack2(l[2], l[3]); wl.z = pack2(l[4], l[5]); wl.w = pack2(l[6], l[7]); *(u32x4*)(ol + (size_t)row * DM + c0) = wl; } }
    }
}
__device__ __forceinline__ void phase_ln_add(int bid, int nb, const float* res, const bf16_t* resh, const bf16_t* resl, const float* add, const float* g, const float* b, float* of, bf16_t* ob, bf16_t* ol) {
    const int lane = tidx() & 63, wid = tidx() >> 6;
    for (int row = bid * 4 + wid; row < NTOK; row += nb * 4) {
        float v[16];
#pragma unroll
        for (int h = 0; h < 2; ++h) {
            const size_t o = (size_t)row * DM + h * 512 + lane * 8;
            f32x4 r0, r1;
            if (res) { r0 = *(const f32x4*)(res + o); r1 = *(const f32x4*)(res + o + 4); }
            else { const u32x4 xh = *(const u32x4*)(resh + o), xl = *(const u32x4*)(resl + o);
                r0[0] = bf2f(xh.x & 0xffffu) + bf2f(xl.x & 0xffffu); r0[1] = bf2f(xh.x >> 16) + bf2f(xl.x >> 16); r0[2] = bf2f(xh.y & 0xffffu) + bf2f(xl.y & 0xffffu); r0[3] = bf2f(xh.y >> 16) + bf2f(xl.y >> 16);
                r1[0] = bf2f(xh.z & 0xffffu) + bf2f(xl.z & 0xffffu); r1[1] = bf2f(xh.z >> 16) + bf2f(xl.z >> 16); r1[2] = bf2f(xh.w & 0xffffu) + bf2f(xl.w & 0xffffu); r1[3] = bf2f(xh.w >> 16) + bf2f(xl.w >> 16); }
            const u32x4 ab = *(const u32x4*)((const bf16_t*)add + o);
            const float a0[4] = {bf2f(ab.x & 0xffffu), bf2f(ab.x >> 16), bf2f(ab.y & 0xffffu), bf2f(ab.y >> 16)};
            const float a1[4] = {bf2f(ab.z & 0xffffu), bf2f(ab.z >> 16), bf2f(ab.w & 0xffffu), bf2f(ab.w >> 16)};
#pragma unroll
            for (int i = 0; i < 4; ++i) { v[h * 8 + i] = DN_ALPHA * r0[i] + a0[i]; v[h * 8 + 4 + i] = DN_ALPHA * r1[i] + a1[i]; }
        }
        ln_row_store(v, g, b, of, ob, row, lane, ol);
    }
}

__device__ __forceinline__ void phase_route(int bid, int nb, const P& p, int layer) {
    const float* br = p.b_router + layer * NEXP;
    const int tid = tidx(), lane = tid & 63, wid = tid >> 6;
    const int gt = bid * 256 + tid, gs = nb * 256;
    for (int i = gt; i < NROWS; i += gs) p.rowtok[i] = (i >= SH_TILE0 * 128) ? (i - SH_TILE0 * 128) : 0;
    const f32x4 bv = *(const f32x4*)(br + lane * 4);
    for (int tb = bid * 4 + wid; tb < NTOK; tb += nb * 4 * 8) {
        int es[8]; float ws[8];
#pragma unroll
        for (int q = 0; q < 8; ++q) {
            const int t = tb + q * nb * 4;
            es[q] = 0; ws[q] = 0.f;
            if (t < NTOK) {
        const f32x4 lg = (*(const f32x4*)(p.LOG + (size_t)t * NEXP + lane * 4) + *(const f32x4*)(p.LOG + (size_t)NTOK * NEXP + (size_t)t * NEXP + lane * 4)) + *(const f32x4*)(p.LOG + (size_t)2 * NTOK * NEXP + (size_t)t * NEXP + lane * 4);
        float sc[4], bs[4];
#pragma unroll
        for (int i = 0; i < 4; ++i) { sc[i] = sigmoidf_(lg[i]); bs[i] = sc[i] + bv[i]; }
        float t1 = fmaxf(bs[0], bs[1]), t2 = fminf(bs[0], bs[1]);
        { const float a = fmaxf(bs[2], bs[3]), c = fminf(bs[2], bs[3]); const float n1 = fmaxf(t1, a); t2 = fmaxf(fminf(t1, a), fmaxf(t2, c)); t1 = n1; }
#pragma unroll
        for (int o = 1; o <= 4; o <<= 1) { const float o1 = __shfl_xor(t1, o), o2 = __shfl_xor(t2, o); const float n1 = fmaxf(t1, o1); t2 = fmaxf(fminf(t1, o1), fmaxf(t2, o2)); t1 = n1; }
        const float gsc = t1 + t2;
        const int g = lane >> 3;
        int rank = 0;
#pragma unroll
        for (int g2 = 0; g2 < 8; ++g2) { const float o = __shfl(gsc, g2 * 8); rank += (o > gsc || (o == gsc && g2 < g)) ? 1 : 0; }
        const bool allowed = rank < 4;
        float cv[4];
#pragma unroll
        for (int i = 0; i < 4; ++i) cv[i] = allowed ? bs[i] : -3e38f;
        float wsel = 0.f; int esel = 0; float wsum = 0.f;
#pragma unroll
        for (int k = 0; k < 8; ++k) {
            float bvv = cv[0]; int bi = 0;
#pragma unroll
            for (int i = 1; i < 4; ++i) if (cv[i] > bvv) { bvv = cv[i]; bi = i; }
            int be = lane * 4 + bi;
#pragma unroll
            for (int o = 1; o <= 32; o <<= 1) { const float ov = __shfl_xor(bvv, o); const int oe = __shfl_xor(be, o); if (ov > bvv || (ov == bvv && oe < be)) { bvv = ov; be = oe; } }
            const int ol = be >> 2, oi = be & 3;
            float sown = 0.f;
#pragma unroll
            for (int i = 0; i < 4; ++i) if (oi == i) sown = sc[i];
            const float sv = __shfl(sown, ol);
            if (lane == ol) {
#pragma unroll
                for (int i = 0; i < 4; ++i) if (oi == i) cv[i] = -3e38f;
            }
            wsum += sv;
            if (lane == k) { wsel = sv; esel = be; }
        }
        es[q] = esel; ws[q] = wsel / wsum * 2.5f;
            }
        }
        int rk[8];
#pragma unroll
        for (int q = 0; q < 8; ++q) { rk[q] = 0; if (lane < 8 && tb + q * nb * 4 < NTOK) rk[q] = atomicAdd(&p.cnt[(bid & 31) * NEXP + es[q]], 1); }
#pragma unroll
        for (int q = 0; q < 8; ++q) { const int t = tb + q * nb * 4; if (lane < 8 && t < NTOK) { p.eidx[t * 8 + lane] = es[q]; p.ew[t * 8 + lane] = ws[q]; p.erank[t * 8 + lane] = rk[q]; } }
    }
}
__device__ __forceinline__ void phase_scatter(char* lds, int bid, int nb, const P& p) {
    int* base = (int*)lds;
    int* pc = base + 260;
    int* so = base + 520;
    const int tid = tidx();
    __syncthreads();
    { int c = 0;
#pragma unroll
      for (int sb = 0; sb < 32; ++sb) { so[sb * 256 + tid] = c; c += p.cnt[sb * NEXP + tid]; }
      pc[tid] = (c + 127) & ~127; }
    __syncthreads();
    { int s = 0; for (int e = 0; e < tid; ++e) s += pc[e]; base[tid] = s; if (tid == 255) base[256] = s + pc[255]; }
    __syncthreads();
    const int tpb = nb * 4;
    for (int a = bid * 256 + tid; a < NTOK * 8; a += nb * 256) {
        const int e = p.eidx[a]; const int t = a >> 3; const int sb = ((t % tpb) >> 2) & 31;
        const int row = base[e] + so[sb * 256 + e] + p.erank[a];
        p.rowtok[row] = t; p.epos[a] = row;
    }
    if (bid == 0) {
        {
            const int xq = tid & 7; int off = 0, tot = 0;
            for (int e = xq; e < 256; e += 8) { const int n = ((pc[e] >> 7) + 1) >> 1; if (e < tid) off += n; tot += n; }
            const int t0 = base[tid] >> 7, nte = pc[tid] >> 7;
            for (int i = 0; i < nte; i += 2) p.plist[xq * 320 + off + (i >> 1)] = (t0 + i) | ((i + 1 < nte) ? 0 : 0x40000000);
            if (tid < 64) { int totp = 0; for (int e = (tid & 7); e < 256; e += 8) totp += ((pc[e] >> 7) + 1) >> 1; p.plist[(tid & 7) * 320 + totp + (tid >> 3)] = SH_TILE0 + 2 * tid; }
            if (tid < 8) p.plen[tid] = tot + 8;
        }
        const int nrt = base[256] >> 7;
        for (int i = tid; i < NTILES; i += 256) if (i >= nrt) p.tile_e[i] = (i >= SH_TILE0) ? NEXP : -1;
        const int t0 = base[tid] >> 7, t1 = base[tid + 1] >> 7;
        for (int i = t0; i < t1; ++i) p.tile_e[i] = tid;
    }
    __syncthreads();
}
__device__ __forceinline__ void phase_moe1(char* lds, int bid, int nb, const P& p, int layer, const bf16_t* Xb) {
    const int tid = tidx(), lane = tid & 63, wid = tid >> 6, wr = wid >> 1, wc = wid & 1, fr = lane & 15, fq = lane >> 4;
    const int xq = bid & 7, tot = p.plen[xq] * 4, stp = nb >> 3;
    int Rr[4], Cc[4];
#pragma unroll
    for (int i = 0; i < 4; ++i) dma_rc32(lane, wid + 4 * i, Rr[i], Cc[i]);
    int ui = bid >> 3;
    int ent0 = 0, e0 = 0, tok0[4] = {0, 0, 0, 0}, ent1 = 0;
    if (ui < tot) { ent0 = p.plist[xq * 320 + (ui >> 2)]; const int t0 = ent0 & 0xffff, t1 = ((ent0 >> 30) & 1) ? t0 : t0 + 1; e0 = p.tile_e[t0];
#pragma unroll
        for (int i = 0; i < 4; ++i) tok0[i] = p.rowtok[(Rr[i] < 128 ? t0 : t1) * 128 + (Rr[i] & 127)]; }
    if (ui + stp < tot) ent1 = p.plist[xq * 320 + ((ui + stp) >> 2)];
    for (; ui < tot; ui += stp) {
        const int nt = ui & 3;
        const int ent = ent0, e = e0;
        const int tile0 = ent & 0xffff, single = (ent >> 30) & 1, tile1 = single ? tile0 : tile0 + 1;
        Dma3A al; al.base = (const char*)Xb;
#pragma unroll
        for (int i = 0; i < 4; ++i) al.voff[i] = (unsigned)(((size_t)tok0[i] * DM + Cc[i]) * 2);
        if (ui + stp < tot) { ent0 = ent1; const int t0 = ent0 & 0xffff, t1 = ((ent0 >> 30) & 1) ? t0 : t0 + 1; e0 = p.tile_e[t0];
#pragma unroll
            for (int i = 0; i < 4; ++i) tok0[i] = p.rowtok[(Rr[i] < 128 ? t0 : t1) * 128 + (Rr[i] & 127)]; }
        if (ui + 2 * stp < tot) ent1 = p.plist[xq * 320 + ((ui + 2 * stp) >> 2)];
        const float* Wg = (e < NEXP) ? p.w_gate + ((size_t)layer * NEXP + e) * (DM * 256) : p.ws_gate + (size_t)layer * (DM * 256);
        const float* Wu = (e < NEXP) ? p.w_up + ((size_t)layer * NEXP + e) * (DM * 256) : p.ws_up + (size_t)layer * (DM * 256);
        Reg3B bl; { const int nq = tid & 31, kg = tid >> 5; const int j = nq * 4, jw = j & 63, w2 = j >> 6; const int col = nt * 64 + w2 * 32 + (jw & 31);
            bl.ldb = 256; bl.bp = ((jw >= 32) ? Wu : Wg) + (size_t)(kg * 4) * 256 + col; }
        f32x4 acc[32];
        gemm_core4(al, bl, DM / 32, acc, single != 0);
        if (!(wr && single)) {
            const int tile = wr ? tile1 : tile0;
#pragma unroll
            for (int i = 0; i < 8; ++i)
#pragma unroll
                for (int n = 0; n < 2; ++n) {
                    const int row = tile * 128 + i * 16 + fr, col = nt * 64 + wc * 32 + n * 16 + fq * 4;
                    const f32x4 g = acc[i * 4 + n], uu = acc[i * 4 + n + 2];
                    u32x2 w; w.x = pack2(siluf_(g[0]) * uu[0], siluf_(g[1]) * uu[1]); w.y = pack2(siluf_(g[2]) * uu[2], siluf_(g[3]) * uu[3]);
                    *(u32x2*)(p.H + (size_t)row * 256 + col) = w;
                }
        }
    }
}
__device__ __forceinline__ void phase_moe2(char* lds, int bid, int nb, const P& p, int layer) {
    const int tid = tidx(), lane = tid & 63, wid = tid >> 6, wr = wid >> 1, wc = wid & 1, fr = lane & 15, fq = lane >> 4;
    const int xq = bid & 7, tot = p.plen[xq] * 8, stp = nb >> 3;
    int Rr[4], Cc[4];
#pragma unroll
    for (int i = 0; i < 4; ++i) dma_rc32(lane, wid + 4 * i, Rr[i], Cc[i]);
    int ui = bid >> 3;
    int ent0 = 0, e0 = 0, ent1 = 0;
    if (ui < tot) { ent0 = p.plist[xq * 320 + (ui >> 3)]; e0 = p.tile_e[ent0 & 0xffff]; }
    if (ui + stp < tot) ent1 = p.plist[xq * 320 + ((ui + stp) >> 3)];
    for (; ui < tot; ui += stp) {
        const int nt = ui & 7;
        const int ent = ent0, e = e0;
        const int tile0 = ent & 0xffff, single = (ent >> 30) & 1, tile1 = single ? tile0 : tile0 + 1;
        if (ui + stp < tot) { ent0 = ent1; e0 = p.tile_e[ent0 & 0xffff]; }
        if (ui + 2 * stp < tot) ent1 = p.plist[xq * 320 + ((ui + 2 * stp) >> 3)];
        const float* Wd = (e < NEXP) ? p.w_down + ((size_t)layer * NEXP + e) * (256 * DM) : p.ws_down + (size_t)layer * (256 * DM);
        Dma3A al; al.base = (const char*)p.H;
#pragma unroll
        for (int i = 0; i < 4; ++i) al.voff[i] = (unsigned)(((size_t)((Rr[i] < 128 ? tile0 : tile1) * 128 + (Rr[i] & 127)) * 256 + Cc[i]) * 2);
        Reg3B bl; { const int nq = tid & 31, kg = tid >> 5; bl.ldb = DM; bl.bp = Wd + (size_t)(kg * 4) * DM + nt * 128 + nq * 4; }
        f32x4 acc[32];
        gemm_core4(al, bl, 256 / 32, acc, single != 0);
        if (!(wr && single)) {
            const int tile = wr ? tile1 : tile0;
#pragma unroll
            for (int i = 0; i < 8; ++i)
#pragma unroll
                for (int n = 0; n < 4; ++n) {
                    const int row = tile * 128 + i * 16 + fr, col = nt * 128 + wc * 64 + n * 16 + fq * 4;
                    f32x4 a = acc[i * 4 + n] * 64.0f;
#pragma unroll
                    for (int c = 0; c < 4; ++c) a[c] = fminf(fmaxf(a[c], -448.0f), 448.0f);
                    int w8 = 0;
                    w8 = __builtin_amdgcn_cvt_pk_fp8_f32(a[0], a[1], w8, false);
                    w8 = __builtin_amdgcn_cvt_pk_fp8_f32(a[2], a[3], w8, true);
                    *(int*)((char*)p.Y + (size_t)row * DM + col) = w8;
                }
        }
    }
}
__device__ __forceinline__ void phase_combine_ln(int bid, int nb, const P& p, const float* X, const float* g, const float* b, float* of, bf16_t* ob, bf16_t* ol) {
    const int lane = tidx() & 63, wid = tidx() >> 6;
    int row = bid * 4 + wid;
    int npos = 0; float nw = 0.f;
    if (row < NTOK && lane < 8) { npos = p.epos[row * 8 + lane]; nw = p.ew[row * 8 + lane]; }
    for (; row < NTOK; row += nb * 4) {
        const int cpos = npos; const float cw = nw;
        { const int nr = row + nb * 4; if (nr < NTOK && lane < 8) { npos = p.epos[nr * 8 + lane]; nw = p.ew[nr * 8 + lane]; } }
        float v[16];
#pragma unroll
        for (int h = 0; h < 2; ++h) {
            const size_t o = (size_t)row * DM + h * 512 + lane * 8;
            const u32x4 xh = *(const u32x4*)(p.XAb + o), xl = *(const u32x4*)(p.XAl + o);
            v[h * 8 + 0] = DN_ALPHA * (bf2f(xh.x & 0xffffu) + bf2f(xl.x & 0xffffu)); v[h * 8 + 1] = DN_ALPHA * (bf2f(xh.x >> 16) + bf2f(xl.x >> 16));
            v[h * 8 + 2] = DN_ALPHA * (bf2f(xh.y & 0xffffu) + bf2f(xl.y & 0xffffu)); v[h * 8 + 3] = DN_ALPHA * (bf2f(xh.y >> 16) + bf2f(xl.y >> 16));
            v[h * 8 + 4] = DN_ALPHA * (bf2f(xh.z & 0xffffu) + bf2f(xl.z & 0xffffu)); v[h * 8 + 5] = DN_ALPHA * (bf2f(xh.z >> 16) + bf2f(xl.z >> 16));
            v[h * 8 + 6] = DN_ALPHA * (bf2f(xh.w & 0xffffu) + bf2f(xl.w & 0xffffu)); v[h * 8 + 7] = DN_ALPHA * (bf2f(xh.w >> 16) + bf2f(xl.w >> 16));
        }
#pragma unroll
        for (int k = 0; k < 9; ++k) {
            const int yr = (k < 8) ? __shfl(cpos, k) : (SH_TILE0 * 128 + row);
            const float w = (k < 8) ? __shfl(cw, k) : 1.0f;
#pragma unroll
            for (int h = 0; h < 2; ++h) {
                const u32x2 y = *(const u32x2*)((const char*)p.Y + (size_t)yr * DM + h * 512 + lane * 8);
                typedef float f32x2v __attribute__((ext_vector_type(2)));
                const f32x2v y0 = __builtin_amdgcn_cvt_pk_f32_fp8((int)y.x, false), y1 = __builtin_amdgcn_cvt_pk_f32_fp8((int)y.x, true);
                const f32x2v y2 = __builtin_amdgcn_cvt_pk_f32_fp8((int)y.y, false), y3 = __builtin_amdgcn_cvt_pk_f32_fp8((int)y.y, true);
                const float ws = w * (1.0f / 64.0f);
                v[h * 8 + 0] += ws * y0.x; v[h * 8 + 1] += ws * y0.y; v[h * 8 + 2] += ws * y1.x; v[h * 8 + 3] += ws * y1.y;
                v[h * 8 + 4] += ws * y2.x; v[h * 8 + 5] += ws * y2.y; v[h * 8 + 6] += ws * y3.x; v[h * 8 + 7] += ws * y3.y;
            }
        }
        ln_row_store(v, g, b, of, ob, row, lane, ol);
    }
}

__device__ __forceinline__ void phase_moba_kmean(int bid, int nb, const P& p) {
    const int tid = tidx();
    for (int u = (nb >= 256 ? bid - 128 : bid); u < NBATCH * 8; u += nb) {
        if (u < 0) continue;
        const int b = u >> 3, j = u & 7;
        const bf16_t* src = p.MK + (size_t)(b * SEQ + j * 256) * 512 + tid * 2;
        float s0 = 0.f, s1 = 0.f;
        for (int r8 = 0; r8 < 256; r8 += 8) {
            unsigned v[8];
#pragma unroll
            for (int i = 0; i < 8; ++i) v[i] = *(const unsigned*)(src + (size_t)(r8 + i) * 512);
#pragma unroll
            for (int i = 0; i < 8; ++i) { s0 += bf2f(v[i] & 0xffffu); s1 += bf2f(v[i] >> 16); }
        }
        const int h = tid >> 5, d = (tid & 31) * 2;
        p.KM[((size_t)(b * 8 + h) * 8 + j) * 64 + d] = s0 * (1.0f / 256.0f);
        p.KM[((size_t)(b * 8 + h) * 8 + j) * 64 + d + 1] = s1 * (1.0f / 256.0f);
    }
}
__device__ __forceinline__ void gemm_t_unit(const bf16_t* Wt, int wrow0, const bf16_t* X, int tok0, bf16_t* dst, int ncol, int col0) {
    const int tid = tidx(), lane = tid & 63, wid = tid >> 6, wr = wid >> 1, wc = wid & 1, fr = lane & 15, fq = lane >> 4;
    Dma3A al; al.set_dense(Wt, wrow0, DM); Dma3B bl; bl.set(X, X, tok0, DM, 1 << 30);
    f32x4 acc[32];
    gemm_core4(al, bl, DM / 32, acc);
#pragma unroll
    for (int i = 0; i < 8; ++i)
#pragma unroll
        for (int n = 0; n < 4; ++n) {
            const int vc = col0 + wr * 128 + i * 16 + fr, r0 = tok0 + wc * 64 + n * 16 + fq * 4;
            const int b = r0 >> 11, t0 = r0 & (SEQ - 1);
            const f32x4 a = acc[i * 4 + n];
            u32x2 w; w.x = pack2(a[0], a[1]); w.y = pack2(a[2], a[3]);
            *(u32x2*)(dst + ((size_t)(b * ncol + vc)) * SEQ + t0) = w;
        }
}
__device__ __forceinline__ void phase_inproj0(char* lds, int bid, int nb, const P& p) {
    const int ntn = 20, nk = DM / 32;
    const int tid = tidx(), lane = tid & 63, wid = tid >> 6, wr = wid >> 1, wc = wid & 1, fr = lane & 15, fq = lane >> 4;
    for (int i = bid * 256 + tid; i < 2 * 8 * 64 * 64; i += nb * 256) {
        const int which = i >> 15, e = i & 32767, h = e >> 12, j = (e >> 6) & 63, ii = e & 63;
        const float v = (which ? p.wx : p.wa)[(h * 64 + ii) * 64 + j];
        (which ? p.WXT : p.WAT)[e] = (bf16_t)f2bf(v);
    }
    for (int jj = 0;; ++jj) {
        int tm, tn; if (!dense_unit3(bid, nb, jj, ntn, tm, tn)) break;
        Dma3A al; al.set_dense(p.XIb, tm * 256, DM); Dma3B bl; bl.set(p.WIN0, p.WIN0, tn * 128, DM, 1 << 30);
        f32x4 acc[32];
        gemm_core4(al, bl, nk, acc);
#pragma unroll
        for (int i = 0; i < 8; ++i)
#pragma unroll
            for (int n = 0; n < 4; ++n) {
                const int row = tm * 256 + wr * 128 + i * 16 + fr, col = tn * 128 + wc * 64 + n * 16 + fq * 4;
                const f32x4 a = acc[i * 4 + n];
                u32x2 w; w.x = pack2(a[0], a[1]); w.y = pack2(a[2], a[3]);
                *(u32x2*)(p.UB0 + (size_t)row * 2560 + col) = w;
            }
    }
    for (int u = (nb >= 512 ? bid - 256 : bid); u < 2 * 128; u += nb) { if (u < 0) continue; const int pn = u & 1, tt = u >> 1; gemm_t_unit(p.WIN0, 2560 + pn * 256, p.XIb, tt * 128, p.VHt, 512, pn * 256); }
}

__device__ __forceinline__ int lds_off128(int r, int c) {
    const int st = (r >> 4) * 4 + (c >> 5), ob = (r & 15) * 64 + (c & 31) * 2;
    return st * 1024 + (ob ^ (((ob >> 9) & 1) << 5));
}
__device__ __forceinline__ float softplusf_(float x) { return fmaxf(x, 0.f) + log1pf(__expf(-fabsf(x))); }

#define LRU1_LDS (4 * 8192)
__device__ __forceinline__ void lru1_unit(char* lds, const P& p, int b, int ck, int half) {
    const int tid = tidx(), lane = tid & 63, w = tid >> 6, fr = lane & 15, fg = lane >> 4;
    char* xt = lds + w * 8192;
    const size_t n0 = (size_t)b * SEQ + ck * 64;
    __syncthreads();
    {
        const int h = half * 4 + w, c = h * 64 + lane;
        const float cw0 = p.conv_w[c], cw1 = p.conv_w[512 + c], cw2 = p.conv_w[1024 + c], cw3 = p.conv_w[1536 + c], cb = p.conv_b[c];
        float xm3 = 0.f, xm2 = 0.f, xm1 = 0.f;
        if (ck > 0) { xm3 = bf2f(p.UB0[(n0 - 3) * 2560 + c]); xm2 = bf2f(p.UB0[(n0 - 2) * 2560 + c]); xm1 = bf2f(p.UB0[(n0 - 1) * 2560 + c]); }
        __builtin_amdgcn_wave_barrier();
        for (int t16 = 0; t16 < 64; t16 += 16) {
            bf16_t raw[16];
#pragma unroll
            for (int i = 0; i < 16; ++i) raw[i] = p.UB0[(n0 + t16 + i) * 2560 + c];
#pragma unroll
            for (int i = 0; i < 16; ++i) {
                const float x = bf2f(raw[i]);
                const float xc = cb + cw0 * xm3 + cw1 * xm2 + cw2 * xm1 + cw3 * x;
                xm3 = xm2; xm2 = xm1; xm1 = x;
                *(bf16_t*)(xt + lds_off(t16 + i, lane & ~7) + (lane & 7) * 2) = (bf16_t)f2bf(xc);
            }
        }
        __builtin_amdgcn_wave_barrier();
        for (int jt = 0; jt < 4; ++jt) {
            const int cj = h * 64 + jt * 16 + fr;
            bf16x8 wra[2], wri[2];
#pragma unroll
            for (int ks = 0; ks < 2; ++ks) {
                wra[ks] = *(const bf16x8*)(p.WAT + (size_t)(h * 64 + jt * 16 + fr) * 64 + ks * 32 + fg * 8);
                wri[ks] = *(const bf16x8*)(p.WXT + (size_t)(h * 64 + jt * 16 + fr) * 64 + ks * 32 + fg * 8);
            }
            const float bav = p.ba[cj], bxv = p.bx[cj], sp = softplusf_(-p.lam[cj]);
            float mA = 1.f, mB = 0.f;
#pragma unroll
            for (int tt = 0; tt < 4; ++tt) {
                const bf16x8 a0 = *(const bf16x8*)(xt + lds_off(tt * 16 + fr, fg * 8)), a1 = *(const bf16x8*)(xt + lds_off(tt * 16 + fr, 32 + fg * 8));
                f32x4 ar = __builtin_amdgcn_mfma_f32_16x16x32_bf16(a0, wra[0], (f32x4){0.f, 0.f, 0.f, 0.f}, 0, 0, 0);
                ar = __builtin_amdgcn_mfma_f32_16x16x32_bf16(a1, wra[1], ar, 0, 0, 0);
                f32x4 ai = __builtin_amdgcn_mfma_f32_16x16x32_bf16(a0, wri[0], (f32x4){0.f, 0.f, 0.f, 0.f}, 0, 0, 0);
                ai = __builtin_amdgcn_mfma_f32_16x16x32_bf16(a1, wri[1], ai, 0, 0, 0);
                float sA = 1.f, sB = 0.f;
#pragma unroll
                for (int r = 0; r < 4; ++r) {
                    const int t = tt * 16 + fg * 4 + r;
                    const float rg = sigmoidf_(ar[r] + bav), ig = sigmoidf_(ai[r] + bxv);
                    const float log_a = -8.0f * rg * sp;
                    const float a = __expf(log_a);
                    const float mult = (ck == 0 && t == 0) ? 1.0f : sqrtf(fmaxf(1.0f - a * a, 0.f));
                    const int jj = jt * 16 + fr;
                    const float xcv = bf2f(*(const bf16_t*)(xt + lds_off(t, jj & ~7) + (jj & 7) * 2));
                    const float bt = mult * ig * xcv;
                    p.LA[(n0 + t) * 512 + cj] = a; p.LB[(n0 + t) * 512 + cj] = bt;
                    sB = a * sB + bt; sA = a * sA;
                }
                float tA = 1.f, tB = 0.f;
#pragma unroll
                for (int g2 = 0; g2 < 4; ++g2) {
                    const float oA = __shfl(sA, g2 * 16 + fr), oB = __shfl(sB, g2 * 16 + fr);
                    tB = oA * tB + oB; tA = oA * tA;
                }
                mB = tA * mB + tB; mA = tA * mA;
            }
            if (fg == 0) { p.CSA[((size_t)b * 32 + ck) * 512 + cj] = mA; p.CSB[((size_t)b * 32 + ck) * 512 + cj] = mB; }
        }
        __builtin_amdgcn_wave_barrier();
    }
}
__device__ __forceinline__ void lru2_unit(const P& p, int b, int ck, int half) {
    const int tid = tidx();
    const size_t n0 = (size_t)b * SEQ + ck * 64;
    {
        const int c = tid + 256 * half;
        float h = 0.f;
        for (int c8 = 0; c8 < ck; c8 += 8) {
            float ca[8], cb[8];
#pragma unroll
            for (int i = 0; i < 8; ++i) { const bool ok = c8 + i < ck; ca[i] = ok ? p.CSA[((size_t)b * 32 + c8 + i) * 512 + c] : 1.f; cb[i] = ok ? p.CSB[((size_t)b * 32 + c8 + i) * 512 + c] : 0.f; }
#pragma unroll
            for (int i = 0; i < 8; ++i) h = ca[i] * h + cb[i];
        }
        for (int t8 = 0; t8 < 64; t8 += 8) {
            float la[8], lb[8], gb[8];
#pragma unroll
            for (int i = 0; i < 8; ++i) { la[i] = p.LA[(n0 + t8 + i) * 512 + c]; lb[i] = p.LB[(n0 + t8 + i) * 512 + c]; gb[i] = bf2f(p.UB0[(n0 + t8 + i) * 2560 + 512 + c]); }
#pragma unroll
            for (int i = 0; i < 8; ++i) { h = la[i] * h + lb[i]; p.MIX[(n0 + t8 + i) * DM + c] = (bf16_t)f2bf(h * gelu_tanh(gb[i])); }
        }
    }
}

#define HG1_LDS (2 * 16384)
__device__ __forceinline__ float hg_lb(const P& p, int ch) {
    const float l0 = p.hg_lb[ch], l1 = p.hg_lb[512 + ch], l2 = p.hg_lb[1024 + ch]; const float mx = fmaxf(l0, fmaxf(l1, l2));
    const float e0 = __expf(l0 - mx), e1 = __expf(l1 - mx), e2 = __expf(l2 - mx); return e0 / (e0 + e1 + e2);
}
__device__ __forceinline__ void hg1_unit(char* lds, const P& p, int b, int h, int ck) {
    const int tid = tidx(), lane = tid & 63, w = tid >> 6, fr = lane & 15, fg = lane >> 4;
    char* kh = lds;
    char* vt = lds + 16384;
    const size_t n0 = (size_t)b * SEQ + ck * 64;
    const int bhc = (b * 4 + h) * 32 + ck;
    __syncthreads();
    if (tid < 128) {
        const int k = tid, ch = h * 128 + k;
        const float lbv = hg_lb(p, ch);
        float f[64];
#pragma unroll
        for (int t16 = 0; t16 < 64; t16 += 16) {
            bf16_t raw[16];
#pragma unroll
            for (int i = 0; i < 16; ++i) raw[i] = p.UB0[(n0 + t16 + i) * 2560 + 1536 + ch];
#pragma unroll
            for (int i = 0; i < 16; ++i) f[t16 + i] = lbv + (1.0f - lbv) * sigmoidf_(bf2f(raw[i]));
        }
        float suf = 1.0f;
#pragma unroll
        for (int t8 = 56; t8 >= 0; t8 -= 8) {
            float kv[8];
#pragma unroll
            for (int i = 7; i >= 0; --i) { kv[i] = (1.0f - f[t8 + i]) * suf; suf *= f[t8 + i]; }
            u32x4 wv; wv.x = pack2(kv[0], kv[1]); wv.y = pack2(kv[2], kv[3]); wv.z = pack2(kv[4], kv[5]); wv.w = pack2(kv[6], kv[7]);
            *(u32x4*)(kh + lds_off(k, t8)) = wv;
        }
        p.DV[(size_t)bhc * 128 + k] = suf;
    } else {
        const int q = tid - 128;
#pragma unroll
        for (int i = 0; i < 8; ++i) { const int pc = q + 128 * i, v = pc >> 3, c8 = pc & 7;
            *(u32x4*)(vt + lds_off(v, c8 * 8)) = *(const u32x4*)(p.VHt + ((size_t)(b * 512 + h * 128 + v)) * SEQ + ck * 64 + c8 * 8); }
    }
    __syncthreads();
    bf16_t* ut = p.UT + (size_t)bhc * 16384;
#pragma unroll
    for (int kk = 0; kk < 2; ++kk) {
        const int kt = w * 2 + kk;
        const bf16x8 a0 = *(const bf16x8*)(kh + lds_off(kt * 16 + fr, fg * 8)), a1 = *(const bf16x8*)(kh + lds_off(kt * 16 + fr, 32 + fg * 8));
#pragma unroll
        for (int v8 = 0; v8 < 8; ++v8) {
            const bf16x8 b0 = *(const bf16x8*)(vt + lds_off(v8 * 16 + fr, fg * 8)), b1 = *(const bf16x8*)(vt + lds_off(v8 * 16 + fr, 32 + fg * 8));
            f32x4 acc = __builtin_amdgcn_mfma_f32_16x16x32_bf16(a0, b0, (f32x4){0.f, 0.f, 0.f, 0.f}, 0, 0, 0);
            acc = __builtin_amdgcn_mfma_f32_16x16x32_bf16(a1, b1, acc, 0, 0, 0);
            u32x2 wv; wv.x = pack2(acc[0], acc[1]); wv.y = pack2(acc[2], acc[3]);
            *(u32x2*)(ut + (size_t)(v8 * 16 + fr) * 128 + kt * 16 + fg * 4) = wv;
        }
    }
}
__device__ __forceinline__ void phase_hg2(int bid, int nb, const P& p) {
    for (int it = bid * 256 + tidx(); it < 32 * 4096; it += nb * 256) {
        const int bh = it >> 12, e4 = (it & 4095) * 4, k4 = e4 & 127;
        float S0 = 0.f, S1 = 0.f, S2 = 0.f, S3 = 0.f;
        for (int c8 = 0; c8 < 32; c8 += 8) {
            u32x2 uv[8]; f32x4 dv[8];
#pragma unroll
            for (int i = 0; i < 8; ++i) { uv[i] = *(const u32x2*)(p.UT + ((size_t)(bh * 32 + c8 + i)) * 16384 + e4); dv[i] = *(const f32x4*)(p.DV + (size_t)(bh * 32 + c8 + i) * 128 + k4); }
#pragma unroll
            for (int i = 0; i < 8; ++i) {
                u32x2 wv; wv.x = pack2(S0, S1); wv.y = pack2(S2, S3);
                *(u32x2*)(p.SP + ((size_t)(bh * 32 + c8 + i)) * 16384 + e4) = wv;
                S0 = dv[i][0] * S0 + bf2f(uv[i].x & 0xffffu); S1 = dv[i][1] * S1 + bf2f(uv[i].x >> 16);
                S2 = dv[i][2] * S2 + bf2f(uv[i].y & 0xffffu); S3 = dv[i][3] * S3 + bf2f(uv[i].y >> 16);
            }
        }
    }
}
#define HG3_QP 0
#define HG3_KP 40960
#define HG3_VT (40960 + 16384)
#define HG3_LDS (40960 + 16384 + 128 * 144)
__device__ __forceinline__ int hg3_qp_base(int j) { return j == 0 ? 0 : (j == 1 ? 16384 : (j == 2 ? 28672 : 36864)); }
__device__ __forceinline__ void hg3_unit(char* lds, const P& p, int b, int h, int ck) {
    const int tid = tidx(), lane = tid & 63, w = tid >> 6, fr = lane & 15, fg = lane >> 4;
    char* qp = lds + HG3_QP; char* kp = lds + HG3_KP; char* vt = lds + HG3_VT;
    const size_t n0 = (size_t)b * SEQ + ck * 64;
    const int bhc = (b * 4 + h) * 32 + ck;
    __syncthreads();
    if (tid < 128) {
        const int k = tid, ch = h * 128 + k;
        const float lbv = hg_lb(p, ch);
        const int ke = (k & 7) * 2, k8 = k & ~7;
        float d0 = 1.f, d1 = 1.f, d2 = 1.f, d3 = 1.f;
#pragma unroll
        for (int i = 0; i < 4; ++i) {
            bf16_t rq[16], rf[16];
#pragma unroll
            for (int tt = 0; tt < 16; ++tt) { rq[tt] = p.UB0[(n0 + i * 16 + tt) * 2560 + 1024 + ch]; rf[tt] = p.UB0[(n0 + i * 16 + tt) * 2560 + 1536 + ch]; }
#pragma unroll
            for (int tt = 0; tt < 16; ++tt) {
                const int t = i * 16 + tt;
                const float qv = siluf_(bf2f(rq[tt]));
                const float f = lbv + (1.0f - lbv) * sigmoidf_(bf2f(rf[tt]));
                d0 *= f; if (i >= 1) d1 *= f; if (i >= 2) d2 *= f; if (i >= 3) d3 *= f;
                const float di = (i == 0) ? d0 : (i == 1 ? d1 : (i == 2 ? d2 : d3));
                *(bf16_t*)(kp + lds_off128(t, k8) + ke) = (bf16_t)f2bf((1.0f - f) * __builtin_amdgcn_rcpf(fmaxf(di, 1.8e-35f)));
                *(bf16_t*)(qp + hg3_qp_base(0) + lds_off128(t, k8) + ke) = (bf16_t)f2bf(qv * d0);
                if (i >= 1) *(bf16_t*)(qp + hg3_qp_base(1) + lds_off128(t - 16, k8) + ke) = (bf16_t)f2bf(qv * d1);
                if (i >= 2) *(bf16_t*)(qp + hg3_qp_base(2) + lds_off128(t - 32, k8) + ke) = (bf16_t)f2bf(qv * d2);
                if (i >= 3) *(bf16_t*)(qp + hg3_qp_base(3) + lds_off128(t - 48, k8) + ke) = (bf16_t)f2bf(qv * d3);
            }
        }
    } else {
        const int q = tid - 128;
#pragma unroll
        for (int i = 0; i < 8; ++i) { const int pc = q + 128 * i, v = pc >> 3, c8 = pc & 7;
            *(u32x4*)(vt + v * 144 + c8 * 16) = *(const u32x4*)(p.VHt + ((size_t)(b * 512 + h * 128 + v)) * SEQ + ck * 64 + c8 * 8); }
    }
    __syncthreads();
    f32x4 acc[8];
#pragma unroll
    for (int v8 = 0; v8 < 8; ++v8) acc[v8] = (f32x4){0.f, 0.f, 0.f, 0.f};
    if (ck > 0) {
        const bf16_t* sp = p.SP + (size_t)bhc * 16384;
#pragma unroll
        for (int ks = 0; ks < 4; ++ks) {
            const bf16x8 bq = *(const bf16x8*)(qp + hg3_qp_base(0) + lds_off128(w * 16 + fr, ks * 32 + fg * 8));
#pragma unroll
            for (int v8 = 0; v8 < 8; ++v8) {
                const bf16x8 as = *(const bf16x8*)(sp + (size_t)(v8 * 16 + fr) * 128 + ks * 32 + fg * 8);
                acc[v8] = __builtin_amdgcn_mfma_f32_16x16x32_bf16(as, bq, acc[v8], 0, 0, 0);
            }
        }
    }
#pragma unroll
    for (int jp = 0; jp < 2; ++jp) {
        if (2 * jp > w) continue;
        f32x4 at[2];
#pragma unroll
        for (int jj = 0; jj < 2; ++jj) {
            const int j = 2 * jp + jj;
            at[jj] = (f32x4){0.f, 0.f, 0.f, 0.f};
            if (j <= w) {
#pragma unroll
                for (int ks = 0; ks < 4; ++ks) {
                    const bf16x8 ak = *(const bf16x8*)(kp + lds_off128(j * 16 + fr, ks * 32 + fg * 8));
                    const bf16x8 bq = *(const bf16x8*)(qp + hg3_qp_base(j) + lds_off128((w - j) * 16 + fr, ks * 32 + fg * 8));
                    at[jj] = __builtin_amdgcn_mfma_f32_16x16x32_bf16(ak, bq, at[jj], 0, 0, 0);
                }
                if (j == w) {
#pragma unroll
                    for (int r = 0; r < 4; ++r) at[jj][r] = (fg * 4 + r <= fr) ? at[jj][r] : 0.f;
                }
            }
        }
        u32x4 pw; pw.x = pack2(at[0][0], at[0][1]); pw.y = pack2(at[0][2], at[0][3]); pw.z = pack2(at[1][0], at[1][1]); pw.w = pack2(at[1][2], at[1][3]);
        const bf16x8 pf = __builtin_bit_cast(bf16x8, pw);
#pragma unroll
        for (int v8 = 0; v8 < 8; ++v8) {
            const char* vb = vt + (v8 * 16 + fr) * 144 + (jp * 32 + fg * 4) * 2;
            const u32x2 v0 = *(const u32x2*)vb, v1 = *(const u32x2*)(vb + 32);
            u32x4 vv; vv.x = v0.x; vv.y = v0.y; vv.z = v1.x; vv.w = v1.y;
            acc[v8] = __builtin_amdgcn_mfma_f32_16x16x32_bf16(__builtin_bit_cast(bf16x8, vv), pf, acc[v8], 0, 0, 0);
        }
    }
    float ss = 0.f;
#pragma unroll
    for (int v8 = 0; v8 < 8; ++v8)
#pragma unroll
        for (int r = 0; r < 4; ++r) ss += acc[v8][r] * acc[v8][r];
    ss += __shfl_xor(ss, 16); ss += __shfl_xor(ss, 32);
    const float rs = rsqrtf(ss * (1.0f / 128.0f) + 1e-6f);
    const size_t n = n0 + w * 16 + fr;
#pragma unroll
    for (int v8 = 0; v8 < 8; ++v8) {
        const int vcol = h * 128 + v8 * 16 + fg * 4;
        const u32x2 gv = *(const u32x2*)(p.UB0 + n * 2560 + 2048 + vcol);
        const f32x4 ng = *(const f32x4*)(p.hg_ng + vcol);
        const float y0 = acc[v8][0] * rs * ng[0] * sigmoidf_(bf2f(gv.x & 0xffffu)), y1 = acc[v8][1] * rs * ng[1] * sigmoidf_(bf2f(gv.x >> 16));
        const float y2 = acc[v8][2] * rs * ng[2] * sigmoidf_(bf2f(gv.y & 0xffffu)), y3 = acc[v8][3] * rs * ng[3] * sigmoidf_(bf2f(gv.y >> 16));
        u32x2 wv; wv.x = pack2(y0, y1); wv.y = pack2(y2, y3);
        *(u32x2*)(p.MIX + n * DM + 512 + vcol) = wv;
    }
}
__device__ __forceinline__ void phase_mix0_a(char* lds, int bid, int nb, const P& p) {
    for (int u = bid; u < 512 + 1024; u += nb) {
        if (u < 512) lru1_unit(lds, p, u >> 6, (u >> 1) & 31, u & 1);
        else { const int v = u - 512; hg1_unit(lds, p, v >> 7, (v >> 5) & 3, v & 31); }
    }
    __syncthreads();
}
__device__ __forceinline__ void phase_mix0_c(char* lds, int bid, int nb, const P& p) {
    for (int u = bid; u < 1024; u += nb) hg3_unit(lds, p, u >> 7, (u >> 5) & 3, u & 31);
    __syncthreads();
}

#ifndef KEEP_U
#define KEEP_U 0
#endif
__device__ __forceinline__ int vcol_actual(int v) { return v < 1280 ? v : (v < 2816 ? v + 24 : v - 1536); }
__device__ __forceinline__ void phase_inproj1(char* lds, int bid, int nb, const P& p) {
    const int ntn = 17, nk = DM / 32;
    const int tid = tidx(), lane = tid & 63, wid = tid >> 6, wr = wid >> 1, wc = wid & 1, fr = lane & 15, fq = lane >> 4;
    for (int jj = 0;; ++jj) {
        int tm, tn; if (!dense_unit3(bid, nb, jj, ntn, tm, tn)) break;
        Dma3A al; al.set_dense(p.XBb, tm * 256, DM); Dma3B bl; bl.set(p.WIN1, p.WIN1, tn * 128, DM, 1 << 30);
        f32x4 acc[32];
        gemm_core4(al, bl, nk, acc);
#pragma unroll
        for (int i = 0; i < 8; ++i)
#pragma unroll
            for (int n = 0; n < 4; ++n) {
                const int row = tm * 256 + wr * 128 + i * 16 + fr, vc = tn * 128 + wc * 64 + n * 16 + fq * 4;
                const f32x4 a = acc[i * 4 + n];
                u32x2 w; w.x = pack2(a[0], a[1]); w.y = pack2(a[2], a[3]);
                if (tn < 4) *(u32x2*)(p.Qb + (size_t)row * 512 + vc) = w;
                else if (tn < 6) *(f32x4*)(p.KCV + (size_t)row * 256 + vc - 512) = a;
                else if (tn == 6) *(u32x2*)(p.KS + (size_t)row * 128 + vc - 768) = w;
                else if (tn == 7) *(u32x2*)(p.KW + (size_t)row * 128 + vc - 896) = w;
                else if (tn < 12) *(u32x2*)(p.MQ + (size_t)row * 512 + vc - 1024) = w;
                else if (tn < 16) *(u32x2*)(p.MK + (size_t)row * 512 + vc - 1536) = w;
                else if (vc < 2072) *(f32x4*)(p.GATES + (size_t)row * 24 + vc - 2048) = a;
            }
    }
    for (int u = (nb >= 512 ? bid - 64 : bid); u < 3 * 128; u += nb) {
        if (u < 0) continue;
        const int pn = u % 3, tt = u / 3;
        if (pn == 0) {
            const int wrr = tidx() >> 7;
            gemm_t_unit(p.WIN1, 2176, p.XBb, tt * 128, wrr ? p.VWt - (size_t)128 * SEQ : p.VSt, 128, 0);
        } else gemm_t_unit(p.WIN1, 2432 + (pn - 1) * 256, p.XBb, tt * 128, p.MVt, 512, (pn - 1) * 256);
    }
}
__device__ __forceinline__ void phase_moba_gate(char* lds, int bid, int nb, const P& p) {
    const int lane = tidx() & 63, wid = tidx() >> 6;
    float* km = (float*)lds + 4096 + wid * 512;
    for (int it = bid * 4 + wid; it < 64 * 32; it += nb * 4) {
        const int bh = it >> 5, tb = it & 31, b = bh >> 3, h = bh & 7;
        const int t = tb * 64 + lane, ob = t >> 8;
        __builtin_amdgcn_wave_barrier();
#pragma unroll
        for (int i = 0; i < 8; ++i) km[i * 64 + lane] = p.KM[(size_t)bh * 512 + i * 64 + lane];
        __builtin_amdgcn_wave_barrier();
        u32x4 qr[8];
#pragma unroll
        for (int i = 0; i < 8; ++i) qr[i] = *(const u32x4*)(p.MQ + (size_t)(b * SEQ + t) * 512 + h * 64 + i * 8);
        float gate[8];
#pragma unroll
        for (int j = 0; j < 8; ++j) gate[j] = 0.f;
#pragma unroll
        for (int i = 0; i < 8; ++i) {
            float q[8];
            q[0] = bf2f(qr[i].x & 0xffffu); q[1] = bf2f(qr[i].x >> 16); q[2] = bf2f(qr[i].y & 0xffffu); q[3] = bf2f(qr[i].y >> 16);
            q[4] = bf2f(qr[i].z & 0xffffu); q[5] = bf2f(qr[i].z >> 16); q[6] = bf2f(qr[i].w & 0xffffu); q[7] = bf2f(qr[i].w >> 16);
#pragma unroll
            for (int j = 0; j < 8; ++j)
#pragma unroll
                for (int e = 0; e < 8; ++e) gate[j] += q[e] * km[j * 64 + i * 8 + e];
        }
#pragma unroll
        for (int j = 0; j < 8; ++j) gate[j] = (j < ob) ? gate[j] : NEGF;
        unsigned selm = 0;
#pragma unroll
        for (int j = 0; j < 8; ++j) {
            int rank = 0;
#pragma unroll
            for (int j2 = 0; j2 < 8; ++j2) rank += (gate[j2] > gate[j] || (gate[j2] == gate[j] && j2 < j)) ? 1 : 0;
            if (j < ob && rank < 3) selm |= 1u << j;
        }
        p.MSEL[(size_t)bh * SEQ + t] = selm;
    }
}

#define ATT_K_BYTES 8192
#define ATT_STAGE 16384
#define ATT_TILE_BYTES (3 * ATT_STAGE)
#define ATT_ORDER_OFF ATT_TILE_BYTES
#define ATT_RED_OFF (ATT_ORDER_OFF + 8192)
__device__ __forceinline__ void att_issue_tile(int stage, const bf16_t* Kg, int ldk, const bf16_t* Vg) {
    const int lane = tidx() & 63, w = tidx() >> 6;
#pragma unroll
    for (int i = 0; i < 2; ++i) { int R, C; dma_rc(lane, w + 4 * i, R, C);
        __builtin_amdgcn_global_load_lds((const unsigned*)(Kg + (size_t)R * ldk + C), (LAS unsigned*)((LAS char*)dyn_lds + stage * ATT_STAGE + (w + 4 * i) * 1024), 16, 0, 0);
        __builtin_amdgcn_global_load_lds((const unsigned*)(Vg + (size_t)R * SEQ + C), (LAS unsigned*)((LAS char*)dyn_lds + stage * ATT_STAGE + ATT_K_BYTES + (w + 4 * i) * 1024), 16, 0, 0); }
}
#define ATT_WAIT_BAR(n) do { asm volatile("s_waitcnt vmcnt(" #n ") lgkmcnt(0)" ::: "memory"); __builtin_amdgcn_s_barrier(); asm volatile("" ::: "memory"); } while (0)
struct AttState { f32x4 O[4][2]; float m[2], l[2]; };
__device__ __forceinline__ void att_reset(AttState& S) {
#pragma unroll
    for (int q = 0; q < 2; ++q) { S.m[q] = NEGF; S.l[q] = 0.f;
#pragma unroll
        for (int d = 0; d < 4; ++d) S.O[d][q] = (f32x4){0.f, 0.f, 0.f, 0.f}; }
}
template <bool MASKED>
__device__ __forceinline__ void att_step(const char* lds, const bf16x8 (&qf)[2][2], AttState& S, const f32x4 (&bini)[4], float slope2,
                                         int s0, int tq0, unsigned selbits  , int winlimit) {
    const int lane = tidx() & 63, fr = lane & 15, fg = lane >> 4;
    const char* ldsV = lds + ATT_K_BYTES;
    const float offbase = slope2 * (float)s0;
    f32x4 s[2][4];
#pragma unroll
    for (int kt = 0; kt < 4; ++kt) {
        const bf16x8 k0 = *(const bf16x8*)(lds + lds_off(kt * 16 + fr, fg * 8)), k1 = *(const bf16x8*)(lds + lds_off(kt * 16 + fr, 32 + fg * 8));
#pragma unroll
        for (int qt = 0; qt < 2; ++qt) {
            s[qt][kt] = __builtin_amdgcn_mfma_f32_16x16x32_bf16(k0, qf[qt][0], bini[kt], 0, 0, 0);
            s[qt][kt] = __builtin_amdgcn_mfma_f32_16x16x32_bf16(k1, qf[qt][1], s[qt][kt], 0, 0, 0);
        }
    }
    __builtin_amdgcn_sched_barrier(0);
    u32x4 pf[2][2];
#pragma unroll
    for (int qt = 0; qt < 2; ++qt) {
        const int tq = tq0 + qt * 16 + fr;
        const float off = ((selbits >> qt) & 1u) ? (offbase - slope2 * (float)tq) : -INFINITY;
        float mx = -INFINITY;
#pragma unroll
        for (int kt = 0; kt < 4; ++kt)
#pragma unroll
            for (int r = 0; r < 4; ++r) {
                float y = s[qt][kt][r];
                if (MASKED) { const int key = s0 + kt * 16 + fg * 4 + r; const bool ok = (key <= tq) && (tq - key < winlimit); y = ok ? y : -INFINITY; s[qt][kt][r] = y; }
                mx = fmaxf(mx, y);
            }
        mx = fmaxf(mx, __shfl_xor(mx, 16)); mx = fmaxf(mx, __shfl_xor(mx, 32));
        const float mnew = fmaxf(S.m[qt], mx + off);
        const float alpha = __builtin_amdgcn_exp2f(S.m[qt] - mnew);
        S.m[qt] = mnew;
        const float thr = mnew - off;
        float ls = 0.f;
#pragma unroll
        for (int kt = 0; kt < 4; ++kt)
#pragma unroll
            for (int r = 0; r < 4; ++r) { const float pr = __builtin_amdgcn_exp2f(s[qt][kt][r] - thr); s[qt][kt][r] = pr; ls += pr; }
        S.l[qt] = S.l[qt] * alpha + ls;
#pragma unroll
        for (int dt = 0; dt < 4; ++dt) S.O[dt][qt] *= alpha;
#pragma unroll
        for (int kk = 0; kk < 2; ++kk) {
            pf[qt][kk].x = pack2(s[qt][2 * kk][0], s[qt][2 * kk][1]); pf[qt][kk].y = pack2(s[qt][2 * kk][2], s[qt][2 * kk][3]);
            pf[qt][kk].z = pack2(s[qt][2 * kk + 1][0], s[qt][2 * kk + 1][1]); pf[qt][kk].w = pack2(s[qt][2 * kk + 1][2], s[qt][2 * kk + 1][3]);
        }
    }
    __builtin_amdgcn_sched_barrier(0);
#pragma unroll
    for (int kk = 0; kk < 2; ++kk)
#pragma unroll
        for (int dt = 0; dt < 4; ++dt) {
            const char* vb = ldsV + (fg & 1) * 8;
            const u32x2 v0 = *(const u32x2*)(vb + lds_off(dt * 16 + fr, kk * 32 + (fg >> 1) * 8)), v1 = *(const u32x2*)(vb + lds_off(dt * 16 + fr, kk * 32 + 16 + (fg >> 1) * 8));
            u32x4 vv; vv.x = v0.x; vv.y = v0.y; vv.z = v1.x; vv.w = v1.y;
            const bf16x8 vf = __builtin_bit_cast(bf16x8, vv);
#pragma unroll
            for (int qt = 0; qt < 2; ++qt) S.O[dt][qt] = __builtin_amdgcn_mfma_f32_16x16x32_bf16(vf, __builtin_bit_cast(bf16x8, pf[qt][kk]), S.O[dt][qt], 0, 0, 0);
        }
    __builtin_amdgcn_sched_barrier(0);
}
__device__ __forceinline__ unsigned wave_or(unsigned v) {
#pragma unroll
    for (int o = 32; o >= 1; o >>= 1) v |= (unsigned)__shfl_xor((int)v, o);
    return v;
}
__device__ __forceinline__ void att_nsa_unit(char* lds, const P& p, int b, int g, int qtile) {
    const int tid = tidx(), lane = tid & 63, w = tid >> 6, fr = lane & 15, fg = lane >> 4;
    const int hd = g * 4 + w, t0 = qtile * 32, own = qtile >> 1;
    const float slope2 = exp2f(-((float)hd + 0.5f)) * LOG2E, c1 = 0.125f * LOG2E;
    bf16x8 qf[2][2];
#pragma unroll
    for (int qt = 0; qt < 2; ++qt)
#pragma unroll
        for (int ks = 0; ks < 2; ++ks) qf[qt][ks] = *(const bf16x8*)(p.Qb + (size_t)(b * SEQ + t0 + qt * 16 + fr) * 512 + hd * 64 + ks * 32 + fg * 8);
#pragma unroll
    for (int qt = 0; qt < 2; ++qt)
#pragma unroll
        for (int ks = 0; ks < 2; ++ks) {
            const u32x4 raw = __builtin_bit_cast(u32x4, qf[qt][ks]); u32x4 o;
            o.x = pack2(bf2f(raw.x & 0xffffu) * c1, bf2f(raw.x >> 16) * c1); o.y = pack2(bf2f(raw.y & 0xffffu) * c1, bf2f(raw.y >> 16) * c1);
            o.z = pack2(bf2f(raw.z & 0xffffu) * c1, bf2f(raw.z >> 16) * c1); o.w = pack2(bf2f(raw.w & 0xffffu) * c1, bf2f(raw.w >> 16) * c1);
            qf[qt][ks] = __builtin_bit_cast(bf16x8, o);
        }
    f32x4 bini[4];
#pragma unroll
    for (int kt = 0; kt < 4; ++kt)
#pragma unroll
        for (int r = 0; r < 4; ++r) bini[kt][r] = slope2 * (float)(kt * 16 + fg * 4 + r);
    unsigned selw[2];
#pragma unroll
    for (int qt = 0; qt < 2; ++qt) selw[qt] = p.SELM[(size_t)(b * 2 + g) * SEQ + t0 + qt * 16 + fr];
    const unsigned um = wave_or(selw[0] | selw[1]);
    AttState S; att_reset(S);
    unsigned rem = um & ((own >= 31) ? 0xffffffffu : ((2u << own) - 1u));
    int wj = own >= 8 ? own - 8 : 0;
    int cbr, cj; bool has = true;
    if (rem) { cj = __ffs(rem) - 1; rem &= rem - 1; cbr = 0; } else { cj = wj++; cbr = 1; }
    const bf16_t* Ks = p.KS + (size_t)b * SEQ * 128 + g * 64; const bf16_t* Kw = p.KW + (size_t)b * SEQ * 128 + g * 64;
    const bf16_t* Vs = p.VSt + (size_t)(b * 128 + g * 64) * SEQ; const bf16_t* Vw = p.VWt + (size_t)(b * 128 + g * 64) * SEQ;
    int n1br = 0, n1j = 0; bool has1;
    if (rem) { n1j = __ffs(rem) - 1; rem &= rem - 1; n1br = 0; has1 = true; } else if (wj <= own) { n1j = wj++; n1br = 1; has1 = true; } else has1 = false;
    __syncthreads();
    att_issue_tile(0, (cbr ? Kw : Ks) + (size_t)cj * 64 * 128, 128, (cbr ? Vw : Vs) + cj * 64);
    if (has1) att_issue_tile(1, (n1br ? Kw : Ks) + (size_t)n1j * 64 * 128, 128, (n1br ? Vw : Vs) + n1j * 64);
    bool switched = false;
    int st = 0;
    while (has) {
        if (has1) ATT_WAIT_BAR(4); else ATT_WAIT_BAR(0);
        int n2br = 0, n2j = 0; bool has2;
        if (!has1) has2 = false;
        else if (rem) { n2j = __ffs(rem) - 1; rem &= rem - 1; n2br = 0; has2 = true; } else if (wj <= own) { n2j = wj++; n2br = 1; has2 = true; } else has2 = false;
        if (has2) att_issue_tile(st == 0 ? 2 : st - 1, (n2br ? Kw : Ks) + (size_t)n2j * 64 * 128, 128, (n2br ? Vw : Vs) + n2j * 64);
        const char* sl = lds + st * ATT_STAGE;
        if (cbr == 1 && !switched) {
            switched = true;
#pragma unroll
            for (int qt = 0; qt < 2; ++qt) {
                float lt = S.l[qt]; lt += __shfl_xor(lt, 16); lt += __shfl_xor(lt, 32);
                const size_t n = (size_t)b * SEQ + t0 + qt * 16 + fr;
                const float sc = sigmoidf_(p.GATES[n * 24 + hd * 3 + 1]) / fmaxf(lt, 1e-30f);
#pragma unroll
                for (int dt = 0; dt < 4; ++dt) { const f32x4 y = S.O[dt][qt] * sc; u32x2 w; w.x = pack2(y[0], y[1]); w.y = pack2(y[2], y[3]); *(u32x2*)((bf16_t*)p.OS + n * 512 + hd * 64 + dt * 16 + fg * 4) = w; }
            }
            att_reset(S);
        }
        unsigned sb = 3u; int wl = 1 << 30; bool msk;
        if (cbr == 0) { sb = ((selw[0] >> cj) & 1u) | (((selw[1] >> cj) & 1u) << 1); msk = (cj == own); }
        else { wl = 512; msk = (cj == own) || (cj + 8 == own); }
        if (msk) att_step<true>(sl, qf, S, bini, slope2, cj * 64, t0, sb, wl);
        else att_step<false>(sl, qf, S, bini, slope2, cj * 64, t0, sb, wl);
        cbr = n1br; cj = n1j; has = has1; n1br = n2br; n1j = n2j; has1 = has2;
        st = (st == 2) ? 0 : st + 1;
    }
#pragma unroll
    for (int qt = 0; qt < 2; ++qt) {
        float lt = S.l[qt]; lt += __shfl_xor(lt, 16); lt += __shfl_xor(lt, 32);
        const size_t n = (size_t)b * SEQ + t0 + qt * 16 + fr;
        const float sc = sigmoidf_(p.GATES[n * 24 + hd * 3 + 2]) / fmaxf(lt, 1e-30f);
        const float g0 = sigmoidf_(p.GATES[n * 24 + hd * 3 + 0]);
#pragma unroll
        for (int dt = 0; dt < 4; ++dt) {
            const size_t o = n * 512 + hd * 64 + dt * 16 + fg * 4;
            const u32x2 osv = *(const u32x2*)((const bf16_t*)p.OS + o), ocv = *(const u32x2*)((const bf16_t*)p.OC + o);
            const f32x4 osf = {bf2f(osv.x & 0xffffu), bf2f(osv.x >> 16), bf2f(osv.y & 0xffffu), bf2f(osv.y >> 16)};
            const f32x4 ocf = {bf2f(ocv.x & 0xffffu), bf2f(ocv.x >> 16), bf2f(ocv.y & 0xffffu), bf2f(ocv.y >> 16)};
            const f32x4 y = S.O[dt][qt] * sc + osf + ocf * g0;
            u32x2 wv; wv.x = pack2(y[0], y[1]); wv.y = pack2(y[2], y[3]);
            *(u32x2*)(p.MIX + n * DM + hd * 64 + dt * 16 + fg * 4) = wv;
        }
    }
}
__device__ __forceinline__ void att_moba_unit(char* lds, const P& p, int b, int h, int ob, int half) {
    const int tid = tidx(), lane = tid & 63, w = tid >> 6, fr = lane & 15, fg = lane >> 4;
    const int tq0 = ob * 256 + half * 128 + w * 32;
    const int dsub = half * 2 + (w >> 1), lastsub = half * 2 + 1;
    const float slope2 = exp2f(-((float)h + 1.0f)) * LOG2E, c1 = 0.125f * LOG2E;
    bf16x8 qf[2][2];
#pragma unroll
    for (int qt = 0; qt < 2; ++qt)
#pragma unroll
        for (int ks = 0; ks < 2; ++ks) qf[qt][ks] = *(const bf16x8*)(p.MQ + (size_t)(b * SEQ + tq0 + qt * 16 + fr) * 512 + h * 64 + ks * 32 + fg * 8);
#pragma unroll
    for (int qt = 0; qt < 2; ++qt)
#pragma unroll
        for (int ks = 0; ks < 2; ++ks) {
            const u32x4 raw = __builtin_bit_cast(u32x4, qf[qt][ks]); u32x4 o;
            o.x = pack2(bf2f(raw.x & 0xffffu) * c1, bf2f(raw.x >> 16) * c1); o.y = pack2(bf2f(raw.y & 0xffffu) * c1, bf2f(raw.y >> 16) * c1);
            o.z = pack2(bf2f(raw.z & 0xffffu) * c1, bf2f(raw.z >> 16) * c1); o.w = pack2(bf2f(raw.w & 0xffffu) * c1, bf2f(raw.w >> 16) * c1);
            qf[qt][ks] = __builtin_bit_cast(bf16x8, o);
        }
    f32x4 bini[4];
#pragma unroll
    for (int kt = 0; kt < 4; ++kt)
#pragma unroll
        for (int r = 0; r < 4; ++r) bini[kt][r] = slope2 * (float)(kt * 16 + fg * 4 + r);
    unsigned selw[2];
#pragma unroll
    for (int qt = 0; qt < 2; ++qt) selw[qt] = p.MSEL[(size_t)(b * 8 + h) * SEQ + tq0 + qt * 16 + fr];
    unsigned* red = (unsigned*)(lds + ATT_RED_OFF);
    const unsigned umw = wave_or(selw[0] | selw[1]);
    __syncthreads();
    if (lane == 0) red[w] = umw;
    __syncthreads();
    unsigned rem = (red[0] | red[1] | red[2] | red[3]) & ((1u << ob) - 1u);
    AttState S; att_reset(S);
    int cj, csub = 0; bool has = true;
    if (rem) { cj = __ffs(rem) - 1; rem &= rem - 1; } else cj = ob;
    const bf16_t* Kb = p.MK + (size_t)b * SEQ * 512 + h * 64; const bf16_t* Vb = p.MVt + (size_t)(b * 512 + h * 64) * SEQ;
#define MOBA_NEXT(J, SUB, NJ, NSUB, HAS) do { \
        if ((J) == ob) { if ((SUB) < lastsub) { NJ = (J); NSUB = (SUB) + 1; HAS = true; } else HAS = false; } \
        else if ((SUB) < 3) { NJ = (J); NSUB = (SUB) + 1; HAS = true; } \
        else { if (rem) { NJ = __ffs(rem) - 1; rem &= rem - 1; } else NJ = ob; NSUB = 0; HAS = true; } } while (0)
    int n1j = 0, n1sub = 0; bool has1;
    MOBA_NEXT(cj, csub, n1j, n1sub, has1);
    __syncthreads();
    att_issue_tile(0, Kb + (size_t)(cj * 256 + csub * 64) * 512, 512, Vb + cj * 256 + csub * 64);
    if (has1) att_issue_tile(1, Kb + (size_t)(n1j * 256 + n1sub * 64) * 512, 512, Vb + n1j * 256 + n1sub * 64);
    int st = 0;
    while (has) {
        if (has1) ATT_WAIT_BAR(4); else ATT_WAIT_BAR(0);
        int n2j = 0, n2sub = 0; bool has2 = false;
        if (has1) MOBA_NEXT(n1j, n1sub, n2j, n2sub, has2);
        if (has2) att_issue_tile(st == 0 ? 2 : st - 1, Kb + (size_t)(n2j * 256 + n2sub * 64) * 512, 512, Vb + n2j * 256 + n2sub * 64);
        const char* sl = lds + st * ATT_STAGE;
        const int s0 = cj * 256 + csub * 64;
        unsigned sb = 3u; bool msk = false, run = true;
        if (cj < ob) sb = ((selw[0] >> cj) & 1u) | (((selw[1] >> cj) & 1u) << 1);
        else { msk = (csub == dsub); run = (csub <= dsub); }
        if (run) {
            if (msk) att_step<true>(sl, qf, S, bini, slope2, s0, tq0, sb, 1 << 30);
            else att_step<false>(sl, qf, S, bini, slope2, s0, tq0, sb, 1 << 30);
        }
        cj = n1j; csub = n1sub; has = has1; n1j = n2j; n1sub = n2sub; has1 = has2;
        st = (st == 2) ? 0 : st + 1;
    }
#undef MOBA_NEXT
#pragma unroll
    for (int qt = 0; qt < 2; ++qt) {
        float lt = S.l[qt]; lt += __shfl_xor(lt, 16); lt += __shfl_xor(lt, 32);
        const size_t n = (size_t)b * SEQ + tq0 + qt * 16 + fr;
        const float sc = 1.0f / fmaxf(lt, 1e-30f);
#pragma unroll
        for (int dt = 0; dt < 4; ++dt) {
            const f32x4 y = S.O[dt][qt] * sc;
            u32x2 wv; wv.x = pack2(y[0], y[1]); wv.y = pack2(y[2], y[3]);
            *(u32x2*)(p.MIX + n * DM + 512 + h * 64 + dt * 16 + fg * 4) = wv;
        }
    }
}
#ifndef ATT_NSA
#define ATT_NSA 1
#endif
#ifndef ATT_MOBA
#define ATT_MOBA 1
#endif
__device__ __forceinline__ int att_class_key(int c) {
    if (c < 64) { const int a = (c >> 1) + 1; return (a < 16 ? a : 16) + (a < 9 ? a : 9); }
    const int ob = (c - 64) >> 1, half = (c - 64) & 1; return 4 * ob + 2 + 2 * half;
}
__device__ __forceinline__ void cmpa_unit(char* lds, const P& p, int b, int g, int qt64);
__device__ __forceinline__ void phase_attn_a(char* lds, int bid, int nb, const P& p) {
    int* order = (int*)(lds + 49152);
    __syncthreads();
    for (int u = tidx(); u < 1024; u += 256) {
        const int c = u & 15, inst = u >> 4;
        const int key = att_class_key(64 + c);
        int pos = inst;
        for (int c2 = 0; c2 < 16; ++c2) { const int k2 = att_class_key(64 + c2); if (k2 > key || (k2 == key && c2 < c)) pos += 64; }
        order[pos] = u;
    }
    __syncthreads();
    for (int r = 0;; ++r) {
        const int idx = r * nb + ((r & 1) ? (nb - 1 - bid) : bid);
        if (idx >= 512 + 1024) break;
        if (idx < 512) cmpa_unit(lds, p, idx >> 6, (idx >> 5) & 1, idx & 31);
        else { const int v = order[idx - 512]; att_moba_unit(lds, p, v >> 7, (v >> 4) & 7, (v >> 1) & 7, v & 1); }
    }
    __syncthreads();
}
__device__ __forceinline__ void phase_attn_b(char* lds, int bid, int nb, const P& p) {
    int* order = (int*)(lds + ATT_ORDER_OFF);
    __syncthreads();
    for (int u = tidx(); u < 1024; u += 256) {
        const int c = u & 63, inst = u >> 6;
        const int key = att_class_key(c);
        int pos = inst;
        for (int c2 = 0; c2 < 64; ++c2) { const int k2 = att_class_key(c2); if (k2 > key || (k2 == key && c2 < c)) pos += 16; }
        order[pos] = u;
    }
    __syncthreads();
    for (int r = 0;; ++r) {
        const int idx = r * nb + ((r & 1) ? (nb - 1 - bid) : bid);
        if (idx >= 1024) break;
        const int u = order[idx];
        att_nsa_unit(lds, p, u >> 7, (u >> 6) & 1, u & 63);
    }
    __syncthreads();
}

struct ALoadCmp {
    const float* base;
    const float* pe;
    int kt0;
    struct Regs { f32x4 v[8]; };
    __device__ __forceinline__ void load(int kt, Regs& R) const {
        const int l = kt + kt0;
        const f32x4 p0 = *(const f32x4*)(pe + l * 64), p1 = *(const f32x4*)(pe + l * 64 + 4);
#pragma unroll
        for (int i = 0; i < 4; ++i) {
            const int row = (tidx() + 256 * i) >> 3; int tok = 16 * row + l; tok = tok > SEQ - 1 ? SEQ - 1 : tok;
            const float* q = base + (size_t)tok * 256;
            R.v[2 * i] = *(const f32x4*)q + p0; R.v[2 * i + 1] = *(const f32x4*)(q + 4) + p1;
        }
    }
    __device__ __forceinline__ void store(int kt, const Regs& R, char* lds) const {
#pragma unroll
        for (int i = 0; i < 4; ++i) {
            const int p = tidx() + 256 * i, row = p >> 3, ch = p & 7;
            const f32x4 a = R.v[2 * i], b = R.v[2 * i + 1];
            u32x4 w; w.x = pack2(a[0], a[1]); w.y = pack2(a[2], a[3]); w.z = pack2(b[0], b[1]); w.w = pack2(b[2], b[3]);
            *(u32x4*)(lds + lds_off(row, ch * 8)) = w;
        }
    }
};
__device__ __forceinline__ void phase_cmp1(char* lds, int bid, int nb, const P& p) {
    const int tid = tidx(), lane = tid & 63, wid = tid >> 6, wr = wid >> 1, wc = wid & 1, fr = lane & 15, fq = lane >> 4;
    for (int u = bid; u < 16 * 2 * 4; u += nb) {
        const int split = u & 3, which = (u >> 2) & 1, bg = u >> 3, b = bg >> 1, g = bg & 1;
        ALoadCmp al; al.kt0 = split * 8; al.base = p.KCV + (size_t)b * SEQ * 256 + which * 128 + g * 64 + (tid & 7) * 8; al.pe = (which ? p.pe_v : p.pe_k) + (tid & 7) * 8;
        BLoadF32 bl; { const int nq = tid & 31, kg = tid >> 5; bl.valid = true; bl.ldb = 128; bl.nk1 = 1 << 30; bl.bp = (which ? p.wv1 : p.wk1) + (size_t)(split * 8 * 64 + kg * 8) * 128 + nq * 4; }
        f32x4 acc[4][4];
        gemm_tile(lds, al, bl, 8, acc);
        float* hid = p.HID + (((size_t)split * 2 + which) * 2048 + bg * 128) * 128;
#pragma unroll
        for (int m = 0; m < 4; ++m)
#pragma unroll
            for (int n = 0; n < 4; ++n) {
                const int row = wr * 64 + m * 16 + fr, col = wc * 64 + n * 16 + fq * 4;
                *(f32x4*)(hid + (size_t)row * 128 + col) = acc[m][n];
            }
    }
}
__device__ __forceinline__ void phase_cmp2(char* lds, int bid, int nb, const P& p) {
    const int tid = tidx(), lane = tid & 63, wid = tid >> 6;
    float* hs = (float*)lds + wid * 128;
    for (int it = bid * 4 + wid; it < 2 * 16 * 128; it += nb * 4) {
        const int which = it >> 11, bg = (it >> 7) & 15, c = it & 127;
        float o = 0.f;
        if (c < 127) {
            const float* hid = p.HID + ((size_t)which * 2048 + bg * 128 + c) * 128;
            const size_t ss = (size_t)2 * 2048 * 128;
            __builtin_amdgcn_wave_barrier();
            hs[lane] = gelu_tanh((hid[lane] + hid[ss + lane]) + (hid[2 * ss + lane] + hid[3 * ss + lane]));
            hs[lane + 64] = gelu_tanh((hid[lane + 64] + hid[ss + lane + 64]) + (hid[2 * ss + lane + 64] + hid[3 * ss + lane + 64]));
            __builtin_amdgcn_wave_barrier();
            const float* w2 = which ? p.wv2 : p.wk2;
#pragma unroll 8
            for (int j = 0; j < 128; ++j) o += hs[j] * w2[j * 64 + lane];
        }
        if (which == 0) p.KCb[((size_t)bg * 128 + c) * 64 + lane] = (bf16_t)f2bf(o);
        else p.VCt[((size_t)bg * 64 + lane) * 128 + c] = (bf16_t)f2bf(o);
    }
}
#define CMPA_LDS (2 * 16384 + 4 * 2048)
__device__ __forceinline__ void cmpa_unit(char* lds, const P& p, int b, int g, int qt64) {
    const int tid = tidx(), lane = tid & 63, w = tid >> 6, fr = lane & 15, fg = lane >> 4;
    const int bg = b * 2 + g;
    char* kc = lds; char* vt = lds + 16384;
    __syncthreads();
#pragma unroll
    for (int i = 0; i < 4; ++i) { const int pc = tid + 256 * i;
        *(u32x4*)(kc + lds_off(pc >> 3, (pc & 7) * 8)) = *(const u32x4*)(p.KCb + (size_t)bg * 8192 + pc * 8);
        *(u32x4*)(vt + lds_off128(pc >> 4, (pc & 15) * 8)) = *(const u32x4*)(p.VCt + (size_t)bg * 8192 + pc * 8); }
    __syncthreads();
    const int t = qt64 * 64 + w * 16 + fr;
    const size_t n = (size_t)b * SEQ + t;
    const float c1 = 0.125f * LOG2E;
    f32x4 psum[8];
#pragma unroll
    for (int ct = 0; ct < 8; ++ct) psum[ct] = (f32x4){0.f, 0.f, 0.f, 0.f};
    bf16x8 qall[4][2];
#pragma unroll
    for (int i = 0; i < 4; ++i) { qall[i][0] = *(const bf16x8*)(p.Qb + n * 512 + (g * 4 + i) * 64 + fg * 8); qall[i][1] = *(const bf16x8*)(p.Qb + n * 512 + (g * 4 + i) * 64 + 32 + fg * 8); }
#pragma unroll
    for (int i = 0; i < 4; ++i) {
        const int hd = g * 4 + i;
        const float slope2 = exp2f(-((float)hd + 0.5f)) * LOG2E;
        const bf16x8 q0 = qall[i][0], q1 = qall[i][1];
        __builtin_amdgcn_sched_barrier(0);
        f32x4 s[8];
        float mx = -INFINITY;
#pragma unroll
        for (int ct = 0; ct < 8; ++ct) {
            const bf16x8 k0 = *(const bf16x8*)(kc + lds_off(ct * 16 + fr, fg * 8)), k1 = *(const bf16x8*)(kc + lds_off(ct * 16 + fr, 32 + fg * 8));
            s[ct] = __builtin_amdgcn_mfma_f32_16x16x32_bf16(k0, q0, (f32x4){0.f, 0.f, 0.f, 0.f}, 0, 0, 0);
            s[ct] = __builtin_amdgcn_mfma_f32_16x16x32_bf16(k1, q1, s[ct], 0, 0, 0);
#pragma unroll
            for (int r = 0; r < 4; ++r) {
                const int e = 16 * (ct * 16 + fg * 4 + r) + 31;
                const float y = (e <= t) ? fmaf(s[ct][r], c1, -slope2 * (float)(t - e)) : -INFINITY;
                s[ct][r] = y; mx = fmaxf(mx, y);
            }
        }
        __builtin_amdgcn_sched_barrier(0);
        mx = fmaxf(mx, __shfl_xor(mx, 16)); mx = fmaxf(mx, __shfl_xor(mx, 32));
        const float mm = (mx == -INFINITY) ? 0.f : mx;
        float ls = 0.f;
#pragma unroll
        for (int ct = 0; ct < 8; ++ct)
#pragma unroll
            for (int r = 0; r < 4; ++r) { const float e = __builtin_amdgcn_exp2f(s[ct][r] - mm); s[ct][r] = e; ls += e; }
        ls += __shfl_xor(ls, 16); ls += __shfl_xor(ls, 32);
        const float inv = 1.0f / fmaxf(ls, 1e-30f);
#pragma unroll
        for (int ct = 0; ct < 8; ++ct) { s[ct] *= inv; psum[ct] += s[ct]; }
        __builtin_amdgcn_sched_barrier(0);
        f32x4 o[4];
#pragma unroll
        for (int dt = 0; dt < 4; ++dt) o[dt] = (f32x4){0.f, 0.f, 0.f, 0.f};
#pragma unroll
        for (int kk = 0; kk < 4; ++kk) {
            u32x4 pw; pw.x = pack2(s[2 * kk][0], s[2 * kk][1]); pw.y = pack2(s[2 * kk][2], s[2 * kk][3]); pw.z = pack2(s[2 * kk + 1][0], s[2 * kk + 1][1]); pw.w = pack2(s[2 * kk + 1][2], s[2 * kk + 1][3]);
            const bf16x8 pf = __builtin_bit_cast(bf16x8, pw);
#pragma unroll
            for (int dt = 0; dt < 4; ++dt) {
                const int c0 = kk * 32 + fg * 4;
                const u32x2 v0 = *(const u32x2*)(vt + lds_off128(dt * 16 + fr, c0 & ~7) + (c0 & 7) * 2);
                const u32x2 v1 = *(const u32x2*)(vt + lds_off128(dt * 16 + fr, (c0 + 16) & ~7) + (c0 & 7) * 2);
                u32x4 vv; vv.x = v0.x; vv.y = v0.y; vv.z = v1.x; vv.w = v1.y;
                o[dt] = __builtin_amdgcn_mfma_f32_16x16x32_bf16(__builtin_bit_cast(bf16x8, vv), pf, o[dt], 0, 0, 0);
            }
        }
#pragma unroll
        for (int dt = 0; dt < 4; ++dt) { u32x2 w; w.x = pack2(o[dt][0], o[dt][1]); w.y = pack2(o[dt][2], o[dt][3]); *(u32x2*)((bf16_t*)p.OC + n * 512 + hd * 64 + dt * 16 + fg * 4) = w; }
    }
    const int own = t >> 6;
    float val[8];
#pragma unroll
    for (int ct = 0; ct < 8; ++ct) {
        const float up = __shfl(psum[ct][3], (lane + 48) & 63);
        const float up0 = (ct > 0) ? __shfl(psum[ct > 0 ? ct - 1 : 0][3], (lane + 48) & 63) : 0.f;
        const float imp = (psum[ct][0] + psum[ct][1]) + (psum[ct][2] + psum[ct][3]) + (fg > 0 ? up : up0);
        const int j = ct * 4 + fg;
        const bool forced = (j == 0) || (j == own) || (j == own - 1);
        val[ct] = (j <= own) ? (imp + (forced ? 1e4f : 0.f)) : NEGF;
    }
    float* vs = (float*)(lds + 32768) + w * 512;
    __builtin_amdgcn_wave_barrier();
#pragma unroll
    for (int ct = 0; ct < 8; ++ct) vs[fr * 32 + ct * 4 + fg] = val[ct];
    __builtin_amdgcn_wave_barrier();
    int rank[8];
#pragma unroll
    for (int ct = 0; ct < 8; ++ct) rank[ct] = 0;
#pragma unroll 2
    for (int oj = 0; oj < 32; ++oj) {
        const float ov = vs[fr * 32 + oj];
#pragma unroll
        for (int ct = 0; ct < 8; ++ct) rank[ct] += (ov > val[ct] || (ov == val[ct] && oj < ct * 4 + fg)) ? 1 : 0;
    }
    __builtin_amdgcn_wave_barrier();
    unsigned bits = 0;
#pragma unroll
    for (int ct = 0; ct < 8; ++ct) if ((ct * 4 + fg <= own) && rank[ct] < 16) bits |= 1u << (ct * 4 + fg);
    bits |= (unsigned)__shfl_xor((int)bits, 16); bits |= (unsigned)__shfl_xor((int)bits, 32);
    if (fg == 0) p.SELM[(size_t)bg * SEQ + t] = bits;
}
#define MEGA_LDS (((HG3_LDS + 255) & ~255) + 16)
static_assert(HG3_LDS >= G4_LDS && HG3_LDS >= CMPA_LDS && HG3_LDS >= GEMM_LDS && HG3_LDS >= ATT_RED_OFF + 16, "LDS map");
#define GBAR() xcd_barrier(bar)

template <int LAYER>
__device__ __forceinline__ void moe_block(char* lds, int bid, int nb, const P& p, const XcdBarrier& bar, float* of, bf16_t* ob, bf16_t* ol) {
    if (bid < 32) p.cnt[bid * NEXP + tidx()] = 0;
    phase_router(bid, nb, p, LAYER);
    GBAR();
    phase_route(bid, nb, p, LAYER);
    GBAR();
    phase_scatter(lds, bid, nb, p);
    GBAR();
    phase_moe1(lds, bid, nb, p, LAYER, p.XAb);
    GBAR();
    phase_moe2(lds, bid, nb, p, LAYER);
    GBAR();
    phase_combine_ln(bid, nb, p, p.XA, p.ln_g + (LAYER * 2 + 1) * DM, p.ln_b + (LAYER * 2 + 1) * DM, of, ob, ol);
}

__global__ void __launch_bounds__(256, 2) mega(P p) {
    char* lds = dyn_lds;
    const int bid = blockIdx.x, nb = gridDim.x;
    volatile LAS unsigned* st = (volatile LAS unsigned*)(dyn_lds + MEGA_LDS - 16);
    if (tidx() == 0) { st[0] = 0u; st[1] = 0u; st[2] = 0u; st[3] = 0u; }
    __syncthreads();
    const XcdBarrier bar = xcd_barrier_post(p.bar, st);
    phase_prep(lds, bid, nb, p);
    GBAR();
    phase_inproj0(lds, bid, nb, p);
    GBAR();
    phase_mix0_a(lds, bid, nb, p);
    GBAR();
    phase_hg2(bid, nb, p);
    for (int u = nb - 1 - bid; u < 512; u += nb) lru2_unit(p, u >> 6, (u >> 1) & 31, u & 1);
    GBAR();
    phase_mix0_c(lds, bid, nb, p);
    GBAR();
    phase_gemm_f32out(bid, nb, p.MIX, p.WOUT0, DM, DM, p.T0);
    GBAR();
    phase_ln_add(bid, nb, p.x, nullptr, nullptr, p.T0, p.ln_g, p.ln_b, nullptr, p.XAb, p.XAl);
    GBAR();
    moe_block<0>(lds, bid, nb, p, bar, nullptr, p.XBb, p.XBl);
    GBAR();
    phase_inproj1(lds, bid, nb, p);
    GBAR();
    phase_cmp1(lds, bid, nb, p);
    phase_moba_kmean(bid, nb, p);
    GBAR();
    phase_cmp2(lds, bid, nb, p);
    phase_moba_gate(lds, bid, nb, p);
    GBAR();
    phase_attn_a(lds, bid, nb, p);
    GBAR();
    phase_attn_b(lds, bid, nb, p);
    GBAR();
    phase_gemm_f32out(bid, nb, p.MIX, p.WOUT1, DM, DM, p.T0);
    GBAR();
    phase_ln_add(bid, nb, nullptr, p.XBb, p.XBl, p.T0, p.ln_g + 2 * DM, p.ln_b + 2 * DM, nullptr, p.XAb, p.XAl);
    GBAR();
    moe_block<1>(lds, bid, nb, p, bar, p.out, nullptr, nullptr);
}

static inline size_t al256(size_t x) { return (x + 255) & ~(size_t)255; }

extern "C" void kernel_launch(void* const* d_in, const int* in_sizes, int n_in, void* d_out, int out_size, void* d_ws, size_t ws_size, hipStream_t stream) {
    P p{};
    const float** ip = (const float**)&p.x;
    for (int i = 0; i < 30; ++i) ip[i] = (const float*)d_in[i];
    p.out = (float*)d_out;
    char* w = (char*)d_ws; size_t o = 0;
    auto take = [&](size_t bytes) { char* r = w + o; o = al256(o + bytes); return r; };
    p.bar = (unsigned*)take(XCD_BAR_WORDS * 4);
    p.U = (float*)take((size_t)NTOK * EVEN_IN * 4);
    p.MIX = (bf16_t*)take((size_t)NTOK * DM * 2);
    p.T0 = (float*)take((size_t)NTOK * DM * 4);
    p.XA = (float*)take((size_t)NTOK * DM * 4); p.XAb = (bf16_t*)take((size_t)NTOK * DM * 2); p.XAl = (bf16_t*)take((size_t)NTOK * DM * 2); p.XBl = (bf16_t*)take((size_t)NTOK * DM * 2);
    p.XB = (float*)take((size_t)NTOK * DM * 4); p.XBb = (bf16_t*)take((size_t)NTOK * DM * 2);
    p.LOG = (float*)take((size_t)3 * NTOK * NEXP * 4);
    p.eidx = (int*)take(NTOK * 8 * 4); p.ew = (float*)take(NTOK * 8 * 4); p.erank = (int*)take(NTOK * 8 * 4); p.epos = (int*)take(NTOK * 8 * 4);
    p.cnt = (int*)take(32 * NEXP * 4); p.tile_e = (int*)take(NTILES * 4); p.rowtok = (int*)take(NROWS * 4);
    p.H = (bf16_t*)take((size_t)NROWS * 256 * 2);
    p.Y = (bf16_t*)take((size_t)NROWS * DM * 2);
    p.LA = (float*)take((size_t)NTOK * 512 * 4); p.LB = (float*)take((size_t)NTOK * 512 * 4);
    p.KC = (float*)take(16 * 127 * 64 * 4); p.VC = (float*)take(16 * 127 * 64 * 4);
    p.OC = (float*)take((size_t)NTOK * 512 * 4);
    p.SELM = (unsigned*)take(16 * SEQ * 4);
    p.KM = (float*)take(8 * 8 * 8 * 64 * 4);
    p.Qb = (bf16_t*)take((size_t)NTOK * 512 * 2); p.KS = (bf16_t*)take((size_t)NTOK * 128 * 2); p.VSt = (bf16_t*)take((size_t)NTOK * 128 * 2);
    p.KW = (bf16_t*)take((size_t)NTOK * 128 * 2); p.VWt = (bf16_t*)take((size_t)NTOK * 128 * 2);
    p.MQ = (bf16_t*)take((size_t)NTOK * 512 * 2); p.MK = (bf16_t*)take((size_t)NTOK * 512 * 2); p.MVt = (bf16_t*)take((size_t)NTOK * 512 * 2);
    p.KCV = (float*)take((size_t)NTOK * 256 * 4); p.GATES = (float*)take((size_t)NTOK * 24 * 4); p.OS = (float*)take((size_t)NTOK * 512 * 4);
    p.MSEL = (unsigned*)take(64 * SEQ * 4);
    p.UB0 = (bf16_t*)take((size_t)NTOK * 2560 * 2); p.VHt = (bf16_t*)take((size_t)NTOK * 512 * 2);
    p.WAT = (bf16_t*)take(8 * 64 * 64 * 2); p.WXT = (bf16_t*)take(8 * 64 * 64 * 2);
    p.CSA = (float*)take(8 * 32 * 512 * 4); p.CSB = (float*)take(8 * 32 * 512 * 4);
    p.UT = (bf16_t*)take((size_t)1024 * 16384 * 2); p.SP = (bf16_t*)take((size_t)1024 * 16384 * 2);
    p.DV = (float*)take(1024 * 128 * 4);
    p.XIb = (bf16_t*)take((size_t)NTOK * DM * 2);
    p.plist = (int*)take(8 * 320 * 4); p.plen = (int*)take(64);
    p.WIN0 = (bf16_t*)take((size_t)EVEN_IN * DM * 2); p.WOUT0 = (bf16_t*)take((size_t)DM * DM * 2); p.WIN1 = (bf16_t*)take((size_t)2944 * DM * 2); p.WOUT1 = (bf16_t*)take((size_t)DM * DM * 2);
    p.WRH = (bf16_t*)take((size_t)2 * NEXP * DM * 2); p.WRL = (bf16_t*)take((size_t)2 * NEXP * DM * 2);
    p.HID = (float*)take((size_t)4 * 2 * 2048 * 128 * 4); p.KCb = (bf16_t*)take(16 * 128 * 64 * 2); p.VCt = (bf16_t*)take(16 * 64 * 128 * 2);
    if (o > ws_size) return;

    static int grid = 0;
    if (!grid) {
        int dev = 0, cus = 0, per_cu = 0;
        (void)hipGetDevice(&dev);
        (void)hipDeviceGetAttribute(&cus, hipDeviceAttributeMultiprocessorCount, dev);
        (void)hipFuncSetAttribute((const void*)mega, hipFuncAttributeMaxDynamicSharedMemorySize, MEGA_LDS);
        (void)hipOccupancyMaxActiveBlocksPerMultiprocessor(&per_cu, (const void*)mega, 256, MEGA_LDS);
        if (per_cu < 1) per_cu = 1;
        grid = cus * (per_cu < 2 ? per_cu : 2);
    }
    (void)hipMemsetAsync(p.bar, 0, XCD_BAR_WORDS * 4, stream);
    hipLaunchKernelGGL(mega, dim3(grid), dim3(256), MEGA_LDS, stream, p);
}
```

```cpp
#include <hip/hip_runtime.h>
#include <hip/hip_bf16.h>
#include <stdint.h>

#define NTOK 16384
#define DM 1024
#define SEQ 2048
#define NBATCH 8
#define EVEN_IN 3072
#define ODD_IN 2840
#define NEXP 256
#define NEGF (-1e30f)
#define LOG2E 1.4426950408889634f
#define DN_ALPHA 1.4142135623730951f
#define LN_EPS 1e-5f
#define MAXRT 1280
#define SH_TILE0 1280
#define NTILES (1280 + 128)
#define NROWS (NTILES * 128)

typedef unsigned short bf16_t;
typedef short bf16x8 __attribute__((ext_vector_type(8)));
typedef float f32x4 __attribute__((ext_vector_type(4)));
typedef unsigned u32x4 __attribute__((ext_vector_type(4)));
typedef unsigned u32x2 __attribute__((ext_vector_type(2)));
extern __shared__ __attribute__((aligned(16))) char dyn_lds[];
#define LAS __attribute__((address_space(3)))

__device__ __forceinline__ int tidx() { int t = threadIdx.x; asm volatile("" : "+v"(t)); return t; }
__device__ __forceinline__ float wave_sum(float v) {
#pragma unroll
    for (int o = 32; o >= 1; o >>= 1) v += __shfl_xor(v, o);
    return v;
}
__device__ __forceinline__ float wave_max(float v) {
#pragma unroll
    for (int o = 32; o >= 1; o >>= 1) v = fmaxf(v, __shfl_xor(v, o));
    return v;
}
typedef __bf16 hwbf16x2 __attribute__((ext_vector_type(2)));
typedef float f32x2 __attribute__((ext_vector_type(2)));
__device__ __forceinline__ unsigned f2bf(float f) { const __bf16 h = (__bf16)f; return (unsigned)__builtin_bit_cast(unsigned short, h); }
__device__ __forceinline__ float bf2f(unsigned b) { return __uint_as_float(b << 16); }
__device__ __forceinline__ unsigned pack2(float lo, float hi) { const f32x2 f = {lo, hi}; const hwbf16x2 v = __builtin_convertvector(f, hwbf16x2); return __builtin_bit_cast(unsigned, v); }
__device__ __forceinline__ float sigmoidf_(float x) { return 1.0f / (1.0f + __expf(-x)); }
__device__ __forceinline__ float siluf_(float x) { return x / (1.0f + __expf(-x)); }
__device__ __forceinline__ float gelu_tanh(float x) {
    const float u2 = 1.5957691216057308f * (x + 0.044715f * x * x * x);
    return x / (1.0f + __expf(-u2));
}


#define XB_TMO      128
#define XB_XCNT(j)  (256  + 64 * (j))
#define XB_XSUB(j)  (1280 + 64 * (j))
#define XB_XGEN(j)  (2304 + 64 * (j))
#define XB_TOP      3328
#define XB_TOPGEN   3392
#define XCD_BAR_WORDS 3456
#define XB_SPIN_CAP (1u << 18)
__device__ __forceinline__ unsigned xb_ld(unsigned* p)              { return __hip_atomic_load(p, __ATOMIC_RELAXED, __HIP_MEMORY_SCOPE_AGENT); }
__device__ __forceinline__ unsigned xb_add(unsigned* p, unsigned v) { return __hip_atomic_fetch_add(p, v, __ATOMIC_RELAXED, __HIP_MEMORY_SCOPE_AGENT); }
__device__ __forceinline__ unsigned xb_xcc_id() { return (unsigned)__builtin_amdgcn_s_getreg((3 << 11) | 20) & 0xFu; }
#define XB_SPIN(cond, bar) do { unsigned _sp = 0; while (cond) { __builtin_amdgcn_s_sleep(1); \
    if ((++_sp & 255u) == 0u) { if (xb_ld(&(bar)[XB_TMO])) break; if (_sp > XB_SPIN_CAP) { atomicAdd(&(bar)[XB_TMO], 1u); break; } } } } while (0)
struct XcdBarrier { unsigned* bar; unsigned x; volatile LAS unsigned* st; };
__device__ __forceinline__ XcdBarrier xcd_barrier_post(unsigned* bar, volatile LAS unsigned* st) {
    XcdBarrier b; b.bar = bar; b.x = xb_xcc_id(); b.st = st;
    if (tidx() == 0) (void)xb_add(&bar[XB_XCNT(b.x)], 1u);
    return b;
}
__device__ __forceinline__ void xcd_barrier_complete(unsigned* bar, unsigned x, unsigned& nloc, unsigned& nx) {
    const unsigned G = gridDim.x * gridDim.y * gridDim.z;
    unsigned sum, cnt, mine, sp = 0u;
    for (;;) {
        sum = 0u; cnt = 0u; mine = 0u;
#pragma unroll
        for (unsigned j = 0; j < 16; ++j) { const unsigned c = xb_ld(&bar[XB_XCNT(j)]); sum += c; cnt += (c > 0u) ? 1u : 0u; mine = (j == x) ? c : mine; }
        if (sum == G) break;
        __builtin_amdgcn_s_sleep(1);
        if ((++sp & 255u) == 0u) { if (xb_ld(&bar[XB_TMO])) break; if (sp > XB_SPIN_CAP) { atomicAdd(&bar[XB_TMO], 1u); break; } }
    }
    nloc = mine > 0u ? mine : 1u; nx = cnt > 0u ? cnt : 1u;
}
__device__ __forceinline__ void xcd_barrier(const XcdBarrier& b) {
    asm volatile("s_waitcnt vmcnt(0)" ::: "memory");
    __syncthreads();
    if (tidx() == 0) {
        unsigned* bar = b.bar;
        __builtin_amdgcn_s_waitcnt(0);
        unsigned nloc = b.st[0], nx = b.st[1];
        if (nloc == 0u) { xcd_barrier_complete(bar, b.x, nloc, nx); b.st[0] = nloc; b.st[1] = nx; }
        const unsigned old = xb_add(&bar[XB_XSUB(b.x)], 1u);
        const unsigned gen = old / nloc;
        if (old + 1u == (gen + 1u) * nloc) {
            __builtin_amdgcn_fence(__ATOMIC_RELEASE, "agent");
            asm volatile("s_waitcnt vmcnt(0)" ::: "memory");
            const unsigned og = xb_add(&bar[XB_TOP], 1u);
            const unsigned tg = og / nx;
            if (og + 1u == (tg + 1u) * nx) xb_add(&bar[XB_TOPGEN], 1u);
            else XB_SPIN(xb_ld(&bar[XB_TOPGEN]) == tg, bar);
            __builtin_amdgcn_fence(__ATOMIC_ACQUIRE, "agent");
            xb_add(&bar[XB_XGEN(b.x)], 1u);
            asm volatile("s_waitcnt vmcnt(0)" ::: "memory");
        } else {
            XB_SPIN(xb_ld(&bar[XB_XGEN(b.x)]) == gen, bar);
            __builtin_amdgcn_fence(__ATOMIC_ACQUIRE, "agent");
            asm volatile("s_waitcnt vmcnt(0)" ::: "memory");
        }
    }
    __syncthreads();
}

struct P {
    const float *x, *even_w_in, *conv_w, *conv_b, *wa, *ba, *wx, *bx, *lam, *hg_lb, *hg_ng, *even_w_out;
    const float *odd_w_in, *pe_k, *pe_v, *wk1, *wk2, *wv1, *wv2, *odd_w_out, *ln_g, *ln_b, *w_router, *b_router;
    const float *w_gate, *w_up, *w_down, *ws_gate, *ws_up, *ws_down;
    float* out;
    float* U;
    bf16_t* MIX;
    float* T0;
    float* XA; bf16_t* XAb; float* XB; bf16_t* XBb; bf16_t* XAl; bf16_t* XBl;
    float* LOG;
    int* eidx; float* ew; int* erank; int* epos;
    int* cnt;
    int* tile_e;
    int* rowtok;
    bf16_t* H;
    bf16_t* Y;
    float* LA; float* LB;
    float* KC; float* VC;
    float* OC;
    unsigned* SELM;
    float* KM;
    unsigned* bar;
    bf16_t *Qb, *KS, *VSt, *KW, *VWt, *MQ, *MK, *MVt;
    float *KCV, *GATES, *OS; unsigned* MSEL;
    bf16_t *UB0;
    bf16_t *VHt;
    bf16_t *WAT, *WXT;
    float *CSA, *CSB;
    bf16_t *UT, *SP;
    float *DV;
    float *HID;
    bf16_t *KCb, *VCt;
    bf16_t *XIb;
    int *plist; int *plen;
    bf16_t *WIN0, *WOUT0, *WIN1, *WOUT1, *WRH, *WRL;
};

__device__ __forceinline__ int lds_off(int r, int c) {
    const int st = (r >> 4) * 2 + (c >> 5), ob = (r & 15) * 64 + (c & 31) * 2;
    return st * 1024 + (ob ^ (((ob >> 9) & 1) << 5));
}
#define GEMM_LDS 32768

__device__ __forceinline__ float cvt_part(float v, int lo) { return lo ? (v - bf2f(f2bf(v))) : v; }

struct BLoadF32 {
    const float* bp; int ldb; bool valid; int nk1;
    struct Regs { f32x4 v[8]; };
    __device__ __forceinline__ void load(int kt, Regs& R) const {
        const float* p = bp + (size_t)((kt % nk1) * 64) * ldb;
#pragma unroll
        for (int j = 0; j < 8; ++j) R.v[j] = valid ? *(const f32x4*)(p + (size_t)j * ldb) : (f32x4){0.f, 0.f, 0.f, 0.f};
    }
    __device__ __forceinline__ void store(int kt, const Regs& R, char* lds) const {
        const int lo = (kt / nk1) == 1;
        const int nq = tidx() & 31, kg = tidx() >> 5;
#pragma unroll
        for (int i = 0; i < 4; ++i) {
            u32x4 w;
            w.x = pack2(cvt_part(R.v[0][i], lo), cvt_part(R.v[1][i], lo)); w.y = pack2(cvt_part(R.v[2][i], lo), cvt_part(R.v[3][i], lo));
            w.z = pack2(cvt_part(R.v[4][i], lo), cvt_part(R.v[5][i], lo)); w.w = pack2(cvt_part(R.v[6][i], lo), cvt_part(R.v[7][i], lo));
            *(u32x4*)(lds + lds_off(nq * 4 + i, kg * 8)) = w;
        }
    }
};

template <class AL, class BL>
__device__ __forceinline__ void gemm_tile(char* lds, const AL& al, const BL& bl, int nk, f32x4 (&acc)[4][4], bool swap = false) {
    const int lane = tidx() & 63, wid = tidx() >> 6, wr = wid >> 1, wc = wid & 1, fr = lane & 15, fq = lane >> 4;
    char* ldsA = lds; char* ldsB = lds + 16384;
    const char* t2 = swap ? ldsB : ldsA; const char* t1 = swap ? ldsA : ldsB; const int w2 = swap ? wc : wr, w1 = swap ? wr : wc;
#pragma unroll
    for (int m = 0; m < 4; ++m)
#pragma unroll
        for (int n = 0; n < 4; ++n) acc[m][n] = (f32x4){0.f, 0.f, 0.f, 0.f};
    typename AL::Regs ra; typename BL::Regs rb;
    al.load(0, ra); bl.load(0, rb);
    for (int kt = 0; kt < nk; ++kt) {
        __syncthreads();
        al.store(kt, ra, ldsA); bl.store(kt, rb, ldsB);
        __syncthreads();
        if (kt + 1 < nk) { al.load(kt + 1, ra); bl.load(kt + 1, rb); }
#pragma unroll
        for (int kk = 0; kk < 2; ++kk) {
            bf16x8 a[4], b[4];
#pragma unroll
            for (int m = 0; m < 4; ++m) a[m] = *(const bf16x8*)(t2 + lds_off(w2 * 64 + m * 16 + fr, kk * 32 + fq * 8));
#pragma unroll
            for (int n = 0; n < 4; ++n) b[n] = *(const bf16x8*)(t1 + lds_off(w1 * 64 + n * 16 + fr, kk * 32 + fq * 8));
#pragma unroll
            for (int m = 0; m < 4; ++m)
#pragma unroll
                for (int n = 0; n < 4; ++n) acc[m][n] = __builtin_amdgcn_mfma_f32_16x16x32_bf16(b[n], a[m], acc[m][n], 0, 0, 0);
        }
    }
}


__device__ __forceinline__ void dma_rc(int lane, int st, int& R, int& C) {
    const int sb = lane * 16, swz = sb ^ (((sb >> 9) & 1) << 5);
    R = (st >> 1) * 16 + (swz >> 6); C = (st & 1) * 32 + ((swz & 63) >> 1);
}
#define G3_STAGE 24576
#define G3_LDS (2 * G3_STAGE)
__device__ __forceinline__ int t32_off(int r, int c) { const int ob = (r & 15) * 64 + c * 2; return (r >> 4) * 1024 + (ob ^ (((ob >> 9) & 1) << 5)); }
__device__ __forceinline__ void dma_rc32(int lane, int st, int& R, int& C) { const int sb = lane * 16, swz = sb ^ (((sb >> 9) & 1) << 5); R = st * 16 + (swz >> 6); C = (swz & 63) >> 1; }
struct Dma3A {
    static constexpr int NV = 4;
    const char* base; unsigned voff[4];
    const char* lo = nullptr; int nk1 = 1 << 30;
    __device__ __forceinline__ void set_dense(const bf16_t* b0, int row0, int ld) {
        base = (const char*)b0; const int lane = tidx() & 63, w = tidx() >> 6;
#pragma unroll
        for (int i = 0; i < 4; ++i) { int R, C; dma_rc32(lane, w + 4 * i, R, C); voff[i] = (unsigned)(((size_t)(row0 + R) * ld + C) * 2); }
    }
    template <int SET = 0> __device__ __forceinline__ void issue(int kt, int ldsoff) const {
        const int w = tidx() >> 6;
#pragma unroll
        for (int i = 0; i < 4; ++i)
            __builtin_amdgcn_global_load_lds((const unsigned*)((((kt / nk1) == 2) ? lo : base) + voff[i] + (size_t)(kt % nk1) * 64), (LAS unsigned*)((LAS char*)dyn_lds + ldsoff + (w + 4 * i) * 1024), 16, 0, 0);
    }
    template <int SET = 0> __device__ __forceinline__ void commit(int, int) const {}
};
struct Dma3B {
    static constexpr int LAYOUT = 0, NV = 2;
    const char* hi; const char* lo; unsigned voff[2]; int nk1;
    __device__ __forceinline__ void set(const bf16_t* h, const bf16_t* l, int row0, int ld, int nk1_) {
        hi = (const char*)h; lo = (const char*)l; nk1 = nk1_; const int lane = tidx() & 63, w = tidx() >> 6;
#pragma unroll
        for (int i = 0; i < 2; ++i) { int R, C; dma_rc32(lane, w + 4 * i, R, C); const int Rs = (R & ~31) + 8 * ((R & 15) >> 2) + 4 * ((R >> 4) & 1) + (R & 3);
            voff[i] = (unsigned)(((size_t)(row0 + Rs) * ld + C) * 2); }
    }
    template <int SET = 0> __device__ __forceinline__ void issue(int kt, int ldsoff) const {
        const int w = tidx() >> 6; const char* base = ((kt / nk1) == 1) ? lo : hi; const size_t ko = (size_t)(kt % nk1) * 64;
#pragma unroll
        for (int i = 0; i < 2; ++i)
            __builtin_amdgcn_global_load_lds((const unsigned*)(base + voff[i] + ko), (LAS unsigned*)((LAS char*)dyn_lds + ldsoff + (w + 4 * i) * 1024), 16, 0, 0);
    }
    template <int SET = 0> __device__ __forceinline__ void commit(int, int) const {}
};
struct Reg3B {
    static constexpr int LAYOUT = 1, NV = 4;
    const float* bp; int ldb; f32x4 v[2][4]; int perm64 = 0;
    template <int SET = 0> __device__ __forceinline__ void issue(int kt, int) {
        const float* p = bp + (size_t)(kt * 32) * ldb;
#pragma unroll
        for (int j = 0; j < 4; ++j) v[SET][j] = *(const f32x4*)(p + (size_t)j * ldb);
    }
    template <int SET = 0> __device__ __forceinline__ void commit(int, int ldsoff) const {
        const int tid = tidx(), nq = tid & 31, kg = tid >> 5;
        u32x2 w[4];
#pragma unroll
        for (int i = 0; i < 4; ++i) { w[i].x = pack2(v[SET][0][i], v[SET][1][i]); w[i].y = pack2(v[SET][2][i], v[SET][3][i]); }
        const int q = nq & 7, q16 = nq & 15;
        const int rowbase = perm64 ? ((nq >> 4) * 64 + (q16 & 3) * 16 + (q16 >> 2) * 4) : ((nq >> 3) * 32 + (q & 1) * 16 + (q >> 1) * 4);
        const int rot = perm64 ? (q16 & 3) : ((q & 1) + 2 * ((q >> 2) & 1));
#pragma unroll
        for (int i = 0; i < 4; ++i) {
            const int e = (i + rot) & 3;
            u32x2 d;
            d.x = e == 0 ? w[0].x : (e == 1 ? w[1].x : (e == 2 ? w[2].x : w[3].x));
            d.y = e == 0 ? w[0].y : (e == 1 ? w[1].y : (e == 2 ? w[2].y : w[3].y));
            *(u32x2*)(dyn_lds + ldsoff + ((((kg >> 1) * 128 + rowbase + e) << 4) + (kg & 1) * 8)) = d;
        }
    }
};
#define G4_LDS (3 * G3_STAGE)
template <class AL, class BL, int PAR>
__device__ __forceinline__ void g4_step(AL& al, BL& bl, int kt, int nk, f32x4 (&acc)[32], bool idle) {
    constexpr int NV = AL::NV + BL::NV;
    const int lane = tidx() & 63, wid = tidx() >> 6, wr = wid >> 1, wc = wid & 1, fr = lane & 15, fq = lane >> 4;
    const int s0 = kt % 3, cur = s0 * G3_STAGE, nx1 = (s0 == 2 ? 0 : s0 + 1) * G3_STAGE, nx2 = (s0 == 0 ? 2 : s0 - 1) * G3_STAGE;
    if (kt + 1 < nk) asm volatile("s_waitcnt vmcnt(%0) lgkmcnt(0)" :: "n"(NV) : "memory");
    else asm volatile("s_waitcnt vmcnt(0) lgkmcnt(0)" ::: "memory");
    __builtin_amdgcn_s_barrier();
    asm volatile("" ::: "memory");
    if (kt + 2 < nk) { al.template issue<PAR>(kt + 2, nx2); bl.template issue<PAR>(kt + 2, nx2 + 16384); }
    if (!idle) {
    bf16x8 sm[4];
#pragma unroll
    for (int j = 0; j < 4; ++j) sm[j] = *(const bf16x8*)(dyn_lds + cur + 16384 + (BL::LAYOUT == 1 ? ((fq * 128 + wc * 64 + j * 16 + fr) << 4) : t32_off(wc * 64 + j * 16 + fr, fq * 8)));
    bf16x8 bigc = *(const bf16x8*)(dyn_lds + cur + t32_off(wr * 128 + fr, fq * 8));
#pragma unroll
    for (int i = 0; i < 8; ++i) {
        bf16x8 bign = bigc;
        if (i < 7) bign = *(const bf16x8*)(dyn_lds + cur + t32_off(wr * 128 + (i + 1) * 16 + fr, fq * 8));
        __builtin_amdgcn_sched_barrier(0);
#pragma unroll
        for (int j = 0; j < 4; ++j) acc[i * 4 + j] = __builtin_amdgcn_mfma_f32_16x16x32_bf16(sm[j], bigc, acc[i * 4 + j], 0, 0, 0);
        __builtin_amdgcn_sched_barrier(0);
        bigc = bign;
    }
    }
    if (kt + 1 < nk) bl.template commit<PAR ^ 1>(kt + 1, nx1 + 16384);
}
template <class AL, class BL>
__device__ __forceinline__ void gemm_core4(AL& al, BL& bl, int nk, f32x4 (&acc)[32], bool idle_hi = false) {
    const bool idle = idle_hi && (tidx() >> 7);
#pragma unroll
    for (int i = 0; i < 32; ++i) acc[i] = (f32x4){0.f, 0.f, 0.f, 0.f};
    al.template issue<0>(0, 0); bl.template issue<0>(0, 16384);
    if (nk > 1) { al.template issue<1>(1, G3_STAGE); bl.template issue<1>(1, G3_STAGE + 16384); }
    bl.template commit<0>(0, 16384);
    for (int kt = 0; kt < nk; kt += 2) {
        g4_step<AL, BL, 0>(al, bl, kt, nk, acc, idle);
        if (kt + 1 < nk) g4_step<AL, BL, 1>(al, bl, kt + 1, nk, acc, idle);
    }
    __syncthreads();
}
__device__ __forceinline__ bool dense_unit3(int bid, int nb, int j, int ntn, int& tm, int& tn) {
    if ((nb & 7) == 0) {
        const int x = bid & 7, r = bid >> 3, R = nb >> 3;
        const int li = r + R * j;
        if (li >= 8 * ntn) return false;
        tn = li >> 3; tm = x * 8 + (li & 7);
        return true;
    }
    const int u = bid + nb * j;
    if (u >= 64 * ntn) return false;
    tm = u / ntn; tn = u % ntn; return true;
}
__device__ __forceinline__ void prep_tile(char* lds, const float* W, int ldw, int k0, int scol0, bool colvalid, bf16_t* Bt, int K, int drow0, int mode) {
    const int tid = tidx();
    bf16_t* t = (bf16_t*)lds;
    __syncthreads();
#pragma unroll
    for (int i = 0; i < 4; ++i) {
        const int k = (tid >> 4) + 16 * i, q = tid & 15;
        f32x4 v = colvalid ? *(const f32x4*)(W + (size_t)(k0 + k) * ldw + scol0 + q * 4) : (f32x4){0.f, 0.f, 0.f, 0.f};
#pragma unroll
        for (int e = 0; e < 4; ++e) { float x = v[e]; if (mode == 2) x = x - bf2f(f2bf(x)); t[(q * 4 + e) * 72 + k] = (bf16_t)f2bf(x); }
    }
    __syncthreads();
#pragma unroll
    for (int i = 0; i < 2; ++i) { const int pc = tid + 256 * i, n = pc >> 3, ch = pc & 7;
        *(u32x4*)(Bt + (size_t)(drow0 + n) * K + k0 + ch * 8) = *(const u32x4*)(t + n * 72 + ch * 8); }
}
__device__ __forceinline__ int vcol_actual(int v);
__device__ __forceinline__ void phase_prep(char* lds, int bid, int nb, const P& p) {
    const int tid = tidx();
    for (size_t i = (size_t)bid * 256 + tid; i < (size_t)NTOK * DM / 8; i += (size_t)nb * 256) {
        const f32x4 a = *(const f32x4*)(p.x + i * 8), b = *(const f32x4*)(p.x + i * 8 + 4);
        u32x4 w; w.x = pack2(a[0], a[1]); w.y = pack2(a[2], a[3]); w.z = pack2(b[0], b[1]); w.w = pack2(b[2], b[3]);
        *(u32x4*)(p.XIb + i * 8) = w;
    }
    for (int u = bid; u < 2272; u += nb) {
        if (u < 768) { const int nt = u >> 4, kt = u & 15; const int d = nt * 64; const int sc = d < 2048 ? d : (d < 2560 ? d + 512 : d - 512);
            prep_tile(lds, p.even_w_in, EVEN_IN, kt * 64, sc, true, p.WIN0, DM, d, 0); }
        else if (u < 1024) { const int v = u - 768, nt = v >> 4, kt = v & 15; prep_tile(lds, p.even_w_out, DM, kt * 64, nt * 64, true, p.WOUT0, DM, nt * 64, 0); }
        else if (u < 1760) { const int v = u - 1024, nt = v >> 4, kt = v & 15; const int d = nt * 64;
            int sc; bool ok = true;
            if (d < 896) sc = d; else if (d < 1024) sc = d + 128; else if (d < 1536) sc = d + 280; else if (d < 2048) sc = d + 280;
            else if (d < 2112) sc = 1280; else if (d < 2176) { sc = 0; ok = false; } else if (d < 2304) sc = d - 1280; else if (d < 2432) sc = d - 1152; else sc = d - 104;
            prep_tile(lds, p.odd_w_in, ODD_IN, kt * 64, sc, ok, p.WIN1, DM, d, 0); }
        else if (u < 2016) { const int v = u - 1760, nt = v >> 4, kt = v & 15; prep_tile(lds, p.odd_w_out, DM, kt * 64, nt * 64, true, p.WOUT1, DM, nt * 64, 0); }
        else { const int v = u - 2016, layer = v >> 7, lo = (v >> 6) & 1, nt = (v >> 4) & 3, kt = v & 15;
            prep_tile(lds, p.w_router + (size_t)layer * DM * NEXP, NEXP, kt * 64, nt * 64, true, (lo ? p.WRL : p.WRH) + (size_t)layer * NEXP * DM, DM, nt * 64, lo ? 2 : 1); }
    }
    __syncthreads();
}


__device__ __forceinline__ void phase_gemm_f32out(int bid, int nb, const bf16_t* A, const bf16_t* Bt, int N, int K, float* C) {
    const int ntn = N / 128;
    const int tid = tidx(), lane = tid & 63, wid = tid >> 6, wr = wid >> 1, wc = wid & 1, fr = lane & 15, fq = lane >> 4;
    for (int j = 0;; ++j) {
        int tm, tn; if (!dense_unit3(bid, nb, j, ntn, tm, tn)) break;
        Dma3A al; al.set_dense(A, tm * 256, K); Dma3B bl; bl.set(Bt, Bt, tn * 128, K, 1 << 30);
        f32x4 acc[32];
        gemm_core4(al, bl, K / 32, acc);
#pragma unroll
        for (int i = 0; i < 8; ++i)
#pragma unroll
            for (int gg = 0; gg < 2; ++gg) { const f32x4 a = acc[i * 4 + 2 * gg], b2 = acc[i * 4 + 2 * gg + 1];
                u32x4 w; w.x = pack2(a[0], a[1]); w.y = pack2(a[2], a[3]); w.z = pack2(b2[0], b2[1]); w.w = pack2(b2[2], b2[3]);
                *(u32x4*)((bf16_t*)C + (size_t)(tm * 256 + wr * 128 + i * 16 + fr) * N + tn * 128 + wc * 64 + gg * 32 + fq * 8) = w; }
    }
}
__device__ __forceinline__ void phase_router(int bid, int nb, const P& p, int layer) {
    const int tid = tidx(), lane = tid & 63, wid = tid >> 6, wr = wid >> 1, wc = wid & 1, fr = lane & 15, fq = lane >> 4;
    for (int j = 0;; ++j) {
        int tm, t6; if (!dense_unit3(bid, nb, j, 6, tm, t6)) break;
        const int tn = t6 & 1, part = t6 >> 1;
        Dma3A al; al.set_dense(part == 2 ? p.XAl : p.XAb, tm * 256, DM);
        const bf16_t* wsrc = (part == 1 ? p.WRL : p.WRH) + (size_t)layer * NEXP * DM;
        Dma3B bl; bl.set(wsrc, wsrc, tn * 128, DM, 1 << 30);
        f32x4 acc[32];
        gemm_core4(al, bl, 32, acc);
        float* dst = p.LOG + (size_t)part * NTOK * NEXP;
#pragma unroll
        for (int i = 0; i < 8; ++i)
#pragma unroll
            for (int gg = 0; gg < 2; ++gg) { float* q = dst + (size_t)(tm * 256 + wr * 128 + i * 16 + fr) * NEXP + tn * 128 + wc * 64 + gg * 32 + fq * 8;
                *(f32x4*)q = acc[i * 4 + 2 * gg]; *(f32x4*)(q + 4) = acc[i * 4 + 2 * gg + 1]; }
    }
}
__device__ __forceinline__ void ln_row_store(float (&v)[16], const float* g, const float* b, float* of, bf16_t* ob, int row, int lane, bf16_t* ol = nullptr) {
    float s = 0.f;
#pragma unroll
    for (int i = 0; i < 16; ++i) s += v[i];
    const float mu = wave_sum(s) * (1.0f / DM);
    float q = 0.f;
#pragma unroll
    for (int i = 0; i < 16; ++i) { const float d = v[i] - mu; q += d * d; }
    const float rstd = rsqrtf(wave_sum(q) * (1.0f / DM) + LN_EPS);
#pragma unroll
    for (int h = 0; h < 2; ++h) {
        const int c0 = h * 512 + lane * 8;
        float o[8];
#pragma unroll
        for (int i = 0; i < 8; ++i) o[i] = (v[h * 8 + i] - mu) * rstd * g[c0 + i] + b[c0 + i];
        if (of) { *(f32x4*)(of + (size_t)row * DM + c0) = (f32x4){o[0], o[1], o[2], o[3]};
                  *(f32x4*)(of + (size_t)row * DM + c0 + 4) = (f32x4){o[4], o[5], o[6], o[7]}; }
        if (ob) { u32x4 w; w.x = pack2(o[0], o[1]); w.y = pack2(o[2], o[3]); w.z = pack2(o[4], o[5]); w.w = pack2(o[6], o[7]); *(u32x4*)(ob + (size_t)row * DM + c0) = w;
            if (ol) { float l[8];
#pragma unroll
                for (int i = 0; i < 8; ++i) l[i] = o[i] - bf2f(f2bf(o[i]));
                u32x4 wl; wl.x = pack2(l[0], l[1]); wl.y = pack2(l[2], l[3]); wl.z = pack2(l[4], l[5]); wl.w = pack2(l[6], l[7]); *(u32x4*)(ol + (size_t)row * DM + c0) = wl; } }
    }
}
__device__ __forceinline__ void phase_ln_add(int bid, int nb, const float* res, const bf16_t* resh, const bf16_t* resl, const float* add, const float* g, const float* b, float* of, bf16_t* ob, bf16_t* ol) {
    const int lane = tidx() & 63, wid = tidx() >> 6;
    for (int row = bid * 4 + wid; row < NTOK; row += nb * 4) {
        float v[16];
#pragma unroll
        for (int h = 0; h < 2; ++h) {
            const size_t o = (size_t)row * DM + h * 512 + lane * 8;
            f32x4 r0, r1;
            if (res) { r0 = *(const f32x4*)(res + o); r1 = *(const f32x4*)(res + o + 4); }
            else { const u32x4 xh = *(const u32x4*)(resh + o), xl = *(const u32x4*)(resl + o);
                r0[0] = bf2f(xh.x & 0xffffu) + bf2f(xl.x & 0xffffu); r0[1] = bf2f(xh.x >> 16) + bf2f(xl.x >> 16); r0[2] = bf2f(xh.y & 0xffffu) + bf2f(xl.y & 0xffffu); r0[3] = bf2f(xh.y >> 16) + bf2f(xl.y >> 16);
                r1[0] = bf2f(xh.z & 0xffffu) + bf2f(xl.z & 0xffffu); r1[1] = bf2f(xh.z >> 16) + bf2f(xl.z >> 16); r1[2] = bf2f(xh.w & 0xffffu) + bf2f(xl.w & 0xffffu); r1[3] = bf2f(xh.w >> 16) + bf2f(xl.w >> 16); }
            const u32x4 ab = *(const u32x4*)((const bf16_t*)add + o);
            const float a0[4] = {bf2f(ab.x & 0xffffu), bf2f(ab.x >> 16), bf2f(ab.y & 0xffffu), bf2f(ab.y >> 16)};
            const float a1[4] = {bf2f(ab.z & 0xffffu), bf2f(ab.z >> 16), bf2f(ab.w & 0xffffu), bf2f(ab.w >> 16)};
#pragma unroll
            for (int i = 0; i < 4; ++i) { v[h * 8 + i] = DN_ALPHA * r0[i] + a0[i]; v[h * 8 + 4 + i] = DN_ALPHA * r1[i] + a1[i]; }
        }
        ln_row_store(v, g, b, of, ob, row, lane, ol);
    }
}

__device__ __forceinline__ void phase_route(int bid, int nb, const P& p, int layer) {
    const float* br = p.b_router + layer * NEXP;
    const int tid = tidx(), lane = tid & 63, wid = tid >> 6;
    const int gt = bid * 256 + tid, gs = nb * 256;
    for (int i = gt; i < NROWS; i += gs) p.rowtok[i] = (i >= SH_TILE0 * 128) ? (i - SH_TILE0 * 128) : 0;
    const f32x4 bv = *(const f32x4*)(br + lane * 4);
    for (int tb = bid * 4 + wid; tb < NTOK; tb += nb * 4 * 8) {
        int es[8]; float ws[8];
#pragma unroll
        for (int q = 0; q < 8; ++q) {
            const int t = tb + q * nb * 4;
            es[q] = 0; ws[q] = 0.f;
            if (t < NTOK) {
        const f32x4 lg = (*(const f32x4*)(p.LOG + (size_t)t * NEXP + lane * 4) + *(const f32x4*)(p.LOG + (size_t)NTOK * NEXP + (size_t)t * NEXP + lane * 4)) + *(const f32x4*)(p.LOG + (size_t)2 * NTOK * NEXP + (size_t)t * NEXP + lane * 4);
        float sc[4], bs[4];
#pragma unroll
        for (int i = 0; i < 4; ++i) { sc[i] = sigmoidf_(lg[i]); bs[i] = sc[i] + bv[i]; }
        float t1 = fmaxf(bs[0], bs[1]), t2 = fminf(bs[0], bs[1]);
        { const float a = fmaxf(bs[2], bs[3]), c = fminf(bs[2], bs[3]); const float n1 = fmaxf(t1, a); t2 = fmaxf(fminf(t1, a), fmaxf(t2, c)); t1 = n1; }
#pragma unroll
        for (int o = 1; o <= 4; o <<= 1) { const float o1 = __shfl_xor(t1, o), o2 = __shfl_xor(t2, o); const float n1 = fmaxf(t1, o1); t2 = fmaxf(fminf(t1, o1), fmaxf(t2, o2)); t1 = n1; }
        const float gsc = t1 + t2;
        const int g = lane >> 3;
        int rank = 0;
#pragma unroll
        for (int g2 = 0; g2 < 8; ++g2) { const float o = __shfl(gsc, g2 * 8); rank += (o > gsc || (o == gsc && g2 < g)) ? 1 : 0; }
        const bool allowed = rank < 4;
        float cv[4];
#pragma unroll
        for (int i = 0; i < 4; ++i) cv[i] = allowed ? bs[i] : -3e38f;
        float wsel = 0.f; int esel = 0; float wsum = 0.f;
#pragma unroll
        for (int k = 0; k < 8; ++k) {
            float bvv = cv[0]; int bi = 0;
#pragma unroll
            for (int i = 1; i < 4; ++i) if (cv[i] > bvv) { bvv = cv[i]; bi = i; }
            int be = lane * 4 + bi;
#pragma unroll
            for (int o = 1; o <= 32; o <<= 1) { const float ov = __shfl_xor(bvv, o); const int oe = __shfl_xor(be, o); if (ov > bvv || (ov == bvv && oe < be)) { bvv = ov; be = oe; } }
            const int ol = be >> 2, oi = be & 3;
            float sown = 0.f;
#pragma unroll
            for (int i = 0; i < 4; ++i) if (oi == i) sown = sc[i];
            const float sv = __shfl(sown, ol);
            if (lane == ol) {
#pragma unroll
                for (int i = 0; i < 4; ++i) if (oi == i) cv[i] = -3e38f;
            }
            wsum += sv;
            if (lane == k) { wsel = sv; esel = be; }
        }
        es[q] = esel; ws[q] = wsel / wsum * 2.5f;
            }
        }
        int rk[8];
#pragma unroll
        for (int q = 0; q < 8; ++q) { rk[q] = 0; if (lane < 8 && tb + q * nb * 4 < NTOK) rk[q] = atomicAdd(&p.cnt[(bid & 31) * NEXP + es[q]], 1); }
#pragma unroll
        for (int q = 0; q < 8; ++q) { const int t = tb + q * nb * 4; if (lane < 8 && t < NTOK) { p.eidx[t * 8 + lane] = es[q]; p.ew[t * 8 + lane] = ws[q]; p.erank[t * 8 + lane] = rk[q]; } }
    }
}
__device__ __forceinline__ void phase_scatter(char* lds, int bid, int nb, const P& p) {
    int* base = (int*)lds;
    int* pc = base + 260;
    int* so = base + 520;
    const int tid = tidx();
    __syncthreads();
    { int c = 0;
#pragma unroll
      for (int sb = 0; sb < 32; ++sb) { so[sb * 256 + tid] = c; c += p.cnt[sb * NEXP + tid]; }
      pc[tid] = (c + 127) & ~127; }
    __syncthreads();
    { int s = 0; for (int e = 0; e < tid; ++e) s += pc[e]; base[tid] = s; if (tid == 255) base[256] = s + pc[255]; }
    __syncthreads();
    const int tpb = nb * 4;
    for (int a = bid * 256 + tid; a < NTOK * 8; a += nb * 256) {
        const int e = p.eidx[a]; const int t = a >> 3; const int sb = ((t % tpb) >> 2) & 31;
        const int row = base[e] + so[sb * 256 + e] + p.erank[a];
        p.rowtok[row] = t; p.epos[a] = row;
    }
    if (bid == 0) {
        {
            const int xq = tid & 7; int off = 0, tot = 0;
            for (int e = xq; e < 256; e += 8) { const int n = ((pc[e] >> 7) + 1) >> 1; if (e < tid) off += n; tot += n; }
            const int t0 = base[tid] >> 7, nte = pc[tid] >> 7;
            for (int i = 0; i < nte; i += 2) p.plist[xq * 320 + off + (i >> 1)] = (t0 + i) | ((i + 1 < nte) ? 0 : 0x40000000);
            if (tid < 64) { int totp = 0; for (int e = (tid & 7); e < 256; e += 8) totp += ((pc[e] >> 7) + 1) >> 1; p.plist[(tid & 7) * 320 + totp + (tid >> 3)] = SH_TILE0 + 2 * tid; }
            if (tid < 8) p.plen[tid] = tot + 8;
        }
        const int nrt = base[256] >> 7;
        for (int i = tid; i < NTILES; i += 256) if (i >= nrt) p.tile_e[i] = (i >= SH_TILE0) ? NEXP : -1;
        const int t0 = base[tid] >> 7, t1 = base[tid + 1] >> 7;
        for (int i = t0; i < t1; ++i) p.tile_e[i] = tid;
    }
    __syncthreads();
}
__device__ __forceinline__ void phase_moe1(char* lds, int bid, int nb, const P& p, int layer, const bf16_t* Xb) {
    const int tid = tidx(), lane = tid & 63, wid = tid >> 6, wr = wid >> 1, wc = wid & 1, fr = lane & 15, fq = lane >> 4;
    const int xq = bid & 7, tot = p.plen[xq] * 4, stp = nb >> 3;
    int Rr[4], Cc[4];
#pragma unroll
    for (int i = 0; i < 4; ++i) dma_rc32(lane, wid + 4 * i, Rr[i], Cc[i]);
    int ui = bid >> 3;
    int ent0 = 0, e0 = 0, tok0[4] = {0, 0, 0, 0}, ent1 = 0;
    if (ui < tot) { ent0 = p.plist[xq * 320 + (ui >> 2)]; const int t0 = ent0 & 0xffff, t1 = ((ent0 >> 30) & 1) ? t0 : t0 + 1; e0 = p.tile_e[t0];
#pragma unroll
        for (int i = 0; i < 4; ++i) tok0[i] = p.rowtok[(Rr[i] < 128 ? t0 : t1) * 128 + (Rr[i] & 127)]; }
    if (ui + stp < tot) ent1 = p.plist[xq * 320 + ((ui + stp) >> 2)];
    for (; ui < tot; ui += stp) {
        const int nt = ui & 3;
        const int ent = ent0, e = e0;
        const int tile0 = ent & 0xffff, single = (ent >> 30) & 1, tile1 = single ? tile0 : tile0 + 1;
        Dma3A al; al.base = (const char*)Xb;
#pragma unroll
        for (int i = 0; i < 4; ++i) al.voff[i] = (unsigned)(((size_t)tok0[i] * DM + Cc[i]) * 2);
        if (ui + stp < tot) { ent0 = ent1; const int t0 = ent0 & 0xffff, t1 = ((ent0 >> 30) & 1) ? t0 : t0 + 1; e0 = p.tile_e[t0];
#pragma unroll
            for (int i = 0; i < 4; ++i) tok0[i] = p.rowtok[(Rr[i] < 128 ? t0 : t1) * 128 + (Rr[i] & 127)]; }
        if (ui + 2 * stp < tot) ent1 = p.plist[xq * 320 + ((ui + 2 * stp) >> 2)];
        const float* Wg = (e < NEXP) ? p.w_gate + ((size_t)layer * NEXP + e) * (DM * 256) : p.ws_gate + (size_t)layer * (DM * 256);
        const float* Wu = (e < NEXP) ? p.w_up + ((size_t)layer * NEXP + e) * (DM * 256) : p.ws_up + (size_t)layer * (DM * 256);
        Reg3B bl; { const int nq = tid & 31, kg = tid >> 5; const int j = nq * 4, jw = j & 63, w2 = j >> 6; const int col = nt * 64 + w2 * 32 + (jw & 31);
            bl.ldb = 256; bl.bp = ((jw >= 32) ? Wu : Wg) + (size_t)(kg * 4) * 256 + col; }
        f32x4 acc[32];
        gemm_core4(al, bl, DM / 32, acc, single != 0);
        if (!(wr && single)) {
            const int tile = wr ? tile1 : tile0;
#pragma unroll
            for (int i = 0; i < 8; ++i)
                {
                    const int row = tile * 128 + i * 16 + fr, col = nt * 64 + wc * 32 + fq * 8;
                    const f32x4 g0 = acc[i * 4 + 0], g1 = acc[i * 4 + 1], u0 = acc[i * 4 + 2], u1 = acc[i * 4 + 3];
                    u32x4 w;
                    w.x = pack2(siluf_(g0[0]) * u0[0], siluf_(g0[1]) * u0[1]); w.y = pack2(siluf_(g0[2]) * u0[2], siluf_(g0[3]) * u0[3]);
                    w.z = pack2(siluf_(g1[0]) * u1[0], siluf_(g1[1]) * u1[1]); w.w = pack2(siluf_(g1[2]) * u1[2], siluf_(g1[3]) * u1[3]);
                    *(u32x4*)(p.H + (size_t)row * 256 + col) = w;
                }
        }
    }
}
__device__ __forceinline__ void phase_moe2(char* lds, int bid, int nb, const P& p, int layer) {
    const int tid = tidx(), lane = tid & 63, wid = tid >> 6, wr = wid >> 1, wc = wid & 1, fr = lane & 15, fq = lane >> 4;
    const int xq = bid & 7, tot = p.plen[xq] * 8, stp = nb >> 3;
    int Rr[4], Cc[4];
#pragma unroll
    for (int i = 0; i < 4; ++i) dma_rc32(lane, wid + 4 * i, Rr[i], Cc[i]);
    int ui = bid >> 3;
    int ent0 = 0, e0 = 0, ent1 = 0;
    if (ui < tot) { ent0 = p.plist[xq * 320 + (ui >> 3)]; e0 = p.tile_e[ent0 & 0xffff]; }
    if (ui + stp < tot) ent1 = p.plist[xq * 320 + ((ui + stp) >> 3)];
    for (; ui < tot; ui += stp) {
        const int nt = ui & 7;
        const int ent = ent0, e = e0;
        const int tile0 = ent & 0xffff, single = (ent >> 30) & 1, tile1 = single ? tile0 : tile0 + 1;
        if (ui + stp < tot) { ent0 = ent1; e0 = p.tile_e[ent0 & 0xffff]; }
        if (ui + 2 * stp < tot) ent1 = p.plist[xq * 320 + ((ui + 2 * stp) >> 3)];
        const float* Wd = (e < NEXP) ? p.w_down + ((size_t)layer * NEXP + e) * (256 * DM) : p.ws_down + (size_t)layer * (256 * DM);
        Dma3A al; al.base = (const char*)p.H;
#pragma unroll
        for (int i = 0; i < 4; ++i) al.voff[i] = (unsigned)(((size_t)((Rr[i] < 128 ? tile0 : tile1) * 128 + (Rr[i] & 127)) * 256 + Cc[i]) * 2);
        Reg3B bl; { const int nq = tid & 31, kg = tid >> 5; bl.ldb = DM; bl.perm64 = 1; bl.bp = Wd + (size_t)(kg * 4) * DM + nt * 128 + nq * 4; }
        f32x4 acc[32];
        gemm_core4(al, bl, 256 / 32, acc, single != 0);
        if (!(wr && single)) {
            const int tile = wr ? tile1 : tile0;
#pragma unroll
            for (int i = 0; i < 8; ++i)
                {
                    const int row = tile * 128 + i * 16 + fr, col = nt * 128 + wc * 64 + fq * 16;
                    u32x4 wv;
#pragma unroll
                    for (int j = 0; j < 4; ++j) {
                        f32x4 a = acc[i * 4 + j] * 64.0f;
#pragma unroll
                        for (int c = 0; c < 4; ++c) a[c] = fminf(fmaxf(a[c], -448.0f), 448.0f);
                        int w0 = 0;
                        w0 = __builtin_amdgcn_cvt_pk_fp8_f32(a[0], a[1], w0, false); w0 = __builtin_amdgcn_cvt_pk_fp8_f32(a[2], a[3], w0, true);
                        wv[j] = (unsigned)w0;
                    }
                    *(u32x4*)((char*)p.Y + (size_t)row * DM + col) = wv;
                }
        }
    }
}
__device__ __forceinline__ void phase_combine_ln(int bid, int nb, const P& p, const float* X, const float* g, const float* b, float* of, bf16_t* ob, bf16_t* ol) {
    const int lane = tidx() & 63, wid = tidx() >> 6;
    int row = bid * 4 + wid;
    int npos = 0; float nw = 0.f;
    if (row < NTOK && lane < 8) { npos = p.epos[row * 8 + lane]; nw = p.ew[row * 8 + lane]; }
    for (; row < NTOK; row += nb * 4) {
        const int cpos = npos; const float cw = nw;
        { const int nr = row + nb * 4; if (nr < NTOK && lane < 8) { npos = p.epos[nr * 8 + lane]; nw = p.ew[nr * 8 + lane]; } }
        float v[16];
#pragma unroll
        for (int h = 0; h < 2; ++h) {
            const size_t o = (size_t)row * DM + h * 512 + lane * 8;
            const u32x4 xh = *(const u32x4*)(p.XAb + o), xl = *(const u32x4*)(p.XAl + o);
            v[h * 8 + 0] = DN_ALPHA * (bf2f(xh.x & 0xffffu) + bf2f(xl.x & 0xffffu)); v[h * 8 + 1] = DN_ALPHA * (bf2f(xh.x >> 16) + bf2f(xl.x >> 16));
            v[h * 8 + 2] = DN_ALPHA * (bf2f(xh.y & 0xffffu) + bf2f(xl.y & 0xffffu)); v[h * 8 + 3] = DN_ALPHA * (bf2f(xh.y >> 16) + bf2f(xl.y >> 16));
            v[h * 8 + 4] = DN_ALPHA * (bf2f(xh.z & 0xffffu) + bf2f(xl.z & 0xffffu)); v[h * 8 + 5] = DN_ALPHA * (bf2f(xh.z >> 16) + bf2f(xl.z >> 16));
            v[h * 8 + 6] = DN_ALPHA * (bf2f(xh.w & 0xffffu) + bf2f(xl.w & 0xffffu)); v[h * 8 + 7] = DN_ALPHA * (bf2f(xh.w >> 16) + bf2f(xl.w >> 16));
        }
#pragma unroll
        for (int k = 0; k < 9; ++k) {
            const int yr = (k < 8) ? __shfl(cpos, k) : (SH_TILE0 * 128 + row);
            const float w = (k < 8) ? __shfl(cw, k) : 1.0f;
#pragma unroll
            for (int h = 0; h < 2; ++h) {
                const u32x2 y = *(const u32x2*)((const char*)p.Y + (size_t)yr * DM + h * 512 + lane * 8);
                typedef float f32x2v __attribute__((ext_vector_type(2)));
                const f32x2v y0 = __builtin_amdgcn_cvt_pk_f32_fp8((int)y.x, false), y1 = __builtin_amdgcn_cvt_pk_f32_fp8((int)y.x, true);
                const f32x2v y2 = __builtin_amdgcn_cvt_pk_f32_fp8((int)y.y, false), y3 = __builtin_amdgcn_cvt_pk_f32_fp8((int)y.y, true);
                const float ws = w * (1.0f / 64.0f);
                v[h * 8 + 0] += ws * y0.x; v[h * 8 + 1] += ws * y0.y; v[h * 8 + 2] += ws * y1.x; v[h * 8 + 3] += ws * y1.y;
                v[h * 8 + 4] += ws * y2.x; v[h * 8 + 5] += ws * y2.y; v[h * 8 + 6] += ws * y3.x; v[h * 8 + 7] += ws * y3.y;
            }
        }
        ln_row_store(v, g, b, of, ob, row, lane, ol);
    }
}

__device__ __forceinline__ void phase_moba_kmean(int bid, int nb, const P& p) {
    const int tid = tidx();
    for (int u = (nb >= 256 ? bid - 128 : bid); u < NBATCH * 8; u += nb) {
        if (u < 0) continue;
        const int b = u >> 3, j = u & 7;
        const bf16_t* src = p.MK + (size_t)(b * SEQ + j * 256) * 512 + tid * 2;
        float s0 = 0.f, s1 = 0.f;
        for (int r8 = 0; r8 < 256; r8 += 8) {
            unsigned v[8];
#pragma unroll
            for (int i = 0; i < 8; ++i) v[i] = *(const unsigned*)(src + (size_t)(r8 + i) * 512);
#pragma unroll
            for (int i = 0; i < 8; ++i) { s0 += bf2f(v[i] & 0xffffu); s1 += bf2f(v[i] >> 16); }
        }
        const int h = tid >> 5, d = (tid & 31) * 2;
        p.KM[((size_t)(b * 8 + h) * 8 + j) * 64 + d] = s0 * (1.0f / 256.0f);
        p.KM[((size_t)(b * 8 + h) * 8 + j) * 64 + d + 1] = s1 * (1.0f / 256.0f);
    }
}
__device__ __forceinline__ void gemm_t_unit(const bf16_t* Wt, int wrow0, const bf16_t* X, int tok0, bf16_t* dst, int ncol, int col0) {
    const int tid = tidx(), lane = tid & 63, wid = tid >> 6, wr = wid >> 1, wc = wid & 1, fr = lane & 15, fq = lane >> 4;
    Dma3A al; al.set_dense(Wt, wrow0, DM); Dma3B bl; bl.set(X, X, tok0, DM, 1 << 30);
    f32x4 acc[32];
    gemm_core4(al, bl, DM / 32, acc);
#pragma unroll
    for (int i = 0; i < 8; ++i)
#pragma unroll
        for (int gg = 0; gg < 2; ++gg) {
            const int vc = col0 + wr * 128 + i * 16 + fr, r0 = tok0 + wc * 64 + gg * 32 + fq * 8;
            const int b = r0 >> 11, t0 = r0 & (SEQ - 1);
            const f32x4 a = acc[i * 4 + 2 * gg], b2 = acc[i * 4 + 2 * gg + 1];
            u32x4 w; w.x = pack2(a[0], a[1]); w.y = pack2(a[2], a[3]); w.z = pack2(b2[0], b2[1]); w.w = pack2(b2[2], b2[3]);
            *(u32x4*)(dst + ((size_t)(b * ncol + vc)) * SEQ + t0) = w;
        }
}
__device__ __forceinline__ void phase_inproj0(char* lds, int bid, int nb, const P& p) {
    const int ntn = 20, nk = DM / 32;
    const int tid = tidx(), lane = tid & 63, wid = tid >> 6, wr = wid >> 1, wc = wid & 1, fr = lane & 15, fq = lane >> 4;
    for (int i = bid * 256 + tid; i < 2 * 8 * 64 * 64; i += nb * 256) {
        const int which = i >> 15, e = i & 32767, h = e >> 12, j = (e >> 6) & 63, ii = e & 63;
        const float v = (which ? p.wx : p.wa)[(h * 64 + ii) * 64 + j];
        (which ? p.WXT : p.WAT)[e] = (bf16_t)f2bf(v);
    }
    for (int jj = 0;; ++jj) {
        int tm, tn; if (!dense_unit3(bid, nb, jj, ntn, tm, tn)) break;
        Dma3A al; al.set_dense(p.XIb, tm * 256, DM); Dma3B bl; bl.set(p.WIN0, p.WIN0, tn * 128, DM, 1 << 30);
        f32x4 acc[32];
        gemm_core4(al, bl, nk, acc);
#pragma unroll
        for (int i = 0; i < 8; ++i)
#pragma unroll
            for (int gg = 0; gg < 2; ++gg) {
                const int row = tm * 256 + wr * 128 + i * 16 + fr, col = tn * 128 + wc * 64 + gg * 32 + fq * 8;
                const f32x4 a = acc[i * 4 + 2 * gg], b2 = acc[i * 4 + 2 * gg + 1];
                u32x4 w; w.x = pack2(a[0], a[1]); w.y = pack2(a[2], a[3]); w.z = pack2(b2[0], b2[1]); w.w = pack2(b2[2], b2[3]);
                *(u32x4*)(p.UB0 + (size_t)row * 2560 + col) = w;
            }
    }
    for (int u = (nb >= 512 ? bid - 256 : bid); u < 2 * 128; u += nb) { if (u < 0) continue; const int pn = u & 1, tt = u >> 1; gemm_t_unit(p.WIN0, 2560 + pn * 256, p.XIb, tt * 128, p.VHt, 512, pn * 256); }
}

__device__ __forceinline__ int lds_off128(int r, int c) {
    const int st = (r >> 4) * 4 + (c >> 5), ob = (r & 15) * 64 + (c & 31) * 2;
    return st * 1024 + (ob ^ (((ob >> 9) & 1) << 5));
}
__device__ __forceinline__ float softplusf_(float x) { return fmaxf(x, 0.f) + log1pf(__expf(-fabsf(x))); }

#define LRU1_LDS (4 * 8192)
__device__ __forceinline__ void lru1_unit(char* lds, const P& p, int b, int ck, int half) {
    const int tid = tidx(), lane = tid & 63, w = tid >> 6, fr = lane & 15, fg = lane >> 4;
    char* xt = lds + w * 8192;
    const size_t n0 = (size_t)b * SEQ + ck * 64;
    __syncthreads();
    {
        const int h = half * 4 + w, c = h * 64 + lane;
        const float cw0 = p.conv_w[c], cw1 = p.conv_w[512 + c], cw2 = p.conv_w[1024 + c], cw3 = p.conv_w[1536 + c], cb = p.conv_b[c];
        float xm3 = 0.f, xm2 = 0.f, xm1 = 0.f;
        if (ck > 0) { xm3 = bf2f(p.UB0[(n0 - 3) * 2560 + c]); xm2 = bf2f(p.UB0[(n0 - 2) * 2560 + c]); xm1 = bf2f(p.UB0[(n0 - 1) * 2560 + c]); }
        __builtin_amdgcn_wave_barrier();
        for (int t16 = 0; t16 < 64; t16 += 16) {
            bf16_t raw[16];
#pragma unroll
            for (int i = 0; i < 16; ++i) raw[i] = p.UB0[(n0 + t16 + i) * 2560 + c];
#pragma unroll
            for (int i = 0; i < 16; ++i) {
                const float x = bf2f(raw[i]);
                const float xc = cb + cw0 * xm3 + cw1 * xm2 + cw2 * xm1 + cw3 * x;
                xm3 = xm2; xm2 = xm1; xm1 = x;
                *(bf16_t*)(xt + lds_off(t16 + i, lane & ~7) + (lane & 7) * 2) = (bf16_t)f2bf(xc);
            }
        }
        __builtin_amdgcn_wave_barrier();
        for (int jt = 0; jt < 4; ++jt) {
            const int cj = h * 64 + jt * 16 + fr;
            bf16x8 wra[2], wri[2];
#pragma unroll
            for (int ks = 0; ks < 2; ++ks) {
                wra[ks] = *(const bf16x8*)(p.WAT + (size_t)(h * 64 + jt * 16 + fr) * 64 + ks * 32 + fg * 8);
                wri[ks] = *(const bf16x8*)(p.WXT + (size_t)(h * 64 + jt * 16 + fr) * 64 + ks * 32 + fg * 8);
            }
            const float bav = p.ba[cj], bxv = p.bx[cj], sp = softplusf_(-p.lam[cj]);
            float mA = 1.f, mB = 0.f;
#pragma unroll
            for (int tt = 0; tt < 4; ++tt) {
                const bf16x8 a0 = *(const bf16x8*)(xt + lds_off(tt * 16 + fr, fg * 8)), a1 = *(const bf16x8*)(xt + lds_off(tt * 16 + fr, 32 + fg * 8));
                f32x4 ar = __builtin_amdgcn_mfma_f32_16x16x32_bf16(a0, wra[0], (f32x4){0.f, 0.f, 0.f, 0.f}, 0, 0, 0);
                ar = __builtin_amdgcn_mfma_f32_16x16x32_bf16(a1, wra[1], ar, 0, 0, 0);
                f32x4 ai = __builtin_amdgcn_mfma_f32_16x16x32_bf16(a0, wri[0], (f32x4){0.f, 0.f, 0.f, 0.f}, 0, 0, 0);
                ai = __builtin_amdgcn_mfma_f32_16x16x32_bf16(a1, wri[1], ai, 0, 0, 0);
                float sA = 1.f, sB = 0.f;
#pragma unroll
                for (int r = 0; r < 4; ++r) {
                    const int t = tt * 16 + fg * 4 + r;
                    const float rg = sigmoidf_(ar[r] + bav), ig = sigmoidf_(ai[r] + bxv);
                    const float log_a = -8.0f * rg * sp;
                    const float a = __expf(log_a);
                    const float mult = (ck == 0 && t == 0) ? 1.0f : sqrtf(fmaxf(1.0f - a * a, 0.f));
                    const int jj = jt * 16 + fr;
                    const float xcv = bf2f(*(const bf16_t*)(xt + lds_off(t, jj & ~7) + (jj & 7) * 2));
                    const float bt = mult * ig * xcv;
                    p.LA[(n0 + t) * 512 + cj] = a; p.LB[(n0 + t) * 512 + cj] = bt;
                    sB = a * sB + bt; sA = a * sA;
                }
                float tA = 1.f, tB = 0.f;
#pragma unroll
                for (int g2 = 0; g2 < 4; ++g2) {
                    const float oA = __shfl(sA, g2 * 16 + fr), oB = __shfl(sB, g2 * 16 + fr);
                    tB = oA * tB + oB; tA = oA * tA;
                }
                mB = tA * mB + tB; mA = tA * mA;
            }
            if (fg == 0) { p.CSA[((size_t)b * 32 + ck) * 512 + cj] = mA; p.CSB[((size_t)b * 32 + ck) * 512 + cj] = mB; }
        }
        __builtin_amdgcn_wave_barrier();
    }
}
__device__ __forceinline__ void lru2_unit(const P& p, int b, int ck, int half) {
    const int tid = tidx();
    const size_t n0 = (size_t)b * SEQ + ck * 64;
    {
        const int c = tid + 256 * half;
        float h = 0.f;
        for (int c8 = 0; c8 < ck; c8 += 8) {
            float ca[8], cb[8];
#pragma unroll
            for (int i = 0; i < 8; ++i) { const bool ok = c8 + i < ck; ca[i] = ok ? p.CSA[((size_t)b * 32 + c8 + i) * 512 + c] : 1.f; cb[i] = ok ? p.CSB[((size_t)b * 32 + c8 + i) * 512 + c] : 0.f; }
#pragma unroll
            for (int i = 0; i < 8; ++i) h = ca[i] * h + cb[i];
        }
        for (int t8 = 0; t8 < 64; t8 += 8) {
            float la[8], lb[8], gb[8];
#pragma unroll
            for (int i = 0; i < 8; ++i) { la[i] = p.LA[(n0 + t8 + i) * 512 + c]; lb[i] = p.LB[(n0 + t8 + i) * 512 + c]; gb[i] = bf2f(p.UB0[(n0 + t8 + i) * 2560 + 512 + c]); }
#pragma unroll
            for (int i = 0; i < 8; ++i) { h = la[i] * h + lb[i]; p.MIX[(n0 + t8 + i) * DM + c] = (bf16_t)f2bf(h * gelu_tanh(gb[i])); }
        }
    }
}

#define HG1_LDS (2 * 16384)
__device__ __forceinline__ float hg_lb(const P& p, int ch) {
    const float l0 = p.hg_lb[ch], l1 = p.hg_lb[512 + ch], l2 = p.hg_lb[1024 + ch]; const float mx = fmaxf(l0, fmaxf(l1, l2));
    const float e0 = __expf(l0 - mx), e1 = __expf(l1 - mx), e2 = __expf(l2 - mx); return e0 / (e0 + e1 + e2);
}
__device__ __forceinline__ void hg1_unit(char* lds, const P& p, int b, int h, int ck) {
    const int tid = tidx(), lane = tid & 63, w = tid >> 6, fr = lane & 15, fg = lane >> 4;
    char* kh = lds;
    char* vt = lds + 16384;
    const size_t n0 = (size_t)b * SEQ + ck * 64;
    const int bhc = (b * 4 + h) * 32 + ck;
    __syncthreads();
    if (tid < 128) {
        const int k = tid, ch = h * 128 + k;
        const float lbv = hg_lb(p, ch);
        float f[64];
#pragma unroll
        for (int t16 = 0; t16 < 64; t16 += 16) {
            bf16_t raw[16];
#pragma unroll
            for (int i = 0; i < 16; ++i) raw[i] = p.UB0[(n0 + t16 + i) * 2560 + 1536 + ch];
#pragma unroll
            for (int i = 0; i < 16; ++i) f[t16 + i] = lbv + (1.0f - lbv) * sigmoidf_(bf2f(raw[i]));
        }
        float suf = 1.0f;
#pragma unroll
        for (int t8 = 56; t8 >= 0; t8 -= 8) {
            float kv[8];
#pragma unroll
            for (int i = 7; i >= 0; --i) { kv[i] = (1.0f - f[t8 + i]) * suf; suf *= f[t8 + i]; }
            u32x4 wv; wv.x = pack2(kv[0], kv[1]); wv.y = pack2(kv[2], kv[3]); wv.z = pack2(kv[4], kv[5]); wv.w = pack2(kv[6], kv[7]);
            *(u32x4*)(kh + lds_off(k, t8)) = wv;
        }
        p.DV[(size_t)bhc * 128 + k] = suf;
    } else {
        const int q = tid - 128;
#pragma unroll
        for (int i = 0; i < 8; ++i) { const int pc = q + 128 * i, v = pc >> 3, c8 = pc & 7;
            *(u32x4*)(vt + lds_off(v, c8 * 8)) = *(const u32x4*)(p.VHt + ((size_t)(b * 512 + h * 128 + v)) * SEQ + ck * 64 + c8 * 8); }
    }
    __syncthreads();
    bf16_t* ut = p.UT + (size_t)bhc * 16384;
#pragma unroll
    for (int kk = 0; kk < 2; ++kk) {
        const int kt = w * 2 + kk;
        const bf16x8 a0 = *(const bf16x8*)(kh + lds_off(kt * 16 + fr, fg * 8)), a1 = *(const bf16x8*)(kh + lds_off(kt * 16 + fr, 32 + fg * 8));
#pragma unroll
        for (int v8 = 0; v8 < 8; ++v8) {
            const bf16x8 b0 = *(const bf16x8*)(vt + lds_off(v8 * 16 + fr, fg * 8)), b1 = *(const bf16x8*)(vt + lds_off(v8 * 16 + fr, 32 + fg * 8));
            f32x4 acc = __builtin_amdgcn_mfma_f32_16x16x32_bf16(a0, b0, (f32x4){0.f, 0.f, 0.f, 0.f}, 0, 0, 0);
            acc = __builtin_amdgcn_mfma_f32_16x16x32_bf16(a1, b1, acc, 0, 0, 0);
            u32x2 wv; wv.x = pack2(acc[0], acc[1]); wv.y = pack2(acc[2], acc[3]);
            *(u32x2*)(ut + (size_t)(v8 * 16 + fr) * 128 + kt * 16 + fg * 4) = wv;
        }
    }
}
__device__ __forceinline__ void phase_hg2(int bid, int nb, const P& p) {
    for (int it = bid * 256 + tidx(); it < 32 * 4096; it += nb * 256) {
        const int bh = it >> 12, e4 = (it & 4095) * 4, k4 = e4 & 127;
        float S0 = 0.f, S1 = 0.f, S2 = 0.f, S3 = 0.f;
        for (int c8 = 0; c8 < 32; c8 += 8) {
            u32x2 uv[8]; f32x4 dv[8];
#pragma unroll
            for (int i = 0; i < 8; ++i) { uv[i] = *(const u32x2*)(p.UT + ((size_t)(bh * 32 + c8 + i)) * 16384 + e4); dv[i] = *(const f32x4*)(p.DV + (size_t)(bh * 32 + c8 + i) * 128 + k4); }
#pragma unroll
            for (int i = 0; i < 8; ++i) {
                u32x2 wv; wv.x = pack2(S0, S1); wv.y = pack2(S2, S3);
                *(u32x2*)(p.SP + ((size_t)(bh * 32 + c8 + i)) * 16384 + e4) = wv;
                S0 = dv[i][0] * S0 + bf2f(uv[i].x & 0xffffu); S1 = dv[i][1] * S1 + bf2f(uv[i].x >> 16);
                S2 = dv[i][2] * S2 + bf2f(uv[i].y & 0xffffu); S3 = dv[i][3] * S3 + bf2f(uv[i].y >> 16);
            }
        }
    }
}
#define HG3_QP 0
#define HG3_KP 40960
#define HG3_VT (40960 + 16384)
#define HG3_LDS (40960 + 16384 + 128 * 144)
__device__ __forceinline__ int hg3_qp_base(int j) { return j == 0 ? 0 : (j == 1 ? 16384 : (j == 2 ? 28672 : 36864)); }
__device__ __forceinline__ void hg3_unit(char* lds, const P& p, int b, int h, int ck) {
    const int tid = tidx(), lane = tid & 63, w = tid >> 6, fr = lane & 15, fg = lane >> 4;
    char* qp = lds + HG3_QP; char* kp = lds + HG3_KP; char* vt = lds + HG3_VT;
    const size_t n0 = (size_t)b * SEQ + ck * 64;
    const int bhc = (b * 4 + h) * 32 + ck;
    __syncthreads();
    if (tid < 128) {
        const int k = tid, ch = h * 128 + k;
        const float lbv = hg_lb(p, ch);
        const int ke = (k & 7) * 2, k8 = k & ~7;
        float d0 = 1.f, d1 = 1.f, d2 = 1.f, d3 = 1.f;
#pragma unroll
        for (int i = 0; i < 4; ++i) {
            bf16_t rq[16], rf[16];
#pragma unroll
            for (int tt = 0; tt < 16; ++tt) { rq[tt] = p.UB0[(n0 + i * 16 + tt) * 2560 + 1024 + ch]; rf[tt] = p.UB0[(n0 + i * 16 + tt) * 2560 + 1536 + ch]; }
#pragma unroll
            for (int tt = 0; tt < 16; ++tt) {
                const int t = i * 16 + tt;
                const float qv = siluf_(bf2f(rq[tt]));
                const float f = lbv + (1.0f - lbv) * sigmoidf_(bf2f(rf[tt]));
                d0 *= f; if (i >= 1) d1 *= f; if (i >= 2) d2 *= f; if (i >= 3) d3 *= f;
                const float di = (i == 0) ? d0 : (i == 1 ? d1 : (i == 2 ? d2 : d3));
                *(bf16_t*)(kp + lds_off128(t, k8) + ke) = (bf16_t)f2bf((1.0f - f) * __builtin_amdgcn_rcpf(fmaxf(di, 1.8e-35f)));
                *(bf16_t*)(qp + hg3_qp_base(0) + lds_off128(t, k8) + ke) = (bf16_t)f2bf(qv * d0);
                if (i >= 1) *(bf16_t*)(qp + hg3_qp_base(1) + lds_off128(t - 16, k8) + ke) = (bf16_t)f2bf(qv * d1);
                if (i >= 2) *(bf16_t*)(qp + hg3_qp_base(2) + lds_off128(t - 32, k8) + ke) = (bf16_t)f2bf(qv * d2);
                if (i >= 3) *(bf16_t*)(qp + hg3_qp_base(3) + lds_off128(t - 48, k8) + ke) = (bf16_t)f2bf(qv * d3);
            }
        }
    } else {
        const int q = tid - 128;
#pragma unroll
        for (int i = 0; i < 8; ++i) { const int pc = q + 128 * i, v = pc >> 3, c8 = pc & 7;
            *(u32x4*)(vt + v * 144 + c8 * 16) = *(const u32x4*)(p.VHt + ((size_t)(b * 512 + h * 128 + v)) * SEQ + ck * 64 + c8 * 8); }
    }
    __syncthreads();
    f32x4 acc[8];
#pragma unroll
    for (int v8 = 0; v8 < 8; ++v8) acc[v8] = (f32x4){0.f, 0.f, 0.f, 0.f};
    if (ck > 0) {
        const bf16_t* sp = p.SP + (size_t)bhc * 16384;
#pragma unroll
        for (int ks = 0; ks < 4; ++ks) {
            const bf16x8 bq = *(const bf16x8*)(qp + hg3_qp_base(0) + lds_off128(w * 16 + fr, ks * 32 + fg * 8));
#pragma unroll
            for (int v8 = 0; v8 < 8; ++v8) {
                const bf16x8 as = *(const bf16x8*)(sp + (size_t)(v8 * 16 + fr) * 128 + ks * 32 + fg * 8);
                acc[v8] = __builtin_amdgcn_mfma_f32_16x16x32_bf16(as, bq, acc[v8], 0, 0, 0);
            }
        }
    }
#pragma unroll
    for (int jp = 0; jp < 2; ++jp) {
        if (2 * jp > w) continue;
        f32x4 at[2];
#pragma unroll
        for (int jj = 0; jj < 2; ++jj) {
            const int j = 2 * jp + jj;
            at[jj] = (f32x4){0.f, 0.f, 0.f, 0.f};
            if (j <= w) {
#pragma unroll
                for (int ks = 0; ks < 4; ++ks) {
                    const bf16x8 ak = *(const bf16x8*)(kp + lds_off128(j * 16 + fr, ks * 32 + fg * 8));
                    const bf16x8 bq = *(const bf16x8*)(qp + hg3_qp_base(j) + lds_off128((w - j) * 16 + fr, ks * 32 + fg * 8));
                    at[jj] = __builtin_amdgcn_mfma_f32_16x16x32_bf16(ak, bq, at[jj], 0, 0, 0);
                }
                if (j == w) {
#pragma unroll
                    for (int r = 0; r < 4; ++r) at[jj][r] = (fg * 4 + r <= fr) ? at[jj][r] : 0.f;
                }
            }
        }
        u32x4 pw; pw.x = pack2(at[0][0], at[0][1]); pw.y = pack2(at[0][2], at[0][3]); pw.z = pack2(at[1][0], at[1][1]); pw.w = pack2(at[1][2], at[1][3]);
        const bf16x8 pf = __builtin_bit_cast(bf16x8, pw);
#pragma unroll
        for (int v8 = 0; v8 < 8; ++v8) {
            const char* vb = vt + (v8 * 16 + fr) * 144 + (jp * 32 + fg * 4) * 2;
            const u32x2 v0 = *(const u32x2*)vb, v1 = *(const u32x2*)(vb + 32);
            u32x4 vv; vv.x = v0.x; vv.y = v0.y; vv.z = v1.x; vv.w = v1.y;
            acc[v8] = __builtin_amdgcn_mfma_f32_16x16x32_bf16(__builtin_bit_cast(bf16x8, vv), pf, acc[v8], 0, 0, 0);
        }
    }
    float ss = 0.f;
#pragma unroll
    for (int v8 = 0; v8 < 8; ++v8)
#pragma unroll
        for (int r = 0; r < 4; ++r) ss += acc[v8][r] * acc[v8][r];
    ss += __shfl_xor(ss, 16); ss += __shfl_xor(ss, 32);
    const float rs = rsqrtf(ss * (1.0f / 128.0f) + 1e-6f);
    const size_t n = n0 + w * 16 + fr;
#pragma unroll
    for (int v8 = 0; v8 < 8; ++v8) {
        const int vcol = h * 128 + v8 * 16 + fg * 4;
        const u32x2 gv = *(const u32x2*)(p.UB0 + n * 2560 + 2048 + vcol);
        const f32x4 ng = *(const f32x4*)(p.hg_ng + vcol);
        const float y0 = acc[v8][0] * rs * ng[0] * sigmoidf_(bf2f(gv.x & 0xffffu)), y1 = acc[v8][1] * rs * ng[1] * sigmoidf_(bf2f(gv.x >> 16));
        const float y2 = acc[v8][2] * rs * ng[2] * sigmoidf_(bf2f(gv.y & 0xffffu)), y3 = acc[v8][3] * rs * ng[3] * sigmoidf_(bf2f(gv.y >> 16));
        u32x2 wv; wv.x = pack2(y0, y1); wv.y = pack2(y2, y3);
        *(u32x2*)(p.MIX + n * DM + 512 + vcol) = wv;
    }
}
__device__ __forceinline__ void phase_mix0_a(char* lds, int bid, int nb, const P& p) {
    for (int u = bid; u < 512 + 1024; u += nb) {
        if (u < 512) lru1_unit(lds, p, u >> 6, (u >> 1) & 31, u & 1);
        else { const int v = u - 512; hg1_unit(lds, p, v >> 7, (v >> 5) & 3, v & 31); }
    }
    __syncthreads();
}
__device__ __forceinline__ void phase_mix0_c(char* lds, int bid, int nb, const P& p) {
    for (int u = bid; u < 1024; u += nb) hg3_unit(lds, p, u >> 7, (u >> 5) & 3, u & 31);
    __syncthreads();
}

#ifndef KEEP_U
#define KEEP_U 0
#endif
__device__ __forceinline__ int vcol_actual(int v) { return v < 1280 ? v : (v < 2816 ? v + 24 : v - 1536); }
__device__ __forceinline__ void phase_inproj1(char* lds, int bid, int nb, const P& p) {
    const int ntn = 17, nk = DM / 32;
    const int tid = tidx(), lane = tid & 63, wid = tid >> 6, wr = wid >> 1, wc = wid & 1, fr = lane & 15, fq = lane >> 4;
    for (int jj = 0;; ++jj) {
        int tm, tn; if (!dense_unit3(bid, nb, jj, ntn, tm, tn)) break;
        Dma3A al; al.set_dense(p.XBb, tm * 256, DM); Dma3B bl; bl.set(p.WIN1, p.WIN1, tn * 128, DM, 1 << 30);
        f32x4 acc[32];
        gemm_core4(al, bl, nk, acc);
#pragma unroll
        for (int i = 0; i < 8; ++i)
#pragma unroll
            for (int gg = 0; gg < 2; ++gg) {
                const int row = tm * 256 + wr * 128 + i * 16 + fr, vc = tn * 128 + wc * 64 + gg * 32 + fq * 8;
                const f32x4 a = acc[i * 4 + 2 * gg], b2 = acc[i * 4 + 2 * gg + 1];
                u32x4 w; w.x = pack2(a[0], a[1]); w.y = pack2(a[2], a[3]); w.z = pack2(b2[0], b2[1]); w.w = pack2(b2[2], b2[3]);
                if (tn < 4) *(u32x4*)(p.Qb + (size_t)row * 512 + vc) = w;
                else if (tn < 6) { *(f32x4*)(p.KCV + (size_t)row * 256 + vc - 512) = a; *(f32x4*)(p.KCV + (size_t)row * 256 + vc - 512 + 4) = b2; }
                else if (tn == 6) *(u32x4*)(p.KS + (size_t)row * 128 + vc - 768) = w;
                else if (tn == 7) *(u32x4*)(p.KW + (size_t)row * 128 + vc - 896) = w;
                else if (tn < 12) *(u32x4*)(p.MQ + (size_t)row * 512 + vc - 1024) = w;
                else if (tn < 16) *(u32x4*)(p.MK + (size_t)row * 512 + vc - 1536) = w;
                else if (vc < 2072) { *(f32x4*)(p.GATES + (size_t)row * 24 + vc - 2048) = a; *(f32x4*)(p.GATES + (size_t)row * 24 + vc - 2048 + 4) = b2; }
            }
    }
    for (int u = (nb >= 512 ? bid - 64 : bid); u < 3 * 128; u += nb) {
        if (u < 0) continue;
        const int pn = u % 3, tt = u / 3;
        if (pn == 0) {
            const int wrr = tidx() >> 7;
            gemm_t_unit(p.WIN1, 2176, p.XBb, tt * 128, wrr ? p.VWt - (size_t)128 * SEQ : p.VSt, 128, 0);
        } else gemm_t_unit(p.WIN1, 2432 + (pn - 1) * 256, p.XBb, tt * 128, p.MVt, 512, (pn - 1) * 256);
    }
}
__device__ __forceinline__ void phase_moba_gate(char* lds, int bid, int nb, const P& p) {
    const int lane = tidx() & 63, wid = tidx() >> 6;
    float* km = (float*)lds + 4096 + wid * 512;
    for (int it = bid * 4 + wid; it < 64 * 32; it += nb * 4) {
        const int bh = it >> 5, tb = it & 31, b = bh >> 3, h = bh & 7;
        const int t = tb * 64 + lane, ob = t >> 8;
        __builtin_amdgcn_wave_barrier();
#pragma unroll
        for (int i = 0; i < 8; ++i) km[i * 64 + lane] = p.KM[(size_t)bh * 512 + i * 64 + lane];
        __builtin_amdgcn_wave_barrier();
        u32x4 qr[8];
#pragma unroll
        for (int i = 0; i < 8; ++i) qr[i] = *(const u32x4*)(p.MQ + (size_t)(b * SEQ + t) * 512 + h * 64 + i * 8);
        float gate[8];
#pragma unroll
        for (int j = 0; j < 8; ++j) gate[j] = 0.f;
#pragma unroll
        for (int i = 0; i < 8; ++i) {
            float q[8];
            q[0] = bf2f(qr[i].x & 0xffffu); q[1] = bf2f(qr[i].x >> 16); q[2] = bf2f(qr[i].y & 0xffffu); q[3] = bf2f(qr[i].y >> 16);
            q[4] = bf2f(qr[i].z & 0xffffu); q[5] = bf2f(qr[i].z >> 16); q[6] = bf2f(qr[i].w & 0xffffu); q[7] = bf2f(qr[i].w >> 16);
#pragma unroll
            for (int j = 0; j < 8; ++j)
#pragma unroll
                for (int e = 0; e < 8; ++e) gate[j] += q[e] * km[j * 64 + i * 8 + e];
        }
#pragma unroll
        for (int j = 0; j < 8; ++j) gate[j] = (j < ob) ? gate[j] : NEGF;
        unsigned selm = 0;
#pragma unroll
        for (int j = 0; j < 8; ++j) {
            int rank = 0;
#pragma unroll
            for (int j2 = 0; j2 < 8; ++j2) rank += (gate[j2] > gate[j] || (gate[j2] == gate[j] && j2 < j)) ? 1 : 0;
            if (j < ob && rank < 3) selm |= 1u << j;
        }
        p.MSEL[(size_t)bh * SEQ + t] = selm;
    }
}

#define ATT_K_BYTES 8192
#define ATT_STAGE 16384
#define ATT_TILE_BYTES (3 * ATT_STAGE)
#define ATT_ORDER_OFF ATT_TILE_BYTES
#define ATT_RED_OFF (ATT_ORDER_OFF + 8192)
__device__ __forceinline__ void att_issue_tile(int stage, const bf16_t* Kg, int ldk, const bf16_t* Vg) {
    const int lane = tidx() & 63, w = tidx() >> 6;
#pragma unroll
    for (int i = 0; i < 2; ++i) { int R, C; dma_rc(lane, w + 4 * i, R, C);
        __builtin_amdgcn_global_load_lds((const unsigned*)(Kg + (size_t)R * ldk + C), (LAS unsigned*)((LAS char*)dyn_lds + stage * ATT_STAGE + (w + 4 * i) * 1024), 16, 0, 0);
        __builtin_amdgcn_global_load_lds((const unsigned*)(Vg + (size_t)R * SEQ + C), (LAS unsigned*)((LAS char*)dyn_lds + stage * ATT_STAGE + ATT_K_BYTES + (w + 4 * i) * 1024), 16, 0, 0); }
}
#define ATT_WAIT_BAR(n) do { asm volatile("s_waitcnt vmcnt(" #n ") lgkmcnt(0)" ::: "memory"); __builtin_amdgcn_s_barrier(); asm volatile("" ::: "memory"); } while (0)
struct AttState { f32x4 O[4][2]; float m[2], l[2]; };
__device__ __forceinline__ void att_reset(AttState& S) {
#pragma unroll
    for (int q = 0; q < 2; ++q) { S.m[q] = NEGF; S.l[q] = 0.f;
#pragma unroll
        for (int d = 0; d < 4; ++d) S.O[d][q] = (f32x4){0.f, 0.f, 0.f, 0.f}; }
}
template <bool MASKED>
__device__ __forceinline__ void att_step(const char* lds, const bf16x8 (&qf)[2][2], AttState& S, const f32x4 (&bini)[4], float slope2,
                                         int s0, int tq0, unsigned selbits  , int winlimit) {
    const int lane = tidx() & 63, fr = lane & 15, fg = lane >> 4;
    const char* ldsV = lds + ATT_K_BYTES;
    const float offbase = slope2 * (float)s0;
    f32x4 s[2][4];
#pragma unroll
    for (int kt = 0; kt < 4; ++kt) {
        const bf16x8 k0 = *(const bf16x8*)(lds + lds_off(kt * 16 + fr, fg * 8)), k1 = *(const bf16x8*)(lds + lds_off(kt * 16 + fr, 32 + fg * 8));
#pragma unroll
        for (int qt = 0; qt < 2; ++qt) {
            s[qt][kt] = __builtin_amdgcn_mfma_f32_16x16x32_bf16(k0, qf[qt][0], bini[kt], 0, 0, 0);
            s[qt][kt] = __builtin_amdgcn_mfma_f32_16x16x32_bf16(k1, qf[qt][1], s[qt][kt], 0, 0, 0);
        }
    }
    __builtin_amdgcn_sched_barrier(0);
    u32x4 pf[2][2];
#pragma unroll
    for (int qt = 0; qt < 2; ++qt) {
        const int tq = tq0 + qt * 16 + fr;
        const float off = ((selbits >> qt) & 1u) ? (offbase - slope2 * (float)tq) : -INFINITY;
        float mx = -INFINITY;
#pragma unroll
        for (int kt = 0; kt < 4; ++kt)
#pragma unroll
            for (int r = 0; r < 4; ++r) {
                float y = s[qt][kt][r];
                if (MASKED) { const int key = s0 + kt * 16 + fg * 4 + r; const bool ok = (key <= tq) && (tq - key < winlimit); y = ok ? y : -INFINITY; s[qt][kt][r] = y; }
                mx = fmaxf(mx, y);
            }
        mx = fmaxf(mx, __shfl_xor(mx, 16)); mx = fmaxf(mx, __shfl_xor(mx, 32));
        const float mnew = fmaxf(S.m[qt], mx + off);
        const float alpha = __builtin_amdgcn_exp2f(S.m[qt] - mnew);
        S.m[qt] = mnew;
        const float thr = mnew - off;
        float ls = 0.f;
#pragma unroll
        for (int kt = 0; kt < 4; ++kt)
#pragma unroll
            for (int r = 0; r < 4; ++r) { const float pr = __builtin_amdgcn_exp2f(s[qt][kt][r] - thr); s[qt][kt][r] = pr; ls += pr; }
        S.l[qt] = S.l[qt] * alpha + ls;
#pragma unroll
        for (int dt = 0; dt < 4; ++dt) S.O[dt][qt] *= alpha;
#pragma unroll
        for (int kk = 0; kk < 2; ++kk) {
            pf[qt][kk].x = pack2(s[qt][2 * kk][0], s[qt][2 * kk][1]); pf[qt][kk].y = pack2(s[qt][2 * kk][2], s[qt][2 * kk][3]);
            pf[qt][kk].z = pack2(s[qt][2 * kk + 1][0], s[qt][2 * kk + 1][1]); pf[qt][kk].w = pack2(s[qt][2 * kk + 1][2], s[qt][2 * kk + 1][3]);
        }
    }
    __builtin_amdgcn_sched_barrier(0);
#pragma unroll
    for (int kk = 0; kk < 2; ++kk)
#pragma unroll
        for (int dt = 0; dt < 4; ++dt) {
            const char* vb = ldsV + (fg & 1) * 8;
            const u32x2 v0 = *(const u32x2*)(vb + lds_off(dt * 16 + fr, kk * 32 + (fg >> 1) * 8)), v1 = *(const u32x2*)(vb + lds_off(dt * 16 + fr, kk * 32 + 16 + (fg >> 1) * 8));
            u32x4 vv; vv.x = v0.x; vv.y = v0.y; vv.z = v1.x; vv.w = v1.y;
            const bf16x8 vf = __builtin_bit_cast(bf16x8, vv);
#pragma unroll
            for (int qt = 0; qt < 2; ++qt) S.O[dt][qt] = __builtin_amdgcn_mfma_f32_16x16x32_bf16(vf, __builtin_bit_cast(bf16x8, pf[qt][kk]), S.O[dt][qt], 0, 0, 0);
        }
    __builtin_amdgcn_sched_barrier(0);
}
__device__ __forceinline__ unsigned wave_or(unsigned v) {
#pragma unroll
    for (int o = 32; o >= 1; o >>= 1) v |= (unsigned)__shfl_xor((int)v, o);
    return v;
}
__device__ __forceinline__ void att_nsa_unit(char* lds, const P& p, int b, int g, int qtile) {
    const int tid = tidx(), lane = tid & 63, w = tid >> 6, fr = lane & 15, fg = lane >> 4;
    const int hd = g * 4 + w, t0 = qtile * 32, own = qtile >> 1;
    const float slope2 = exp2f(-((float)hd + 0.5f)) * LOG2E, c1 = 0.125f * LOG2E;
    bf16x8 qf[2][2];
#pragma unroll
    for (int qt = 0; qt < 2; ++qt)
#pragma unroll
        for (int ks = 0; ks < 2; ++ks) qf[qt][ks] = *(const bf16x8*)(p.Qb + (size_t)(b * SEQ + t0 + qt * 16 + fr) * 512 + hd * 64 + ks * 32 + fg * 8);
#pragma unroll
    for (int qt = 0; qt < 2; ++qt)
#pragma unroll
        for (int ks = 0; ks < 2; ++ks) {
            const u32x4 raw = __builtin_bit_cast(u32x4, qf[qt][ks]); u32x4 o;
            o.x = pack2(bf2f(raw.x & 0xffffu) * c1, bf2f(raw.x >> 16) * c1); o.y = pack2(bf2f(raw.y & 0xffffu) * c1, bf2f(raw.y >> 16) * c1);
            o.z = pack2(bf2f(raw.z & 0xffffu) * c1, bf2f(raw.z >> 16) * c1); o.w = pack2(bf2f(raw.w & 0xffffu) * c1, bf2f(raw.w >> 16) * c1);
            qf[qt][ks] = __builtin_bit_cast(bf16x8, o);
        }
    f32x4 bini[4];
#pragma unroll
    for (int kt = 0; kt < 4; ++kt)
#pragma unroll
        for (int r = 0; r < 4; ++r) bini[kt][r] = slope2 * (float)(kt * 16 + fg * 4 + r);
    unsigned selw[2];
#pragma unroll
    for (int qt = 0; qt < 2; ++qt) selw[qt] = p.SELM[(size_t)(b * 2 + g) * SEQ + t0 + qt * 16 + fr];
    const unsigned um = wave_or(selw[0] | selw[1]);
    AttState S; att_reset(S);
    unsigned rem = um & ((own >= 31) ? 0xffffffffu : ((2u << own) - 1u));
    int wj = own >= 8 ? own - 8 : 0;
    int cbr, cj; bool has = true;
    if (rem) { cj = __ffs(rem) - 1; rem &= rem - 1; cbr = 0; } else { cj = wj++; cbr = 1; }
    const bf16_t* Ks = p.KS + (size_t)b * SEQ * 128 + g * 64; const bf16_t* Kw = p.KW + (size_t)b * SEQ * 128 + g * 64;
    const bf16_t* Vs = p.VSt + (size_t)(b * 128 + g * 64) * SEQ; const bf16_t* Vw = p.VWt + (size_t)(b * 128 + g * 64) * SEQ;
    int n1br = 0, n1j = 0; bool has1;
    if (rem) { n1j = __ffs(rem) - 1; rem &= rem - 1; n1br = 0; has1 = true; } else if (wj <= own) { n1j = wj++; n1br = 1; has1 = true; } else has1 = false;
    __syncthreads();
    att_issue_tile(0, (cbr ? Kw : Ks) + (size_t)cj * 64 * 128, 128, (cbr ? Vw : Vs) + cj * 64);
    if (has1) att_issue_tile(1, (n1br ? Kw : Ks) + (size_t)n1j * 64 * 128, 128, (n1br ? Vw : Vs) + n1j * 64);
    bool switched = false;
    int st = 0;
    while (has) {
        if (has1) ATT_WAIT_BAR(4); else ATT_WAIT_BAR(0);
        int n2br = 0, n2j = 0; bool has2;
        if (!has1) has2 = false;
        else if (rem) { n2j = __ffs(rem) - 1; rem &= rem - 1; n2br = 0; has2 = true; } else if (wj <= own) { n2j = wj++; n2br = 1; has2 = true; } else has2 = false;
        if (has2) att_issue_tile(st == 0 ? 2 : st - 1, (n2br ? Kw : Ks) + (size_t)n2j * 64 * 128, 128, (n2br ? Vw : Vs) + n2j * 64);
        const char* sl = lds + st * ATT_STAGE;
        if (cbr == 1 && !switched) {
            switched = true;
#pragma unroll
            for (int qt = 0; qt < 2; ++qt) {
                float lt = S.l[qt]; lt += __shfl_xor(lt, 16); lt += __shfl_xor(lt, 32);
                const size_t n = (size_t)b * SEQ + t0 + qt * 16 + fr;
                const float sc = sigmoidf_(p.GATES[n * 24 + hd * 3 + 1]) / fmaxf(lt, 1e-30f);
#pragma unroll
                for (int dt = 0; dt < 4; ++dt) { const f32x4 y = S.O[dt][qt] * sc; u32x2 w; w.x = pack2(y[0], y[1]); w.y = pack2(y[2], y[3]); *(u32x2*)((bf16_t*)p.OS + n * 512 + hd * 64 + dt * 16 + fg * 4) = w; }
            }
            att_reset(S);
        }
        unsigned sb = 3u; int wl = 1 << 30; bool msk;
        if (cbr == 0) { sb = ((selw[0] >> cj) & 1u) | (((selw[1] >> cj) & 1u) << 1); msk = (cj == own); }
        else { wl = 512; msk = (cj == own) || (cj + 8 == own); }
        if (msk) att_step<true>(sl, qf, S, bini, slope2, cj * 64, t0, sb, wl);
        else att_step<false>(sl, qf, S, bini, slope2, cj * 64, t0, sb, wl);
        cbr = n1br; cj = n1j; has = has1; n1br = n2br; n1j = n2j; has1 = has2;
        st = (st == 2) ? 0 : st + 1;
    }
#pragma unroll
    for (int qt = 0; qt < 2; ++qt) {
        float lt = S.l[qt]; lt += __shfl_xor(lt, 16); lt += __shfl_xor(lt, 32);
        const size_t n = (size_t)b * SEQ + t0 + qt * 16 + fr;
        const float sc = sigmoidf_(p.GATES[n * 24 + hd * 3 + 2]) / fmaxf(lt, 1e-30f);
        const float g0 = sigmoidf_(p.GATES[n * 24 + hd * 3 + 0]);
#pragma unroll
        for (int dt = 0; dt < 4; ++dt) {
            const size_t o = n * 512 + hd * 64 + dt * 16 + fg * 4;
            const u32x2 osv = *(const u32x2*)((const bf16_t*)p.OS + o), ocv = *(const u32x2*)((const bf16_t*)p.OC + o);
            const f32x4 osf = {bf2f(osv.x & 0xffffu), bf2f(osv.x >> 16), bf2f(osv.y & 0xffffu), bf2f(osv.y >> 16)};
            const f32x4 ocf = {bf2f(ocv.x & 0xffffu), bf2f(ocv.x >> 16), bf2f(ocv.y & 0xffffu), bf2f(ocv.y >> 16)};
            const f32x4 y = S.O[dt][qt] * sc + osf + ocf * g0;
            u32x2 wv; wv.x = pack2(y[0], y[1]); wv.y = pack2(y[2], y[3]);
            *(u32x2*)(p.MIX + n * DM + hd * 64 + dt * 16 + fg * 4) = wv;
        }
    }
}
__device__ __forceinline__ void att_moba_unit(char* lds, const P& p, int b, int h, int ob, int half) {
    const int tid = tidx(), lane = tid & 63, w = tid >> 6, fr = lane & 15, fg = lane >> 4;
    const int tq0 = ob * 256 + half * 128 + w * 32;
    const int dsub = half * 2 + (w >> 1), lastsub = half * 2 + 1;
    const float slope2 = exp2f(-((float)h + 1.0f)) * LOG2E, c1 = 0.125f * LOG2E;
    bf16x8 qf[2][2];
#pragma unroll
    for (int qt = 0; qt < 2; ++qt)
#pragma unroll
        for (int ks = 0; ks < 2; ++ks) qf[qt][ks] = *(const bf16x8*)(p.MQ + (size_t)(b * SEQ + tq0 + qt * 16 + fr) * 512 + h * 64 + ks * 32 + fg * 8);
#pragma unroll
    for (int qt = 0; qt < 2; ++qt)
#pragma unroll
        for (int ks = 0; ks < 2; ++ks) {
            const u32x4 raw = __builtin_bit_cast(u32x4, qf[qt][ks]); u32x4 o;
            o.x = pack2(bf2f(raw.x & 0xffffu) * c1, bf2f(raw.x >> 16) * c1); o.y = pack2(bf2f(raw.y & 0xffffu) * c1, bf2f(raw.y >> 16) * c1);
            o.z = pack2(bf2f(raw.z & 0xffffu) * c1, bf2f(raw.z >> 16) * c1); o.w = pack2(bf2f(raw.w & 0xffffu) * c1, bf2f(raw.w >> 16) * c1);
            qf[qt][ks] = __builtin_bit_cast(bf16x8, o);
        }
    f32x4 bini[4];
#pragma unroll
    for (int kt = 0; kt < 4; ++kt)
#pragma unroll
        for (int r = 0; r < 4; ++r) bini[kt][r] = slope2 * (float)(kt * 16 + fg * 4 + r);
    unsigned selw[2];
#pragma unroll
    for (int qt = 0; qt < 2; ++qt) selw[qt] = p.MSEL[(size_t)(b * 8 + h) * SEQ + tq0 + qt * 16 + fr];
    unsigned* red = (unsigned*)(lds + ATT_RED_OFF);
    const unsigned umw = wave_or(selw[0] | selw[1]);
    __syncthreads();
    if (lane == 0) red[w] = umw;
    __syncthreads();
    unsigned rem = (red[0] | red[1] | red[2] | red[3]) & ((1u << ob) - 1u);
    AttState S; att_reset(S);
    int cj, csub = 0; bool has = true;
    if (rem) { cj = __ffs(rem) - 1; rem &= rem - 1; } else cj = ob;
    const bf16_t* Kb = p.MK + (size_t)b * SEQ * 512 + h * 64; const bf16_t* Vb = p.MVt + (size_t)(b * 512 + h * 64) * SEQ;
#define MOBA_NEXT(J, SUB, NJ, NSUB, HAS) do { \
        if ((J) == ob) { if ((SUB) < lastsub) { NJ = (J); NSUB = (SUB) + 1; HAS = true; } else HAS = false; } \
        else if ((SUB) < 3) { NJ = (J); NSUB = (SUB) + 1; HAS = true; } \
        else { if (rem) { NJ = __ffs(rem) - 1; rem &= rem - 1; } else NJ = ob; NSUB = 0; HAS = true; } } while (0)
    int n1j = 0, n1sub = 0; bool has1;
    MOBA_NEXT(cj, csub, n1j, n1sub, has1);
    __syncthreads();
    att_issue_tile(0, Kb + (size_t)(cj * 256 + csub * 64) * 512, 512, Vb + cj * 256 + csub * 64);
    if (has1) att_issue_tile(1, Kb + (size_t)(n1j * 256 + n1sub * 64) * 512, 512, Vb + n1j * 256 + n1sub * 64);
    int st = 0;
    while (has) {
        if (has1) ATT_WAIT_BAR(4); else ATT_WAIT_BAR(0);
        int n2j = 0, n2sub = 0; bool has2 = false;
        if (has1) MOBA_NEXT(n1j, n1sub, n2j, n2sub, has2);
        if (has2) att_issue_tile(st == 0 ? 2 : st - 1, Kb + (size_t)(n2j * 256 + n2sub * 64) * 512, 512, Vb + n2j * 256 + n2sub * 64);
        const char* sl = lds + st * ATT_STAGE;
        const int s0 = cj * 256 + csub * 64;
        unsigned sb = 3u; bool msk = false, run = true;
        if (cj < ob) sb = ((selw[0] >> cj) & 1u) | (((selw[1] >> cj) & 1u) << 1);
        else { msk = (csub == dsub); run = (csub <= dsub); }
        if (run) {
            if (msk) att_step<true>(sl, qf, S, bini, slope2, s0, tq0, sb, 1 << 30);
            else att_step<false>(sl, qf, S, bini, slope2, s0, tq0, sb, 1 << 30);
        }
        cj = n1j; csub = n1sub; has = has1; n1j = n2j; n1sub = n2sub; has1 = has2;
        st = (st == 2) ? 0 : st + 1;
    }
#undef MOBA_NEXT
#pragma unroll
    for (int qt = 0; qt < 2; ++qt) {
        float lt = S.l[qt]; lt += __shfl_xor(lt, 16); lt += __shfl_xor(lt, 32);
        const size_t n = (size_t)b * SEQ + tq0 + qt * 16 + fr;
        const float sc = 1.0f / fmaxf(lt, 1e-30f);
#pragma unroll
        for (int dt = 0; dt < 4; ++dt) {
            const f32x4 y = S.O[dt][qt] * sc;
            u32x2 wv; wv.x = pack2(y[0], y[1]); wv.y = pack2(y[2], y[3]);
            *(u32x2*)(p.MIX + n * DM + 512 + h * 64 + dt * 16 + fg * 4) = wv;
        }
    }
}
#ifndef ATT_NSA
#define ATT_NSA 1
#endif
#ifndef ATT_MOBA
#define ATT_MOBA 1
#endif
__device__ __forceinline__ int att_class_key(int c) {
    if (c < 64) { const int a = (c >> 1) + 1; return (a < 16 ? a : 16) + (a < 9 ? a : 9); }
    const int ob = (c - 64) >> 1, half = (c - 64) & 1; return 4 * ob + 2 + 2 * half;
}
__device__ __forceinline__ void cmpa_unit(char* lds, const P& p, int b, int g, int qt64);
__device__ __forceinline__ void phase_attn_a(char* lds, int bid, int nb, const P& p) {
    int* order = (int*)(lds + 49152);
    __syncthreads();
    for (int u = tidx(); u < 1024; u += 256) {
        const int c = u & 15, inst = u >> 4;
        const int key = att_class_key(64 + c);
        int pos = inst;
        for (int c2 = 0; c2 < 16; ++c2) { const int k2 = att_class_key(64 + c2); if (k2 > key || (k2 == key && c2 < c)) pos += 64; }
        order[pos] = u;
    }
    __syncthreads();
    for (int r = 0;; ++r) {
        const int idx = r * nb + ((r & 1) ? (nb - 1 - bid) : bid);
        if (idx >= 512 + 1024) break;
        if (idx < 512) cmpa_unit(lds, p, idx >> 6, (idx >> 5) & 1, idx & 31);
        else { const int v = order[idx - 512]; att_moba_unit(lds, p, v >> 7, (v >> 4) & 7, (v >> 1) & 7, v & 1); }
    }
    __syncthreads();
}
__device__ __forceinline__ void phase_attn_b(char* lds, int bid, int nb, const P& p) {
    int* order = (int*)(lds + ATT_ORDER_OFF);
    __syncthreads();
    for (int u = tidx(); u < 1024; u += 256) {
        const int c = u & 63, inst = u >> 6;
        const int key = att_class_key(c);
        int pos = inst;
        for (int c2 = 0; c2 < 64; ++c2) { const int k2 = att_class_key(c2); if (k2 > key || (k2 == key && c2 < c)) pos += 16; }
        order[pos] = u;
    }
    __syncthreads();
    for (int r = 0;; ++r) {
        const int idx = r * nb + ((r & 1) ? (nb - 1 - bid) : bid);
        if (idx >= 1024) break;
        const int u = order[idx];
        att_nsa_unit(lds, p, u >> 7, (u >> 6) & 1, u & 63);
    }
    __syncthreads();
}

struct ALoadCmp {
    const float* base;
    const float* pe;
    int kt0;
    struct Regs { f32x4 v[8]; };
    __device__ __forceinline__ void load(int kt, Regs& R) const {
        const int l = kt + kt0;
        const f32x4 p0 = *(const f32x4*)(pe + l * 64), p1 = *(const f32x4*)(pe + l * 64 + 4);
#pragma unroll
        for (int i = 0; i < 4; ++i) {
            const int row = (tidx() + 256 * i) >> 3; int tok = 16 * row + l; tok = tok > SEQ - 1 ? SEQ - 1 : tok;
            const float* q = base + (size_t)tok * 256;
            R.v[2 * i] = *(const f32x4*)q + p0; R.v[2 * i + 1] = *(const f32x4*)(q + 4) + p1;
        }
    }
    __device__ __forceinline__ void store(int kt, const Regs& R, char* lds) const {
#pragma unroll
        for (int i = 0; i < 4; ++i) {
            const int p = tidx() + 256 * i, row = p >> 3, ch = p & 7;
            const f32x4 a = R.v[2 * i], b = R.v[2 * i + 1];
            u32x4 w; w.x = pack2(a[0], a[1]); w.y = pack2(a[2], a[3]); w.z = pack2(b[0], b[1]); w.w = pack2(b[2], b[3]);
            *(u32x4*)(lds + lds_off(row, ch * 8)) = w;
        }
    }
};
__device__ __forceinline__ void phase_cmp1(char* lds, int bid, int nb, const P& p) {
    const int tid = tidx(), lane = tid & 63, wid = tid >> 6, wr = wid >> 1, wc = wid & 1, fr = lane & 15, fq = lane >> 4;
    for (int u = bid; u < 16 * 2 * 4; u += nb) {
        const int split = u & 3, which = (u >> 2) & 1, bg = u >> 3, b = bg >> 1, g = bg & 1;
        ALoadCmp al; al.kt0 = split * 8; al.base = p.KCV + (size_t)b * SEQ * 256 + which * 128 + g * 64 + (tid & 7) * 8; al.pe = (which ? p.pe_v : p.pe_k) + (tid & 7) * 8;
        BLoadF32 bl; { const int nq = tid & 31, kg = tid >> 5; bl.valid = true; bl.ldb = 128; bl.nk1 = 1 << 30; bl.bp = (which ? p.wv1 : p.wk1) + (size_t)(split * 8 * 64 + kg * 8) * 128 + nq * 4; }
        f32x4 acc[4][4];
        gemm_tile(lds, al, bl, 8, acc);
        float* hid = p.HID + (((size_t)split * 2 + which) * 2048 + bg * 128) * 128;
#pragma unroll
        for (int m = 0; m < 4; ++m)
#pragma unroll
            for (int n = 0; n < 4; ++n) {
                const int row = wr * 64 + m * 16 + fr, col = wc * 64 + n * 16 + fq * 4;
                *(f32x4*)(hid + (size_t)row * 128 + col) = acc[m][n];
            }
    }
}
__device__ __forceinline__ void phase_cmp2(char* lds, int bid, int nb, const P& p) {
    const int tid = tidx(), lane = tid & 63, wid = tid >> 6;
    float* hs = (float*)lds + wid * 128;
    for (int it = bid * 4 + wid; it < 2 * 16 * 128; it += nb * 4) {
        const int which = it >> 11, bg = (it >> 7) & 15, c = it & 127;
        float o = 0.f;
        if (c < 127) {
            const float* hid = p.HID + ((size_t)which * 2048 + bg * 128 + c) * 128;
            const size_t ss = (size_t)2 * 2048 * 128;
            __builtin_amdgcn_wave_barrier();
            hs[lane] = gelu_tanh((hid[lane] + hid[ss + lane]) + (hid[2 * ss + lane] + hid[3 * ss + lane]));
            hs[lane + 64] = gelu_tanh((hid[lane + 64] + hid[ss + lane + 64]) + (hid[2 * ss + lane + 64] + hid[3 * ss + lane + 64]));
            __builtin_amdgcn_wave_barrier();
            const float* w2 = which ? p.wv2 : p.wk2;
#pragma unroll 8
            for (int j = 0; j < 128; ++j) o += hs[j] * w2[j * 64 + lane];
        }
        if (which == 0) p.KCb[((size_t)bg * 128 + c) * 64 + lane] = (bf16_t)f2bf(o);
        else p.VCt[((size_t)bg * 64 + lane) * 128 + c] = (bf16_t)f2bf(o);
    }
}
#define CMPA_LDS (2 * 16384 + 4 * 2048)
__device__ __forceinline__ void cmpa_unit(char* lds, const P& p, int b, int g, int qt64) {
    const int tid = tidx(), lane = tid & 63, w = tid >> 6, fr = lane & 15, fg = lane >> 4;
    const int bg = b * 2 + g;
    char* kc = lds; char* vt = lds + 16384;
    __syncthreads();
#pragma unroll
    for (int i = 0; i < 4; ++i) { const int pc = tid + 256 * i;
        *(u32x4*)(kc + lds_off(pc >> 3, (pc & 7) * 8)) = *(const u32x4*)(p.KCb + (size_t)bg * 8192 + pc * 8);
        *(u32x4*)(vt + lds_off128(pc >> 4, (pc & 15) * 8)) = *(const u32x4*)(p.VCt + (size_t)bg * 8192 + pc * 8); }
    __syncthreads();
    const int t = qt64 * 64 + w * 16 + fr;
    const size_t n = (size_t)b * SEQ + t;
    const float c1 = 0.125f * LOG2E;
    f32x4 psum[8];
#pragma unroll
    for (int ct = 0; ct < 8; ++ct) psum[ct] = (f32x4){0.f, 0.f, 0.f, 0.f};
    bf16x8 qall[4][2];
#pragma unroll
    for (int i = 0; i < 4; ++i) { qall[i][0] = *(const bf16x8*)(p.Qb + n * 512 + (g * 4 + i) * 64 + fg * 8); qall[i][1] = *(const bf16x8*)(p.Qb + n * 512 + (g * 4 + i) * 64 + 32 + fg * 8); }
#pragma unroll
    for (int i = 0; i < 4; ++i) {
        const int hd = g * 4 + i;
        const float slope2 = exp2f(-((float)hd + 0.5f)) * LOG2E;
        const bf16x8 q0 = qall[i][0], q1 = qall[i][1];
        __builtin_amdgcn_sched_barrier(0);
        f32x4 s[8];
        float mx = -INFINITY;
#pragma unroll
        for (int ct = 0; ct < 8; ++ct) {
            const bf16x8 k0 = *(const bf16x8*)(kc + lds_off(ct * 16 + fr, fg * 8)), k1 = *(const bf16x8*)(kc + lds_off(ct * 16 + fr, 32 + fg * 8));
            s[ct] = __builtin_amdgcn_mfma_f32_16x16x32_bf16(k0, q0, (f32x4){0.f, 0.f, 0.f, 0.f}, 0, 0, 0);
            s[ct] = __builtin_amdgcn_mfma_f32_16x16x32_bf16(k1, q1, s[ct], 0, 0, 0);
#pragma unroll
            for (int r = 0; r < 4; ++r) {
                const int e = 16 * (ct * 16 + fg * 4 + r) + 31;
                const float y = (e <= t) ? fmaf(s[ct][r], c1, -slope2 * (float)(t - e)) : -INFINITY;
                s[ct][r] = y; mx = fmaxf(mx, y);
            }
        }
        __builtin_amdgcn_sched_barrier(0);
        mx = fmaxf(mx, __shfl_xor(mx, 16)); mx = fmaxf(mx, __shfl_xor(mx, 32));
        const float mm = (mx == -INFINITY) ? 0.f : mx;
        float ls = 0.f;
#pragma unroll
        for (int ct = 0; ct < 8; ++ct)
#pragma unroll
            for (int r = 0; r < 4; ++r) { const float e = __builtin_amdgcn_exp2f(s[ct][r] - mm); s[ct][r] = e; ls += e; }
        ls += __shfl_xor(ls, 16); ls += __shfl_xor(ls, 32);
        const float inv = 1.0f / fmaxf(ls, 1e-30f);
#pragma unroll
        for (int ct = 0; ct < 8; ++ct) { s[ct] *= inv; psum[ct] += s[ct]; }
        __builtin_amdgcn_sched_barrier(0);
        f32x4 o[4];
#pragma unroll
        for (int dt = 0; dt < 4; ++dt) o[dt] = (f32x4){0.f, 0.f, 0.f, 0.f};
#pragma unroll
        for (int kk = 0; kk < 4; ++kk) {
            u32x4 pw; pw.x = pack2(s[2 * kk][0], s[2 * kk][1]); pw.y = pack2(s[2 * kk][2], s[2 * kk][3]); pw.z = pack2(s[2 * kk + 1][0], s[2 * kk + 1][1]); pw.w = pack2(s[2 * kk + 1][2], s[2 * kk + 1][3]);
            const bf16x8 pf = __builtin_bit_cast(bf16x8, pw);
#pragma unroll
            for (int dt = 0; dt < 4; ++dt) {
                const int c0 = kk * 32 + fg * 4;
                const u32x2 v0 = *(const u32x2*)(vt + lds_off128(dt * 16 + fr, c0 & ~7) + (c0 & 7) * 2);
                const u32x2 v1 = *(const u32x2*)(vt + lds_off128(dt * 16 + fr, (c0 + 16) & ~7) + (c0 & 7) * 2);
                u32x4 vv; vv.x = v0.x; vv.y = v0.y; vv.z = v1.x; vv.w = v1.y;
                o[dt] = __builtin_amdgcn_mfma_f32_16x16x32_bf16(__builtin_bit_cast(bf16x8, vv), pf, o[dt], 0, 0, 0);
            }
        }
#pragma unroll
        for (int dt = 0; dt < 4; ++dt) { u32x2 w; w.x = pack2(o[dt][0], o[dt][1]); w.y = pack2(o[dt][2], o[dt][3]); *(u32x2*)((bf16_t*)p.OC + n * 512 + hd * 64 + dt * 16 + fg * 4) = w; }
    }
    const int own = t >> 6;
    float val[8];
#pragma unroll
    for (int ct = 0; ct < 8; ++ct) {
        const float up = __shfl(psum[ct][3], (lane + 48) & 63);
        const float up0 = (ct > 0) ? __shfl(psum[ct > 0 ? ct - 1 : 0][3], (lane + 48) & 63) : 0.f;
        const float imp = (psum[ct][0] + psum[ct][1]) + (psum[ct][2] + psum[ct][3]) + (fg > 0 ? up : up0);
        const int j = ct * 4 + fg;
        const bool forced = (j == 0) || (j == own) || (j == own - 1);
        val[ct] = (j <= own) ? (imp + (forced ? 1e4f : 0.f)) : NEGF;
    }
    float* vs = (float*)(lds + 32768) + w * 512;
    __builtin_amdgcn_wave_barrier();
#pragma unroll
    for (int ct = 0; ct < 8; ++ct) vs[fr * 32 + ct * 4 + fg] = val[ct];
    __builtin_amdgcn_wave_barrier();
    int rank[8];
#pragma unroll
    for (int ct = 0; ct < 8; ++ct) rank[ct] = 0;
#pragma unroll 2
    for (int oj = 0; oj < 32; ++oj) {
        const float ov = vs[fr * 32 + oj];
#pragma unroll
        for (int ct = 0; ct < 8; ++ct) rank[ct] += (ov > val[ct] || (ov == val[ct] && oj < ct * 4 + fg)) ? 1 : 0;
    }
    __builtin_amdgcn_wave_barrier();
    unsigned bits = 0;
#pragma unroll
    for (int ct = 0; ct < 8; ++ct) if ((ct * 4 + fg <= own) && rank[ct] < 16) bits |= 1u << (ct * 4 + fg);
    bits |= (unsigned)__shfl_xor((int)bits, 16); bits |= (unsigned)__shfl_xor((int)bits, 32);
    if (fg == 0) p.SELM[(size_t)bg * SEQ + t] = bits;
}
#define MEGA_LDS (((HG3_LDS + 255) & ~255) + 16)
static_assert(HG3_LDS >= G4_LDS && HG3_LDS >= CMPA_LDS && HG3_LDS >= GEMM_LDS && HG3_LDS >= ATT_RED_OFF + 16, "LDS map");
#define GBAR() xcd_barrier(bar)

template <int LAYER>
__device__ __forceinline__ void moe_block(char* lds, int bid, int nb, const P& p, const XcdBarrier& bar, float* of, bf16_t* ob, bf16_t* ol) {
    if (bid < 32) p.cnt[bid * NEXP + tidx()] = 0;
    phase_router(bid, nb, p, LAYER);
    GBAR();
    phase_route(bid, nb, p, LAYER);
    GBAR();
    phase_scatter(lds, bid, nb, p);
    GBAR();
    phase_moe1(lds, bid, nb, p, LAYER, p.XAb);
    GBAR();
    phase_moe2(lds, bid, nb, p, LAYER);
    GBAR();
    phase_combine_ln(bid, nb, p, p.XA, p.ln_g + (LAYER * 2 + 1) * DM, p.ln_b + (LAYER * 2 + 1) * DM, of, ob, ol);
}

__global__ void __launch_bounds__(256, 2) mega(P p) {
    char* lds = dyn_lds;
    const int bid = blockIdx.x, nb = gridDim.x;
    volatile LAS unsigned* st = (volatile LAS unsigned*)(dyn_lds + MEGA_LDS - 16);
    if (tidx() == 0) { st[0] = 0u; st[1] = 0u; st[2] = 0u; st[3] = 0u; }
    __syncthreads();
    const XcdBarrier bar = xcd_barrier_post(p.bar, st);
    phase_prep(lds, bid, nb, p);
    GBAR();
    phase_inproj0(lds, bid, nb, p);
    GBAR();
    phase_mix0_a(lds, bid, nb, p);
    GBAR();
    phase_hg2(bid, nb, p);
    for (int u = nb - 1 - bid; u < 512; u += nb) lru2_unit(p, u >> 6, (u >> 1) & 31, u & 1);
    GBAR();
    phase_mix0_c(lds, bid, nb, p);
    GBAR();
    phase_gemm_f32out(bid, nb, p.MIX, p.WOUT0, DM, DM, p.T0);
    GBAR();
    phase_ln_add(bid, nb, p.x, nullptr, nullptr, p.T0, p.ln_g, p.ln_b, nullptr, p.XAb, p.XAl);
    GBAR();
    moe_block<0>(lds, bid, nb, p, bar, nullptr, p.XBb, p.XBl);
    GBAR();
    phase_inproj1(lds, bid, nb, p);
    GBAR();
    phase_cmp1(lds, bid, nb, p);
    phase_moba_kmean(bid, nb, p);
    GBAR();
    phase_cmp2(lds, bid, nb, p);
    phase_moba_gate(lds, bid, nb, p);
    GBAR();
    phase_attn_a(lds, bid, nb, p);
    GBAR();
    phase_attn_b(lds, bid, nb, p);
    GBAR();
    phase_gemm_f32out(bid, nb, p.MIX, p.WOUT1, DM, DM, p.T0);
    GBAR();
    phase_ln_add(bid, nb, nullptr, p.XBb, p.XBl, p.T0, p.ln_g + 2 * DM, p.ln_b + 2 * DM, nullptr, p.XAb, p.XAl);
    GBAR();
    moe_block<1>(lds, bid, nb, p, bar, p.out, nullptr, nullptr);
}

static inline size_t al256(size_t x) { return (x + 255) & ~(size_t)255; }

extern "C" void kernel_launch(void* const* d_in, const int* in_sizes, int n_in, void* d_out, int out_size, void* d_ws, size_t ws_size, hipStream_t stream) {
    P p{};
    const float** ip = (const float**)&p.x;
    for (int i = 0; i < 30; ++i) ip[i] = (const float*)d_in[i];
    p.out = (float*)d_out;
    char* w = (char*)d_ws; size_t o = 0;
    auto take = [&](size_t bytes) { char* r = w + o; o = al256(o + bytes); return r; };
    p.bar = (unsigned*)take(XCD_BAR_WORDS * 4);
    p.U = (float*)take((size_t)NTOK * EVEN_IN * 4);
    p.MIX = (bf16_t*)take((size_t)NTOK * DM * 2);
    p.T0 = (float*)take((size_t)NTOK * DM * 4);
    p.XA = (float*)take((size_t)NTOK * DM * 4); p.XAb = (bf16_t*)take((size_t)NTOK * DM * 2); p.XAl = (bf16_t*)take((size_t)NTOK * DM * 2); p.XBl = (bf16_t*)take((size_t)NTOK * DM * 2);
    p.XB = (float*)take((size_t)NTOK * DM * 4); p.XBb = (bf16_t*)take((size_t)NTOK * DM * 2);
    p.LOG = (float*)take((size_t)3 * NTOK * NEXP * 4);
    p.eidx = (int*)take(NTOK * 8 * 4); p.ew = (float*)take(NTOK * 8 * 4); p.erank = (int*)take(NTOK * 8 * 4); p.epos = (int*)take(NTOK * 8 * 4);
    p.cnt = (int*)take(32 * NEXP * 4); p.tile_e = (int*)take(NTILES * 4); p.rowtok = (int*)take(NROWS * 4);
    p.H = (bf16_t*)take((size_t)NROWS * 256 * 2);
    p.Y = (bf16_t*)take((size_t)NROWS * DM * 2);
    p.LA = (float*)take((size_t)NTOK * 512 * 4); p.LB = (float*)take((size_t)NTOK * 512 * 4);
    p.KC = (float*)take(16 * 127 * 64 * 4); p.VC = (float*)take(16 * 127 * 64 * 4);
    p.OC = (float*)take((size_t)NTOK * 512 * 4);
    p.SELM = (unsigned*)take(16 * SEQ * 4);
    p.KM = (float*)take(8 * 8 * 8 * 64 * 4);
    p.Qb = (bf16_t*)take((size_t)NTOK * 512 * 2); p.KS = (bf16_t*)take((size_t)NTOK * 128 * 2); p.VSt = (bf16_t*)take((size_t)NTOK * 128 * 2);
    p.KW = (bf16_t*)take((size_t)NTOK * 128 * 2); p.VWt = (bf16_t*)take((size_t)NTOK * 128 * 2);
    p.MQ = (bf16_t*)take((size_t)NTOK * 512 * 2); p.MK = (bf16_t*)take((size_t)NTOK * 512 * 2); p.MVt = (bf16_t*)take((size_t)NTOK * 512 * 2);
    p.KCV = (float*)take((size_t)NTOK * 256 * 4); p.GATES = (float*)take((size_t)NTOK * 24 * 4); p.OS = (float*)take((size_t)NTOK * 512 * 4);
    p.MSEL = (unsigned*)take(64 * SEQ * 4);
    p.UB0 = (bf16_t*)take((size_t)NTOK * 2560 * 2); p.VHt = (bf16_t*)take((size_t)NTOK * 512 * 2);
    p.WAT = (bf16_t*)take(8 * 64 * 64 * 2); p.WXT = (bf16_t*)take(8 * 64 * 64 * 2);
    p.CSA = (float*)take(8 * 32 * 512 * 4); p.CSB = (float*)take(8 * 32 * 512 * 4);
    p.UT = (bf16_t*)take((size_t)1024 * 16384 * 2); p.SP = (bf16_t*)take((size_t)1024 * 16384 * 2);
    p.DV = (float*)take(1024 * 128 * 4);
    p.XIb = (bf16_t*)take((size_t)NTOK * DM * 2);
    p.plist = (int*)take(8 * 320 * 4); p.plen = (int*)take(64);
    p.WIN0 = (bf16_t*)take((size_t)EVEN_IN * DM * 2); p.WOUT0 = (bf16_t*)take((size_t)DM * DM * 2); p.WIN1 = (bf16_t*)take((size_t)2944 * DM * 2); p.WOUT1 = (bf16_t*)take((size_t)DM * DM * 2);
    p.WRH = (bf16_t*)take((size_t)2 * NEXP * DM * 2); p.WRL = (bf16_t*)take((size_t)2 * NEXP * DM * 2);
    p.HID = (float*)take((size_t)4 * 2 * 2048 * 128 * 4); p.KCb = (bf16_t*)take(16 * 128 * 64 * 2); p.VCt = (bf16_t*)take(16 * 64 * 128 * 2);
    if (o > ws_size) return;

    static int grid = 0;
    if (!grid) {
        int dev = 0, cus = 0, per_cu = 0;
        (void)hipGetDevice(&dev);
        (void)hipDeviceGetAttribute(&cus, hipDeviceAttributeMultiprocessorCount, dev);
        (void)hipFuncSetAttribute((const void*)mega, hipFuncAttributeMaxDynamicSharedMemorySize, MEGA_LDS);
        (void)hipOccupancyMaxActiveBlocksPerMultiprocessor(&per_cu, (const void*)mega, 256, MEGA_LDS);
        if (per_cu < 1) per_cu = 1;
        grid = cus * (per_cu < 2 ? per_cu : 2);
    }
    (void)hipMemsetAsync(p.bar, 0, XCD_BAR_WORDS * 4, stream);
    hipLaunchKernelGGL(mega, dim3(grid), dim3(256), MEGA_LDS, stream, p);
}
```

```cpp
#include <hip/hip_runtime.h>
#include <hip/hip_bf16.h>
#include <stdint.h>

#define NTOK 16384
#define DM 1024
#define SEQ 2048
#define NBATCH 8
#define EVEN_IN 3072
#define ODD_IN 2840
#define NEXP 256
#define NEGF (-1e30f)
#define LOG2E 1.4426950408889634f
#define DN_ALPHA 1.4142135623730951f
#define LN_EPS 1e-5f
#define MAXRT 1280
#define SH_TILE0 1280
#define NTILES (1280 + 128)
#define NROWS (NTILES * 128)

typedef unsigned short bf16_t;
typedef short bf16x8 __attribute__((ext_vector_type(8)));
typedef float f32x4 __attribute__((ext_vector_type(4)));
typedef unsigned u32x4 __attribute__((ext_vector_type(4)));
typedef unsigned u32x2 __attribute__((ext_vector_type(2)));
extern __shared__ __attribute__((aligned(16))) char dyn_lds[];
#define LAS __attribute__((address_space(3)))

__device__ __forceinline__ int tidx() { int t = threadIdx.x; asm volatile("" : "+v"(t)); return t; }
__device__ __forceinline__ float wave_sum(float v) {
#pragma unroll
    for (int o = 32; o >= 1; o >>= 1) v += __shfl_xor(v, o);
    return v;
}
__device__ __forceinline__ float wave_max(float v) {
#pragma unroll
    for (int o = 32; o >= 1; o >>= 1) v = fmaxf(v, __shfl_xor(v, o));
    return v;
}
typedef __bf16 hwbf16x2 __attribute__((ext_vector_type(2)));
typedef float f32x2 __attribute__((ext_vector_type(2)));
__device__ __forceinline__ unsigned f2bf(float f) { const __bf16 h = (__bf16)f; return (unsigned)__builtin_bit_cast(unsigned short, h); }
__device__ __forceinline__ float bf2f(unsigned b) { return __uint_as_float(b << 16); }
__device__ __forceinline__ unsigned pack2(float lo, float hi) { const f32x2 f = {lo, hi}; const hwbf16x2 v = __builtin_convertvector(f, hwbf16x2); return __builtin_bit_cast(unsigned, v); }
__device__ __forceinline__ float sigmoidf_(float x) { return 1.0f / (1.0f + __expf(-x)); }
__device__ __forceinline__ float siluf_(float x) { return x / (1.0f + __expf(-x)); }
__device__ __forceinline__ float gelu_tanh(float x) {
    const float u2 = 1.5957691216057308f * (x + 0.044715f * x * x * x);
    return x / (1.0f + __expf(-u2));
}


#define XB_TMO      128
#define XB_XCNT(j)  (256  + 64 * (j))
#define XB_XSUB(j)  (1280 + 64 * (j))
#define XB_XGEN(j)  (2304 + 64 * (j))
#define XB_TOP      3328
#define XB_TOPGEN   3392
#define XCD_BAR_WORDS 3456
#define XB_SPIN_CAP (1u << 18)
__device__ __forceinline__ unsigned xb_ld(unsigned* p)              { return __hip_atomic_load(p, __ATOMIC_RELAXED, __HIP_MEMORY_SCOPE_AGENT); }
__device__ __forceinline__ unsigned xb_add(unsigned* p, unsigned v) { return __hip_atomic_fetch_add(p, v, __ATOMIC_RELAXED, __HIP_MEMORY_SCOPE_AGENT); }
__device__ __forceinline__ unsigned xb_xcc_id() { return (unsigned)__builtin_amdgcn_s_getreg((3 << 11) | 20) & 0xFu; }
#define XB_SPIN(cond, bar) do { unsigned _sp = 0; while (cond) { __builtin_amdgcn_s_sleep(1); \
    if ((++_sp & 255u) == 0u) { if (xb_ld(&(bar)[XB_TMO])) break; if (_sp > XB_SPIN_CAP) { atomicAdd(&(bar)[XB_TMO], 1u); break; } } } } while (0)
struct XcdBarrier { unsigned* bar; unsigned x; volatile LAS unsigned* st; };
__device__ __forceinline__ XcdBarrier xcd_barrier_post(unsigned* bar, volatile LAS unsigned* st) {
    XcdBarrier b; b.bar = bar; b.x = xb_xcc_id(); b.st = st;
    if (tidx() == 0) (void)xb_add(&bar[XB_XCNT(b.x)], 1u);
    return b;
}
__device__ __forceinline__ void xcd_barrier_complete(unsigned* bar, unsigned x, unsigned& nloc, unsigned& nx) {
    const unsigned G = gridDim.x * gridDim.y * gridDim.z;
    unsigned sum, cnt, mine, sp = 0u;
    for (;;) {
        sum = 0u; cnt = 0u; mine = 0u;
#pragma unroll
        for (unsigned j = 0; j < 16; ++j) { const unsigned c = xb_ld(&bar[XB_XCNT(j)]); sum += c; cnt += (c > 0u) ? 1u : 0u; mine = (j == x) ? c : mine; }
        if (sum == G) break;
        __builtin_amdgcn_s_sleep(1);
        if ((++sp & 255u) == 0u) { if (xb_ld(&bar[XB_TMO])) break; if (sp > XB_SPIN_CAP) { atomicAdd(&bar[XB_TMO], 1u); break; } }
    }
    nloc = mine > 0u ? mine : 1u; nx = cnt > 0u ? cnt : 1u;
}
__device__ __forceinline__ void xcd_barrier(const XcdBarrier& b) {
    asm volatile("s_waitcnt vmcnt(0)" ::: "memory");
    __syncthreads();
    if (tidx() == 0) {
        unsigned* bar = b.bar;
        __builtin_amdgcn_s_waitcnt(0);
        unsigned nloc = b.st[0], nx = b.st[1];
        if (nloc == 0u) { xcd_barrier_complete(bar, b.x, nloc, nx); b.st[0] = nloc; b.st[1] = nx; }
        const unsigned old = xb_add(&bar[XB_XSUB(b.x)], 1u);
        const unsigned gen = old / nloc;
        if (old + 1u == (gen + 1u) * nloc) {
            __builtin_amdgcn_fence(__ATOMIC_RELEASE, "agent");
            asm volatile("s_waitcnt vmcnt(0)" ::: "memory");
            const unsigned og = xb_add(&bar[XB_TOP], 1u);
            const unsigned tg = og / nx;
            if (og + 1u == (tg + 1u) * nx) xb_add(&bar[XB_TOPGEN], 1u);
            else XB_SPIN(xb_ld(&bar[XB_TOPGEN]) == tg, bar);
            __builtin_amdgcn_fence(__ATOMIC_ACQUIRE, "agent");
            xb_add(&bar[XB_XGEN(b.x)], 1u);
            asm volatile("s_waitcnt vmcnt(0)" ::: "memory");
        } else {
            XB_SPIN(xb_ld(&bar[XB_XGEN(b.x)]) == gen, bar);
            __builtin_amdgcn_fence(__ATOMIC_ACQUIRE, "agent");
            asm volatile("s_waitcnt vmcnt(0)" ::: "memory");
        }
    }
    __syncthreads();
}

struct P {
    const float *x, *even_w_in, *conv_w, *conv_b, *wa, *ba, *wx, *bx, *lam, *hg_lb, *hg_ng, *even_w_out;
    const float *odd_w_in, *pe_k, *pe_v, *wk1, *wk2, *wv1, *wv2, *odd_w_out, *ln_g, *ln_b, *w_router, *b_router;
    const float *w_gate, *w_up, *w_down, *ws_gate, *ws_up, *ws_down;
    float* out;
    float* U;
    bf16_t* MIX;
    float* T0;
    float* XA; bf16_t* XAb; float* XB; bf16_t* XBb; bf16_t* XAl; bf16_t* XBl;
    float* LOG;
    int* eidx; float* ew; int* erank; int* epos;
    int* cnt;
    int* tile_e;
    int* rowtok;
    bf16_t* H;
    bf16_t* Y;
    float* LA; float* LB;
    float* KC; float* VC;
    float* OC;
    unsigned* SELM;
    float* KM;
    unsigned* bar;
    bf16_t *Qb, *KS, *VSt, *KW, *VWt, *MQ, *MK, *MVt;
    float *KCV, *GATES, *OS; unsigned* MSEL;
    bf16_t *UB0;
    bf16_t *VHt;
    bf16_t *WAT, *WXT;
    float *CSA, *CSB;
    bf16_t *UT, *SP;
    float *DV;
    float *HID;
    bf16_t *KCb, *VCt;
    bf16_t *XIb;
    int *plist; int *plen;
    bf16_t *WIN0, *WOUT0, *WIN1, *WOUT1, *WRH, *WRL;
};

__device__ __forceinline__ int lds_off(int r, int c) {
    const int st = (r >> 4) * 2 + (c >> 5), ob = (r & 15) * 64 + (c & 31) * 2;
    return st * 1024 + (ob ^ (((ob >> 9) & 1) << 5));
}
#define GEMM_LDS 32768

__device__ __forceinline__ float cvt_part(float v, int lo) { return lo ? (v - bf2f(f2bf(v))) : v; }

struct BLoadF32 {
    const float* bp; int ldb; bool valid; int nk1;
    struct Regs { f32x4 v[8]; };
    __device__ __forceinline__ void load(int kt, Regs& R) const {
        const float* p = bp + (size_t)((kt % nk1) * 64) * ldb;
#pragma unroll
        for (int j = 0; j < 8; ++j) R.v[j] = valid ? *(const f32x4*)(p + (size_t)j * ldb) : (f32x4){0.f, 0.f, 0.f, 0.f};
    }
    __device__ __forceinline__ void store(int kt, const Regs& R, char* lds) const {
        const int lo = (kt / nk1) == 1;
        const int nq = tidx() & 31, kg = tidx() >> 5;
#pragma unroll
        for (int i = 0; i < 4; ++i) {
            u32x4 w;
            w.x = pack2(cvt_part(R.v[0][i], lo), cvt_part(R.v[1][i], lo)); w.y = pack2(cvt_part(R.v[2][i], lo), cvt_part(R.v[3][i], lo));
            w.z = pack2(cvt_part(R.v[4][i], lo), cvt_part(R.v[5][i], lo)); w.w = pack2(cvt_part(R.v[6][i], lo), cvt_part(R.v[7][i], lo));
            *(u32x4*)(lds + lds_off(nq * 4 + i, kg * 8)) = w;
        }
    }
};

template <class AL, class BL>
__device__ __forceinline__ void gemm_tile(char* lds, const AL& al, const BL& bl, int nk, f32x4 (&acc)[4][4], bool swap = false) {
    const int lane = tidx() & 63, wid = tidx() >> 6, wr = wid >> 1, wc = wid & 1, fr = lane & 15, fq = lane >> 4;
    char* ldsA = lds; char* ldsB = lds + 16384;
    const char* t2 = swap ? ldsB : ldsA; const char* t1 = swap ? ldsA : ldsB; const int w2 = swap ? wc : wr, w1 = swap ? wr : wc;
#pragma unroll
    for (int m = 0; m < 4; ++m)
#pragma unroll
        for (int n = 0; n < 4; ++n) acc[m][n] = (f32x4){0.f, 0.f, 0.f, 0.f};
    typename AL::Regs ra; typename BL::Regs rb;
    al.load(0, ra); bl.load(0, rb);
    for (int kt = 0; kt < nk; ++kt) {
        __syncthreads();
        al.store(kt, ra, ldsA); bl.store(kt, rb, ldsB);
        __syncthreads();
        if (kt + 1 < nk) { al.load(kt + 1, ra); bl.load(kt + 1, rb); }
#pragma unroll
        for (int kk = 0; kk < 2; ++kk) {
            bf16x8 a[4], b[4];
#pragma unroll
            for (int m = 0; m < 4; ++m) a[m] = *(const bf16x8*)(t2 + lds_off(w2 * 64 + m * 16 + fr, kk * 32 + fq * 8));
#pragma unroll
            for (int n = 0; n < 4; ++n) b[n] = *(const bf16x8*)(t1 + lds_off(w1 * 64 + n * 16 + fr, kk * 32 + fq * 8));
#pragma unroll
            for (int m = 0; m < 4; ++m)
#pragma unroll
                for (int n = 0; n < 4; ++n) acc[m][n] = __builtin_amdgcn_mfma_f32_16x16x32_bf16(b[n], a[m], acc[m][n], 0, 0, 0);
        }
    }
}


__device__ __forceinline__ void dma_rc(int lane, int st, int& R, int& C) {
    const int sb = lane * 16, swz = sb ^ (((sb >> 9) & 1) << 5);
    R = (st >> 1) * 16 + (swz >> 6); C = (st & 1) * 32 + ((swz & 63) >> 1);
}
#define G3_STAGE 24576
#define G3_LDS (2 * G3_STAGE)
__device__ __forceinline__ int t32_off(int r, int c) { const int ob = (r & 15) * 64 + c * 2; return (r >> 4) * 1024 + (ob ^ (((ob >> 9) & 1) << 5)); }
__device__ __forceinline__ void dma_rc32(int lane, int st, int& R, int& C) { const int sb = lane * 16, swz = sb ^ (((sb >> 9) & 1) << 5); R = st * 16 + (swz >> 6); C = (swz & 63) >> 1; }
struct Dma3A {
    static constexpr int NV = 4;
    const char* base; unsigned voff[4];
    const char* lo = nullptr; int nk1 = 1 << 30;
    __device__ __forceinline__ void set_dense(const bf16_t* b0, int row0, int ld) {
        base = (const char*)b0; const int lane = tidx() & 63, w = tidx() >> 6;
#pragma unroll
        for (int i = 0; i < 4; ++i) { int R, C; dma_rc32(lane, w + 4 * i, R, C); voff[i] = (unsigned)(((size_t)(row0 + R) * ld + C) * 2); }
    }
    template <int SET = 0> __device__ __forceinline__ void issue(int kt, int ldsoff) const {
        const int w = tidx() >> 6;
#pragma unroll
        for (int i = 0; i < 4; ++i)
            __builtin_amdgcn_global_load_lds((const unsigned*)((((kt / nk1) == 2) ? lo : base) + voff[i] + (size_t)(kt % nk1) * 64), (LAS unsigned*)((LAS char*)dyn_lds + ldsoff + (w + 4 * i) * 1024), 16, 0, 0);
    }
    template <int SET = 0> __device__ __forceinline__ void commit(int, int) const {}
};
struct Dma3B {
    static constexpr int LAYOUT = 0, NV = 2;
    const char* hi; const char* lo; unsigned voff[2]; int nk1;
    __device__ __forceinline__ void set(const bf16_t* h, const bf16_t* l, int row0, int ld, int nk1_) {
        hi = (const char*)h; lo = (const char*)l; nk1 = nk1_; const int lane = tidx() & 63, w = tidx() >> 6;
#pragma unroll
        for (int i = 0; i < 2; ++i) { int R, C; dma_rc32(lane, w + 4 * i, R, C); const int Rs = (R & ~31) + 8 * ((R & 15) >> 2) + 4 * ((R >> 4) & 1) + (R & 3);
            voff[i] = (unsigned)(((size_t)(row0 + Rs) * ld + C) * 2); }
    }
    template <int SET = 0> __device__ __forceinline__ void issue(int kt, int ldsoff) const {
        const int w = tidx() >> 6; const char* base = ((kt / nk1) == 1) ? lo : hi; const size_t ko = (size_t)(kt % nk1) * 64;
#pragma unroll
        for (int i = 0; i < 2; ++i)
            __builtin_amdgcn_global_load_lds((const unsigned*)(base + voff[i] + ko), (LAS unsigned*)((LAS char*)dyn_lds + ldsoff + (w + 4 * i) * 1024), 16, 0, 0);
    }
    template <int SET = 0> __device__ __forceinline__ void commit(int, int) const {}
};
struct Reg3B {
    static constexpr int LAYOUT = 1, NV = 4;
    const float* bp; int ldb; f32x4 v[2][4]; int perm64 = 0;
    template <int SET = 0> __device__ __forceinline__ void issue(int kt, int) {
        const float* p = bp + (size_t)(kt * 32) * ldb;
#pragma unroll
        for (int j = 0; j < 4; ++j) v[SET][j] = *(const f32x4*)(p + (size_t)j * ldb);
    }
    template <int SET = 0> __device__ __forceinline__ void commit(int, int ldsoff) const {
        const int tid = tidx(), nq = tid & 31, kg = tid >> 5;
        u32x2 w[4];
#pragma unroll
        for (int i = 0; i < 4; ++i) { w[i].x = pack2(v[SET][0][i], v[SET][1][i]); w[i].y = pack2(v[SET][2][i], v[SET][3][i]); }
        const int q = nq & 7, q16 = nq & 15;
        const int rowbase = perm64 ? ((nq >> 4) * 64 + (q16 & 3) * 16 + (q16 >> 2) * 4) : ((nq >> 3) * 32 + (q & 1) * 16 + (q >> 1) * 4);
        const int rot = perm64 ? (q16 & 3) : ((q & 1) + 2 * ((q >> 2) & 1));
#pragma unroll
        for (int i = 0; i < 4; ++i) {
            const int e = (i + rot) & 3;
            u32x2 d;
            d.x = e == 0 ? w[0].x : (e == 1 ? w[1].x : (e == 2 ? w[2].x : w[3].x));
            d.y = e == 0 ? w[0].y : (e == 1 ? w[1].y : (e == 2 ? w[2].y : w[3].y));
            *(u32x2*)(dyn_lds + ldsoff + ((((kg >> 1) * 128 + rowbase + e) << 4) + (kg & 1) * 8)) = d;
        }
    }
};
#define G4_LDS (3 * G3_STAGE)
template <class AL, class BL, int PAR>
__device__ __forceinline__ void g4_step(AL& al, BL& bl, int kt, int nk, f32x4 (&acc)[32], bool idle) {
    constexpr int NV = AL::NV + BL::NV;
    const int lane = tidx() & 63, wid = tidx() >> 6, wr = wid >> 1, wc = wid & 1, fr = lane & 15, fq = lane >> 4;
    const int s0 = kt % 3, cur = s0 * G3_STAGE, nx1 = (s0 == 2 ? 0 : s0 + 1) * G3_STAGE, nx2 = (s0 == 0 ? 2 : s0 - 1) * G3_STAGE;
    if (kt + 1 < nk) asm volatile("s_waitcnt vmcnt(%0) lgkmcnt(0)" :: "n"(NV) : "memory");
    else asm volatile("s_waitcnt vmcnt(0) lgkmcnt(0)" ::: "memory");
    __builtin_amdgcn_s_barrier();
    asm volatile("" ::: "memory");
    if (kt + 2 < nk) { al.template issue<PAR>(kt + 2, nx2); bl.template issue<PAR>(kt + 2, nx2 + 16384); }
    if (!idle) {
    bf16x8 sm[4];
#pragma unroll
    for (int j = 0; j < 4; ++j) sm[j] = *(const bf16x8*)(dyn_lds + cur + 16384 + (BL::LAYOUT == 1 ? ((fq * 128 + wc * 64 + j * 16 + fr) << 4) : t32_off(wc * 64 + j * 16 + fr, fq * 8)));
    bf16x8 bigc = *(const bf16x8*)(dyn_lds + cur + t32_off(wr * 128 + fr, fq * 8));
#pragma unroll
    for (int i = 0; i < 8; ++i) {
        bf16x8 bign = bigc;
        if (i < 7) bign = *(const bf16x8*)(dyn_lds + cur + t32_off(wr * 128 + (i + 1) * 16 + fr, fq * 8));
        __builtin_amdgcn_sched_barrier(0);
#pragma unroll
        for (int j = 0; j < 4; ++j) acc[i * 4 + j] = __builtin_amdgcn_mfma_f32_16x16x32_bf16(sm[j], bigc, acc[i * 4 + j], 0, 0, 0);
        __builtin_amdgcn_sched_barrier(0);
        bigc = bign;
    }
    }
    if (kt + 1 < nk) bl.template commit<PAR ^ 1>(kt + 1, nx1 + 16384);
}
template <class AL, class BL>
__device__ __forceinline__ void gemm_core4(AL& al, BL& bl, int nk, f32x4 (&acc)[32], bool idle_hi = false) {
    const bool idle = idle_hi && (tidx() >> 7);
#pragma unroll
    for (int i = 0; i < 32; ++i) acc[i] = (f32x4){0.f, 0.f, 0.f, 0.f};
    al.template issue<0>(0, 0); bl.template issue<0>(0, 16384);
    if (nk > 1) { al.template issue<1>(1, G3_STAGE); bl.template issue<1>(1, G3_STAGE + 16384); }
    bl.template commit<0>(0, 16384);
    for (int kt = 0; kt < nk; kt += 2) {
        g4_step<AL, BL, 0>(al, bl, kt, nk, acc, idle);
        if (kt + 1 < nk) g4_step<AL, BL, 1>(al, bl, kt + 1, nk, acc, idle);
    }
    __syncthreads();
}
__device__ __forceinline__ bool dense_unit3(int bid, int nb, int j, int ntn, int& tm, int& tn) {
    if ((nb & 7) == 0) {
        const int x = bid & 7, r = bid >> 3, R = nb >> 3;
        const int li = r + R * j;
        if (li >= 8 * ntn) return false;
        tn = li >> 3; tm = x * 8 + (li & 7);
        return true;
    }
    const int u = bid + nb * j;
    if (u >= 64 * ntn) return false;
    tm = u / ntn; tn = u % ntn; return true;
}
__device__ __forceinline__ void prep_tile(char* lds, const float* W, int ldw, int k0, int scol0, bool colvalid, bf16_t* Bt, int K, int drow0, int mode) {
    const int tid = tidx();
    bf16_t* t = (bf16_t*)lds;
    __syncthreads();
#pragma unroll
    for (int i = 0; i < 4; ++i) {
        const int k = (tid >> 4) + 16 * i, q = tid & 15;
        f32x4 v = colvalid ? *(const f32x4*)(W + (size_t)(k0 + k) * ldw + scol0 + q * 4) : (f32x4){0.f, 0.f, 0.f, 0.f};
#pragma unroll
        for (int e = 0; e < 4; ++e) { float x = v[e]; if (mode == 2) x = x - bf2f(f2bf(x)); t[(q * 4 + e) * 72 + k] = (bf16_t)f2bf(x); }
    }
    __syncthreads();
#pragma unroll
    for (int i = 0; i < 2; ++i) { const int pc = tid + 256 * i, n = pc >> 3, ch = pc & 7;
        *(u32x4*)(Bt + (size_t)(drow0 + n) * K + k0 + ch * 8) = *(const u32x4*)(t + n * 72 + ch * 8); }
}
__device__ __forceinline__ int vcol_actual(int v);
__device__ __forceinline__ void phase_prep(char* lds, int bid, int nb, const P& p) {
    const int tid = tidx();
    for (size_t i = (size_t)bid * 256 + tid; i < (size_t)NTOK * DM / 8; i += (size_t)nb * 256) {
        const f32x4 a = *(const f32x4*)(p.x + i * 8), b = *(const f32x4*)(p.x + i * 8 + 4);
        u32x4 w; w.x = pack2(a[0], a[1]); w.y = pack2(a[2], a[3]); w.z = pack2(b[0], b[1]); w.w = pack2(b[2], b[3]);
        *(u32x4*)(p.XIb + i * 8) = w;
    }
    for (int u = bid; u < 2272; u += nb) {
        if (u < 768) { const int nt = u >> 4, kt = u & 15; const int d = nt * 64; const int sc = d < 2048 ? d : (d < 2560 ? d + 512 : d - 512);
            prep_tile(lds, p.even_w_in, EVEN_IN, kt * 64, sc, true, p.WIN0, DM, d, 0); }
        else if (u < 1024) { const int v = u - 768, nt = v >> 4, kt = v & 15; prep_tile(lds, p.even_w_out, DM, kt * 64, nt * 64, true, p.WOUT0, DM, nt * 64, 0); }
        else if (u < 1760) { const int v = u - 1024, nt = v >> 4, kt = v & 15; const int d = nt * 64;
            int sc; bool ok = true;
            if (d < 896) sc = d; else if (d < 1024) sc = d + 128; else if (d < 1536) sc = d + 280; else if (d < 2048) sc = d + 280;
            else if (d < 2112) sc = 1280; else if (d < 2176) { sc = 0; ok = false; } else if (d < 2304) sc = d - 1280; else if (d < 2432) sc = d - 1152; else sc = d - 104;
            prep_tile(lds, p.odd_w_in, ODD_IN, kt * 64, sc, ok, p.WIN1, DM, d, 0); }
        else if (u < 2016) { const int v = u - 1760, nt = v >> 4, kt = v & 15; prep_tile(lds, p.odd_w_out, DM, kt * 64, nt * 64, true, p.WOUT1, DM, nt * 64, 0); }
        else { const int v = u - 2016, layer = v >> 7, lo = (v >> 6) & 1, nt = (v >> 4) & 3, kt = v & 15;
            prep_tile(lds, p.w_router + (size_t)layer * DM * NEXP, NEXP, kt * 64, nt * 64, true, (lo ? p.WRL : p.WRH) + (size_t)layer * NEXP * DM, DM, nt * 64, lo ? 2 : 1); }
    }
    __syncthreads();
}


__device__ __forceinline__ void phase_gemm_f32out(int bid, int nb, const bf16_t* A, const bf16_t* Bt, int N, int K, float* C) {
    const int ntn = N / 128;
    const int tid = tidx(), lane = tid & 63, wid = tid >> 6, wr = wid >> 1, wc = wid & 1, fr = lane & 15, fq = lane >> 4;
    for (int j = 0;; ++j) {
        int tm, tn; if (!dense_unit3(bid, nb, j, ntn, tm, tn)) break;
        Dma3A al; al.set_dense(A, tm * 256, K); Dma3B bl; bl.set(Bt, Bt, tn * 128, K, 1 << 30);
        f32x4 acc[32];
        gemm_core4(al, bl, K / 32, acc);
#pragma unroll
        for (int i = 0; i < 8; ++i)
#pragma unroll
            for (int gg = 0; gg < 2; ++gg) { const f32x4 a = acc[i * 4 + 2 * gg], b2 = acc[i * 4 + 2 * gg + 1];
                u32x4 w; w.x = pack2(a[0], a[1]); w.y = pack2(a[2], a[3]); w.z = pack2(b2[0], b2[1]); w.w = pack2(b2[2], b2[3]);
                *(u32x4*)((bf16_t*)C + (size_t)(tm * 256 + wr * 128 + i * 16 + fr) * N + tn * 128 + wc * 64 + gg * 32 + fq * 8) = w; }
    }
}
__device__ __forceinline__ void phase_router(int bid, int nb, const P& p, int layer) {
    const int tid = tidx(), lane = tid & 63, wid = tid >> 6, wr = wid >> 1, wc = wid & 1, fr = lane & 15, fq = lane >> 4;
    for (int j = 0;; ++j) {
        int tm, t6; if (!dense_unit3(bid, nb, j, 6, tm, t6)) break;
        const int tn = t6 & 1, part = t6 >> 1;
        Dma3A al; al.set_dense(part == 2 ? p.XAl : p.XAb, tm * 256, DM);
        const bf16_t* wsrc = (part == 1 ? p.WRL : p.WRH) + (size_t)layer * NEXP * DM;
        Dma3B bl; bl.set(wsrc, wsrc, tn * 128, DM, 1 << 30);
        f32x4 acc[32];
        gemm_core4(al, bl, 32, acc);
        float* dst = p.LOG + (size_t)part * NTOK * NEXP;
#pragma unroll
        for (int i = 0; i < 8; ++i)
#pragma unroll
            for (int gg = 0; gg < 2; ++gg) { float* q = dst + (size_t)(tm * 256 + wr * 128 + i * 16 + fr) * NEXP + tn * 128 + wc * 64 + gg * 32 + fq * 8;
                *(f32x4*)q = acc[i * 4 + 2 * gg]; *(f32x4*)(q + 4) = acc[i * 4 + 2 * gg + 1]; }
    }
}
__device__ __forceinline__ void ln_row_store(float (&v)[16], const float* g, const float* b, float* of, bf16_t* ob, int row, int lane, bf16_t* ol = nullptr) {
    float s = 0.f;
#pragma unroll
    for (int i = 0; i < 16; ++i) s += v[i];
    const float mu = wave_sum(s) * (1.0f / DM);
    float q = 0.f;
#pragma unroll
    for (int i = 0; i < 16; ++i) { const float d = v[i] - mu; q += d * d; }
    const float rstd = rsqrtf(wave_sum(q) * (1.0f / DM) + LN_EPS);
#pragma unroll
    for (int h = 0; h < 2; ++h) {
        const int c0 = h * 512 + lane * 8;
        float o[8];
#pragma unroll
        for (int i = 0; i < 8; ++i) o[i] = (v[h * 8 + i] - mu) * rstd * g[c0 + i] + b[c0 + i];
        if (of) { *(f32x4*)(of + (size_t)row * DM + c0) = (f32x4){o[0], o[1], o[2], o[3]};
                  *(f32x4*)(of + (size_t)row * DM + c0 + 4) = (f32x4){o[4], o[5], o[6], o[7]}; }
        if (ob) { u32x4 w; w.x = pack2(o[0], o[1]); w.y = pack2(o[2], o[3]); w.z = pack2(o[4], o[5]); w.w = pack2(o[6], o[7]); *(u32x4*)(ob + (size_t)row * DM + c0) = w;
            if (ol) { float l[8];
#pragma unroll
                for (int i = 0; i < 8; ++i) l[i] = o[i] - bf2f(f2bf(o[i]));
                u32x4 wl; wl.x = pack2(l[0], l[1]); wl.y = pack2(l[2], l[3]); wl.z = pack2(l[4], l[5]); wl.w = pack2(l[6], l[7]); *(u32x4*)(ol + (size_t)row * DM + c0) = wl; } }
    }
}
__device__ __forceinline__ void phase_ln_add(int bid, int nb, const float* res, const bf16_t* resh, const bf16_t* resl, const float* add, const float* g, const float* b, float* of, bf16_t* ob, bf16_t* ol) {
    const int lane = tidx() & 63, wid = tidx() >> 6;
    for (int row = bid * 4 + wid; row < NTOK; row += nb * 4) {
        float v[16];
#pragma unroll
        for (int h = 0; h < 2; ++h) {
            const size_t o = (size_t)row * DM + h * 512 + lane * 8;
            f32x4 r0, r1;
            if (res) { r0 = *(const f32x4*)(res + o); r1 = *(const f32x4*)(res + o + 4); }
            else { const u32x4 xh = *(const u32x4*)(resh + o);
                r0[0] = bf2f(xh.x & 0xffffu); r0[1] = bf2f(xh.x >> 16); r0[2] = bf2f(xh.y & 0xffffu); r0[3] = bf2f(xh.y >> 16);
                r1[0] = bf2f(xh.z & 0xffffu); r1[1] = bf2f(xh.z >> 16); r1[2] = bf2f(xh.w & 0xffffu); r1[3] = bf2f(xh.w >> 16); }
            const u32x4 ab = *(const u32x4*)((const bf16_t*)add + o);
            const float a0[4] = {bf2f(ab.x & 0xffffu), bf2f(ab.x >> 16), bf2f(ab.y & 0xffffu), bf2f(ab.y >> 16)};
            const float a1[4] = {bf2f(ab.z & 0xffffu), bf2f(ab.z >> 16), bf2f(ab.w & 0xffffu), bf2f(ab.w >> 16)};
#pragma unroll
            for (int i = 0; i < 4; ++i) { v[h * 8 + i] = DN_ALPHA * r0[i] + a0[i]; v[h * 8 + 4 + i] = DN_ALPHA * r1[i] + a1[i]; }
        }
        ln_row_store(v, g, b, of, ob, row, lane, ol);
    }
}

__device__ __forceinline__ void phase_route(int bid, int nb, const P& p, int layer) {
    const float* br = p.b_router + layer * NEXP;
    const int tid = tidx(), lane = tid & 63, wid = tid >> 6;
    const int gt = bid * 256 + tid, gs = nb * 256;
    for (int i = gt; i < NROWS; i += gs) p.rowtok[i] = (i >= SH_TILE0 * 128) ? (i - SH_TILE0 * 128) : 0;
    const f32x4 bv = *(const f32x4*)(br + lane * 4);
    for (int tb = bid * 4 + wid; tb < NTOK; tb += nb * 4 * 8) {
        int es[8]; float ws[8];
#pragma unroll
        for (int q = 0; q < 8; ++q) {
            const int t = tb + q * nb * 4;
            es[q] = 0; ws[q] = 0.f;
            if (t < NTOK) {
        const f32x4 lg = (*(const f32x4*)(p.LOG + (size_t)t * NEXP + lane * 4) + *(const f32x4*)(p.LOG + (size_t)NTOK * NEXP + (size_t)t * NEXP + lane * 4)) + *(const f32x4*)(p.LOG + (size_t)2 * NTOK * NEXP + (size_t)t * NEXP + lane * 4);
        float sc[4], bs[4];
#pragma unroll
        for (int i = 0; i < 4; ++i) { sc[i] = sigmoidf_(lg[i]); bs[i] = sc[i] + bv[i]; }
        float t1 = fmaxf(bs[0], bs[1]), t2 = fminf(bs[0], bs[1]);
        { const float a = fmaxf(bs[2], bs[3]), c = fminf(bs[2], bs[3]); const float n1 = fmaxf(t1, a); t2 = fmaxf(fminf(t1, a), fmaxf(t2, c)); t1 = n1; }
#pragma unroll
        for (int o = 1; o <= 4; o <<= 1) { const float o1 = __shfl_xor(t1, o), o2 = __shfl_xor(t2, o); const float n1 = fmaxf(t1, o1); t2 = fmaxf(fminf(t1, o1), fmaxf(t2, o2)); t1 = n1; }
        const float gsc = t1 + t2;
        const int g = lane >> 3;
        int rank = 0;
#pragma unroll
        for (int g2 = 0; g2 < 8; ++g2) { const float o = __shfl(gsc, g2 * 8); rank += (o > gsc || (o == gsc && g2 < g)) ? 1 : 0; }
        const bool allowed = rank < 4;
        float cv[4];
#pragma unroll
        for (int i = 0; i < 4; ++i) cv[i] = allowed ? bs[i] : -3e38f;
        float wsel = 0.f; int esel = 0; float wsum = 0.f;
#pragma unroll
        for (int k = 0; k < 8; ++k) {
            float bvv = cv[0]; int bi = 0;
#pragma unroll
            for (int i = 1; i < 4; ++i) if (cv[i] > bvv) { bvv = cv[i]; bi = i; }
            int be = lane * 4 + bi;
#pragma unroll
            for (int o = 1; o <= 32; o <<= 1) { const float ov = __shfl_xor(bvv, o); const int oe = __shfl_xor(be, o); if (ov > bvv || (ov == bvv && oe < be)) { bvv = ov; be = oe; } }
            const int ol = be >> 2, oi = be & 3;
            float sown = 0.f;
#pragma unroll
            for (int i = 0; i < 4; ++i) if (oi == i) sown = sc[i];
            const float sv = __shfl(sown, ol);
            if (lane == ol) {
#pragma unroll
                for (int i = 0; i < 4; ++i) if (oi == i) cv[i] = -3e38f;
            }
            wsum += sv;
            if (lane == k) { wsel = sv; esel = be; }
        }
        es[q] = esel; ws[q] = wsel / wsum * 2.5f;
            }
        }
        int rk[8];
#pragma unroll
        for (int q = 0; q < 8; ++q) { rk[q] = 0; if (lane < 8 && tb + q * nb * 4 < NTOK) rk[q] = atomicAdd(&p.cnt[(bid & 31) * NEXP + es[q]], 1); }
#pragma unroll
        for (int q = 0; q < 8; ++q) { const int t = tb + q * nb * 4; if (lane < 8 && t < NTOK) { p.eidx[t * 8 + lane] = es[q]; p.ew[t * 8 + lane] = ws[q]; p.erank[t * 8 + lane] = rk[q]; } }
    }
}
__device__ __forceinline__ void phase_scatter(char* lds, int bid, int nb, const P& p) {
    int* base = (int*)lds;
    int* pc = base + 260;
    int* so = base + 520;
    const int tid = tidx();
    __syncthreads();
    { int c = 0;
#pragma unroll
      for (int sb = 0; sb < 32; ++sb) { so[sb * 256 + tid] = c; c += p.cnt[sb * NEXP + tid]; }
      pc[tid] = (c + 127) & ~127; }
    __syncthreads();
    { int s = 0; for (int e = 0; e < tid; ++e) s += pc[e]; base[tid] = s; if (tid == 255) base[256] = s + pc[255]; }
    __syncthreads();
    const int tpb = nb * 4;
    for (int a = bid * 256 + tid; a < NTOK * 8; a += nb * 256) {
        const int e = p.eidx[a]; const int t = a >> 3; const int sb = ((t % tpb) >> 2) & 31;
        const int row = base[e] + so[sb * 256 + e] + p.erank[a];
        p.rowtok[row] = t; p.epos[a] = row;
    }
    if (bid == 0) {
        {
            const int xq = tid & 7; int off = 0, tot = 0;
            for (int e = xq; e < 256; e += 8) { const int n = ((pc[e] >> 7) + 1) >> 1; if (e < tid) off += n; tot += n; }
            const int t0 = base[tid] >> 7, nte = pc[tid] >> 7;
            for (int i = 0; i < nte; i += 2) p.plist[xq * 320 + off + (i >> 1)] = (t0 + i) | ((i + 1 < nte) ? 0 : 0x40000000);
            if (tid < 64) { int totp = 0; for (int e = (tid & 7); e < 256; e += 8) totp += ((pc[e] >> 7) + 1) >> 1; p.plist[(tid & 7) * 320 + totp + (tid >> 3)] = SH_TILE0 + 2 * tid; }
            if (tid < 8) p.plen[tid] = tot + 8;
        }
        const int nrt = base[256] >> 7;
        for (int i = tid; i < NTILES; i += 256) if (i >= nrt) p.tile_e[i] = (i >= SH_TILE0) ? NEXP : -1;
        const int t0 = base[tid] >> 7, t1 = base[tid + 1] >> 7;
        for (int i = t0; i < t1; ++i) p.tile_e[i] = tid;
    }
    __syncthreads();
}
__device__ __forceinline__ void phase_moe1(char* lds, int bid, int nb, const P& p, int layer, const bf16_t* Xb) {
    const int tid = tidx(), lane = tid & 63, wid = tid >> 6, wr = wid >> 1, wc = wid & 1, fr = lane & 15, fq = lane >> 4;
    const int xq = bid & 7, tot = p.plen[xq] * 4, stp = nb >> 3;
    int Rr[4], Cc[4];
#pragma unroll
    for (int i = 0; i < 4; ++i) dma_rc32(lane, wid + 4 * i, Rr[i], Cc[i]);
    int ui = bid >> 3;
    int ent0 = 0, e0 = 0, tok0[4] = {0, 0, 0, 0}, ent1 = 0;
    if (ui < tot) { ent0 = p.plist[xq * 320 + (ui >> 2)]; const int t0 = ent0 & 0xffff, t1 = ((ent0 >> 30) & 1) ? t0 : t0 + 1; e0 = p.tile_e[t0];
#pragma unroll
        for (int i = 0; i < 4; ++i) tok0[i] = p.rowtok[(Rr[i] < 128 ? t0 : t1) * 128 + (Rr[i] & 127)]; }
    if (ui + stp < tot) ent1 = p.plist[xq * 320 + ((ui + stp) >> 2)];
    for (; ui < tot; ui += stp) {
        const int nt = ui & 3;
        const int ent = ent0, e = e0;
        const int tile0 = ent & 0xffff, single = (ent >> 30) & 1, tile1 = single ? tile0 : tile0 + 1;
        Dma3A al; al.base = (const char*)Xb;
#pragma unroll
        for (int i = 0; i < 4; ++i) al.voff[i] = (unsigned)(((size_t)tok0[i] * DM + Cc[i]) * 2);
        if (ui + stp < tot) { ent0 = ent1; const int t0 = ent0 & 0xffff, t1 = ((ent0 >> 30) & 1) ? t0 : t0 + 1; e0 = p.tile_e[t0];
#pragma unroll
            for (int i = 0; i < 4; ++i) tok0[i] = p.rowtok[(Rr[i] < 128 ? t0 : t1) * 128 + (Rr[i] & 127)]; }
        if (ui + 2 * stp < tot) ent1 = p.plist[xq * 320 + ((ui + 2 * stp) >> 2)];
        const float* Wg = (e < NEXP) ? p.w_gate + ((size_t)layer * NEXP + e) * (DM * 256) : p.ws_gate + (size_t)layer * (DM * 256);
        const float* Wu = (e < NEXP) ? p.w_up + ((size_t)layer * NEXP + e) * (DM * 256) : p.ws_up + (size_t)layer * (DM * 256);
        Reg3B bl; { const int nq = tid & 31, kg = tid >> 5; const int j = nq * 4, jw = j & 63, w2 = j >> 6; const int col = nt * 64 + w2 * 32 + (jw & 31);
            bl.ldb = 256; bl.bp = ((jw >= 32) ? Wu : Wg) + (size_t)(kg * 4) * 256 + col; }
        f32x4 acc[32];
        gemm_core4(al, bl, DM / 32, acc, single != 0);
        if (!(wr && single)) {
            const int tile = wr ? tile1 : tile0;
#pragma unroll
            for (int i = 0; i < 8; ++i)
                {
                    const int row = tile * 128 + i * 16 + fr, col = nt * 64 + wc * 32 + fq * 8;
                    const f32x4 g0 = acc[i * 4 + 0], g1 = acc[i * 4 + 1], u0 = acc[i * 4 + 2], u1 = acc[i * 4 + 3];
                    u32x4 w;
                    w.x = pack2(siluf_(g0[0]) * u0[0], siluf_(g0[1]) * u0[1]); w.y = pack2(siluf_(g0[2]) * u0[2], siluf_(g0[3]) * u0[3]);
                    w.z = pack2(siluf_(g1[0]) * u1[0], siluf_(g1[1]) * u1[1]); w.w = pack2(siluf_(g1[2]) * u1[2], siluf_(g1[3]) * u1[3]);
                    *(u32x4*)(p.H + (size_t)row * 256 + col) = w;
                }
        }
    }
}
__device__ __forceinline__ void phase_moe2(char* lds, int bid, int nb, const P& p, int layer) {
    const int tid = tidx(), lane = tid & 63, wid = tid >> 6, wr = wid >> 1, wc = wid & 1, fr = lane & 15, fq = lane >> 4;
    const int xq = bid & 7, tot = p.plen[xq] * 8, stp = nb >> 3;
    int Rr[4], Cc[4];
#pragma unroll
    for (int i = 0; i < 4; ++i) dma_rc32(lane, wid + 4 * i, Rr[i], Cc[i]);
    int ui = bid >> 3;
    int ent0 = 0, e0 = 0, ent1 = 0;
    if (ui < tot) { ent0 = p.plist[xq * 320 + (ui >> 3)]; e0 = p.tile_e[ent0 & 0xffff]; }
    if (ui + stp < tot) ent1 = p.plist[xq * 320 + ((ui + stp) >> 3)];
    for (; ui < tot; ui += stp) {
        const int nt = ui & 7;
        const int ent = ent0, e = e0;
        const int tile0 = ent & 0xffff, single = (ent >> 30) & 1, tile1 = single ? tile0 : tile0 + 1;
        if (ui + stp < tot) { ent0 = ent1; e0 = p.tile_e[ent0 & 0xffff]; }
        if (ui + 2 * stp < tot) ent1 = p.plist[xq * 320 + ((ui + 2 * stp) >> 3)];
        const float* Wd = (e < NEXP) ? p.w_down + ((size_t)layer * NEXP + e) * (256 * DM) : p.ws_down + (size_t)layer * (256 * DM);
        Dma3A al; al.base = (const char*)p.H;
#pragma unroll
        for (int i = 0; i < 4; ++i) al.voff[i] = (unsigned)(((size_t)((Rr[i] < 128 ? tile0 : tile1) * 128 + (Rr[i] & 127)) * 256 + Cc[i]) * 2);
        Reg3B bl; { const int nq = tid & 31, kg = tid >> 5; bl.ldb = DM; bl.perm64 = 1; bl.bp = Wd + (size_t)(kg * 4) * DM + nt * 128 + nq * 4; }
        f32x4 acc[32];
        gemm_core4(al, bl, 256 / 32, acc, single != 0);
        if (!(wr && single)) {
            const int tile = wr ? tile1 : tile0;
#pragma unroll
            for (int i = 0; i < 8; ++i)
                {
                    const int row = tile * 128 + i * 16 + fr, col = nt * 128 + wc * 64 + fq * 16;
                    u32x4 wv;
#pragma unroll
                    for (int j = 0; j < 4; ++j) {
                        f32x4 a = acc[i * 4 + j] * 64.0f;
#pragma unroll
                        for (int c = 0; c < 4; ++c) a[c] = fminf(fmaxf(a[c], -448.0f), 448.0f);
                        int w0 = 0;
                        w0 = __builtin_amdgcn_cvt_pk_fp8_f32(a[0], a[1], w0, false); w0 = __builtin_amdgcn_cvt_pk_fp8_f32(a[2], a[3], w0, true);
                        wv[j] = (unsigned)w0;
                    }
                    *(u32x4*)((char*)p.Y + (size_t)row * DM + col) = wv;
                }
        }
    }
}
__device__ __forceinline__ void phase_combine_ln(int bid, int nb, const P& p, const float* X, const float* g, const float* b, float* of, bf16_t* ob, bf16_t* ol) {
    const int lane = tidx() & 63, wid = tidx() >> 6;
    int row = bid * 4 + wid;
    int npos = 0; float nw = 0.f;
    if (row < NTOK && lane < 8) { npos = p.epos[row * 8 + lane]; nw = p.ew[row * 8 + lane]; }
    for (; row < NTOK; row += nb * 4) {
        const int cpos = npos; const float cw = nw;
        { const int nr = row + nb * 4; if (nr < NTOK && lane < 8) { npos = p.epos[nr * 8 + lane]; nw = p.ew[nr * 8 + lane]; } }
        float v[16];
#pragma unroll
        for (int h = 0; h < 2; ++h) {
            const size_t o = (size_t)row * DM + h * 512 + lane * 8;
            const u32x4 xh = *(const u32x4*)(p.XAb + o);
            v[h * 8 + 0] = DN_ALPHA * bf2f(xh.x & 0xffffu); v[h * 8 + 1] = DN_ALPHA * bf2f(xh.x >> 16);
            v[h * 8 + 2] = DN_ALPHA * bf2f(xh.y & 0xffffu); v[h * 8 + 3] = DN_ALPHA * bf2f(xh.y >> 16);
            v[h * 8 + 4] = DN_ALPHA * bf2f(xh.z & 0xffffu); v[h * 8 + 5] = DN_ALPHA * bf2f(xh.z >> 16);
            v[h * 8 + 6] = DN_ALPHA * bf2f(xh.w & 0xffffu); v[h * 8 + 7] = DN_ALPHA * bf2f(xh.w >> 16);
        }
#pragma unroll
        for (int k = 0; k < 9; ++k) {
            const int yr = (k < 8) ? __shfl(cpos, k) : (SH_TILE0 * 128 + row);
            const float w = (k < 8) ? __shfl(cw, k) : 1.0f;
#pragma unroll
            for (int h = 0; h < 2; ++h) {
                const u32x2 y = *(const u32x2*)((const char*)p.Y + (size_t)yr * DM + h * 512 + lane * 8);
                typedef float f32x2v __attribute__((ext_vector_type(2)));
                const f32x2v y0 = __builtin_amdgcn_cvt_pk_f32_fp8((int)y.x, false), y1 = __builtin_amdgcn_cvt_pk_f32_fp8((int)y.x, true);
                const f32x2v y2 = __builtin_amdgcn_cvt_pk_f32_fp8((int)y.y, false), y3 = __builtin_amdgcn_cvt_pk_f32_fp8((int)y.y, true);
                const float ws = w * (1.0f / 64.0f);
                v[h * 8 + 0] += ws * y0.x; v[h * 8 + 1] += ws * y0.y; v[h * 8 + 2] += ws * y1.x; v[h * 8 + 3] += ws * y1.y;
                v[h * 8 + 4] += ws * y2.x; v[h * 8 + 5] += ws * y2.y; v[h * 8 + 6] += ws * y3.x; v[h * 8 + 7] += ws * y3.y;
            }
        }
        ln_row_store(v, g, b, of, ob, row, lane, ol);
    }
}

__device__ __forceinline__ void phase_moba_kmean(int bid, int nb, const P& p) {
    const int tid = tidx();
    for (int u = (nb >= 256 ? bid - 128 : bid); u < NBATCH * 8; u += nb) {
        if (u < 0) continue;
        const int b = u >> 3, j = u & 7;
        const bf16_t* src = p.MK + (size_t)(b * SEQ + j * 256) * 512 + tid * 2;
        float s0 = 0.f, s1 = 0.f;
        for (int r8 = 0; r8 < 256; r8 += 8) {
            unsigned v[8];
#pragma unroll
            for (int i = 0; i < 8; ++i) v[i] = *(const unsigned*)(src + (size_t)(r8 + i) * 512);
#pragma unroll
            for (int i = 0; i < 8; ++i) { s0 += bf2f(v[i] & 0xffffu); s1 += bf2f(v[i] >> 16); }
        }
        const int h = tid >> 5, d = (tid & 31) * 2;
        p.KM[((size_t)(b * 8 + h) * 8 + j) * 64 + d] = s0 * (1.0f / 256.0f);
        p.KM[((size_t)(b * 8 + h) * 8 + j) * 64 + d + 1] = s1 * (1.0f / 256.0f);
    }
}
__device__ __forceinline__ void gemm_t_unit(const bf16_t* Wt, int wrow0, const bf16_t* X, int tok0, bf16_t* dst, int ncol, int col0) {
    const int tid = tidx(), lane = tid & 63, wid = tid >> 6, wr = wid >> 1, wc = wid & 1, fr = lane & 15, fq = lane >> 4;
    Dma3A al; al.set_dense(Wt, wrow0, DM); Dma3B bl; bl.set(X, X, tok0, DM, 1 << 30);
    f32x4 acc[32];
    gemm_core4(al, bl, DM / 32, acc);
#pragma unroll
    for (int i = 0; i < 8; ++i)
#pragma unroll
        for (int gg = 0; gg < 2; ++gg) {
            const int vc = col0 + wr * 128 + i * 16 + fr, r0 = tok0 + wc * 64 + gg * 32 + fq * 8;
            const int b = r0 >> 11, t0 = r0 & (SEQ - 1);
            const f32x4 a = acc[i * 4 + 2 * gg], b2 = acc[i * 4 + 2 * gg + 1];
            u32x4 w; w.x = pack2(a[0], a[1]); w.y = pack2(a[2], a[3]); w.z = pack2(b2[0], b2[1]); w.w = pack2(b2[2], b2[3]);
            *(u32x4*)(dst + ((size_t)(b * ncol + vc)) * SEQ + t0) = w;
        }
}
__device__ __forceinline__ void phase_inproj0(char* lds, int bid, int nb, const P& p) {
    const int ntn = 20, nk = DM / 32;
    const int tid = tidx(), lane = tid & 63, wid = tid >> 6, wr = wid >> 1, wc = wid & 1, fr = lane & 15, fq = lane >> 4;
    for (int i = bid * 256 + tid; i < 2 * 8 * 64 * 64; i += nb * 256) {
        const int which = i >> 15, e = i & 32767, h = e >> 12, j = (e >> 6) & 63, ii = e & 63;
        const float v = (which ? p.wx : p.wa)[(h * 64 + ii) * 64 + j];
        (which ? p.WXT : p.WAT)[e] = (bf16_t)f2bf(v);
    }
    for (int jj = 0;; ++jj) {
        int tm, tn; if (!dense_unit3(bid, nb, jj, ntn, tm, tn)) break;
        Dma3A al; al.set_dense(p.XIb, tm * 256, DM); Dma3B bl; bl.set(p.WIN0, p.WIN0, tn * 128, DM, 1 << 30);
        f32x4 acc[32];
        gemm_core4(al, bl, nk, acc);
#pragma unroll
        for (int i = 0; i < 8; ++i)
#pragma unroll
            for (int gg = 0; gg < 2; ++gg) {
                const int row = tm * 256 + wr * 128 + i * 16 + fr, col = tn * 128 + wc * 64 + gg * 32 + fq * 8;
                const f32x4 a = acc[i * 4 + 2 * gg], b2 = acc[i * 4 + 2 * gg + 1];
                u32x4 w; w.x = pack2(a[0], a[1]); w.y = pack2(a[2], a[3]); w.z = pack2(b2[0], b2[1]); w.w = pack2(b2[2], b2[3]);
                *(u32x4*)(p.UB0 + (size_t)row * 2560 + col) = w;
            }
    }
    for (int u = (nb >= 512 ? bid - 256 : bid); u < 2 * 128; u += nb) { if (u < 0) continue; const int pn = u & 1, tt = u >> 1; gemm_t_unit(p.WIN0, 2560 + pn * 256, p.XIb, tt * 128, p.VHt, 512, pn * 256); }
}

__device__ __forceinline__ int lds_off128(int r, int c) {
    const int st = (r >> 4) * 4 + (c >> 5), ob = (r & 15) * 64 + (c & 31) * 2;
    return st * 1024 + (ob ^ (((ob >> 9) & 1) << 5));
}
__device__ __forceinline__ float softplusf_(float x) { return fmaxf(x, 0.f) + log1pf(__expf(-fabsf(x))); }

#define LRU1_LDS (4 * 8192)
__device__ __forceinline__ void lru1_unit(char* lds, const P& p, int b, int ck, int half) {
    const int tid = tidx(), lane = tid & 63, w = tid >> 6, fr = lane & 15, fg = lane >> 4;
    char* xt = lds + w * 8192;
    const size_t n0 = (size_t)b * SEQ + ck * 64;
    __syncthreads();
    {
        const int h = half * 4 + w, c = h * 64 + lane;
        const float cw0 = p.conv_w[c], cw1 = p.conv_w[512 + c], cw2 = p.conv_w[1024 + c], cw3 = p.conv_w[1536 + c], cb = p.conv_b[c];
        float xm3 = 0.f, xm2 = 0.f, xm1 = 0.f;
        if (ck > 0) { xm3 = bf2f(p.UB0[(n0 - 3) * 2560 + c]); xm2 = bf2f(p.UB0[(n0 - 2) * 2560 + c]); xm1 = bf2f(p.UB0[(n0 - 1) * 2560 + c]); }
        __builtin_amdgcn_wave_barrier();
        for (int t16 = 0; t16 < 64; t16 += 16) {
            bf16_t raw[16];
#pragma unroll
            for (int i = 0; i < 16; ++i) raw[i] = p.UB0[(n0 + t16 + i) * 2560 + c];
#pragma unroll
            for (int i = 0; i < 16; ++i) {
                const float x = bf2f(raw[i]);
                const float xc = cb + cw0 * xm3 + cw1 * xm2 + cw2 * xm1 + cw3 * x;
                xm3 = xm2; xm2 = xm1; xm1 = x;
                *(bf16_t*)(xt + lds_off(t16 + i, lane & ~7) + (lane & 7) * 2) = (bf16_t)f2bf(xc);
            }
        }
        __builtin_amdgcn_wave_barrier();
        for (int jt = 0; jt < 4; ++jt) {
            const int cj = h * 64 + jt * 16 + fr;
            bf16x8 wra[2], wri[2];
#pragma unroll
            for (int ks = 0; ks < 2; ++ks) {
                wra[ks] = *(const bf16x8*)(p.WAT + (size_t)(h * 64 + jt * 16 + fr) * 64 + ks * 32 + fg * 8);
                wri[ks] = *(const bf16x8*)(p.WXT + (size_t)(h * 64 + jt * 16 + fr) * 64 + ks * 32 + fg * 8);
            }
            const float bav = p.ba[cj], bxv = p.bx[cj], sp = softplusf_(-p.lam[cj]);
            float mA = 1.f, mB = 0.f;
#pragma unroll
            for (int tt = 0; tt < 4; ++tt) {
                const bf16x8 a0 = *(const bf16x8*)(xt + lds_off(tt * 16 + fr, fg * 8)), a1 = *(const bf16x8*)(xt + lds_off(tt * 16 + fr, 32 + fg * 8));
                f32x4 ar = __builtin_amdgcn_mfma_f32_16x16x32_bf16(a0, wra[0], (f32x4){0.f, 0.f, 0.f, 0.f}, 0, 0, 0);
                ar = __builtin_amdgcn_mfma_f32_16x16x32_bf16(a1, wra[1], ar, 0, 0, 0);
                f32x4 ai = __builtin_amdgcn_mfma_f32_16x16x32_bf16(a0, wri[0], (f32x4){0.f, 0.f, 0.f, 0.f}, 0, 0, 0);
                ai = __builtin_amdgcn_mfma_f32_16x16x32_bf16(a1, wri[1], ai, 0, 0, 0);
                float sA = 1.f, sB = 0.f;
#pragma unroll
                for (int r = 0; r < 4; ++r) {
                    const int t = tt * 16 + fg * 4 + r;
                    const float rg = sigmoidf_(ar[r] + bav), ig = sigmoidf_(ai[r] + bxv);
                    const float log_a = -8.0f * rg * sp;
                    const float a = __expf(log_a);
                    const float mult = (ck == 0 && t == 0) ? 1.0f : sqrtf(fmaxf(1.0f - a * a, 0.f));
                    const int jj = jt * 16 + fr;
                    const float xcv = bf2f(*(const bf16_t*)(xt + lds_off(t, jj & ~7) + (jj & 7) * 2));
                    const float bt = mult * ig * xcv;
                    p.LA[(n0 + t) * 512 + cj] = a; p.LB[(n0 + t) * 512 + cj] = bt;
                    sB = a * sB + bt; sA = a * sA;
                }
                float tA = 1.f, tB = 0.f;
#pragma unroll
                for (int g2 = 0; g2 < 4; ++g2) {
                    const float oA = __shfl(sA, g2 * 16 + fr), oB = __shfl(sB, g2 * 16 + fr);
                    tB = oA * tB + oB; tA = oA * tA;
                }
                mB = tA * mB + tB; mA = tA * mA;
            }
            if (fg == 0) { p.CSA[((size_t)b * 32 + ck) * 512 + cj] = mA; p.CSB[((size_t)b * 32 + ck) * 512 + cj] = mB; }
        }
        __builtin_amdgcn_wave_barrier();
    }
}
__device__ __forceinline__ void lru2_unit(const P& p, int b, int ck, int half) {
    const int tid = tidx();
    const size_t n0 = (size_t)b * SEQ + ck * 64;
    {
        const int c = tid + 256 * half;
        float h = 0.f;
        for (int c8 = 0; c8 < ck; c8 += 8) {
            float ca[8], cb[8];
#pragma unroll
            for (int i = 0; i < 8; ++i) { const bool ok = c8 + i < ck; ca[i] = ok ? p.CSA[((size_t)b * 32 + c8 + i) * 512 + c] : 1.f; cb[i] = ok ? p.CSB[((size_t)b * 32 + c8 + i) * 512 + c] : 0.f; }
#pragma unroll
            for (int i = 0; i < 8; ++i) h = ca[i] * h + cb[i];
        }
        for (int t8 = 0; t8 < 64; t8 += 8) {
            float la[8], lb[8], gb[8];
#pragma unroll
            for (int i = 0; i < 8; ++i) { la[i] = p.LA[(n0 + t8 + i) * 512 + c]; lb[i] = p.LB[(n0 + t8 + i) * 512 + c]; gb[i] = bf2f(p.UB0[(n0 + t8 + i) * 2560 + 512 + c]); }
#pragma unroll
            for (int i = 0; i < 8; ++i) { h = la[i] * h + lb[i]; p.MIX[(n0 + t8 + i) * DM + c] = (bf16_t)f2bf(h * gelu_tanh(gb[i])); }
        }
    }
}

#define HG1_LDS (2 * 16384)
__device__ __forceinline__ float hg_lb(const P& p, int ch) {
    const float l0 = p.hg_lb[ch], l1 = p.hg_lb[512 + ch], l2 = p.hg_lb[1024 + ch]; const float mx = fmaxf(l0, fmaxf(l1, l2));
    const float e0 = __expf(l0 - mx), e1 = __expf(l1 - mx), e2 = __expf(l2 - mx); return e0 / (e0 + e1 + e2);
}
__device__ __forceinline__ void hg1_unit(char* lds, const P& p, int b, int h, int ck) {
    const int tid = tidx(), lane = tid & 63, w = tid >> 6, fr = lane & 15, fg = lane >> 4;
    char* kh = lds;
    char* vt = lds + 16384;
    const size_t n0 = (size_t)b * SEQ + ck * 64;
    const int bhc = (b * 4 + h) * 32 + ck;
    __syncthreads();
    if (tid < 128) {
        const int k = tid, ch = h * 128 + k;
        const float lbv = hg_lb(p, ch);
        float f[64];
#pragma unroll
        for (int t16 = 0; t16 < 64; t16 += 16) {
            bf16_t raw[16];
#pragma unroll
            for (int i = 0; i < 16; ++i) raw[i] = p.UB0[(n0 + t16 + i) * 2560 + 1536 + ch];
#pragma unroll
            for (int i = 0; i < 16; ++i) f[t16 + i] = lbv + (1.0f - lbv) * sigmoidf_(bf2f(raw[i]));
        }
        float suf = 1.0f;
#pragma unroll
        for (int t8 = 56; t8 >= 0; t8 -= 8) {
            float kv[8];
#pragma unroll
            for (int i = 7; i >= 0; --i) { kv[i] = (1.0f - f[t8 + i]) * suf; suf *= f[t8 + i]; }
            u32x4 wv; wv.x = pack2(kv[0], kv[1]); wv.y = pack2(kv[2], kv[3]); wv.z = pack2(kv[4], kv[5]); wv.w = pack2(kv[6], kv[7]);
            *(u32x4*)(kh + lds_off(k, t8)) = wv;
        }
        p.DV[(size_t)bhc * 128 + k] = suf;
    } else {
        const int q = tid - 128;
#pragma unroll
        for (int i = 0; i < 8; ++i) { const int pc = q + 128 * i, v = pc >> 3, c8 = pc & 7;
            *(u32x4*)(vt + lds_off(v, c8 * 8)) = *(const u32x4*)(p.VHt + ((size_t)(b * 512 + h * 128 + v)) * SEQ + ck * 64 + c8 * 8); }
    }
    __syncthreads();
    bf16_t* ut = p.UT + (size_t)bhc * 16384;
#pragma unroll
    for (int kk = 0; kk < 2; ++kk) {
        const int kt = w * 2 + kk;
        const bf16x8 a0 = *(const bf16x8*)(kh + lds_off(kt * 16 + fr, fg * 8)), a1 = *(const bf16x8*)(kh + lds_off(kt * 16 + fr, 32 + fg * 8));
#pragma unroll
        for (int v8 = 0; v8 < 8; ++v8) {
            const bf16x8 b0 = *(const bf16x8*)(vt + lds_off(v8 * 16 + fr, fg * 8)), b1 = *(const bf16x8*)(vt + lds_off(v8 * 16 + fr, 32 + fg * 8));
            f32x4 acc = __builtin_amdgcn_mfma_f32_16x16x32_bf16(a0, b0, (f32x4){0.f, 0.f, 0.f, 0.f}, 0, 0, 0);
            acc = __builtin_amdgcn_mfma_f32_16x16x32_bf16(a1, b1, acc, 0, 0, 0);
            u32x2 wv; wv.x = pack2(acc[0], acc[1]); wv.y = pack2(acc[2], acc[3]);
            *(u32x2*)(ut + (size_t)(v8 * 16 + fr) * 128 + kt * 16 + fg * 4) = wv;
        }
    }
}
__device__ __forceinline__ void phase_hg2(int bid, int nb, const P& p) {
    for (int it = bid * 256 + tidx(); it < 32 * 4096; it += nb * 256) {
        const int bh = it >> 12, e4 = (it & 4095) * 4, k4 = e4 & 127;
        float S0 = 0.f, S1 = 0.f, S2 = 0.f, S3 = 0.f;
        for (int c8 = 0; c8 < 32; c8 += 8) {
            u32x2 uv[8]; f32x4 dv[8];
#pragma unroll
            for (int i = 0; i < 8; ++i) { uv[i] = *(const u32x2*)(p.UT + ((size_t)(bh * 32 + c8 + i)) * 16384 + e4); dv[i] = *(const f32x4*)(p.DV + (size_t)(bh * 32 + c8 + i) * 128 + k4); }
#pragma unroll
            for (int i = 0; i < 8; ++i) {
                u32x2 wv; wv.x = pack2(S0, S1); wv.y = pack2(S2, S3);
                *(u32x2*)(p.SP + ((size_t)(bh * 32 + c8 + i)) * 16384 + e4) = wv;
                S0 = dv[i][0] * S0 + bf2f(uv[i].x & 0xffffu); S1 = dv[i][1] * S1 + bf2f(uv[i].x >> 16);
                S2 = dv[i][2] * S2 + bf2f(uv[i].y & 0xffffu); S3 = dv[i][3] * S3 + bf2f(uv[i].y >> 16);
            }
        }
    }
}
#define HG3_QP 0
#define HG3_KP 40960
#define HG3_VT (40960 + 16384)
#define HG3_LDS (40960 + 16384 + 128 * 144)
__device__ __forceinline__ int hg3_qp_base(int j) { return j == 0 ? 0 : (j == 1 ? 16384 : (j == 2 ? 28672 : 36864)); }
__device__ __forceinline__ void hg3_unit(char* lds, const P& p, int b, int h, int ck) {
    const int tid = tidx(), lane = tid & 63, w = tid >> 6, fr = lane & 15, fg = lane >> 4;
    char* qp = lds + HG3_QP; char* kp = lds + HG3_KP; char* vt = lds + HG3_VT;
    const size_t n0 = (size_t)b * SEQ + ck * 64;
    const int bhc = (b * 4 + h) * 32 + ck;
    __syncthreads();
    if (tid < 128) {
        const int k = tid, ch = h * 128 + k;
        const float lbv = hg_lb(p, ch);
        const int ke = (k & 7) * 2, k8 = k & ~7;
        float d0 = 1.f, d1 = 1.f, d2 = 1.f, d3 = 1.f;
#pragma unroll
        for (int i = 0; i < 4; ++i) {
            bf16_t rq[16], rf[16];
#pragma unroll
            for (int tt = 0; tt < 16; ++tt) { rq[tt] = p.UB0[(n0 + i * 16 + tt) * 2560 + 1024 + ch]; rf[tt] = p.UB0[(n0 + i * 16 + tt) * 2560 + 1536 + ch]; }
#pragma unroll
            for (int tt = 0; tt < 16; ++tt) {
                const int t = i * 16 + tt;
                const float qv = siluf_(bf2f(rq[tt]));
                const float f = lbv + (1.0f - lbv) * sigmoidf_(bf2f(rf[tt]));
                d0 *= f; if (i >= 1) d1 *= f; if (i >= 2) d2 *= f; if (i >= 3) d3 *= f;
                const float di = (i == 0) ? d0 : (i == 1 ? d1 : (i == 2 ? d2 : d3));
                *(bf16_t*)(kp + lds_off128(t, k8) + ke) = (bf16_t)f2bf((1.0f - f) * __builtin_amdgcn_rcpf(fmaxf(di, 1.8e-35f)));
                *(bf16_t*)(qp + hg3_qp_base(0) + lds_off128(t, k8) + ke) = (bf16_t)f2bf(qv * d0);
                if (i >= 1) *(bf16_t*)(qp + hg3_qp_base(1) + lds_off128(t - 16, k8) + ke) = (bf16_t)f2bf(qv * d1);
                if (i >= 2) *(bf16_t*)(qp + hg3_qp_base(2) + lds_off128(t - 32, k8) + ke) = (bf16_t)f2bf(qv * d2);
                if (i >= 3) *(bf16_t*)(qp + hg3_qp_base(3) + lds_off128(t - 48, k8) + ke) = (bf16_t)f2bf(qv * d3);
            }
        }
    } else {
        const int q = tid - 128;
#pragma unroll
        for (int i = 0; i < 8; ++i) { const int pc = q + 128 * i, v = pc >> 3, c8 = pc & 7;
            *(u32x4*)(vt + v * 144 + c8 * 16) = *(const u32x4*)(p.VHt + ((size_t)(b * 512 + h * 128 + v)) * SEQ + ck * 64 + c8 * 8); }
    }
    __syncthreads();
    f32x4 acc[8];
#pragma unroll
    for (int v8 = 0; v8 < 8; ++v8) acc[v8] = (f32x4){0.f, 0.f, 0.f, 0.f};
    if (ck > 0) {
        const bf16_t* sp = p.SP + (size_t)bhc * 16384;
#pragma unroll
        for (int ks = 0; ks < 4; ++ks) {
            const bf16x8 bq = *(const bf16x8*)(qp + hg3_qp_base(0) + lds_off128(w * 16 + fr, ks * 32 + fg * 8));
#pragma unroll
            for (int v8 = 0; v8 < 8; ++v8) {
                const bf16x8 as = *(const bf16x8*)(sp + (size_t)(v8 * 16 + fr) * 128 + ks * 32 + fg * 8);
                acc[v8] = __builtin_amdgcn_mfma_f32_16x16x32_bf16(as, bq, acc[v8], 0, 0, 0);
            }
        }
    }
#pragma unroll
    for (int jp = 0; jp < 2; ++jp) {
        if (2 * jp > w) continue;
        f32x4 at[2];
#pragma unroll
        for (int jj = 0; jj < 2; ++jj) {
            const int j = 2 * jp + jj;
            at[jj] = (f32x4){0.f, 0.f, 0.f, 0.f};
            if (j <= w) {
#pragma unroll
                for (int ks = 0; ks < 4; ++ks) {
                    const bf16x8 ak = *(const bf16x8*)(kp + lds_off128(j * 16 + fr, ks * 32 + fg * 8));
                    const bf16x8 bq = *(const bf16x8*)(qp + hg3_qp_base(j) + lds_off128((w - j) * 16 + fr, ks * 32 + fg * 8));
                    at[jj] = __builtin_amdgcn_mfma_f32_16x16x32_bf16(ak, bq, at[jj], 0, 0, 0);
                }
                if (j == w) {
#pragma unroll
                    for (int r = 0; r < 4; ++r) at[jj][r] = (fg * 4 + r <= fr) ? at[jj][r] : 0.f;
                }
            }
        }
        u32x4 pw; pw.x = pack2(at[0][0], at[0][1]); pw.y = pack2(at[0][2], at[0][3]); pw.z = pack2(at[1][0], at[1][1]); pw.w = pack2(at[1][2], at[1][3]);
        const bf16x8 pf = __builtin_bit_cast(bf16x8, pw);
#pragma unroll
        for (int v8 = 0; v8 < 8; ++v8) {
            const char* vb = vt + (v8 * 16 + fr) * 144 + (jp * 32 + fg * 4) * 2;
            const u32x2 v0 = *(const u32x2*)vb, v1 = *(const u32x2*)(vb + 32);
            u32x4 vv; vv.x = v0.x; vv.y = v0.y; vv.z = v1.x; vv.w = v1.y;
            acc[v8] = __builtin_amdgcn_mfma_f32_16x16x32_bf16(__builtin_bit_cast(bf16x8, vv), pf, acc[v8], 0, 0, 0);
        }
    }
    float ss = 0.f;
#pragma unroll
    for (int v8 = 0; v8 < 8; ++v8)
#pragma unroll
        for (int r = 0; r < 4; ++r) ss += acc[v8][r] * acc[v8][r];
    ss += __shfl_xor(ss, 16); ss += __shfl_xor(ss, 32);
    const float rs = rsqrtf(ss * (1.0f / 128.0f) + 1e-6f);
    const size_t n = n0 + w * 16 + fr;
#pragma unroll
    for (int v8 = 0; v8 < 8; ++v8) {
        const int vcol = h * 128 + v8 * 16 + fg * 4;
        const u32x2 gv = *(const u32x2*)(p.UB0 + n * 2560 + 2048 + vcol);
        const f32x4 ng = *(const f32x4*)(p.hg_ng + vcol);
        const float y0 = acc[v8][0] * rs * ng[0] * sigmoidf_(bf2f(gv.x & 0xffffu)), y1 = acc[v8][1] * rs * ng[1] * sigmoidf_(bf2f(gv.x >> 16));
        const float y2 = acc[v8][2] * rs * ng[2] * sigmoidf_(bf2f(gv.y & 0xffffu)), y3 = acc[v8][3] * rs * ng[3] * sigmoidf_(bf2f(gv.y >> 16));
        u32x2 wv; wv.x = pack2(y0, y1); wv.y = pack2(y2, y3);
        *(u32x2*)(p.MIX + n * DM + 512 + vcol) = wv;
    }
}
__device__ __forceinline__ void phase_mix0_a(char* lds, int bid, int nb, const P& p) {
    for (int u = bid; u < 512 + 1024; u += nb) {
        if (u < 512) lru1_unit(lds, p, u >> 6, (u >> 1) & 31, u & 1);
        else { const int v = u - 512; hg1_unit(lds, p, v >> 7, (v >> 5) & 3, v & 31); }
    }
    __syncthreads();
}
__device__ __forceinline__ void phase_mix0_c(char* lds, int bid, int nb, const P& p) {
    for (int u = bid; u < 1024; u += nb) hg3_unit(lds, p, u >> 7, (u >> 5) & 3, u & 31);
    __syncthreads();
}

#ifndef KEEP_U
#define KEEP_U 0
#endif
__device__ __forceinline__ int vcol_actual(int v) { return v < 1280 ? v : (v < 2816 ? v + 24 : v - 1536); }
__device__ __forceinline__ void phase_inproj1(char* lds, int bid, int nb, const P& p) {
    const int ntn = 17, nk = DM / 32;
    const int tid = tidx(), lane = tid & 63, wid = tid >> 6, wr = wid >> 1, wc = wid & 1, fr = lane & 15, fq = lane >> 4;
    for (int jj = 0;; ++jj) {
        int tm, tn; if (!dense_unit3(bid, nb, jj, ntn, tm, tn)) break;
        Dma3A al; al.set_dense(p.XBb, tm * 256, DM); Dma3B bl; bl.set(p.WIN1, p.WIN1, tn * 128, DM, 1 << 30);
        f32x4 acc[32];
        gemm_core4(al, bl, nk, acc);
#pragma unroll
        for (int i = 0; i < 8; ++i)
#pragma unroll
            for (int gg = 0; gg < 2; ++gg) {
                const int row = tm * 256 + wr * 128 + i * 16 + fr, vc = tn * 128 + wc * 64 + gg * 32 + fq * 8;
                const f32x4 a = acc[i * 4 + 2 * gg], b2 = acc[i * 4 + 2 * gg + 1];
                u32x4 w; w.x = pack2(a[0], a[1]); w.y = pack2(a[2], a[3]); w.z = pack2(b2[0], b2[1]); w.w = pack2(b2[2], b2[3]);
                if (tn < 4) *(u32x4*)(p.Qb + (size_t)row * 512 + vc) = w;
                else if (tn < 6) { *(f32x4*)(p.KCV + (size_t)row * 256 + vc - 512) = a; *(f32x4*)(p.KCV + (size_t)row * 256 + vc - 512 + 4) = b2; }
                else if (tn == 6) *(u32x4*)(p.KS + (size_t)row * 128 + vc - 768) = w;
                else if (tn == 7) *(u32x4*)(p.KW + (size_t)row * 128 + vc - 896) = w;
                else if (tn < 12) *(u32x4*)(p.MQ + (size_t)row * 512 + vc - 1024) = w;
                else if (tn < 16) *(u32x4*)(p.MK + (size_t)row * 512 + vc - 1536) = w;
                else if (vc < 2072) { *(f32x4*)(p.GATES + (size_t)row * 24 + vc - 2048) = a; *(f32x4*)(p.GATES + (size_t)row * 24 + vc - 2048 + 4) = b2; }
            }
    }
    for (int u = (nb >= 512 ? bid - 64 : bid); u < 3 * 128; u += nb) {
        if (u < 0) continue;
        const int pn = u % 3, tt = u / 3;
        if (pn == 0) {
            const int wrr = tidx() >> 7;
            gemm_t_unit(p.WIN1, 2176, p.XBb, tt * 128, wrr ? p.VWt - (size_t)128 * SEQ : p.VSt, 128, 0);
        } else gemm_t_unit(p.WIN1, 2432 + (pn - 1) * 256, p.XBb, tt * 128, p.MVt, 512, (pn - 1) * 256);
    }
}
__device__ __forceinline__ void phase_moba_gate(char* lds, int bid, int nb, const P& p) {
    const int lane = tidx() & 63, wid = tidx() >> 6;
    float* km = (float*)lds + 4096 + wid * 512;
    for (int it = bid * 4 + wid; it < 64 * 32; it += nb * 4) {
        const int bh = it >> 5, tb = it & 31, b = bh >> 3, h = bh & 7;
        const int t = tb * 64 + lane, ob = t >> 8;
        __builtin_amdgcn_wave_barrier();
#pragma unroll
        for (int i = 0; i < 8; ++i) km[i * 64 + lane] = p.KM[(size_t)bh * 512 + i * 64 + lane];
        __builtin_amdgcn_wave_barrier();
        u32x4 qr[8];
#pragma unroll
        for (int i = 0; i < 8; ++i) qr[i] = *(const u32x4*)(p.MQ + (size_t)(b * SEQ + t) * 512 + h * 64 + i * 8);
        float gate[8];
#pragma unroll
        for (int j = 0; j < 8; ++j) gate[j] = 0.f;
#pragma unroll
        for (int i = 0; i < 8; ++i) {
            float q[8];
            q[0] = bf2f(qr[i].x & 0xffffu); q[1] = bf2f(qr[i].x >> 16); q[2] = bf2f(qr[i].y & 0xffffu); q[3] = bf2f(qr[i].y >> 16);
            q[4] = bf2f(qr[i].z & 0xffffu); q[5] = bf2f(qr[i].z >> 16); q[6] = bf2f(qr[i].w & 0xffffu); q[7] = bf2f(qr[i].w >> 16);
#pragma unroll
            for (int j = 0; j < 8; ++j)
#pragma unroll
                for (int e = 0; e < 8; ++e) gate[j] += q[e] * km[j * 64 + i * 8 + e];
        }
#pragma unroll
        for (int j = 0; j < 8; ++j) gate[j] = (j < ob) ? gate[j] : NEGF;
        unsigned selm = 0;
#pragma unroll
        for (int j = 0; j < 8; ++j) {
            int rank = 0;
#pragma unroll
            for (int j2 = 0; j2 < 8; ++j2) rank += (gate[j2] > gate[j] || (gate[j2] == gate[j] && j2 < j)) ? 1 : 0;
            if (j < ob && rank < 3) selm |= 1u << j;
        }
        p.MSEL[(size_t)bh * SEQ + t] = selm;
    }
}

#define ATT_K_BYTES 8192
#define ATT_STAGE 16384
#define ATT_TILE_BYTES (3 * ATT_STAGE)
#define ATT_ORDER_OFF ATT_TILE_BYTES
#define ATT_RED_OFF (ATT_ORDER_OFF + 8192)
__device__ __forceinline__ void att_issue_tile(int stage, const bf16_t* Kg, int ldk, const bf16_t* Vg) {
    const int lane = tidx() & 63, w = tidx() >> 6;
#pragma unroll
    for (int i = 0; i < 2; ++i) { int R, C; dma_rc(lane, w + 4 * i, R, C);
        __builtin_amdgcn_global_load_lds((const unsigned*)(Kg + (size_t)R * ldk + C), (LAS unsigned*)((LAS char*)dyn_lds + stage * ATT_STAGE + (w + 4 * i) * 1024), 16, 0, 0);
        __builtin_amdgcn_global_load_lds((const unsigned*)(Vg + (size_t)R * SEQ + C), (LAS unsigned*)((LAS char*)dyn_lds + stage * ATT_STAGE + ATT_K_BYTES + (w + 4 * i) * 1024), 16, 0, 0); }
}
#define ATT_WAIT_BAR(n) do { asm volatile("s_waitcnt vmcnt(" #n ") lgkmcnt(0)" ::: "memory"); __builtin_amdgcn_s_barrier(); asm volatile("" ::: "memory"); } while (0)
struct AttState { f32x4 O[4][2]; float m[2], l[2]; };
__device__ __forceinline__ void att_reset(AttState& S) {
#pragma unroll
    for (int q = 0; q < 2; ++q) { S.m[q] = NEGF; S.l[q] = 0.f;
#pragma unroll
        for (int d = 0; d < 4; ++d) S.O[d][q] = (f32x4){0.f, 0.f, 0.f, 0.f}; }
}
template <bool MASKED>
__device__ __forceinline__ void att_step(const char* lds, const bf16x8 (&qf)[2][2], AttState& S, const f32x4 (&bini)[4], float slope2,
                                         int s0, int tq0, unsigned selbits  , int winlimit) {
    const int lane = tidx() & 63, fr = lane & 15, fg = lane >> 4;
    const char* ldsV = lds + ATT_K_BYTES;
    const float offbase = slope2 * (float)s0;
    f32x4 s[2][4];
#pragma unroll
    for (int kt = 0; kt < 4; ++kt) {
        const bf16x8 k0 = *(const bf16x8*)(lds + lds_off(kt * 16 + fr, fg * 8)), k1 = *(const bf16x8*)(lds + lds_off(kt * 16 + fr, 32 + fg * 8));
#pragma unroll
        for (int qt = 0; qt < 2; ++qt) {
            s[qt][kt] = __builtin_amdgcn_mfma_f32_16x16x32_bf16(k0, qf[qt][0], bini[kt], 0, 0, 0);
            s[qt][kt] = __builtin_amdgcn_mfma_f32_16x16x32_bf16(k1, qf[qt][1], s[qt][kt], 0, 0, 0);
        }
    }
    __builtin_amdgcn_sched_barrier(0);
    u32x4 pf[2][2];
#pragma unroll
    for (int qt = 0; qt < 2; ++qt) {
        const int tq = tq0 + qt * 16 + fr;
        const float off = ((selbits >> qt) & 1u) ? (offbase - slope2 * (float)tq) : -INFINITY;
        float mx = -INFINITY;
#pragma unroll
        for (int kt = 0; kt < 4; ++kt)
#pragma unroll
            for (int r = 0; r < 4; ++r) {
                float y = s[qt][kt][r];
                if (MASKED) { const int key = s0 + kt * 16 + fg * 4 + r; const bool ok = (key <= tq) && (tq - key < winlimit); y = ok ? y : -INFINITY; s[qt][kt][r] = y; }
                mx = fmaxf(mx, y);
            }
        mx = fmaxf(mx, __shfl_xor(mx, 16)); mx = fmaxf(mx, __shfl_xor(mx, 32));
        const float mnew = fmaxf(S.m[qt], mx + off);
        const float alpha = __builtin_amdgcn_exp2f(S.m[qt] - mnew);
        S.m[qt] = mnew;
        const float thr = mnew - off;
        float ls = 0.f;
#pragma unroll
        for (int kt = 0; kt < 4; ++kt)
#pragma unroll
            for (int r = 0; r < 4; ++r) { const float pr = __builtin_amdgcn_exp2f(s[qt][kt][r] - thr); s[qt][kt][r] = pr; ls += pr; }
        S.l[qt] = S.l[qt] * alpha + ls;
#pragma unroll
        for (int dt = 0; dt < 4; ++dt) S.O[dt][qt] *= alpha;
#pragma unroll
        for (int kk = 0; kk < 2; ++kk) {
            pf[qt][kk].x = pack2(s[qt][2 * kk][0], s[qt][2 * kk][1]); pf[qt][kk].y = pack2(s[qt][2 * kk][2], s[qt][2 * kk][3]);
            pf[qt][kk].z = pack2(s[qt][2 * kk + 1][0], s[qt][2 * kk + 1][1]); pf[qt][kk].w = pack2(s[qt][2 * kk + 1][2], s[qt][2 * kk + 1][3]);
        }
    }
    __builtin_amdgcn_sched_barrier(0);
#pragma unroll
    for (int kk = 0; kk < 2; ++kk)
#pragma unroll
        for (int dt = 0; dt < 4; ++dt) {
            const char* vb = ldsV + (fg & 1) * 8;
            const u32x2 v0 = *(const u32x2*)(vb + lds_off(dt * 16 + fr, kk * 32 + (fg >> 1) * 8)), v1 = *(const u32x2*)(vb + lds_off(dt * 16 + fr, kk * 32 + 16 + (fg >> 1) * 8));
            u32x4 vv; vv.x = v0.x; vv.y = v0.y; vv.z = v1.x; vv.w = v1.y;
            const bf16x8 vf = __builtin_bit_cast(bf16x8, vv);
#pragma unroll
            for (int qt = 0; qt < 2; ++qt) S.O[dt][qt] = __builtin_amdgcn_mfma_f32_16x16x32_bf16(vf, __builtin_bit_cast(bf16x8, pf[qt][kk]), S.O[dt][qt], 0, 0, 0);
        }
    __builtin_amdgcn_sched_barrier(0);
}
__device__ __forceinline__ unsigned wave_or(unsigned v) {
#pragma unroll
    for (int o = 32; o >= 1; o >>= 1) v |= (unsigned)__shfl_xor((int)v, o);
    return v;
}
__device__ __forceinline__ void att_nsa_unit(char* lds, const P& p, int b, int g, int qtile) {
    const int tid = tidx(), lane = tid & 63, w = tid >> 6, fr = lane & 15, fg = lane >> 4;
    const int hd = g * 4 + w, t0 = qtile * 32, own = qtile >> 1;
    const float slope2 = exp2f(-((float)hd + 0.5f)) * LOG2E, c1 = 0.125f * LOG2E;
    bf16x8 qf[2][2];
#pragma unroll
    for (int qt = 0; qt < 2; ++qt)
#pragma unroll
        for (int ks = 0; ks < 2; ++ks) qf[qt][ks] = *(const bf16x8*)(p.Qb + (size_t)(b * SEQ + t0 + qt * 16 + fr) * 512 + hd * 64 + ks * 32 + fg * 8);
#pragma unroll
    for (int qt = 0; qt < 2; ++qt)
#pragma unroll
        for (int ks = 0; ks < 2; ++ks) {
            const u32x4 raw = __builtin_bit_cast(u32x4, qf[qt][ks]); u32x4 o;
            o.x = pack2(bf2f(raw.x & 0xffffu) * c1, bf2f(raw.x >> 16) * c1); o.y = pack2(bf2f(raw.y & 0xffffu) * c1, bf2f(raw.y >> 16) * c1);
            o.z = pack2(bf2f(raw.z & 0xffffu) * c1, bf2f(raw.z >> 16) * c1); o.w = pack2(bf2f(raw.w & 0xffffu) * c1, bf2f(raw.w >> 16) * c1);
            qf[qt][ks] = __builtin_bit_cast(bf16x8, o);
        }
    f32x4 bini[4];
#pragma unroll
    for (int kt = 0; kt < 4; ++kt)
#pragma unroll
        for (int r = 0; r < 4; ++r) bini[kt][r] = slope2 * (float)(kt * 16 + fg * 4 + r);
    unsigned selw[2];
#pragma unroll
    for (int qt = 0; qt < 2; ++qt) selw[qt] = p.SELM[(size_t)(b * 2 + g) * SEQ + t0 + qt * 16 + fr];
    const unsigned um = wave_or(selw[0] | selw[1]);
    AttState S; att_reset(S);
    unsigned rem = um & ((own >= 31) ? 0xffffffffu : ((2u << own) - 1u));
    int wj = own >= 8 ? own - 8 : 0;
    int cbr, cj; bool has = true;
    if (rem) { cj = __ffs(rem) - 1; rem &= rem - 1; cbr = 0; } else { cj = wj++; cbr = 1; }
    const bf16_t* Ks = p.KS + (size_t)b * SEQ * 128 + g * 64; const bf16_t* Kw = p.KW + (size_t)b * SEQ * 128 + g * 64;
    const bf16_t* Vs = p.VSt + (size_t)(b * 128 + g * 64) * SEQ; const bf16_t* Vw = p.VWt + (size_t)(b * 128 + g * 64) * SEQ;
    int n1br = 0, n1j = 0; bool has1;
    if (rem) { n1j = __ffs(rem) - 1; rem &= rem - 1; n1br = 0; has1 = true; } else if (wj <= own) { n1j = wj++; n1br = 1; has1 = true; } else has1 = false;
    __syncthreads();
    att_issue_tile(0, (cbr ? Kw : Ks) + (size_t)cj * 64 * 128, 128, (cbr ? Vw : Vs) + cj * 64);
    if (has1) att_issue_tile(1, (n1br ? Kw : Ks) + (size_t)n1j * 64 * 128, 128, (n1br ? Vw : Vs) + n1j * 64);
    bool switched = false;
    int st = 0;
    while (has) {
        if (has1) ATT_WAIT_BAR(4); else ATT_WAIT_BAR(0);
        int n2br = 0, n2j = 0; bool has2;
        if (!has1) has2 = false;
        else if (rem) { n2j = __ffs(rem) - 1; rem &= rem - 1; n2br = 0; has2 = true; } else if (wj <= own) { n2j = wj++; n2br = 1; has2 = true; } else has2 = false;
        if (has2) att_issue_tile(st == 0 ? 2 : st - 1, (n2br ? Kw : Ks) + (size_t)n2j * 64 * 128, 128, (n2br ? Vw : Vs) + n2j * 64);
        const char* sl = lds + st * ATT_STAGE;
        if (cbr == 1 && !switched) {
            switched = true;
#pragma unroll
            for (int qt = 0; qt < 2; ++qt) {
                float lt = S.l[qt]; lt += __shfl_xor(lt, 16); lt += __shfl_xor(lt, 32);
                const size_t n = (size_t)b * SEQ + t0 + qt * 16 + fr;
                const float sc = sigmoidf_(p.GATES[n * 24 + hd * 3 + 1]) / fmaxf(lt, 1e-30f);
#pragma unroll
                for (int dt = 0; dt < 4; ++dt) { const f32x4 y = S.O[dt][qt] * sc; u32x2 w; w.x = pack2(y[0], y[1]); w.y = pack2(y[2], y[3]); *(u32x2*)((bf16_t*)p.OS + n * 512 + hd * 64 + dt * 16 + fg * 4) = w; }
            }
            att_reset(S);
        }
        unsigned sb = 3u; int wl = 1 << 30; bool msk;
        if (cbr == 0) { sb = ((selw[0] >> cj) & 1u) | (((selw[1] >> cj) & 1u) << 1); msk = (cj == own); }
        else { wl = 512; msk = (cj == own) || (cj + 8 == own); }
        if (msk) att_step<true>(sl, qf, S, bini, slope2, cj * 64, t0, sb, wl);
        else att_step<false>(sl, qf, S, bini, slope2, cj * 64, t0, sb, wl);
        cbr = n1br; cj = n1j; has = has1; n1br = n2br; n1j = n2j; has1 = has2;
        st = (st == 2) ? 0 : st + 1;
    }
#pragma unroll
    for (int qt = 0; qt < 2; ++qt) {
        float lt = S.l[qt]; lt += __shfl_xor(lt, 16); lt += __shfl_xor(lt, 32);
        const size_t n = (size_t)b * SEQ + t0 + qt * 16 + fr;
        const float sc = sigmoidf_(p.GATES[n * 24 + hd * 3 + 2]) / fmaxf(lt, 1e-30f);
        const float g0 = sigmoidf_(p.GATES[n * 24 + hd * 3 + 0]);
#pragma unroll
        for (int dt = 0; dt < 4; ++dt) {
            const size_t o = n * 512 + hd * 64 + dt * 16 + fg * 4;
            const u32x2 osv = *(const u32x2*)((const bf16_t*)p.OS + o), ocv = *(const u32x2*)((const bf16_t*)p.OC + o);
            const f32x4 osf = {bf2f(osv.x & 0xffffu), bf2f(osv.x >> 16), bf2f(osv.y & 0xffffu), bf2f(osv.y >> 16)};
            const f32x4 ocf = {bf2f(ocv.x & 0xffffu), bf2f(ocv.x >> 16), bf2f(ocv.y & 0xffffu), bf2f(ocv.y >> 16)};
            const f32x4 y = S.O[dt][qt] * sc + osf + ocf * g0;
            u32x2 wv; wv.x = pack2(y[0], y[1]); wv.y = pack2(y[2], y[3]);
            *(u32x2*)(p.MIX + n * DM + hd * 64 + dt * 16 + fg * 4) = wv;
        }
    }
}
__device__ __forceinline__ void att_moba_unit(char* lds, const P& p, int b, int h, int ob, int half) {
    const int tid = tidx(), lane = tid & 63, w = tid >> 6, fr = lane & 15, fg = lane >> 4;
    const int tq0 = ob * 256 + half * 128 + w * 32;
    const int dsub = half * 2 + (w >> 1), lastsub = half * 2 + 1;
    const float slope2 = exp2f(-((float)h + 1.0f)) * LOG2E, c1 = 0.125f * LOG2E;
    bf16x8 qf[2][2];
#pragma unroll
    for (int qt = 0; qt < 2; ++qt)
#pragma unroll
        for (int ks = 0; ks < 2; ++ks) qf[qt][ks] = *(const bf16x8*)(p.MQ + (size_t)(b * SEQ + tq0 + qt * 16 + fr) * 512 + h * 64 + ks * 32 + fg * 8);
#pragma unroll
    for (int qt = 0; qt < 2; ++qt)
#pragma unroll
        for (int ks = 0; ks < 2; ++ks) {
            const u32x4 raw = __builtin_bit_cast(u32x4, qf[qt][ks]); u32x4 o;
            o.x = pack2(bf2f(raw.x & 0xffffu) * c1, bf2f(raw.x >> 16) * c1); o.y = pack2(bf2f(raw.y & 0xffffu) * c1, bf2f(raw.y >> 16) * c1);
            o.z = pack2(bf2f(raw.z & 0xffffu) * c1, bf2f(raw.z >> 16) * c1); o.w = pack2(bf2f(raw.w & 0xffffu) * c1, bf2f(raw.w >> 16) * c1);
            qf[qt][ks] = __builtin_bit_cast(bf16x8, o);
        }
    f32x4 bini[4];
#pragma unroll
    for (int kt = 0; kt < 4; ++kt)
#pragma unroll
        for (int r = 0; r < 4; ++r) bini[kt][r] = slope2 * (float)(kt * 16 + fg * 4 + r);
    unsigned selw[2];
#pragma unroll
    for (int qt = 0; qt < 2; ++qt) selw[qt] = p.MSEL[(size_t)(b * 8 + h) * SEQ + tq0 + qt * 16 + fr];
    unsigned* red = (unsigned*)(lds + ATT_RED_OFF);
    const unsigned umw = wave_or(selw[0] | selw[1]);
    __syncthreads();
    if (lane == 0) red[w] = umw;
    __syncthreads();
    unsigned rem = (red[0] | red[1] | red[2] | red[3]) & ((1u << ob) - 1u);
    AttState S; att_reset(S);
    int cj, csub = 0; bool has = true;
    if (rem) { cj = __ffs(rem) - 1; rem &= rem - 1; } else cj = ob;
    const bf16_t* Kb = p.MK + (size_t)b * SEQ * 512 + h * 64; const bf16_t* Vb = p.MVt + (size_t)(b * 512 + h * 64) * SEQ;
#define MOBA_NEXT(J, SUB, NJ, NSUB, HAS) do { \
        if ((J) == ob) { if ((SUB) < lastsub) { NJ = (J); NSUB = (SUB) + 1; HAS = true; } else HAS = false; } \
        else if ((SUB) < 3) { NJ = (J); NSUB = (SUB) + 1; HAS = true; } \
        else { if (rem) { NJ = __ffs(rem) - 1; rem &= rem - 1; } else NJ = ob; NSUB = 0; HAS = true; } } while (0)
    int n1j = 0, n1sub = 0; bool has1;
    MOBA_NEXT(cj, csub, n1j, n1sub, has1);
    __syncthreads();
    att_issue_tile(0, Kb + (size_t)(cj * 256 + csub * 64) * 512, 512, Vb + cj * 256 + csub * 64);
    if (has1) att_issue_tile(1, Kb + (size_t)(n1j * 256 + n1sub * 64) * 512, 512, Vb + n1j * 256 + n1sub * 64);
    int st = 0;
    while (has) {
        if (has1) ATT_WAIT_BAR(4); else ATT_WAIT_BAR(0);
        int n2j = 0, n2sub = 0; bool has2 = false;
        if (has1) MOBA_NEXT(n1j, n1sub, n2j, n2sub, has2);
        if (has2) att_issue_tile(st == 0 ? 2 : st - 1, Kb + (size_t)(n2j * 256 + n2sub * 64) * 512, 512, Vb + n2j * 256 + n2sub * 64);
        const char* sl = lds + st * ATT_STAGE;
        const int s0 = cj * 256 + csub * 64;
        unsigned sb = 3u; bool msk = false, run = true;
        if (cj < ob) sb = ((selw[0] >> cj) & 1u) | (((selw[1] >> cj) & 1u) << 1);
        else { msk = (csub == dsub); run = (csub <= dsub); }
        if (run) {
            if (msk) att_step<true>(sl, qf, S, bini, slope2, s0, tq0, sb, 1 << 30);
            else att_step<false>(sl, qf, S, bini, slope2, s0, tq0, sb, 1 << 30);
        }
        cj = n1j; csub = n1sub; has = has1; n1j = n2j; n1sub = n2sub; has1 = has2;
        st = (st == 2) ? 0 : st + 1;
    }
#undef MOBA_NEXT
#pragma unroll
    for (int qt = 0; qt < 2; ++qt) {
        float lt = S.l[qt]; lt += __shfl_xor(lt, 16); lt += __shfl_xor(lt, 32);
        const size_t n = (size_t)b * SEQ + tq0 + qt * 16 + fr;
        const float sc = 1.0f / fmaxf(lt, 1e-30f);
#pragma unroll
        for (int dt = 0; dt < 4; ++dt) {
            const f32x4 y = S.O[dt][qt] * sc;
            u32x2 wv; wv.x = pack2(y[0], y[1]); wv.y = pack2(y[2], y[3]);
            *(u32x2*)(p.MIX + n * DM + 512 + h * 64 + dt * 16 + fg * 4) = wv;
        }
    }
}
#ifndef ATT_NSA
#define ATT_NSA 1
#endif
#ifndef ATT_MOBA
#define ATT_MOBA 1
#endif
__device__ __forceinline__ int att_class_key(int c) {
    if (c < 64) { const int a = (c >> 1) + 1; return (a < 16 ? a : 16) + (a < 9 ? a : 9); }
    const int ob = (c - 64) >> 1, half = (c - 64) & 1; return 4 * ob + 2 + 2 * half;
}
__device__ __forceinline__ void cmpa_unit(char* lds, const P& p, int b, int g, int qt64);
__device__ __forceinline__ void phase_attn_a(char* lds, int bid, int nb, const P& p) {
    int* order = (int*)(lds + 49152);
    __syncthreads();
    for (int u = tidx(); u < 1024; u += 256) {
        const int c = u & 15, inst = u >> 4;
        const int key = att_class_key(64 + c);
        int pos = inst;
        for (int c2 = 0; c2 < 16; ++c2) { const int k2 = att_class_key(64 + c2); if (k2 > key || (k2 == key && c2 < c)) pos += 64; }
        order[pos] = u;
    }
    __syncthreads();
    for (int r = 0;; ++r) {
        const int idx = r * nb + ((r & 1) ? (nb - 1 - bid) : bid);
        if (idx >= 512 + 1024) break;
        if (idx < 512) cmpa_unit(lds, p, idx >> 6, (idx >> 5) & 1, idx & 31);
        else { const int v = order[idx - 512]; att_moba_unit(lds, p, v >> 7, (v >> 4) & 7, (v >> 1) & 7, v & 1); }
    }
    __syncthreads();
}
__device__ __forceinline__ void phase_attn_b(char* lds, int bid, int nb, const P& p) {
    int* order = (int*)(lds + ATT_ORDER_OFF);
    __syncthreads();
    for (int u = tidx(); u < 1024; u += 256) {
        const int c = u & 63, inst = u >> 6;
        const int key = att_class_key(c);
        int pos = inst;
        for (int c2 = 0; c2 < 64; ++c2) { const int k2 = att_class_key(c2); if (k2 > key || (k2 == key && c2 < c)) pos += 16; }
        order[pos] = u;
    }
    __syncthreads();
    for (int r = 0;; ++r) {
        const int idx = r * nb + ((r & 1) ? (nb - 1 - bid) : bid);
        if (idx >= 1024) break;
        const int u = order[idx];
        att_nsa_unit(lds, p, u >> 7, (u >> 6) & 1, u & 63);
    }
    __syncthreads();
}

struct ALoadCmp {
    const float* base;
    const float* pe;
    int kt0;
    struct Regs { f32x4 v[8]; };
    __device__ __forceinline__ void load(int kt, Regs& R) const {
        const int l = kt + kt0;
        const f32x4 p0 = *(const f32x4*)(pe + l * 64), p1 = *(const f32x4*)(pe + l * 64 + 4);
#pragma unroll
        for (int i = 0; i < 4; ++i) {
            const int row = (tidx() + 256 * i) >> 3; int tok = 16 * row + l; tok = tok > SEQ - 1 ? SEQ - 1 : tok;
            const float* q = base + (size_t)tok * 256;
            R.v[2 * i] = *(const f32x4*)q + p0; R.v[2 * i + 1] = *(const f32x4*)(q + 4) + p1;
        }
    }
    __device__ __forceinline__ void store(int kt, const Regs& R, char* lds) const {
#pragma unroll
        for (int i = 0; i < 4; ++i) {
            const int p = tidx() + 256 * i, row = p >> 3, ch = p & 7;
            const f32x4 a = R.v[2 * i], b = R.v[2 * i + 1];
            u32x4 w; w.x = pack2(a[0], a[1]); w.y = pack2(a[2], a[3]); w.z = pack2(b[0], b[1]); w.w = pack2(b[2], b[3]);
            *(u32x4*)(lds + lds_off(row, ch * 8)) = w;
        }
    }
};
__device__ __forceinline__ void phase_cmp1(char* lds, int bid, int nb, const P& p) {
    const int tid = tidx(), lane = tid & 63, wid = tid >> 6, wr = wid >> 1, wc = wid & 1, fr = lane & 15, fq = lane >> 4;
    for (int u = bid; u < 16 * 2 * 4; u += nb) {
        const int split = u & 3, which = (u >> 2) & 1, bg = u >> 3, b = bg >> 1, g = bg & 1;
        ALoadCmp al; al.kt0 = split * 8; al.base = p.KCV + (size_t)b * SEQ * 256 + which * 128 + g * 64 + (tid & 7) * 8; al.pe = (which ? p.pe_v : p.pe_k) + (tid & 7) * 8;
        BLoadF32 bl; { const int nq = tid & 31, kg = tid >> 5; bl.valid = true; bl.ldb = 128; bl.nk1 = 1 << 30; bl.bp = (which ? p.wv1 : p.wk1) + (size_t)(split * 8 * 64 + kg * 8) * 128 + nq * 4; }
        f32x4 acc[4][4];
        gemm_tile(lds, al, bl, 8, acc);
        float* hid = p.HID + (((size_t)split * 2 + which) * 2048 + bg * 128) * 128;
#pragma unroll
        for (int m = 0; m < 4; ++m)
#pragma unroll
            for (int n = 0; n < 4; ++n) {
                const int row = wr * 64 + m * 16 + fr, col = wc * 64 + n * 16 + fq * 4;
                *(f32x4*)(hid + (size_t)row * 128 + col) = acc[m][n];
            }
    }
}
__device__ __forceinline__ void phase_cmp2(char* lds, int bid, int nb, const P& p) {
    const int tid = tidx(), lane = tid & 63, wid = tid >> 6;
    float* hs = (float*)lds + wid * 128;
    for (int it = bid * 4 + wid; it < 2 * 16 * 128; it += nb * 4) {
        const int which = it >> 11, bg = (it >> 7) & 15, c = it & 127;
        float o = 0.f;
        if (c < 127) {
            const float* hid = p.HID + ((size_t)which * 2048 + bg * 128 + c) * 128;
            const size_t ss = (size_t)2 * 2048 * 128;
            __builtin_amdgcn_wave_barrier();
            hs[lane] = gelu_tanh((hid[lane] + hid[ss + lane]) + (hid[2 * ss + lane] + hid[3 * ss + lane]));
            hs[lane + 64] = gelu_tanh((hid[lane + 64] + hid[ss + lane + 64]) + (hid[2 * ss + lane + 64] + hid[3 * ss + lane + 64]));
            __builtin_amdgcn_wave_barrier();
            const float* w2 = which ? p.wv2 : p.wk2;
#pragma unroll 8
            for (int j = 0; j < 128; ++j) o += hs[j] * w2[j * 64 + lane];
        }
        if (which == 0) p.KCb[((size_t)bg * 128 + c) * 64 + lane] = (bf16_t)f2bf(o);
        else p.VCt[((size_t)bg * 64 + lane) * 128 + c] = (bf16_t)f2bf(o);
    }
}
#define CMPA_LDS (2 * 16384 + 4 * 2048)
__device__ __forceinline__ void cmpa_unit(char* lds, const P& p, int b, int g, int qt64) {
    const int tid = tidx(), lane = tid & 63, w = tid >> 6, fr = lane & 15, fg = lane >> 4;
    const int bg = b * 2 + g;
    char* kc = lds; char* vt = lds + 16384;
    __syncthreads();
#pragma unroll
    for (int i = 0; i < 4; ++i) { const int pc = tid + 256 * i;
        *(u32x4*)(kc + lds_off(pc >> 3, (pc & 7) * 8)) = *(const u32x4*)(p.KCb + (size_t)bg * 8192 + pc * 8);
        *(u32x4*)(vt + lds_off128(pc >> 4, (pc & 15) * 8)) = *(const u32x4*)(p.VCt + (size_t)bg * 8192 + pc * 8); }
    __syncthreads();
    const int t = qt64 * 64 + w * 16 + fr;
    const size_t n = (size_t)b * SEQ + t;
    const float c1 = 0.125f * LOG2E;
    f32x4 psum[8];
#pragma unroll
    for (int ct = 0; ct < 8; ++ct) psum[ct] = (f32x4){0.f, 0.f, 0.f, 0.f};
    bf16x8 qall[4][2];
#pragma unroll
    for (int i = 0; i < 4; ++i) { qall[i][0] = *(const bf16x8*)(p.Qb + n * 512 + (g * 4 + i) * 64 + fg * 8); qall[i][1] = *(const bf16x8*)(p.Qb + n * 512 + (g * 4 + i) * 64 + 32 + fg * 8); }
#pragma unroll
    for (int i = 0; i < 4; ++i) {
        const int hd = g * 4 + i;
        const float slope2 = exp2f(-((float)hd + 0.5f)) * LOG2E;
        const bf16x8 q0 = qall[i][0], q1 = qall[i][1];
        __builtin_amdgcn_sched_barrier(0);
        f32x4 s[8];
        float mx = -INFINITY;
#pragma unroll
        for (int ct = 0; ct < 8; ++ct) {
            const bf16x8 k0 = *(const bf16x8*)(kc + lds_off(ct * 16 + fr, fg * 8)), k1 = *(const bf16x8*)(kc + lds_off(ct * 16 + fr, 32 + fg * 8));
            s[ct] = __builtin_amdgcn_mfma_f32_16x16x32_bf16(k0, q0, (f32x4){0.f, 0.f, 0.f, 0.f}, 0, 0, 0);
            s[ct] = __builtin_amdgcn_mfma_f32_16x16x32_bf16(k1, q1, s[ct], 0, 0, 0);
#pragma unroll
            for (int r = 0; r < 4; ++r) {
                const int e = 16 * (ct * 16 + fg * 4 + r) + 31;
                const float y = (e <= t) ? fmaf(s[ct][r], c1, -slope2 * (float)(t - e)) : -INFINITY;
                s[ct][r] = y; mx = fmaxf(mx, y);
            }
        }
        __builtin_amdgcn_sched_barrier(0);
        mx = fmaxf(mx, __shfl_xor(mx, 16)); mx = fmaxf(mx, __shfl_xor(mx, 32));
        const float mm = (mx == -INFINITY) ? 0.f : mx;
        float ls = 0.f;
#pragma unroll
        for (int ct = 0; ct < 8; ++ct)
#pragma unroll
            for (int r = 0; r < 4; ++r) { const float e = __builtin_amdgcn_exp2f(s[ct][r] - mm); s[ct][r] = e; ls += e; }
        ls += __shfl_xor(ls, 16); ls += __shfl_xor(ls, 32);
        const float inv = 1.0f / fmaxf(ls, 1e-30f);
#pragma unroll
        for (int ct = 0; ct < 8; ++ct) { s[ct] *= inv; psum[ct] += s[ct]; }
        __builtin_amdgcn_sched_barrier(0);
        f32x4 o[4];
#pragma unroll
        for (int dt = 0; dt < 4; ++dt) o[dt] = (f32x4){0.f, 0.f, 0.f, 0.f};
#pragma unroll
        for (int kk = 0; kk < 4; ++kk) {
            u32x4 pw; pw.x = pack2(s[2 * kk][0], s[2 * kk][1]); pw.y = pack2(s[2 * kk][2], s[2 * kk][3]); pw.z = pack2(s[2 * kk + 1][0], s[2 * kk + 1][1]); pw.w = pack2(s[2 * kk + 1][2], s[2 * kk + 1][3]);
            const bf16x8 pf = __builtin_bit_cast(bf16x8, pw);
#pragma unroll
            for (int dt = 0; dt < 4; ++dt) {
                const int c0 = kk * 32 + fg * 4;
                const u32x2 v0 = *(const u32x2*)(vt + lds_off128(dt * 16 + fr, c0 & ~7) + (c0 & 7) * 2);
                const u32x2 v1 = *(const u32x2*)(vt + lds_off128(dt * 16 + fr, (c0 + 16) & ~7) + (c0 & 7) * 2);
                u32x4 vv; vv.x = v0.x; vv.y = v0.y; vv.z = v1.x; vv.w = v1.y;
                o[dt] = __builtin_amdgcn_mfma_f32_16x16x32_bf16(__builtin_bit_cast(bf16x8, vv), pf, o[dt], 0, 0, 0);
            }
        }
#pragma unroll
        for (int dt = 0; dt < 4; ++dt) { u32x2 w; w.x = pack2(o[dt][0], o[dt][1]); w.y = pack2(o[dt][2], o[dt][3]); *(u32x2*)((bf16_t*)p.OC + n * 512 + hd * 64 + dt * 16 + fg * 4) = w; }
    }
    const int own = t >> 6;
    float val[8];
#pragma unroll
    for (int ct = 0; ct < 8; ++ct) {
        const float up = __shfl(psum[ct][3], (lane + 48) & 63);
        const float up0 = (ct > 0) ? __shfl(psum[ct > 0 ? ct - 1 : 0][3], (lane + 48) & 63) : 0.f;
        const float imp = (psum[ct][0] + psum[ct][1]) + (psum[ct][2] + psum[ct][3]) + (fg > 0 ? up : up0);
        const int j = ct * 4 + fg;
        const bool forced = (j == 0) || (j == own) || (j == own - 1);
        val[ct] = (j <= own) ? (imp + (forced ? 1e4f : 0.f)) : NEGF;
    }
    float* vs = (float*)(lds + 32768) + w * 512;
    __builtin_amdgcn_wave_barrier();
#pragma unroll
    for (int ct = 0; ct < 8; ++ct) vs[fr * 32 + ct * 4 + fg] = val[ct];
    __builtin_amdgcn_wave_barrier();
    int rank[8];
#pragma unroll
    for (int ct = 0; ct < 8; ++ct) rank[ct] = 0;
#pragma unroll 2
    for (int oj = 0; oj < 32; ++oj) {
        const float ov = vs[fr * 32 + oj];
#pragma unroll
        for (int ct = 0; ct < 8; ++ct) rank[ct] += (ov > val[ct] || (ov == val[ct] && oj < ct * 4 + fg)) ? 1 : 0;
    }
    __builtin_amdgcn_wave_barrier();
    unsigned bits = 0;
#pragma unroll
    for (int ct = 0; ct < 8; ++ct) if ((ct * 4 + fg <= own) && rank[ct] < 16) bits |= 1u << (ct * 4 + fg);
    bits |= (unsigned)__shfl_xor((int)bits, 16); bits |= (unsigned)__shfl_xor((int)bits, 32);
    if (fg == 0) p.SELM[(size_t)bg * SEQ + t] = bits;
}
#define MEGA_LDS (((HG3_LDS + 255) & ~255) + 16)
static_assert(HG3_LDS >= G4_LDS && HG3_LDS >= CMPA_LDS && HG3_LDS >= GEMM_LDS && HG3_LDS >= ATT_RED_OFF + 16, "LDS map");
#define GBAR() xcd_barrier(bar)

template <int LAYER>
__device__ __forceinline__ void moe_block(char* lds, int bid, int nb, const P& p, const XcdBarrier& bar, float* of, bf16_t* ob, bf16_t* ol) {
    if (bid < 32) p.cnt[bid * NEXP + tidx()] = 0;
    phase_router(bid, nb, p, LAYER);
    GBAR();
    phase_route(bid, nb, p, LAYER);
    GBAR();
    phase_scatter(lds, bid, nb, p);
    GBAR();
    phase_moe1(lds, bid, nb, p, LAYER, p.XAb);
    GBAR();
    phase_moe2(lds, bid, nb, p, LAYER);
    GBAR();
    phase_combine_ln(bid, nb, p, p.XA, p.ln_g + (LAYER * 2 + 1) * DM, p.ln_b + (LAYER * 2 + 1) * DM, of, ob, ol);
}

__global__ void __launch_bounds__(256, 2) mega(P p) {
    char* lds = dyn_lds;
    const int bid = blockIdx.x, nb = gridDim.x;
    volatile LAS unsigned* st = (volatile LAS unsigned*)(dyn_lds + MEGA_LDS - 16);
    if (tidx() == 0) { st[0] = 0u; st[1] = 0u; st[2] = 0u; st[3] = 0u; }
    __syncthreads();
    const XcdBarrier bar = xcd_barrier_post(p.bar, st);
    phase_prep(lds, bid, nb, p);
    GBAR();
    phase_inproj0(lds, bid, nb, p);
    GBAR();
    phase_mix0_a(lds, bid, nb, p);
    GBAR();
    phase_hg2(bid, nb, p);
    for (int u = nb - 1 - bid; u < 512; u += nb) lru2_unit(p, u >> 6, (u >> 1) & 31, u & 1);
    GBAR();
    phase_mix0_c(lds, bid, nb, p);
    GBAR();
    phase_gemm_f32out(bid, nb, p.MIX, p.WOUT0, DM, DM, p.T0);
    GBAR();
    phase_ln_add(bid, nb, p.x, nullptr, nullptr, p.T0, p.ln_g, p.ln_b, nullptr, p.XAb, p.XAl);
    GBAR();
    moe_block<0>(lds, bid, nb, p, bar, nullptr, p.XBb, nullptr);
    GBAR();
    phase_inproj1(lds, bid, nb, p);
    GBAR();
    phase_cmp1(lds, bid, nb, p);
    phase_moba_kmean(bid, nb, p);
    GBAR();
    phase_cmp2(lds, bid, nb, p);
    phase_moba_gate(lds, bid, nb, p);
    GBAR();
    phase_attn_a(lds, bid, nb, p);
    GBAR();
    phase_attn_b(lds, bid, nb, p);
    GBAR();
    phase_gemm_f32out(bid, nb, p.MIX, p.WOUT1, DM, DM, p.T0);
    GBAR();
    phase_ln_add(bid, nb, nullptr, p.XBb, p.XBl, p.T0, p.ln_g + 2 * DM, p.ln_b + 2 * DM, nullptr, p.XAb, p.XAl);
    GBAR();
    moe_block<1>(lds, bid, nb, p, bar, p.out, nullptr, nullptr);
}

static inline size_t al256(size_t x) { return (x + 255) & ~(size_t)255; }

extern "C" void kernel_launch(void* const* d_in, const int* in_sizes, int n_in, void* d_out, int out_size, void* d_ws, size_t ws_size, hipStream_t stream) {
    P p{};
    const float** ip = (const float**)&p.x;
    for (int i = 0; i < 30; ++i) ip[i] = (const float*)d_in[i];
    p.out = (float*)d_out;
    char* w = (char*)d_ws; size_t o = 0;
    auto take = [&](size_t bytes) { char* r = w + o; o = al256(o + bytes); return r; };
    p.bar = (unsigned*)take(XCD_BAR_WORDS * 4);
    p.U = (float*)take((size_t)NTOK * EVEN_IN * 4);
    p.MIX = (bf16_t*)take((size_t)NTOK * DM * 2);
    p.T0 = (float*)take((size_t)NTOK * DM * 4);
    p.XA = (float*)take((size_t)NTOK * DM * 4); p.XAb = (bf16_t*)take((size_t)NTOK * DM * 2); p.XAl = (bf16_t*)take((size_t)NTOK * DM * 2); p.XBl = (bf16_t*)take((size_t)NTOK * DM * 2);
    p.XB = (float*)take((size_t)NTOK * DM * 4); p.XBb = (bf16_t*)take((size_t)NTOK * DM * 2);
    p.LOG = (float*)take((size_t)3 * NTOK * NEXP * 4);
    p.eidx = (int*)take(NTOK * 8 * 4); p.ew = (float*)take(NTOK * 8 * 4); p.erank = (int*)take(NTOK * 8 * 4); p.epos = (int*)take(NTOK * 8 * 4);
    p.cnt = (int*)take(32 * NEXP * 4); p.tile_e = (int*)take(NTILES * 4); p.rowtok = (int*)take(NROWS * 4);
    p.H = (bf16_t*)take((size_t)NROWS * 256 * 2);
    p.Y = (bf16_t*)take((size_t)NROWS * DM * 2);
    p.LA = (float*)take((size_t)NTOK * 512 * 4); p.LB = (float*)take((size_t)NTOK * 512 * 4);
    p.KC = (float*)take(16 * 127 * 64 * 4); p.VC = (float*)take(16 * 127 * 64 * 4);
    p.OC = (float*)take((size_t)NTOK * 512 * 4);
    p.SELM = (unsigned*)take(16 * SEQ * 4);
    p.KM = (float*)take(8 * 8 * 8 * 64 * 4);
    p.Qb = (bf16_t*)take((size_t)NTOK * 512 * 2); p.KS = (bf16_t*)take((size_t)NTOK * 128 * 2); p.VSt = (bf16_t*)take((size_t)NTOK * 128 * 2);
    p.KW = (bf16_t*)take((size_t)NTOK * 128 * 2); p.VWt = (bf16_t*)take((size_t)NTOK * 128 * 2);
    p.MQ = (bf16_t*)take((size_t)NTOK * 512 * 2); p.MK = (bf16_t*)take((size_t)NTOK * 512 * 2); p.MVt = (bf16_t*)take((size_t)NTOK * 512 * 2);
    p.KCV = (float*)take((size_t)NTOK * 256 * 4); p.GATES = (float*)take((size_t)NTOK * 24 * 4); p.OS = (float*)take((size_t)NTOK * 512 * 4);
    p.MSEL = (unsigned*)take(64 * SEQ * 4);
    p.UB0 = (bf16_t*)take((size_t)NTOK * 2560 * 2); p.VHt = (bf16_t*)take((size_t)NTOK * 512 * 2);
    p.WAT = (bf16_t*)take(8 * 64 * 64 * 2); p.WXT = (bf16_t*)take(8 * 64 * 64 * 2);
    p.CSA = (float*)take(8 * 32 * 512 * 4); p.CSB = (float*)take(8 * 32 * 512 * 4);
    p.UT = (bf16_t*)take((size_t)1024 * 16384 * 2); p.SP = (bf16_t*)take((size_t)1024 * 16384 * 2);
    p.DV = (float*)take(1024 * 128 * 4);
    p.XIb = (bf16_t*)take((size_t)NTOK * DM * 2);
    p.plist = (int*)take(8 * 320 * 4); p.plen = (int*)take(64);
    p.WIN0 = (bf16_t*)take((size_t)EVEN_IN * DM * 2); p.WOUT0 = (bf16_t*)take((size_t)DM * DM * 2); p.WIN1 = (bf16_t*)take((size_t)2944 * DM * 2); p.WOUT1 = (bf16_t*)take((size_t)DM * DM * 2);
    p.WRH = (bf16_t*)take((size_t)2 * NEXP * DM * 2); p.WRL = (bf16_t*)take((size_t)2 * NEXP * DM * 2);
    p.HID = (float*)take((size_t)4 * 2 * 2048 * 128 * 4); p.KCb = (bf16_t*)take(16 * 128 * 64 * 2); p.VCt = (bf16_t*)take(16 * 64 * 128 * 2);
    if (o > ws_size) return;

    static int grid = 0;
    if (!grid) {
        int dev = 0, cus = 0, per_cu = 0;
        (void)hipGetDevice(&dev);
        (void)hipDeviceGetAttribute(&cus, hipDeviceAttributeMultiprocessorCount, dev);
        (void)hipFuncSetAttribute((const void*)mega, hipFuncAttributeMaxDynamicSharedMemorySize, MEGA_LDS);
        (void)hipOccupancyMaxActiveBlocksPerMultiprocessor(&per_cu, (const void*)mega, 256, MEGA_LDS);
        if (per_cu < 1) per_cu = 1;
        grid = cus * (per_cu < 2 ? per_cu : 2);
    }
    (void)hipMemsetAsync(p.bar, 0, XCD_BAR_WORDS * 4, stream);
    hipLaunchKernelGGL(mega, dim3(grid), dim3(256), MEGA_LDS, stream, p);
}
```

```cpp
#include <hip/hip_runtime.h>
#include <hip/hip_bf16.h>
#include <stdint.h>

#define NTOK 16384
#define DM 1024
#define SEQ 2048
#define NBATCH 8
#define EVEN_IN 3072
#define ODD_IN 2840
#define NEXP 256
#define NEGF (-1e30f)
#define LOG2E 1.4426950408889634f
#define DN_ALPHA 1.4142135623730951f
#define LN_EPS 1e-5f
#define MAXRT 1280
#define SH_TILE0 1280
#define NTILES (1280 + 128)
#define NROWS (NTILES * 128)

typedef unsigned short bf16_t;
typedef short bf16x8 __attribute__((ext_vector_type(8)));
typedef float f32x4 __attribute__((ext_vector_type(4)));
typedef unsigned u32x4 __attribute__((ext_vector_type(4)));
typedef unsigned u32x2 __attribute__((ext_vector_type(2)));
extern __shared__ __attribute__((aligned(16))) char dyn_lds[];
#define LAS __attribute__((address_space(3)))

__device__ __forceinline__ int tidx() { int t = threadIdx.x; asm volatile("" : "+v"(t)); return t; }
__device__ __forceinline__ float wave_sum(float v) {
#pragma unroll
    for (int o = 32; o >= 1; o >>= 1) v += __shfl_xor(v, o);
    return v;
}
__device__ __forceinline__ float wave_max(float v) {
#pragma unroll
    for (int o = 32; o >= 1; o >>= 1) v = fmaxf(v, __shfl_xor(v, o));
    return v;
}
typedef __bf16 hwbf16x2 __attribute__((ext_vector_type(2)));
typedef float f32x2 __attribute__((ext_vector_type(2)));
__device__ __forceinline__ unsigned f2bf(float f) { const __bf16 h = (__bf16)f; return (unsigned)__builtin_bit_cast(unsigned short, h); }
__device__ __forceinline__ float bf2f(unsigned b) { return __uint_as_float(b << 16); }
__device__ __forceinline__ unsigned pack2(float lo, float hi) { const f32x2 f = {lo, hi}; const hwbf16x2 v = __builtin_convertvector(f, hwbf16x2); return __builtin_bit_cast(unsigned, v); }
__device__ __forceinline__ float sigmoidf_(float x) { return 1.0f / (1.0f + __expf(-x)); }
__device__ __forceinline__ float siluf_(float x) { return x / (1.0f + __expf(-x)); }
__device__ __forceinline__ float gelu_tanh(float x) {
    const float u2 = 1.5957691216057308f * (x + 0.044715f * x * x * x);
    return x / (1.0f + __expf(-u2));
}


#define XB_TMO      128
#define XB_XCNT(j)  (256  + 64 * (j))
#define XB_XSUB(j)  (1280 + 64 * (j))
#define XB_XGEN(j)  (2304 + 64 * (j))
#define XB_TOP      3328
#define XB_TOPGEN   3392
#define XCD_BAR_WORDS 3456
#define XB_SPIN_CAP (1u << 18)
__device__ __forceinline__ unsigned xb_ld(unsigned* p)              { return __hip_atomic_load(p, __ATOMIC_RELAXED, __HIP_MEMORY_SCOPE_AGENT); }
__device__ __forceinline__ unsigned xb_add(unsigned* p, unsigned v) { return __hip_atomic_fetch_add(p, v, __ATOMIC_RELAXED, __HIP_MEMORY_SCOPE_AGENT); }
__device__ __forceinline__ unsigned xb_xcc_id() { return (unsigned)__builtin_amdgcn_s_getreg((3 << 11) | 20) & 0xFu; }
#define XB_SPIN(cond, bar) do { unsigned _sp = 0; while (cond) { __builtin_amdgcn_s_sleep(1); \
    if ((++_sp & 255u) == 0u) { if (xb_ld(&(bar)[XB_TMO])) break; if (_sp > XB_SPIN_CAP) { atomicAdd(&(bar)[XB_TMO], 1u); break; } } } } while (0)
struct XcdBarrier { unsigned* bar; unsigned x; volatile LAS unsigned* st; };
__device__ __forceinline__ XcdBarrier xcd_barrier_post(unsigned* bar, volatile LAS unsigned* st) {
    XcdBarrier b; b.bar = bar; b.x = xb_xcc_id(); b.st = st;
    if (tidx() == 0) (void)xb_add(&bar[XB_XCNT(b.x)], 1u);
    return b;
}
__device__ __forceinline__ void xcd_barrier_complete(unsigned* bar, unsigned x, unsigned& nloc, unsigned& nx) {
    const unsigned G = gridDim.x * gridDim.y * gridDim.z;
    unsigned sum, cnt, mine, sp = 0u;
    for (;;) {
        sum = 0u; cnt = 0u; mine = 0u;
#pragma unroll
        for (unsigned j = 0; j < 16; ++j) { const unsigned c = xb_ld(&bar[XB_XCNT(j)]); sum += c; cnt += (c > 0u) ? 1u : 0u; mine = (j == x) ? c : mine; }
        if (sum == G) break;
        __builtin_amdgcn_s_sleep(1);
        if ((++sp & 255u) == 0u) { if (xb_ld(&bar[XB_TMO])) break; if (sp > XB_SPIN_CAP) { atomicAdd(&bar[XB_TMO], 1u); break; } }
    }
    nloc = mine > 0u ? mine : 1u; nx = cnt > 0u ? cnt : 1u;
}
__device__ __forceinline__ void xcd_barrier(const XcdBarrier& b) {
    asm volatile("s_waitcnt vmcnt(0)" ::: "memory");
    __syncthreads();
    if (tidx() == 0) {
        unsigned* bar = b.bar;
        __builtin_amdgcn_s_waitcnt(0);
        unsigned nloc = b.st[0], nx = b.st[1];
        if (nloc == 0u) { xcd_barrier_complete(bar, b.x, nloc, nx); b.st[0] = nloc; b.st[1] = nx; }
        const unsigned old = xb_add(&bar[XB_XSUB(b.x)], 1u);
        const unsigned gen = old / nloc;
        if (old + 1u == (gen + 1u) * nloc) {
            __builtin_amdgcn_fence(__ATOMIC_RELEASE, "agent");
            asm volatile("s_waitcnt vmcnt(0)" ::: "memory");
            const unsigned og = xb_add(&bar[XB_TOP], 1u);
            const unsigned tg = og / nx;
            if (og + 1u == (tg + 1u) * nx) xb_add(&bar[XB_TOPGEN], 1u);
            else XB_SPIN(xb_ld(&bar[XB_TOPGEN]) == tg, bar);
            __builtin_amdgcn_fence(__ATOMIC_ACQUIRE, "agent");
            xb_add(&bar[XB_XGEN(b.x)], 1u);
            asm volatile("s_waitcnt vmcnt(0)" ::: "memory");
        } else {
            XB_SPIN(xb_ld(&bar[XB_XGEN(b.x)]) == gen, bar);
            __builtin_amdgcn_fence(__ATOMIC_ACQUIRE, "agent");
            asm volatile("s_waitcnt vmcnt(0)" ::: "memory");
        }
    }
    __syncthreads();
}

struct P {
    const float *x, *even_w_in, *conv_w, *conv_b, *wa, *ba, *wx, *bx, *lam, *hg_lb, *hg_ng, *even_w_out;
    const float *odd_w_in, *pe_k, *pe_v, *wk1, *wk2, *wv1, *wv2, *odd_w_out, *ln_g, *ln_b, *w_router, *b_router;
    const float *w_gate, *w_up, *w_down, *ws_gate, *ws_up, *ws_down;
    float* out;
    float* U;
    bf16_t* MIX;
    float* T0;
    float* XA; bf16_t* XAb; float* XB; bf16_t* XBb; bf16_t* XAl; bf16_t* XBl;
    float* LOG;
    int* eidx; float* ew; int* erank; int* epos;
    int* cnt;
    int* tile_e;
    int* rowtok;
    bf16_t* H;
    bf16_t* Y;
    float* LA; float* LB;
    float* KC; float* VC;
    float* OC;
    unsigned* SELM;
    float* KM;
    unsigned* bar;
    bf16_t *Qb, *KS, *VSt, *KW, *VWt, *MQ, *MK, *MVt;
    float *KCV, *GATES, *OS; unsigned* MSEL;
    bf16_t *UB0;
    bf16_t *VHt;
    bf16_t *WAT, *WXT;
    float *CSA, *CSB;
    bf16_t *UT, *SP;
    float *DV;
    float *HID;
    bf16_t *KCb, *VCt;
    bf16_t *XIb;
    int *plist; int *plen;
    bf16_t *WIN0, *WOUT0, *WIN1, *WOUT1, *WRH, *WRL;
};

__device__ __forceinline__ int lds_off(int r, int c) {
    const int st = (r >> 4) * 2 + (c >> 5), ob = (r & 15) * 64 + (c & 31) * 2;
    return st * 1024 + (ob ^ (((ob >> 9) & 1) << 5));
}
#define GEMM_LDS 32768

__device__ __forceinline__ float cvt_part(float v, int lo) { return lo ? (v - bf2f(f2bf(v))) : v; }

struct BLoadF32 {
    const float* bp; int ldb; bool valid; int nk1;
    struct Regs { f32x4 v[8]; };
    __device__ __forceinline__ void load(int kt, Regs& R) const {
        const float* p = bp + (size_t)((kt % nk1) * 64) * ldb;
#pragma unroll
        for (int j = 0; j < 8; ++j) R.v[j] = valid ? *(const f32x4*)(p + (size_t)j * ldb) : (f32x4){0.f, 0.f, 0.f, 0.f};
    }
    __device__ __forceinline__ void store(int kt, const Regs& R, char* lds) const {
        const int lo = (kt / nk1) == 1;
        const int nq = tidx() & 31, kg = tidx() >> 5;
#pragma unroll
        for (int i = 0; i < 4; ++i) {
            u32x4 w;
            w.x = pack2(cvt_part(R.v[0][i], lo), cvt_part(R.v[1][i], lo)); w.y = pack2(cvt_part(R.v[2][i], lo), cvt_part(R.v[3][i], lo));
            w.z = pack2(cvt_part(R.v[4][i], lo), cvt_part(R.v[5][i], lo)); w.w = pack2(cvt_part(R.v[6][i], lo), cvt_part(R.v[7][i], lo));
            *(u32x4*)(lds + lds_off(nq * 4 + i, kg * 8)) = w;
        }
    }
};

template <class AL, class BL>
__device__ __forceinline__ void gemm_tile(char* lds, const AL& al, const BL& bl, int nk, f32x4 (&acc)[4][4], bool swap = false) {
    const int lane = tidx() & 63, wid = tidx() >> 6, wr = wid >> 1, wc = wid & 1, fr = lane & 15, fq = lane >> 4;
    char* ldsA = lds; char* ldsB = lds + 16384;
    const char* t2 = swap ? ldsB : ldsA; const char* t1 = swap ? ldsA : ldsB; const int w2 = swap ? wc : wr, w1 = swap ? wr : wc;
#pragma unroll
    for (int m = 0; m < 4; ++m)
#pragma unroll
        for (int n = 0; n < 4; ++n) acc[m][n] = (f32x4){0.f, 0.f, 0.f, 0.f};
    typename AL::Regs ra; typename BL::Regs rb;
    al.load(0, ra); bl.load(0, rb);
    for (int kt = 0; kt < nk; ++kt) {
        __syncthreads();
        al.store(kt, ra, ldsA); bl.store(kt, rb, ldsB);
        __syncthreads();
        if (kt + 1 < nk) { al.load(kt + 1, ra); bl.load(kt + 1, rb); }
#pragma unroll
        for (int kk = 0; kk < 2; ++kk) {
            bf16x8 a[4], b[4];
#pragma unroll
            for (int m = 0; m < 4; ++m) a[m] = *(const bf16x8*)(t2 + lds_off(w2 * 64 + m * 16 + fr, kk * 32 + fq * 8));
#pragma unroll
            for (int n = 0; n < 4; ++n) b[n] = *(const bf16x8*)(t1 + lds_off(w1 * 64 + n * 16 + fr, kk * 32 + fq * 8));
#pragma unroll
            for (int m = 0; m < 4; ++m)
#pragma unroll
                for (int n = 0; n < 4; ++n) acc[m][n] = __builtin_amdgcn_mfma_f32_16x16x32_bf16(b[n], a[m], acc[m][n], 0, 0, 0);
        }
    }
}


__device__ __forceinline__ void dma_rc(int lane, int st, int& R, int& C) {
    const int sb = lane * 16, swz = sb ^ (((sb >> 9) & 1) << 5);
    R = (st >> 1) * 16 + (swz >> 6); C = (st & 1) * 32 + ((swz & 63) >> 1);
}
#define G3_STAGE 24576
#define G3_LDS (2 * G3_STAGE)
__device__ __forceinline__ int t32_off(int r, int c) { const int ob = (r & 15) * 64 + c * 2; return (r >> 4) * 1024 + (ob ^ (((ob >> 9) & 1) << 5)); }
__device__ __forceinline__ void dma_rc32(int lane, int st, int& R, int& C) { const int sb = lane * 16, swz = sb ^ (((sb >> 9) & 1) << 5); R = st * 16 + (swz >> 6); C = (swz & 63) >> 1; }
struct Dma3A {
    static constexpr int NV = 4;
    const char* base; unsigned voff[4];
    const char* lo = nullptr; int nk1 = 1 << 30;
    __device__ __forceinline__ void set_dense(const bf16_t* b0, int row0, int ld) {
        base = (const char*)b0; const int lane = tidx() & 63, w = tidx() >> 6;
#pragma unroll
        for (int i = 0; i < 4; ++i) { int R, C; dma_rc32(lane, w + 4 * i, R, C); voff[i] = (unsigned)(((size_t)(row0 + R) * ld + C) * 2); }
    }
    template <int SET = 0> __device__ __forceinline__ void issue(int kt, int ldsoff) const {
        const int w = tidx() >> 6;
#pragma unroll
        for (int i = 0; i < 4; ++i)
            __builtin_amdgcn_global_load_lds((const unsigned*)((((kt / nk1) == 2) ? lo : base) + voff[i] + (size_t)(kt % nk1) * 64), (LAS unsigned*)((LAS char*)dyn_lds + ldsoff + (w + 4 * i) * 1024), 16, 0, 0);
    }
    template <int SET = 0> __device__ __forceinline__ void commit(int, int) const {}
};
struct Dma3B {
    static constexpr int LAYOUT = 0, NV = 2;
    const char* hi; const char* lo; unsigned voff[2]; int nk1;
    __device__ __forceinline__ void set(const bf16_t* h, const bf16_t* l, int row0, int ld, int nk1_) {
        hi = (const char*)h; lo = (const char*)l; nk1 = nk1_; const int lane = tidx() & 63, w = tidx() >> 6;
#pragma unroll
        for (int i = 0; i < 2; ++i) { int R, C; dma_rc32(lane, w + 4 * i, R, C); const int Rs = (R & ~31) + 8 * ((R & 15) >> 2) + 4 * ((R >> 4) & 1) + (R & 3);
            voff[i] = (unsigned)(((size_t)(row0 + Rs) * ld + C) * 2); }
    }
    template <int SET = 0> __device__ __forceinline__ void issue(int kt, int ldsoff) const {
        const int w = tidx() >> 6; const char* base = ((kt / nk1) == 1) ? lo : hi; const size_t ko = (size_t)(kt % nk1) * 64;
#pragma unroll
        for (int i = 0; i < 2; ++i)
            __builtin_amdgcn_global_load_lds((const unsigned*)(base + voff[i] + ko), (LAS unsigned*)((LAS char*)dyn_lds + ldsoff + (w + 4 * i) * 1024), 16, 0, 0);
    }
    template <int SET = 0> __device__ __forceinline__ void commit(int, int) const {}
};
struct Reg3B {
    static constexpr int LAYOUT = 1, NV = 4;
    const float* bp; int ldb; f32x4 v[2][4]; int perm64 = 0;
    template <int SET = 0> __device__ __forceinline__ void issue(int kt, int) {
        const float* p = bp + (size_t)(kt * 32) * ldb;
#pragma unroll
        for (int j = 0; j < 4; ++j) v[SET][j] = *(const f32x4*)(p + (size_t)j * ldb);
    }
    template <int SET = 0> __device__ __forceinline__ void commit(int, int ldsoff) const {
        const int tid = tidx(), nq = tid & 31, kg = tid >> 5;
        u32x2 w[4];
#pragma unroll
        for (int i = 0; i < 4; ++i) { w[i].x = pack2(v[SET][0][i], v[SET][1][i]); w[i].y = pack2(v[SET][2][i], v[SET][3][i]); }
        const int q = nq & 7, q16 = nq & 15;
        const int rowbase = perm64 ? ((nq >> 4) * 64 + (q16 & 3) * 16 + (q16 >> 2) * 4) : ((nq >> 3) * 32 + (q & 1) * 16 + (q >> 1) * 4);
        const int rot = perm64 ? (q16 & 3) : ((q & 1) + 2 * ((q >> 2) & 1));
#pragma unroll
        for (int i = 0; i < 4; ++i) {
            const int e = (i + rot) & 3;
            u32x2 d;
            d.x = e == 0 ? w[0].x : (e == 1 ? w[1].x : (e == 2 ? w[2].x : w[3].x));
            d.y = e == 0 ? w[0].y : (e == 1 ? w[1].y : (e == 2 ? w[2].y : w[3].y));
            *(u32x2*)(dyn_lds + ldsoff + ((((kg >> 1) * 128 + rowbase + e) << 4) + (kg & 1) * 8)) = d;
        }
    }
};
#define G4_LDS (3 * G3_STAGE)
template <class AL, class BL, int PAR>
__device__ __forceinline__ void g4_step(AL& al, BL& bl, int kt, int nk, f32x4 (&acc)[32], bool idle) {
    constexpr int NV = AL::NV + BL::NV;
    const int lane = tidx() & 63, wid = tidx() >> 6, wr = wid >> 1, wc = wid & 1, fr = lane & 15, fq = lane >> 4;
    const int s0 = kt % 3, cur = s0 * G3_STAGE, nx1 = (s0 == 2 ? 0 : s0 + 1) * G3_STAGE, nx2 = (s0 == 0 ? 2 : s0 - 1) * G3_STAGE;
    if (kt + 1 < nk) asm volatile("s_waitcnt vmcnt(%0) lgkmcnt(0)" :: "n"(NV) : "memory");
    else asm volatile("s_waitcnt vmcnt(0) lgkmcnt(0)" ::: "memory");
    __builtin_amdgcn_s_barrier();
    asm volatile("" ::: "memory");
    if (kt + 2 < nk) { al.template issue<PAR>(kt + 2, nx2); bl.template issue<PAR>(kt + 2, nx2 + 16384); }
    if (!idle) {
    bf16x8 sm[4];
#pragma unroll
    for (int j = 0; j < 4; ++j) sm[j] = *(const bf16x8*)(dyn_lds + cur + 16384 + (BL::LAYOUT == 1 ? ((fq * 128 + wc * 64 + j * 16 + fr) << 4) : t32_off(wc * 64 + j * 16 + fr, fq * 8)));
    bf16x8 bigc = *(const bf16x8*)(dyn_lds + cur + t32_off(wr * 128 + fr, fq * 8));
#pragma unroll
    for (int i = 0; i < 8; ++i) {
        bf16x8 bign = bigc;
        if (i < 7) bign = *(const bf16x8*)(dyn_lds + cur + t32_off(wr * 128 + (i + 1) * 16 + fr, fq * 8));
        __builtin_amdgcn_sched_barrier(0);
#pragma unroll
        for (int j = 0; j < 4; ++j) acc[i * 4 + j] = __builtin_amdgcn_mfma_f32_16x16x32_bf16(sm[j], bigc, acc[i * 4 + j], 0, 0, 0);
        __builtin_amdgcn_sched_barrier(0);
        bigc = bign;
    }
    }
    if (kt + 1 < nk) bl.template commit<PAR ^ 1>(kt + 1, nx1 + 16384);
}
template <class AL, class BL>
__device__ __forceinline__ void gemm_core4(AL& al, BL& bl, int nk, f32x4 (&acc)[32], bool idle_hi = false) {
    const bool idle = idle_hi && (tidx() >> 7);
#pragma unroll
    for (int i = 0; i < 32; ++i) acc[i] = (f32x4){0.f, 0.f, 0.f, 0.f};
    al.template issue<0>(0, 0); bl.template issue<0>(0, 16384);
    if (nk > 1) { al.template issue<1>(1, G3_STAGE); bl.template issue<1>(1, G3_STAGE + 16384); }
    bl.template commit<0>(0, 16384);
    for (int kt = 0; kt < nk; kt += 2) {
        g4_step<AL, BL, 0>(al, bl, kt, nk, acc, idle);
        if (kt + 1 < nk) g4_step<AL, BL, 1>(al, bl, kt + 1, nk, acc, idle);
    }
    __syncthreads();
}
__device__ __forceinline__ bool dense_unit3(int bid, int nb, int j, int ntn, int& tm, int& tn) {
    if ((nb & 7) == 0) {
        const int x = bid & 7, r = bid >> 3, R = nb >> 3;
        const int li = r + R * j;
        if (li >= 8 * ntn) return false;
        tn = li >> 3; tm = x * 8 + (li & 7);
        return true;
    }
    const int u = bid + nb * j;
    if (u >= 64 * ntn) return false;
    tm = u / ntn; tn = u % ntn; return true;
}
__device__ __forceinline__ void prep_tile(char* lds, const float* W, int ldw, int k0, int scol0, bool colvalid, bf16_t* Bt, int K, int drow0, int mode) {
    const int tid = tidx();
    bf16_t* t = (bf16_t*)lds;
    __syncthreads();
#pragma unroll
    for (int i = 0; i < 4; ++i) {
        const int k = (tid >> 4) + 16 * i, q = tid & 15;
        f32x4 v = colvalid ? *(const f32x4*)(W + (size_t)(k0 + k) * ldw + scol0 + q * 4) : (f32x4){0.f, 0.f, 0.f, 0.f};
#pragma unroll
        for (int e = 0; e < 4; ++e) { float x = v[e]; if (mode == 2) x = x - bf2f(f2bf(x)); t[(q * 4 + e) * 72 + k] = (bf16_t)f2bf(x); }
    }
    __syncthreads();
#pragma unroll
    for (int i = 0; i < 2; ++i) { const int pc = tid + 256 * i, n = pc >> 3, ch = pc & 7;
        *(u32x4*)(Bt + (size_t)(drow0 + n) * K + k0 + ch * 8) = *(const u32x4*)(t + n * 72 + ch * 8); }
}
__device__ __forceinline__ int vcol_actual(int v);
__device__ __forceinline__ void phase_prep(char* lds, int bid, int nb, const P& p) {
    const int tid = tidx();
    for (size_t i = (size_t)bid * 256 + tid; i < (size_t)NTOK * DM / 8; i += (size_t)nb * 256) {
        const f32x4 a = *(const f32x4*)(p.x + i * 8), b = *(const f32x4*)(p.x + i * 8 + 4);
        u32x4 w; w.x = pack2(a[0], a[1]); w.y = pack2(a[2], a[3]); w.z = pack2(b[0], b[1]); w.w = pack2(b[2], b[3]);
        *(u32x4*)(p.XIb + i * 8) = w;
    }
    for (int u = bid; u < 2272; u += nb) {
        if (u < 768) { const int nt = u >> 4, kt = u & 15; const int d = nt * 64; const int sc = d < 2048 ? d : (d < 2560 ? d + 512 : d - 512);
            prep_tile(lds, p.even_w_in, EVEN_IN, kt * 64, sc, true, p.WIN0, DM, d, 0); }
        else if (u < 1024) { const int v = u - 768, nt = v >> 4, kt = v & 15; prep_tile(lds, p.even_w_out, DM, kt * 64, nt * 64, true, p.WOUT0, DM, nt * 64, 0); }
        else if (u < 1760) { const int v = u - 1024, nt = v >> 4, kt = v & 15; const int d = nt * 64;
            int sc; bool ok = true;
            if (d < 896) sc = d; else if (d < 1024) sc = d + 128; else if (d < 1536) sc = d + 280; else if (d < 2048) sc = d + 280;
            else if (d < 2112) sc = 1280; else if (d < 2176) { sc = 0; ok = false; } else if (d < 2304) sc = d - 1280; else if (d < 2432) sc = d - 1152; else sc = d - 104;
            prep_tile(lds, p.odd_w_in, ODD_IN, kt * 64, sc, ok, p.WIN1, DM, d, 0); }
        else if (u < 2016) { const int v = u - 1760, nt = v >> 4, kt = v & 15; prep_tile(lds, p.odd_w_out, DM, kt * 64, nt * 64, true, p.WOUT1, DM, nt * 64, 0); }
        else { const int v = u - 2016, layer = v >> 7, lo = (v >> 6) & 1, nt = (v >> 4) & 3, kt = v & 15;
            prep_tile(lds, p.w_router + (size_t)layer * DM * NEXP, NEXP, kt * 64, nt * 64, true, (lo ? p.WRL : p.WRH) + (size_t)layer * NEXP * DM, DM, nt * 64, lo ? 2 : 1); }
    }
    __syncthreads();
}


__device__ __forceinline__ void phase_gemm_f32out(int bid, int nb, const bf16_t* A, const bf16_t* Bt, int N, int K, float* C) {
    const int ntn = N / 128;
    const int tid = tidx(), lane = tid & 63, wid = tid >> 6, wr = wid >> 1, wc = wid & 1, fr = lane & 15, fq = lane >> 4;
    for (int j = 0;; ++j) {
        int tm, tn; if (!dense_unit3(bid, nb, j, ntn, tm, tn)) break;
        Dma3A al; al.set_dense(A, tm * 256, K); Dma3B bl; bl.set(Bt, Bt, tn * 128, K, 1 << 30);
        f32x4 acc[32];
        gemm_core4(al, bl, K / 32, acc);
#pragma unroll
        for (int i = 0; i < 8; ++i)
#pragma unroll
            for (int gg = 0; gg < 2; ++gg) { const f32x4 a = acc[i * 4 + 2 * gg], b2 = acc[i * 4 + 2 * gg + 1];
                u32x4 w; w.x = pack2(a[0], a[1]); w.y = pack2(a[2], a[3]); w.z = pack2(b2[0], b2[1]); w.w = pack2(b2[2], b2[3]);
                *(u32x4*)((bf16_t*)C + (size_t)(tm * 256 + wr * 128 + i * 16 + fr) * N + tn * 128 + wc * 64 + gg * 32 + fq * 8) = w; }
    }
}
__device__ __forceinline__ void phase_router(int bid, int nb, const P& p, int layer) {
    const int tid = tidx(), lane = tid & 63, wid = tid >> 6, wr = wid >> 1, wc = wid & 1, fr = lane & 15, fq = lane >> 4;
    for (int j = 0;; ++j) {
        int tm, t6; if (!dense_unit3(bid, nb, j, 6, tm, t6)) break;
        const int tn = t6 & 1, part = t6 >> 1;
        Dma3A al; al.set_dense(part == 2 ? p.XAl : p.XAb, tm * 256, DM);
        const bf16_t* wsrc = (part == 1 ? p.WRL : p.WRH) + (size_t)layer * NEXP * DM;
        Dma3B bl; bl.set(wsrc, wsrc, tn * 128, DM, 1 << 30);
        f32x4 acc[32];
        gemm_core4(al, bl, 32, acc);
        float* dst = p.LOG + (size_t)part * NTOK * NEXP;
#pragma unroll
        for (int i = 0; i < 8; ++i)
#pragma unroll
            for (int gg = 0; gg < 2; ++gg) { float* q = dst + (size_t)(tm * 256 + wr * 128 + i * 16 + fr) * NEXP + tn * 128 + wc * 64 + gg * 32 + fq * 8;
                *(f32x4*)q = acc[i * 4 + 2 * gg]; *(f32x4*)(q + 4) = acc[i * 4 + 2 * gg + 1]; }
    }
}
__device__ __forceinline__ void ln_row_store(float (&v)[16], const float* g, const float* b, float* of, bf16_t* ob, int row, int lane, bf16_t* ol = nullptr) {
    float s = 0.f;
#pragma unroll
    for (int i = 0; i < 16; ++i) s += v[i];
    const float mu = wave_sum(s) * (1.0f / DM);
    float q = 0.f;
#pragma unroll
    for (int i = 0; i < 16; ++i) { const float d = v[i] - mu; q += d * d; }
    const float rstd = rsqrtf(wave_sum(q) * (1.0f / DM) + LN_EPS);
#pragma unroll
    for (int h = 0; h < 2; ++h) {
        const int c0 = h * 512 + lane * 8;
        float o[8];
#pragma unroll
        for (int i = 0; i < 8; ++i) o[i] = (v[h * 8 + i] - mu) * rstd * g[c0 + i] + b[c0 + i];
        if (of) { *(f32x4*)(of + (size_t)row * DM + c0) = (f32x4){o[0], o[1], o[2], o[3]};
                  *(f32x4*)(of + (size_t)row * DM + c0 + 4) = (f32x4){o[4], o[5], o[6], o[7]}; }
        if (ob) { u32x4 w; w.x = pack2(o[0], o[1]); w.y = pack2(o[2], o[3]); w.z = pack2(o[4], o[5]); w.w = pack2(o[6], o[7]); *(u32x4*)(ob + (size_t)row * DM + c0) = w;
            if (ol) { float l[8];
#pragma unroll
                for (int i = 0; i < 8; ++i) l[i] = o[i] - bf2f(f2bf(o[i]));
                u32x4 wl; wl.x = pack2(l[0], l[1]); wl.y = pack2(l[2], l[3]); wl.z = pack2(l[4], l[5]); wl.w = pack2(l[6], l[7]); *(u32x4*)(ol + (size_t)row * DM + c0) = wl; } }
    }
}
__device__ __forceinline__ void phase_ln_add(int bid, int nb, const float* res, const bf16_t* resh, const bf16_t* resl, const float* add, const float* g, const float* b, float* of, bf16_t* ob, bf16_t* ol) {
    const int lane = tidx() & 63, wid = tidx() >> 6;
    for (int row = bid * 4 + wid; row < NTOK; row += nb * 4) {
        float v[16];
#pragma unroll
        for (int h = 0; h < 2; ++h) {
            const size_t o = (size_t)row * DM + h * 512 + lane * 8;
            f32x4 r0, r1;
            if (res) { r0 = *(const f32x4*)(res + o); r1 = *(const f32x4*)(res + o + 4); }
            else { const u32x4 xh = *(const u32x4*)(resh + o);
                r0[0] = bf2f(xh.x & 0xffffu); r0[1] = bf2f(xh.x >> 16); r0[2] = bf2f(xh.y & 0xffffu); r0[3] = bf2f(xh.y >> 16);
                r1[0] = bf2f(xh.z & 0xffffu); r1[1] = bf2f(xh.z >> 16); r1[2] = bf2f(xh.w & 0xffffu); r1[3] = bf2f(xh.w >> 16); }
            const u32x4 ab = *(const u32x4*)((const bf16_t*)add + o);
            const float a0[4] = {bf2f(ab.x & 0xffffu), bf2f(ab.x >> 16), bf2f(ab.y & 0xffffu), bf2f(ab.y >> 16)};
            const float a1[4] = {bf2f(ab.z & 0xffffu), bf2f(ab.z >> 16), bf2f(ab.w & 0xffffu), bf2f(ab.w >> 16)};
#pragma unroll
            for (int i = 0; i < 4; ++i) { v[h * 8 + i] = DN_ALPHA * r0[i] + a0[i]; v[h * 8 + 4 + i] = DN_ALPHA * r1[i] + a1[i]; }
        }
        ln_row_store(v, g, b, of, ob, row, lane, ol);
    }
}

__device__ __forceinline__ void phase_route(int bid, int nb, const P& p, int layer) {
    const float* br = p.b_router + layer * NEXP;
    const int tid = tidx(), lane = tid & 63, wid = tid >> 6;
    const int gt = bid * 256 + tid, gs = nb * 256;
    for (int i = gt; i < NROWS; i += gs) p.rowtok[i] = (i >= SH_TILE0 * 128) ? (i - SH_TILE0 * 128) : 0;
    const f32x4 bv = *(const f32x4*)(br + lane * 4);
    for (int tb = bid * 4 + wid; tb < NTOK; tb += nb * 4 * 8) {
        int es[8]; float ws[8];
#pragma unroll
        for (int q = 0; q < 8; ++q) {
            const int t = tb + q * nb * 4;
            es[q] = 0; ws[q] = 0.f;
            if (t < NTOK) {
        const f32x4 lg = (*(const f32x4*)(p.LOG + (size_t)t * NEXP + lane * 4) + *(const f32x4*)(p.LOG + (size_t)NTOK * NEXP + (size_t)t * NEXP + lane * 4)) + *(const f32x4*)(p.LOG + (size_t)2 * NTOK * NEXP + (size_t)t * NEXP + lane * 4);
        float sc[4], bs[4];
#pragma unroll
        for (int i = 0; i < 4; ++i) { sc[i] = sigmoidf_(lg[i]); bs[i] = sc[i] + bv[i]; }
        float t1 = fmaxf(bs[0], bs[1]), t2 = fminf(bs[0], bs[1]);
        { const float a = fmaxf(bs[2], bs[3]), c = fminf(bs[2], bs[3]); const float n1 = fmaxf(t1, a); t2 = fmaxf(fminf(t1, a), fmaxf(t2, c)); t1 = n1; }
#pragma unroll
        for (int o = 1; o <= 4; o <<= 1) { const float o1 = __shfl_xor(t1, o), o2 = __shfl_xor(t2, o); const float n1 = fmaxf(t1, o1); t2 = fmaxf(fminf(t1, o1), fmaxf(t2, o2)); t1 = n1; }
        const float gsc = t1 + t2;
        const int g = lane >> 3;
        int rank = 0;
#pragma unroll
        for (int g2 = 0; g2 < 8; ++g2) { const float o = __shfl(gsc, g2 * 8); rank += (o > gsc || (o == gsc && g2 < g)) ? 1 : 0; }
        const bool allowed = rank < 4;
        float cv[4];
#pragma unroll
        for (int i = 0; i < 4; ++i) cv[i] = allowed ? bs[i] : -3e38f;
        float wsel = 0.f; int esel = 0; float wsum = 0.f;
#pragma unroll
        for (int k = 0; k < 8; ++k) {
            float bvv = cv[0]; int bi = 0;
#pragma unroll
            for (int i = 1; i < 4; ++i) if (cv[i] > bvv) { bvv = cv[i]; bi = i; }
            int be = lane * 4 + bi;
#pragma unroll
            for (int o = 1; o <= 32; o <<= 1) { const float ov = __shfl_xor(bvv, o); const int oe = __shfl_xor(be, o); if (ov > bvv || (ov == bvv && oe < be)) { bvv = ov; be = oe; } }
            const int ol = be >> 2, oi = be & 3;
            float sown = 0.f;
#pragma unroll
            for (int i = 0; i < 4; ++i) if (oi == i) sown = sc[i];
            const float sv = __shfl(sown, ol);
            if (lane == ol) {
#pragma unroll
                for (int i = 0; i < 4; ++i) if (oi == i) cv[i] = -3e38f;
            }
            wsum += sv;
            if (lane == k) { wsel = sv; esel = be; }
        }
        es[q] = esel; ws[q] = wsel / wsum * 2.5f;
            }
        }
        int rk[8];
#pragma unroll
        for (int q = 0; q < 8; ++q) { rk[q] = 0; if (lane < 8 && tb + q * nb * 4 < NTOK) rk[q] = atomicAdd(&p.cnt[(bid & 31) * NEXP + es[q]], 1); }
#pragma unroll
        for (int q = 0; q < 8; ++q) { const int t = tb + q * nb * 4; if (lane < 8 && t < NTOK) { p.eidx[t * 8 + lane] = es[q]; p.ew[t * 8 + lane] = ws[q]; p.erank[t * 8 + lane] = rk[q]; } }
    }
}
__device__ __forceinline__ void phase_scatter(char* lds, int bid, int nb, const P& p) {
    int* base = (int*)lds;
    int* pc = base + 260;
    int* so = base + 520;
    const int tid = tidx();
    __syncthreads();
    { int c = 0;
#pragma unroll
      for (int sb = 0; sb < 32; ++sb) { so[sb * 256 + tid] = c; c += p.cnt[sb * NEXP + tid]; }
      pc[tid] = (c + 127) & ~127; }
    __syncthreads();
    { int s = 0; for (int e = 0; e < tid; ++e) s += pc[e]; base[tid] = s; if (tid == 255) base[256] = s + pc[255]; }
    __syncthreads();
    const int tpb = nb * 4;
    for (int a = bid * 256 + tid; a < NTOK * 8; a += nb * 256) {
        const int e = p.eidx[a]; const int t = a >> 3; const int sb = ((t % tpb) >> 2) & 31;
        const int row = base[e] + so[sb * 256 + e] + p.erank[a];
        p.rowtok[row] = t; p.epos[a] = row;
    }
    if (bid == 0) {
        {
            const int xq = tid & 7; int off = 0, tot = 0;
            for (int e = xq; e < 256; e += 8) { const int n = ((pc[e] >> 7) + 1) >> 1; if (e < tid) off += n; tot += n; }
            const int t0 = base[tid] >> 7, nte = pc[tid] >> 7;
            for (int i = 0; i < nte; i += 2) p.plist[xq * 320 + off + (i >> 1)] = (t0 + i) | ((i + 1 < nte) ? 0 : 0x40000000);
            if (tid < 64) { int totp = 0; for (int e = (tid & 7); e < 256; e += 8) totp += ((pc[e] >> 7) + 1) >> 1; p.plist[(tid & 7) * 320 + totp + (tid >> 3)] = SH_TILE0 + 2 * tid; }
            if (tid < 8) p.plen[tid] = tot + 8;
        }
        const int nrt = base[256] >> 7;
        for (int i = tid; i < NTILES; i += 256) if (i >= nrt) p.tile_e[i] = (i >= SH_TILE0) ? NEXP : -1;
        const int t0 = base[tid] >> 7, t1 = base[tid + 1] >> 7;
        for (int i = t0; i < t1; ++i) p.tile_e[i] = tid;
    }
    __syncthreads();
}
__device__ __forceinline__ void phase_moe1(char* lds, int bid, int nb, const P& p, int layer, const bf16_t* Xb) {
    const int tid = tidx(), lane = tid & 63, wid = tid >> 6, wr = wid >> 1, wc = wid & 1, fr = lane & 15, fq = lane >> 4;
    const int xq = bid & 7, tot = p.plen[xq] * 4, stp = nb >> 3;
    int Rr[4], Cc[4];
#pragma unroll
    for (int i = 0; i < 4; ++i) dma_rc32(lane, wid + 4 * i, Rr[i], Cc[i]);
    int ui = bid >> 3;
    int ent0 = 0, e0 = 0, tok0[4] = {0, 0, 0, 0}, ent1 = 0;
    if (ui < tot) { ent0 = p.plist[xq * 320 + (ui >> 2)]; const int t0 = ent0 & 0xffff, t1 = ((ent0 >> 30) & 1) ? t0 : t0 + 1; e0 = p.tile_e[t0];
#pragma unroll
        for (int i = 0; i < 4; ++i) tok0[i] = p.rowtok[(Rr[i] < 128 ? t0 : t1) * 128 + (Rr[i] & 127)]; }
    if (ui + stp < tot) ent1 = p.plist[xq * 320 + ((ui + stp) >> 2)];
    for (; ui < tot; ui += stp) {
        const int nt = ui & 3;
        const int ent = ent0, e = e0;
        const int tile0 = ent & 0xffff, single = (ent >> 30) & 1, tile1 = single ? tile0 : tile0 + 1;
        Dma3A al; al.base = (const char*)Xb;
#pragma unroll
        for (int i = 0; i < 4; ++i) al.voff[i] = (unsigned)(((size_t)tok0[i] * DM + Cc[i]) * 2);
        if (ui + stp < tot) { ent0 = ent1; const int t0 = ent0 & 0xffff, t1 = ((ent0 >> 30) & 1) ? t0 : t0 + 1; e0 = p.tile_e[t0];
#pragma unroll
            for (int i = 0; i < 4; ++i) tok0[i] = p.rowtok[(Rr[i] < 128 ? t0 : t1) * 128 + (Rr[i] & 127)]; }
        if (ui + 2 * stp < tot) ent1 = p.plist[xq * 320 + ((ui + 2 * stp) >> 2)];
        const float* Wg = (e < NEXP) ? p.w_gate + ((size_t)layer * NEXP + e) * (DM * 256) : p.ws_gate + (size_t)layer * (DM * 256);
        const float* Wu = (e < NEXP) ? p.w_up + ((size_t)layer * NEXP + e) * (DM * 256) : p.ws_up + (size_t)layer * (DM * 256);
        Reg3B bl; { const int nq = tid & 31, kg = tid >> 5; const int j = nq * 4, jw = j & 63, w2 = j >> 6; const int col = nt * 64 + w2 * 32 + (jw & 31);
            bl.ldb = 256; bl.bp = ((jw >= 32) ? Wu : Wg) + (size_t)(kg * 4) * 256 + col; }
        f32x4 acc[32];
        gemm_core4(al, bl, DM / 32, acc, single != 0);
        if (!(wr && single)) {
            const int tile = wr ? tile1 : tile0;
#pragma unroll
            for (int i = 0; i < 8; ++i)
                {
                    const int row = tile * 128 + i * 16 + fr, col = nt * 64 + wc * 32 + fq * 8;
                    const f32x4 g0 = acc[i * 4 + 0], g1 = acc[i * 4 + 1], u0 = acc[i * 4 + 2], u1 = acc[i * 4 + 3];
                    u32x4 w;
                    w.x = pack2(siluf_(g0[0]) * u0[0], siluf_(g0[1]) * u0[1]); w.y = pack2(siluf_(g0[2]) * u0[2], siluf_(g0[3]) * u0[3]);
                    w.z = pack2(siluf_(g1[0]) * u1[0], siluf_(g1[1]) * u1[1]); w.w = pack2(siluf_(g1[2]) * u1[2], siluf_(g1[3]) * u1[3]);
                    *(u32x4*)(p.H + (size_t)row * 256 + col) = w;
                }
        }
    }
}
__device__ __forceinline__ void phase_moe2(char* lds, int bid, int nb, const P& p, int layer) {
    const int tid = tidx(), lane = tid & 63, wid = tid >> 6, wr = wid >> 1, wc = wid & 1, fr = lane & 15, fq = lane >> 4;
    const int xq = bid & 7, tot = p.plen[xq] * 8, stp = nb >> 3;
    int Rr[4], Cc[4];
#pragma unroll
    for (int i = 0; i < 4; ++i) dma_rc32(lane, wid + 4 * i, Rr[i], Cc[i]);
    int ui = bid >> 3;
    int ent0 = 0, e0 = 0, ent1 = 0;
    if (ui < tot) { ent0 = p.plist[xq * 320 + (ui >> 3)]; e0 = p.tile_e[ent0 & 0xffff]; }
    if (ui + stp < tot) ent1 = p.plist[xq * 320 + ((ui + stp) >> 3)];
    for (; ui < tot; ui += stp) {
        const int nt = ui & 7;
        const int ent = ent0, e = e0;
        const int tile0 = ent & 0xffff, single = (ent >> 30) & 1, tile1 = single ? tile0 : tile0 + 1;
        if (ui + stp < tot) { ent0 = ent1; e0 = p.tile_e[ent0 & 0xffff]; }
        if (ui + 2 * stp < tot) ent1 = p.plist[xq * 320 + ((ui + 2 * stp) >> 3)];
        const float* Wd = (e < NEXP) ? p.w_down + ((size_t)layer * NEXP + e) * (256 * DM) : p.ws_down + (size_t)layer * (256 * DM);
        Dma3A al; al.base = (const char*)p.H;
#pragma unroll
        for (int i = 0; i < 4; ++i) al.voff[i] = (unsigned)(((size_t)((Rr[i] < 128 ? tile0 : tile1) * 128 + (Rr[i] & 127)) * 256 + Cc[i]) * 2);
        Reg3B bl; { const int nq = tid & 31, kg = tid >> 5; bl.ldb = DM; bl.perm64 = 1; bl.bp = Wd + (size_t)(kg * 4) * DM + nt * 128 + nq * 4; }
        f32x4 acc[32];
        gemm_core4(al, bl, 256 / 32, acc, single != 0);
        if (!(wr && single)) {
            const int tile = wr ? tile1 : tile0;
#pragma unroll
            for (int i = 0; i < 8; ++i)
                {
                    const int row = tile * 128 + i * 16 + fr, col = nt * 128 + wc * 64 + fq * 16;
                    u32x4 wv;
#pragma unroll
                    for (int j = 0; j < 4; ++j) {
                        f32x4 a = acc[i * 4 + j] * 64.0f;
#pragma unroll
                        for (int c = 0; c < 4; ++c) a[c] = fminf(fmaxf(a[c], -448.0f), 448.0f);
                        int w0 = 0;
                        w0 = __builtin_amdgcn_cvt_pk_fp8_f32(a[0], a[1], w0, false); w0 = __builtin_amdgcn_cvt_pk_fp8_f32(a[2], a[3], w0, true);
                        wv[j] = (unsigned)w0;
                    }
                    *(u32x4*)((char*)p.Y + (size_t)row * DM + col) = wv;
                }
        }
    }
}
__device__ __forceinline__ void phase_combine_ln(int bid, int nb, const P& p, const float* X, const float* g, const float* b, float* of, bf16_t* ob, bf16_t* ol) {
    const int lane = tidx() & 63, wid = tidx() >> 6;
    int row = bid * 4 + wid;
    int npos = 0; float nw = 0.f;
    if (row < NTOK && lane < 8) { npos = p.epos[row * 8 + lane]; nw = p.ew[row * 8 + lane]; }
    for (; row < NTOK; row += nb * 4) {
        const int cpos = npos; const float cw = nw;
        { const int nr = row + nb * 4; if (nr < NTOK && lane < 8) { npos = p.epos[nr * 8 + lane]; nw = p.ew[nr * 8 + lane]; } }
        float v[16];
#pragma unroll
        for (int h = 0; h < 2; ++h) {
            const size_t o = (size_t)row * DM + h * 512 + lane * 8;
            const u32x4 xh = *(const u32x4*)(p.XAb + o);
            v[h * 8 + 0] = DN_ALPHA * bf2f(xh.x & 0xffffu); v[h * 8 + 1] = DN_ALPHA * bf2f(xh.x >> 16);
            v[h * 8 + 2] = DN_ALPHA * bf2f(xh.y & 0xffffu); v[h * 8 + 3] = DN_ALPHA * bf2f(xh.y >> 16);
            v[h * 8 + 4] = DN_ALPHA * bf2f(xh.z & 0xffffu); v[h * 8 + 5] = DN_ALPHA * bf2f(xh.z >> 16);
            v[h * 8 + 6] = DN_ALPHA * bf2f(xh.w & 0xffffu); v[h * 8 + 7] = DN_ALPHA * bf2f(xh.w >> 16);
        }
#pragma unroll
        for (int k = 0; k < 9; ++k) {
            const int yr = (k < 8) ? __shfl(cpos, k) : (SH_TILE0 * 128 + row);
            const float w = (k < 8) ? __shfl(cw, k) : 1.0f;
#pragma unroll
            for (int h = 0; h < 2; ++h) {
                const u32x2 y = *(const u32x2*)((const char*)p.Y + (size_t)yr * DM + h * 512 + lane * 8);
                typedef float f32x2v __attribute__((ext_vector_type(2)));
                const f32x2v y0 = __builtin_amdgcn_cvt_pk_f32_fp8((int)y.x, false), y1 = __builtin_amdgcn_cvt_pk_f32_fp8((int)y.x, true);
                const f32x2v y2 = __builtin_amdgcn_cvt_pk_f32_fp8((int)y.y, false), y3 = __builtin_amdgcn_cvt_pk_f32_fp8((int)y.y, true);
                const float ws = w * (1.0f / 64.0f);
                v[h * 8 + 0] += ws * y0.x; v[h * 8 + 1] += ws * y0.y; v[h * 8 + 2] += ws * y1.x; v[h * 8 + 3] += ws * y1.y;
                v[h * 8 + 4] += ws * y2.x; v[h * 8 + 5] += ws * y2.y; v[h * 8 + 6] += ws * y3.x; v[h * 8 + 7] += ws * y3.y;
            }
        }
        ln_row_store(v, g, b, of, ob, row, lane, ol);
    }
}

__device__ __forceinline__ void phase_moba_kmean(int bid, int nb, const P& p) {
    const int tid = tidx();
    for (int u = (nb >= 256 ? bid - 128 : bid); u < NBATCH * 8; u += nb) {
        if (u < 0) continue;
        const int b = u >> 3, j = u & 7;
        const bf16_t* src = p.MK + (size_t)(b * SEQ + j * 256) * 512 + tid * 2;
        float s0 = 0.f, s1 = 0.f;
        for (int r8 = 0; r8 < 256; r8 += 8) {
            unsigned v[8];
#pragma unroll
            for (int i = 0; i < 8; ++i) v[i] = *(const unsigned*)(src + (size_t)(r8 + i) * 512);
#pragma unroll
            for (int i = 0; i < 8; ++i) { s0 += bf2f(v[i] & 0xffffu); s1 += bf2f(v[i] >> 16); }
        }
        const int h = tid >> 5, d = (tid & 31) * 2;
        p.KM[((size_t)(b * 8 + h) * 8 + j) * 64 + d] = s0 * (1.0f / 256.0f);
        p.KM[((size_t)(b * 8 + h) * 8 + j) * 64 + d + 1] = s1 * (1.0f / 256.0f);
    }
}
__device__ __forceinline__ void gemm_t_unit(const bf16_t* Wt, int wrow0, const bf16_t* X, int tok0, bf16_t* dst, int ncol, int col0) {
    const int tid = tidx(), lane = tid & 63, wid = tid >> 6, wr = wid >> 1, wc = wid & 1, fr = lane & 15, fq = lane >> 4;
    Dma3A al; al.set_dense(Wt, wrow0, DM); Dma3B bl; bl.set(X, X, tok0, DM, 1 << 30);
    f32x4 acc[32];
    gemm_core4(al, bl, DM / 32, acc);
#pragma unroll
    for (int i = 0; i < 8; ++i)
#pragma unroll
        for (int gg = 0; gg < 2; ++gg) {
            const int vc = col0 + wr * 128 + i * 16 + fr, r0 = tok0 + wc * 64 + gg * 32 + fq * 8;
            const int b = r0 >> 11, t0 = r0 & (SEQ - 1);
            const f32x4 a = acc[i * 4 + 2 * gg], b2 = acc[i * 4 + 2 * gg + 1];
            u32x4 w; w.x = pack2(a[0], a[1]); w.y = pack2(a[2], a[3]); w.z = pack2(b2[0], b2[1]); w.w = pack2(b2[2], b2[3]);
            *(u32x4*)(dst + ((size_t)(b * ncol + vc)) * SEQ + t0) = w;
        }
}
__device__ __forceinline__ void phase_inproj0(char* lds, int bid, int nb, const P& p) {
    const int ntn = 20, nk = DM / 32;
    const int tid = tidx(), lane = tid & 63, wid = tid >> 6, wr = wid >> 1, wc = wid & 1, fr = lane & 15, fq = lane >> 4;
    for (int i = bid * 256 + tid; i < 2 * 8 * 64 * 64; i += nb * 256) {
        const int which = i >> 15, e = i & 32767, h = e >> 12, j = (e >> 6) & 63, ii = e & 63;
        const float v = (which ? p.wx : p.wa)[(h * 64 + ii) * 64 + j];
        (which ? p.WXT : p.WAT)[e] = (bf16_t)f2bf(v);
    }
    for (int jj = 0;; ++jj) {
        int tm, tn; if (!dense_unit3(bid, nb, jj, ntn, tm, tn)) break;
        Dma3A al; al.set_dense(p.XIb, tm * 256, DM); Dma3B bl; bl.set(p.WIN0, p.WIN0, tn * 128, DM, 1 << 30);
        f32x4 acc[32];
        gemm_core4(al, bl, nk, acc);
#pragma unroll
        for (int i = 0; i < 8; ++i)
#pragma unroll
            for (int gg = 0; gg < 2; ++gg) {
                const int row = tm * 256 + wr * 128 + i * 16 + fr, col = tn * 128 + wc * 64 + gg * 32 + fq * 8;
                const f32x4 a = acc[i * 4 + 2 * gg], b2 = acc[i * 4 + 2 * gg + 1];
                u32x4 w; w.x = pack2(a[0], a[1]); w.y = pack2(a[2], a[3]); w.z = pack2(b2[0], b2[1]); w.w = pack2(b2[2], b2[3]);
                *(u32x4*)(p.UB0 + (size_t)row * 2560 + col) = w;
            }
    }
    for (int u = (nb >= 512 ? bid - 256 : bid); u < 2 * 128; u += nb) { if (u < 0) continue; const int pn = u & 1, tt = u >> 1; gemm_t_unit(p.WIN0, 2560 + pn * 256, p.XIb, tt * 128, p.VHt, 512, pn * 256); }
}

__device__ __forceinline__ int lds_off128(int r, int c) {
    const int st = (r >> 4) * 4 + (c >> 5), ob = (r & 15) * 64 + (c & 31) * 2;
    return st * 1024 + (ob ^ (((ob >> 9) & 1) << 5));
}
__device__ __forceinline__ float softplusf_(float x) { return fmaxf(x, 0.f) + log1pf(__expf(-fabsf(x))); }

#define LRU1_LDS (4 * 8192)
__device__ __forceinline__ void lru1_unit(char* lds, const P& p, int b, int ck, int half) {
    const int tid = tidx(), lane = tid & 63, w = tid >> 6, fr = lane & 15, fg = lane >> 4;
    char* xt = lds + w * 8192;
    const size_t n0 = (size_t)b * SEQ + ck * 64;
    __syncthreads();
    {
        const int h = half * 4 + w, c = h * 64 + lane;
        const float cw0 = p.conv_w[c], cw1 = p.conv_w[512 + c], cw2 = p.conv_w[1024 + c], cw3 = p.conv_w[1536 + c], cb = p.conv_b[c];
        float xm3 = 0.f, xm2 = 0.f, xm1 = 0.f;
        if (ck > 0) { xm3 = bf2f(p.UB0[(n0 - 3) * 2560 + c]); xm2 = bf2f(p.UB0[(n0 - 2) * 2560 + c]); xm1 = bf2f(p.UB0[(n0 - 1) * 2560 + c]); }
        __builtin_amdgcn_wave_barrier();
        for (int t16 = 0; t16 < 64; t16 += 16) {
            bf16_t raw[16];
#pragma unroll
            for (int i = 0; i < 16; ++i) raw[i] = p.UB0[(n0 + t16 + i) * 2560 + c];
#pragma unroll
            for (int i = 0; i < 16; ++i) {
                const float x = bf2f(raw[i]);
                const float xc = cb + cw0 * xm3 + cw1 * xm2 + cw2 * xm1 + cw3 * x;
                xm3 = xm2; xm2 = xm1; xm1 = x;
                *(bf16_t*)(xt + lds_off(t16 + i, lane & ~7) + (lane & 7) * 2) = (bf16_t)f2bf(xc);
            }
        }
        __builtin_amdgcn_wave_barrier();
        for (int jt = 0; jt < 4; ++jt) {
            const int cj = h * 64 + jt * 16 + fr;
            bf16x8 wra[2], wri[2];
#pragma unroll
            for (int ks = 0; ks < 2; ++ks) {
                wra[ks] = *(const bf16x8*)(p.WAT + (size_t)(h * 64 + jt * 16 + fr) * 64 + ks * 32 + fg * 8);
                wri[ks] = *(const bf16x8*)(p.WXT + (size_t)(h * 64 + jt * 16 + fr) * 64 + ks * 32 + fg * 8);
            }
            const float bav = p.ba[cj], bxv = p.bx[cj], sp = softplusf_(-p.lam[cj]);
            float mA = 1.f, mB = 0.f;
#pragma unroll
            for (int tt = 0; tt < 4; ++tt) {
                const bf16x8 a0 = *(const bf16x8*)(xt + lds_off(tt * 16 + fr, fg * 8)), a1 = *(const bf16x8*)(xt + lds_off(tt * 16 + fr, 32 + fg * 8));
                f32x4 ar = __builtin_amdgcn_mfma_f32_16x16x32_bf16(a0, wra[0], (f32x4){0.f, 0.f, 0.f, 0.f}, 0, 0, 0);
                ar = __builtin_amdgcn_mfma_f32_16x16x32_bf16(a1, wra[1], ar, 0, 0, 0);
                f32x4 ai = __builtin_amdgcn_mfma_f32_16x16x32_bf16(a0, wri[0], (f32x4){0.f, 0.f, 0.f, 0.f}, 0, 0, 0);
                ai = __builtin_amdgcn_mfma_f32_16x16x32_bf16(a1, wri[1], ai, 0, 0, 0);
                float sA = 1.f, sB = 0.f;
#pragma unroll
                for (int r = 0; r < 4; ++r) {
                    const int t = tt * 16 + fg * 4 + r;
                    const float rg = sigmoidf_(ar[r] + bav), ig = sigmoidf_(ai[r] + bxv);
                    const float log_a = -8.0f * rg * sp;
                    const float a = __expf(log_a);
                    const float mult = (ck == 0 && t == 0) ? 1.0f : sqrtf(fmaxf(1.0f - a * a, 0.f));
                    const int jj = jt * 16 + fr;
                    const float xcv = bf2f(*(const bf16_t*)(xt + lds_off(t, jj & ~7) + (jj & 7) * 2));
                    const float bt = mult * ig * xcv;
                    p.LA[(n0 + t) * 512 + cj] = a; p.LB[(n0 + t) * 512 + cj] = bt;
                    sB = a * sB + bt; sA = a * sA;
                }
                float tA = 1.f, tB = 0.f;
#pragma unroll
                for (int g2 = 0; g2 < 4; ++g2) {
                    const float oA = __shfl(sA, g2 * 16 + fr), oB = __shfl(sB, g2 * 16 + fr);
                    tB = oA * tB + oB; tA = oA * tA;
                }
                mB = tA * mB + tB; mA = tA * mA;
            }
            if (fg == 0) { p.CSA[((size_t)b * 32 + ck) * 512 + cj] = mA; p.CSB[((size_t)b * 32 + ck) * 512 + cj] = mB; }
        }
        __builtin_amdgcn_wave_barrier();
    }
}
__device__ __forceinline__ void lru2_unit(const P& p, int b, int ck, int half) {
    const int tid = tidx();
    const size_t n0 = (size_t)b * SEQ + ck * 64;
    {
        const int c = tid + 256 * half;
        float h = 0.f;
        for (int c8 = 0; c8 < ck; c8 += 8) {
            float ca[8], cb[8];
#pragma unroll
            for (int i = 0; i < 8; ++i) { const bool ok = c8 + i < ck; ca[i] = ok ? p.CSA[((size_t)b * 32 + c8 + i) * 512 + c] : 1.f; cb[i] = ok ? p.CSB[((size_t)b * 32 + c8 + i) * 512 + c] : 0.f; }
#pragma unroll
            for (int i = 0; i < 8; ++i) h = ca[i] * h + cb[i];
        }
        for (int t8 = 0; t8 < 64; t8 += 8) {
            float la[8], lb[8], gb[8];
#pragma unroll
            for (int i = 0; i < 8; ++i) { la[i] = p.LA[(n0 + t8 + i) * 512 + c]; lb[i] = p.LB[(n0 + t8 + i) * 512 + c]; gb[i] = bf2f(p.UB0[(n0 + t8 + i) * 2560 + 512 + c]); }
#pragma unroll
            for (int i = 0; i < 8; ++i) { h = la[i] * h + lb[i]; p.MIX[(n0 + t8 + i) * DM + c] = (bf16_t)f2bf(h * gelu_tanh(gb[i])); }
        }
    }
}

#define HG1_LDS (2 * 16384)
__device__ __forceinline__ float hg_lb(const P& p, int ch) {
    const float l0 = p.hg_lb[ch], l1 = p.hg_lb[512 + ch], l2 = p.hg_lb[1024 + ch]; const float mx = fmaxf(l0, fmaxf(l1, l2));
    const float e0 = __expf(l0 - mx), e1 = __expf(l1 - mx), e2 = __expf(l2 - mx); return e0 / (e0 + e1 + e2);
}
__device__ __forceinline__ void hg1_unit(char* lds, const P& p, int b, int h, int ck) {
    const int tid = tidx(), lane = tid & 63, w = tid >> 6, fr = lane & 15, fg = lane >> 4;
    char* kh = lds;
    char* vt = lds + 16384;
    const size_t n0 = (size_t)b * SEQ + ck * 64;
    const int bhc = (b * 4 + h) * 32 + ck;
    __syncthreads();
    if (tid < 128) {
        const int k = tid, ch = h * 128 + k;
        const float lbv = hg_lb(p, ch);
        float f[64];
#pragma unroll
        for (int t16 = 0; t16 < 64; t16 += 16) {
            bf16_t raw[16];
#pragma unroll
            for (int i = 0; i < 16; ++i) raw[i] = p.UB0[(n0 + t16 + i) * 2560 + 1536 + ch];
#pragma unroll
            for (int i = 0; i < 16; ++i) f[t16 + i] = lbv + (1.0f - lbv) * sigmoidf_(bf2f(raw[i]));
        }
        float suf = 1.0f;
#pragma unroll
        for (int t8 = 56; t8 >= 0; t8 -= 8) {
            float kv[8];
#pragma unroll
            for (int i = 7; i >= 0; --i) { kv[i] = (1.0f - f[t8 + i]) * suf; suf *= f[t8 + i]; }
            u32x4 wv; wv.x = pack2(kv[0], kv[1]); wv.y = pack2(kv[2], kv[3]); wv.z = pack2(kv[4], kv[5]); wv.w = pack2(kv[6], kv[7]);
            *(u32x4*)(kh + lds_off(k, t8)) = wv;
        }
        p.DV[(size_t)bhc * 128 + k] = suf;
    } else {
        const int q = tid - 128;
#pragma unroll
        for (int i = 0; i < 8; ++i) { const int pc = q + 128 * i, v = pc >> 3, c8 = pc & 7;
            *(u32x4*)(vt + lds_off(v, c8 * 8)) = *(const u32x4*)(p.VHt + ((size_t)(b * 512 + h * 128 + v)) * SEQ + ck * 64 + c8 * 8); }
    }
    __syncthreads();
    bf16_t* ut = p.UT + (size_t)bhc * 16384;
#pragma unroll
    for (int kk = 0; kk < 2; ++kk) {
        const int kt = w * 2 + kk;
        const bf16x8 a0 = *(const bf16x8*)(kh + lds_off(kt * 16 + fr, fg * 8)), a1 = *(const bf16x8*)(kh + lds_off(kt * 16 + fr, 32 + fg * 8));
#pragma unroll
        for (int v8 = 0; v8 < 8; ++v8) {
            const bf16x8 b0 = *(const bf16x8*)(vt + lds_off(v8 * 16 + fr, fg * 8)), b1 = *(const bf16x8*)(vt + lds_off(v8 * 16 + fr, 32 + fg * 8));
            f32x4 acc = __builtin_amdgcn_mfma_f32_16x16x32_bf16(a0, b0, (f32x4){0.f, 0.f, 0.f, 0.f}, 0, 0, 0);
            acc = __builtin_amdgcn_mfma_f32_16x16x32_bf16(a1, b1, acc, 0, 0, 0);
            u32x2 wv; wv.x = pack2(acc[0], acc[1]); wv.y = pack2(acc[2], acc[3]);
            *(u32x2*)(ut + (size_t)(v8 * 16 + fr) * 128 + kt * 16 + fg * 4) = wv;
        }
    }
}
__device__ __forceinline__ void phase_hg2(int bid, int nb, const P& p) {
    for (int it = bid * 256 + tidx(); it < 32 * 4096; it += nb * 256) {
        const int bh = it >> 12, e4 = (it & 4095) * 4, k4 = e4 & 127;
        float S0 = 0.f, S1 = 0.f, S2 = 0.f, S3 = 0.f;
        for (int c8 = 0; c8 < 32; c8 += 8) {
            u32x2 uv[8]; f32x4 dv[8];
#pragma unroll
            for (int i = 0; i < 8; ++i) { uv[i] = *(const u32x2*)(p.UT + ((size_t)(bh * 32 + c8 + i)) * 16384 + e4); dv[i] = *(const f32x4*)(p.DV + (size_t)(bh * 32 + c8 + i) * 128 + k4); }
#pragma unroll
            for (int i = 0; i < 8; ++i) {
                u32x2 wv; wv.x = pack2(S0, S1); wv.y = pack2(S2, S3);
                *(u32x2*)(p.SP + ((size_t)(bh * 32 + c8 + i)) * 16384 + e4) = wv;
                S0 = dv[i][0] * S0 + bf2f(uv[i].x & 0xffffu); S1 = dv[i][1] * S1 + bf2f(uv[i].x >> 16);
                S2 = dv[i][2] * S2 + bf2f(uv[i].y & 0xffffu); S3 = dv[i][3] * S3 + bf2f(uv[i].y >> 16);
            }
        }
    }
}
#define HG3_QP 0
#define HG3_KP 40960
#define HG3_VT (40960 + 16384)
#define HG3_LDS (40960 + 16384 + 128 * 144)
__device__ __forceinline__ int hg3_qp_base(int j) { return j == 0 ? 0 : (j == 1 ? 16384 : (j == 2 ? 28672 : 36864)); }
__device__ __forceinline__ void hg3_unit(char* lds, const P& p, int b, int h, int ck) {
    const int tid = tidx(), lane = tid & 63, w = tid >> 6, fr = lane & 15, fg = lane >> 4;
    char* qp = lds + HG3_QP; char* kp = lds + HG3_KP; char* vt = lds + HG3_VT;
    const size_t n0 = (size_t)b * SEQ + ck * 64;
    const int bhc = (b * 4 + h) * 32 + ck;
    __syncthreads();
    if (tid < 128) {
        const int k = tid, ch = h * 128 + k;
        const float lbv = hg_lb(p, ch);
        const int ke = (k & 7) * 2, k8 = k & ~7;
        float d0 = 1.f, d1 = 1.f, d2 = 1.f, d3 = 1.f;
#pragma unroll
        for (int i = 0; i < 4; ++i) {
            bf16_t rq[16], rf[16];
#pragma unroll
            for (int tt = 0; tt < 16; ++tt) { rq[tt] = p.UB0[(n0 + i * 16 + tt) * 2560 + 1024 + ch]; rf[tt] = p.UB0[(n0 + i * 16 + tt) * 2560 + 1536 + ch]; }
#pragma unroll
            for (int tt = 0; tt < 16; ++tt) {
                const int t = i * 16 + tt;
                const float qv = siluf_(bf2f(rq[tt]));
                const float f = lbv + (1.0f - lbv) * sigmoidf_(bf2f(rf[tt]));
                d0 *= f; if (i >= 1) d1 *= f; if (i >= 2) d2 *= f; if (i >= 3) d3 *= f;
                const float di = (i == 0) ? d0 : (i == 1 ? d1 : (i == 2 ? d2 : d3));
                *(bf16_t*)(kp + lds_off128(t, k8) + ke) = (bf16_t)f2bf((1.0f - f) * __builtin_amdgcn_rcpf(fmaxf(di, 1.8e-35f)));
                *(bf16_t*)(qp + hg3_qp_base(0) + lds_off128(t, k8) + ke) = (bf16_t)f2bf(qv * d0);
                if (i >= 1) *(bf16_t*)(qp + hg3_qp_base(1) + lds_off128(t - 16, k8) + ke) = (bf16_t)f2bf(qv * d1);
                if (i >= 2) *(bf16_t*)(qp + hg3_qp_base(2) + lds_off128(t - 32, k8) + ke) = (bf16_t)f2bf(qv * d2);
                if (i >= 3) *(bf16_t*)(qp + hg3_qp_base(3) + lds_off128(t - 48, k8) + ke) = (bf16_t)f2bf(qv * d3);
            }
        }
    } else {
        const int q = tid - 128;
#pragma unroll
        for (int i = 0; i < 8; ++i) { const int pc = q + 128 * i, v = pc >> 3, c8 = pc & 7;
            *(u32x4*)(vt + v * 144 + c8 * 16) = *(const u32x4*)(p.VHt + ((size_t)(b * 512 + h * 128 + v)) * SEQ + ck * 64 + c8 * 8); }
    }
    __syncthreads();
    f32x4 acc[8];
#pragma unroll
    for (int v8 = 0; v8 < 8; ++v8) acc[v8] = (f32x4){0.f, 0.f, 0.f, 0.f};
    if (ck > 0) {
        const bf16_t* sp = p.SP + (size_t)bhc * 16384;
#pragma unroll
        for (int ks = 0; ks < 4; ++ks) {
            const bf16x8 bq = *(const bf16x8*)(qp + hg3_qp_base(0) + lds_off128(w * 16 + fr, ks * 32 + fg * 8));
#pragma unroll
            for (int v8 = 0; v8 < 8; ++v8) {
                const bf16x8 as = *(const bf16x8*)(sp + (size_t)(v8 * 16 + fr) * 128 + ks * 32 + fg * 8);
                acc[v8] = __builtin_amdgcn_mfma_f32_16x16x32_bf16(as, bq, acc[v8], 0, 0, 0);
            }
        }
    }
#pragma unroll
    for (int jp = 0; jp < 2; ++jp) {
        if (2 * jp > w) continue;
        f32x4 at[2];
#pragma unroll
        for (int jj = 0; jj < 2; ++jj) {
            const int j = 2 * jp + jj;
            at[jj] = (f32x4){0.f, 0.f, 0.f, 0.f};
            if (j <= w) {
#pragma unroll
                for (int ks = 0; ks < 4; ++ks) {
                    const bf16x8 ak = *(const bf16x8*)(kp + lds_off128(j * 16 + fr, ks * 32 + fg * 8));
                    const bf16x8 bq = *(const bf16x8*)(qp + hg3_qp_base(j) + lds_off128((w - j) * 16 + fr, ks * 32 + fg * 8));
                    at[jj] = __builtin_amdgcn_mfma_f32_16x16x32_bf16(ak, bq, at[jj], 0, 0, 0);
                }
                if (j == w) {
#pragma unroll
                    for (int r = 0; r < 4; ++r) at[jj][r] = (fg * 4 + r <= fr) ? at[jj][r] : 0.f;
                }
            }
        }
        u32x4 pw; pw.x = pack2(at[0][0], at[0][1]); pw.y = pack2(at[0][2], at[0][3]); pw.z = pack2(at[1][0], at[1][1]); pw.w = pack2(at[1][2], at[1][3]);
        const bf16x8 pf = __builtin_bit_cast(bf16x8, pw);
#pragma unroll
        for (int v8 = 0; v8 < 8; ++v8) {
            const char* vb = vt + (v8 * 16 + fr) * 144 + (jp * 32 + fg * 4) * 2;
            const u32x2 v0 = *(const u32x2*)vb, v1 = *(const u32x2*)(vb + 32);
            u32x4 vv; vv.x = v0.x; vv.y = v0.y; vv.z = v1.x; vv.w = v1.y;
            acc[v8] = __builtin_amdgcn_mfma_f32_16x16x32_bf16(__builtin_bit_cast(bf16x8, vv), pf, acc[v8], 0, 0, 0);
        }
    }
    float ss = 0.f;
#pragma unroll
    for (int v8 = 0; v8 < 8; ++v8)
#pragma unroll
        for (int r = 0; r < 4; ++r) ss += acc[v8][r] * acc[v8][r];
    ss += __shfl_xor(ss, 16); ss += __shfl_xor(ss, 32);
    const float rs = rsqrtf(ss * (1.0f / 128.0f) + 1e-6f);
    const size_t n = n0 + w * 16 + fr;
#pragma unroll
    for (int v8 = 0; v8 < 8; ++v8) {
        const int vcol = h * 128 + v8 * 16 + fg * 4;
        const u32x2 gv = *(const u32x2*)(p.UB0 + n * 2560 + 2048 + vcol);
        const f32x4 ng = *(const f32x4*)(p.hg_ng + vcol);
        const float y0 = acc[v8][0] * rs * ng[0] * sigmoidf_(bf2f(gv.x & 0xffffu)), y1 = acc[v8][1] * rs * ng[1] * sigmoidf_(bf2f(gv.x >> 16));
        const float y2 = acc[v8][2] * rs * ng[2] * sigmoidf_(bf2f(gv.y & 0xffffu)), y3 = acc[v8][3] * rs * ng[3] * sigmoidf_(bf2f(gv.y >> 16));
        u32x2 wv; wv.x = pack2(y0, y1); wv.y = pack2(y2, y3);
        *(u32x2*)(p.MIX + n * DM + 512 + vcol) = wv;
    }
}
__device__ __forceinline__ void phase_mix0_a(char* lds, int bid, int nb, const P& p) {
    for (int u = bid; u < 512 + 1024; u += nb) {
        if (u < 512) lru1_unit(lds, p, u >> 6, (u >> 1) & 31, u & 1);
        else { const int v = u - 512; hg1_unit(lds, p, v >> 7, (v >> 5) & 3, v & 31); }
    }
    __syncthreads();
}
__device__ __forceinline__ void phase_mix0_c(char* lds, int bid, int nb, const P& p) {
    for (int u = bid; u < 1024; u += nb) hg3_unit(lds, p, u >> 7, (u >> 5) & 3, u & 31);
    __syncthreads();
}

#ifndef KEEP_U
#define KEEP_U 0
#endif
__device__ __forceinline__ int vcol_actual(int v) { return v < 1280 ? v : (v < 2816 ? v + 24 : v - 1536); }
__device__ __forceinline__ void phase_inproj1(char* lds, int bid, int nb, const P& p) {
    const int ntn = 17, nk = DM / 32;
    const int tid = tidx(), lane = tid & 63, wid = tid >> 6, wr = wid >> 1, wc = wid & 1, fr = lane & 15, fq = lane >> 4;
    for (int jj = 0;; ++jj) {
        int tm, tn; if (!dense_unit3(bid, nb, jj, ntn, tm, tn)) break;
        Dma3A al; al.set_dense(p.XBb, tm * 256, DM); Dma3B bl; bl.set(p.WIN1, p.WIN1, tn * 128, DM, 1 << 30);
        f32x4 acc[32];
        gemm_core4(al, bl, nk, acc);
#pragma unroll
        for (int i = 0; i < 8; ++i)
#pragma unroll
            for (int gg = 0; gg < 2; ++gg) {
                const int row = tm * 256 + wr * 128 + i * 16 + fr, vc = tn * 128 + wc * 64 + gg * 32 + fq * 8;
                const f32x4 a = acc[i * 4 + 2 * gg], b2 = acc[i * 4 + 2 * gg + 1];
                u32x4 w; w.x = pack2(a[0], a[1]); w.y = pack2(a[2], a[3]); w.z = pack2(b2[0], b2[1]); w.w = pack2(b2[2], b2[3]);
                if (tn < 4) *(u32x4*)(p.Qb + (size_t)row * 512 + vc) = w;
                else if (tn < 6) { *(f32x4*)(p.KCV + (size_t)row * 256 + vc - 512) = a; *(f32x4*)(p.KCV + (size_t)row * 256 + vc - 512 + 4) = b2; }
                else if (tn == 6) *(u32x4*)(p.KS + (size_t)row * 128 + vc - 768) = w;
                else if (tn == 7) *(u32x4*)(p.KW + (size_t)row * 128 + vc - 896) = w;
                else if (tn < 12) *(u32x4*)(p.MQ + (size_t)row * 512 + vc - 1024) = w;
                else if (tn < 16) *(u32x4*)(p.MK + (size_t)row * 512 + vc - 1536) = w;
                else if (vc < 2072) { *(f32x4*)(p.GATES + (size_t)row * 24 + vc - 2048) = a; *(f32x4*)(p.GATES + (size_t)row * 24 + vc - 2048 + 4) = b2; }
            }
    }
    for (int u = (nb >= 512 ? bid - 64 : bid); u < 3 * 128; u += nb) {
        if (u < 0) continue;
        const int pn = u % 3, tt = u / 3;
        if (pn == 0) {
            const int wrr = tidx() >> 7;
            gemm_t_unit(p.WIN1, 2176, p.XBb, tt * 128, wrr ? p.VWt - (size_t)128 * SEQ : p.VSt, 128, 0);
        } else gemm_t_unit(p.WIN1, 2432 + (pn - 1) * 256, p.XBb, tt * 128, p.MVt, 512, (pn - 1) * 256);
    }
}
__device__ __forceinline__ void phase_moba_gate(char* lds, int bid, int nb, const P& p) {
    const int lane = tidx() & 63, wid = tidx() >> 6;
    float* km = (float*)lds + 4096 + wid * 512;
    for (int it = bid * 4 + wid; it < 64 * 32; it += nb * 4) {
        const int bh = it >> 5, tb = it & 31, b = bh >> 3, h = bh & 7;
        const int t = tb * 64 + lane, ob = t >> 8;
        __builtin_amdgcn_wave_barrier();
#pragma unroll
        for (int i = 0; i < 8; ++i) km[i * 64 + lane] = p.KM[(size_t)bh * 512 + i * 64 + lane];
        __builtin_amdgcn_wave_barrier();
        u32x4 qr[8];
#pragma unroll
        for (int i = 0; i < 8; ++i) qr[i] = *(const u32x4*)(p.MQ + (size_t)(b * SEQ + t) * 512 + h * 64 + i * 8);
        float gate[8];
#pragma unroll
        for (int j = 0; j < 8; ++j) gate[j] = 0.f;
#pragma unroll
        for (int i = 0; i < 8; ++i) {
            float q[8];
            q[0] = bf2f(qr[i].x & 0xffffu); q[1] = bf2f(qr[i].x >> 16); q[2] = bf2f(qr[i].y & 0xffffu); q[3] = bf2f(qr[i].y >> 16);
            q[4] = bf2f(qr[i].z & 0xffffu); q[5] = bf2f(qr[i].z >> 16); q[6] = bf2f(qr[i].w & 0xffffu); q[7] = bf2f(qr[i].w >> 16);
#pragma unroll
            for (int j = 0; j < 8; ++j)
#pragma unroll
                for (int e = 0; e < 8; ++e) gate[j] += q[e] * km[j * 64 + i * 8 + e];
        }
#pragma unroll
        for (int j = 0; j < 8; ++j) gate[j] = (j < ob) ? gate[j] : NEGF;
        unsigned selm = 0;
#pragma unroll
        for (int j = 0; j < 8; ++j) {
            int rank = 0;
#pragma unroll
            for (int j2 = 0; j2 < 8; ++j2) rank += (gate[j2] > gate[j] || (gate[j2] == gate[j] && j2 < j)) ? 1 : 0;
            if (j < ob && rank < 3) selm |= 1u << j;
        }
        p.MSEL[(size_t)bh * SEQ + t] = selm;
    }
}

#define ATT_K_BYTES 8192
#define ATT_STAGE 16384
#define ATT_TILE_BYTES (3 * ATT_STAGE)
#define ATT_ORDER_OFF ATT_TILE_BYTES
#define ATT_RED_OFF (ATT_ORDER_OFF + 8192)
__device__ __forceinline__ void att_issue_tile(int stage, const bf16_t* Kg, int ldk, const bf16_t* Vg) {
    const int lane = tidx() & 63, w = tidx() >> 6;
#pragma unroll
    for (int i = 0; i < 2; ++i) { int R, C; dma_rc(lane, w + 4 * i, R, C);
        __builtin_amdgcn_global_load_lds((const unsigned*)(Kg + (size_t)R * ldk + C), (LAS unsigned*)((LAS char*)dyn_lds + stage * ATT_STAGE + (w + 4 * i) * 1024), 16, 0, 0);
        __builtin_amdgcn_global_load_lds((const unsigned*)(Vg + (size_t)R * SEQ + C), (LAS unsigned*)((LAS char*)dyn_lds + stage * ATT_STAGE + ATT_K_BYTES + (w + 4 * i) * 1024), 16, 0, 0); }
}
#define ATT_WAIT_BAR(n) do { asm volatile("s_waitcnt vmcnt(" #n ") lgkmcnt(0)" ::: "memory"); __builtin_amdgcn_s_barrier(); asm volatile("" ::: "memory"); } while (0)
struct AttState { f32x4 O[4][2]; float m[2], l[2]; };
__device__ __forceinline__ void att_reset(AttState& S) {
#pragma unroll
    for (int q = 0; q < 2; ++q) { S.m[q] = NEGF; S.l[q] = 0.f;
#pragma unroll
        for (int d = 0; d < 4; ++d) S.O[d][q] = (f32x4){0.f, 0.f, 0.f, 0.f}; }
}
template <bool MASKED>
__device__ __forceinline__ void att_step(const char* lds, const bf16x8 (&qf)[2][2], AttState& S, const f32x4 (&bini)[4], float slope2,
                                         int s0, int tq0, unsigned selbits  , int winlimit) {
    const int lane = tidx() & 63, fr = lane & 15, fg = lane >> 4;
    const char* ldsV = lds + ATT_K_BYTES;
    const float offbase = slope2 * (float)s0;
    f32x4 s[2][4];
#pragma unroll
    for (int kt = 0; kt < 4; ++kt) {
        const bf16x8 k0 = *(const bf16x8*)(lds + lds_off(kt * 16 + fr, fg * 8)), k1 = *(const bf16x8*)(lds + lds_off(kt * 16 + fr, 32 + fg * 8));
#pragma unroll
        for (int qt = 0; qt < 2; ++qt) {
            s[qt][kt] = __builtin_amdgcn_mfma_f32_16x16x32_bf16(k0, qf[qt][0], bini[kt], 0, 0, 0);
            s[qt][kt] = __builtin_amdgcn_mfma_f32_16x16x32_bf16(k1, qf[qt][1], s[qt][kt], 0, 0, 0);
        }
    }
    __builtin_amdgcn_sched_barrier(0);
    u32x4 pf[2][2];
#pragma unroll
    for (int qt = 0; qt < 2; ++qt) {
        const int tq = tq0 + qt * 16 + fr;
        const float off = ((selbits >> qt) & 1u) ? (offbase - slope2 * (float)tq) : -INFINITY;
        float mx = -INFINITY;
#pragma unroll
        for (int kt = 0; kt < 4; ++kt)
#pragma unroll
            for (int r = 0; r < 4; ++r) {
                float y = s[qt][kt][r];
                if (MASKED) { const int key = s0 + kt * 16 + fg * 4 + r; const bool ok = (key <= tq) && (tq - key < winlimit); y = ok ? y : -INFINITY; s[qt][kt][r] = y; }
                mx = fmaxf(mx, y);
            }
        mx = fmaxf(mx, __shfl_xor(mx, 16)); mx = fmaxf(mx, __shfl_xor(mx, 32));
        const float mnew = fmaxf(S.m[qt], mx + off);
        const float alpha = __builtin_amdgcn_exp2f(S.m[qt] - mnew);
        S.m[qt] = mnew;
        const float thr = mnew - off;
        float ls = 0.f;
#pragma unroll
        for (int kt = 0; kt < 4; ++kt)
#pragma unroll
            for (int r = 0; r < 4; ++r) { const float pr = __builtin_amdgcn_exp2f(s[qt][kt][r] - thr); s[qt][kt][r] = pr; ls += pr; }
        S.l[qt] = S.l[qt] * alpha + ls;
#pragma unroll
        for (int dt = 0; dt < 4; ++dt) S.O[dt][qt] *= alpha;
#pragma unroll
        for (int kk = 0; kk < 2; ++kk) {
            pf[qt][kk].x = pack2(s[qt][2 * kk][0], s[qt][2 * kk][1]); pf[qt][kk].y = pack2(s[qt][2 * kk][2], s[qt][2 * kk][3]);
            pf[qt][kk].z = pack2(s[qt][2 * kk + 1][0], s[qt][2 * kk + 1][1]); pf[qt][kk].w = pack2(s[qt][2 * kk + 1][2], s[qt][2 * kk + 1][3]);
        }
    }
    __builtin_amdgcn_sched_barrier(0);
#pragma unroll
    for (int kk = 0; kk < 2; ++kk)
#pragma unroll
        for (int dt = 0; dt < 4; ++dt) {
            const char* vb = ldsV + (fg & 1) * 8;
            const u32x2 v0 = *(const u32x2*)(vb + lds_off(dt * 16 + fr, kk * 32 + (fg >> 1) * 8)), v1 = *(const u32x2*)(vb + lds_off(dt * 16 + fr, kk * 32 + 16 + (fg >> 1) * 8));
            u32x4 vv; vv.x = v0.x; vv.y = v0.y; vv.z = v1.x; vv.w = v1.y;
            const bf16x8 vf = __builtin_bit_cast(bf16x8, vv);
#pragma unroll
            for (int qt = 0; qt < 2; ++qt) S.O[dt][qt] = __builtin_amdgcn_mfma_f32_16x16x32_bf16(vf, __builtin_bit_cast(bf16x8, pf[qt][kk]), S.O[dt][qt], 0, 0, 0);
        }
    __builtin_amdgcn_sched_barrier(0);
}
__device__ __forceinline__ unsigned wave_or(unsigned v) {
#pragma unroll
    for (int o = 32; o >= 1; o >>= 1) v |= (unsigned)__shfl_xor((int)v, o);
    return v;
}
__device__ __forceinline__ void att_nsa_unit(char* lds, const P& p, int b, int g, int qtile) {
    const int tid = tidx(), lane = tid & 63, w = tid >> 6, fr = lane & 15, fg = lane >> 4;
    const int hd = g * 4 + w, t0 = qtile * 32, own = qtile >> 1;
    const float slope2 = exp2f(-((float)hd + 0.5f)) * LOG2E, c1 = 0.125f * LOG2E;
    bf16x8 qf[2][2];
#pragma unroll
    for (int qt = 0; qt < 2; ++qt)
#pragma unroll
        for (int ks = 0; ks < 2; ++ks) qf[qt][ks] = *(const bf16x8*)(p.Qb + (size_t)(b * SEQ + t0 + qt * 16 + fr) * 512 + hd * 64 + ks * 32 + fg * 8);
#pragma unroll
    for (int qt = 0; qt < 2; ++qt)
#pragma unroll
        for (int ks = 0; ks < 2; ++ks) {
            const u32x4 raw = __builtin_bit_cast(u32x4, qf[qt][ks]); u32x4 o;
            o.x = pack2(bf2f(raw.x & 0xffffu) * c1, bf2f(raw.x >> 16) * c1); o.y = pack2(bf2f(raw.y & 0xffffu) * c1, bf2f(raw.y >> 16) * c1);
            o.z = pack2(bf2f(raw.z & 0xffffu) * c1, bf2f(raw.z >> 16) * c1); o.w = pack2(bf2f(raw.w & 0xffffu) * c1, bf2f(raw.w >> 16) * c1);
            qf[qt][ks] = __builtin_bit_cast(bf16x8, o);
        }
    f32x4 bini[4];
#pragma unroll
    for (int kt = 0; kt < 4; ++kt)
#pragma unroll
        for (int r = 0; r < 4; ++r) bini[kt][r] = slope2 * (float)(kt * 16 + fg * 4 + r);
    unsigned selw[2];
#pragma unroll
    for (int qt = 0; qt < 2; ++qt) selw[qt] = p.SELM[(size_t)(b * 2 + g) * SEQ + t0 + qt * 16 + fr];
    const unsigned um = wave_or(selw[0] | selw[1]);
    AttState S; att_reset(S);
    unsigned rem = um & ((own >= 31) ? 0xffffffffu : ((2u << own) - 1u));
    int wj = own >= 8 ? own - 8 : 0;
    int cbr, cj; bool has = true;
    if (rem) { cj = __ffs(rem) - 1; rem &= rem - 1; cbr = 0; } else { cj = wj++; cbr = 1; }
    const bf16_t* Ks = p.KS + (size_t)b * SEQ * 128 + g * 64; const bf16_t* Kw = p.KW + (size_t)b * SEQ * 128 + g * 64;
    const bf16_t* Vs = p.VSt + (size_t)(b * 128 + g * 64) * SEQ; const bf16_t* Vw = p.VWt + (size_t)(b * 128 + g * 64) * SEQ;
    int n1br = 0, n1j = 0; bool has1;
    if (rem) { n1j = __ffs(rem) - 1; rem &= rem - 1; n1br = 0; has1 = true; } else if (wj <= own) { n1j = wj++; n1br = 1; has1 = true; } else has1 = false;
    __syncthreads();
    att_issue_tile(0, (cbr ? Kw : Ks) + (size_t)cj * 64 * 128, 128, (cbr ? Vw : Vs) + cj * 64);
    if (has1) att_issue_tile(1, (n1br ? Kw : Ks) + (size_t)n1j * 64 * 128, 128, (n1br ? Vw : Vs) + n1j * 64);
    bool switched = false;
    int st = 0;
    while (has) {
        if (has1) ATT_WAIT_BAR(4); else ATT_WAIT_BAR(0);
        int n2br = 0, n2j = 0; bool has2;
        if (!has1) has2 = false;
        else if (rem) { n2j = __ffs(rem) - 1; rem &= rem - 1; n2br = 0; has2 = true; } else if (wj <= own) { n2j = wj++; n2br = 1; has2 = true; } else has2 = false;
        if (has2) att_issue_tile(st == 0 ? 2 : st - 1, (n2br ? Kw : Ks) + (size_t)n2j * 64 * 128, 128, (n2br ? Vw : Vs) + n2j * 64);
        const char* sl = lds + st * ATT_STAGE;
        if (cbr == 1 && !switched) {
            switched = true;
#pragma unroll
            for (int qt = 0; qt < 2; ++qt) {
                float lt = S.l[qt]; lt += __shfl_xor(lt, 16); lt += __shfl_xor(lt, 32);
                const size_t n = (size_t)b * SEQ + t0 + qt * 16 + fr;
                const float sc = sigmoidf_(p.GATES[n * 24 + hd * 3 + 1]) / fmaxf(lt, 1e-30f);
#pragma unroll
                for (int dt = 0; dt < 4; ++dt) { const f32x4 y = S.O[dt][qt] * sc; u32x2 w; w.x = pack2(y[0], y[1]); w.y = pack2(y[2], y[3]); *(u32x2*)((bf16_t*)p.OS + n * 512 + hd * 64 + dt * 16 + fg * 4) = w; }
            }
            att_reset(S);
        }
        unsigned sb = 3u; int wl = 1 << 30; bool msk;
        if (cbr == 0) { sb = ((selw[0] >> cj) & 1u) | (((selw[1] >> cj) & 1u) << 1); msk = (cj == own); }
        else { wl = 512; msk = (cj == own) || (cj + 8 == own); }
        if (msk) att_step<true>(sl, qf, S, bini, slope2, cj * 64, t0, sb, wl);
        else att_step<false>(sl, qf, S, bini, slope2, cj * 64, t0, sb, wl);
        cbr = n1br; cj = n1j; has = has1; n1br = n2br; n1j = n2j; has1 = has2;
        st = (st == 2) ? 0 : st + 1;
    }
#pragma unroll
    for (int qt = 0; qt < 2; ++qt) {
        float lt = S.l[qt]; lt += __shfl_xor(lt, 16); lt += __shfl_xor(lt, 32);
        const size_t n = (size_t)b * SEQ + t0 + qt * 16 + fr;
        const float sc = sigmoidf_(p.GATES[n * 24 + hd * 3 + 2]) / fmaxf(lt, 1e-30f);
        const float g0 = sigmoidf_(p.GATES[n * 24 + hd * 3 + 0]);
#pragma unroll
        for (int dt = 0; dt < 4; ++dt) {
            const size_t o = n * 512 + hd * 64 + dt * 16 + fg * 4;
            const u32x2 osv = *(const u32x2*)((const bf16_t*)p.OS + o), ocv = *(const u32x2*)((const bf16_t*)p.OC + o);
            const f32x4 osf = {bf2f(osv.x & 0xffffu), bf2f(osv.x >> 16), bf2f(osv.y & 0xffffu), bf2f(osv.y >> 16)};
            const f32x4 ocf = {bf2f(ocv.x & 0xffffu), bf2f(ocv.x >> 16), bf2f(ocv.y & 0xffffu), bf2f(ocv.y >> 16)};
            const f32x4 y = S.O[dt][qt] * sc + osf + ocf * g0;
            u32x2 wv; wv.x = pack2(y[0], y[1]); wv.y = pack2(y[2], y[3]);
            *(u32x2*)(p.MIX + n * DM + hd * 64 + dt * 16 + fg * 4) = wv;
        }
    }
}
__device__ __forceinline__ void att_moba_unit(char* lds, const P& p, int b, int h, int ob, int half) {
    const int tid = tidx(), lane = tid & 63, w = tid >> 6, fr = lane & 15, fg = lane >> 4;
    const int tq0 = ob * 256 + half * 128 + w * 32;
    const int dsub = half * 2 + (w >> 1), lastsub = half * 2 + 1;
    const float slope2 = exp2f(-((float)h + 1.0f)) * LOG2E, c1 = 0.125f * LOG2E;
    bf16x8 qf[2][2];
#pragma unroll
    for (int qt = 0; qt < 2; ++qt)
#pragma unroll
        for (int ks = 0; ks < 2; ++ks) qf[qt][ks] = *(const bf16x8*)(p.MQ + (size_t)(b * SEQ + tq0 + qt * 16 + fr) * 512 + h * 64 + ks * 32 + fg * 8);
#pragma unroll
    for (int qt = 0; qt < 2; ++qt)
#pragma unroll
        for (int ks = 0; ks < 2; ++ks) {
            const u32x4 raw = __builtin_bit_cast(u32x4, qf[qt][ks]); u32x4 o;
            o.x = pack2(bf2f(raw.x & 0xffffu) * c1, bf2f(raw.x >> 16) * c1); o.y = pack2(bf2f(raw.y & 0xffffu) * c1, bf2f(raw.y >> 16) * c1);
            o.z = pack2(bf2f(raw.z & 0xffffu) * c1, bf2f(raw.z >> 16) * c1); o.w = pack2(bf2f(raw.w & 0xffffu) * c1, bf2f(raw.w >> 16) * c1);
            qf[qt][ks] = __builtin_bit_cast(bf16x8, o);
        }
    f32x4 bini[4];
#pragma unroll
    for (int kt = 0; kt < 4; ++kt)
#pragma unroll
        for (int r = 0; r < 4; ++r) bini[kt][r] = slope2 * (float)(kt * 16 + fg * 4 + r);
    unsigned selw[2];
#pragma unroll
    for (int qt = 0; qt < 2; ++qt) selw[qt] = p.MSEL[(size_t)(b * 8 + h) * SEQ + tq0 + qt * 16 + fr];
    unsigned* red = (unsigned*)(lds + ATT_RED_OFF);
    const unsigned umw = wave_or(selw[0] | selw[1]);
    __syncthreads();
    if (lane == 0) red[w] = umw;
    __syncthreads();
    unsigned rem = (red[0] | red[1] | red[2] | red[3]) & ((1u << ob) - 1u);
    AttState S; att_reset(S);
    int cj, csub = 0; bool has = true;
    if (rem) { cj = __ffs(rem) - 1; rem &= rem - 1; } else cj = ob;
    const bf16_t* Kb = p.MK + (size_t)b * SEQ * 512 + h * 64; const bf16_t* Vb = p.MVt + (size_t)(b * 512 + h * 64) * SEQ;
#define MOBA_NEXT(J, SUB, NJ, NSUB, HAS) do { \
        if ((J) == ob) { if ((SUB) < lastsub) { NJ = (J); NSUB = (SUB) + 1; HAS = true; } else HAS = false; } \
        else if ((SUB) < 3) { NJ = (J); NSUB = (SUB) + 1; HAS = true; } \
        else { if (rem) { NJ = __ffs(rem) - 1; rem &= rem - 1; } else NJ = ob; NSUB = 0; HAS = true; } } while (0)
    int n1j = 0, n1sub = 0; bool has1;
    MOBA_NEXT(cj, csub, n1j, n1sub, has1);
    __syncthreads();
    att_issue_tile(0, Kb + (size_t)(cj * 256 + csub * 64) * 512, 512, Vb + cj * 256 + csub * 64);
    if (has1) att_issue_tile(1, Kb + (size_t)(n1j * 256 + n1sub * 64) * 512, 512, Vb + n1j * 256 + n1sub * 64);
    int st = 0;
    while (has) {
        if (has1) ATT_WAIT_BAR(4); else ATT_WAIT_BAR(0);
        int n2j = 0, n2sub = 0; bool has2 = false;
        if (has1) MOBA_NEXT(n1j, n1sub, n2j, n2sub, has2);
        if (has2) att_issue_tile(st == 0 ? 2 : st - 1, Kb + (size_t)(n2j * 256 + n2sub * 64) * 512, 512, Vb + n2j * 256 + n2sub * 64);
        const char* sl = lds + st * ATT_STAGE;
        const int s0 = cj * 256 + csub * 64;
        unsigned sb = 3u; bool msk = false, run = true;
        if (cj < ob) sb = ((selw[0] >> cj) & 1u) | (((selw[1] >> cj) & 1u) << 1);
        else { msk = (csub == dsub); run = (csub <= dsub); }
        if (run) {
            if (msk) att_step<true>(sl, qf, S, bini, slope2, s0, tq0, sb, 1 << 30);
            else att_step<false>(sl, qf, S, bini, slope2, s0, tq0, sb, 1 << 30);
        }
        cj = n1j; csub = n1sub; has = has1; n1j = n2j; n1sub = n2sub; has1 = has2;
        st = (st == 2) ? 0 : st + 1;
    }
#undef MOBA_NEXT
#pragma unroll
    for (int qt = 0; qt < 2; ++qt) {
        float lt = S.l[qt]; lt += __shfl_xor(lt, 16); lt += __shfl_xor(lt, 32);
        const size_t n = (size_t)b * SEQ + tq0 + qt * 16 + fr;
        const float sc = 1.0f / fmaxf(lt, 1e-30f);
#pragma unroll
        for (int dt = 0; dt < 4; ++dt) {
            const f32x4 y = S.O[dt][qt] * sc;
            u32x2 wv; wv.x = pack2(y[0], y[1]); wv.y = pack2(y[2], y[3]);
            *(u32x2*)(p.MIX + n * DM + 512 + h * 64 + dt * 16 + fg * 4) = wv;
        }
    }
}
#ifndef ATT_NSA
#define ATT_NSA 1
#endif
#ifndef ATT_MOBA
#define ATT_MOBA 1
#endif
__device__ __forceinline__ int att_class_key(int c) {
    if (c < 64) { const int a = (c >> 1) + 1; return (a < 16 ? a : 16) + (a < 9 ? a : 9); }
    const int ob = (c - 64) >> 1, half = (c - 64) & 1; return 4 * ob + 2 + 2 * half;
}
__device__ __forceinline__ void cmpa_unit(char* lds, const P& p, int b, int g, int qt64);
__device__ __forceinline__ void phase_attn_a(char* lds, int bid, int nb, const P& p) {
    int* order = (int*)(lds + 49152);
    __syncthreads();
    for (int u = tidx(); u < 1024; u += 256) {
        const int c = u & 15, inst = u >> 4;
        const int key = att_class_key(64 + c);
        int pos = inst;
        for (int c2 = 0; c2 < 16; ++c2) { const int k2 = att_class_key(64 + c2); if (k2 > key || (k2 == key && c2 < c)) pos += 64; }
        order[pos] = u;
    }
    __syncthreads();
    for (int r = 0;; ++r) {
        const int idx = r * nb + ((r & 1) ? (nb - 1 - bid) : bid);
        if (idx >= 512 + 1024) break;
        if (idx < 512) cmpa_unit(lds, p, idx >> 6, (idx >> 5) & 1, idx & 31);
        else { const int v = order[idx - 512]; att_moba_unit(lds, p, v >> 7, (v >> 4) & 7, (v >> 1) & 7, v & 1); }
    }
    __syncthreads();
}
__device__ __forceinline__ void phase_attn_b(char* lds, int bid, int nb, const P& p) {
    int* order = (int*)(lds + ATT_ORDER_OFF);
    __syncthreads();
    for (int u = tidx(); u < 1024; u += 256) {
        const int c = u & 63, inst = u >> 6;
        const int key = att_class_key(c);
        int pos = inst;
        for (int c2 = 0; c2 < 64; ++c2) { const int k2 = att_class_key(c2); if (k2 > key || (k2 == key && c2 < c)) pos += 16; }
        order[pos] = u;
    }
    __syncthreads();
    for (int r = 0;; ++r) {
        const int idx = r * nb + ((r & 1) ? (nb - 1 - bid) : bid);
        if (idx >= 1024) break;
        const int u = order[idx];
        att_nsa_unit(lds, p, u >> 7, (u >> 6) & 1, u & 63);
    }
    __syncthreads();
}

struct ALoadCmp {
    const float* base;
    const float* pe;
    int kt0;
    struct Regs { f32x4 v[8]; };
    __device__ __forceinline__ void load(int kt, Regs& R) const {
        const int l = kt + kt0;
        const f32x4 p0 = *(const f32x4*)(pe + l * 64), p1 = *(const f32x4*)(pe + l * 64 + 4);
#pragma unroll
        for (int i = 0; i < 4; ++i) {
            const int row = (tidx() + 256 * i) >> 3; int tok = 16 * row + l; tok = tok > SEQ - 1 ? SEQ - 1 : tok;
            const float* q = base + (size_t)tok * 256;
            R.v[2 * i] = *(const f32x4*)q + p0; R.v[2 * i + 1] = *(const f32x4*)(q + 4) + p1;
        }
    }
    __device__ __forceinline__ void store(int kt, const Regs& R, char* lds) const {
#pragma unroll
        for (int i = 0; i < 4; ++i) {
            const int p = tidx() + 256 * i, row = p >> 3, ch = p & 7;
            const f32x4 a = R.v[2 * i], b = R.v[2 * i + 1];
            u32x4 w; w.x = pack2(a[0], a[1]); w.y = pack2(a[2], a[3]); w.z = pack2(b[0], b[1]); w.w = pack2(b[2], b[3]);
            *(u32x4*)(lds + lds_off(row, ch * 8)) = w;
        }
    }
};
__device__ __forceinline__ void phase_cmp1(char* lds, int bid, int nb, const P& p) {
    const int tid = tidx(), lane = tid & 63, wid = tid >> 6, wr = wid >> 1, wc = wid & 1, fr = lane & 15, fq = lane >> 4;
    for (int u = bid; u < 16 * 2 * 4; u += nb) {
        const int split = u & 3, which = (u >> 2) & 1, bg = u >> 3, b = bg >> 1, g = bg & 1;
        ALoadCmp al; al.kt0 = split * 8; al.base = p.KCV + (size_t)b * SEQ * 256 + which * 128 + g * 64 + (tid & 7) * 8; al.pe = (which ? p.pe_v : p.pe_k) + (tid & 7) * 8;
        BLoadF32 bl; { const int nq = tid & 31, kg = tid >> 5; bl.valid = true; bl.ldb = 128; bl.nk1 = 1 << 30; bl.bp = (which ? p.wv1 : p.wk1) + (size_t)(split * 8 * 64 + kg * 8) * 128 + nq * 4; }
        f32x4 acc[4][4];
        gemm_tile(lds, al, bl, 8, acc);
        float* hid = p.HID + (((size_t)split * 2 + which) * 2048 + bg * 128) * 128;
#pragma unroll
        for (int m = 0; m < 4; ++m)
#pragma unroll
            for (int n = 0; n < 4; ++n) {
                const int row = wr * 64 + m * 16 + fr, col = wc * 64 + n * 16 + fq * 4;
                *(f32x4*)(hid + (size_t)row * 128 + col) = acc[m][n];
            }
    }
}
__device__ __forceinline__ void phase_cmp2(char* lds, int bid, int nb, const P& p) {
    const int tid = tidx(), lane = tid & 63, wid = tid >> 6;
    float* hs = (float*)lds + wid * 128;
    for (int it = bid * 4 + wid; it < 2 * 16 * 128; it += nb * 4) {
        const int which = it >> 11, bg = (it >> 7) & 15, c = it & 127;
        float o = 0.f;
        if (c < 127) {
            const float* hid = p.HID + ((size_t)which * 2048 + bg * 128 + c) * 128;
            const size_t ss = (size_t)2 * 2048 * 128;
            __builtin_amdgcn_wave_barrier();
            hs[lane] = gelu_tanh((hid[lane] + hid[ss + lane]) + (hid[2 * ss + lane] + hid[3 * ss + lane]));
            hs[lane + 64] = gelu_tanh((hid[lane + 64] + hid[ss + lane + 64]) + (hid[2 * ss + lane + 64] + hid[3 * ss + lane + 64]));
            __builtin_amdgcn_wave_barrier();
            const float* w2 = which ? p.wv2 : p.wk2;
#pragma unroll 8
            for (int j = 0; j < 128; ++j) o += hs[j] * w2[j * 64 + lane];
        }
        if (which == 0) p.KCb[((size_t)bg * 128 + c) * 64 + lane] = (bf16_t)f2bf(o);
        else p.VCt[((size_t)bg * 64 + lane) * 128 + c] = (bf16_t)f2bf(o);
    }
}
#define CMPA_LDS (2 * 16384 + 4 * 2048)
__device__ __forceinline__ void cmpa_unit(char* lds, const P& p, int b, int g, int qt64) {
    const int tid = tidx(), lane = tid & 63, w = tid >> 6, fr = lane & 15, fg = lane >> 4;
    const int bg = b * 2 + g;
    char* kc = lds; char* vt = lds + 16384;
    __syncthreads();
#pragma unroll
    for (int i = 0; i < 4; ++i) { const int pc = tid + 256 * i;
        *(u32x4*)(kc + lds_off(pc >> 3, (pc & 7) * 8)) = *(const u32x4*)(p.KCb + (size_t)bg * 8192 + pc * 8);
        *(u32x4*)(vt + lds_off128(pc >> 4, (pc & 15) * 8)) = *(const u32x4*)(p.VCt + (size_t)bg * 8192 + pc * 8); }
    __syncthreads();
    const int t = qt64 * 64 + w * 16 + fr;
    const size_t n = (size_t)b * SEQ + t;
    const float c1 = 0.125f * LOG2E;
    f32x4 psum[8];
#pragma unroll
    for (int ct = 0; ct < 8; ++ct) psum[ct] = (f32x4){0.f, 0.f, 0.f, 0.f};
    bf16x8 qall[4][2];
#pragma unroll
    for (int i = 0; i < 4; ++i) { qall[i][0] = *(const bf16x8*)(p.Qb + n * 512 + (g * 4 + i) * 64 + fg * 8); qall[i][1] = *(const bf16x8*)(p.Qb + n * 512 + (g * 4 + i) * 64 + 32 + fg * 8); }
#pragma unroll
    for (int i = 0; i < 4; ++i) {
        const int hd = g * 4 + i;
        const float slope2 = exp2f(-((float)hd + 0.5f)) * LOG2E;
        const bf16x8 q0 = qall[i][0], q1 = qall[i][1];
        __builtin_amdgcn_sched_barrier(0);
        f32x4 s[8];
        float mx = -INFINITY;
#pragma unroll
        for (int ct = 0; ct < 8; ++ct) {
            const bf16x8 k0 = *(const bf16x8*)(kc + lds_off(ct * 16 + fr, fg * 8)), k1 = *(const bf16x8*)(kc + lds_off(ct * 16 + fr, 32 + fg * 8));
            s[ct] = __builtin_amdgcn_mfma_f32_16x16x32_bf16(k0, q0, (f32x4){0.f, 0.f, 0.f, 0.f}, 0, 0, 0);
            s[ct] = __builtin_amdgcn_mfma_f32_16x16x32_bf16(k1, q1, s[ct], 0, 0, 0);
#pragma unroll
            for (int r = 0; r < 4; ++r) {
                const int e = 16 * (ct * 16 + fg * 4 + r) + 31;
                const float y = (e <= t) ? fmaf(s[ct][r], c1, -slope2 * (float)(t - e)) : -INFINITY;
                s[ct][r] = y; mx = fmaxf(mx, y);
            }
        }
        __builtin_amdgcn_sched_barrier(0);
        mx = fmaxf(mx, __shfl_xor(mx, 16)); mx = fmaxf(mx, __shfl_xor(mx, 32));
        const float mm = (mx == -INFINITY) ? 0.f : mx;
        float ls = 0.f;
#pragma unroll
        for (int ct = 0; ct < 8; ++ct)
#pragma unroll
            for (int r = 0; r < 4; ++r) { const float e = __builtin_amdgcn_exp2f(s[ct][r] - mm); s[ct][r] = e; ls += e; }
        ls += __shfl_xor(ls, 16); ls += __shfl_xor(ls, 32);
        const float inv = 1.0f / fmaxf(ls, 1e-30f);
#pragma unroll
        for (int ct = 0; ct < 8; ++ct) { s[ct] *= inv; psum[ct] += s[ct]; }
        __builtin_amdgcn_sched_barrier(0);
        f32x4 o[4];
#pragma unroll
        for (int dt = 0; dt < 4; ++dt) o[dt] = (f32x4){0.f, 0.f, 0.f, 0.f};
#pragma unroll
        for (int kk = 0; kk < 4; ++kk) {
            u32x4 pw; pw.x = pack2(s[2 * kk][0], s[2 * kk][1]); pw.y = pack2(s[2 * kk][2], s[2 * kk][3]); pw.z = pack2(s[2 * kk + 1][0], s[2 * kk + 1][1]); pw.w = pack2(s[2 * kk + 1][2], s[2 * kk + 1][3]);
            const bf16x8 pf = __builtin_bit_cast(bf16x8, pw);
#pragma unroll
            for (int dt = 0; dt < 4; ++dt) {
                const int c0 = kk * 32 + fg * 4;
                const u32x2 v0 = *(const u32x2*)(vt + lds_off128(dt * 16 + fr, c0 & ~7) + (c0 & 7) * 2);
                const u32x2 v1 = *(const u32x2*)(vt + lds_off128(dt * 16 + fr, (c0 + 16) & ~7) + (c0 & 7) * 2);
                u32x4 vv; vv.x = v0.x; vv.y = v0.y; vv.z = v1.x; vv.w = v1.y;
                o[dt] = __builtin_amdgcn_mfma_f32_16x16x32_bf16(__builtin_bit_cast(bf16x8, vv), pf, o[dt], 0, 0, 0);
            }
        }
#pragma unroll
        for (int dt = 0; dt < 4; ++dt) { u32x2 w; w.x = pack2(o[dt][0], o[dt][1]); w.y = pack2(o[dt][2], o[dt][3]); *(u32x2*)((bf16_t*)p.OC + n * 512 + hd * 64 + dt * 16 + fg * 4) = w; }
    }
    const int own = t >> 6;
    float val[8];
#pragma unroll
    for (int ct = 0; ct < 8; ++ct) {
        const float up = __shfl(psum[ct][3], (lane + 48) & 63);
        const float up0 = (ct > 0) ? __shfl(psum[ct > 0 ? ct - 1 : 0][3], (lane + 48) & 63) : 0.f;
        const float imp = (psum[ct][0] + psum[ct][1]) + (psum[ct][2] + psum[ct][3]) + (fg > 0 ? up : up0);
        const int j = ct * 4 + fg;
        const bool forced = (j == 0) || (j == own) || (j == own - 1);
        val[ct] = (j <= own) ? (imp + (forced ? 1e4f : 0.f)) : NEGF;
    }
    float* vs = (float*)(lds + 32768) + w * 512;
    __builtin_amdgcn_wave_barrier();
#pragma unroll
    for (int ct = 0; ct < 8; ++ct) vs[fr * 32 + ct * 4 + fg] = val[ct];
    __builtin_amdgcn_wave_barrier();
    int rank[8];
#pragma unroll
    for (int ct = 0; ct < 8; ++ct) rank[ct] = 0;
#pragma unroll 2
    for (int oj = 0; oj < 32; ++oj) {
        const float ov = vs[fr * 32 + oj];
#pragma unroll
        for (int ct = 0; ct < 8; ++ct) rank[ct] += (ov > val[ct] || (ov == val[ct] && oj < ct * 4 + fg)) ? 1 : 0;
    }
    __builtin_amdgcn_wave_barrier();
    unsigned bits = 0;
#pragma unroll
    for (int ct = 0; ct < 8; ++ct) if ((ct * 4 + fg <= own) && rank[ct] < 16) bits |= 1u << (ct * 4 + fg);
    bits |= (unsigned)__shfl_xor((int)bits, 16); bits |= (unsigned)__shfl_xor((int)bits, 32);
    if (fg == 0) p.SELM[(size_t)bg * SEQ + t] = bits;
}
#define MEGA_LDS (((HG3_LDS + 255) & ~255) + 16)
static_assert(HG3_LDS >= G4_LDS && HG3_LDS >= CMPA_LDS && HG3_LDS >= GEMM_LDS && HG3_LDS >= ATT_RED_OFF + 16, "LDS map");
#define GBAR() xcd_barrier(bar)

template <int LAYER>
__device__ __forceinline__ void moe_block(char* lds, int bid, int nb, const P& p, const XcdBarrier& bar, float* of, bf16_t* ob, bf16_t* ol) {
    if (bid < 32) p.cnt[bid * NEXP + tidx()] = 0;
    phase_router(bid, nb, p, LAYER);
    GBAR();
    phase_route(bid, nb, p, LAYER);
    GBAR();
    phase_scatter(lds, bid, nb, p);
    GBAR();
    phase_moe1(lds, bid, nb, p, LAYER, p.XAb);
    GBAR();
    phase_moe2(lds, bid, nb, p, LAYER);
    GBAR();
    phase_combine_ln(bid, nb, p, p.XA, p.ln_g + (LAYER * 2 + 1) * DM, p.ln_b + (LAYER * 2 + 1) * DM, of, ob, ol);
}

__global__ void __launch_bounds__(256, 2) mega(P p) {
    char* lds = dyn_lds;
    const int bid = blockIdx.x, nb = gridDim.x;
    volatile LAS unsigned* st = (volatile LAS unsigned*)(dyn_lds + MEGA_LDS - 16);
    if (tidx() == 0) { st[0] = 0u; st[1] = 0u; st[2] = 0u; st[3] = 0u; }
    __syncthreads();
    const XcdBarrier bar = xcd_barrier_post(p.bar, st);
    phase_prep(lds, bid, nb, p);
    GBAR();
    phase_inproj0(lds, bid, nb, p);
    GBAR();
    phase_mix0_a(lds, bid, nb, p);
    GBAR();
    phase_hg2(bid, nb, p);
    for (int u = nb - 1 - bid; u < 512; u += nb) lru2_unit(p, u >> 6, (u >> 1) & 31, u & 1);
    GBAR();
    phase_mix0_c(lds, bid, nb, p);
    GBAR();
    phase_gemm_f32out(bid, nb, p.MIX, p.WOUT0, DM, DM, p.T0);
    GBAR();
    phase_ln_add(bid, nb, p.x, nullptr, nullptr, p.T0, p.ln_g, p.ln_b, nullptr, p.XAb, p.XAl);
    GBAR();
    moe_block<0>(lds, bid, nb, p, bar, nullptr, p.XBb, nullptr);
    GBAR();
    phase_inproj1(lds, bid, nb, p);
    GBAR();
    phase_cmp1(lds, bid, nb, p);
    phase_moba_kmean(bid, nb, p);
    GBAR();
    phase_cmp2(lds, bid, nb, p);
    phase_moba_gate(lds, bid, nb, p);
    GBAR();
    phase_attn_a(lds, bid, nb, p);
    GBAR();
    phase_attn_b(lds, bid, nb, p);
    GBAR();
    phase_gemm_f32out(bid, nb, p.MIX, p.WOUT1, DM, DM, p.T0);
    GBAR();
    phase_ln_add(bid, nb, nullptr, p.XBb, p.XBl, p.T0, p.ln_g + 2 * DM, p.ln_b + 2 * DM, nullptr, p.XAb, p.XAl);
    GBAR();
    moe_block<1>(lds, bid, nb, p, bar, p.out, nullptr, nullptr);
}

static inline size_t al256(size_t x) { return (x + 255) & ~(size_t)255; }

extern "C" void kernel_launch(void* const* d_in, const int* in_sizes, int n_in, void* d_out, int out_size, void* d_ws, size_t ws_size, hipStream_t stream) {
    P p{};
    const float** ip = (const float**)&p.x;
    for (int i = 0; i < 30; ++i) ip[i] = (const float*)d_in[i];
    p.out = (float*)d_out;
    char* w = (char*)d_ws; size_t o = 0;
    auto take = [&](size_t bytes) { char* r = w + o; o = al256(o + bytes); return r; };
    p.bar = (unsigned*)take(XCD_BAR_WORDS * 4);
    p.U = nullptr;
    p.MIX = (bf16_t*)take((size_t)NTOK * DM * 2);
    p.T0 = (float*)take((size_t)NTOK * DM * 4);
    p.XA = nullptr; p.XAb = (bf16_t*)take((size_t)NTOK * DM * 2); p.XAl = (bf16_t*)take((size_t)NTOK * DM * 2); p.XBl = nullptr;
    p.XB = nullptr; p.XBb = (bf16_t*)take((size_t)NTOK * DM * 2);
    p.LOG = (float*)take((size_t)3 * NTOK * NEXP * 4);
    p.eidx = (int*)take(NTOK * 8 * 4); p.ew = (float*)take(NTOK * 8 * 4); p.erank = (int*)take(NTOK * 8 * 4); p.epos = (int*)take(NTOK * 8 * 4);
    p.cnt = (int*)take(32 * NEXP * 4); p.tile_e = (int*)take(NTILES * 4); p.rowtok = (int*)take(NROWS * 4);
    p.H = (bf16_t*)take((size_t)NROWS * 256 * 2);
    p.Y = (bf16_t*)take((size_t)NROWS * DM * 2);
    p.LA = (float*)take((size_t)NTOK * 512 * 4); p.LB = (float*)take((size_t)NTOK * 512 * 4);
    p.KC = nullptr; p.VC = nullptr;
    p.OC = (float*)take((size_t)NTOK * 512 * 4);
    p.SELM = (unsigned*)take(16 * SEQ * 4);
    p.KM = (float*)take(8 * 8 * 8 * 64 * 4);
    p.Qb = (bf16_t*)take((size_t)NTOK * 512 * 2); p.KS = (bf16_t*)take((size_t)NTOK * 128 * 2); p.VSt = (bf16_t*)take((size_t)NTOK * 128 * 2);
    p.KW = (bf16_t*)take((size_t)NTOK * 128 * 2); p.VWt = (bf16_t*)take((size_t)NTOK * 128 * 2);
    p.MQ = (bf16_t*)take((size_t)NTOK * 512 * 2); p.MK = (bf16_t*)take((size_t)NTOK * 512 * 2); p.MVt = (bf16_t*)take((size_t)NTOK * 512 * 2);
    p.KCV = (float*)take((size_t)NTOK * 256 * 4); p.GATES = (float*)take((size_t)NTOK * 24 * 4); p.OS = (float*)take((size_t)NTOK * 512 * 4);
    p.MSEL = (unsigned*)take(64 * SEQ * 4);
    p.UB0 = (bf16_t*)take((size_t)NTOK * 2560 * 2); p.VHt = (bf16_t*)take((size_t)NTOK * 512 * 2);
    p.WAT = (bf16_t*)take(8 * 64 * 64 * 2); p.WXT = (bf16_t*)take(8 * 64 * 64 * 2);
    p.CSA = (float*)take(8 * 32 * 512 * 4); p.CSB = (float*)take(8 * 32 * 512 * 4);
    p.UT = (bf16_t*)take((size_t)1024 * 16384 * 2); p.SP = (bf16_t*)take((size_t)1024 * 16384 * 2);
    p.DV = (float*)take(1024 * 128 * 4);
    p.XIb = (bf16_t*)take((size_t)NTOK * DM * 2);
    p.plist = (int*)take(8 * 320 * 4); p.plen = (int*)take(64);
    p.WIN0 = (bf16_t*)take((size_t)EVEN_IN * DM * 2); p.WOUT0 = (bf16_t*)take((size_t)DM * DM * 2); p.WIN1 = (bf16_t*)take((size_t)2944 * DM * 2); p.WOUT1 = (bf16_t*)take((size_t)DM * DM * 2);
    p.WRH = (bf16_t*)take((size_t)2 * NEXP * DM * 2); p.WRL = (bf16_t*)take((size_t)2 * NEXP * DM * 2);
    p.HID = (float*)take((size_t)4 * 2 * 2048 * 128 * 4); p.KCb = (bf16_t*)take(16 * 128 * 64 * 2); p.VCt = (bf16_t*)take(16 * 64 * 128 * 2);
    if (o > ws_size) return;

    static int grid = 0;
    if (!grid) {
        int dev = 0, cus = 0, per_cu = 0;
        (void)hipGetDevice(&dev);
        (void)hipDeviceGetAttribute(&cus, hipDeviceAttributeMultiprocessorCount, dev);
        (void)hipFuncSetAttribute((const void*)mega, hipFuncAttributeMaxDynamicSharedMemorySize, MEGA_LDS);
        (void)hipOccupancyMaxActiveBlocksPerMultiprocessor(&per_cu, (const void*)mega, 256, MEGA_LDS);
        if (per_cu < 1) per_cu = 1;
        grid = cus * (per_cu < 2 ? per_cu : 2);
    }
    (void)hipMemsetAsync(p.bar, 0, XCD_BAR_WORDS * 4, stream);
    hipLaunchKernelGGL(mega, dim3(grid), dim3(256), MEGA_LDS, stream, p);
}
```

```cpp
#include <hip/hip_runtime.h>
#include <hip/hip_bf16.h>
#include <stdint.h>

#define NTOK 16384
#define DM 1024
#define SEQ 2048
#define NBATCH 8
#define EVEN_IN 3072
#define ODD_IN 2840
#define NEXP 256
#define NEGF (-1e30f)
#define LOG2E 1.4426950408889634f
#define DN_ALPHA 1.4142135623730951f
#define LN_EPS 1e-5f
#define MAXRT 1280
#define SH_TILE0 1280
#define NTILES (1280 + 128)
#define NROWS (NTILES * 128)

typedef unsigned short bf16_t;
typedef short bf16x8 __attribute__((ext_vector_type(8)));
typedef float f32x4 __attribute__((ext_vector_type(4)));
typedef unsigned u32x4 __attribute__((ext_vector_type(4)));
typedef unsigned u32x2 __attribute__((ext_vector_type(2)));
extern __shared__ __attribute__((aligned(16))) char dyn_lds[];
#define LAS __attribute__((address_space(3)))

__device__ __forceinline__ int tidx() { int t = threadIdx.x; asm volatile("" : "+v"(t)); return t; }
__device__ __forceinline__ float wave_sum(float v) {
#pragma unroll
    for (int o = 32; o >= 1; o >>= 1) v += __shfl_xor(v, o);
    return v;
}
__device__ __forceinline__ float wave_max(float v) {
#pragma unroll
    for (int o = 32; o >= 1; o >>= 1) v = fmaxf(v, __shfl_xor(v, o));
    return v;
}
template <int CTRL> __device__ __forceinline__ float dppf(float v) { return __int_as_float(__builtin_amdgcn_update_dpp(0, __float_as_int(v), CTRL, 0xF, 0xF, true)); }
__device__ __forceinline__ float rlanef(float v, int l) { return __int_as_float(__builtin_amdgcn_readlane(__float_as_int(v), l)); }
__device__ __forceinline__ unsigned fkey(float f) { const unsigned u = __float_as_uint(f); return (u & 0x80000000u) ? ~u : (u | 0x80000000u); }
typedef __bf16 hwbf16x2 __attribute__((ext_vector_type(2)));
typedef float f32x2 __attribute__((ext_vector_type(2)));
__device__ __forceinline__ unsigned f2bf(float f) { const __bf16 h = (__bf16)f; return (unsigned)__builtin_bit_cast(unsigned short, h); }
__device__ __forceinline__ float bf2f(unsigned b) { return __uint_as_float(b << 16); }
__device__ __forceinline__ unsigned pack2(float lo, float hi) { const f32x2 f = {lo, hi}; const hwbf16x2 v = __builtin_convertvector(f, hwbf16x2); return __builtin_bit_cast(unsigned, v); }
__device__ __forceinline__ float sigmoidf_(float x) { return 1.0f / (1.0f + __expf(-x)); }
__device__ __forceinline__ float siluf_(float x) { return x / (1.0f + __expf(-x)); }
__device__ __forceinline__ float gelu_tanh(float x) {
    const float u2 = 1.5957691216057308f * (x + 0.044715f * x * x * x);
    return x / (1.0f + __expf(-u2));
}


#define XB_TMO      128
#define XB_XCNT(j)  (256  + 64 * (j))
#define XB_XSUB(j)  (1280 + 64 * (j))
#define XB_XGEN(j)  (2304 + 64 * (j))
#define XB_TOP      3328
#define XB_TOPGEN   3392
#define XCD_BAR_WORDS 3456
#define XB_SPIN_CAP (1u << 18)
__device__ __forceinline__ unsigned xb_ld(unsigned* p)              { return __hip_atomic_load(p, __ATOMIC_RELAXED, __HIP_MEMORY_SCOPE_AGENT); }
__device__ __forceinline__ unsigned xb_add(unsigned* p, unsigned v) { return __hip_atomic_fetch_add(p, v, __ATOMIC_RELAXED, __HIP_MEMORY_SCOPE_AGENT); }
__device__ __forceinline__ unsigned xb_xcc_id() { return (unsigned)__builtin_amdgcn_s_getreg((3 << 11) | 20) & 0xFu; }
#define XB_SPIN(cond, bar) do { unsigned _sp = 0; while (cond) { __builtin_amdgcn_s_sleep(1); \
    if ((++_sp & 255u) == 0u) { if (xb_ld(&(bar)[XB_TMO])) break; if (_sp > XB_SPIN_CAP) { atomicAdd(&(bar)[XB_TMO], 1u); break; } } } } while (0)
struct XcdBarrier { unsigned* bar; unsigned x; volatile LAS unsigned* st; };
__device__ __forceinline__ XcdBarrier xcd_barrier_post(unsigned* bar, volatile LAS unsigned* st) {
    XcdBarrier b; b.bar = bar; b.x = xb_xcc_id(); b.st = st;
    if (tidx() == 0) (void)xb_add(&bar[XB_XCNT(b.x)], 1u);
    return b;
}
__device__ __forceinline__ void xcd_barrier_complete(unsigned* bar, unsigned x, unsigned& nloc, unsigned& nx) {
    const unsigned G = gridDim.x * gridDim.y * gridDim.z;
    unsigned sum, cnt, mine, sp = 0u;
    for (;;) {
        sum = 0u; cnt = 0u; mine = 0u;
#pragma unroll
        for (unsigned j = 0; j < 16; ++j) { const unsigned c = xb_ld(&bar[XB_XCNT(j)]); sum += c; cnt += (c > 0u) ? 1u : 0u; mine = (j == x) ? c : mine; }
        if (sum == G) break;
        __builtin_amdgcn_s_sleep(1);
        if ((++sp & 255u) == 0u) { if (xb_ld(&bar[XB_TMO])) break; if (sp > XB_SPIN_CAP) { atomicAdd(&bar[XB_TMO], 1u); break; } }
    }
    nloc = mine > 0u ? mine : 1u; nx = cnt > 0u ? cnt : 1u;
}
__device__ __forceinline__ void xcd_barrier(const XcdBarrier& b) {
    asm volatile("s_waitcnt vmcnt(0)" ::: "memory");
    __syncthreads();
    if (tidx() == 0) {
        unsigned* bar = b.bar;
        __builtin_amdgcn_s_waitcnt(0);
        unsigned nloc = b.st[0], nx = b.st[1];
        if (nloc == 0u) { xcd_barrier_complete(bar, b.x, nloc, nx); b.st[0] = nloc; b.st[1] = nx; }
        const unsigned old = xb_add(&bar[XB_XSUB(b.x)], 1u);
        const unsigned gen = old / nloc;
        if (old + 1u == (gen + 1u) * nloc) {
            __builtin_amdgcn_fence(__ATOMIC_RELEASE, "agent");
            asm volatile("s_waitcnt vmcnt(0)" ::: "memory");
            const unsigned og = xb_add(&bar[XB_TOP], 1u);
            const unsigned tg = og / nx;
            if (og + 1u == (tg + 1u) * nx) xb_add(&bar[XB_TOPGEN], 1u);
            else XB_SPIN(xb_ld(&bar[XB_TOPGEN]) == tg, bar);
            __builtin_amdgcn_fence(__ATOMIC_ACQUIRE, "agent");
            xb_add(&bar[XB_XGEN(b.x)], 1u);
            asm volatile("s_waitcnt vmcnt(0)" ::: "memory");
        } else {
            XB_SPIN(xb_ld(&bar[XB_XGEN(b.x)]) == gen, bar);
            __builtin_amdgcn_fence(__ATOMIC_ACQUIRE, "agent");
            asm volatile("s_waitcnt vmcnt(0)" ::: "memory");
        }
    }
    __syncthreads();
}

struct P {
    const float *x, *even_w_in, *conv_w, *conv_b, *wa, *ba, *wx, *bx, *lam, *hg_lb, *hg_ng, *even_w_out;
    const float *odd_w_in, *pe_k, *pe_v, *wk1, *wk2, *wv1, *wv2, *odd_w_out, *ln_g, *ln_b, *w_router, *b_router;
    const float *w_gate, *w_up, *w_down, *ws_gate, *ws_up, *ws_down;
    float* out;
    float* U;
    bf16_t* MIX;
    float* T0;
    float* XA; bf16_t* XAb; float* XB; bf16_t* XBb; bf16_t* XAl; bf16_t* XBl;
    float* LOG;
    int* eidx; float* ew; int* erank; int* epos;
    int* cnt;
    int* tile_e;
    int* rowtok;
    bf16_t* H;
    bf16_t* Y;
    float* LA; float* LB;
    float* KC; float* VC;
    float* OC;
    unsigned* SELM;
    float* KM;
    unsigned* bar;
    bf16_t *Qb, *KS, *VSt, *KW, *VWt, *MQ, *MK, *MVt;
    float *KCV, *GATES, *OS; unsigned* MSEL;
    bf16_t *UB0;
    bf16_t *VHt;
    bf16_t *WAT, *WXT;
    float *CSA, *CSB;
    bf16_t *UT, *SP;
    float *DV;
    float *HID;
    bf16_t *KCb, *VCt;
    bf16_t *XIb;
    int *plist; int *plen;
    bf16_t *WIN0, *WOUT0, *WIN1, *WOUT1, *WRH, *WRL;
};

__device__ __forceinline__ int lds_off(int r, int c) {
    const int st = (r >> 4) * 2 + (c >> 5), ob = (r & 15) * 64 + (c & 31) * 2;
    return st * 1024 + (ob ^ (((ob >> 9) & 1) << 5));
}
#define GEMM_LDS 32768

__device__ __forceinline__ float cvt_part(float v, int lo) { return lo ? (v - bf2f(f2bf(v))) : v; }

struct BLoadF32 {
    const float* bp; int ldb; bool valid; int nk1;
    struct Regs { f32x4 v[8]; };
    __device__ __forceinline__ void load(int kt, Regs& R) const {
        const float* p = bp + (size_t)((kt % nk1) * 64) * ldb;
#pragma unroll
        for (int j = 0; j < 8; ++j) R.v[j] = valid ? *(const f32x4*)(p + (size_t)j * ldb) : (f32x4){0.f, 0.f, 0.f, 0.f};
    }
    __device__ __forceinline__ void store(int kt, const Regs& R, char* lds) const {
        const int lo = (kt / nk1) == 1;
        const int nq = tidx() & 31, kg = tidx() >> 5;
#pragma unroll
        for (int i = 0; i < 4; ++i) {
            u32x4 w;
            w.x = pack2(cvt_part(R.v[0][i], lo), cvt_part(R.v[1][i], lo)); w.y = pack2(cvt_part(R.v[2][i], lo), cvt_part(R.v[3][i], lo));
            w.z = pack2(cvt_part(R.v[4][i], lo), cvt_part(R.v[5][i], lo)); w.w = pack2(cvt_part(R.v[6][i], lo), cvt_part(R.v[7][i], lo));
            *(u32x4*)(lds + lds_off(nq * 4 + i, kg * 8)) = w;
        }
    }
};

template <class AL, class BL>
__device__ __forceinline__ void gemm_tile(char* lds, const AL& al, const BL& bl, int nk, f32x4 (&acc)[4][4], bool swap = false) {
    const int lane = tidx() & 63, wid = tidx() >> 6, wr = wid >> 1, wc = wid & 1, fr = lane & 15, fq = lane >> 4;
    char* ldsA = lds; char* ldsB = lds + 16384;
    const char* t2 = swap ? ldsB : ldsA; const char* t1 = swap ? ldsA : ldsB; const int w2 = swap ? wc : wr, w1 = swap ? wr : wc;
#pragma unroll
    for (int m = 0; m < 4; ++m)
#pragma unroll
        for (int n = 0; n < 4; ++n) acc[m][n] = (f32x4){0.f, 0.f, 0.f, 0.f};
    typename AL::Regs ra; typename BL::Regs rb;
    al.load(0, ra); bl.load(0, rb);
    for (int kt = 0; kt < nk; ++kt) {
        __syncthreads();
        al.store(kt, ra, ldsA); bl.store(kt, rb, ldsB);
        __syncthreads();
        if (kt + 1 < nk) { al.load(kt + 1, ra); bl.load(kt + 1, rb); }
#pragma unroll
        for (int kk = 0; kk < 2; ++kk) {
            bf16x8 a[4], b[4];
#pragma unroll
            for (int m = 0; m < 4; ++m) a[m] = *(const bf16x8*)(t2 + lds_off(w2 * 64 + m * 16 + fr, kk * 32 + fq * 8));
#pragma unroll
            for (int n = 0; n < 4; ++n) b[n] = *(const bf16x8*)(t1 + lds_off(w1 * 64 + n * 16 + fr, kk * 32 + fq * 8));
#pragma unroll
            for (int m = 0; m < 4; ++m)
#pragma unroll
                for (int n = 0; n < 4; ++n) acc[m][n] = __builtin_amdgcn_mfma_f32_16x16x32_bf16(b[n], a[m], acc[m][n], 0, 0, 0);
        }
    }
}


__device__ __forceinline__ void dma_rc(int lane, int st, int& R, int& C) {
    const int sb = lane * 16, swz = sb ^ (((sb >> 9) & 1) << 5);
    R = (st >> 1) * 16 + (swz >> 6); C = (st & 1) * 32 + ((swz & 63) >> 1);
}
#define G3_STAGE 24576
#define G3_LDS (2 * G3_STAGE)
__device__ __forceinline__ int t32_off(int r, int c) { const int ob = (r & 15) * 64 + c * 2; return (r >> 4) * 1024 + (ob ^ (((ob >> 9) & 1) << 5)); }
__device__ __forceinline__ void dma_rc32(int lane, int st, int& R, int& C) { const int sb = lane * 16, swz = sb ^ (((sb >> 9) & 1) << 5); R = st * 16 + (swz >> 6); C = (swz & 63) >> 1; }
struct Dma3A {
    static constexpr int NV = 4;
    const char* base; unsigned voff[4];
    const char* lo = nullptr; int nk1 = 1 << 30;
    __device__ __forceinline__ void set_dense(const bf16_t* b0, int row0, int ld) {
        base = (const char*)b0; const int lane = tidx() & 63, w = tidx() >> 6;
#pragma unroll
        for (int i = 0; i < 4; ++i) { int R, C; dma_rc32(lane, w + 4 * i, R, C); voff[i] = (unsigned)(((size_t)(row0 + R) * ld + C) * 2); }
    }
    template <int SET = 0> __device__ __forceinline__ void issue(int kt, int ldsoff) const {
        const int w = tidx() >> 6;
#pragma unroll
        for (int i = 0; i < 4; ++i)
            __builtin_amdgcn_global_load_lds((const unsigned*)((((kt / nk1) == 2) ? lo : base) + voff[i] + (size_t)(kt % nk1) * 64), (LAS unsigned*)((LAS char*)dyn_lds + ldsoff + (w + 4 * i) * 1024), 16, 0, 0);
    }
    template <int SET = 0> __device__ __forceinline__ void commit(int, int) const {}
};
struct Dma3B {
    static constexpr int LAYOUT = 0, NV = 2;
    const char* hi; const char* lo; unsigned voff[2]; int nk1;
    __device__ __forceinline__ void set(const bf16_t* h, const bf16_t* l, int row0, int ld, int nk1_) {
        hi = (const char*)h; lo = (const char*)l; nk1 = nk1_; const int lane = tidx() & 63, w = tidx() >> 6;
#pragma unroll
        for (int i = 0; i < 2; ++i) { int R, C; dma_rc32(lane, w + 4 * i, R, C); const int Rs = (R & ~31) + 8 * ((R & 15) >> 2) + 4 * ((R >> 4) & 1) + (R & 3);
            voff[i] = (unsigned)(((size_t)(row0 + Rs) * ld + C) * 2); }
    }
    template <int SET = 0> __device__ __forceinline__ void issue(int kt, int ldsoff) const {
        const int w = tidx() >> 6; const char* base = ((kt / nk1) == 1) ? lo : hi; const size_t ko = (size_t)(kt % nk1) * 64;
#pragma unroll
        for (int i = 0; i < 2; ++i)
            __builtin_amdgcn_global_load_lds((const unsigned*)(base + voff[i] + ko), (LAS unsigned*)((LAS char*)dyn_lds + ldsoff + (w + 4 * i) * 1024), 16, 0, 0);
    }
    template <int SET = 0> __device__ __forceinline__ void commit(int, int) const {}
};
struct Reg3B {
    static constexpr int LAYOUT = 1, NV = 4;
    const float* bp; int ldb; f32x4 v[2][4]; int perm64 = 0;
    template <int SET = 0> __device__ __forceinline__ void issue(int kt, int) {
        const float* p = bp + (size_t)(kt * 32) * ldb;
#pragma unroll
        for (int j = 0; j < 4; ++j) v[SET][j] = *(const f32x4*)(p + (size_t)j * ldb);
    }
    template <int SET = 0> __device__ __forceinline__ void commit(int, int ldsoff) const {
        const int tid = tidx(), nq = tid & 31, kg = tid >> 5;
        u32x2 w[4];
#pragma unroll
        for (int i = 0; i < 4; ++i) { w[i].x = pack2(v[SET][0][i], v[SET][1][i]); w[i].y = pack2(v[SET][2][i], v[SET][3][i]); }
        const int q = nq & 7, q16 = nq & 15;
        const int rowbase = perm64 ? ((nq >> 4) * 64 + (q16 & 3) * 16 + (q16 >> 2) * 4) : ((nq >> 3) * 32 + (q & 1) * 16 + (q >> 1) * 4);
        const int rot = perm64 ? (q16 & 3) : ((q & 1) + 2 * ((q >> 2) & 1));
#pragma unroll
        for (int i = 0; i < 4; ++i) {
            const int e = (i + rot) & 3;
            u32x2 d;
            d.x = e == 0 ? w[0].x : (e == 1 ? w[1].x : (e == 2 ? w[2].x : w[3].x));
            d.y = e == 0 ? w[0].y : (e == 1 ? w[1].y : (e == 2 ? w[2].y : w[3].y));
            *(u32x2*)(dyn_lds + ldsoff + ((((kg >> 1) * 128 + rowbase + e) << 4) + (kg & 1) * 8)) = d;
        }
    }
};
#define G4_LDS (3 * G3_STAGE)
template <class AL, class BL, int PAR>
__device__ __forceinline__ void g4_step(AL& al, BL& bl, int kt, int nk, f32x4 (&acc)[32], bool idle) {
    constexpr int NV = AL::NV + BL::NV;
    const int lane = tidx() & 63, wid = tidx() >> 6, wr = wid >> 1, wc = wid & 1, fr = lane & 15, fq = lane >> 4;
    const int s0 = kt % 3, cur = s0 * G3_STAGE, nx1 = (s0 == 2 ? 0 : s0 + 1) * G3_STAGE, nx2 = (s0 == 0 ? 2 : s0 - 1) * G3_STAGE;
    if (kt + 1 < nk) asm volatile("s_waitcnt vmcnt(%0) lgkmcnt(0)" :: "n"(NV) : "memory");
    else asm volatile("s_waitcnt vmcnt(0) lgkmcnt(0)" ::: "memory");
    __builtin_amdgcn_s_barrier();
    asm volatile("" ::: "memory");
    if (kt + 2 < nk) { al.template issue<PAR>(kt + 2, nx2); bl.template issue<PAR>(kt + 2, nx2 + 16384); }
    if (!idle) {
    constexpr int BS = BL::LAYOUT == 1 ? 256 : 1024;
    const unsigned baddr = (unsigned)(size_t)((LAS char*)dyn_lds + cur + 16384 + (BL::LAYOUT == 1 ? ((fq * 128 + wc * 64 + fr) << 4) : t32_off(wc * 64 + fr, fq * 8)));
    const unsigned aaddr = (unsigned)(size_t)((LAS char*)dyn_lds + cur + t32_off(wr * 128 + fr, fq * 8));
    u32x4 sm0, sm1, sm2, sm3, a0, a1, a2;
#define DSR(dst, addr, off) asm volatile("ds_read_b128 %0, %1 offset:%2" : "=v"(dst) : "v"(addr), "n"(off) : "memory")
#define MF4(I, AF) do { __builtin_amdgcn_sched_barrier(0); \
        acc[(I) * 4 + 0] = __builtin_amdgcn_mfma_f32_16x16x32_bf16(__builtin_bit_cast(bf16x8, sm0), __builtin_bit_cast(bf16x8, AF), acc[(I) * 4 + 0], 0, 0, 0); \
        acc[(I) * 4 + 1] = __builtin_amdgcn_mfma_f32_16x16x32_bf16(__builtin_bit_cast(bf16x8, sm1), __builtin_bit_cast(bf16x8, AF), acc[(I) * 4 + 1], 0, 0, 0); \
        acc[(I) * 4 + 2] = __builtin_amdgcn_mfma_f32_16x16x32_bf16(__builtin_bit_cast(bf16x8, sm2), __builtin_bit_cast(bf16x8, AF), acc[(I) * 4 + 2], 0, 0, 0); \
        acc[(I) * 4 + 3] = __builtin_amdgcn_mfma_f32_16x16x32_bf16(__builtin_bit_cast(bf16x8, sm3), __builtin_bit_cast(bf16x8, AF), acc[(I) * 4 + 3], 0, 0, 0); \
        __builtin_amdgcn_sched_barrier(0); } while (0)
    DSR(sm0, baddr, 0); DSR(sm1, baddr, BS); DSR(sm2, baddr, 2 * BS); DSR(sm3, baddr, 3 * BS);
    DSR(a0, aaddr, 0); DSR(a1, aaddr, 1024);
    asm volatile("s_waitcnt lgkmcnt(1)" : "+v"(sm0), "+v"(sm1), "+v"(sm2), "+v"(sm3), "+v"(a0) :: "memory");
    DSR(a2, aaddr, 2048); MF4(0, a0);
    asm volatile("s_waitcnt lgkmcnt(1)" : "+v"(a1) :: "memory"); DSR(a0, aaddr, 3072); MF4(1, a1);
    asm volatile("s_waitcnt lgkmcnt(1)" : "+v"(a2) :: "memory"); DSR(a1, aaddr, 4096); MF4(2, a2);
    asm volatile("s_waitcnt lgkmcnt(1)" : "+v"(a0) :: "memory"); DSR(a2, aaddr, 5120); MF4(3, a0);
    asm volatile("s_waitcnt lgkmcnt(1)" : "+v"(a1) :: "memory"); DSR(a0, aaddr, 6144); MF4(4, a1);
    asm volatile("s_waitcnt lgkmcnt(1)" : "+v"(a2) :: "memory"); DSR(a1, aaddr, 7168); MF4(5, a2);
    asm volatile("s_waitcnt lgkmcnt(1)" : "+v"(a0) :: "memory"); MF4(6, a0);
    asm volatile("s_waitcnt lgkmcnt(0)" : "+v"(a1) :: "memory"); MF4(7, a1);
#undef DSR
#undef MF4
    }
    if (kt + 1 < nk) bl.template commit<PAR ^ 1>(kt + 1, nx1 + 16384);
}
template <class AL, class BL>
__device__ __forceinline__ void gemm_core4(AL& al, BL& bl, int nk, f32x4 (&acc)[32], bool idle_hi = false) {
    const bool idle = idle_hi && (tidx() >> 7);
#pragma unroll
    for (int i = 0; i < 32; ++i) acc[i] = (f32x4){0.f, 0.f, 0.f, 0.f};
    al.template issue<0>(0, 0); bl.template issue<0>(0, 16384);
    if (nk > 1) { al.template issue<1>(1, G3_STAGE); bl.template issue<1>(1, G3_STAGE + 16384); }
    bl.template commit<0>(0, 16384);
    for (int kt = 0; kt < nk; kt += 2) {
        g4_step<AL, BL, 0>(al, bl, kt, nk, acc, idle);
        if (kt + 1 < nk) g4_step<AL, BL, 1>(al, bl, kt + 1, nk, acc, idle);
    }
    __syncthreads();
}
__device__ __forceinline__ bool dense_unit3(int bid, int nb, int j, int ntn, int& tm, int& tn) {
    if ((nb & 7) == 0) {
        const int x = bid & 7, r = bid >> 3, R = nb >> 3;
        const int li = r + R * j;
        if (li >= 8 * ntn) return false;
        tn = li >> 3; tm = x * 8 + (li & 7);
        return true;
    }
    const int u = bid + nb * j;
    if (u >= 64 * ntn) return false;
    tm = u / ntn; tn = u % ntn; return true;
}
__device__ __forceinline__ void prep_tile(char* lds, const float* W, int ldw, int k0, int scol0, bool colvalid, bf16_t* Bt, int K, int drow0, int mode) {
    const int tid = tidx();
    bf16_t* t = (bf16_t*)lds;
    __syncthreads();
#pragma unroll
    for (int i = 0; i < 4; ++i) {
        const int k = (tid >> 4) + 16 * i, q = tid & 15;
        f32x4 v = colvalid ? *(const f32x4*)(W + (size_t)(k0 + k) * ldw + scol0 + q * 4) : (f32x4){0.f, 0.f, 0.f, 0.f};
#pragma unroll
        for (int e = 0; e < 4; ++e) { float x = v[e]; if (mode == 2) x = x - bf2f(f2bf(x)); t[(q * 4 + e) * 72 + k] = (bf16_t)f2bf(x); }
    }
    __syncthreads();
#pragma unroll
    for (int i = 0; i < 2; ++i) { const int pc = tid + 256 * i, n = pc >> 3, ch = pc & 7;
        *(u32x4*)(Bt + (size_t)(drow0 + n) * K + k0 + ch * 8) = *(const u32x4*)(t + n * 72 + ch * 8); }
}
__device__ __forceinline__ int vcol_actual(int v);
__device__ __forceinline__ void phase_prep(char* lds, int bid, int nb, const P& p) {
    const int tid = tidx();
    for (size_t i = (size_t)bid * 256 + tid; i < (size_t)NTOK * DM / 8; i += (size_t)nb * 256) {
        const f32x4 a = *(const f32x4*)(p.x + i * 8), b = *(const f32x4*)(p.x + i * 8 + 4);
        u32x4 w; w.x = pack2(a[0], a[1]); w.y = pack2(a[2], a[3]); w.z = pack2(b[0], b[1]); w.w = pack2(b[2], b[3]);
        *(u32x4*)(p.XIb + i * 8) = w;
    }
    for (int u = bid; u < 2272; u += nb) {
        if (u < 768) { const int nt = u >> 4, kt = u & 15; const int d = nt * 64; const int sc = d < 2048 ? d : (d < 2560 ? d + 512 : d - 512);
            prep_tile(lds, p.even_w_in, EVEN_IN, kt * 64, sc, true, p.WIN0, DM, d, 0); }
        else if (u < 1024) { const int v = u - 768, nt = v >> 4, kt = v & 15; prep_tile(lds, p.even_w_out, DM, kt * 64, nt * 64, true, p.WOUT0, DM, nt * 64, 0); }
        else if (u < 1760) { const int v = u - 1024, nt = v >> 4, kt = v & 15; const int d = nt * 64;
            int sc; bool ok = true;
            if (d < 896) sc = d; else if (d < 1024) sc = d + 128; else if (d < 1536) sc = d + 280; else if (d < 2048) sc = d + 280;
            else if (d < 2112) sc = 1280; else if (d < 2176) { sc = 0; ok = false; } else if (d < 2304) sc = d - 1280; else if (d < 2432) sc = d - 1152; else sc = d - 104;
            prep_tile(lds, p.odd_w_in, ODD_IN, kt * 64, sc, ok, p.WIN1, DM, d, 0); }
        else if (u < 2016) { const int v = u - 1760, nt = v >> 4, kt = v & 15; prep_tile(lds, p.odd_w_out, DM, kt * 64, nt * 64, true, p.WOUT1, DM, nt * 64, 0); }
        else { const int v = u - 2016, layer = v >> 7, lo = (v >> 6) & 1, nt = (v >> 4) & 3, kt = v & 15;
            prep_tile(lds, p.w_router + (size_t)layer * DM * NEXP, NEXP, kt * 64, nt * 64, true, (lo ? p.WRL : p.WRH) + (size_t)layer * NEXP * DM, DM, nt * 64, lo ? 2 : 1); }
    }
    __syncthreads();
}


__device__ __forceinline__ void phase_gemm_f32out(int bid, int nb, const bf16_t* A, const bf16_t* Bt, int N, int K, float* C) {
    const int ntn = N / 128;
    const int tid = tidx(), lane = tid & 63, wid = tid >> 6, wr = wid >> 1, wc = wid & 1, fr = lane & 15, fq = lane >> 4;
    for (int j = 0;; ++j) {
        int tm, tn; if (!dense_unit3(bid, nb, j, ntn, tm, tn)) break;
        Dma3A al; al.set_dense(A, tm * 256, K); Dma3B bl; bl.set(Bt, Bt, tn * 128, K, 1 << 30);
        f32x4 acc[32];
        gemm_core4(al, bl, K / 32, acc);
#pragma unroll
        for (int i = 0; i < 8; ++i)
#pragma unroll
            for (int gg = 0; gg < 2; ++gg) { const f32x4 a = acc[i * 4 + 2 * gg], b2 = acc[i * 4 + 2 * gg + 1];
                u32x4 w; w.x = pack2(a[0], a[1]); w.y = pack2(a[2], a[3]); w.z = pack2(b2[0], b2[1]); w.w = pack2(b2[2], b2[3]);
                *(u32x4*)((bf16_t*)C + (size_t)(tm * 256 + wr * 128 + i * 16 + fr) * N + tn * 128 + wc * 64 + gg * 32 + fq * 8) = w; }
    }
}
__device__ __forceinline__ void phase_router(int bid, int nb, const P& p, int layer) {
    const int tid = tidx(), lane = tid & 63, wid = tid >> 6, wr = wid >> 1, wc = wid & 1, fr = lane & 15, fq = lane >> 4;
    for (int j = 0;; ++j) {
        int tm, t6; if (!dense_unit3(bid, nb, j, 6, tm, t6)) break;
        const int tn = t6 & 1, part = t6 >> 1;
        Dma3A al; al.set_dense(part == 2 ? p.XAl : p.XAb, tm * 256, DM);
        const bf16_t* wsrc = (part == 1 ? p.WRL : p.WRH) + (size_t)layer * NEXP * DM;
        Dma3B bl; bl.set(wsrc, wsrc, tn * 128, DM, 1 << 30);
        f32x4 acc[32];
        gemm_core4(al, bl, 32, acc);
        float* dst = p.LOG + (size_t)part * NTOK * NEXP;
#pragma unroll
        for (int i = 0; i < 8; ++i)
#pragma unroll
            for (int gg = 0; gg < 2; ++gg) { float* q = dst + (size_t)(tm * 256 + wr * 128 + i * 16 + fr) * NEXP + tn * 128 + wc * 64 + gg * 32 + fq * 8;
                *(f32x4*)q = acc[i * 4 + 2 * gg]; *(f32x4*)(q + 4) = acc[i * 4 + 2 * gg + 1]; }
    }
}
__device__ __forceinline__ void ln_row_store(float (&v)[16], const float* g, const float* b, float* of, bf16_t* ob, int row, int lane, bf16_t* ol = nullptr) {
    float s = 0.f;
#pragma unroll
    for (int i = 0; i < 16; ++i) s += v[i];
    const float mu = wave_sum(s) * (1.0f / DM);
    float q = 0.f;
#pragma unroll
    for (int i = 0; i < 16; ++i) { const float d = v[i] - mu; q += d * d; }
    const float rstd = rsqrtf(wave_sum(q) * (1.0f / DM) + LN_EPS);
#pragma unroll
    for (int h = 0; h < 2; ++h) {
        const int c0 = h * 512 + lane * 8;
        float o[8];
#pragma unroll
        for (int i = 0; i < 8; ++i) o[i] = (v[h * 8 + i] - mu) * rstd * g[c0 + i] + b[c0 + i];
        if (of) { *(f32x4*)(of + (size_t)row * DM + c0) = (f32x4){o[0], o[1], o[2], o[3]};
                  *(f32x4*)(of + (size_t)row * DM + c0 + 4) = (f32x4){o[4], o[5], o[6], o[7]}; }
        if (ob) { u32x4 w; w.x = pack2(o[0], o[1]); w.y = pack2(o[2], o[3]); w.z = pack2(o[4], o[5]); w.w = pack2(o[6], o[7]); *(u32x4*)(ob + (size_t)row * DM + c0) = w;
            if (ol) { float l[8];
#pragma unroll
                for (int i = 0; i < 8; ++i) l[i] = o[i] - bf2f(f2bf(o[i]));
                u32x4 wl; wl.x = pack2(l[0], l[1]); wl.y = pack2(l[2], l[3]); wl.z = pack2(l[4], l[5]); wl.w = pack2(l[6], l[7]); *(u32x4*)(ol + (size_t)row * DM + c0) = wl; } }
    }
}
__device__ __forceinline__ void phase_ln_add(int bid, int nb, const float* res, const bf16_t* resh, const bf16_t* resl, const float* add, const float* g, const float* b, float* of, bf16_t* ob, bf16_t* ol) {
    const int lane = tidx() & 63, wid = tidx() >> 6;
    for (int row = bid * 4 + wid; row < NTOK; row += nb * 4) {
        float v[16];
#pragma unroll
        for (int h = 0; h < 2; ++h) {
            const size_t o = (size_t)row * DM + h * 512 + lane * 8;
            f32x4 r0, r1;
            if (res) { r0 = *(const f32x4*)(res + o); r1 = *(const f32x4*)(res + o + 4); }
            else { const u32x4 xh = *(const u32x4*)(resh + o);
                r0[0] = bf2f(xh.x & 0xffffu); r0[1] = bf2f(xh.x >> 16); r0[2] = bf2f(xh.y & 0xffffu); r0[3] = bf2f(xh.y >> 16);
                r1[0] = bf2f(xh.z & 0xffffu); r1[1] = bf2f(xh.z >> 16); r1[2] = bf2f(xh.w & 0xffffu); r1[3] = bf2f(xh.w >> 16); }
            const u32x4 ab = *(const u32x4*)((const bf16_t*)add + o);
            const float a0[4] = {bf2f(ab.x & 0xffffu), bf2f(ab.x >> 16), bf2f(ab.y & 0xffffu), bf2f(ab.y >> 16)};
            const float a1[4] = {bf2f(ab.z & 0xffffu), bf2f(ab.z >> 16), bf2f(ab.w & 0xffffu), bf2f(ab.w >> 16)};
#pragma unroll
            for (int i = 0; i < 4; ++i) { v[h * 8 + i] = DN_ALPHA * r0[i] + a0[i]; v[h * 8 + 4 + i] = DN_ALPHA * r1[i] + a1[i]; }
        }
        ln_row_store(v, g, b, of, ob, row, lane, ol);
    }
}

__device__ __forceinline__ void phase_route(int bid, int nb, const P& p, int layer) {
    const float* br = p.b_router + layer * NEXP;
    const int tid = tidx(), lane = tid & 63, wid = tid >> 6;
    const int gt = bid * 256 + tid, gs = nb * 256;
    for (int i = gt; i < NROWS; i += gs) p.rowtok[i] = (i >= SH_TILE0 * 128) ? (i - SH_TILE0 * 128) : 0;
    const f32x4 bv = *(const f32x4*)(br + lane * 4);
    for (int tb = bid * 4 + wid; tb < NTOK; tb += nb * 4 * 8) {
        int es[8]; float ws[8];
        f32x4 lgs[8];
#pragma unroll
        for (int q = 0; q < 8; ++q) {
            const int t = min(tb + q * nb * 4, NTOK - 1);
            lgs[q] = (*(const f32x4*)(p.LOG + (size_t)t * NEXP + lane * 4) + *(const f32x4*)(p.LOG + (size_t)NTOK * NEXP + (size_t)t * NEXP + lane * 4)) + *(const f32x4*)(p.LOG + (size_t)2 * NTOK * NEXP + (size_t)t * NEXP + lane * 4);
        }
#pragma unroll
        for (int q = 0; q < 8; ++q) {
            const int t = tb + q * nb * 4;
            es[q] = 0; ws[q] = 0.f;
            if (t < NTOK) {
        const f32x4 lg = lgs[q];
        float sc[4], bs[4];
#pragma unroll
        for (int i = 0; i < 4; ++i) { sc[i] = sigmoidf_(lg[i]); bs[i] = sc[i] + bv[i]; }
        float t1 = fmaxf(bs[0], bs[1]), t2 = fminf(bs[0], bs[1]);
        { const float a = fmaxf(bs[2], bs[3]), c = fminf(bs[2], bs[3]); const float n1 = fmaxf(t1, a); t2 = fmaxf(fminf(t1, a), fmaxf(t2, c)); t1 = n1; }
#define R_MERGE(CTRL) { const float o1 = dppf<CTRL>(t1), o2 = dppf<CTRL>(t2); const float n1 = fmaxf(t1, o1); t2 = fmaxf(fminf(t1, o1), fmaxf(t2, o2)); t1 = n1; }
        R_MERGE(0xB1) R_MERGE(0x4E) R_MERGE(0x141)
#undef R_MERGE
        const float gsc = t1 + t2;
        const int g = lane >> 3;
        int rank = 0;
#pragma unroll
        for (int g2 = 0; g2 < 8; ++g2) { const float o = rlanef(gsc, g2 * 8); rank += (o > gsc || (o == gsc && g2 < g)) ? 1 : 0; }
        const bool allowed = rank < 4;
        unsigned key[4];
#pragma unroll
        for (int i = 0; i < 4; ++i) key[i] = allowed ? fkey(bs[i] + 0.0f) : 0u;
        unsigned T = 0u;
#pragma unroll 1
        for (int bbit = 31; bbit >= 0; --bbit) {
            const unsigned cand = T | (1u << bbit);
            const int c = __builtin_popcountll(__builtin_amdgcn_ballot_w64(key[0] >= cand)) + __builtin_popcountll(__builtin_amdgcn_ballot_w64(key[1] >= cand))
                        + __builtin_popcountll(__builtin_amdgcn_ballot_w64(key[2] >= cand)) + __builtin_popcountll(__builtin_amdgcn_ballot_w64(key[3] >= cand));
            if (c >= 8) T = cand;
        }
        unsigned long long m0 = __builtin_amdgcn_ballot_w64(key[0] > T), m1 = __builtin_amdgcn_ballot_w64(key[1] > T);
        unsigned long long m2 = __builtin_amdgcn_ballot_w64(key[2] > T), m3 = __builtin_amdgcn_ballot_w64(key[3] > T);
        unsigned long long q0 = __builtin_amdgcn_ballot_w64(key[0] == T), q1 = __builtin_amdgcn_ballot_w64(key[1] == T);
        unsigned long long q2 = __builtin_amdgcn_ballot_w64(key[2] == T), q3 = __builtin_amdgcn_ballot_w64(key[3] == T);
        const int need = 8 - (__builtin_popcountll(m0) + __builtin_popcountll(m1) + __builtin_popcountll(m2) + __builtin_popcountll(m3));
        for (int drop = __builtin_popcountll(q0) + __builtin_popcountll(q1) + __builtin_popcountll(q2) + __builtin_popcountll(q3) - need; drop > 0; --drop) {
            const int e0 = q0 ? (63 - __builtin_clzll(q0)) * 4 + 0 : -1, e1 = q1 ? (63 - __builtin_clzll(q1)) * 4 + 1 : -1;
            const int e2 = q2 ? (63 - __builtin_clzll(q2)) * 4 + 2 : -1, e3 = q3 ? (63 - __builtin_clzll(q3)) * 4 + 3 : -1;
            const int best = max(max(e0, e1), max(e2, e3));
            const unsigned long long keep = ~(1ull << (best >> 2));
            if ((best & 3) == 0) q0 &= keep; else if ((best & 3) == 1) q1 &= keep; else if ((best & 3) == 2) q2 &= keep; else q3 &= keep;
        }
        m0 |= q0; m1 |= q1; m2 |= q2; m3 |= q3;
        float wsel = 0.f; int esel = 0; float wsum = 0.f;
#pragma unroll
        for (int n = 0; n < 8; ++n) {
            const int in_ = m0 ? 0 : (m1 ? 1 : (m2 ? 2 : 3));
            const unsigned long long mm = m0 ? m0 : (m1 ? m1 : (m2 ? m2 : m3));
            const int l = __builtin_ctzll(mm | 0x8000000000000000ull);
            const unsigned long long cl = mm & (mm - 1ull);
            if (in_ == 0) m0 = cl; else if (in_ == 1) m1 = cl; else if (in_ == 2) m2 = cl; else m3 = cl;
            const float s0 = rlanef(sc[0], l), s1 = rlanef(sc[1], l), s2 = rlanef(sc[2], l), s3 = rlanef(sc[3], l);
            const float sv = in_ == 0 ? s0 : (in_ == 1 ? s1 : (in_ == 2 ? s2 : s3));
            wsum += sv;
            if (lane == n) { wsel = sv; esel = l * 4 + in_; }
        }
        es[q] = esel; ws[q] = wsel / wsum * 2.5f;
            }
        }
        int rk[8];
#pragma unroll
        for (int q = 0; q < 8; ++q) { rk[q] = 0; if (lane < 8 && tb + q * nb * 4 < NTOK) rk[q] = atomicAdd(&p.cnt[(bid & 31) * NEXP + es[q]], 1); }
#pragma unroll
        for (int q = 0; q < 8; ++q) { const int t = tb + q * nb * 4; if (lane < 8 && t < NTOK) { p.eidx[t * 8 + lane] = es[q]; p.ew[t * 8 + lane] = ws[q]; p.erank[t * 8 + lane] = rk[q]; } }
    }
}
__device__ __forceinline__ void phase_scatter(char* lds, int bid, int nb, const P& p) {
    int* base = (int*)lds;
    int* pc = base + 260;
    int* so = base + 520;
    const int tid = tidx();
    __syncthreads();
    { int c = 0;
#pragma unroll
      for (int sb = 0; sb < 32; ++sb) { so[sb * 256 + tid] = c; c += p.cnt[sb * NEXP + tid]; }
      pc[tid] = (c + 127) & ~127; }
    __syncthreads();
    { int s = 0; for (int e = 0; e < tid; ++e) s += pc[e]; base[tid] = s; if (tid == 255) base[256] = s + pc[255]; }
    __syncthreads();
    const int tpb = nb * 4;
    for (int a = bid * 256 + tid; a < NTOK * 8; a += nb * 256) {
        const int e = p.eidx[a]; const int t = a >> 3; const int sb = ((t % tpb) >> 2) & 31;
        const int row = base[e] + so[sb * 256 + e] + p.erank[a];
        p.rowtok[row] = t; p.epos[a] = row;
    }
    if (bid == 0) {
        {
            const int xq = tid & 7; int off = 0, tot = 0;
            for (int e = xq; e < 256; e += 8) { const int n = ((pc[e] >> 7) + 1) >> 1; if (e < tid) off += n; tot += n; }
            const int t0 = base[tid] >> 7, nte = pc[tid] >> 7;
            for (int i = 0; i < nte; i += 2) p.plist[xq * 320 + off + (i >> 1)] = (t0 + i) | ((i + 1 < nte) ? 0 : 0x40000000);
            if (tid < 64) { int totp = 0; for (int e = (tid & 7); e < 256; e += 8) totp += ((pc[e] >> 7) + 1) >> 1; p.plist[(tid & 7) * 320 + totp + (tid >> 3)] = SH_TILE0 + 2 * tid; }
            if (tid < 8) p.plen[tid] = tot + 8;
        }
        const int nrt = base[256] >> 7;
        for (int i = tid; i < NTILES; i += 256) if (i >= nrt) p.tile_e[i] = (i >= SH_TILE0) ? NEXP : -1;
        const int t0 = base[tid] >> 7, t1 = base[tid + 1] >> 7;
        for (int i = t0; i < t1; ++i) p.tile_e[i] = tid;
    }
    __syncthreads();
}
__device__ __forceinline__ void phase_moe1(char* lds, int bid, int nb, const P& p, int layer, const bf16_t* Xb) {
    const int tid = tidx(), lane = tid & 63, wid = tid >> 6, wr = wid >> 1, wc = wid & 1, fr = lane & 15, fq = lane >> 4;
    const int xq = bid & 7, tot = p.plen[xq] * 4, stp = nb >> 3;
    int Rr[4], Cc[4];
#pragma unroll
    for (int i = 0; i < 4; ++i) dma_rc32(lane, wid + 4 * i, Rr[i], Cc[i]);
    int ui = bid >> 3;
    int ent0 = 0, e0 = 0, tok0[4] = {0, 0, 0, 0}, ent1 = 0;
    if (ui < tot) { ent0 = p.plist[xq * 320 + (ui >> 2)]; const int t0 = ent0 & 0xffff, t1 = ((ent0 >> 30) & 1) ? t0 : t0 + 1; e0 = p.tile_e[t0];
#pragma unroll
        for (int i = 0; i < 4; ++i) tok0[i] = p.rowtok[(Rr[i] < 128 ? t0 : t1) * 128 + (Rr[i] & 127)]; }
    if (ui + stp < tot) ent1 = p.plist[xq * 320 + ((ui + stp) >> 2)];
    for (; ui < tot; ui += stp) {
        const int nt = ui & 3;
        const int ent = ent0, e = e0;
        const int tile0 = ent & 0xffff, single = (ent >> 30) & 1, tile1 = single ? tile0 : tile0 + 1;
        Dma3A al; al.base = (const char*)Xb;
#pragma unroll
        for (int i = 0; i < 4; ++i) al.voff[i] = (unsigned)(((size_t)tok0[i] * DM + Cc[i]) * 2);
        if (ui + stp < tot) { ent0 = ent1; const int t0 = ent0 & 0xffff, t1 = ((ent0 >> 30) & 1) ? t0 : t0 + 1; e0 = p.tile_e[t0];
#pragma unroll
            for (int i = 0; i < 4; ++i) tok0[i] = p.rowtok[(Rr[i] < 128 ? t0 : t1) * 128 + (Rr[i] & 127)]; }
        if (ui + 2 * stp < tot) ent1 = p.plist[xq * 320 + ((ui + 2 * stp) >> 2)];
        const float* Wg = (e < NEXP) ? p.w_gate + ((size_t)layer * NEXP + e) * (DM * 256) : p.ws_gate + (size_t)layer * (DM * 256);
        const float* Wu = (e < NEXP) ? p.w_up + ((size_t)layer * NEXP + e) * (DM * 256) : p.ws_up + (size_t)layer * (DM * 256);
        Reg3B bl; { const int nq = tid & 31, kg = tid >> 5; const int j = nq * 4, jw = j & 63, w2 = j >> 6; const int col = nt * 64 + w2 * 32 + (jw & 31);
            bl.ldb = 256; bl.bp = ((jw >= 32) ? Wu : Wg) + (size_t)(kg * 4) * 256 + col; }
        f32x4 acc[32];
        gemm_core4(al, bl, DM / 32, acc, single != 0);
        if (!(wr && single)) {
            const int tile = wr ? tile1 : tile0;
#pragma unroll
            for (int i = 0; i < 8; ++i)
                {
                    const int row = tile * 128 + i * 16 + fr, col = nt * 64 + wc * 32 + fq * 8;
                    const f32x4 g0 = acc[i * 4 + 0], g1 = acc[i * 4 + 1], u0 = acc[i * 4 + 2], u1 = acc[i * 4 + 3];
                    u32x4 w;
                    w.x = pack2(siluf_(g0[0]) * u0[0], siluf_(g0[1]) * u0[1]); w.y = pack2(siluf_(g0[2]) * u0[2], siluf_(g0[3]) * u0[3]);
                    w.z = pack2(siluf_(g1[0]) * u1[0], siluf_(g1[1]) * u1[1]); w.w = pack2(siluf_(g1[2]) * u1[2], siluf_(g1[3]) * u1[3]);
                    *(u32x4*)(p.H + (size_t)row * 256 + col) = w;
                }
        }
    }
}
__device__ __forceinline__ void phase_moe2(char* lds, int bid, int nb, const P& p, int layer) {
    const int tid = tidx(), lane = tid & 63, wid = tid >> 6, wr = wid >> 1, wc = wid & 1, fr = lane & 15, fq = lane >> 4;
    const int xq = bid & 7, tot = p.plen[xq] * 8, stp = nb >> 3;
    int Rr[4], Cc[4];
#pragma unroll
    for (int i = 0; i < 4; ++i) dma_rc32(lane, wid + 4 * i, Rr[i], Cc[i]);
    int ui = bid >> 3;
    int ent0 = 0, e0 = 0, ent1 = 0;
    if (ui < tot) { ent0 = p.plist[xq * 320 + (ui >> 3)]; e0 = p.tile_e[ent0 & 0xffff]; }
    if (ui + stp < tot) ent1 = p.plist[xq * 320 + ((ui + stp) >> 3)];
    for (; ui < tot; ui += stp) {
        const int nt = ui & 7;
        const int ent = ent0, e = e0;
        const int tile0 = ent & 0xffff, single = (ent >> 30) & 1, tile1 = single ? tile0 : tile0 + 1;
        if (ui + stp < tot) { ent0 = ent1; e0 = p.tile_e[ent0 & 0xffff]; }
        if (ui + 2 * stp < tot) ent1 = p.plist[xq * 320 + ((ui + 2 * stp) >> 3)];
        const float* Wd = (e < NEXP) ? p.w_down + ((size_t)layer * NEXP + e) * (256 * DM) : p.ws_down + (size_t)layer * (256 * DM);
        Dma3A al; al.base = (const char*)p.H;
#pragma unroll
        for (int i = 0; i < 4; ++i) al.voff[i] = (unsigned)(((size_t)((Rr[i] < 128 ? tile0 : tile1) * 128 + (Rr[i] & 127)) * 256 + Cc[i]) * 2);
        Reg3B bl; { const int nq = tid & 31, kg = tid >> 5; bl.ldb = DM; bl.perm64 = 1; bl.bp = Wd + (size_t)(kg * 4) * DM + nt * 128 + nq * 4; }
        f32x4 acc[32];
        gemm_core4(al, bl, 256 / 32, acc, single != 0);
        if (!(wr && single)) {
            const int tile = wr ? tile1 : tile0;
#pragma unroll
            for (int i = 0; i < 8; ++i)
                {
                    const int row = tile * 128 + i * 16 + fr, col = nt * 128 + wc * 64 + fq * 16;
                    u32x4 wv;
#pragma unroll
                    for (int j = 0; j < 4; ++j) {
                        f32x4 a = acc[i * 4 + j] * 64.0f;
#pragma unroll
                        for (int c = 0; c < 4; ++c) a[c] = fminf(fmaxf(a[c], -448.0f), 448.0f);
                        int w0 = 0;
                        w0 = __builtin_amdgcn_cvt_pk_fp8_f32(a[0], a[1], w0, false); w0 = __builtin_amdgcn_cvt_pk_fp8_f32(a[2], a[3], w0, true);
                        wv[j] = (unsigned)w0;
                    }
                    *(u32x4*)((char*)p.Y + (size_t)row * DM + col) = wv;
                }
        }
    }
}
__device__ __forceinline__ void phase_combine_ln(int bid, int nb, const P& p, const float* X, const float* g, const float* b, float* of, bf16_t* ob, bf16_t* ol) {
    const int lane = tidx() & 63, wid = tidx() >> 6;
    int row = bid * 4 + wid;
    int npos = 0; float nw = 0.f;
    if (row < NTOK && lane < 8) { npos = p.epos[row * 8 + lane]; nw = p.ew[row * 8 + lane]; }
    for (; row < NTOK; row += nb * 4) {
        const int cpos = npos; const float cw = nw;
        { const int nr = row + nb * 4; if (nr < NTOK && lane < 8) { npos = p.epos[nr * 8 + lane]; nw = p.ew[nr * 8 + lane]; } }
        float v[16];
#pragma unroll
        for (int h = 0; h < 2; ++h) {
            const size_t o = (size_t)row * DM + h * 512 + lane * 8;
            const u32x4 xh = *(const u32x4*)(p.XAb + o);
            v[h * 8 + 0] = DN_ALPHA * bf2f(xh.x & 0xffffu); v[h * 8 + 1] = DN_ALPHA * bf2f(xh.x >> 16);
            v[h * 8 + 2] = DN_ALPHA * bf2f(xh.y & 0xffffu); v[h * 8 + 3] = DN_ALPHA * bf2f(xh.y >> 16);
            v[h * 8 + 4] = DN_ALPHA * bf2f(xh.z & 0xffffu); v[h * 8 + 5] = DN_ALPHA * bf2f(xh.z >> 16);
            v[h * 8 + 6] = DN_ALPHA * bf2f(xh.w & 0xffffu); v[h * 8 + 7] = DN_ALPHA * bf2f(xh.w >> 16);
        }
#pragma unroll
        for (int k = 0; k < 9; ++k) {
            const int yr = (k < 8) ? __shfl(cpos, k) : (SH_TILE0 * 128 + row);
            const float w = (k < 8) ? __shfl(cw, k) : 1.0f;
#pragma unroll
            for (int h = 0; h < 2; ++h) {
                const u32x2 y = *(const u32x2*)((const char*)p.Y + (size_t)yr * DM + h * 512 + lane * 8);
                typedef float f32x2v __attribute__((ext_vector_type(2)));
                const f32x2v y0 = __builtin_amdgcn_cvt_pk_f32_fp8((int)y.x, false), y1 = __builtin_amdgcn_cvt_pk_f32_fp8((int)y.x, true);
                const f32x2v y2 = __builtin_amdgcn_cvt_pk_f32_fp8((int)y.y, false), y3 = __builtin_amdgcn_cvt_pk_f32_fp8((int)y.y, true);
                const float ws = w * (1.0f / 64.0f);
                v[h * 8 + 0] += ws * y0.x; v[h * 8 + 1] += ws * y0.y; v[h * 8 + 2] += ws * y1.x; v[h * 8 + 3] += ws * y1.y;
                v[h * 8 + 4] += ws * y2.x; v[h * 8 + 5] += ws * y2.y; v[h * 8 + 6] += ws * y3.x; v[h * 8 + 7] += ws * y3.y;
            }
        }
        ln_row_store(v, g, b, of, ob, row, lane, ol);
    }
}

__device__ __forceinline__ void phase_moba_kmean(int bid, int nb, const P& p) {
    const int tid = tidx();
    for (int u = (nb >= 256 ? bid - 128 : bid); u < NBATCH * 8; u += nb) {
        if (u < 0) continue;
        const int b = u >> 3, j = u & 7;
        const bf16_t* src = p.MK + (size_t)(b * SEQ + j * 256) * 512 + tid * 2;
        float s0 = 0.f, s1 = 0.f;
        for (int r8 = 0; r8 < 256; r8 += 8) {
            unsigned v[8];
#pragma unroll
            for (int i = 0; i < 8; ++i) v[i] = *(const unsigned*)(src + (size_t)(r8 + i) * 512);
#pragma unroll
            for (int i = 0; i < 8; ++i) { s0 += bf2f(v[i] & 0xffffu); s1 += bf2f(v[i] >> 16); }
        }
        const int h = tid >> 5, d = (tid & 31) * 2;
        p.KM[((size_t)(b * 8 + h) * 8 + j) * 64 + d] = s0 * (1.0f / 256.0f);
        p.KM[((size_t)(b * 8 + h) * 8 + j) * 64 + d + 1] = s1 * (1.0f / 256.0f);
    }
}
__device__ __forceinline__ void gemm_t_unit(const bf16_t* Wt, int wrow0, const bf16_t* X, int tok0, bf16_t* dst, int ncol, int col0) {
    const int tid = tidx(), lane = tid & 63, wid = tid >> 6, wr = wid >> 1, wc = wid & 1, fr = lane & 15, fq = lane >> 4;
    Dma3A al; al.set_dense(Wt, wrow0, DM); Dma3B bl; bl.set(X, X, tok0, DM, 1 << 30);
    f32x4 acc[32];
    gemm_core4(al, bl, DM / 32, acc);
#pragma unroll
    for (int i = 0; i < 8; ++i)
#pragma unroll
        for (int gg = 0; gg < 2; ++gg) {
            const int vc = col0 + wr * 128 + i * 16 + fr, r0 = tok0 + wc * 64 + gg * 32 + fq * 8;
            const int b = r0 >> 11, t0 = r0 & (SEQ - 1);
            const f32x4 a = acc[i * 4 + 2 * gg], b2 = acc[i * 4 + 2 * gg + 1];
            u32x4 w; w.x = pack2(a[0], a[1]); w.y = pack2(a[2], a[3]); w.z = pack2(b2[0], b2[1]); w.w = pack2(b2[2], b2[3]);
            *(u32x4*)(dst + ((size_t)(b * ncol + vc)) * SEQ + t0) = w;
        }
}
__device__ __forceinline__ void phase_inproj0(char* lds, int bid, int nb, const P& p) {
    const int ntn = 20, nk = DM / 32;
    const int tid = tidx(), lane = tid & 63, wid = tid >> 6, wr = wid >> 1, wc = wid & 1, fr = lane & 15, fq = lane >> 4;
    for (int i = bid * 256 + tid; i < 2 * 8 * 64 * 64; i += nb * 256) {
        const int which = i >> 15, e = i & 32767, h = e >> 12, j = (e >> 6) & 63, ii = e & 63;
        const float v = (which ? p.wx : p.wa)[(h * 64 + ii) * 64 + j];
        (which ? p.WXT : p.WAT)[e] = (bf16_t)f2bf(v);
    }
    for (int jj = 0;; ++jj) {
        int tm, tn; if (!dense_unit3(bid, nb, jj, ntn, tm, tn)) break;
        Dma3A al; al.set_dense(p.XIb, tm * 256, DM); Dma3B bl; bl.set(p.WIN0, p.WIN0, tn * 128, DM, 1 << 30);
        f32x4 acc[32];
        gemm_core4(al, bl, nk, acc);
#pragma unroll
        for (int i = 0; i < 8; ++i)
#pragma unroll
            for (int gg = 0; gg < 2; ++gg) {
                const int row = tm * 256 + wr * 128 + i * 16 + fr, col = tn * 128 + wc * 64 + gg * 32 + fq * 8;
                const f32x4 a = acc[i * 4 + 2 * gg], b2 = acc[i * 4 + 2 * gg + 1];
                u32x4 w; w.x = pack2(a[0], a[1]); w.y = pack2(a[2], a[3]); w.z = pack2(b2[0], b2[1]); w.w = pack2(b2[2], b2[3]);
                *(u32x4*)(p.UB0 + (size_t)row * 2560 + col) = w;
            }
    }
    for (int u = (nb >= 512 ? bid - 256 : bid); u < 2 * 128; u += nb) { if (u < 0) continue; const int pn = u & 1, tt = u >> 1; gemm_t_unit(p.WIN0, 2560 + pn * 256, p.XIb, tt * 128, p.VHt, 512, pn * 256); }
}

__device__ __forceinline__ int lds_off128(int r, int c) {
    const int st = (r >> 4) * 4 + (c >> 5), ob = (r & 15) * 64 + (c & 31) * 2;
    return st * 1024 + (ob ^ (((ob >> 9) & 1) << 5));
}
__device__ __forceinline__ float softplusf_(float x) { return fmaxf(x, 0.f) + log1pf(__expf(-fabsf(x))); }

#define LRU1_LDS (4 * 8192)
__device__ __forceinline__ void lru1_unit(char* lds, const P& p, int b, int ck, int half) {
    const int tid = tidx(), lane = tid & 63, w = tid >> 6, fr = lane & 15, fg = lane >> 4;
    char* xt = lds + w * 8192;
    const size_t n0 = (size_t)b * SEQ + ck * 64;
    __syncthreads();
    {
        const int h = half * 4 + w, c = h * 64 + lane;
        const float cw0 = p.conv_w[c], cw1 = p.conv_w[512 + c], cw2 = p.conv_w[1024 + c], cw3 = p.conv_w[1536 + c], cb = p.conv_b[c];
        float xm3 = 0.f, xm2 = 0.f, xm1 = 0.f;
        if (ck > 0) { xm3 = bf2f(p.UB0[(n0 - 3) * 2560 + c]); xm2 = bf2f(p.UB0[(n0 - 2) * 2560 + c]); xm1 = bf2f(p.UB0[(n0 - 1) * 2560 + c]); }
        __builtin_amdgcn_wave_barrier();
        for (int t16 = 0; t16 < 64; t16 += 16) {
            bf16_t raw[16];
#pragma unroll
            for (int i = 0; i < 16; ++i) raw[i] = p.UB0[(n0 + t16 + i) * 2560 + c];
#pragma unroll
            for (int i = 0; i < 16; ++i) {
                const float x = bf2f(raw[i]);
                const float xc = cb + cw0 * xm3 + cw1 * xm2 + cw2 * xm1 + cw3 * x;
                xm3 = xm2; xm2 = xm1; xm1 = x;
                *(bf16_t*)(xt + lds_off(t16 + i, lane & ~7) + (lane & 7) * 2) = (bf16_t)f2bf(xc);
            }
        }
        __builtin_amdgcn_wave_barrier();
        for (int jt = 0; jt < 4; ++jt) {
            const int cj = h * 64 + jt * 16 + fr;
            bf16x8 wra[2], wri[2];
#pragma unroll
            for (int ks = 0; ks < 2; ++ks) {
                wra[ks] = *(const bf16x8*)(p.WAT + (size_t)(h * 64 + jt * 16 + fr) * 64 + ks * 32 + fg * 8);
                wri[ks] = *(const bf16x8*)(p.WXT + (size_t)(h * 64 + jt * 16 + fr) * 64 + ks * 32 + fg * 8);
            }
            const float bav = p.ba[cj], bxv = p.bx[cj], sp = softplusf_(-p.lam[cj]);
            float mA = 1.f, mB = 0.f;
#pragma unroll
            for (int tt = 0; tt < 4; ++tt) {
                const bf16x8 a0 = *(const bf16x8*)(xt + lds_off(tt * 16 + fr, fg * 8)), a1 = *(const bf16x8*)(xt + lds_off(tt * 16 + fr, 32 + fg * 8));
                f32x4 ar = __builtin_amdgcn_mfma_f32_16x16x32_bf16(a0, wra[0], (f32x4){0.f, 0.f, 0.f, 0.f}, 0, 0, 0);
                ar = __builtin_amdgcn_mfma_f32_16x16x32_bf16(a1, wra[1], ar, 0, 0, 0);
                f32x4 ai = __builtin_amdgcn_mfma_f32_16x16x32_bf16(a0, wri[0], (f32x4){0.f, 0.f, 0.f, 0.f}, 0, 0, 0);
                ai = __builtin_amdgcn_mfma_f32_16x16x32_bf16(a1, wri[1], ai, 0, 0, 0);
                float sA = 1.f, sB = 0.f;
#pragma unroll
                for (int r = 0; r < 4; ++r) {
                    const int t = tt * 16 + fg * 4 + r;
                    const float rg = sigmoidf_(ar[r] + bav), ig = sigmoidf_(ai[r] + bxv);
                    const float log_a = -8.0f * rg * sp;
                    const float a = __expf(log_a);
                    const float mult = (ck == 0 && t == 0) ? 1.0f : sqrtf(fmaxf(1.0f - a * a, 0.f));
                    const int jj = jt * 16 + fr;
                    const float xcv = bf2f(*(const bf16_t*)(xt + lds_off(t, jj & ~7) + (jj & 7) * 2));
                    const float bt = mult * ig * xcv;
                    p.LA[(n0 + t) * 512 + cj] = a; p.LB[(n0 + t) * 512 + cj] = bt;
                    sB = a * sB + bt; sA = a * sA;
                }
                float tA = 1.f, tB = 0.f;
#pragma unroll
                for (int g2 = 0; g2 < 4; ++g2) {
                    const float oA = __shfl(sA, g2 * 16 + fr), oB = __shfl(sB, g2 * 16 + fr);
                    tB = oA * tB + oB; tA = oA * tA;
                }
                mB = tA * mB + tB; mA = tA * mA;
            }
            if (fg == 0) { p.CSA[((size_t)b * 32 + ck) * 512 + cj] = mA; p.CSB[((size_t)b * 32 + ck) * 512 + cj] = mB; }
        }
        __builtin_amdgcn_wave_barrier();
    }
}
__device__ __forceinline__ void lru2_unit(const P& p, int b, int ck, int half) {
    const int tid = tidx();
    const size_t n0 = (size_t)b * SEQ + ck * 64;
    {
        const int c = tid + 256 * half;
        float h = 0.f;
        for (int c8 = 0; c8 < ck; c8 += 8) {
            float ca[8], cb[8];
#pragma unroll
            for (int i = 0; i < 8; ++i) { const bool ok = c8 + i < ck; ca[i] = ok ? p.CSA[((size_t)b * 32 + c8 + i) * 512 + c] : 1.f; cb[i] = ok ? p.CSB[((size_t)b * 32 + c8 + i) * 512 + c] : 0.f; }
#pragma unroll
            for (int i = 0; i < 8; ++i) h = ca[i] * h + cb[i];
        }
        for (int t8 = 0; t8 < 64; t8 += 8) {
            float la[8], lb[8], gb[8];
#pragma unroll
            for (int i = 0; i < 8; ++i) { la[i] = p.LA[(n0 + t8 + i) * 512 + c]; lb[i] = p.LB[(n0 + t8 + i) * 512 + c]; gb[i] = bf2f(p.UB0[(n0 + t8 + i) * 2560 + 512 + c]); }
#pragma unroll
            for (int i = 0; i < 8; ++i) { h = la[i] * h + lb[i]; p.MIX[(n0 + t8 + i) * DM + c] = (bf16_t)f2bf(h * gelu_tanh(gb[i])); }
        }
    }
}

#define HG1_LDS (2 * 16384)
__device__ __forceinline__ float hg_lb(const P& p, int ch) {
    const float l0 = p.hg_lb[ch], l1 = p.hg_lb[512 + ch], l2 = p.hg_lb[1024 + ch]; const float mx = fmaxf(l0, fmaxf(l1, l2));
    const float e0 = __expf(l0 - mx), e1 = __expf(l1 - mx), e2 = __expf(l2 - mx); return e0 / (e0 + e1 + e2);
}
__device__ __forceinline__ void hg1_unit(char* lds, const P& p, int b, int h, int ck) {
    const int tid = tidx(), lane = tid & 63, w = tid >> 6, fr = lane & 15, fg = lane >> 4;
    char* kh = lds;
    char* vt = lds + 16384;
    const size_t n0 = (size_t)b * SEQ + ck * 64;
    const int bhc = (b * 4 + h) * 32 + ck;
    __syncthreads();
    if (tid < 128) {
        const int k = tid, ch = h * 128 + k;
        const float lbv = hg_lb(p, ch);
        float f[64];
#pragma unroll
        for (int t16 = 0; t16 < 64; t16 += 16) {
            bf16_t raw[16];
#pragma unroll
            for (int i = 0; i < 16; ++i) raw[i] = p.UB0[(n0 + t16 + i) * 2560 + 1536 + ch];
#pragma unroll
            for (int i = 0; i < 16; ++i) f[t16 + i] = lbv + (1.0f - lbv) * sigmoidf_(bf2f(raw[i]));
        }
        float suf = 1.0f;
#pragma unroll
        for (int t8 = 56; t8 >= 0; t8 -= 8) {
            float kv[8];
#pragma unroll
            for (int i = 7; i >= 0; --i) { kv[i] = (1.0f - f[t8 + i]) * suf; suf *= f[t8 + i]; }
            u32x4 wv; wv.x = pack2(kv[0], kv[1]); wv.y = pack2(kv[2], kv[3]); wv.z = pack2(kv[4], kv[5]); wv.w = pack2(kv[6], kv[7]);
            *(u32x4*)(kh + lds_off(k, t8)) = wv;
        }
        p.DV[(size_t)bhc * 128 + k] = suf;
    } else {
        const int q = tid - 128;
#pragma unroll
        for (int i = 0; i < 8; ++i) { const int pc = q + 128 * i, v = pc >> 3, c8 = pc & 7;
            *(u32x4*)(vt + lds_off(v, c8 * 8)) = *(const u32x4*)(p.VHt + ((size_t)(b * 512 + h * 128 + v)) * SEQ + ck * 64 + c8 * 8); }
    }
    __syncthreads();
    bf16_t* ut = p.UT + (size_t)bhc * 16384;
#pragma unroll
    for (int kk = 0; kk < 2; ++kk) {
        const int kt = w * 2 + kk;
        const bf16x8 a0 = *(const bf16x8*)(kh + lds_off(kt * 16 + fr, fg * 8)), a1 = *(const bf16x8*)(kh + lds_off(kt * 16 + fr, 32 + fg * 8));
#pragma unroll
        for (int v8 = 0; v8 < 8; ++v8) {
            const bf16x8 b0 = *(const bf16x8*)(vt + lds_off(v8 * 16 + fr, fg * 8)), b1 = *(const bf16x8*)(vt + lds_off(v8 * 16 + fr, 32 + fg * 8));
            f32x4 acc = __builtin_amdgcn_mfma_f32_16x16x32_bf16(a0, b0, (f32x4){0.f, 0.f, 0.f, 0.f}, 0, 0, 0);
            acc = __builtin_amdgcn_mfma_f32_16x16x32_bf16(a1, b1, acc, 0, 0, 0);
            u32x2 wv; wv.x = pack2(acc[0], acc[1]); wv.y = pack2(acc[2], acc[3]);
            *(u32x2*)(ut + (size_t)(v8 * 16 + fr) * 128 + kt * 16 + fg * 4) = wv;
        }
    }
}
__device__ __forceinline__ void phase_hg2(int bid, int nb, const P& p) {
    for (int it = bid * 256 + tidx(); it < 32 * 4096; it += nb * 256) {
        const int bh = it >> 12, e4 = (it & 4095) * 4, k4 = e4 & 127;
        float S0 = 0.f, S1 = 0.f, S2 = 0.f, S3 = 0.f;
        for (int c8 = 0; c8 < 32; c8 += 8) {
            u32x2 uv[8]; f32x4 dv[8];
#pragma unroll
            for (int i = 0; i < 8; ++i) { uv[i] = *(const u32x2*)(p.UT + ((size_t)(bh * 32 + c8 + i)) * 16384 + e4); dv[i] = *(const f32x4*)(p.DV + (size_t)(bh * 32 + c8 + i) * 128 + k4); }
#pragma unroll
            for (int i = 0; i < 8; ++i) {
                u32x2 wv; wv.x = pack2(S0, S1); wv.y = pack2(S2, S3);
                *(u32x2*)(p.SP + ((size_t)(bh * 32 + c8 + i)) * 16384 + e4) = wv;
                S0 = dv[i][0] * S0 + bf2f(uv[i].x & 0xffffu); S1 = dv[i][1] * S1 + bf2f(uv[i].x >> 16);
                S2 = dv[i][2] * S2 + bf2f(uv[i].y & 0xffffu); S3 = dv[i][3] * S3 + bf2f(uv[i].y >> 16);
            }
        }
    }
}
#define HG3_QP 0
#define HG3_KP 40960
#define HG3_VT (40960 + 16384)
#define HG3_LDS (40960 + 16384 + 128 * 144)
__device__ __forceinline__ int hg3_qp_base(int j) { return j == 0 ? 0 : (j == 1 ? 16384 : (j == 2 ? 28672 : 36864)); }
__device__ __forceinline__ void hg3_unit(char* lds, const P& p, int b, int h, int ck) {
    const int tid = tidx(), lane = tid & 63, w = tid >> 6, fr = lane & 15, fg = lane >> 4;
    char* qp = lds + HG3_QP; char* kp = lds + HG3_KP; char* vt = lds + HG3_VT;
    const size_t n0 = (size_t)b * SEQ + ck * 64;
    const int bhc = (b * 4 + h) * 32 + ck;
    __syncthreads();
    if (tid < 128) {
        const int k = tid, ch = h * 128 + k;
        const float lbv = hg_lb(p, ch);
        const int ke = (k & 7) * 2, k8 = k & ~7;
        float d0 = 1.f, d1 = 1.f, d2 = 1.f, d3 = 1.f;
#pragma unroll
        for (int i = 0; i < 4; ++i) {
            bf16_t rq[16], rf[16];
#pragma unroll
            for (int tt = 0; tt < 16; ++tt) { rq[tt] = p.UB0[(n0 + i * 16 + tt) * 2560 + 1024 + ch]; rf[tt] = p.UB0[(n0 + i * 16 + tt) * 2560 + 1536 + ch]; }
#pragma unroll
            for (int tt = 0; tt < 16; ++tt) {
                const int t = i * 16 + tt;
                const float qv = siluf_(bf2f(rq[tt]));
                const float f = lbv + (1.0f - lbv) * sigmoidf_(bf2f(rf[tt]));
                d0 *= f; if (i >= 1) d1 *= f; if (i >= 2) d2 *= f; if (i >= 3) d3 *= f;
                const float di = (i == 0) ? d0 : (i == 1 ? d1 : (i == 2 ? d2 : d3));
                *(bf16_t*)(kp + lds_off128(t, k8) + ke) = (bf16_t)f2bf((1.0f - f) * __builtin_amdgcn_rcpf(fmaxf(di, 1.8e-35f)));
                *(bf16_t*)(qp + hg3_qp_base(0) + lds_off128(t, k8) + ke) = (bf16_t)f2bf(qv * d0);
                if (i >= 1) *(bf16_t*)(qp + hg3_qp_base(1) + lds_off128(t - 16, k8) + ke) = (bf16_t)f2bf(qv * d1);
                if (i >= 2) *(bf16_t*)(qp + hg3_qp_base(2) + lds_off128(t - 32, k8) + ke) = (bf16_t)f2bf(qv * d2);
                if (i >= 3) *(bf16_t*)(qp + hg3_qp_base(3) + lds_off128(t - 48, k8) + ke) = (bf16_t)f2bf(qv * d3);
            }
        }
    } else {
        const int q = tid - 128;
#pragma unroll
        for (int i = 0; i < 8; ++i) { const int pc = q + 128 * i, v = pc >> 3, c8 = pc & 7;
            *(u32x4*)(vt + v * 144 + c8 * 16) = *(const u32x4*)(p.VHt + ((size_t)(b * 512 + h * 128 + v)) * SEQ + ck * 64 + c8 * 8); }
    }
    __syncthreads();
    f32x4 acc[8];
#pragma unroll
    for (int v8 = 0; v8 < 8; ++v8) acc[v8] = (f32x4){0.f, 0.f, 0.f, 0.f};
    if (ck > 0) {
        const bf16_t* sp = p.SP + (size_t)bhc * 16384;
#pragma unroll
        for (int ks = 0; ks < 4; ++ks) {
            const bf16x8 bq = *(const bf16x8*)(qp + hg3_qp_base(0) + lds_off128(w * 16 + fr, ks * 32 + fg * 8));
#pragma unroll
            for (int v8 = 0; v8 < 8; ++v8) {
                const bf16x8 as = *(const bf16x8*)(sp + (size_t)(v8 * 16 + fr) * 128 + ks * 32 + fg * 8);
                acc[v8] = __builtin_amdgcn_mfma_f32_16x16x32_bf16(as, bq, acc[v8], 0, 0, 0);
            }
        }
    }
#pragma unroll
    for (int jp = 0; jp < 2; ++jp) {
        if (2 * jp > w) continue;
        f32x4 at[2];
#pragma unroll
        for (int jj = 0; jj < 2; ++jj) {
            const int j = 2 * jp + jj;
            at[jj] = (f32x4){0.f, 0.f, 0.f, 0.f};
            if (j <= w) {
#pragma unroll
                for (int ks = 0; ks < 4; ++ks) {
                    const bf16x8 ak = *(const bf16x8*)(kp + lds_off128(j * 16 + fr, ks * 32 + fg * 8));
                    const bf16x8 bq = *(const bf16x8*)(qp + hg3_qp_base(j) + lds_off128((w - j) * 16 + fr, ks * 32 + fg * 8));
                    at[jj] = __builtin_amdgcn_mfma_f32_16x16x32_bf16(ak, bq, at[jj], 0, 0, 0);
                }
                if (j == w) {
#pragma unroll
                    for (int r = 0; r < 4; ++r) at[jj][r] = (fg * 4 + r <= fr) ? at[jj][r] : 0.f;
                }
            }
        }
        u32x4 pw; pw.x = pack2(at[0][0], at[0][1]); pw.y = pack2(at[0][2], at[0][3]); pw.z = pack2(at[1][0], at[1][1]); pw.w = pack2(at[1][2], at[1][3]);
        const bf16x8 pf = __builtin_bit_cast(bf16x8, pw);
#pragma unroll
        for (int v8 = 0; v8 < 8; ++v8) {
            const char* vb = vt + (v8 * 16 + fr) * 144 + (jp * 32 + fg * 4) * 2;
            const u32x2 v0 = *(const u32x2*)vb, v1 = *(const u32x2*)(vb + 32);
            u32x4 vv; vv.x = v0.x; vv.y = v0.y; vv.z = v1.x; vv.w = v1.y;
            acc[v8] = __builtin_amdgcn_mfma_f32_16x16x32_bf16(__builtin_bit_cast(bf16x8, vv), pf, acc[v8], 0, 0, 0);
        }
    }
    float ss = 0.f;
#pragma unroll
    for (int v8 = 0; v8 < 8; ++v8)
#pragma unroll
        for (int r = 0; r < 4; ++r) ss += acc[v8][r] * acc[v8][r];
    ss += __shfl_xor(ss, 16); ss += __shfl_xor(ss, 32);
    const float rs = rsqrtf(ss * (1.0f / 128.0f) + 1e-6f);
    const size_t n = n0 + w * 16 + fr;
#pragma unroll
    for (int v8 = 0; v8 < 8; ++v8) {
        const int vcol = h * 128 + v8 * 16 + fg * 4;
        const u32x2 gv = *(const u32x2*)(p.UB0 + n * 2560 + 2048 + vcol);
        const f32x4 ng = *(const f32x4*)(p.hg_ng + vcol);
        const float y0 = acc[v8][0] * rs * ng[0] * sigmoidf_(bf2f(gv.x & 0xffffu)), y1 = acc[v8][1] * rs * ng[1] * sigmoidf_(bf2f(gv.x >> 16));
        const float y2 = acc[v8][2] * rs * ng[2] * sigmoidf_(bf2f(gv.y & 0xffffu)), y3 = acc[v8][3] * rs * ng[3] * sigmoidf_(bf2f(gv.y >> 16));
        u32x2 wv; wv.x = pack2(y0, y1); wv.y = pack2(y2, y3);
        *(u32x2*)(p.MIX + n * DM + 512 + vcol) = wv;
    }
}
__device__ __forceinline__ void phase_mix0_a(char* lds, int bid, int nb, const P& p) {
    for (int u = bid; u < 512 + 1024; u += nb) {
        if (u < 512) lru1_unit(lds, p, u >> 6, (u >> 1) & 31, u & 1);
        else { const int v = u - 512; hg1_unit(lds, p, v >> 7, (v >> 5) & 3, v & 31); }
    }
    __syncthreads();
}
__device__ __forceinline__ void phase_mix0_c(char* lds, int bid, int nb, const P& p) {
    for (int u = bid; u < 1024; u += nb) hg3_unit(lds, p, u >> 7, (u >> 5) & 3, u & 31);
    __syncthreads();
}

#ifndef KEEP_U
#define KEEP_U 0
#endif
__device__ __forceinline__ int vcol_actual(int v) { return v < 1280 ? v : (v < 2816 ? v + 24 : v - 1536); }
__device__ __forceinline__ void phase_inproj1(char* lds, int bid, int nb, const P& p) {
    const int ntn = 17, nk = DM / 32;
    const int tid = tidx(), lane = tid & 63, wid = tid >> 6, wr = wid >> 1, wc = wid & 1, fr = lane & 15, fq = lane >> 4;
    for (int jj = 0;; ++jj) {
        int tm, tn; if (!dense_unit3(bid, nb, jj, ntn, tm, tn)) break;
        Dma3A al; al.set_dense(p.XBb, tm * 256, DM); Dma3B bl; bl.set(p.WIN1, p.WIN1, tn * 128, DM, 1 << 30);
        f32x4 acc[32];
        gemm_core4(al, bl, nk, acc);
#pragma unroll
        for (int i = 0; i < 8; ++i)
#pragma unroll
            for (int gg = 0; gg < 2; ++gg) {
                const int row = tm * 256 + wr * 128 + i * 16 + fr, vc = tn * 128 + wc * 64 + gg * 32 + fq * 8;
                const f32x4 a = acc[i * 4 + 2 * gg], b2 = acc[i * 4 + 2 * gg + 1];
                u32x4 w; w.x = pack2(a[0], a[1]); w.y = pack2(a[2], a[3]); w.z = pack2(b2[0], b2[1]); w.w = pack2(b2[2], b2[3]);
                if (tn < 4) *(u32x4*)(p.Qb + (size_t)row * 512 + vc) = w;
                else if (tn < 6) { *(f32x4*)(p.KCV + (size_t)row * 256 + vc - 512) = a; *(f32x4*)(p.KCV + (size_t)row * 256 + vc - 512 + 4) = b2; }
                else if (tn == 6) *(u32x4*)(p.KS + (size_t)row * 128 + vc - 768) = w;
                else if (tn == 7) *(u32x4*)(p.KW + (size_t)row * 128 + vc - 896) = w;
                else if (tn < 12) *(u32x4*)(p.MQ + (size_t)row * 512 + vc - 1024) = w;
                else if (tn < 16) *(u32x4*)(p.MK + (size_t)row * 512 + vc - 1536) = w;
                else if (vc < 2072) { *(f32x4*)(p.GATES + (size_t)row * 24 + vc - 2048) = a; *(f32x4*)(p.GATES + (size_t)row * 24 + vc - 2048 + 4) = b2; }
            }
    }
    for (int u = (nb >= 512 ? bid - 64 : bid); u < 3 * 128; u += nb) {
        if (u < 0) continue;
        const int pn = u % 3, tt = u / 3;
        if (pn == 0) {
            const int wrr = tidx() >> 7;
            gemm_t_unit(p.WIN1, 2176, p.XBb, tt * 128, wrr ? p.VWt - (size_t)128 * SEQ : p.VSt, 128, 0);
        } else gemm_t_unit(p.WIN1, 2432 + (pn - 1) * 256, p.XBb, tt * 128, p.MVt, 512, (pn - 1) * 256);
    }
}
__device__ __forceinline__ void phase_moba_gate(char* lds, int bid, int nb, const P& p) {
    const int lane = tidx() & 63, wid = tidx() >> 6;
    float* km = (float*)lds + 4096 + wid * 512;
    for (int it = bid * 4 + wid; it < 64 * 32; it += nb * 4) {
        const int bh = it >> 5, tb = it & 31, b = bh >> 3, h = bh & 7;
        const int t = tb * 64 + lane, ob = t >> 8;
        __builtin_amdgcn_wave_barrier();
#pragma unroll
        for (int i = 0; i < 8; ++i) km[i * 64 + lane] = p.KM[(size_t)bh * 512 + i * 64 + lane];
        __builtin_amdgcn_wave_barrier();
        u32x4 qr[8];
#pragma unroll
        for (int i = 0; i < 8; ++i) qr[i] = *(const u32x4*)(p.MQ + (size_t)(b * SEQ + t) * 512 + h * 64 + i * 8);
        float gate[8];
#pragma unroll
        for (int j = 0; j < 8; ++j) gate[j] = 0.f;
#pragma unroll
        for (int i = 0; i < 8; ++i) {
            float q[8];
            q[0] = bf2f(qr[i].x & 0xffffu); q[1] = bf2f(qr[i].x >> 16); q[2] = bf2f(qr[i].y & 0xffffu); q[3] = bf2f(qr[i].y >> 16);
            q[4] = bf2f(qr[i].z & 0xffffu); q[5] = bf2f(qr[i].z >> 16); q[6] = bf2f(qr[i].w & 0xffffu); q[7] = bf2f(qr[i].w >> 16);
#pragma unroll
            for (int j = 0; j < 8; ++j)
#pragma unroll
                for (int e = 0; e < 8; ++e) gate[j] += q[e] * km[j * 64 + i * 8 + e];
        }
#pragma unroll
        for (int j = 0; j < 8; ++j) gate[j] = (j < ob) ? gate[j] : NEGF;
        unsigned selm = 0;
#pragma unroll
        for (int j = 0; j < 8; ++j) {
            int rank = 0;
#pragma unroll
            for (int j2 = 0; j2 < 8; ++j2) rank += (gate[j2] > gate[j] || (gate[j2] == gate[j] && j2 < j)) ? 1 : 0;
            if (j < ob && rank < 3) selm |= 1u << j;
        }
        p.MSEL[(size_t)bh * SEQ + t] = selm;
    }
}

#define ATT_K_BYTES 8192
#define ATT_STAGE 16384
#define ATT_TILE_BYTES (3 * ATT_STAGE)
#define ATT_ORDER_OFF ATT_TILE_BYTES
#define ATT_RED_OFF (ATT_ORDER_OFF + 8192)
__device__ __forceinline__ void att_issue_tile(int stage, const bf16_t* Kg, int ldk, const bf16_t* Vg) {
    const int lane = tidx() & 63, w = tidx() >> 6;
#pragma unroll
    for (int i = 0; i < 2; ++i) { int R, C; dma_rc(lane, w + 4 * i, R, C);
        __builtin_amdgcn_global_load_lds((const unsigned*)(Kg + (size_t)R * ldk + C), (LAS unsigned*)((LAS char*)dyn_lds + stage * ATT_STAGE + (w + 4 * i) * 1024), 16, 0, 0);
        __builtin_amdgcn_global_load_lds((const unsigned*)(Vg + (size_t)R * SEQ + C), (LAS unsigned*)((LAS char*)dyn_lds + stage * ATT_STAGE + ATT_K_BYTES + (w + 4 * i) * 1024), 16, 0, 0); }
}
#define ATT_WAIT_BAR(n) do { asm volatile("s_waitcnt vmcnt(" #n ") lgkmcnt(0)" ::: "memory"); __builtin_amdgcn_s_barrier(); asm volatile("" ::: "memory"); } while (0)
struct AttState { f32x4 O[4][2]; float m[2], l[2]; };
__device__ __forceinline__ void att_reset(AttState& S) {
#pragma unroll
    for (int q = 0; q < 2; ++q) { S.m[q] = NEGF; S.l[q] = 0.f;
#pragma unroll
        for (int d = 0; d < 4; ++d) S.O[d][q] = (f32x4){0.f, 0.f, 0.f, 0.f}; }
}
template <bool MASKED>
__device__ __forceinline__ void att_step(const char* lds, const bf16x8 (&qf)[2][2], AttState& S, const f32x4 (&bini)[4], float slope2,
                                         int s0, int tq0, unsigned selbits  , int winlimit) {
    const int lane = tidx() & 63, fr = lane & 15, fg = lane >> 4;
    const char* ldsV = lds + ATT_K_BYTES;
    const float offbase = slope2 * (float)s0;
    f32x4 s[2][4];
#pragma unroll
    for (int kt = 0; kt < 4; ++kt) {
        const bf16x8 k0 = *(const bf16x8*)(lds + lds_off(kt * 16 + fr, fg * 8)), k1 = *(const bf16x8*)(lds + lds_off(kt * 16 + fr, 32 + fg * 8));
#pragma unroll
        for (int qt = 0; qt < 2; ++qt) {
            s[qt][kt] = __builtin_amdgcn_mfma_f32_16x16x32_bf16(k0, qf[qt][0], bini[kt], 0, 0, 0);
            s[qt][kt] = __builtin_amdgcn_mfma_f32_16x16x32_bf16(k1, qf[qt][1], s[qt][kt], 0, 0, 0);
        }
    }
    __builtin_amdgcn_sched_barrier(0);
    u32x4 pf[2][2];
#pragma unroll
    for (int qt = 0; qt < 2; ++qt) {
        const int tq = tq0 + qt * 16 + fr;
        const float off = ((selbits >> qt) & 1u) ? (offbase - slope2 * (float)tq) : -INFINITY;
        float mx = -INFINITY;
#pragma unroll
        for (int kt = 0; kt < 4; ++kt)
#pragma unroll
            for (int r = 0; r < 4; ++r) {
                float y = s[qt][kt][r];
                if (MASKED) { const int key = s0 + kt * 16 + fg * 4 + r; const bool ok = (key <= tq) && (tq - key < winlimit); y = ok ? y : -INFINITY; s[qt][kt][r] = y; }
                mx = fmaxf(mx, y);
            }
        mx = fmaxf(mx, __shfl_xor(mx, 16)); mx = fmaxf(mx, __shfl_xor(mx, 32));
        const float mnew = fmaxf(S.m[qt], mx + off);
        const float alpha = __builtin_amdgcn_exp2f(S.m[qt] - mnew);
        S.m[qt] = mnew;
        const float thr = mnew - off;
        float ls = 0.f;
#pragma unroll
        for (int kt = 0; kt < 4; ++kt)
#pragma unroll
            for (int r = 0; r < 4; ++r) { const float pr = __builtin_amdgcn_exp2f(s[qt][kt][r] - thr); s[qt][kt][r] = pr; ls += pr; }
        S.l[qt] = S.l[qt] * alpha + ls;
#pragma unroll
        for (int dt = 0; dt < 4; ++dt) S.O[dt][qt] *= alpha;
#pragma unroll
        for (int kk = 0; kk < 2; ++kk) {
            pf[qt][kk].x = pack2(s[qt][2 * kk][0], s[qt][2 * kk][1]); pf[qt][kk].y = pack2(s[qt][2 * kk][2], s[qt][2 * kk][3]);
            pf[qt][kk].z = pack2(s[qt][2 * kk + 1][0], s[qt][2 * kk + 1][1]); pf[qt][kk].w = pack2(s[qt][2 * kk + 1][2], s[qt][2 * kk + 1][3]);
        }
    }
    __builtin_amdgcn_sched_barrier(0);
#pragma unroll
    for (int kk = 0; kk < 2; ++kk)
#pragma unroll
        for (int dt = 0; dt < 4; ++dt) {
            const char* vb = ldsV + (fg & 1) * 8;
            const u32x2 v0 = *(const u32x2*)(vb + lds_off(dt * 16 + fr, kk * 32 + (fg >> 1) * 8)), v1 = *(const u32x2*)(vb + lds_off(dt * 16 + fr, kk * 32 + 16 + (fg >> 1) * 8));
            u32x4 vv; vv.x = v0.x; vv.y = v0.y; vv.z = v1.x; vv.w = v1.y;
            const bf16x8 vf = __builtin_bit_cast(bf16x8, vv);
#pragma unroll
            for (int qt = 0; qt < 2; ++qt) S.O[dt][qt] = __builtin_amdgcn_mfma_f32_16x16x32_bf16(vf, __builtin_bit_cast(bf16x8, pf[qt][kk]), S.O[dt][qt], 0, 0, 0);
        }
    __builtin_amdgcn_sched_barrier(0);
}
__device__ __forceinline__ unsigned wave_or(unsigned v) {
#pragma unroll
    for (int o = 32; o >= 1; o >>= 1) v |= (unsigned)__shfl_xor((int)v, o);
    return v;
}
__device__ __forceinline__ void att_nsa_unit(char* lds, const P& p, int b, int g, int qtile) {
    const int tid = tidx(), lane = tid & 63, w = tid >> 6, fr = lane & 15, fg = lane >> 4;
    const int hd = g * 4 + w, t0 = qtile * 32, own = qtile >> 1;
    const float slope2 = exp2f(-((float)hd + 0.5f)) * LOG2E, c1 = 0.125f * LOG2E;
    bf16x8 qf[2][2];
#pragma unroll
    for (int qt = 0; qt < 2; ++qt)
#pragma unroll
        for (int ks = 0; ks < 2; ++ks) qf[qt][ks] = *(const bf16x8*)(p.Qb + (size_t)(b * SEQ + t0 + qt * 16 + fr) * 512 + hd * 64 + ks * 32 + fg * 8);
#pragma unroll
    for (int qt = 0; qt < 2; ++qt)
#pragma unroll
        for (int ks = 0; ks < 2; ++ks) {
            const u32x4 raw = __builtin_bit_cast(u32x4, qf[qt][ks]); u32x4 o;
            o.x = pack2(bf2f(raw.x & 0xffffu) * c1, bf2f(raw.x >> 16) * c1); o.y = pack2(bf2f(raw.y & 0xffffu) * c1, bf2f(raw.y >> 16) * c1);
            o.z = pack2(bf2f(raw.z & 0xffffu) * c1, bf2f(raw.z >> 16) * c1); o.w = pack2(bf2f(raw.w & 0xffffu) * c1, bf2f(raw.w >> 16) * c1);
            qf[qt][ks] = __builtin_bit_cast(bf16x8, o);
        }
    f32x4 bini[4];
#pragma unroll
    for (int kt = 0; kt < 4; ++kt)
#pragma unroll
        for (int r = 0; r < 4; ++r) bini[kt][r] = slope2 * (float)(kt * 16 + fg * 4 + r);
    unsigned selw[2];
#pragma unroll
    for (int qt = 0; qt < 2; ++qt) selw[qt] = p.SELM[(size_t)(b * 2 + g) * SEQ + t0 + qt * 16 + fr];
    const unsigned um = wave_or(selw[0] | selw[1]);
    AttState S; att_reset(S);
    unsigned rem = um & ((own >= 31) ? 0xffffffffu : ((2u << own) - 1u));
    int wj = own >= 8 ? own - 8 : 0;
    int cbr, cj; bool has = true;
    if (rem) { cj = __ffs(rem) - 1; rem &= rem - 1; cbr = 0; } else { cj = wj++; cbr = 1; }
    const bf16_t* Ks = p.KS + (size_t)b * SEQ * 128 + g * 64; const bf16_t* Kw = p.KW + (size_t)b * SEQ * 128 + g * 64;
    const bf16_t* Vs = p.VSt + (size_t)(b * 128 + g * 64) * SEQ; const bf16_t* Vw = p.VWt + (size_t)(b * 128 + g * 64) * SEQ;
    int n1br = 0, n1j = 0; bool has1;
    if (rem) { n1j = __ffs(rem) - 1; rem &= rem - 1; n1br = 0; has1 = true; } else if (wj <= own) { n1j = wj++; n1br = 1; has1 = true; } else has1 = false;
    __syncthreads();
    att_issue_tile(0, (cbr ? Kw : Ks) + (size_t)cj * 64 * 128, 128, (cbr ? Vw : Vs) + cj * 64);
    if (has1) att_issue_tile(1, (n1br ? Kw : Ks) + (size_t)n1j * 64 * 128, 128, (n1br ? Vw : Vs) + n1j * 64);
    bool switched = false;
    int st = 0;
    while (has) {
        if (has1) ATT_WAIT_BAR(4); else ATT_WAIT_BAR(0);
        int n2br = 0, n2j = 0; bool has2;
        if (!has1) has2 = false;
        else if (rem) { n2j = __ffs(rem) - 1; rem &= rem - 1; n2br = 0; has2 = true; } else if (wj <= own) { n2j = wj++; n2br = 1; has2 = true; } else has2 = false;
        if (has2) att_issue_tile(st == 0 ? 2 : st - 1, (n2br ? Kw : Ks) + (size_t)n2j * 64 * 128, 128, (n2br ? Vw : Vs) + n2j * 64);
        const char* sl = lds + st * ATT_STAGE;
        if (cbr == 1 && !switched) {
            switched = true;
#pragma unroll
            for (int qt = 0; qt < 2; ++qt) {
                float lt = S.l[qt]; lt += __shfl_xor(lt, 16); lt += __shfl_xor(lt, 32);
                const size_t n = (size_t)b * SEQ + t0 + qt * 16 + fr;
                const float sc = sigmoidf_(p.GATES[n * 24 + hd * 3 + 1]) / fmaxf(lt, 1e-30f);
#pragma unroll
                for (int dt = 0; dt < 4; ++dt) { const f32x4 y = S.O[dt][qt] * sc; u32x2 w; w.x = pack2(y[0], y[1]); w.y = pack2(y[2], y[3]); *(u32x2*)((bf16_t*)p.OS + n * 512 + hd * 64 + dt * 16 + fg * 4) = w; }
            }
            att_reset(S);
        }
        unsigned sb = 3u; int wl = 1 << 30; bool msk;
        if (cbr == 0) { sb = ((selw[0] >> cj) & 1u) | (((selw[1] >> cj) & 1u) << 1); msk = (cj == own); }
        else { wl = 512; msk = (cj == own) || (cj + 8 == own); }
        if (msk) att_step<true>(sl, qf, S, bini, slope2, cj * 64, t0, sb, wl);
        else att_step<false>(sl, qf, S, bini, slope2, cj * 64, t0, sb, wl);
        cbr = n1br; cj = n1j; has = has1; n1br = n2br; n1j = n2j; has1 = has2;
        st = (st == 2) ? 0 : st + 1;
    }
#pragma unroll
    for (int qt = 0; qt < 2; ++qt) {
        float lt = S.l[qt]; lt += __shfl_xor(lt, 16); lt += __shfl_xor(lt, 32);
        const size_t n = (size_t)b * SEQ + t0 + qt * 16 + fr;
        const float sc = sigmoidf_(p.GATES[n * 24 + hd * 3 + 2]) / fmaxf(lt, 1e-30f);
        const float g0 = sigmoidf_(p.GATES[n * 24 + hd * 3 + 0]);
#pragma unroll
        for (int dt = 0; dt < 4; ++dt) {
            const size_t o = n * 512 + hd * 64 + dt * 16 + fg * 4;
            const u32x2 osv = *(const u32x2*)((const bf16_t*)p.OS + o), ocv = *(const u32x2*)((const bf16_t*)p.OC + o);
            const f32x4 osf = {bf2f(osv.x & 0xffffu), bf2f(osv.x >> 16), bf2f(osv.y & 0xffffu), bf2f(osv.y >> 16)};
            const f32x4 ocf = {bf2f(ocv.x & 0xffffu), bf2f(ocv.x >> 16), bf2f(ocv.y & 0xffffu), bf2f(ocv.y >> 16)};
            const f32x4 y = S.O[dt][qt] * sc + osf + ocf * g0;
            u32x2 wv; wv.x = pack2(y[0], y[1]); wv.y = pack2(y[2], y[3]);
            *(u32x2*)(p.MIX + n * DM + hd * 64 + dt * 16 + fg * 4) = wv;
        }
    }
}
__device__ __forceinline__ void att_moba_unit(char* lds, const P& p, int b, int h, int ob, int half) {
    const int tid = tidx(), lane = tid & 63, w = tid >> 6, fr = lane & 15, fg = lane >> 4;
    const int tq0 = ob * 256 + half * 128 + w * 32;
    const int dsub = half * 2 + (w >> 1), lastsub = half * 2 + 1;
    const float slope2 = exp2f(-((float)h + 1.0f)) * LOG2E, c1 = 0.125f * LOG2E;
    bf16x8 qf[2][2];
#pragma unroll
    for (int qt = 0; qt < 2; ++qt)
#pragma unroll
        for (int ks = 0; ks < 2; ++ks) qf[qt][ks] = *(const bf16x8*)(p.MQ + (size_t)(b * SEQ + tq0 + qt * 16 + fr) * 512 + h * 64 + ks * 32 + fg * 8);
#pragma unroll
    for (int qt = 0; qt < 2; ++qt)
#pragma unroll
        for (int ks = 0; ks < 2; ++ks) {
            const u32x4 raw = __builtin_bit_cast(u32x4, qf[qt][ks]); u32x4 o;
            o.x = pack2(bf2f(raw.x & 0xffffu) * c1, bf2f(raw.x >> 16) * c1); o.y = pack2(bf2f(raw.y & 0xffffu) * c1, bf2f(raw.y >> 16) * c1);
            o.z = pack2(bf2f(raw.z & 0xffffu) * c1, bf2f(raw.z >> 16) * c1); o.w = pack2(bf2f(raw.w & 0xffffu) * c1, bf2f(raw.w >> 16) * c1);
            qf[qt][ks] = __builtin_bit_cast(bf16x8, o);
        }
    f32x4 bini[4];
#pragma unroll
    for (int kt = 0; kt < 4; ++kt)
#pragma unroll
        for (int r = 0; r < 4; ++r) bini[kt][r] = slope2 * (float)(kt * 16 + fg * 4 + r);
    unsigned selw[2];
#pragma unroll
    for (int qt = 0; qt < 2; ++qt) selw[qt] = p.MSEL[(size_t)(b * 8 + h) * SEQ + tq0 + qt * 16 + fr];
    unsigned* red = (unsigned*)(lds + ATT_RED_OFF);
    const unsigned umw = wave_or(selw[0] | selw[1]);
    __syncthreads();
    if (lane == 0) red[w] = umw;
    __syncthreads();
    unsigned rem = (red[0] | red[1] | red[2] | red[3]) & ((1u << ob) - 1u);
    AttState S; att_reset(S);
    int cj, csub = 0; bool has = true;
    if (rem) { cj = __ffs(rem) - 1; rem &= rem - 1; } else cj = ob;
    const bf16_t* Kb = p.MK + (size_t)b * SEQ * 512 + h * 64; const bf16_t* Vb = p.MVt + (size_t)(b * 512 + h * 64) * SEQ;
#define MOBA_NEXT(J, SUB, NJ, NSUB, HAS) do { \
        if ((J) == ob) { if ((SUB) < lastsub) { NJ = (J); NSUB = (SUB) + 1; HAS = true; } else HAS = false; } \
        else if ((SUB) < 3) { NJ = (J); NSUB = (SUB) + 1; HAS = true; } \
        else { if (rem) { NJ = __ffs(rem) - 1; rem &= rem - 1; } else NJ = ob; NSUB = 0; HAS = true; } } while (0)
    int n1j = 0, n1sub = 0; bool has1;
    MOBA_NEXT(cj, csub, n1j, n1sub, has1);
    __syncthreads();
    att_issue_tile(0, Kb + (size_t)(cj * 256 + csub * 64) * 512, 512, Vb + cj * 256 + csub * 64);
    if (has1) att_issue_tile(1, Kb + (size_t)(n1j * 256 + n1sub * 64) * 512, 512, Vb + n1j * 256 + n1sub * 64);
    int st = 0;
    while (has) {
        if (has1) ATT_WAIT_BAR(4); else ATT_WAIT_BAR(0);
        int n2j = 0, n2sub = 0; bool has2 = false;
        if (has1) MOBA_NEXT(n1j, n1sub, n2j, n2sub, has2);
        if (has2) att_issue_tile(st == 0 ? 2 : st - 1, Kb + (size_t)(n2j * 256 + n2sub * 64) * 512, 512, Vb + n2j * 256 + n2sub * 64);
        const char* sl = lds + st * ATT_STAGE;
        const int s0 = cj * 256 + csub * 64;
        unsigned sb = 3u; bool msk = false, run = true;
        if (cj < ob) sb = ((selw[0] >> cj) & 1u) | (((selw[1] >> cj) & 1u) << 1);
        else { msk = (csub == dsub); run = (csub <= dsub); }
        if (run) {
            if (msk) att_step<true>(sl, qf, S, bini, slope2, s0, tq0, sb, 1 << 30);
            else att_step<false>(sl, qf, S, bini, slope2, s0, tq0, sb, 1 << 30);
        }
        cj = n1j; csub = n1sub; has = has1; n1j = n2j; n1sub = n2sub; has1 = has2;
        st = (st == 2) ? 0 : st + 1;
    }
#undef MOBA_NEXT
#pragma unroll
    for (int qt = 0; qt < 2; ++qt) {
        float lt = S.l[qt]; lt += __shfl_xor(lt, 16); lt += __shfl_xor(lt, 32);
        const size_t n = (size_t)b * SEQ + tq0 + qt * 16 + fr;
        const float sc = 1.0f / fmaxf(lt, 1e-30f);
#pragma unroll
        for (int dt = 0; dt < 4; ++dt) {
            const f32x4 y = S.O[dt][qt] * sc;
            u32x2 wv; wv.x = pack2(y[0], y[1]); wv.y = pack2(y[2], y[3]);
            *(u32x2*)(p.MIX + n * DM + 512 + h * 64 + dt * 16 + fg * 4) = wv;
        }
    }
}
#ifndef ATT_NSA
#define ATT_NSA 1
#endif
#ifndef ATT_MOBA
#define ATT_MOBA 1
#endif
__device__ __forceinline__ int att_class_key(int c) {
    if (c < 64) { const int a = (c >> 1) + 1; return (a < 16 ? a : 16) + (a < 9 ? a : 9); }
    const int ob = (c - 64) >> 1, half = (c - 64) & 1; return 4 * ob + 2 + 2 * half;
}
__device__ __forceinline__ void cmpa_unit(char* lds, const P& p, int b, int g, int qt64);
__device__ __forceinline__ void phase_attn_a(char* lds, int bid, int nb, const P& p) {
    int* order = (int*)(lds + 49152);
    __syncthreads();
    for (int u = tidx(); u < 1024; u += 256) {
        const int c = u & 15, inst = u >> 4;
        const int key = att_class_key(64 + c);
        int pos = inst;
        for (int c2 = 0; c2 < 16; ++c2) { const int k2 = att_class_key(64 + c2); if (k2 > key || (k2 == key && c2 < c)) pos += 64; }
        order[pos] = u;
    }
    __syncthreads();
    for (int r = 0;; ++r) {
        const int idx = r * nb + ((r & 1) ? (nb - 1 - bid) : bid);
        if (idx >= 512 + 1024) break;
        if (idx < 512) cmpa_unit(lds, p, idx >> 6, (idx >> 5) & 1, idx & 31);
        else { const int v = order[idx - 512]; att_moba_unit(lds, p, v >> 7, (v >> 4) & 7, (v >> 1) & 7, v & 1); }
    }
    __syncthreads();
}
__device__ __forceinline__ void phase_attn_b(char* lds, int bid, int nb, const P& p) {
    int* order = (int*)(lds + ATT_ORDER_OFF);
    __syncthreads();
    for (int u = tidx(); u < 1024; u += 256) {
        const int c = u & 63, inst = u >> 6;
        const int key = att_class_key(c);
        int pos = inst;
        for (int c2 = 0; c2 < 64; ++c2) { const int k2 = att_class_key(c2); if (k2 > key || (k2 == key && c2 < c)) pos += 16; }
        order[pos] = u;
    }
    __syncthreads();
    for (int r = 0;; ++r) {
        const int idx = r * nb + ((r & 1) ? (nb - 1 - bid) : bid);
        if (idx >= 1024) break;
        const int u = order[idx];
        att_nsa_unit(lds, p, u >> 7, (u >> 6) & 1, u & 63);
    }
    __syncthreads();
}

struct ALoadCmp {
    const float* base;
    const float* pe;
    int kt0;
    struct Regs { f32x4 v[8]; };
    __device__ __forceinline__ void load(int kt, Regs& R) const {
        const int l = kt + kt0;
        const f32x4 p0 = *(const f32x4*)(pe + l * 64), p1 = *(const f32x4*)(pe + l * 64 + 4);
#pragma unroll
        for (int i = 0; i < 4; ++i) {
            const int row = (tidx() + 256 * i) >> 3; int tok = 16 * row + l; tok = tok > SEQ - 1 ? SEQ - 1 : tok;
            const float* q = base + (size_t)tok * 256;
            R.v[2 * i] = *(const f32x4*)q + p0; R.v[2 * i + 1] = *(const f32x4*)(q + 4) + p1;
        }
    }
    __device__ __forceinline__ void store(int kt, const Regs& R, char* lds) const {
#pragma unroll
        for (int i = 0; i < 4; ++i) {
            const int p = tidx() + 256 * i, row = p >> 3, ch = p & 7;
            const f32x4 a = R.v[2 * i], b = R.v[2 * i + 1];
            u32x4 w; w.x = pack2(a[0], a[1]); w.y = pack2(a[2], a[3]); w.z = pack2(b[0], b[1]); w.w = pack2(b[2], b[3]);
            *(u32x4*)(lds + lds_off(row, ch * 8)) = w;
        }
    }
};
__device__ __forceinline__ void phase_cmp1(char* lds, int bid, int nb, const P& p) {
    const int tid = tidx(), lane = tid & 63, wid = tid >> 6, wr = wid >> 1, wc = wid & 1, fr = lane & 15, fq = lane >> 4;
    for (int u = bid; u < 16 * 2 * 4; u += nb) {
        const int split = u & 3, which = (u >> 2) & 1, bg = u >> 3, b = bg >> 1, g = bg & 1;
        ALoadCmp al; al.kt0 = split * 8; al.base = p.KCV + (size_t)b * SEQ * 256 + which * 128 + g * 64 + (tid & 7) * 8; al.pe = (which ? p.pe_v : p.pe_k) + (tid & 7) * 8;
        BLoadF32 bl; { const int nq = tid & 31, kg = tid >> 5; bl.valid = true; bl.ldb = 128; bl.nk1 = 1 << 30; bl.bp = (which ? p.wv1 : p.wk1) + (size_t)(split * 8 * 64 + kg * 8) * 128 + nq * 4; }
        f32x4 acc[4][4];
        gemm_tile(lds, al, bl, 8, acc);
        float* hid = p.HID + (((size_t)split * 2 + which) * 2048 + bg * 128) * 128;
#pragma unroll
        for (int m = 0; m < 4; ++m)
#pragma unroll
            for (int n = 0; n < 4; ++n) {
                const int row = wr * 64 + m * 16 + fr, col = wc * 64 + n * 16 + fq * 4;
                *(f32x4*)(hid + (size_t)row * 128 + col) = acc[m][n];
            }
    }
}
__device__ __forceinline__ void phase_cmp2(char* lds, int bid, int nb, const P& p) {
    const int tid = tidx(), lane = tid & 63, wid = tid >> 6;
    float* hs = (float*)lds + wid * 128;
    for (int it = bid * 4 + wid; it < 2 * 16 * 128; it += nb * 4) {
        const int which = it >> 11, bg = (it >> 7) & 15, c = it & 127;
        float o = 0.f;
        if (c < 127) {
            const float* hid = p.HID + ((size_t)which * 2048 + bg * 128 + c) * 128;
            const size_t ss = (size_t)2 * 2048 * 128;
            __builtin_amdgcn_wave_barrier();
            hs[lane] = gelu_tanh((hid[lane] + hid[ss + lane]) + (hid[2 * ss + lane] + hid[3 * ss + lane]));
            hs[lane + 64] = gelu_tanh((hid[lane + 64] + hid[ss + lane + 64]) + (hid[2 * ss + lane + 64] + hid[3 * ss + lane + 64]));
            __builtin_amdgcn_wave_barrier();
            const float* w2 = which ? p.wv2 : p.wk2;
#pragma unroll 8
            for (int j = 0; j < 128; ++j) o += hs[j] * w2[j * 64 + lane];
        }
        if (which == 0) p.KCb[((size_t)bg * 128 + c) * 64 + lane] = (bf16_t)f2bf(o);
        else p.VCt[((size_t)bg * 64 + lane) * 128 + c] = (bf16_t)f2bf(o);
    }
}
#define CMPA_LDS (2 * 16384 + 4 * 2048)
__device__ __forceinline__ void cmpa_unit(char* lds, const P& p, int b, int g, int qt64) {
    const int tid = tidx(), lane = tid & 63, w = tid >> 6, fr = lane & 15, fg = lane >> 4;
    const int bg = b * 2 + g;
    char* kc = lds; char* vt = lds + 16384;
    __syncthreads();
#pragma unroll
    for (int i = 0; i < 4; ++i) { const int pc = tid + 256 * i;
        *(u32x4*)(kc + lds_off(pc >> 3, (pc & 7) * 8)) = *(const u32x4*)(p.KCb + (size_t)bg * 8192 + pc * 8);
        *(u32x4*)(vt + lds_off128(pc >> 4, (pc & 15) * 8)) = *(const u32x4*)(p.VCt + (size_t)bg * 8192 + pc * 8); }
    __syncthreads();
    const int t = qt64 * 64 + w * 16 + fr;
    const size_t n = (size_t)b * SEQ + t;
    const float c1 = 0.125f * LOG2E;
    f32x4 psum[8];
#pragma unroll
    for (int ct = 0; ct < 8; ++ct) psum[ct] = (f32x4){0.f, 0.f, 0.f, 0.f};
    bf16x8 qall[4][2];
#pragma unroll
    for (int i = 0; i < 4; ++i) { qall[i][0] = *(const bf16x8*)(p.Qb + n * 512 + (g * 4 + i) * 64 + fg * 8); qall[i][1] = *(const bf16x8*)(p.Qb + n * 512 + (g * 4 + i) * 64 + 32 + fg * 8); }
#pragma unroll
    for (int i = 0; i < 4; ++i) {
        const int hd = g * 4 + i;
        const float slope2 = exp2f(-((float)hd + 0.5f)) * LOG2E;
        const bf16x8 q0 = qall[i][0], q1 = qall[i][1];
        __builtin_amdgcn_sched_barrier(0);
        f32x4 s[8];
        float mx = -INFINITY;
#pragma unroll
        for (int ct = 0; ct < 8; ++ct) {
            const bf16x8 k0 = *(const bf16x8*)(kc + lds_off(ct * 16 + fr, fg * 8)), k1 = *(const bf16x8*)(kc + lds_off(ct * 16 + fr, 32 + fg * 8));
            s[ct] = __builtin_amdgcn_mfma_f32_16x16x32_bf16(k0, q0, (f32x4){0.f, 0.f, 0.f, 0.f}, 0, 0, 0);
            s[ct] = __builtin_amdgcn_mfma_f32_16x16x32_bf16(k1, q1, s[ct], 0, 0, 0);
#pragma unroll
            for (int r = 0; r < 4; ++r) {
                const int e = 16 * (ct * 16 + fg * 4 + r) + 31;
                const float y = (e <= t) ? fmaf(s[ct][r], c1, -slope2 * (float)(t - e)) : -INFINITY;
                s[ct][r] = y; mx = fmaxf(mx, y);
            }
        }
        __builtin_amdgcn_sched_barrier(0);
        mx = fmaxf(mx, __shfl_xor(mx, 16)); mx = fmaxf(mx, __shfl_xor(mx, 32));
        const float mm = (mx == -INFINITY) ? 0.f : mx;
        float ls = 0.f;
#pragma unroll
        for (int ct = 0; ct < 8; ++ct)
#pragma unroll
            for (int r = 0; r < 4; ++r) { const float e = __builtin_amdgcn_exp2f(s[ct][r] - mm); s[ct][r] = e; ls += e; }
        ls += __shfl_xor(ls, 16); ls += __shfl_xor(ls, 32);
        const float inv = 1.0f / fmaxf(ls, 1e-30f);
#pragma unroll
        for (int ct = 0; ct < 8; ++ct) { s[ct] *= inv; psum[ct] += s[ct]; }
        __builtin_amdgcn_sched_barrier(0);
        f32x4 o[4];
#pragma unroll
        for (int dt = 0; dt < 4; ++dt) o[dt] = (f32x4){0.f, 0.f, 0.f, 0.f};
#pragma unroll
        for (int kk = 0; kk < 4; ++kk) {
            u32x4 pw; pw.x = pack2(s[2 * kk][0], s[2 * kk][1]); pw.y = pack2(s[2 * kk][2], s[2 * kk][3]); pw.z = pack2(s[2 * kk + 1][0], s[2 * kk + 1][1]); pw.w = pack2(s[2 * kk + 1][2], s[2 * kk + 1][3]);
            const bf16x8 pf = __builtin_bit_cast(bf16x8, pw);
#pragma unroll
            for (int dt = 0; dt < 4; ++dt) {
                const int c0 = kk * 32 + fg * 4;
                const u32x2 v0 = *(const u32x2*)(vt + lds_off128(dt * 16 + fr, c0 & ~7) + (c0 & 7) * 2);
                const u32x2 v1 = *(const u32x2*)(vt + lds_off128(dt * 16 + fr, (c0 + 16) & ~7) + (c0 & 7) * 2);
                u32x4 vv; vv.x = v0.x; vv.y = v0.y; vv.z = v1.x; vv.w = v1.y;
                o[dt] = __builtin_amdgcn_mfma_f32_16x16x32_bf16(__builtin_bit_cast(bf16x8, vv), pf, o[dt], 0, 0, 0);
            }
        }
#pragma unroll
        for (int dt = 0; dt < 4; ++dt) { u32x2 w; w.x = pack2(o[dt][0], o[dt][1]); w.y = pack2(o[dt][2], o[dt][3]); *(u32x2*)((bf16_t*)p.OC + n * 512 + hd * 64 + dt * 16 + fg * 4) = w; }
    }
    const int own = t >> 6;
    float val[8];
#pragma unroll
    for (int ct = 0; ct < 8; ++ct) {
        const float up = __shfl(psum[ct][3], (lane + 48) & 63);
        const float up0 = (ct > 0) ? __shfl(psum[ct > 0 ? ct - 1 : 0][3], (lane + 48) & 63) : 0.f;
        const float imp = (psum[ct][0] + psum[ct][1]) + (psum[ct][2] + psum[ct][3]) + (fg > 0 ? up : up0);
        const int j = ct * 4 + fg;
        const bool forced = (j == 0) || (j == own) || (j == own - 1);
        val[ct] = (j <= own) ? (imp + (forced ? 1e4f : 0.f)) : NEGF;
    }
    float* vs = (float*)(lds + 32768) + w * 512;
    __builtin_amdgcn_wave_barrier();
#pragma unroll
    for (int ct = 0; ct < 8; ++ct) vs[fr * 32 + ct * 4 + fg] = val[ct];
    __builtin_amdgcn_wave_barrier();
    int rank[8];
#pragma unroll
    for (int ct = 0; ct < 8; ++ct) rank[ct] = 0;
#pragma unroll 2
    for (int oj = 0; oj < 32; ++oj) {
        const float ov = vs[fr * 32 + oj];
#pragma unroll
        for (int ct = 0; ct < 8; ++ct) rank[ct] += (ov > val[ct] || (ov == val[ct] && oj < ct * 4 + fg)) ? 1 : 0;
    }
    __builtin_amdgcn_wave_barrier();
    unsigned bits = 0;
#pragma unroll
    for (int ct = 0; ct < 8; ++ct) if ((ct * 4 + fg <= own) && rank[ct] < 16) bits |= 1u << (ct * 4 + fg);
    bits |= (unsigned)__shfl_xor((int)bits, 16); bits |= (unsigned)__shfl_xor((int)bits, 32);
    if (fg == 0) p.SELM[(size_t)bg * SEQ + t] = bits;
}
#define MEGA_LDS (((HG3_LDS + 255) & ~255) + 16)
static_assert(HG3_LDS >= G4_LDS && HG3_LDS >= CMPA_LDS && HG3_LDS >= GEMM_LDS && HG3_LDS >= ATT_RED_OFF + 16, "LDS map");
#define GBAR() xcd_barrier(bar)

template <int LAYER>
__device__ __forceinline__ void moe_block(char* lds, int bid, int nb, const P& p, const XcdBarrier& bar, float* of, bf16_t* ob, bf16_t* ol) {
    if (bid < 32) p.cnt[bid * NEXP + tidx()] = 0;
    phase_router(bid, nb, p, LAYER);
    GBAR();
    phase_route(bid, nb, p, LAYER);
    GBAR();
    phase_scatter(lds, bid, nb, p);
    GBAR();
    phase_moe1(lds, bid, nb, p, LAYER, p.XAb);
    GBAR();
    phase_moe2(lds, bid, nb, p, LAYER);
    GBAR();
    phase_combine_ln(bid, nb, p, p.XA, p.ln_g + (LAYER * 2 + 1) * DM, p.ln_b + (LAYER * 2 + 1) * DM, of, ob, ol);
}

__global__ void __launch_bounds__(256, 2) mega(P p) {
    char* lds = dyn_lds;
    const int bid = blockIdx.x, nb = gridDim.x;
    volatile LAS unsigned* st = (volatile LAS unsigned*)(dyn_lds + MEGA_LDS - 16);
    if (tidx() == 0) { st[0] = 0u; st[1] = 0u; st[2] = 0u; st[3] = 0u; }
    __syncthreads();
    const XcdBarrier bar = xcd_barrier_post(p.bar, st);
    phase_prep(lds, bid, nb, p);
    GBAR();
    phase_inproj0(lds, bid, nb, p);
    GBAR();
    phase_mix0_a(lds, bid, nb, p);
    GBAR();
    phase_hg2(bid, nb, p);
    for (int u = nb - 1 - bid; u < 512; u += nb) lru2_unit(p, u >> 6, (u >> 1) & 31, u & 1);
    GBAR();
    phase_mix0_c(lds, bid, nb, p);
    GBAR();
    phase_gemm_f32out(bid, nb, p.MIX, p.WOUT0, DM, DM, p.T0);
    GBAR();
    phase_ln_add(bid, nb, p.x, nullptr, nullptr, p.T0, p.ln_g, p.ln_b, nullptr, p.XAb, p.XAl);
    GBAR();
    moe_block<0>(lds, bid, nb, p, bar, nullptr, p.XBb, nullptr);
    GBAR();
    phase_inproj1(lds, bid, nb, p);
    GBAR();
    phase_cmp1(lds, bid, nb, p);
    phase_moba_kmean(bid, nb, p);
    GBAR();
    phase_cmp2(lds, bid, nb, p);
    phase_moba_gate(lds, bid, nb, p);
    GBAR();
    phase_attn_a(lds, bid, nb, p);
    GBAR();
    phase_attn_b(lds, bid, nb, p);
    GBAR();
    phase_gemm_f32out(bid, nb, p.MIX, p.WOUT1, DM, DM, p.T0);
    GBAR();
    phase_ln_add(bid, nb, nullptr, p.XBb, p.XBl, p.T0, p.ln_g + 2 * DM, p.ln_b + 2 * DM, nullptr, p.XAb, p.XAl);
    GBAR();
    moe_block<1>(lds, bid, nb, p, bar, p.out, nullptr, nullptr);
}

static inline size_t al256(size_t x) { return (x + 255) & ~(size_t)255; }

extern "C" void kernel_launch(void* const* d_in, const int* in_sizes, int n_in, void* d_out, int out_size, void* d_ws, size_t ws_size, hipStream_t stream) {
    P p{};
    const float** ip = (const float**)&p.x;
    for (int i = 0; i < 30; ++i) ip[i] = (const float*)d_in[i];
    p.out = (float*)d_out;
    char* w = (char*)d_ws; size_t o = 0;
    auto take = [&](size_t bytes) { char* r = w + o; o = al256(o + bytes); return r; };
    p.bar = (unsigned*)take(XCD_BAR_WORDS * 4);
    p.U = nullptr;
    p.MIX = (bf16_t*)take((size_t)NTOK * DM * 2);
    p.T0 = (float*)take((size_t)NTOK * DM * 4);
    p.XA = nullptr; p.XAb = (bf16_t*)take((size_t)NTOK * DM * 2); p.XAl = (bf16_t*)take((size_t)NTOK * DM * 2); p.XBl = nullptr;
    p.XB = nullptr; p.XBb = (bf16_t*)take((size_t)NTOK * DM * 2);
    p.LOG = (float*)take((size_t)3 * NTOK * NEXP * 4);
    p.eidx = (int*)take(NTOK * 8 * 4); p.ew = (float*)take(NTOK * 8 * 4); p.erank = (int*)take(NTOK * 8 * 4); p.epos = (int*)take(NTOK * 8 * 4);
    p.cnt = (int*)take(32 * NEXP * 4); p.tile_e = (int*)take(NTILES * 4); p.rowtok = (int*)take(NROWS * 4);
    p.H = (bf16_t*)take((size_t)NROWS * 256 * 2);
    p.Y = (bf16_t*)take((size_t)NROWS * DM * 2);
    p.LA = (float*)take((size_t)NTOK * 512 * 4); p.LB = (float*)take((size_t)NTOK * 512 * 4);
    p.KC = nullptr; p.VC = nullptr;
    p.OC = (float*)take((size_t)NTOK * 512 * 4);
    p.SELM = (unsigned*)take(16 * SEQ * 4);
    p.KM = (float*)take(8 * 8 * 8 * 64 * 4);
    p.Qb = (bf16_t*)take((size_t)NTOK * 512 * 2); p.KS = (bf16_t*)take((size_t)NTOK * 128 * 2); p.VSt = (bf16_t*)take((size_t)NTOK * 128 * 2);
    p.KW = (bf16_t*)take((size_t)NTOK * 128 * 2); p.VWt = (bf16_t*)take((size_t)NTOK * 128 * 2);
    p.MQ = (bf16_t*)take((size_t)NTOK * 512 * 2); p.MK = (bf16_t*)take((size_t)NTOK * 512 * 2); p.MVt = (bf16_t*)take((size_t)NTOK * 512 * 2);
    p.KCV = (float*)take((size_t)NTOK * 256 * 4); p.GATES = (float*)take((size_t)NTOK * 24 * 4); p.OS = (float*)take((size_t)NTOK * 512 * 4);
    p.MSEL = (unsigned*)take(64 * SEQ * 4);
    p.UB0 = (bf16_t*)take((size_t)NTOK * 2560 * 2); p.VHt = (bf16_t*)take((size_t)NTOK * 512 * 2);
    p.WAT = (bf16_t*)take(8 * 64 * 64 * 2); p.WXT = (bf16_t*)take(8 * 64 * 64 * 2);
    p.CSA = (float*)take(8 * 32 * 512 * 4); p.CSB = (float*)take(8 * 32 * 512 * 4);
    p.UT = (bf16_t*)take((size_t)1024 * 16384 * 2); p.SP = (bf16_t*)take((size_t)1024 * 16384 * 2);
    p.DV = (float*)take(1024 * 128 * 4);
    p.XIb = (bf16_t*)take((size_t)NTOK * DM * 2);
    p.plist = (int*)take(8 * 320 * 4); p.plen = (int*)take(64);
    p.WIN0 = (bf16_t*)take((size_t)EVEN_IN * DM * 2); p.WOUT0 = (bf16_t*)take((size_t)DM * DM * 2); p.WIN1 = (bf16_t*)take((size_t)2944 * DM * 2); p.WOUT1 = (bf16_t*)take((size_t)DM * DM * 2);
    p.WRH = (bf16_t*)take((size_t)2 * NEXP * DM * 2); p.WRL = (bf16_t*)take((size_t)2 * NEXP * DM * 2);
    p.HID = (float*)take((size_t)4 * 2 * 2048 * 128 * 4); p.KCb = (bf16_t*)take(16 * 128 * 64 * 2); p.VCt = (bf16_t*)take(16 * 64 * 128 * 2);
    if (o > ws_size) return;

    static int grid = 0;
    if (!grid) {
        int dev = 0, cus = 0, per_cu = 0;
        (void)hipGetDevice(&dev);
        (void)hipDeviceGetAttribute(&cus, hipDeviceAttributeMultiprocessorCount, dev);
        (void)hipFuncSetAttribute((const void*)mega, hipFuncAttributeMaxDynamicSharedMemorySize, MEGA_LDS);
        (void)hipOccupancyMaxActiveBlocksPerMultiprocessor(&per_cu, (const void*)mega, 256, MEGA_LDS);
        if (per_cu < 1) per_cu = 1;
        grid = cus * (per_cu < 2 ? per_cu : 2);
    }
    (void)hipMemsetAsync(p.bar, 0, XCD_BAR_WORDS * 4, stream);
    hipLaunchKernelGGL(mega, dim3(grid), dim3(256), MEGA_LDS, stream, p);
}
```

```cpp
#include <hip/hip_runtime.h>
#include <hip/hip_bf16.h>
#include <stdint.h>

#define NTOK 16384
#define DM 1024
#define SEQ 2048
#define NBATCH 8
#define EVEN_IN 3072
#define ODD_IN 2840
#define NEXP 256
#define NEGF (-1e30f)
#define LOG2E 1.4426950408889634f
#define DN_ALPHA 1.4142135623730951f
#define LN_EPS 1e-5f
#define MAXRT 1280
#define SH_TILE0 1280
#define NTILES (1280 + 128)
#define NROWS (NTILES * 128)

typedef unsigned short bf16_t;
typedef short bf16x8 __attribute__((ext_vector_type(8)));
typedef float f32x4 __attribute__((ext_vector_type(4)));
typedef unsigned u32x4 __attribute__((ext_vector_type(4)));
typedef unsigned u32x2 __attribute__((ext_vector_type(2)));
extern __shared__ __attribute__((aligned(16))) char dyn_lds[];
#define LAS __attribute__((address_space(3)))

__device__ __forceinline__ int tidx() { int t = threadIdx.x; asm volatile("" : "+v"(t)); return t; }
__device__ __forceinline__ float wave_sum(float v) {
#pragma unroll
    for (int o = 32; o >= 1; o >>= 1) v += __shfl_xor(v, o);
    return v;
}
__device__ __forceinline__ float wave_max(float v) {
#pragma unroll
    for (int o = 32; o >= 1; o >>= 1) v = fmaxf(v, __shfl_xor(v, o));
    return v;
}
template <int CTRL> __device__ __forceinline__ float dppf(float v) { return __int_as_float(__builtin_amdgcn_update_dpp(0, __float_as_int(v), CTRL, 0xF, 0xF, true)); }
__device__ __forceinline__ float rlanef(float v, int l) { return __int_as_float(__builtin_amdgcn_readlane(__float_as_int(v), l)); }
__device__ __forceinline__ unsigned fkey(float f) { const unsigned u = __float_as_uint(f); return (u & 0x80000000u) ? ~u : (u | 0x80000000u); }
typedef __bf16 hwbf16x2 __attribute__((ext_vector_type(2)));
typedef float f32x2 __attribute__((ext_vector_type(2)));
__device__ __forceinline__ unsigned f2bf(float f) { const __bf16 h = (__bf16)f; return (unsigned)__builtin_bit_cast(unsigned short, h); }
__device__ __forceinline__ float bf2f(unsigned b) { return __uint_as_float(b << 16); }
__device__ __forceinline__ unsigned pack2(float lo, float hi) { const f32x2 f = {lo, hi}; const hwbf16x2 v = __builtin_convertvector(f, hwbf16x2); return __builtin_bit_cast(unsigned, v); }
__device__ __forceinline__ float sigmoidf_(float x) { return 1.0f / (1.0f + __expf(-x)); }
__device__ __forceinline__ float siluf_(float x) { return x / (1.0f + __expf(-x)); }
__device__ __forceinline__ float gelu_tanh(float x) {
    const float u2 = 1.5957691216057308f * (x + 0.044715f * x * x * x);
    return x / (1.0f + __expf(-u2));
}


#define XB_TMO      128
#define XB_XCNT(j)  (256  + 64 * (j))
#define XB_XSUB(j)  (1280 + 64 * (j))
#define XB_XGEN(j)  (2304 + 64 * (j))
#define XB_TOP      3328
#define XB_TOPGEN   3392
#define XCD_BAR_WORDS 3456
#define XB_SPIN_CAP (1u << 18)
__device__ __forceinline__ unsigned xb_ld(unsigned* p)              { return __hip_atomic_load(p, __ATOMIC_RELAXED, __HIP_MEMORY_SCOPE_AGENT); }
__device__ __forceinline__ unsigned xb_add(unsigned* p, unsigned v) { return __hip_atomic_fetch_add(p, v, __ATOMIC_RELAXED, __HIP_MEMORY_SCOPE_AGENT); }
__device__ __forceinline__ unsigned xb_xcc_id() { return (unsigned)__builtin_amdgcn_s_getreg((3 << 11) | 20) & 0xFu; }
#define XB_SPIN(cond, bar) do { unsigned _sp = 0; while (cond) { __builtin_amdgcn_s_sleep(1); \
    if ((++_sp & 255u) == 0u) { if (xb_ld(&(bar)[XB_TMO])) break; if (_sp > XB_SPIN_CAP) { atomicAdd(&(bar)[XB_TMO], 1u); break; } } } } while (0)
struct XcdBarrier { unsigned* bar; unsigned x; volatile LAS unsigned* st; };
__device__ __forceinline__ XcdBarrier xcd_barrier_post(unsigned* bar, volatile LAS unsigned* st) {
    XcdBarrier b; b.bar = bar; b.x = xb_xcc_id(); b.st = st;
    if (tidx() == 0) (void)xb_add(&bar[XB_XCNT(b.x)], 1u);
    return b;
}
__device__ __forceinline__ void xcd_barrier_complete(unsigned* bar, unsigned x, unsigned& nloc, unsigned& nx) {
    const unsigned G = gridDim.x * gridDim.y * gridDim.z;
    unsigned sum, cnt, mine, sp = 0u;
    for (;;) {
        sum = 0u; cnt = 0u; mine = 0u;
#pragma unroll
        for (unsigned j = 0; j < 16; ++j) { const unsigned c = xb_ld(&bar[XB_XCNT(j)]); sum += c; cnt += (c > 0u) ? 1u : 0u; mine = (j == x) ? c : mine; }
        if (sum == G) break;
        __builtin_amdgcn_s_sleep(1);
        if ((++sp & 255u) == 0u) { if (xb_ld(&bar[XB_TMO])) break; if (sp > XB_SPIN_CAP) { atomicAdd(&bar[XB_TMO], 1u); break; } }
    }
    nloc = mine > 0u ? mine : 1u; nx = cnt > 0u ? cnt : 1u;
}
__device__ __forceinline__ void xcd_barrier(const XcdBarrier& b) {
    asm volatile("s_waitcnt vmcnt(0)" ::: "memory");
    __syncthreads();
    if (tidx() == 0) {
        unsigned* bar = b.bar;
        __builtin_amdgcn_s_waitcnt(0);
        unsigned nloc = b.st[0], nx = b.st[1];
        if (nloc == 0u) { xcd_barrier_complete(bar, b.x, nloc, nx); b.st[0] = nloc; b.st[1] = nx; }
        const unsigned old = xb_add(&bar[XB_XSUB(b.x)], 1u);
        const unsigned gen = old / nloc;
        if (old + 1u == (gen + 1u) * nloc) {
            __builtin_amdgcn_fence(__ATOMIC_RELEASE, "agent");
            asm volatile("s_waitcnt vmcnt(0)" ::: "memory");
            const unsigned og = xb_add(&bar[XB_TOP], 1u);
            const unsigned tg = og / nx;
            if (og + 1u == (tg + 1u) * nx) xb_add(&bar[XB_TOPGEN], 1u);
            else XB_SPIN(xb_ld(&bar[XB_TOPGEN]) == tg, bar);
            __builtin_amdgcn_fence(__ATOMIC_ACQUIRE, "agent");
            xb_add(&bar[XB_XGEN(b.x)], 1u);
            asm volatile("s_waitcnt vmcnt(0)" ::: "memory");
        } else {
            XB_SPIN(xb_ld(&bar[XB_XGEN(b.x)]) == gen, bar);
            __builtin_amdgcn_fence(__ATOMIC_ACQUIRE, "agent");
            asm volatile("s_waitcnt vmcnt(0)" ::: "memory");
        }
    }
    __syncthreads();
}

struct P {
    const float *x, *even_w_in, *conv_w, *conv_b, *wa, *ba, *wx, *bx, *lam, *hg_lb, *hg_ng, *even_w_out;
    const float *odd_w_in, *pe_k, *pe_v, *wk1, *wk2, *wv1, *wv2, *odd_w_out, *ln_g, *ln_b, *w_router, *b_router;
    const float *w_gate, *w_up, *w_down, *ws_gate, *ws_up, *ws_down;
    float* out;
    float* U;
    bf16_t* MIX;
    float* T0;
    float* XA; bf16_t* XAb; float* XB; bf16_t* XBb; bf16_t* XAl; bf16_t* XBl;
    float* LOG;
    int* eidx; float* ew; int* erank; int* epos;
    int* cnt;
    int* tile_e;
    int* rowtok;
    bf16_t* H;
    bf16_t* Y;
    float* LA; float* LB;
    float* KC; float* VC;
    float* OC;
    unsigned* SELM;
    float* KM;
    unsigned* bar;
    bf16_t *Qb, *KS, *VSt, *KW, *VWt, *MQ, *MK, *MVt;
    float *KCV, *GATES, *OS; unsigned* MSEL;
    bf16_t *UB0;
    bf16_t *VHt;
    bf16_t *WAT, *WXT;
    float *CSA, *CSB;
    bf16_t *UT, *SP;
    float *DV;
    float *HID;
    bf16_t *KCb, *VCt;
    bf16_t *XIb;
    int *plist; int *plen;
    bf16_t *WIN0, *WOUT0, *WIN1, *WOUT1, *WRH, *WRL;
};

__device__ __forceinline__ int lds_off(int r, int c) {
    const int st = (r >> 4) * 2 + (c >> 5), ob = (r & 15) * 64 + (c & 31) * 2;
    return st * 1024 + (ob ^ (((ob >> 9) & 1) << 5));
}
#define GEMM_LDS 32768

__device__ __forceinline__ float cvt_part(float v, int lo) { return lo ? (v - bf2f(f2bf(v))) : v; }

struct BLoadF32 {
    const float* bp; int ldb; bool valid; int nk1;
    struct Regs { f32x4 v[8]; };
    __device__ __forceinline__ void load(int kt, Regs& R) const {
        const float* p = bp + (size_t)((kt % nk1) * 64) * ldb;
#pragma unroll
        for (int j = 0; j < 8; ++j) R.v[j] = valid ? *(const f32x4*)(p + (size_t)j * ldb) : (f32x4){0.f, 0.f, 0.f, 0.f};
    }
    __device__ __forceinline__ void store(int kt, const Regs& R, char* lds) const {
        const int lo = (kt / nk1) == 1;
        const int nq = tidx() & 31, kg = tidx() >> 5;
#pragma unroll
        for (int i = 0; i < 4; ++i) {
            u32x4 w;
            w.x = pack2(cvt_part(R.v[0][i], lo), cvt_part(R.v[1][i], lo)); w.y = pack2(cvt_part(R.v[2][i], lo), cvt_part(R.v[3][i], lo));
            w.z = pack2(cvt_part(R.v[4][i], lo), cvt_part(R.v[5][i], lo)); w.w = pack2(cvt_part(R.v[6][i], lo), cvt_part(R.v[7][i], lo));
            *(u32x4*)(lds + lds_off(nq * 4 + i, kg * 8)) = w;
        }
    }
};

template <class AL, class BL>
__device__ __forceinline__ void gemm_tile(char* lds, const AL& al, const BL& bl, int nk, f32x4 (&acc)[4][4], bool swap = false) {
    const int lane = tidx() & 63, wid = tidx() >> 6, wr = wid >> 1, wc = wid & 1, fr = lane & 15, fq = lane >> 4;
    char* ldsA = lds; char* ldsB = lds + 16384;
    const char* t2 = swap ? ldsB : ldsA; const char* t1 = swap ? ldsA : ldsB; const int w2 = swap ? wc : wr, w1 = swap ? wr : wc;
#pragma unroll
    for (int m = 0; m < 4; ++m)
#pragma unroll
        for (int n = 0; n < 4; ++n) acc[m][n] = (f32x4){0.f, 0.f, 0.f, 0.f};
    typename AL::Regs ra; typename BL::Regs rb;
    al.load(0, ra); bl.load(0, rb);
    for (int kt = 0; kt < nk; ++kt) {
        __syncthreads();
        al.store(kt, ra, ldsA); bl.store(kt, rb, ldsB);
        __syncthreads();
        if (kt + 1 < nk) { al.load(kt + 1, ra); bl.load(kt + 1, rb); }
#pragma unroll
        for (int kk = 0; kk < 2; ++kk) {
            bf16x8 a[4], b[4];
#pragma unroll
            for (int m = 0; m < 4; ++m) a[m] = *(const bf16x8*)(t2 + lds_off(w2 * 64 + m * 16 + fr, kk * 32 + fq * 8));
#pragma unroll
            for (int n = 0; n < 4; ++n) b[n] = *(const bf16x8*)(t1 + lds_off(w1 * 64 + n * 16 + fr, kk * 32 + fq * 8));
#pragma unroll
            for (int m = 0; m < 4; ++m)
#pragma unroll
                for (int n = 0; n < 4; ++n) acc[m][n] = __builtin_amdgcn_mfma_f32_16x16x32_bf16(b[n], a[m], acc[m][n], 0, 0, 0);
        }
    }
}


__device__ __forceinline__ void dma_rc(int lane, int st, int& R, int& C) {
    const int sb = lane * 16, swz = sb ^ (((sb >> 9) & 1) << 5);
    R = (st >> 1) * 16 + (swz >> 6); C = (st & 1) * 32 + ((swz & 63) >> 1);
}
#define G3_STAGE 24576
#define G3_LDS (2 * G3_STAGE)
__device__ __forceinline__ int t32_off(int r, int c) { const int ob = (r & 15) * 64 + c * 2; return (r >> 4) * 1024 + (ob ^ (((ob >> 9) & 1) << 5)); }
__device__ __forceinline__ void dma_rc32(int lane, int st, int& R, int& C) { const int sb = lane * 16, swz = sb ^ (((sb >> 9) & 1) << 5); R = st * 16 + (swz >> 6); C = (swz & 63) >> 1; }
struct Dma3A {
    static constexpr int NV = 4;
    const char* base; unsigned voff[4];
    const char* lo = nullptr; int nk1 = 1 << 30;
    int kt0 = 0;
    int np = 4;
    __device__ __forceinline__ void set_dense(const bf16_t* b0, int row0, int ld) {
        base = (const char*)b0; const int lane = tidx() & 63, w = tidx() >> 6;
#pragma unroll
        for (int i = 0; i < 4; ++i) { int R, C; dma_rc32(lane, w + 4 * i, R, C); voff[i] = (unsigned)(((size_t)(row0 + R) * ld + C) * 2); }
    }
    template <int SET = 0> __device__ __forceinline__ void issue(int kt, int ldsoff) const {
        const int w = tidx() >> 6;
#pragma unroll
        for (int i = 0; i < 4; ++i) if (i < np)
            __builtin_amdgcn_global_load_lds((const unsigned*)(((((kt + kt0) / nk1) == 2) ? lo : base) + voff[i] + (size_t)((kt + kt0) % nk1) * 64), (LAS unsigned*)((LAS char*)dyn_lds + ldsoff + (w + 4 * i) * 1024), 16, 0, 0);
    }
    template <int SET = 0> __device__ __forceinline__ void commit(int, int) const {}
};
struct Dma3B {
    static constexpr int LAYOUT = 0, NV = 2;
    const char* hi; const char* lo; unsigned voff[2]; int nk1; int kt0 = 0;
    __device__ __forceinline__ void set(const bf16_t* h, const bf16_t* l, int row0, int ld, int nk1_) {
        hi = (const char*)h; lo = (const char*)l; nk1 = nk1_; const int lane = tidx() & 63, w = tidx() >> 6;
#pragma unroll
        for (int i = 0; i < 2; ++i) { int R, C; dma_rc32(lane, w + 4 * i, R, C); const int Rs = (R & ~31) + 8 * ((R & 15) >> 2) + 4 * ((R >> 4) & 1) + (R & 3);
            voff[i] = (unsigned)(((size_t)(row0 + Rs) * ld + C) * 2); }
    }
    template <int SET = 0> __device__ __forceinline__ void issue(int kt, int ldsoff) const {
        const int w = tidx() >> 6; const char* base = (((kt + kt0) / nk1) == 1) ? lo : hi; const size_t ko = (size_t)((kt + kt0) % nk1) * 64;
#pragma unroll
        for (int i = 0; i < 2; ++i)
            __builtin_amdgcn_global_load_lds((const unsigned*)(base + voff[i] + ko), (LAS unsigned*)((LAS char*)dyn_lds + ldsoff + (w + 4 * i) * 1024), 16, 0, 0);
    }
    template <int SET = 0> __device__ __forceinline__ void commit(int, int) const {}
};
struct Reg3B {
    static constexpr int LAYOUT = 1, NV = 4;
    const float* bp; int ldb; f32x4 v[2][4]; int perm64 = 0;
    template <int SET = 0> __device__ __forceinline__ void issue(int kt, int) {
        const float* p = bp + (size_t)(kt * 32) * ldb;
#pragma unroll
        for (int j = 0; j < 4; ++j) v[SET][j] = *(const f32x4*)(p + (size_t)j * ldb);
    }
    template <int SET = 0> __device__ __forceinline__ void commit(int, int ldsoff) const {
        const int tid = tidx(), nq = tid & 31, kg = tid >> 5;
        u32x2 w[4];
#pragma unroll
        for (int i = 0; i < 4; ++i) { w[i].x = pack2(v[SET][0][i], v[SET][1][i]); w[i].y = pack2(v[SET][2][i], v[SET][3][i]); }
        const int q = nq & 7, q16 = nq & 15;
        const int rowbase = perm64 ? ((nq >> 4) * 64 + (q16 & 3) * 16 + (q16 >> 2) * 4) : ((nq >> 3) * 32 + (q & 1) * 16 + (q >> 1) * 4);
        const int rot = perm64 ? (q16 & 3) : ((q & 1) + 2 * ((q >> 2) & 1));
#pragma unroll
        for (int i = 0; i < 4; ++i) {
            const int e = (i + rot) & 3;
            u32x2 d;
            d.x = e == 0 ? w[0].x : (e == 1 ? w[1].x : (e == 2 ? w[2].x : w[3].x));
            d.y = e == 0 ? w[0].y : (e == 1 ? w[1].y : (e == 2 ? w[2].y : w[3].y));
            *(u32x2*)(dyn_lds + ldsoff + ((((kg >> 1) * 128 + rowbase + e) << 4) + (kg & 1) * 8)) = d;
        }
    }
};
#define G4_LDS (3 * G3_STAGE)
template <class AL, class BL, int PAR>
__device__ __forceinline__ void g4_step(AL& al, BL& bl, int kt, int nk, f32x4 (&acc)[32], bool idle, int skipA) {
    constexpr int NV = AL::NV + BL::NV;
    const int lane = tidx() & 63, wid = tidx() >> 6, wr = wid >> 1, wc = wid & 1, fr = lane & 15, fq = lane >> 4;
    const int s0 = kt % 3, cur = s0 * G3_STAGE, nx1 = (s0 == 2 ? 0 : s0 + 1) * G3_STAGE, nx2 = (s0 == 0 ? 2 : s0 - 1) * G3_STAGE;
    if (BL::LAYOUT == 1) asm volatile("s_waitcnt vmcnt(0) lgkmcnt(0)" ::: "memory");
    else if (kt + 1 < nk) {
        if (skipA == 0) asm volatile("s_waitcnt vmcnt(%0) lgkmcnt(0)" :: "n"(NV) : "memory");
        else if (skipA == 1) asm volatile("s_waitcnt vmcnt(%0) lgkmcnt(0)" :: "n"(NV - 1) : "memory");
        else if (skipA == 2) asm volatile("s_waitcnt vmcnt(%0) lgkmcnt(0)" :: "n"(NV - 2) : "memory");
        else if (skipA == 3) asm volatile("s_waitcnt vmcnt(%0) lgkmcnt(0)" :: "n"(NV - 3) : "memory");
        else asm volatile("s_waitcnt vmcnt(%0) lgkmcnt(0)" :: "n"(NV - 4) : "memory");
    } else asm volatile("s_waitcnt vmcnt(0) lgkmcnt(0)" ::: "memory");
    __builtin_amdgcn_s_barrier();
    asm volatile("" ::: "memory");
    if (kt + 2 < nk) { al.template issue<PAR>(kt + 2, nx2); bl.template issue<PAR>(kt + 2, nx2 + 16384); }
    if (!idle) {
    bf16x8 sm[4];
#pragma unroll
    for (int j = 0; j < 4; ++j) sm[j] = *(const bf16x8*)(dyn_lds + cur + 16384 + (BL::LAYOUT == 1 ? ((fq * 128 + wc * 64 + j * 16 + fr) << 4) : t32_off(wc * 64 + j * 16 + fr, fq * 8)));
    bf16x8 bigc = *(const bf16x8*)(dyn_lds + cur + t32_off(wr * 128 + fr, fq * 8));
#pragma unroll
    for (int i = 0; i < 8; ++i) {
        bf16x8 bign = bigc;
        if (i < 7) bign = *(const bf16x8*)(dyn_lds + cur + t32_off(wr * 128 + (i + 1) * 16 + fr, fq * 8));
        __builtin_amdgcn_sched_barrier(0);
#pragma unroll
        for (int j = 0; j < 4; ++j) acc[i * 4 + j] = __builtin_amdgcn_mfma_f32_16x16x32_bf16(sm[j], bigc, acc[i * 4 + j], 0, 0, 0);
        __builtin_amdgcn_sched_barrier(0);
        bigc = bign;
    }
    }
    if (kt + 1 < nk) bl.template commit<PAR ^ 1>(kt + 1, nx1 + 16384);
}
template <class AL, class BL>
__device__ __forceinline__ void gemm_core4(AL& al, BL& bl, int nk, f32x4 (&acc)[32], bool idle_hi = false, int skipA = 0) {
    const bool idle = idle_hi && (tidx() >> 7);
#pragma unroll
    for (int i = 0; i < 32; ++i) acc[i] = (f32x4){0.f, 0.f, 0.f, 0.f};
    al.template issue<0>(0, 0); bl.template issue<0>(0, 16384);
    if (nk > 1) { al.template issue<1>(1, G3_STAGE); bl.template issue<1>(1, G3_STAGE + 16384); }
    bl.template commit<0>(0, 16384);
    for (int kt = 0; kt < nk; kt += 2) {
        g4_step<AL, BL, 0>(al, bl, kt, nk, acc, idle, skipA);
        if (kt + 1 < nk) g4_step<AL, BL, 1>(al, bl, kt + 1, nk, acc, idle, skipA);
    }
    __syncthreads();
}
__device__ __forceinline__ bool dense_unit3(int bid, int nb, int j, int ntn, int& tm, int& tn) {
    if ((nb & 7) == 0) {
        const int x = bid & 7, r = bid >> 3, R = nb >> 3;
        const int li = r + R * j;
        if (li >= 8 * ntn) return false;
        tn = li >> 3; tm = x * 8 + (li & 7);
        return true;
    }
    const int u = bid + nb * j;
    if (u >= 64 * ntn) return false;
    tm = u / ntn; tn = u % ntn; return true;
}
__device__ __forceinline__ void prep_tile(char* lds, const float* W, int ldw, int k0, int scol0, bool colvalid, bf16_t* Bt, int K, int drow0, int mode) {
    const int tid = tidx();
    bf16_t* t = (bf16_t*)lds;
    __syncthreads();
#pragma unroll
    for (int i = 0; i < 4; ++i) {
        const int k = (tid >> 4) + 16 * i, q = tid & 15;
        f32x4 v = colvalid ? *(const f32x4*)(W + (size_t)(k0 + k) * ldw + scol0 + q * 4) : (f32x4){0.f, 0.f, 0.f, 0.f};
#pragma unroll
        for (int e = 0; e < 4; ++e) { float x = v[e]; if (mode == 2) x = x - bf2f(f2bf(x)); t[(q * 4 + e) * 72 + k] = (bf16_t)f2bf(x); }
    }
    __syncthreads();
#pragma unroll
    for (int i = 0; i < 2; ++i) { const int pc = tid + 256 * i, n = pc >> 3, ch = pc & 7;
        *(u32x4*)(Bt + (size_t)(drow0 + n) * K + k0 + ch * 8) = *(const u32x4*)(t + n * 72 + ch * 8); }
}
__device__ __forceinline__ int vcol_actual(int v);
__device__ __forceinline__ void phase_prep(char* lds, int bid, int nb, const P& p) {
    const int tid = tidx();
    for (size_t i = (size_t)bid * 256 + tid; i < (size_t)NTOK * DM / 8; i += (size_t)nb * 256) {
        const f32x4 a = *(const f32x4*)(p.x + i * 8), b = *(const f32x4*)(p.x + i * 8 + 4);
        u32x4 w; w.x = pack2(a[0], a[1]); w.y = pack2(a[2], a[3]); w.z = pack2(b[0], b[1]); w.w = pack2(b[2], b[3]);
        *(u32x4*)(p.XIb + i * 8) = w;
    }
    for (int u = bid; u < 2272; u += nb) {
        if (u < 768) { const int nt = u >> 4, kt = u & 15; const int d = nt * 64; const int sc = d < 2048 ? d : (d < 2560 ? d + 512 : d - 512);
            prep_tile(lds, p.even_w_in, EVEN_IN, kt * 64, sc, true, p.WIN0, DM, d, 0); }
        else if (u < 1024) { const int v = u - 768, nt = v >> 4, kt = v & 15; prep_tile(lds, p.even_w_out, DM, kt * 64, nt * 64, true, p.WOUT0, DM, nt * 64, 0); }
        else if (u < 1760) { const int v = u - 1024, nt = v >> 4, kt = v & 15; const int d = nt * 64;
            int sc; bool ok = true;
            if (d < 896) sc = d; else if (d < 1024) sc = d + 128; else if (d < 1536) sc = d + 280; else if (d < 2048) sc = d + 280;
            else if (d < 2112) sc = 1280; else if (d < 2176) { sc = 0; ok = false; } else if (d < 2304) sc = d - 1280; else if (d < 2432) sc = d - 1152; else sc = d - 104;
            prep_tile(lds, p.odd_w_in, ODD_IN, kt * 64, sc, ok, p.WIN1, DM, d, 0); }
        else if (u < 2016) { const int v = u - 1760, nt = v >> 4, kt = v & 15; prep_tile(lds, p.odd_w_out, DM, kt * 64, nt * 64, true, p.WOUT1, DM, nt * 64, 0); }
        else { const int v = u - 2016, layer = v >> 7, lo = (v >> 6) & 1, nt = (v >> 4) & 3, kt = v & 15;
            prep_tile(lds, p.w_router + (size_t)layer * DM * NEXP, NEXP, kt * 64, nt * 64, true, (lo ? p.WRL : p.WRH) + (size_t)layer * NEXP * DM, DM, nt * 64, lo ? 2 : 1); }
    }
    __syncthreads();
}


__device__ __forceinline__ void phase_gemm_f32out(int bid, int nb, const bf16_t* A, const bf16_t* Bt, int N, int K, float* C) {
    const int ntn = N / 128;
    const int tid = tidx(), lane = tid & 63, wid = tid >> 6, wr = wid >> 1, wc = wid & 1, fr = lane & 15, fq = lane >> 4;
    for (int j = 0;; ++j) {
        int tm, tn; if (!dense_unit3(bid, nb, j, ntn, tm, tn)) break;
        Dma3A al; al.set_dense(A, tm * 256, K); Dma3B bl; bl.set(Bt, Bt, tn * 128, K, 1 << 30);
        f32x4 acc[32];
        gemm_core4(al, bl, K / 32, acc);
#pragma unroll
        for (int i = 0; i < 8; ++i)
#pragma unroll
            for (int gg = 0; gg < 2; ++gg) { const f32x4 a = acc[i * 4 + 2 * gg], b2 = acc[i * 4 + 2 * gg + 1];
                u32x4 w; w.x = pack2(a[0], a[1]); w.y = pack2(a[2], a[3]); w.z = pack2(b2[0], b2[1]); w.w = pack2(b2[2], b2[3]);
                *(u32x4*)((bf16_t*)C + (size_t)(tm * 256 + wr * 128 + i * 16 + fr) * N + tn * 128 + wc * 64 + gg * 32 + fq * 8) = w; }
    }
}
__device__ __forceinline__ void phase_router(int bid, int nb, const P& p, int layer) {
    const int tid = tidx(), lane = tid & 63, wid = tid >> 6, wr = wid >> 1, wc = wid & 1, fr = lane & 15, fq = lane >> 4;
    for (int j = 0;; ++j) {
        int tm, t8; if (!dense_unit3(bid, nb, j, 8, tm, t8)) break;
        const int tn = t8 & 1, chunk = t8 >> 1;
        Dma3A al; al.set_dense(p.XAb, tm * 256, DM); al.lo = (const char*)p.XAl; al.nk1 = 32; al.kt0 = chunk * 24;
        const bf16_t* wh = p.WRH + (size_t)layer * NEXP * DM; const bf16_t* wl = p.WRL + (size_t)layer * NEXP * DM;
        Dma3B bl; bl.set(wh, wl, tn * 128, DM, 32); bl.kt0 = chunk * 24;
        f32x4 acc[32];
        gemm_core4(al, bl, 24, acc);
        float* dst = p.LOG + (size_t)chunk * NTOK * NEXP;
#pragma unroll
        for (int i = 0; i < 8; ++i)
#pragma unroll
            for (int gg = 0; gg < 2; ++gg) { float* q = dst + (size_t)(tm * 256 + wr * 128 + i * 16 + fr) * NEXP + tn * 128 + wc * 64 + gg * 32 + fq * 8;
                *(f32x4*)q = acc[i * 4 + 2 * gg]; *(f32x4*)(q + 4) = acc[i * 4 + 2 * gg + 1]; }
    }
}
__device__ __forceinline__ void ln_row_store(float (&v)[16], const float* g, const float* b, float* of, bf16_t* ob, int row, int lane, bf16_t* ol = nullptr) {
    float s = 0.f;
#pragma unroll
    for (int i = 0; i < 16; ++i) s += v[i];
    const float mu = wave_sum(s) * (1.0f / DM);
    float q = 0.f;
#pragma unroll
    for (int i = 0; i < 16; ++i) { const float d = v[i] - mu; q += d * d; }
    const float rstd = rsqrtf(wave_sum(q) * (1.0f / DM) + LN_EPS);
#pragma unroll
    for (int h = 0; h < 2; ++h) {
        const int c0 = h * 512 + lane * 8;
        float o[8];
#pragma unroll
        for (int i = 0; i < 8; ++i) o[i] = (v[h * 8 + i] - mu) * rstd * g[c0 + i] + b[c0 + i];
        if (of) { *(f32x4*)(of + (size_t)row * DM + c0) = (f32x4){o[0], o[1], o[2], o[3]};
                  *(f32x4*)(of + (size_t)row * DM + c0 + 4) = (f32x4){o[4], o[5], o[6], o[7]}; }
        if (ob) { u32x4 w; w.x = pack2(o[0], o[1]); w.y = pack2(o[2], o[3]); w.z = pack2(o[4], o[5]); w.w = pack2(o[6], o[7]); *(u32x4*)(ob + (size_t)row * DM + c0) = w;
            if (ol) { float l[8];
#pragma unroll
                for (int i = 0; i < 8; ++i) l[i] = o[i] - bf2f(f2bf(o[i]));
                u32x4 wl; wl.x = pack2(l[0], l[1]); wl.y = pack2(l[2], l[3]); wl.z = pack2(l[4], l[5]); wl.w = pack2(l[6], l[7]); *(u32x4*)(ol + (size_t)row * DM + c0) = wl; } }
    }
}
__device__ __forceinline__ void phase_ln_add(int bid, int nb, const float* res, const bf16_t* resh, const bf16_t* resl, const float* add, const float* g, const float* b, float* of, bf16_t* ob, bf16_t* ol) {
    const int lane = tidx() & 63, wid = tidx() >> 6;
    for (int row = bid * 4 + wid; row < NTOK; row += nb * 4) {
        float v[16];
#pragma unroll
        for (int h = 0; h < 2; ++h) {
            const size_t o = (size_t)row * DM + h * 512 + lane * 8;
            f32x4 r0, r1;
            if (res) { r0 = *(const f32x4*)(res + o); r1 = *(const f32x4*)(res + o + 4); }
            else { const u32x4 xh = *(const u32x4*)(resh + o);
                r0[0] = bf2f(xh.x & 0xffffu); r0[1] = bf2f(xh.x >> 16); r0[2] = bf2f(xh.y & 0xffffu); r0[3] = bf2f(xh.y >> 16);
                r1[0] = bf2f(xh.z & 0xffffu); r1[1] = bf2f(xh.z >> 16); r1[2] = bf2f(xh.w & 0xffffu); r1[3] = bf2f(xh.w >> 16); }
            const u32x4 ab = *(const u32x4*)((const bf16_t*)add + o);
            const float a0[4] = {bf2f(ab.x & 0xffffu), bf2f(ab.x >> 16), bf2f(ab.y & 0xffffu), bf2f(ab.y >> 16)};
            const float a1[4] = {bf2f(ab.z & 0xffffu), bf2f(ab.z >> 16), bf2f(ab.w & 0xffffu), bf2f(ab.w >> 16)};
#pragma unroll
            for (int i = 0; i < 4; ++i) { v[h * 8 + i] = DN_ALPHA * r0[i] + a0[i]; v[h * 8 + 4 + i] = DN_ALPHA * r1[i] + a1[i]; }
        }
        ln_row_store(v, g, b, of, ob, row, lane, ol);
    }
}

__device__ __forceinline__ void phase_route(int bid, int nb, const P& p, int layer) {
    const float* br = p.b_router + layer * NEXP;
    const int tid = tidx(), lane = tid & 63, wid = tid >> 6;
    const int gt = bid * 256 + tid, gs = nb * 256;
    for (int i = gt; i < NROWS; i += gs) p.rowtok[i] = (i >= SH_TILE0 * 128) ? (i - SH_TILE0 * 128) : 0;
    const f32x4 bv = *(const f32x4*)(br + lane * 4);
    for (int tb = bid * 4 + wid; tb < NTOK; tb += nb * 4 * 8) {
        int es[8]; float ws[8];
        f32x4 lgs[8];
#pragma unroll
        for (int q = 0; q < 8; ++q) {
            const int t = min(tb + q * nb * 4, NTOK - 1);
            lgs[q] = (*(const f32x4*)(p.LOG + (size_t)t * NEXP + lane * 4) + *(const f32x4*)(p.LOG + (size_t)NTOK * NEXP + (size_t)t * NEXP + lane * 4))
                   + (*(const f32x4*)(p.LOG + (size_t)2 * NTOK * NEXP + (size_t)t * NEXP + lane * 4) + *(const f32x4*)(p.LOG + (size_t)3 * NTOK * NEXP + (size_t)t * NEXP + lane * 4));
        }
#pragma unroll
        for (int q = 0; q < 8; ++q) {
            const int t = tb + q * nb * 4;
            es[q] = 0; ws[q] = 0.f;
            if (t < NTOK) {
        const f32x4 lg = lgs[q];
        float sc[4], bs[4];
#pragma unroll
        for (int i = 0; i < 4; ++i) { sc[i] = sigmoidf_(lg[i]); bs[i] = sc[i] + bv[i]; }
        float t1 = fmaxf(bs[0], bs[1]), t2 = fminf(bs[0], bs[1]);
        { const float a = fmaxf(bs[2], bs[3]), c = fminf(bs[2], bs[3]); const float n1 = fmaxf(t1, a); t2 = fmaxf(fminf(t1, a), fmaxf(t2, c)); t1 = n1; }
#define R_MERGE(CTRL) { const float o1 = dppf<CTRL>(t1), o2 = dppf<CTRL>(t2); const float n1 = fmaxf(t1, o1); t2 = fmaxf(fminf(t1, o1), fmaxf(t2, o2)); t1 = n1; }
        R_MERGE(0xB1) R_MERGE(0x4E) R_MERGE(0x141)
#undef R_MERGE
        const float gsc = t1 + t2;
        const int g = lane >> 3;
        int rank = 0;
#pragma unroll
        for (int g2 = 0; g2 < 8; ++g2) { const float o = rlanef(gsc, g2 * 8); rank += (o > gsc || (o == gsc && g2 < g)) ? 1 : 0; }
        const bool allowed = rank < 4;
        unsigned key[4];
#pragma unroll
        for (int i = 0; i < 4; ++i) key[i] = allowed ? fkey(bs[i] + 0.0f) : 0u;
        unsigned T = 0u; int bstart = 31;
        {
            const unsigned K05 = 0xBF000000u, K10 = 0xBF800000u;
            const int c05 = __builtin_popcountll(__builtin_amdgcn_ballot_w64(key[0] >= K05)) + __builtin_popcountll(__builtin_amdgcn_ballot_w64(key[1] >= K05))
                          + __builtin_popcountll(__builtin_amdgcn_ballot_w64(key[2] >= K05)) + __builtin_popcountll(__builtin_amdgcn_ballot_w64(key[3] >= K05));
            const int c10 = __builtin_popcountll(__builtin_amdgcn_ballot_w64(key[0] >= K10)) + __builtin_popcountll(__builtin_amdgcn_ballot_w64(key[1] >= K10))
                          + __builtin_popcountll(__builtin_amdgcn_ballot_w64(key[2] >= K10)) + __builtin_popcountll(__builtin_amdgcn_ballot_w64(key[3] >= K10));
            if (c05 >= 8 && c10 < 8) { T = K05; bstart = (c05 == 8) ? -1 : 22; }
        }
#pragma unroll 1
        for (int bbit = bstart; bbit >= 0; --bbit) {
            const unsigned cand = T | (1u << bbit);
            const int c = __builtin_popcountll(__builtin_amdgcn_ballot_w64(key[0] >= cand)) + __builtin_popcountll(__builtin_amdgcn_ballot_w64(key[1] >= cand))
                        + __builtin_popcountll(__builtin_amdgcn_ballot_w64(key[2] >= cand)) + __builtin_popcountll(__builtin_amdgcn_ballot_w64(key[3] >= cand));
            if (c >= 8) { T = cand; if (c == 8) break; }
        }
        unsigned long long m0 = __builtin_amdgcn_ballot_w64(key[0] > T), m1 = __builtin_amdgcn_ballot_w64(key[1] > T);
        unsigned long long m2 = __builtin_amdgcn_ballot_w64(key[2] > T), m3 = __builtin_amdgcn_ballot_w64(key[3] > T);
        unsigned long long q0 = __builtin_amdgcn_ballot_w64(key[0] == T), q1 = __builtin_amdgcn_ballot_w64(key[1] == T);
        unsigned long long q2 = __builtin_amdgcn_ballot_w64(key[2] == T), q3 = __builtin_amdgcn_ballot_w64(key[3] == T);
        const int need = 8 - (__builtin_popcountll(m0) + __builtin_popcountll(m1) + __builtin_popcountll(m2) + __builtin_popcountll(m3));
        for (int drop = __builtin_popcountll(q0) + __builtin_popcountll(q1) + __builtin_popcountll(q2) + __builtin_popcountll(q3) - need; drop > 0; --drop) {
            const int e0 = q0 ? (63 - __builtin_clzll(q0)) * 4 + 0 : -1, e1 = q1 ? (63 - __builtin_clzll(q1)) * 4 + 1 : -1;
            const int e2 = q2 ? (63 - __builtin_clzll(q2)) * 4 + 2 : -1, e3 = q3 ? (63 - __builtin_clzll(q3)) * 4 + 3 : -1;
            const int best = max(max(e0, e1), max(e2, e3));
            const unsigned long long keep = ~(1ull << (best >> 2));
            if ((best & 3) == 0) q0 &= keep; else if ((best & 3) == 1) q1 &= keep; else if ((best & 3) == 2) q2 &= keep; else q3 &= keep;
        }
        m0 |= q0; m1 |= q1; m2 |= q2; m3 |= q3;
        float wsel = 0.f; int esel = 0; float wsum = 0.f;
        {
            int n = 0;
#define R_PICK(I, M) { unsigned long long mm = (M); \
                while (mm) { const int l = __builtin_ctzll(mm); mm &= mm - 1ull; const float sv = rlanef(sc[I], l); wsum += sv; if (lane == n) { wsel = sv; esel = l * 4 + (I); } ++n; } }
            R_PICK(0, m0) R_PICK(1, m1) R_PICK(2, m2) R_PICK(3, m3)
#undef R_PICK
        }
        es[q] = esel; ws[q] = wsel / wsum * 2.5f;
            }
        }
        int rk[8];
#pragma unroll
        for (int q = 0; q < 8; ++q) { rk[q] = 0; if (lane < 8 && tb + q * nb * 4 < NTOK) rk[q] = atomicAdd(&p.cnt[(bid & 31) * NEXP + es[q]], 1); }
#pragma unroll
        for (int q = 0; q < 8; ++q) { const int t = tb + q * nb * 4; if (lane < 8 && t < NTOK) { p.eidx[t * 8 + lane] = es[q]; p.ew[t * 8 + lane] = ws[q]; p.erank[t * 8 + lane] = rk[q]; } }
    }
}
__device__ __forceinline__ void phase_scatter(char* lds, int bid, int nb, const P& p) {
    int* base = (int*)lds;
    int* pc = base + 260;
    int* so = base + 520;
    int* rc = so + 32 * 256;
    const int tid = tidx();
    __syncthreads();
    { int c = 0;
#pragma unroll
      for (int sb = 0; sb < 32; ++sb) { so[sb * 256 + tid] = c; c += p.cnt[sb * NEXP + tid]; }
      pc[tid] = (c + 127) & ~127; rc[tid] = c; }
    __syncthreads();
    { int s = 0; for (int e = 0; e < tid; ++e) s += pc[e]; base[tid] = s; if (tid == 255) base[256] = s + pc[255]; }
    __syncthreads();
    const int tpb = nb * 4;
    for (int a = bid * 256 + tid; a < NTOK * 8; a += nb * 256) {
        const int e = p.eidx[a]; const int t = a >> 3; const int sb = ((t % tpb) >> 2) & 31;
        const int row = base[e] + so[sb * 256 + e] + p.erank[a];
        p.rowtok[row] = t; p.epos[a] = row;
    }
    if (bid == 0) {
        {
            const int xq = tid & 7; int off = 0, tot = 0;
            for (int e = xq; e < 256; e += 8) { const int n = ((pc[e] >> 7) + 1) >> 1; if (e < tid) off += n; tot += n; }
            const int t0 = base[tid] >> 7, nte = pc[tid] >> 7;
            for (int i = 0; i < nte; i += 2) { const int vr = min(256, rc[tid] - 128 * i);
                p.plist[xq * 320 + off + (i >> 1)] = (t0 + i) | (((vr + 15) >> 4) << 16) | ((i + 1 < nte) ? 0 : 0x40000000); }
            if (tid < 64) { int totp = 0; for (int e = (tid & 7); e < 256; e += 8) totp += ((pc[e] >> 7) + 1) >> 1; p.plist[(tid & 7) * 320 + totp + (tid >> 3)] = (SH_TILE0 + 2 * tid) | (16 << 16); }
            if (tid < 8) p.plen[tid] = tot + 8;
        }
        const int nrt = base[256] >> 7;
        for (int i = tid; i < NTILES; i += 256) if (i >= nrt) p.tile_e[i] = (i >= SH_TILE0) ? NEXP : -1;
        const int t0 = base[tid] >> 7, t1 = base[tid + 1] >> 7;
        for (int i = t0; i < t1; ++i) p.tile_e[i] = tid;
    }
    __syncthreads();
}
__device__ __forceinline__ void phase_moe1(char* lds, int bid, int nb, const P& p, int layer, const bf16_t* Xb) {
    const int tid = tidx(), lane = tid & 63, wid = tid >> 6, wr = wid >> 1, wc = wid & 1, fr = lane & 15, fq = lane >> 4;
    const int xq = bid & 7, tot = p.plen[xq] * 4, stp = nb >> 3;
    int Rr[4], Cc[4];
#pragma unroll
    for (int i = 0; i < 4; ++i) dma_rc32(lane, wid + 4 * i, Rr[i], Cc[i]);
    int ui = bid >> 3;
    int ent0 = 0, e0 = 0, tok0[4] = {0, 0, 0, 0}, ent1 = 0;
    if (ui < tot) { ent0 = p.plist[xq * 320 + (ui >> 2)]; const int t0 = ent0 & 0xffff, t1 = ((ent0 >> 30) & 1) ? t0 : t0 + 1; e0 = p.tile_e[t0];
#pragma unroll
        for (int i = 0; i < 4; ++i) tok0[i] = p.rowtok[(Rr[i] < 128 ? t0 : t1) * 128 + (Rr[i] & 127)]; }
    if (ui + stp < tot) ent1 = p.plist[xq * 320 + ((ui + stp) >> 2)];
    for (; ui < tot; ui += stp) {
        const int nt = ui & 3;
        const int ent = ent0, e = e0;
        const int tile0 = ent & 0xffff, single = (ent >> 30) & 1, tile1 = single ? tile0 : tile0 + 1;
        Dma3A al; al.base = (const char*)Xb;
#pragma unroll
        for (int i = 0; i < 4; ++i) al.voff[i] = (unsigned)(((size_t)tok0[i] * DM + Cc[i]) * 2);
        if (ui + stp < tot) { ent0 = ent1; const int t0 = ent0 & 0xffff, t1 = ((ent0 >> 30) & 1) ? t0 : t0 + 1; e0 = p.tile_e[t0];
#pragma unroll
            for (int i = 0; i < 4; ++i) tok0[i] = p.rowtok[(Rr[i] < 128 ? t0 : t1) * 128 + (Rr[i] & 127)]; }
        if (ui + 2 * stp < tot) ent1 = p.plist[xq * 320 + ((ui + 2 * stp) >> 2)];
        const float* Wg = (e < NEXP) ? p.w_gate + ((size_t)layer * NEXP + e) * (DM * 256) : p.ws_gate + (size_t)layer * (DM * 256);
        const float* Wu = (e < NEXP) ? p.w_up + ((size_t)layer * NEXP + e) * (DM * 256) : p.ws_up + (size_t)layer * (DM * 256);
        Reg3B bl; { const int nq = tid & 31, kg = tid >> 5; const int j = nq * 4, jw = j & 63, w2 = j >> 6; const int col = nt * 64 + w2 * 32 + (jw & 31);
            bl.ldb = 256; bl.bp = ((jw >= 32) ? Wu : Wg) + (size_t)(kg * 4) * 256 + col; }
        f32x4 acc[32];
        { const int nf = (ent >> 16) & 31, w_ = __builtin_amdgcn_readfirstlane(wid); al.np = nf > w_ ? min(4, ((nf - 1 - w_) >> 2) + 1) : 0; }
        gemm_core4(al, bl, DM / 32, acc, single != 0, 4 - al.np);
        if (!(wr && single)) {
            const int tile = wr ? tile1 : tile0;
#pragma unroll
            for (int i = 0; i < 8; ++i)
                {
                    const int row = tile * 128 + i * 16 + fr, col = nt * 64 + wc * 32 + fq * 8;
                    const f32x4 g0 = acc[i * 4 + 0], g1 = acc[i * 4 + 1], u0 = acc[i * 4 + 2], u1 = acc[i * 4 + 3];
                    u32x4 w;
                    w.x = pack2(siluf_(g0[0]) * u0[0], siluf_(g0[1]) * u0[1]); w.y = pack2(siluf_(g0[2]) * u0[2], siluf_(g0[3]) * u0[3]);
                    w.z = pack2(siluf_(g1[0]) * u1[0], siluf_(g1[1]) * u1[1]); w.w = pack2(siluf_(g1[2]) * u1[2], siluf_(g1[3]) * u1[3]);
                    *(u32x4*)(p.H + (size_t)row * 256 + col) = w;
                }
        }
    }
}
__device__ __forceinline__ void phase_moe2(char* lds, int bid, int nb, const P& p, int layer) {
    const int tid = tidx(), lane = tid & 63, wid = tid >> 6, wr = wid >> 1, wc = wid & 1, fr = lane & 15, fq = lane >> 4;
    const int xq = bid & 7, tot = p.plen[xq] * 8, stp = nb >> 3;
    int Rr[4], Cc[4];
#pragma unroll
    for (int i = 0; i < 4; ++i) dma_rc32(lane, wid + 4 * i, Rr[i], Cc[i]);
    int ui = bid >> 3;
    int ent0 = 0, e0 = 0, ent1 = 0;
    if (ui < tot) { ent0 = p.plist[xq * 320 + (ui >> 3)]; e0 = p.tile_e[ent0 & 0xffff]; }
    if (ui + stp < tot) ent1 = p.plist[xq * 320 + ((ui + stp) >> 3)];
    for (; ui < tot; ui += stp) {
        const int nt = ui & 7;
        const int ent = ent0, e = e0;
        const int tile0 = ent & 0xffff, single = (ent >> 30) & 1, tile1 = single ? tile0 : tile0 + 1;
        if (ui + stp < tot) { ent0 = ent1; e0 = p.tile_e[ent0 & 0xffff]; }
        if (ui + 2 * stp < tot) ent1 = p.plist[xq * 320 + ((ui + 2 * stp) >> 3)];
        const float* Wd = (e < NEXP) ? p.w_down + ((size_t)layer * NEXP + e) * (256 * DM) : p.ws_down + (size_t)layer * (256 * DM);
        Dma3A al; al.base = (const char*)p.H;
#pragma unroll
        for (int i = 0; i < 4; ++i) al.voff[i] = (unsigned)(((size_t)((Rr[i] < 128 ? tile0 : tile1) * 128 + (Rr[i] & 127)) * 256 + Cc[i]) * 2);
        Reg3B bl; { const int nq = tid & 31, kg = tid >> 5; bl.ldb = DM; bl.perm64 = 1; bl.bp = Wd + (size_t)(kg * 4) * DM + nt * 128 + nq * 4; }
        f32x4 acc[32];
        { const int nf = (ent >> 16) & 31, w_ = __builtin_amdgcn_readfirstlane(wid); al.np = nf > w_ ? min(4, ((nf - 1 - w_) >> 2) + 1) : 0; }
        gemm_core4(al, bl, 256 / 32, acc, single != 0, 4 - al.np);
        if (!(wr && single)) {
            const int tile = wr ? tile1 : tile0;
#pragma unroll
            for (int i = 0; i < 8; ++i)
                {
                    const int row = tile * 128 + i * 16 + fr, col = nt * 128 + wc * 64 + fq * 16;
                    u32x4 wv;
#pragma unroll
                    for (int j = 0; j < 4; ++j) {
                        f32x4 a = acc[i * 4 + j] * 64.0f;
#pragma unroll
                        for (int c = 0; c < 4; ++c) a[c] = fminf(fmaxf(a[c], -448.0f), 448.0f);
                        int w0 = 0;
                        w0 = __builtin_amdgcn_cvt_pk_fp8_f32(a[0], a[1], w0, false); w0 = __builtin_amdgcn_cvt_pk_fp8_f32(a[2], a[3], w0, true);
                        wv[j] = (unsigned)w0;
                    }
                    *(u32x4*)((char*)p.Y + (size_t)row * DM + col) = wv;
                }
        }
    }
}
__device__ __forceinline__ void phase_combine_ln(int bid, int nb, const P& p, const float* X, const float* g, const float* b, float* of, bf16_t* ob, bf16_t* ol) {
    const int lane = tidx() & 63, wid = tidx() >> 6;
    int row = bid * 4 + wid;
    int npos = 0; float nw = 0.f;
    if (row < NTOK && lane < 8) { npos = p.epos[row * 8 + lane]; nw = p.ew[row * 8 + lane]; }
    for (; row < NTOK; row += nb * 4) {
        const int cpos = npos; const float cw = nw;
        { const int nr = row + nb * 4; if (nr < NTOK && lane < 8) { npos = p.epos[nr * 8 + lane]; nw = p.ew[nr * 8 + lane]; } }
        float v[16];
#pragma unroll
        for (int h = 0; h < 2; ++h) {
            const size_t o = (size_t)row * DM + h * 512 + lane * 8;
            const u32x4 xh = *(const u32x4*)(p.XAb + o);
            v[h * 8 + 0] = DN_ALPHA * bf2f(xh.x & 0xffffu); v[h * 8 + 1] = DN_ALPHA * bf2f(xh.x >> 16);
            v[h * 8 + 2] = DN_ALPHA * bf2f(xh.y & 0xffffu); v[h * 8 + 3] = DN_ALPHA * bf2f(xh.y >> 16);
            v[h * 8 + 4] = DN_ALPHA * bf2f(xh.z & 0xffffu); v[h * 8 + 5] = DN_ALPHA * bf2f(xh.z >> 16);
            v[h * 8 + 6] = DN_ALPHA * bf2f(xh.w & 0xffffu); v[h * 8 + 7] = DN_ALPHA * bf2f(xh.w >> 16);
        }
#pragma unroll
        for (int k = 0; k < 9; ++k) {
            const int yr = (k < 8) ? __shfl(cpos, k) : (SH_TILE0 * 128 + row);
            const float w = (k < 8) ? __shfl(cw, k) : 1.0f;
#pragma unroll
            for (int h = 0; h < 2; ++h) {
                const u32x2 y = *(const u32x2*)((const char*)p.Y + (size_t)yr * DM + h * 512 + lane * 8);
                typedef float f32x2v __attribute__((ext_vector_type(2)));
                const f32x2v y0 = __builtin_amdgcn_cvt_pk_f32_fp8((int)y.x, false), y1 = __builtin_amdgcn_cvt_pk_f32_fp8((int)y.x, true);
                const f32x2v y2 = __builtin_amdgcn_cvt_pk_f32_fp8((int)y.y, false), y3 = __builtin_amdgcn_cvt_pk_f32_fp8((int)y.y, true);
                const float ws = w * (1.0f / 64.0f);
                v[h * 8 + 0] += ws * y0.x; v[h * 8 + 1] += ws * y0.y; v[h * 8 + 2] += ws * y1.x; v[h * 8 + 3] += ws * y1.y;
                v[h * 8 + 4] += ws * y2.x; v[h * 8 + 5] += ws * y2.y; v[h * 8 + 6] += ws * y3.x; v[h * 8 + 7] += ws * y3.y;
            }
        }
        ln_row_store(v, g, b, of, ob, row, lane, ol);
    }
}

__device__ __forceinline__ void phase_moba_kmean(int bid, int nb, const P& p) {
    const int tid = tidx();
    for (int u = (nb >= 256 ? bid - 128 : bid); u < NBATCH * 8; u += nb) {
        if (u < 0) continue;
        const int b = u >> 3, j = u & 7;
        const bf16_t* src = p.MK + (size_t)(b * SEQ + j * 256) * 512 + tid * 2;
        float s0 = 0.f, s1 = 0.f;
        for (int r8 = 0; r8 < 256; r8 += 8) {
            unsigned v[8];
#pragma unroll
            for (int i = 0; i < 8; ++i) v[i] = *(const unsigned*)(src + (size_t)(r8 + i) * 512);
#pragma unroll
            for (int i = 0; i < 8; ++i) { s0 += bf2f(v[i] & 0xffffu); s1 += bf2f(v[i] >> 16); }
        }
        const int h = tid >> 5, d = (tid & 31) * 2;
        p.KM[((size_t)(b * 8 + h) * 8 + j) * 64 + d] = s0 * (1.0f / 256.0f);
        p.KM[((size_t)(b * 8 + h) * 8 + j) * 64 + d + 1] = s1 * (1.0f / 256.0f);
    }
}
__device__ __forceinline__ void gemm_t_unit(const bf16_t* Wt, int wrow0, const bf16_t* X, int tok0, bf16_t* dst, int ncol, int col0) {
    const int tid = tidx(), lane = tid & 63, wid = tid >> 6, wr = wid >> 1, wc = wid & 1, fr = lane & 15, fq = lane >> 4;
    Dma3A al; al.set_dense(Wt, wrow0, DM); Dma3B bl; bl.set(X, X, tok0, DM, 1 << 30);
    f32x4 acc[32];
    gemm_core4(al, bl, DM / 32, acc);
#pragma unroll
    for (int i = 0; i < 8; ++i)
#pragma unroll
        for (int gg = 0; gg < 2; ++gg) {
            const int vc = col0 + wr * 128 + i * 16 + fr, r0 = tok0 + wc * 64 + gg * 32 + fq * 8;
            const int b = r0 >> 11, t0 = r0 & (SEQ - 1);
            const f32x4 a = acc[i * 4 + 2 * gg], b2 = acc[i * 4 + 2 * gg + 1];
            u32x4 w; w.x = pack2(a[0], a[1]); w.y = pack2(a[2], a[3]); w.z = pack2(b2[0], b2[1]); w.w = pack2(b2[2], b2[3]);
            *(u32x4*)(dst + ((size_t)(b * ncol + vc)) * SEQ + t0) = w;
        }
}
__device__ __forceinline__ void phase_inproj0(char* lds, int bid, int nb, const P& p) {
    const int ntn = 20, nk = DM / 32;
    const int tid = tidx(), lane = tid & 63, wid = tid >> 6, wr = wid >> 1, wc = wid & 1, fr = lane & 15, fq = lane >> 4;
    for (int i = bid * 256 + tid; i < 2 * 8 * 64 * 64; i += nb * 256) {
        const int which = i >> 15, e = i & 32767, h = e >> 12, j = (e >> 6) & 63, ii = e & 63;
        const float v = (which ? p.wx : p.wa)[(h * 64 + ii) * 64 + j];
        (which ? p.WXT : p.WAT)[e] = (bf16_t)f2bf(v);
    }
    for (int jj = 0;; ++jj) {
        int tm, tn; if (!dense_unit3(bid, nb, jj, ntn, tm, tn)) break;
        Dma3A al; al.set_dense(p.XIb, tm * 256, DM); Dma3B bl; bl.set(p.WIN0, p.WIN0, tn * 128, DM, 1 << 30);
        f32x4 acc[32];
        gemm_core4(al, bl, nk, acc);
#pragma unroll
        for (int i = 0; i < 8; ++i)
#pragma unroll
            for (int gg = 0; gg < 2; ++gg) {
                const int row = tm * 256 + wr * 128 + i * 16 + fr, col = tn * 128 + wc * 64 + gg * 32 + fq * 8;
                const f32x4 a = acc[i * 4 + 2 * gg], b2 = acc[i * 4 + 2 * gg + 1];
                u32x4 w; w.x = pack2(a[0], a[1]); w.y = pack2(a[2], a[3]); w.z = pack2(b2[0], b2[1]); w.w = pack2(b2[2], b2[3]);
                *(u32x4*)(p.UB0 + (size_t)row * 2560 + col) = w;
            }
    }
    for (int u = (nb >= 512 ? bid - 256 : bid); u < 2 * 128; u += nb) { if (u < 0) continue; const int pn = u & 1, tt = u >> 1; gemm_t_unit(p.WIN0, 2560 + pn * 256, p.XIb, tt * 128, p.VHt, 512, pn * 256); }
}

__device__ __forceinline__ int lds_off128(int r, int c) {
    const int st = (r >> 4) * 4 + (c >> 5), ob = (r & 15) * 64 + (c & 31) * 2;
    return st * 1024 + (ob ^ (((ob >> 9) & 1) << 5));
}
__device__ __forceinline__ float softplusf_(float x) { return fmaxf(x, 0.f) + log1pf(__expf(-fabsf(x))); }

#define LRU1_LDS (4 * 8192)
__device__ __forceinline__ void lru1_unit(char* lds, const P& p, int b, int ck, int half) {
    const int tid = tidx(), lane = tid & 63, w = tid >> 6, fr = lane & 15, fg = lane >> 4;
    char* xt = lds + w * 8192;
    const size_t n0 = (size_t)b * SEQ + ck * 64;
    __syncthreads();
    {
        const int h = half * 4 + w, c = h * 64 + lane;
        const float cw0 = p.conv_w[c], cw1 = p.conv_w[512 + c], cw2 = p.conv_w[1024 + c], cw3 = p.conv_w[1536 + c], cb = p.conv_b[c];
        float xm3 = 0.f, xm2 = 0.f, xm1 = 0.f;
        if (ck > 0) { xm3 = bf2f(p.UB0[(n0 - 3) * 2560 + c]); xm2 = bf2f(p.UB0[(n0 - 2) * 2560 + c]); xm1 = bf2f(p.UB0[(n0 - 1) * 2560 + c]); }
        __builtin_amdgcn_wave_barrier();
        for (int t16 = 0; t16 < 64; t16 += 16) {
            bf16_t raw[16];
#pragma unroll
            for (int i = 0; i < 16; ++i) raw[i] = p.UB0[(n0 + t16 + i) * 2560 + c];
#pragma unroll
            for (int i = 0; i < 16; ++i) {
                const float x = bf2f(raw[i]);
                const float xc = cb + cw0 * xm3 + cw1 * xm2 + cw2 * xm1 + cw3 * x;
                xm3 = xm2; xm2 = xm1; xm1 = x;
                *(bf16_t*)(xt + lds_off(t16 + i, lane & ~7) + (lane & 7) * 2) = (bf16_t)f2bf(xc);
            }
        }
        __builtin_amdgcn_wave_barrier();
        for (int jt = 0; jt < 4; ++jt) {
            const int cj = h * 64 + jt * 16 + fr;
            bf16x8 wra[2], wri[2];
#pragma unroll
            for (int ks = 0; ks < 2; ++ks) {
                wra[ks] = *(const bf16x8*)(p.WAT + (size_t)(h * 64 + jt * 16 + fr) * 64 + ks * 32 + fg * 8);
                wri[ks] = *(const bf16x8*)(p.WXT + (size_t)(h * 64 + jt * 16 + fr) * 64 + ks * 32 + fg * 8);
            }
            const float bav = p.ba[cj], bxv = p.bx[cj], sp = softplusf_(-p.lam[cj]);
            float mA = 1.f, mB = 0.f;
#pragma unroll
            for (int tt = 0; tt < 4; ++tt) {
                const bf16x8 a0 = *(const bf16x8*)(xt + lds_off(tt * 16 + fr, fg * 8)), a1 = *(const bf16x8*)(xt + lds_off(tt * 16 + fr, 32 + fg * 8));
                f32x4 ar = __builtin_amdgcn_mfma_f32_16x16x32_bf16(a0, wra[0], (f32x4){0.f, 0.f, 0.f, 0.f}, 0, 0, 0);
                ar = __builtin_amdgcn_mfma_f32_16x16x32_bf16(a1, wra[1], ar, 0, 0, 0);
                f32x4 ai = __builtin_amdgcn_mfma_f32_16x16x32_bf16(a0, wri[0], (f32x4){0.f, 0.f, 0.f, 0.f}, 0, 0, 0);
                ai = __builtin_amdgcn_mfma_f32_16x16x32_bf16(a1, wri[1], ai, 0, 0, 0);
                float sA = 1.f, sB = 0.f;
#pragma unroll
                for (int r = 0; r < 4; ++r) {
                    const int t = tt * 16 + fg * 4 + r;
                    const float rg = sigmoidf_(ar[r] + bav), ig = sigmoidf_(ai[r] + bxv);
                    const float log_a = -8.0f * rg * sp;
                    const float a = __expf(log_a);
                    const float mult = (ck == 0 && t == 0) ? 1.0f : sqrtf(fmaxf(1.0f - a * a, 0.f));
                    const int jj = jt * 16 + fr;
                    const float xcv = bf2f(*(const bf16_t*)(xt + lds_off(t, jj & ~7) + (jj & 7) * 2));
                    const float bt = mult * ig * xcv;
                    p.LA[(n0 + t) * 512 + cj] = a; p.LB[(n0 + t) * 512 + cj] = bt;
                    sB = a * sB + bt; sA = a * sA;
                }
                float tA = 1.f, tB = 0.f;
#pragma unroll
                for (int g2 = 0; g2 < 4; ++g2) {
                    const float oA = __shfl(sA, g2 * 16 + fr), oB = __shfl(sB, g2 * 16 + fr);
                    tB = oA * tB + oB; tA = oA * tA;
                }
                mB = tA * mB + tB; mA = tA * mA;
            }
            if (fg == 0) { p.CSA[((size_t)b * 32 + ck) * 512 + cj] = mA; p.CSB[((size_t)b * 32 + ck) * 512 + cj] = mB; }
        }
        __builtin_amdgcn_wave_barrier();
    }
}
__device__ __forceinline__ void lru2_unit(const P& p, int b, int ck, int half) {
    const int tid = tidx();
    const size_t n0 = (size_t)b * SEQ + ck * 64;
    {
        const int c = tid + 256 * half;
        float h = 0.f;
        for (int c8 = 0; c8 < ck; c8 += 8) {
            float ca[8], cb[8];
#pragma unroll
            for (int i = 0; i < 8; ++i) { const bool ok = c8 + i < ck; ca[i] = ok ? p.CSA[((size_t)b * 32 + c8 + i) * 512 + c] : 1.f; cb[i] = ok ? p.CSB[((size_t)b * 32 + c8 + i) * 512 + c] : 0.f; }
#pragma unroll
            for (int i = 0; i < 8; ++i) h = ca[i] * h + cb[i];
        }
        for (int t8 = 0; t8 < 64; t8 += 8) {
            float la[8], lb[8], gb[8];
#pragma unroll
            for (int i = 0; i < 8; ++i) { la[i] = p.LA[(n0 + t8 + i) * 512 + c]; lb[i] = p.LB[(n0 + t8 + i) * 512 + c]; gb[i] = bf2f(p.UB0[(n0 + t8 + i) * 2560 + 512 + c]); }
#pragma unroll
            for (int i = 0; i < 8; ++i) { h = la[i] * h + lb[i]; p.MIX[(n0 + t8 + i) * DM + c] = (bf16_t)f2bf(h * gelu_tanh(gb[i])); }
        }
    }
}

#define HG1_LDS (2 * 16384)
__device__ __forceinline__ float hg_lb(const P& p, int ch) {
    const float l0 = p.hg_lb[ch], l1 = p.hg_lb[512 + ch], l2 = p.hg_lb[1024 + ch]; const float mx = fmaxf(l0, fmaxf(l1, l2));
    const float e0 = __expf(l0 - mx), e1 = __expf(l1 - mx), e2 = __expf(l2 - mx); return e0 / (e0 + e1 + e2);
}
__device__ __forceinline__ void hg1_unit(char* lds, const P& p, int b, int h, int ck) {
    const int tid = tidx(), lane = tid & 63, w = tid >> 6, fr = lane & 15, fg = lane >> 4;
    char* kh = lds;
    char* vt = lds + 16384;
    const size_t n0 = (size_t)b * SEQ + ck * 64;
    const int bhc = (b * 4 + h) * 32 + ck;
    __syncthreads();
    if (tid < 128) {
        const int k = tid, ch = h * 128 + k;
        const float lbv = hg_lb(p, ch);
        float f[64];
#pragma unroll
        for (int t16 = 0; t16 < 64; t16 += 16) {
            bf16_t raw[16];
#pragma unroll
            for (int i = 0; i < 16; ++i) raw[i] = p.UB0[(n0 + t16 + i) * 2560 + 1536 + ch];
#pragma unroll
            for (int i = 0; i < 16; ++i) f[t16 + i] = lbv + (1.0f - lbv) * sigmoidf_(bf2f(raw[i]));
        }
        float suf = 1.0f;
#pragma unroll
        for (int t8 = 56; t8 >= 0; t8 -= 8) {
            float kv[8];
#pragma unroll
            for (int i = 7; i >= 0; --i) { kv[i] = (1.0f - f[t8 + i]) * suf; suf *= f[t8 + i]; }
            u32x4 wv; wv.x = pack2(kv[0], kv[1]); wv.y = pack2(kv[2], kv[3]); wv.z = pack2(kv[4], kv[5]); wv.w = pack2(kv[6], kv[7]);
            *(u32x4*)(kh + lds_off(k, t8)) = wv;
        }
        p.DV[(size_t)bhc * 128 + k] = suf;
    } else {
        const int q = tid - 128;
#pragma unroll
        for (int i = 0; i < 8; ++i) { const int pc = q + 128 * i, v = pc >> 3, c8 = pc & 7;
            *(u32x4*)(vt + lds_off(v, c8 * 8)) = *(const u32x4*)(p.VHt + ((size_t)(b * 512 + h * 128 + v)) * SEQ + ck * 64 + c8 * 8); }
    }
    __syncthreads();
    bf16_t* ut = p.UT + (size_t)bhc * 16384;
#pragma unroll
    for (int kk = 0; kk < 2; ++kk) {
        const int kt = w * 2 + kk;
        const bf16x8 a0 = *(const bf16x8*)(kh + lds_off(kt * 16 + fr, fg * 8)), a1 = *(const bf16x8*)(kh + lds_off(kt * 16 + fr, 32 + fg * 8));
#pragma unroll
        for (int v8 = 0; v8 < 8; ++v8) {
            const bf16x8 b0 = *(const bf16x8*)(vt + lds_off(v8 * 16 + fr, fg * 8)), b1 = *(const bf16x8*)(vt + lds_off(v8 * 16 + fr, 32 + fg * 8));
            f32x4 acc = __builtin_amdgcn_mfma_f32_16x16x32_bf16(a0, b0, (f32x4){0.f, 0.f, 0.f, 0.f}, 0, 0, 0);
            acc = __builtin_amdgcn_mfma_f32_16x16x32_bf16(a1, b1, acc, 0, 0, 0);
            u32x2 wv; wv.x = pack2(acc[0], acc[1]); wv.y = pack2(acc[2], acc[3]);
            *(u32x2*)(ut + (size_t)(v8 * 16 + fr) * 128 + kt * 16 + fg * 4) = wv;
        }
    }
}
__device__ __forceinline__ void phase_hg2(int bid, int nb, const P& p) {
    for (int it = bid * 256 + tidx(); it < 32 * 4096; it += nb * 256) {
        const int bh = it >> 12, e4 = (it & 4095) * 4, k4 = e4 & 127;
        float S0 = 0.f, S1 = 0.f, S2 = 0.f, S3 = 0.f;
        for (int c8 = 0; c8 < 32; c8 += 8) {
            u32x2 uv[8]; f32x4 dv[8];
#pragma unroll
            for (int i = 0; i < 8; ++i) { uv[i] = *(const u32x2*)(p.UT + ((size_t)(bh * 32 + c8 + i)) * 16384 + e4); dv[i] = *(const f32x4*)(p.DV + (size_t)(bh * 32 + c8 + i) * 128 + k4); }
#pragma unroll
            for (int i = 0; i < 8; ++i) {
                u32x2 wv; wv.x = pack2(S0, S1); wv.y = pack2(S2, S3);
                *(u32x2*)(p.SP + ((size_t)(bh * 32 + c8 + i)) * 16384 + e4) = wv;
                S0 = dv[i][0] * S0 + bf2f(uv[i].x & 0xffffu); S1 = dv[i][1] * S1 + bf2f(uv[i].x >> 16);
                S2 = dv[i][2] * S2 + bf2f(uv[i].y & 0xffffu); S3 = dv[i][3] * S3 + bf2f(uv[i].y >> 16);
            }
        }
    }
}
#define HG3_QP 0
#define HG3_KP 40960
#define HG3_VT (40960 + 16384)
#define HG3_LDS (40960 + 16384 + 128 * 144)
__device__ __forceinline__ int hg3_qp_base(int j) { return j == 0 ? 0 : (j == 1 ? 16384 : (j == 2 ? 28672 : 36864)); }
__device__ __forceinline__ void hg3_unit(char* lds, const P& p, int b, int h, int ck) {
    const int tid = tidx(), lane = tid & 63, w = tid >> 6, fr = lane & 15, fg = lane >> 4;
    char* qp = lds + HG3_QP; char* kp = lds + HG3_KP; char* vt = lds + HG3_VT;
    const size_t n0 = (size_t)b * SEQ + ck * 64;
    const int bhc = (b * 4 + h) * 32 + ck;
    __syncthreads();
    if (tid < 128) {
        const int k = tid, ch = h * 128 + k;
        const float lbv = hg_lb(p, ch);
        const int ke = (k & 7) * 2, k8 = k & ~7;
        float d0 = 1.f, d1 = 1.f, d2 = 1.f, d3 = 1.f;
#pragma unroll
        for (int i = 0; i < 4; ++i) {
            bf16_t rq[16], rf[16];
#pragma unroll
            for (int tt = 0; tt < 16; ++tt) { rq[tt] = p.UB0[(n0 + i * 16 + tt) * 2560 + 1024 + ch]; rf[tt] = p.UB0[(n0 + i * 16 + tt) * 2560 + 1536 + ch]; }
#pragma unroll
            for (int tt = 0; tt < 16; ++tt) {
                const int t = i * 16 + tt;
                const float qv = siluf_(bf2f(rq[tt]));
                const float f = lbv + (1.0f - lbv) * sigmoidf_(bf2f(rf[tt]));
                d0 *= f; if (i >= 1) d1 *= f; if (i >= 2) d2 *= f; if (i >= 3) d3 *= f;
                const float di = (i == 0) ? d0 : (i == 1 ? d1 : (i == 2 ? d2 : d3));
                *(bf16_t*)(kp + lds_off128(t, k8) + ke) = (bf16_t)f2bf((1.0f - f) * __builtin_amdgcn_rcpf(fmaxf(di, 1.8e-35f)));
                *(bf16_t*)(qp + hg3_qp_base(0) + lds_off128(t, k8) + ke) = (bf16_t)f2bf(qv * d0);
                if (i >= 1) *(bf16_t*)(qp + hg3_qp_base(1) + lds_off128(t - 16, k8) + ke) = (bf16_t)f2bf(qv * d1);
                if (i >= 2) *(bf16_t*)(qp + hg3_qp_base(2) + lds_off128(t - 32, k8) + ke) = (bf16_t)f2bf(qv * d2);
                if (i >= 3) *(bf16_t*)(qp + hg3_qp_base(3) + lds_off128(t - 48, k8) + ke) = (bf16_t)f2bf(qv * d3);
            }
        }
    } else {
        const int q = tid - 128;
#pragma unroll
        for (int i = 0; i < 8; ++i) { const int pc = q + 128 * i, v = pc >> 3, c8 = pc & 7;
            *(u32x4*)(vt + v * 144 + c8 * 16) = *(const u32x4*)(p.VHt + ((size_t)(b * 512 + h * 128 + v)) * SEQ + ck * 64 + c8 * 8); }
    }
    __syncthreads();
    f32x4 acc[8];
#pragma unroll
    for (int v8 = 0; v8 < 8; ++v8) acc[v8] = (f32x4){0.f, 0.f, 0.f, 0.f};
    if (ck > 0) {
        const bf16_t* sp = p.SP + (size_t)bhc * 16384;
#pragma unroll
        for (int ks = 0; ks < 4; ++ks) {
            const bf16x8 bq = *(const bf16x8*)(qp + hg3_qp_base(0) + lds_off128(w * 16 + fr, ks * 32 + fg * 8));
#pragma unroll
            for (int v8 = 0; v8 < 8; ++v8) {
                const bf16x8 as = *(const bf16x8*)(sp + (size_t)(v8 * 16 + fr) * 128 + ks * 32 + fg * 8);
                acc[v8] = __builtin_amdgcn_mfma_f32_16x16x32_bf16(as, bq, acc[v8], 0, 0, 0);
            }
        }
    }
#pragma unroll
    for (int jp = 0; jp < 2; ++jp) {
        if (2 * jp > w) continue;
        f32x4 at[2];
#pragma unroll
        for (int jj = 0; jj < 2; ++jj) {
            const int j = 2 * jp + jj;
            at[jj] = (f32x4){0.f, 0.f, 0.f, 0.f};
            if (j <= w) {
#pragma unroll
                for (int ks = 0; ks < 4; ++ks) {
                    const bf16x8 ak = *(const bf16x8*)(kp + lds_off128(j * 16 + fr, ks * 32 + fg * 8));
                    const bf16x8 bq = *(const bf16x8*)(qp + hg3_qp_base(j) + lds_off128((w - j) * 16 + fr, ks * 32 + fg * 8));
                    at[jj] = __builtin_amdgcn_mfma_f32_16x16x32_bf16(ak, bq, at[jj], 0, 0, 0);
                }
                if (j == w) {
#pragma unroll
                    for (int r = 0; r < 4; ++r) at[jj][r] = (fg * 4 + r <= fr) ? at[jj][r] : 0.f;
                }
            }
        }
        u32x4 pw; pw.x = pack2(at[0][0], at[0][1]); pw.y = pack2(at[0][2], at[0][3]); pw.z = pack2(at[1][0], at[1][1]); pw.w = pack2(at[1][2], at[1][3]);
        const bf16x8 pf = __builtin_bit_cast(bf16x8, pw);
#pragma unroll
        for (int v8 = 0; v8 < 8; ++v8) {
            const char* vb = vt + (v8 * 16 + fr) * 144 + (jp * 32 + fg * 4) * 2;
            const u32x2 v0 = *(const u32x2*)vb, v1 = *(const u32x2*)(vb + 32);
            u32x4 vv; vv.x = v0.x; vv.y = v0.y; vv.z = v1.x; vv.w = v1.y;
            acc[v8] = __builtin_amdgcn_mfma_f32_16x16x32_bf16(__builtin_bit_cast(bf16x8, vv), pf, acc[v8], 0, 0, 0);
        }
    }
    float ss = 0.f;
#pragma unroll
    for (int v8 = 0; v8 < 8; ++v8)
#pragma unroll
        for (int r = 0; r < 4; ++r) ss += acc[v8][r] * acc[v8][r];
    ss += __shfl_xor(ss, 16); ss += __shfl_xor(ss, 32);
    const float rs = rsqrtf(ss * (1.0f / 128.0f) + 1e-6f);
    const size_t n = n0 + w * 16 + fr;
#pragma unroll
    for (int v8 = 0; v8 < 8; ++v8) {
        const int vcol = h * 128 + v8 * 16 + fg * 4;
        const u32x2 gv = *(const u32x2*)(p.UB0 + n * 2560 + 2048 + vcol);
        const f32x4 ng = *(const f32x4*)(p.hg_ng + vcol);
        const float y0 = acc[v8][0] * rs * ng[0] * sigmoidf_(bf2f(gv.x & 0xffffu)), y1 = acc[v8][1] * rs * ng[1] * sigmoidf_(bf2f(gv.x >> 16));
        const float y2 = acc[v8][2] * rs * ng[2] * sigmoidf_(bf2f(gv.y & 0xffffu)), y3 = acc[v8][3] * rs * ng[3] * sigmoidf_(bf2f(gv.y >> 16));
        u32x2 wv; wv.x = pack2(y0, y1); wv.y = pack2(y2, y3);
        *(u32x2*)(p.MIX + n * DM + 512 + vcol) = wv;
    }
}
__device__ __forceinline__ void phase_mix0_a(char* lds, int bid, int nb, const P& p) {
    for (int u = bid; u < 512 + 1024; u += nb) {
        if (u < 512) lru1_unit(lds, p, u >> 6, (u >> 1) & 31, u & 1);
        else { const int v = u - 512; hg1_unit(lds, p, v >> 7, (v >> 5) & 3, v & 31); }
    }
    __syncthreads();
}
__device__ __forceinline__ void phase_mix0_c(char* lds, int bid, int nb, const P& p) {
    for (int u = bid; u < 1024; u += nb) hg3_unit(lds, p, u >> 7, (u >> 5) & 3, u & 31);
    __syncthreads();
}

#ifndef KEEP_U
#define KEEP_U 0
#endif
__device__ __forceinline__ int vcol_actual(int v) { return v < 1280 ? v : (v < 2816 ? v + 24 : v - 1536); }
__device__ __forceinline__ void phase_inproj1(char* lds, int bid, int nb, const P& p) {
    const int ntn = 17, nk = DM / 32;
    const int tid = tidx(), lane = tid & 63, wid = tid >> 6, wr = wid >> 1, wc = wid & 1, fr = lane & 15, fq = lane >> 4;
    for (int jj = 0;; ++jj) {
        int tm, tn; if (!dense_unit3(bid, nb, jj, ntn, tm, tn)) break;
        Dma3A al; al.set_dense(p.XBb, tm * 256, DM); Dma3B bl; bl.set(p.WIN1, p.WIN1, tn * 128, DM, 1 << 30);
        f32x4 acc[32];
        gemm_core4(al, bl, nk, acc);
#pragma unroll
        for (int i = 0; i < 8; ++i)
#pragma unroll
            for (int gg = 0; gg < 2; ++gg) {
                const int row = tm * 256 + wr * 128 + i * 16 + fr, vc = tn * 128 + wc * 64 + gg * 32 + fq * 8;
                const f32x4 a = acc[i * 4 + 2 * gg], b2 = acc[i * 4 + 2 * gg + 1];
                u32x4 w; w.x = pack2(a[0], a[1]); w.y = pack2(a[2], a[3]); w.z = pack2(b2[0], b2[1]); w.w = pack2(b2[2], b2[3]);
                if (tn < 4) *(u32x4*)(p.Qb + (size_t)row * 512 + vc) = w;
                else if (tn < 6) { *(f32x4*)(p.KCV + (size_t)row * 256 + vc - 512) = a; *(f32x4*)(p.KCV + (size_t)row * 256 + vc - 512 + 4) = b2; }
                else if (tn == 6) *(u32x4*)(p.KS + (size_t)row * 128 + vc - 768) = w;
                else if (tn == 7) *(u32x4*)(p.KW + (size_t)row * 128 + vc - 896) = w;
                else if (tn < 12) *(u32x4*)(p.MQ + (size_t)row * 512 + vc - 1024) = w;
                else if (tn < 16) *(u32x4*)(p.MK + (size_t)row * 512 + vc - 1536) = w;
                else if (vc < 2072) { *(f32x4*)(p.GATES + (size_t)row * 24 + vc - 2048) = a; *(f32x4*)(p.GATES + (size_t)row * 24 + vc - 2048 + 4) = b2; }
            }
    }
    for (int u = (nb >= 512 ? bid - 64 : bid); u < 3 * 128; u += nb) {
        if (u < 0) continue;
        const int pn = u % 3, tt = u / 3;
        if (pn == 0) {
            const int wrr = tidx() >> 7;
            gemm_t_unit(p.WIN1, 2176, p.XBb, tt * 128, wrr ? p.VWt - (size_t)128 * SEQ : p.VSt, 128, 0);
        } else gemm_t_unit(p.WIN1, 2432 + (pn - 1) * 256, p.XBb, tt * 128, p.MVt, 512, (pn - 1) * 256);
    }
}
__device__ __forceinline__ void phase_moba_gate(char* lds, int bid, int nb, const P& p) {
    const int lane = tidx() & 63, wid = tidx() >> 6;
    float* km = (float*)lds + 4096 + wid * 512;
    for (int it = bid * 4 + wid; it < 64 * 32; it += nb * 4) {
        const int bh = it >> 5, tb = it & 31, b = bh >> 3, h = bh & 7;
        const int t = tb * 64 + lane, ob = t >> 8;
        __builtin_amdgcn_wave_barrier();
#pragma unroll
        for (int i = 0; i < 8; ++i) km[i * 64 + lane] = p.KM[(size_t)bh * 512 + i * 64 + lane];
        __builtin_amdgcn_wave_barrier();
        u32x4 qr[8];
#pragma unroll
        for (int i = 0; i < 8; ++i) qr[i] = *(const u32x4*)(p.MQ + (size_t)(b * SEQ + t) * 512 + h * 64 + i * 8);
        float gate[8];
#pragma unroll
        for (int j = 0; j < 8; ++j) gate[j] = 0.f;
#pragma unroll
        for (int i = 0; i < 8; ++i) {
            float q[8];
            q[0] = bf2f(qr[i].x & 0xffffu); q[1] = bf2f(qr[i].x >> 16); q[2] = bf2f(qr[i].y & 0xffffu); q[3] = bf2f(qr[i].y >> 16);
            q[4] = bf2f(qr[i].z & 0xffffu); q[5] = bf2f(qr[i].z >> 16); q[6] = bf2f(qr[i].w & 0xffffu); q[7] = bf2f(qr[i].w >> 16);
#pragma unroll
            for (int j = 0; j < 8; ++j)
#pragma unroll
                for (int e = 0; e < 8; ++e) gate[j] += q[e] * km[j * 64 + i * 8 + e];
        }
#pragma unroll
        for (int j = 0; j < 8; ++j) gate[j] = (j < ob) ? gate[j] : NEGF;
        unsigned selm = 0;
#pragma unroll
        for (int j = 0; j < 8; ++j) {
            int rank = 0;
#pragma unroll
            for (int j2 = 0; j2 < 8; ++j2) rank += (gate[j2] > gate[j] || (gate[j2] == gate[j] && j2 < j)) ? 1 : 0;
            if (j < ob && rank < 3) selm |= 1u << j;
        }
        p.MSEL[(size_t)bh * SEQ + t] = selm;
    }
}

#define ATT_K_BYTES 8192
#define ATT_STAGE 16384
#define ATT_TILE_BYTES (3 * ATT_STAGE)
#define ATT_ORDER_OFF ATT_TILE_BYTES
#define ATT_RED_OFF (ATT_ORDER_OFF + 8192)
__device__ __forceinline__ void att_issue_tile(int stage, const bf16_t* Kg, int ldk, const bf16_t* Vg) {
    const int lane = tidx() & 63, w = tidx() >> 6;
#pragma unroll
    for (int i = 0; i < 2; ++i) { int R, C; dma_rc(lane, w + 4 * i, R, C);
        __builtin_amdgcn_global_load_lds((const unsigned*)(Kg + (size_t)R * ldk + C), (LAS unsigned*)((LAS char*)dyn_lds + stage * ATT_STAGE + (w + 4 * i) * 1024), 16, 0, 0);
        __builtin_amdgcn_global_load_lds((const unsigned*)(Vg + (size_t)R * SEQ + C), (LAS unsigned*)((LAS char*)dyn_lds + stage * ATT_STAGE + ATT_K_BYTES + (w + 4 * i) * 1024), 16, 0, 0); }
}
#define ATT_WAIT_BAR(n) do { asm volatile("s_waitcnt vmcnt(" #n ") lgkmcnt(0)" ::: "memory"); __builtin_amdgcn_s_barrier(); asm volatile("" ::: "memory"); } while (0)
struct AttState { f32x4 O[4][2]; float m[2], l[2]; };
__device__ __forceinline__ void att_reset(AttState& S) {
#pragma unroll
    for (int q = 0; q < 2; ++q) { S.m[q] = NEGF; S.l[q] = 0.f;
#pragma unroll
        for (int d = 0; d < 4; ++d) S.O[d][q] = (f32x4){0.f, 0.f, 0.f, 0.f}; }
}
template <bool MASKED>
__device__ __forceinline__ void att_step(const char* lds, const bf16x8 (&qf)[2][2], AttState& S, const f32x4 (&bini)[4], float slope2,
                                         int s0, int tq0, unsigned selbits  , int winlimit) {
    const int lane = tidx() & 63, fr = lane & 15, fg = lane >> 4;
    const char* ldsV = lds + ATT_K_BYTES;
    const float offbase = slope2 * (float)s0;
    f32x4 s[2][4];
#pragma unroll
    for (int kt = 0; kt < 4; ++kt) {
        const bf16x8 k0 = *(const bf16x8*)(lds + lds_off(kt * 16 + fr, fg * 8)), k1 = *(const bf16x8*)(lds + lds_off(kt * 16 + fr, 32 + fg * 8));
#pragma unroll
        for (int qt = 0; qt < 2; ++qt) {
            s[qt][kt] = __builtin_amdgcn_mfma_f32_16x16x32_bf16(k0, qf[qt][0], bini[kt], 0, 0, 0);
            s[qt][kt] = __builtin_amdgcn_mfma_f32_16x16x32_bf16(k1, qf[qt][1], s[qt][kt], 0, 0, 0);
        }
    }
    __builtin_amdgcn_sched_barrier(0);
    u32x4 pf[2][2];
#pragma unroll
    for (int qt = 0; qt < 2; ++qt) {
        const int tq = tq0 + qt * 16 + fr;
        const float off = ((selbits >> qt) & 1u) ? (offbase - slope2 * (float)tq) : -INFINITY;
        float mx = -INFINITY;
#pragma unroll
        for (int kt = 0; kt < 4; ++kt)
#pragma unroll
            for (int r = 0; r < 4; ++r) {
                float y = s[qt][kt][r];
                if (MASKED) { const int key = s0 + kt * 16 + fg * 4 + r; const bool ok = (key <= tq) && (tq - key < winlimit); y = ok ? y : -INFINITY; s[qt][kt][r] = y; }
                mx = fmaxf(mx, y);
            }
        mx = fmaxf(mx, __shfl_xor(mx, 16)); mx = fmaxf(mx, __shfl_xor(mx, 32));
        const float mnew = fmaxf(S.m[qt], mx + off);
        const float alpha = __builtin_amdgcn_exp2f(S.m[qt] - mnew);
        S.m[qt] = mnew;
        const float thr = mnew - off;
        float ls = 0.f;
#pragma unroll
        for (int kt = 0; kt < 4; ++kt)
#pragma unroll
            for (int r = 0; r < 4; ++r) { const float pr = __builtin_amdgcn_exp2f(s[qt][kt][r] - thr); s[qt][kt][r] = pr; ls += pr; }
        S.l[qt] = S.l[qt] * alpha + ls;
#pragma unroll
        for (int dt = 0; dt < 4; ++dt) S.O[dt][qt] *= alpha;
#pragma unroll
        for (int kk = 0; kk < 2; ++kk) {
            pf[qt][kk].x = pack2(s[qt][2 * kk][0], s[qt][2 * kk][1]); pf[qt][kk].y = pack2(s[qt][2 * kk][2], s[qt][2 * kk][3]);
            pf[qt][kk].z = pack2(s[qt][2 * kk + 1][0], s[qt][2 * kk + 1][1]); pf[qt][kk].w = pack2(s[qt][2 * kk + 1][2], s[qt][2 * kk + 1][3]);
        }
    }
    __builtin_amdgcn_sched_barrier(0);
#pragma unroll
    for (int kk = 0; kk < 2; ++kk)
#pragma unroll
        for (int dt = 0; dt < 4; ++dt) {
            const char* vb = ldsV + (fg & 1) * 8;
            const u32x2 v0 = *(const u32x2*)(vb + lds_off(dt * 16 + fr, kk * 32 + (fg >> 1) * 8)), v1 = *(const u32x2*)(vb + lds_off(dt * 16 + fr, kk * 32 + 16 + (fg >> 1) * 8));
            u32x4 vv; vv.x = v0.x; vv.y = v0.y; vv.z = v1.x; vv.w = v1.y;
            const bf16x8 vf = __builtin_bit_cast(bf16x8, vv);
#pragma unroll
            for (int qt = 0; qt < 2; ++qt) S.O[dt][qt] = __builtin_amdgcn_mfma_f32_16x16x32_bf16(vf, __builtin_bit_cast(bf16x8, pf[qt][kk]), S.O[dt][qt], 0, 0, 0);
        }
    __builtin_amdgcn_sched_barrier(0);
}
__device__ __forceinline__ unsigned wave_or(unsigned v) {
#pragma unroll
    for (int o = 32; o >= 1; o >>= 1) v |= (unsigned)__shfl_xor((int)v, o);
    return v;
}
__device__ __forceinline__ void att_nsa_unit(char* lds, const P& p, int b, int g, int qtile) {
    const int tid = tidx(), lane = tid & 63, w = tid >> 6, fr = lane & 15, fg = lane >> 4;
    const int hd = g * 4 + w, t0 = qtile * 32, own = qtile >> 1;
    const float slope2 = exp2f(-((float)hd + 0.5f)) * LOG2E, c1 = 0.125f * LOG2E;
    bf16x8 qf[2][2];
#pragma unroll
    for (int qt = 0; qt < 2; ++qt)
#pragma unroll
        for (int ks = 0; ks < 2; ++ks) qf[qt][ks] = *(const bf16x8*)(p.Qb + (size_t)(b * SEQ + t0 + qt * 16 + fr) * 512 + hd * 64 + ks * 32 + fg * 8);
#pragma unroll
    for (int qt = 0; qt < 2; ++qt)
#pragma unroll
        for (int ks = 0; ks < 2; ++ks) {
            const u32x4 raw = __builtin_bit_cast(u32x4, qf[qt][ks]); u32x4 o;
            o.x = pack2(bf2f(raw.x & 0xffffu) * c1, bf2f(raw.x >> 16) * c1); o.y = pack2(bf2f(raw.y & 0xffffu) * c1, bf2f(raw.y >> 16) * c1);
            o.z = pack2(bf2f(raw.z & 0xffffu) * c1, bf2f(raw.z >> 16) * c1); o.w = pack2(bf2f(raw.w & 0xffffu) * c1, bf2f(raw.w >> 16) * c1);
            qf[qt][ks] = __builtin_bit_cast(bf16x8, o);
        }
    f32x4 bini[4];
#pragma unroll
    for (int kt = 0; kt < 4; ++kt)
#pragma unroll
        for (int r = 0; r < 4; ++r) bini[kt][r] = slope2 * (float)(kt * 16 + fg * 4 + r);
    unsigned selw[2];
#pragma unroll
    for (int qt = 0; qt < 2; ++qt) selw[qt] = p.SELM[(size_t)(b * 2 + g) * SEQ + t0 + qt * 16 + fr];
    const unsigned um = wave_or(selw[0] | selw[1]);
    AttState S; att_reset(S);
    unsigned rem = um & ((own >= 31) ? 0xffffffffu : ((2u << own) - 1u));
    int wj = own >= 8 ? own - 8 : 0;
    int cbr, cj; bool has = true;
    if (rem) { cj = __ffs(rem) - 1; rem &= rem - 1; cbr = 0; } else { cj = wj++; cbr = 1; }
    const bf16_t* Ks = p.KS + (size_t)b * SEQ * 128 + g * 64; const bf16_t* Kw = p.KW + (size_t)b * SEQ * 128 + g * 64;
    const bf16_t* Vs = p.VSt + (size_t)(b * 128 + g * 64) * SEQ; const bf16_t* Vw = p.VWt + (size_t)(b * 128 + g * 64) * SEQ;
    int n1br = 0, n1j = 0; bool has1;
    if (rem) { n1j = __ffs(rem) - 1; rem &= rem - 1; n1br = 0; has1 = true; } else if (wj <= own) { n1j = wj++; n1br = 1; has1 = true; } else has1 = false;
    __syncthreads();
    att_issue_tile(0, (cbr ? Kw : Ks) + (size_t)cj * 64 * 128, 128, (cbr ? Vw : Vs) + cj * 64);
    if (has1) att_issue_tile(1, (n1br ? Kw : Ks) + (size_t)n1j * 64 * 128, 128, (n1br ? Vw : Vs) + n1j * 64);
    bool switched = false;
    int st = 0;
    while (has) {
        if (has1) ATT_WAIT_BAR(4); else ATT_WAIT_BAR(0);
        int n2br = 0, n2j = 0; bool has2;
        if (!has1) has2 = false;
        else if (rem) { n2j = __ffs(rem) - 1; rem &= rem - 1; n2br = 0; has2 = true; } else if (wj <= own) { n2j = wj++; n2br = 1; has2 = true; } else has2 = false;
        if (has2) att_issue_tile(st == 0 ? 2 : st - 1, (n2br ? Kw : Ks) + (size_t)n2j * 64 * 128, 128, (n2br ? Vw : Vs) + n2j * 64);
        const char* sl = lds + st * ATT_STAGE;
        if (cbr == 1 && !switched) {
            switched = true;
#pragma unroll
            for (int qt = 0; qt < 2; ++qt) {
                float lt = S.l[qt]; lt += __shfl_xor(lt, 16); lt += __shfl_xor(lt, 32);
                const size_t n = (size_t)b * SEQ + t0 + qt * 16 + fr;
                const float sc = sigmoidf_(p.GATES[n * 24 + hd * 3 + 1]) / fmaxf(lt, 1e-30f);
#pragma unroll
                for (int dt = 0; dt < 4; ++dt) { const f32x4 y = S.O[dt][qt] * sc; u32x2 w; w.x = pack2(y[0], y[1]); w.y = pack2(y[2], y[3]); *(u32x2*)((bf16_t*)p.OS + n * 512 + hd * 64 + dt * 16 + fg * 4) = w; }
            }
            att_reset(S);
        }
        unsigned sb = 3u; int wl = 1 << 30; bool msk;
        if (cbr == 0) { sb = ((selw[0] >> cj) & 1u) | (((selw[1] >> cj) & 1u) << 1); msk = (cj == own); }
        else { wl = 512; msk = (cj == own) || (cj + 8 == own); }
        if (msk) att_step<true>(sl, qf, S, bini, slope2, cj * 64, t0, sb, wl);
        else att_step<false>(sl, qf, S, bini, slope2, cj * 64, t0, sb, wl);
        cbr = n1br; cj = n1j; has = has1; n1br = n2br; n1j = n2j; has1 = has2;
        st = (st == 2) ? 0 : st + 1;
    }
#pragma unroll
    for (int qt = 0; qt < 2; ++qt) {
        float lt = S.l[qt]; lt += __shfl_xor(lt, 16); lt += __shfl_xor(lt, 32);
        const size_t n = (size_t)b * SEQ + t0 + qt * 16 + fr;
        const float sc = sigmoidf_(p.GATES[n * 24 + hd * 3 + 2]) / fmaxf(lt, 1e-30f);
        const float g0 = sigmoidf_(p.GATES[n * 24 + hd * 3 + 0]);
#pragma unroll
        for (int dt = 0; dt < 4; ++dt) {
            const size_t o = n * 512 + hd * 64 + dt * 16 + fg * 4;
            const u32x2 osv = *(const u32x2*)((const bf16_t*)p.OS + o), ocv = *(const u32x2*)((const bf16_t*)p.OC + o);
            const f32x4 osf = {bf2f(osv.x & 0xffffu), bf2f(osv.x >> 16), bf2f(osv.y & 0xffffu), bf2f(osv.y >> 16)};
            const f32x4 ocf = {bf2f(ocv.x & 0xffffu), bf2f(ocv.x >> 16), bf2f(ocv.y & 0xffffu), bf2f(ocv.y >> 16)};
            const f32x4 y = S.O[dt][qt] * sc + osf + ocf * g0;
            u32x2 wv; wv.x = pack2(y[0], y[1]); wv.y = pack2(y[2], y[3]);
            *(u32x2*)(p.MIX + n * DM + hd * 64 + dt * 16 + fg * 4) = wv;
        }
    }
}
__device__ __forceinline__ void att_moba_unit(char* lds, const P& p, int b, int h, int ob, int half) {
    const int tid = tidx(), lane = tid & 63, w = tid >> 6, fr = lane & 15, fg = lane >> 4;
    const int tq0 = ob * 256 + half * 128 + w * 32;
    const int dsub = half * 2 + (w >> 1), lastsub = half * 2 + 1;
    const float slope2 = exp2f(-((float)h + 1.0f)) * LOG2E, c1 = 0.125f * LOG2E;
    bf16x8 qf[2][2];
#pragma unroll
    for (int qt = 0; qt < 2; ++qt)
#pragma unroll
        for (int ks = 0; ks < 2; ++ks) qf[qt][ks] = *(const bf16x8*)(p.MQ + (size_t)(b * SEQ + tq0 + qt * 16 + fr) * 512 + h * 64 + ks * 32 + fg * 8);
#pragma unroll
    for (int qt = 0; qt < 2; ++qt)
#pragma unroll
        for (int ks = 0; ks < 2; ++ks) {
            const u32x4 raw = __builtin_bit_cast(u32x4, qf[qt][ks]); u32x4 o;
            o.x = pack2(bf2f(raw.x & 0xffffu) * c1, bf2f(raw.x >> 16) * c1); o.y = pack2(bf2f(raw.y & 0xffffu) * c1, bf2f(raw.y >> 16) * c1);
            o.z = pack2(bf2f(raw.z & 0xffffu) * c1, bf2f(raw.z >> 16) * c1); o.w = pack2(bf2f(raw.w & 0xffffu) * c1, bf2f(raw.w >> 16) * c1);
            qf[qt][ks] = __builtin_bit_cast(bf16x8, o);
        }
    f32x4 bini[4];
#pragma unroll
    for (int kt = 0; kt < 4; ++kt)
#pragma unroll
        for (int r = 0; r < 4; ++r) bini[kt][r] = slope2 * (float)(kt * 16 + fg * 4 + r);
    unsigned selw[2];
#pragma unroll
    for (int qt = 0; qt < 2; ++qt) selw[qt] = p.MSEL[(size_t)(b * 8 + h) * SEQ + tq0 + qt * 16 + fr];
    unsigned* red = (unsigned*)(lds + ATT_RED_OFF);
    const unsigned umw = wave_or(selw[0] | selw[1]);
    __syncthreads();
    if (lane == 0) red[w] = umw;
    __syncthreads();
    unsigned rem = (red[0] | red[1] | red[2] | red[3]) & ((1u << ob) - 1u);
    AttState S; att_reset(S);
    int cj, csub = 0; bool has = true;
    if (rem) { cj = __ffs(rem) - 1; rem &= rem - 1; } else cj = ob;
    const bf16_t* Kb = p.MK + (size_t)b * SEQ * 512 + h * 64; const bf16_t* Vb = p.MVt + (size_t)(b * 512 + h * 64) * SEQ;
#define MOBA_NEXT(J, SUB, NJ, NSUB, HAS) do { \
        if ((J) == ob) { if ((SUB) < lastsub) { NJ = (J); NSUB = (SUB) + 1; HAS = true; } else HAS = false; } \
        else if ((SUB) < 3) { NJ = (J); NSUB = (SUB) + 1; HAS = true; } \
        else { if (rem) { NJ = __ffs(rem) - 1; rem &= rem - 1; } else NJ = ob; NSUB = 0; HAS = true; } } while (0)
    int n1j = 0, n1sub = 0; bool has1;
    MOBA_NEXT(cj, csub, n1j, n1sub, has1);
    __syncthreads();
    att_issue_tile(0, Kb + (size_t)(cj * 256 + csub * 64) * 512, 512, Vb + cj * 256 + csub * 64);
    if (has1) att_issue_tile(1, Kb + (size_t)(n1j * 256 + n1sub * 64) * 512, 512, Vb + n1j * 256 + n1sub * 64);
    int st = 0;
    while (has) {
        if (has1) ATT_WAIT_BAR(4); else ATT_WAIT_BAR(0);
        int n2j = 0, n2sub = 0; bool has2 = false;
        if (has1) MOBA_NEXT(n1j, n1sub, n2j, n2sub, has2);
        if (has2) att_issue_tile(st == 0 ? 2 : st - 1, Kb + (size_t)(n2j * 256 + n2sub * 64) * 512, 512, Vb + n2j * 256 + n2sub * 64);
        const char* sl = lds + st * ATT_STAGE;
        const int s0 = cj * 256 + csub * 64;
        unsigned sb = 3u; bool msk = false, run = true;
        if (cj < ob) sb = ((selw[0] >> cj) & 1u) | (((selw[1] >> cj) & 1u) << 1);
        else { msk = (csub == dsub); run = (csub <= dsub); }
        if (run) {
            if (msk) att_step<true>(sl, qf, S, bini, slope2, s0, tq0, sb, 1 << 30);
            else att_step<false>(sl, qf, S, bini, slope2, s0, tq0, sb, 1 << 30);
        }
        cj = n1j; csub = n1sub; has = has1; n1j = n2j; n1sub = n2sub; has1 = has2;
        st = (st == 2) ? 0 : st + 1;
    }
#undef MOBA_NEXT
#pragma unroll
    for (int qt = 0; qt < 2; ++qt) {
        float lt = S.l[qt]; lt += __shfl_xor(lt, 16); lt += __shfl_xor(lt, 32);
        const size_t n = (size_t)b * SEQ + tq0 + qt * 16 + fr;
        const float sc = 1.0f / fmaxf(lt, 1e-30f);
#pragma unroll
        for (int dt = 0; dt < 4; ++dt) {
            const f32x4 y = S.O[dt][qt] * sc;
            u32x2 wv; wv.x = pack2(y[0], y[1]); wv.y = pack2(y[2], y[3]);
            *(u32x2*)(p.MIX + n * DM + 512 + h * 64 + dt * 16 + fg * 4) = wv;
        }
    }
}
#ifndef ATT_NSA
#define ATT_NSA 1
#endif
#ifndef ATT_MOBA
#define ATT_MOBA 1
#endif
__device__ __forceinline__ int att_class_key(int c) {
    if (c < 64) { const int a = (c >> 1) + 1; return (a < 16 ? a : 16) + (a < 9 ? a : 9); }
    const int ob = (c - 64) >> 1, half = (c - 64) & 1; return 4 * ob + 2 + 2 * half;
}
__device__ __forceinline__ void cmpa_unit(char* lds, const P& p, int b, int g, int qt64);
__device__ __forceinline__ void phase_attn_a(char* lds, int bid, int nb, const P& p) {
    int* order = (int*)(lds + 49152);
    __syncthreads();
    for (int u = tidx(); u < 1024; u += 256) {
        const int c = u & 15, inst = u >> 4;
        const int key = att_class_key(64 + c);
        int pos = inst;
        for (int c2 = 0; c2 < 16; ++c2) { const int k2 = att_class_key(64 + c2); if (k2 > key || (k2 == key && c2 < c)) pos += 64; }
        order[pos] = u;
    }
    __syncthreads();
    for (int r = 0;; ++r) {
        const int idx = r * nb + ((r & 1) ? (nb - 1 - bid) : bid);
        if (idx >= 512 + 1024) break;
        if (idx < 512) cmpa_unit(lds, p, idx >> 6, (idx >> 5) & 1, idx & 31);
        else { const int v = order[idx - 512]; att_moba_unit(lds, p, v >> 7, (v >> 4) & 7, (v >> 1) & 7, v & 1); }
    }
    __syncthreads();
}
__device__ __forceinline__ void phase_attn_b(char* lds, int bid, int nb, const P& p) {
    int* order = (int*)(lds + ATT_ORDER_OFF);
    __syncthreads();
    for (int u = tidx(); u < 1024; u += 256) {
        const int c = u & 63, inst = u >> 6;
        const int key = att_class_key(c);
        int pos = inst;
        for (int c2 = 0; c2 < 64; ++c2) { const int k2 = att_class_key(c2); if (k2 > key || (k2 == key && c2 < c)) pos += 16; }
        order[pos] = u;
    }
    __syncthreads();
    for (int r = 0;; ++r) {
        const int idx = r * nb + ((r & 1) ? (nb - 1 - bid) : bid);
        if (idx >= 1024) break;
        const int u = order[idx];
        att_nsa_unit(lds, p, u >> 7, (u >> 6) & 1, u & 63);
    }
    __syncthreads();
}

struct ALoadCmp {
    const float* base;
    const float* pe;
    int kt0;
    struct Regs { f32x4 v[8]; };
    __device__ __forceinline__ void load(int kt, Regs& R) const {
        const int l = kt + kt0;
        const f32x4 p0 = *(const f32x4*)(pe + l * 64), p1 = *(const f32x4*)(pe + l * 64 + 4);
#pragma unroll
        for (int i = 0; i < 4; ++i) {
            const int row = (tidx() + 256 * i) >> 3; int tok = 16 * row + l; tok = tok > SEQ - 1 ? SEQ - 1 : tok;
            const float* q = base + (size_t)tok * 256;
            R.v[2 * i] = *(const f32x4*)q + p0; R.v[2 * i + 1] = *(const f32x4*)(q + 4) + p1;
        }
    }
    __device__ __forceinline__ void store(int kt, const Regs& R, char* lds) const {
#pragma unroll
        for (int i = 0; i < 4; ++i) {
            const int p = tidx() + 256 * i, row = p >> 3, ch = p & 7;
            const f32x4 a = R.v[2 * i], b = R.v[2 * i + 1];
            u32x4 w; w.x = pack2(a[0], a[1]); w.y = pack2(a[2], a[3]); w.z = pack2(b[0], b[1]); w.w = pack2(b[2], b[3]);
            *(u32x4*)(lds + lds_off(row, ch * 8)) = w;
        }
    }
};
__device__ __forceinline__ void phase_cmp1(char* lds, int bid, int nb, const P& p) {
    const int tid = tidx(), lane = tid & 63, wid = tid >> 6, wr = wid >> 1, wc = wid & 1, fr = lane & 15, fq = lane >> 4;
    for (int u = bid; u < 16 * 2 * 4; u += nb) {
        const int split = u & 3, which = (u >> 2) & 1, bg = u >> 3, b = bg >> 1, g = bg & 1;
        ALoadCmp al; al.kt0 = split * 8; al.base = p.KCV + (size_t)b * SEQ * 256 + which * 128 + g * 64 + (tid & 7) * 8; al.pe = (which ? p.pe_v : p.pe_k) + (tid & 7) * 8;
        BLoadF32 bl; { const int nq = tid & 31, kg = tid >> 5; bl.valid = true; bl.ldb = 128; bl.nk1 = 1 << 30; bl.bp = (which ? p.wv1 : p.wk1) + (size_t)(split * 8 * 64 + kg * 8) * 128 + nq * 4; }
        f32x4 acc[4][4];
        gemm_tile(lds, al, bl, 8, acc);
        float* hid = p.HID + (((size_t)split * 2 + which) * 2048 + bg * 128) * 128;
#pragma unroll
        for (int m = 0; m < 4; ++m)
#pragma unroll
            for (int n = 0; n < 4; ++n) {
                const int row = wr * 64 + m * 16 + fr, col = wc * 64 + n * 16 + fq * 4;
                *(f32x4*)(hid + (size_t)row * 128 + col) = acc[m][n];
            }
    }
}
__device__ __forceinline__ void phase_cmp2(char* lds, int bid, int nb, const P& p) {
    const int tid = tidx(), lane = tid & 63, wid = tid >> 6;
    float* hs = (float*)lds + wid * 128;
    for (int it = bid * 4 + wid; it < 2 * 16 * 128; it += nb * 4) {
        const int which = it >> 11, bg = (it >> 7) & 15, c = it & 127;
        float o = 0.f;
        if (c < 127) {
            const float* hid = p.HID + ((size_t)which * 2048 + bg * 128 + c) * 128;
            const size_t ss = (size_t)2 * 2048 * 128;
            __builtin_amdgcn_wave_barrier();
            hs[lane] = gelu_tanh((hid[lane] + hid[ss + lane]) + (hid[2 * ss + lane] + hid[3 * ss + lane]));
            hs[lane + 64] = gelu_tanh((hid[lane + 64] + hid[ss + lane + 64]) + (hid[2 * ss + lane + 64] + hid[3 * ss + lane + 64]));
            __builtin_amdgcn_wave_barrier();
            const float* w2 = which ? p.wv2 : p.wk2;
#pragma unroll 16
            for (int j = 0; j < 128; ++j) o += hs[j] * w2[j * 64 + lane];
        }
        if (which == 0) p.KCb[((size_t)bg * 128 + c) * 64 + lane] = (bf16_t)f2bf(o);
        else p.VCt[((size_t)bg * 64 + lane) * 128 + c] = (bf16_t)f2bf(o);
    }
}
#define CMPA_LDS (2 * 16384 + 4 * 2048)
__device__ __forceinline__ void cmpa_unit(char* lds, const P& p, int b, int g, int qt64) {
    const int tid = tidx(), lane = tid & 63, w = tid >> 6, fr = lane & 15, fg = lane >> 4;
    const int bg = b * 2 + g;
    char* kc = lds; char* vt = lds + 16384;
    __syncthreads();
#pragma unroll
    for (int i = 0; i < 4; ++i) { const int pc = tid + 256 * i;
        *(u32x4*)(kc + lds_off(pc >> 3, (pc & 7) * 8)) = *(const u32x4*)(p.KCb + (size_t)bg * 8192 + pc * 8);
        *(u32x4*)(vt + lds_off128(pc >> 4, (pc & 15) * 8)) = *(const u32x4*)(p.VCt + (size_t)bg * 8192 + pc * 8); }
    __syncthreads();
    const int t = qt64 * 64 + w * 16 + fr;
    const size_t n = (size_t)b * SEQ + t;
    const float c1 = 0.125f * LOG2E;
    f32x4 psum[8];
#pragma unroll
    for (int ct = 0; ct < 8; ++ct) psum[ct] = (f32x4){0.f, 0.f, 0.f, 0.f};
    bf16x8 qall[4][2];
#pragma unroll
    for (int i = 0; i < 4; ++i) { qall[i][0] = *(const bf16x8*)(p.Qb + n * 512 + (g * 4 + i) * 64 + fg * 8); qall[i][1] = *(const bf16x8*)(p.Qb + n * 512 + (g * 4 + i) * 64 + 32 + fg * 8); }
#pragma unroll
    for (int i = 0; i < 4; ++i) {
        const int hd = g * 4 + i;
        const float slope2 = exp2f(-((float)hd + 0.5f)) * LOG2E;
        const bf16x8 q0 = qall[i][0], q1 = qall[i][1];
        __builtin_amdgcn_sched_barrier(0);
        f32x4 s[8];
        float mx = -INFINITY;
#pragma unroll
        for (int ct = 0; ct < 8; ++ct) {
            const bf16x8 k0 = *(const bf16x8*)(kc + lds_off(ct * 16 + fr, fg * 8)), k1 = *(const bf16x8*)(kc + lds_off(ct * 16 + fr, 32 + fg * 8));
            s[ct] = __builtin_amdgcn_mfma_f32_16x16x32_bf16(k0, q0, (f32x4){0.f, 0.f, 0.f, 0.f}, 0, 0, 0);
            s[ct] = __builtin_amdgcn_mfma_f32_16x16x32_bf16(k1, q1, s[ct], 0, 0, 0);
#pragma unroll
            for (int r = 0; r < 4; ++r) {
                const int e = 16 * (ct * 16 + fg * 4 + r) + 31;
                const float y = (e <= t) ? fmaf(s[ct][r], c1, -slope2 * (float)(t - e)) : -INFINITY;
                s[ct][r] = y; mx = fmaxf(mx, y);
            }
        }
        __builtin_amdgcn_sched_barrier(0);
        mx = fmaxf(mx, __shfl_xor(mx, 16)); mx = fmaxf(mx, __shfl_xor(mx, 32));
        const float mm = (mx == -INFINITY) ? 0.f : mx;
        float ls = 0.f;
#pragma unroll
        for (int ct = 0; ct < 8; ++ct)
#pragma unroll
            for (int r = 0; r < 4; ++r) { const float e = __builtin_amdgcn_exp2f(s[ct][r] - mm); s[ct][r] = e; ls += e; }
        ls += __shfl_xor(ls, 16); ls += __shfl_xor(ls, 32);
        const float inv = 1.0f / fmaxf(ls, 1e-30f);
#pragma unroll
        for (int ct = 0; ct < 8; ++ct) { s[ct] *= inv; psum[ct] += s[ct]; }
        __builtin_amdgcn_sched_barrier(0);
        f32x4 o[4];
#pragma unroll
        for (int dt = 0; dt < 4; ++dt) o[dt] = (f32x4){0.f, 0.f, 0.f, 0.f};
#pragma unroll
        for (int kk = 0; kk < 4; ++kk) {
            u32x4 pw; pw.x = pack2(s[2 * kk][0], s[2 * kk][1]); pw.y = pack2(s[2 * kk][2], s[2 * kk][3]); pw.z = pack2(s[2 * kk + 1][0], s[2 * kk + 1][1]); pw.w = pack2(s[2 * kk + 1][2], s[2 * kk + 1][3]);
            const bf16x8 pf = __builtin_bit_cast(bf16x8, pw);
#pragma unroll
            for (int dt = 0; dt < 4; ++dt) {
                const int c0 = kk * 32 + fg * 4;
                const u32x2 v0 = *(const u32x2*)(vt + lds_off128(dt * 16 + fr, c0 & ~7) + (c0 & 7) * 2);
                const u32x2 v1 = *(const u32x2*)(vt + lds_off128(dt * 16 + fr, (c0 + 16) & ~7) + (c0 & 7) * 2);
                u32x4 vv; vv.x = v0.x; vv.y = v0.y; vv.z = v1.x; vv.w = v1.y;
                o[dt] = __builtin_amdgcn_mfma_f32_16x16x32_bf16(__builtin_bit_cast(bf16x8, vv), pf, o[dt], 0, 0, 0);
            }
        }
#pragma unroll
        for (int dt = 0; dt < 4; ++dt) { u32x2 w; w.x = pack2(o[dt][0], o[dt][1]); w.y = pack2(o[dt][2], o[dt][3]); *(u32x2*)((bf16_t*)p.OC + n * 512 + hd * 64 + dt * 16 + fg * 4) = w; }
    }
    const int own = t >> 6;
    float val[8];
#pragma unroll
    for (int ct = 0; ct < 8; ++ct) {
        const float up = __shfl(psum[ct][3], (lane + 48) & 63);
        const float up0 = (ct > 0) ? __shfl(psum[ct > 0 ? ct - 1 : 0][3], (lane + 48) & 63) : 0.f;
        const float imp = (psum[ct][0] + psum[ct][1]) + (psum[ct][2] + psum[ct][3]) + (fg > 0 ? up : up0);
        const int j = ct * 4 + fg;
        const bool forced = (j == 0) || (j == own) || (j == own - 1);
        val[ct] = (j <= own) ? (imp + (forced ? 1e4f : 0.f)) : NEGF;
    }
    float* vs = (float*)(lds + 32768) + w * 512;
    __builtin_amdgcn_wave_barrier();
#pragma unroll
    for (int ct = 0; ct < 8; ++ct) vs[fr * 32 + ct * 4 + fg] = val[ct];
    __builtin_amdgcn_wave_barrier();
    int rank[8];
#pragma unroll
    for (int ct = 0; ct < 8; ++ct) rank[ct] = 0;
#pragma unroll 2
    for (int oj = 0; oj < 32; ++oj) {
        const float ov = vs[fr * 32 + oj];
#pragma unroll
        for (int ct = 0; ct < 8; ++ct) rank[ct] += (ov > val[ct] || (ov == val[ct] && oj < ct * 4 + fg)) ? 1 : 0;
    }
    __builtin_amdgcn_wave_barrier();
    unsigned bits = 0;
#pragma unroll
    for (int ct = 0; ct < 8; ++ct) if ((ct * 4 + fg <= own) && rank[ct] < 16) bits |= 1u << (ct * 4 + fg);
    bits |= (unsigned)__shfl_xor((int)bits, 16); bits |= (unsigned)__shfl_xor((int)bits, 32);
    if (fg == 0) p.SELM[(size_t)bg * SEQ + t] = bits;
}
#define MEGA_LDS (((HG3_LDS + 255) & ~255) + 16)
static_assert(HG3_LDS >= G4_LDS && HG3_LDS >= CMPA_LDS && HG3_LDS >= GEMM_LDS && HG3_LDS >= ATT_RED_OFF + 16, "LDS map");
#define GBAR() xcd_barrier(bar)

template <int LAYER>
__device__ __forceinline__ void moe_block(char* lds, int bid, int nb, const P& p, const XcdBarrier& bar, float* of, bf16_t* ob, bf16_t* ol) {
    if (bid < 32) p.cnt[bid * NEXP + tidx()] = 0;
    phase_router(bid, nb, p, LAYER);
    GBAR();
    phase_route(bid, nb, p, LAYER);
    GBAR();
    phase_scatter(lds, bid, nb, p);
    GBAR();
    phase_moe1(lds, bid, nb, p, LAYER, p.XAb);
    GBAR();
    phase_moe2(lds, bid, nb, p, LAYER);
    GBAR();
    phase_combine_ln(bid, nb, p, p.XA, p.ln_g + (LAYER * 2 + 1) * DM, p.ln_b + (LAYER * 2 + 1) * DM, of, ob, ol);
}

__global__ void __launch_bounds__(256, 2) mega(P p) {
    char* lds = dyn_lds;
    const int bid = blockIdx.x, nb = gridDim.x;
    volatile LAS unsigned* st = (volatile LAS unsigned*)(dyn_lds + MEGA_LDS - 16);
    if (tidx() == 0) { st[0] = 0u; st[1] = 0u; st[2] = 0u; st[3] = 0u; }
    __syncthreads();
    const XcdBarrier bar = xcd_barrier_post(p.bar, st);
    phase_prep(lds, bid, nb, p);
    GBAR();
    phase_inproj0(lds, bid, nb, p);
    GBAR();
    phase_mix0_a(lds, bid, nb, p);
    GBAR();
    phase_hg2(bid, nb, p);
    for (int u = nb - 1 - bid; u < 512; u += nb) lru2_unit(p, u >> 6, (u >> 1) & 31, u & 1);
    GBAR();
    phase_mix0_c(lds, bid, nb, p);
    GBAR();
    phase_gemm_f32out(bid, nb, p.MIX, p.WOUT0, DM, DM, p.T0);
    GBAR();
    phase_ln_add(bid, nb, p.x, nullptr, nullptr, p.T0, p.ln_g, p.ln_b, nullptr, p.XAb, p.XAl);
    GBAR();
    moe_block<0>(lds, bid, nb, p, bar, nullptr, p.XBb, nullptr);
    GBAR();
    phase_inproj1(lds, bid, nb, p);
    GBAR();
    phase_cmp1(lds, bid, nb, p);
    phase_moba_kmean(bid, nb, p);
    GBAR();
    phase_cmp2(lds, bid, nb, p);
    phase_moba_gate(lds, bid, nb, p);
    GBAR();
    phase_attn_a(lds, bid, nb, p);
    GBAR();
    phase_attn_b(lds, bid, nb, p);
    GBAR();
    phase_gemm_f32out(bid, nb, p.MIX, p.WOUT1, DM, DM, p.T0);
    GBAR();
    phase_ln_add(bid, nb, nullptr, p.XBb, p.XBl, p.T0, p.ln_g + 2 * DM, p.ln_b + 2 * DM, nullptr, p.XAb, p.XAl);
    GBAR();
    moe_block<1>(lds, bid, nb, p, bar, p.out, nullptr, nullptr);
}

static inline size_t al256(size_t x) { return (x + 255) & ~(size_t)255; }

extern "C" void kernel_launch(void* const* d_in, const int* in_sizes, int n_in, void* d_out, int out_size, void* d_ws, size_t ws_size, hipStream_t stream) {
    P p{};
    const float** ip = (const float**)&p.x;
    for (int i = 0; i < 30; ++i) ip[i] = (const float*)d_in[i];
    p.out = (float*)d_out;
    char* w = (char*)d_ws; size_t o = 0;
    auto take = [&](size_t bytes) { char* r = w + o; o = al256(o + bytes); return r; };
    p.bar = (unsigned*)take(XCD_BAR_WORDS * 4);
    p.U = nullptr;
    p.MIX = (bf16_t*)take((size_t)NTOK * DM * 2);
    p.T0 = (float*)take((size_t)NTOK * DM * 4);
    p.XA = nullptr; p.XAb = (bf16_t*)take((size_t)NTOK * DM * 2); p.XAl = (bf16_t*)take((size_t)NTOK * DM * 2); p.XBl = nullptr;
    p.XB = nullptr; p.XBb = (bf16_t*)take((size_t)NTOK * DM * 2);
    p.LOG = (float*)take((size_t)4 * NTOK * NEXP * 4);
    p.eidx = (int*)take(NTOK * 8 * 4); p.ew = (float*)take(NTOK * 8 * 4); p.erank = (int*)take(NTOK * 8 * 4); p.epos = (int*)take(NTOK * 8 * 4);
    p.cnt = (int*)take(32 * NEXP * 4); p.tile_e = (int*)take(NTILES * 4); p.rowtok = (int*)take(NROWS * 4);
    p.H = (bf16_t*)take((size_t)NROWS * 256 * 2);
    p.Y = (bf16_t*)take((size_t)NROWS * DM * 2);
    p.LA = (float*)take((size_t)NTOK * 512 * 4); p.LB = (float*)take((size_t)NTOK * 512 * 4);
    p.KC = nullptr; p.VC = nullptr;
    p.OC = (float*)take((size_t)NTOK * 512 * 4);
    p.SELM = (unsigned*)take(16 * SEQ * 4);
    p.KM = (float*)take(8 * 8 * 8 * 64 * 4);
    p.Qb = (bf16_t*)take((size_t)NTOK * 512 * 2); p.KS = (bf16_t*)take((size_t)NTOK * 128 * 2); p.VSt = (bf16_t*)take((size_t)NTOK * 128 * 2);
    p.KW = (bf16_t*)take((size_t)NTOK * 128 * 2); p.VWt = (bf16_t*)take((size_t)NTOK * 128 * 2);
    p.MQ = (bf16_t*)take((size_t)NTOK * 512 * 2); p.MK = (bf16_t*)take((size_t)NTOK * 512 * 2); p.MVt = (bf16_t*)take((size_t)NTOK * 512 * 2);
    p.KCV = (float*)take((size_t)NTOK * 256 * 4); p.GATES = (float*)take((size_t)NTOK * 24 * 4); p.OS = (float*)take((size_t)NTOK * 512 * 4);
    p.MSEL = (unsigned*)take(64 * SEQ * 4);
    p.UB0 = (bf16_t*)take((size_t)NTOK * 2560 * 2); p.VHt = (bf16_t*)take((size_t)NTOK * 512 * 2);
    p.WAT = (bf16_t*)take(8 * 64 * 64 * 2); p.WXT = (bf16_t*)take(8 * 64 * 64 * 2);
    p.CSA = (float*)take(8 * 32 * 512 * 4); p.CSB = (float*)take(8 * 32 * 512 * 4);
    p.UT = (bf16_t*)take((size_t)1024 * 16384 * 2); p.SP = (bf16_t*)take((size_t)1024 * 16384 * 2);
    p.DV = (float*)take(1024 * 128 * 4);
    p.XIb = (bf16_t*)take((size_t)NTOK * DM * 2);
    p.plist = (int*)take(8 * 320 * 4); p.plen = (int*)take(64);
    p.WIN0 = (bf16_t*)take((size_t)EVEN_IN * DM * 2); p.WOUT0 = (bf16_t*)take((size_t)DM * DM * 2); p.WIN1 = (bf16_t*)take((size_t)2944 * DM * 2); p.WOUT1 = (bf16_t*)take((size_t)DM * DM * 2);
    p.WRH = (bf16_t*)take((size_t)2 * NEXP * DM * 2); p.WRL = (bf16_t*)take((size_t)2 * NEXP * DM * 2);
    p.HID = (float*)take((size_t)4 * 2 * 2048 * 128 * 4); p.KCb = (bf16_t*)take(16 * 128 * 64 * 2); p.VCt = (bf16_t*)take(16 * 64 * 128 * 2);
    if (o > ws_size) return;

    static int grid = 0;
    if (!grid) {
        int dev = 0, cus = 0, per_cu = 0;
        (void)hipGetDevice(&dev);
        (void)hipDeviceGetAttribute(&cus, hipDeviceAttributeMultiprocessorCount, dev);
        (void)hipFuncSetAttribute((const void*)mega, hipFuncAttributeMaxDynamicSharedMemorySize, MEGA_LDS);
        (void)hipOccupancyMaxActiveBlocksPerMultiprocessor(&per_cu, (const void*)mega, 256, MEGA_LDS);
        if (per_cu < 1) per_cu = 1;
        grid = cus * (per_cu < 2 ? per_cu : 2);
    }
    (void)hipMemsetAsync(p.bar, 0, XCD_BAR_WORDS * 4, stream);
    hipLaunchKernelGGL(mega, dim3(grid), dim3(256), MEGA_LDS, stream, p);
}
```
